# Optimizing an MI355X kernel written in HIP

```python
import jax, jax.numpy as jnp
from jax import lax
import numpy as np


D_MODEL = 1024
BATCH = 2
SEQ = 8192
DEPTH = 1

N_META = 16
CHUNK = 128
FRONT = CHUNK - N_META
EPS = 1e-6

SSD_EXPAND = 2
SSD_D_INNER = SSD_EXPAND * D_MODEL
SSD_HEAD_DIM = 64
SSD_HEADS = SSD_D_INNER // SSD_HEAD_DIM
SSD_GROUPS = 4
SSD_STATE = 128
SSD_CONV = 4
SSD_CONV_DIM = SSD_D_INNER + 2 * SSD_GROUPS * SSD_STATE

RET_HEADS = 4
RET_QK_DIM = D_MODEL
RET_V_DIM = 2 * D_MODEL
RET_HEAD_QK = RET_QK_DIM // RET_HEADS
RET_HEAD_V = RET_V_DIM // RET_HEADS
ROPE_BASE = 10000.0

D_FF = ((8 * D_MODEL // 3 + 127) // 128) * 128
FFN_CONV = 3

IN_PROJ_DIM = SSD_D_INNER + SSD_CONV_DIM + SSD_HEADS + 2 * RET_QK_DIM + 2 * RET_V_DIM + 2 * D_MODEL

kernel_name = 'hybrid_ssd_retention_meta_block'


def _split_points():
    widths = [SSD_D_INNER, SSD_CONV_DIM, SSD_HEADS, RET_QK_DIM, RET_QK_DIM,
              RET_V_DIM, RET_V_DIM, D_MODEL, D_MODEL]
    pts = []
    acc = 0
    for w in widths[:-1]:
        acc += w
        pts.append(acc)
    return pts


def rmsnorm(x, w):
    xf = x.astype(jnp.float32)
    y = xf * lax.rsqrt(jnp.mean(xf * xf, axis=-1, keepdims=True) + EPS)
    return (y * w.astype(jnp.float32)).astype(x.dtype)


def causal_dwconv(x, w, b):
    k_width = w.shape[0]
    seq_len = x.shape[1]
    xp = jnp.pad(x, ((0, 0), (k_width - 1, 0), (0, 0)))
    y = b + xp[:, 0:seq_len] * w[0]
    for k in range(1, k_width):
        y = y + xp[:, k:k + seq_len] * w[k]
    return y


def _pad_to_chunks(t):
    n_tok = t.shape[1] - N_META
    end = (-n_tok) % CHUNK
    widths = [(0, 0), (FRONT, end)] + [(0, 0)] * (t.ndim - 2)
    return jnp.pad(t, widths)


def ssd_mixer(z, xbc, dt_raw, conv_w, conv_b, dt_bias, A_log, D_skip, norm_w):
    f32 = jnp.float32
    bsz, seq_len, _ = z.shape
    hpg = SSD_HEADS // SSD_GROUPS
    xbc = jax.nn.silu(causal_dwconv(xbc, conv_w, conv_b))
    xs, b_in, c_in = jnp.split(xbc, [SSD_D_INNER, SSD_D_INNER + SSD_GROUPS * SSD_STATE], axis=-1)
    dt = jax.nn.softplus(dt_raw.astype(f32) + dt_bias.astype(f32))
    xs, b_in, c_in, dt = [_pad_to_chunks(t) for t in (xs, b_in, c_in, dt)]
    n_chunks = xs.shape[1] // CHUNK
    xs = xs.reshape(bsz, n_chunks, CHUNK, SSD_GROUPS, hpg, SSD_HEAD_DIM)
    b_in = b_in.reshape(bsz, n_chunks, CHUNK, SSD_GROUPS, SSD_STATE)
    c_in = c_in.reshape(bsz, n_chunks, CHUNK, SSD_GROUPS, SSD_STATE)
    dt = dt.reshape(bsz, n_chunks, CHUNK, SSD_GROUPS, hpg)
    A = -jnp.exp(A_log.astype(f32)).reshape(SSD_GROUPS, hpg)
    a_cs = jnp.cumsum(dt * A, axis=2)
    xdt = xs * dt[..., None]
    causal = jnp.tril(jnp.ones((CHUNK, CHUNK), dtype=bool))
    seg = a_cs[:, :, :, None] - a_cs[:, :, None, :]
    decay_ls = jnp.exp(jnp.where(causal[:, :, None, None], seg, -jnp.inf))
    cb = jnp.einsum('bclgn,bcsgn->bclsg', c_in, b_in)
    y = jnp.einsum('bclsgh,bcsghp->bclghp', cb[..., None] * decay_ls, xdt)
    decay_to_end = jnp.exp(a_cs[:, :, -1:] - a_cs)
    chunk_states = jnp.einsum('bcsgn,bcsghp->bcghpn', b_in, xdt * decay_to_end[..., None])
    chunk_decay = jnp.exp(a_cs[:, :, -1])

    def step(state, inp):
        st, dec = inp
        return state * dec[..., None, None] + st, state

    init = jnp.zeros_like(chunk_states[:, 0])
    _, prev = lax.scan(step, init, (jnp.moveaxis(chunk_states, 1, 0), jnp.moveaxis(chunk_decay, 1, 0)))
    prev = jnp.moveaxis(prev, 0, 1)
    y = y + jnp.einsum('bclgn,bcghpn->bclghp', c_in, prev) * jnp.exp(a_cs)[..., None]
    y = y + D_skip.astype(f32).reshape(SSD_GROUPS, hpg, 1) * xs
    y = y.reshape(bsz, n_chunks * CHUNK, SSD_D_INNER)[:, FRONT:FRONT + seq_len]
    yz = (y * jax.nn.silu(z.astype(f32))).reshape(bsz, seq_len, SSD_GROUPS, -1)
    yz = yz * lax.rsqrt(jnp.mean(yz * yz, axis=-1, keepdims=True) + EPS)
    return (yz.reshape(bsz, seq_len, SSD_D_INNER) * norm_w.astype(f32)).astype(z.dtype)


def _rotary(t, cos, sin):
    half = t.shape[-1] // 2
    t1, t2 = t[..., :half], t[..., half:]
    return jnp.concatenate([t1 * cos - t2 * sin, t2 * cos + t1 * sin], axis=-1).astype(t.dtype)


def retention_mixer(q, k, v, g):
    f32 = jnp.float32
    bsz, seq_len, _ = q.shape
    q = q.reshape(bsz, seq_len, RET_HEADS, RET_HEAD_QK)
    k = k.reshape(bsz, seq_len, RET_HEADS, RET_HEAD_QK)
    v = v.reshape(bsz, seq_len, RET_HEADS, RET_HEAD_V)
    pos = jnp.arange(seq_len, dtype=f32)
    inv_freq = ROPE_BASE ** (-jnp.linspace(0.0, 1.0, RET_HEAD_QK // 2, dtype=f32))
    ang = pos[:, None] * inv_freq[None, :]
    cos = jnp.cos(ang)[None, :, None, :]
    sin = jnp.sin(ang)[None, :, None, :]
    q = _rotary(q, cos, sin)
    k = _rotary(k, cos, sin) * (RET_HEAD_QK ** -0.5)
    q, k, v = [_pad_to_chunks(t) for t in (q, k, v)]
    n_chunks = q.shape[1] // CHUNK
    q = q.reshape(bsz, n_chunks, CHUNK, RET_HEADS, RET_HEAD_QK)
    k = k.reshape(bsz, n_chunks, CHUNK, RET_HEADS, RET_HEAD_QK)
    v = v.reshape(bsz, n_chunks, CHUNK, RET_HEADS, RET_HEAD_V)
    log_gamma = jnp.log(1.0 - 2.0 ** (-5.0 - jnp.arange(RET_HEADS, dtype=f32)))
    idx = jnp.arange(CHUNK, dtype=f32)
    causal = jnp.tril(jnp.ones((CHUNK, CHUNK), dtype=bool))
    dist = (idx[:, None] - idx[None, :])[..., None] * log_gamma
    decay_ls = jnp.exp(jnp.where(causal[..., None], dist, -jnp.inf)).transpose(2, 0, 1)
    scores = jnp.einsum('bclhd,bcshd->bchls', q, k) * decay_ls
    out = jnp.einsum('bchls,bcshe->bclhe', scores, v)
    k_dec = k * jnp.exp((CHUNK - 1.0 - idx)[:, None] * log_gamma)[..., None]
    kv = jnp.einsum('bcshd,bcshe->bchde', k_dec, v)
    chunk_decay = jnp.exp(CHUNK * log_gamma)

    def step(state, kv_c):
        return state * chunk_decay[:, None, None] + kv_c, state

    init = jnp.zeros_like(kv[:, 0])
    _, prev = lax.scan(step, init, jnp.moveaxis(kv, 1, 0))
    prev = jnp.moveaxis(prev, 0, 1)
    cross = jnp.einsum('bclhd,bchde->bclhe', q, prev) * jnp.exp((idx + 1.0)[:, None] * log_gamma)[..., None]
    out = (out + cross).reshape(bsz, n_chunks * CHUNK, RET_HEADS, RET_HEAD_V)[:, FRONT:FRONT + seq_len]
    out = out.astype(f32)
    out = out * lax.rsqrt(jnp.mean(out * out, axis=-1, keepdims=True) + EPS)
    return (jax.nn.silu(g.astype(f32)) * out.reshape(bsz, seq_len, RET_V_DIM)).astype(g.dtype)


def setup_inputs(seed: int = 0) -> dict:
    key = jax.random.key(seed)
    ks = jax.random.split(key, 24)
    f32 = jnp.float32
    nrm = lambda k, shape, scale: jax.random.normal(k, shape, f32) * scale
    dt0 = jnp.exp(jax.random.uniform(ks[6], (DEPTH, SSD_HEADS), f32, np.log(1e-3), np.log(1e-1)))
    return {
        'x': nrm(ks[0], (BATCH, SEQ, D_MODEL), 1.0),
        'meta_tokens': nrm(ks[1], (N_META, D_MODEL), 1.0),
        'mix_norm_w': 1.0 + nrm(ks[2], (DEPTH, D_MODEL), 0.01),
        'w_in': nrm(ks[3], (DEPTH, D_MODEL, IN_PROJ_DIM), D_MODEL ** -0.5),
        'ssd_conv_w': nrm(ks[4], (DEPTH, SSD_CONV, SSD_CONV_DIM), SSD_CONV ** -0.5),
        'ssd_conv_b': nrm(ks[5], (DEPTH, SSD_CONV_DIM), 0.01),
        'ssd_dt_bias': dt0 + jnp.log(-jnp.expm1(-dt0)),
        'ssd_A_log': jnp.log(jax.random.uniform(ks[7], (DEPTH, SSD_HEADS), f32, 1.0, 16.0)),
        'ssd_D': 1.0 + nrm(ks[8], (DEPTH, SSD_HEADS), 0.01),
        'ssd_norm_w': 1.0 + nrm(ks[9], (DEPTH, SSD_D_INNER), 0.01),
        'w_branch_ssd': nrm(ks[10], (DEPTH, SSD_D_INNER, D_MODEL), SSD_D_INNER ** -0.5),
        'w_branch_ret': nrm(ks[11], (DEPTH, RET_V_DIM, D_MODEL), RET_V_DIM ** -0.5),
        'w_out': nrm(ks[12], (DEPTH, D_MODEL, D_MODEL), D_MODEL ** -0.5),
        'ffn_norm_w': 1.0 + nrm(ks[13], (DEPTH, D_MODEL), 0.01),
        'w_up': nrm(ks[14], (DEPTH, D_MODEL, 2 * D_FF), D_MODEL ** -0.5),
        'ffn_conv_w': nrm(ks[15], (DEPTH, FFN_CONV, 2 * D_FF), FFN_CONV ** -0.5),
        'ffn_conv_b': nrm(ks[16], (DEPTH, 2 * D_FF), 0.01),
        'w_down': nrm(ks[17], (DEPTH, D_FF, D_MODEL), D_FF ** -0.5),
        'final_norm_w': 1.0 + nrm(ks[18], (D_MODEL,), 0.01),
    }


def reference(x, meta_tokens, mix_norm_w, w_in, ssd_conv_w, ssd_conv_b, ssd_dt_bias, ssd_A_log,
              ssd_D, ssd_norm_w, w_branch_ssd, w_branch_ret, w_out, ffn_norm_w, w_up,
              ffn_conv_w, ffn_conv_b, w_down, final_norm_w):
    bsz = x.shape[0]
    meta = jnp.broadcast_to(meta_tokens[None].astype(x.dtype), (bsz, N_META, D_MODEL))
    h = jnp.concatenate([meta, x], axis=1)
    for layer in range(DEPTH):
        u = rmsnorm(h, mix_norm_w[layer])
        proj = u @ w_in[layer]
        z, xbc, dt_raw, q, k, v, g, gate_ssd, gate_ret = jnp.split(proj, _split_points(), axis=-1)
        y_ssd = ssd_mixer(z, xbc, dt_raw, ssd_conv_w[layer], ssd_conv_b[layer], ssd_dt_bias[layer],
                          ssd_A_log[layer], ssd_D[layer], ssd_norm_w[layer])
        y_ret = retention_mixer(q, k, v, g)
        merged = (jax.nn.sigmoid(gate_ssd) * (y_ssd @ w_branch_ssd[layer])
                  + jax.nn.sigmoid(gate_ret) * (y_ret @ w_branch_ret[layer]))
        h = h + merged @ w_out[layer]
        u = rmsnorm(h, ffn_norm_w[layer])
        a = causal_dwconv(u @ w_up[layer], ffn_conv_w[layer], ffn_conv_b[layer])
        a_gate, a_val = jnp.split(a, 2, axis=-1)
        h = h + (jax.nn.silu(a_gate) * a_val) @ w_down[layer]
    out = rmsnorm(h, final_norm_w)
    return out[:, N_META:]
```

```cpp
#include <hip/hip_runtime.h>
#include <hip/hip_cooperative_groups.h>
#include <cstdio>
namespace cg = cooperative_groups;

typedef unsigned short u16;
typedef __bf16 bf16x8 __attribute__((ext_vector_type(8)));
typedef short s16x4 __attribute__((ext_vector_type(4)));
typedef short s16x8 __attribute__((ext_vector_type(8)));
typedef float f32x16 __attribute__((ext_vector_type(16)));
typedef unsigned int u32x4 __attribute__((ext_vector_type(4)));
typedef unsigned int u32x2 __attribute__((ext_vector_type(2)));
typedef float f32x4 __attribute__((ext_vector_type(4)));

#define DEV __device__ __forceinline__
#define LDSP __attribute__((address_space(3)))

constexpr int D = 1024;
constexpr int L = 8208;
constexpr int SEQ = 8192;
constexpr int NMETA = 16;
constexpr int NPROJ = 13344;
constexpr int NPROJ_PAD = 13568;
constexpr int DFF = 2816;
constexpr float EPS = 1e-6f;

constexpr size_t OFF_Z = 0;
constexpr size_t OFF_G = 33619968;
constexpr size_t OFF_GS = 67239936;
constexpr size_t OFF_GR = 84049920;
constexpr size_t OFF_Q = 100859904;
constexpr size_t OFF_XBC = 117669888;
constexpr size_t OFF_K = 168099840;
constexpr size_t OFF_V = 184909824;
constexpr size_t OFF_DT = 218529792;
constexpr size_t OFF_S2 = 219580416;
constexpr size_t OFF_S1 = 227969024;
constexpr size_t OFF_CD = 261523456;
constexpr size_t OFF_HM = 261531648;
constexpr size_t OFF_BAR = 261597184;
constexpr size_t OFF_WOUT = OFF_S1;
constexpr size_t OFF_WUP = OFF_S1 + 2097152;
constexpr size_t OFF_WDOWN = OFF_S1 + 13631488;
constexpr size_t OFF_UP = OFF_XBC;
constexpr size_t OFF_ACT = OFF_Z;
constexpr size_t OFF_U2 = OFF_Q;
constexpr size_t OUT_HALF = 33554432;

constexpr int SMEM_TEAM = 73728;
constexpr int SMEM_BYTES = 2 * SMEM_TEAM;

struct Params {
  const float* in[19];
  float* out;
  char* ws;
};

DEV int get_tid8() { int t = threadIdx.x; asm volatile("" : "+v"(t)); return t; }
DEV int get_tid() { int t = threadIdx.x & 255; asm volatile("" : "+v"(t)); return t; }
DEV int get_rbid() { int t = blockIdx.x; asm volatile("" : "+s"(t)); return t; }
DEV int get_bid() { int t = get_rbid() * 2 + (get_tid8() >> 8); return __builtin_amdgcn_readfirstlane(t); }
DEV int nworkers() { return (int)gridDim.x * 2; }
DEV float bf2f(u16 h) { return __uint_as_float(((unsigned)h) << 16); }
DEV u16 f2bf(float f) { unsigned u = __float_as_uint(f); u += 0x7fffu + ((u >> 16) & 1u); return (u16)(u >> 16); }
DEV unsigned pack2(float a, float b) { return (unsigned)f2bf(a) | ((unsigned)f2bf(b) << 16); }
DEV float silu_f(float x) { return x / (1.f + __expf(-x)); }
DEV float sigmoid_f(float x) { return 1.f / (1.f + __expf(-x)); }
DEV float lo_f(unsigned u) { return __uint_as_float(u << 16); }
DEV float hi_f(unsigned u) { return __uint_as_float(u & 0xffff0000u); }
DEV float wave_sum(float v) {
#pragma unroll
  for (int o = 32; o > 0; o >>= 1) v += __shfl_xor(v, o);
  return v;
}
DEV float half_sum(float v) {
#pragma unroll
  for (int o = 16; o > 0; o >>= 1) v += __shfl_xor(v, o);
  return v;
}
DEV float log_gamma(int h) {
  return h == 0 ? -0.0317486983145803f : (h == 1 ? -0.015748356968139168f : (h == 2 ? -0.007843177461025893f : -0.003913899321136329f));
}
DEV f32x16 mfma(bf16x8 a, bf16x8 b, f32x16 c) { return __builtin_amdgcn_mfma_f32_32x32x16_bf16(a, b, c, 0, 0, 0); }
DEV f32x16 zero16() { f32x16 z;
#pragma unroll
  for (int i = 0; i < 16; ++i) z[i] = 0.f;
  return z; }
DEV int acc_row(int i, int h) { return (i & 3) + 8 * (i >> 2) + 4 * h; }

DEV bf16x8 frag_tr(const u16* T, int ld, int k0, int x0, int lane) {
  const int h = lane >> 5, blk = (lane >> 4) & 1, q = (lane & 15) >> 2, pp = lane & 3;
  const u16* a0 = T + (k0 + 8 * h + q) * ld + x0 + 16 * blk + 4 * pp;
  s16x4 lo = __builtin_amdgcn_ds_read_tr16_b64_v4i16((LDSP s16x4*)a0);
  s16x4 hi = __builtin_amdgcn_ds_read_tr16_b64_v4i16((LDSP s16x4*)(a0 + 4 * ld));
  s16x8 v = {lo[0], lo[1], lo[2], lo[3], hi[0], hi[1], hi[2], hi[3]};
  return __builtin_bit_cast(bf16x8, v);
}
DEV bf16x8 frag_row(const u16* T, int ld, int row, int k) {
  return *(const bf16x8*)(T + row * ld + k);
}

template <int MI>
DEV void gemm_tile(f32x16 (&acc)[MI][2], const u16* __restrict__ A, int lda, int arow0, int arow_max,
                   const u16* __restrict__ B, int ldb, int brow0, int K, char* smem) {
  constexpr int BM = MI * 64;
  constexpr int LD = 72;
  constexpr int ACH = BM * 8 / 256;
  u16* As = (u16*)smem;
  u16* Bs = As + BM * LD;
  const int tid = get_tid(), lane = tid & 63, w = tid >> 6, wm = w >> 1, wn = w & 1, r = lane & 31, h = lane >> 5;
  u32x4 ra[ACH], rb[4];
  const u16* ap[ACH];
  const u16* bp[4];
#pragma unroll
  for (int i = 0; i < ACH; ++i) {
    int c = tid + i * 256, row = c >> 3, kc = c & 7;
    int gr = arow0 + row; gr = gr > arow_max ? arow_max : gr;
    ap[i] = A + (size_t)gr * lda + kc * 8;
  }
#pragma unroll
  for (int i = 0; i < 4; ++i) {
    int c = tid + i * 256, row = c >> 3, kc = c & 7;
    bp[i] = B + (size_t)(brow0 + row) * ldb + kc * 8;
  }
#pragma unroll
  for (int i = 0; i < ACH; ++i) ra[i] = *(const u32x4*)(ap[i]);
#pragma unroll
  for (int i = 0; i < 4; ++i) rb[i] = *(const u32x4*)(bp[i]);
  const int nk = K >> 6;
  for (int kt = 0; kt < nk; ++kt) {
#pragma unroll
    for (int i = 0; i < ACH; ++i) { int c = tid + i * 256, row = c >> 3, kc = c & 7; *(u32x4*)(As + row * LD + kc * 8) = ra[i]; }
#pragma unroll
    for (int i = 0; i < 4; ++i) { int c = tid + i * 256, row = c >> 3, kc = c & 7; *(u32x4*)(Bs + row * LD + kc * 8) = rb[i]; }
    __syncthreads();
    if (kt + 1 < nk) {
#pragma unroll
      for (int i = 0; i < ACH; ++i) ra[i] = *(const u32x4*)(ap[i] + (kt + 1) * 64);
#pragma unroll
      for (int i = 0; i < 4; ++i) rb[i] = *(const u32x4*)(bp[i] + (kt + 1) * 64);
    }
#pragma unroll
    for (int ks = 0; ks < 4; ++ks) {
      bf16x8 a[MI], b[2];
#pragma unroll
      for (int mi = 0; mi < MI; ++mi) a[mi] = frag_row(As, LD, wm * MI * 32 + mi * 32 + r, ks * 16 + h * 8);
#pragma unroll
      for (int ni = 0; ni < 2; ++ni) b[ni] = frag_row(Bs, LD, wn * 64 + ni * 32 + r, ks * 16 + h * 8);
#pragma unroll
      for (int mi = 0; mi < MI; ++mi)
#pragma unroll
        for (int ni = 0; ni < 2; ++ni) acc[mi][ni] = mfma(a[mi], b[ni], acc[mi][ni]);
    }
    __syncthreads();
  }
}

DEV int orig_col(int n) {
  if (n < 5120) return n;
  if (n < 7168) {
    int q = n - 5120; int which = q >> 10; int c = q & 1023; int head = c >> 8; int ip = c & 255; int blk = ip >> 6; int wi = ip & 63;
    int j = (wi < 32) ? (blk * 32 + wi) : (128 + blk * 32 + wi - 32);
    return 5152 + which * 1024 + head * 256 + j;
  }
  if (n < 13312) return n + 32;
  if (n < 13344) return 5120 + (n - 13312);
  return -1;
}
DEV void convert_tile(const float* __restrict__ W, int Nsrc, int K, u16* __restrict__ WT, int kt, int ntile, int mode, char* smem) {
  float* t = (float*)smem;
  const int tid = get_tid();
  {
    const int tx = tid & 15, ty = tid >> 4;
    const int n = ntile * 64 + tx * 4;
    int on = n;
    if (mode == 1) on = orig_col(n);
    else if (mode == 2) { const int tl = n >> 8, wi = n & 255; on = (wi < 128) ? (tl * 128 + wi) : (2816 + tl * 128 + wi - 128); }
#pragma unroll
    for (int kk = ty; kk < 64; kk += 16) {
      f32x4 v = {0.f, 0.f, 0.f, 0.f};
      if (on >= 0) v = *(const f32x4*)(W + (size_t)(kt * 64 + kk) * Nsrc + on);
      *(f32x4*)(t + kk * 68 + tx * 4) = v;
    }
  }
  __syncthreads();
  {
    const int nn = tid >> 2, kq = (tid & 3) * 16;
    u32x4 o[2];
#pragma unroll
    for (int j = 0; j < 8; ++j) o[j >> 2][j & 3] = pack2(t[(kq + 2 * j) * 68 + nn], t[(kq + 2 * j + 1) * 68 + nn]);
    u16* d = WT + (size_t)(ntile * 64 + nn) * K + kt * 64 + kq;
    *(u32x4*)d = o[0]; *(u32x4*)(d + 8) = o[1];
  }
  __syncthreads();
}

DEV void rmsnorm_row_bf16(const float* __restrict__ src, const float* __restrict__ w, u16* __restrict__ dst, int lane) {
  f32x4 v[4]; float ss = 0.f;
#pragma unroll
  for (int j = 0; j < 4; ++j) { v[j] = *(const f32x4*)(src + j * 256 + lane * 4); ss += v[j][0] * v[j][0] + v[j][1] * v[j][1] + v[j][2] * v[j][2] + v[j][3] * v[j][3]; }
  ss = wave_sum(ss);
  const float rstd = rsqrtf(ss * (1.f / 1024.f) + EPS);
#pragma unroll
  for (int j = 0; j < 4; ++j) {
    f32x4 ww = *(const f32x4*)(w + j * 256 + lane * 4);
    u32x2 o; o[0] = pack2(v[j][0] * rstd * ww[0], v[j][1] * rstd * ww[1]); o[1] = pack2(v[j][2] * rstd * ww[2], v[j][3] * rstd * ww[3]);
    *(u32x2*)(dst + j * 256 + lane * 4) = o;
  }
}
DEV void rmsnorm_row_f32_inplace(float* __restrict__ row, const float* __restrict__ w, int lane) {
  f32x4 v[4]; float ss = 0.f;
#pragma unroll
  for (int j = 0; j < 4; ++j) { v[j] = *(const f32x4*)(row + j * 256 + lane * 4); ss += v[j][0] * v[j][0] + v[j][1] * v[j][1] + v[j][2] * v[j][2] + v[j][3] * v[j][3]; }
  ss = wave_sum(ss);
  const float rstd = rsqrtf(ss * (1.f / 1024.f) + EPS);
#pragma unroll
  for (int j = 0; j < 4; ++j) {
    f32x4 ww = *(const f32x4*)(w + j * 256 + lane * 4);
    f32x4 o; o[0] = v[j][0] * rstd * ww[0]; o[1] = v[j][1] * rstd * ww[1]; o[2] = v[j][2] * rstd * ww[2]; o[3] = v[j][3] * rstd * ww[3];
    *(f32x4*)(row + j * 256 + lane * 4) = o;
  }
}

template <int R, int C, bool SCALE>
DEV void stage_conv(u16* dst, int ld, const u16* __restrict__ xbc, int row0, int ch0, const float* __restrict__ cw, const float* __restrict__ cb, const float* rs) {
  constexpr int CG = C / 8, RG = 256 / CG, RPT = R / RG;
  const int tid = get_tid();
  const int cgi = tid % CG, rgi = tid / CG;
  const int ch = ch0 + cgi * 8, r0 = rgi * RPT;
  float w[4][8], bias[8], xw[3][8];
#pragma unroll
  for (int k = 0; k < 4; ++k) {
    f32x4 a = *(const f32x4*)(cw + k * 3072 + ch), b = *(const f32x4*)(cw + k * 3072 + ch + 4);
#pragma unroll
    for (int j = 0; j < 4; ++j) { w[k][j] = a[j]; w[k][4 + j] = b[j]; }
  }
  {
    f32x4 a = *(const f32x4*)(cb + ch), b = *(const f32x4*)(cb + ch + 4);
#pragma unroll
    for (int j = 0; j < 4; ++j) { bias[j] = a[j]; bias[4 + j] = b[j]; }
  }
#pragma unroll
  for (int k = 0; k < 3; ++k) {
    const int tr = row0 + r0 - 3 + k;
    u32x4 v = {0u, 0u, 0u, 0u};
    if (tr >= 0 && tr < L) v = *(const u32x4*)(xbc + (size_t)tr * 3072 + ch);
#pragma unroll
    for (int j = 0; j < 4; ++j) { xw[k][2 * j] = lo_f(v[j]); xw[k][2 * j + 1] = hi_f(v[j]); }
  }
#pragma unroll
  for (int i = 0; i < RPT; ++i) {
    const int tr = row0 + r0 + i;
    const bool valid = tr < L;
    u32x4 v = {0u, 0u, 0u, 0u};
    if (valid) v = *(const u32x4*)(xbc + (size_t)tr * 3072 + ch);
    float xc[8], o[8];
#pragma unroll
    for (int j = 0; j < 4; ++j) { xc[2 * j] = lo_f(v[j]); xc[2 * j + 1] = hi_f(v[j]); }
    float sc = 1.f;
    if (SCALE) sc = rs[(cgi >> 3) * 128 + r0 + i];
#pragma unroll
    for (int j = 0; j < 8; ++j) {
      float a = bias[j] + w[0][j] * xw[0][j] + w[1][j] * xw[1][j] + w[2][j] * xw[2][j] + w[3][j] * xc[j];
      a = silu_f(a) * sc;
      o[j] = valid ? a : 0.f;
      xw[0][j] = xw[1][j]; xw[1][j] = xw[2][j]; xw[2][j] = xc[j];
    }
    u32x4 pk; pk[0] = pack2(o[0], o[1]); pk[1] = pack2(o[2], o[3]); pk[2] = pack2(o[4], o[5]); pk[3] = pack2(o[6], o[7]);
    *(u32x4*)(dst + (r0 + i) * ld + cgi * 8) = pk;
  }
}

DEV float chunk_cumsum(const float* __restrict__ DT, int c, int H, float A, float* acs, float* dts, int lane) {
  const int s0 = 2 * lane;
  const int t0 = c * 128 + s0;
  const float d0 = (t0 < L) ? DT[(size_t)t0 * 32 + H] : 0.f;
  const float d1 = (t0 + 1 < L) ? DT[(size_t)(t0 + 1) * 32 + H] : 0.f;
  const float a0 = d0 * A, a1 = a0 + d1 * A;
  float tot = a1;
#pragma unroll
  for (int o = 1; o < 64; o <<= 1) { float n = __shfl_up(tot, o); if (lane >= o) tot += n; }
  const float excl = tot - a1;
  acs[s0] = excl + a0; acs[s0 + 1] = excl + a1;
  dts[s0] = d0; dts[s0 + 1] = d1;
  return __shfl(tot, 63);
}

DEV void phase_prep(const Params& p, int b, bool first, char* smem) {
  const int tid = get_tid(), lane = tid & 63, w = tid >> 6;
  u16* U = (u16*)((char*)p.out + OUT_HALF);
  const int n_norm = L / 4;
  const int n_win = 16 * (NPROJ_PAD / 64);
  const int n_wb = first ? 2 * 32 * 16 : 0;
  const int total = n_norm + n_win + n_wb;
  for (int it = get_bid(); it < total; it += nworkers()) {
    if (it < n_norm) {
      const int t = it * 4 + w;
      const float* src = (t < NMETA) ? (p.in[1] + (size_t)t * D) : (p.in[0] + ((size_t)b * SEQ + (t - NMETA)) * D);
      rmsnorm_row_bf16(src, p.in[2], U + (size_t)t * D, lane);
    } else if (it < n_norm + n_win) {
      const int j = it - n_norm; const int ntile = j >> 4, kt = j & 15;
      convert_tile(p.in[3], NPROJ, 1024, (u16*)(p.ws + OFF_S1), kt, ntile, 1, smem);
    } else {
      int j = it - n_norm - n_win; const int which = j >> 9; j &= 511; const int ntile = j >> 5, kt = j & 31;
      convert_tile(p.in[10 + which], 1024, 2048, (u16*)(p.ws + OFF_S2 + (size_t)which * 4194304), kt, ntile, 0, smem);
    }
  }
}

DEV void phase_inproj(const Params& p, int b, char* smem) {
  const int tid = get_tid(), lane = tid & 63, w = tid >> 6, wm = w >> 1, wn = w & 1, r = lane & 31, h = lane >> 5;
  const u16* U = (const u16*)((char*)p.out + OUT_HALF);
  const u16* WT = (const u16*)(p.ws + OFF_S1);
  const int MT = 65, NT = 105;
  for (int it = get_bid(); it < MT * NT; it += gridDim.x) {
    const int nt = it / MT, mt = it % MT;
    f32x16 acc[2][2];
#pragma unroll
    for (int mi = 0; mi < 2; ++mi)
#pragma unroll
      for (int ni = 0; ni < 2; ++ni) acc[mi][ni] = zero16();
    gemm_tile<2>(acc, U, 1024, mt * 128, L - 1, WT, 1024, nt * 128, 1024, smem);
    const int n0 = nt * 128;
    if (nt >= 40 && nt < 56) {
      const bool isk = nt >= 48;
      const int cq = n0 - (isk ? 6144 : 5120);
      const int blk = ((cq & 255) >> 6) + wn;
      const int jf = blk * 32 + r;
      const double invf_rev = exp(-(double)jf * 0.07252236513367073) * 0.15915494309189535;
      const float sc = isk ? 0.0625f : 1.f;
      u16* dst = (u16*)(p.ws + (isk ? OFF_K : OFF_Q));
#pragma unroll
      for (int mi = 0; mi < 2; ++mi)
#pragma unroll
        for (int i = 0; i < 16; ++i) {
          const int t = mt * 128 + wm * 64 + mi * 32 + acc_row(i, h);
          if (t < L) {
            double rev = (double)t * invf_rev;
            rev -= floor(rev);
            const float fr = (float)rev;
            const float sn = __builtin_amdgcn_sinf(fr), cs = __builtin_amdgcn_cosf(fr);
            const float x1 = acc[mi][0][i], x2 = acc[mi][1][i];
            const float o1 = (x1 * cs - x2 * sn) * sc, o2 = (x2 * cs + x1 * sn) * sc;
            u16* d = dst + (size_t)t * 1024 + cq + wn * 64 + r;
            d[0] = f2bf(o1); d[32] = f2bf(o2);
          }
        }
    } else if (nt == 104) {
      float* DT = (float*)(p.ws + OFF_DT);
      if (wn == 0) {
        const float bias = p.in[6][r];
#pragma unroll
        for (int mi = 0; mi < 2; ++mi)
#pragma unroll
          for (int i = 0; i < 16; ++i) {
            const int t = mt * 128 + wm * 64 + mi * 32 + acc_row(i, h);
            if (t < L) {
              const float x = acc[mi][0][i] + bias;
              const float e = __expf(x);
              DT[(size_t)t * 32 + r] = (x > 20.f) ? x : (e < 0.01f ? e * (1.f - 0.5f * e + e * e * (1.f / 3.f)) : __logf(1.f + e));
            }
          }
      }
    } else {
      u16* dst; int ld, c0; bool sig = false;
      if (nt < 16) { dst = (u16*)(p.ws + OFF_Z); ld = 2048; c0 = n0; }
      else if (nt < 40) { dst = (u16*)(p.ws + OFF_XBC); ld = 3072; c0 = n0 - 2048; }
      else if (nt < 72) { dst = (u16*)(p.ws + OFF_V); ld = 2048; c0 = n0 - 7168; }
      else if (nt < 88) { dst = (u16*)(p.ws + OFF_G); ld = 2048; c0 = n0 - 9216; }
      else if (nt < 96) { dst = (u16*)(p.ws + OFF_GS); ld = 1024; c0 = n0 - 11264; sig = true; }
      else { dst = (u16*)(p.ws + OFF_GR); ld = 1024; c0 = n0 - 12288; sig = true; }
#pragma unroll
      for (int mi = 0; mi < 2; ++mi)
#pragma unroll
        for (int ni = 0; ni < 2; ++ni)
#pragma unroll
          for (int i = 0; i < 16; ++i) {
            const int t = mt * 128 + wm * 64 + mi * 32 + acc_row(i, h);
            if (t < L) {
              float v = acc[mi][ni][i];
              if (sig) v = sigmoid_f(v);
              dst[(size_t)t * ld + c0 + wn * 64 + ni * 32 + r] = f2bf(v);
            }
          }
    }
  }
}

DEV void ssd_state_item(const Params& p, int it, char* smem) {
  const int tid = get_tid(), lane = tid & 63, w = tid >> 6, wm = w >> 1, wn = w & 1, r = lane & 31, h = lane >> 5;
  const int c = it >> 4, hp = it & 15, H0 = hp * 2, g = H0 >> 3;
  u16* Xw = (u16*)smem;
  u16* Bc = Xw + 128 * 136;
  float* wsc = (float*)(Bc + 128 * 136);
  float* tmp = wsc + 256;
  const float* DT = (const float*)(p.ws + OFF_DT);
  float* CD = (float*)(p.ws + OFF_CD);
  const u16* XBC = (const u16*)(p.ws + OFF_XBC);
  if (w < 2) {
    const int H = H0 + w;
    const float A = -expf(p.in[7][H]);
    float* acs = tmp + w * 128;
    float* dts = wsc + w * 128;
    const float aend = chunk_cumsum(DT, c, H, A, acs, dts, lane);
    const int s0 = 2 * lane;
    const float w0 = __expf(aend - acs[s0]) * dts[s0], w1 = __expf(aend - acs[s0 + 1]) * dts[s0 + 1];
    dts[s0] = w0; dts[s0 + 1] = w1;
    if (lane == 0) CD[c * 32 + H] = __expf(aend);
  }
  __syncthreads();
  stage_conv<128, 128, true>(Xw, 136, XBC, c * 128, H0 * 64, p.in[4], p.in[5], wsc);
  stage_conv<128, 128, false>(Bc, 136, XBC, c * 128, 2048 + g * 128, p.in[4], p.in[5], nullptr);
  __syncthreads();
  f32x16 acc[2][2];
#pragma unroll
  for (int mi = 0; mi < 2; ++mi)
#pragma unroll
    for (int ni = 0; ni < 2; ++ni) acc[mi][ni] = zero16();
#pragma unroll
  for (int ks = 0; ks < 8; ++ks) {
    bf16x8 a[2], bq[2];
#pragma unroll
    for (int mi = 0; mi < 2; ++mi) a[mi] = frag_tr(Xw, 136, ks * 16, wm * 64 + mi * 32, lane);
#pragma unroll
    for (int ni = 0; ni < 2; ++ni) bq[ni] = frag_tr(Bc, 136, ks * 16, wn * 64 + ni * 32, lane);
#pragma unroll
    for (int mi = 0; mi < 2; ++mi)
#pragma unroll
      for (int ni = 0; ni < 2; ++ni) acc[mi][ni] = mfma(a[mi], bq[ni], acc[mi][ni]);
  }
  u16* ST = (u16*)(p.ws + OFF_S1) + (size_t)(c * 32 + H0) * 8192;
  __syncthreads();
#pragma unroll
  for (int mi = 0; mi < 2; ++mi)
#pragma unroll
    for (int ni = 0; ni < 2; ++ni)
#pragma unroll
      for (int i = 0; i < 16; ++i) Xw[(wm * 64 + mi * 32 + acc_row(i, h)) * 136 + wn * 64 + ni * 32 + r] = f2bf(acc[mi][ni][i]);
  asm volatile("s_waitcnt lgkmcnt(0)" ::: "memory");
#pragma unroll
  for (int j = 0; j < 8; ++j) {
    const int m = wm * 64 + (lane >> 3) + 8 * j, n = wn * 64 + (lane & 7) * 8;
    *(u32x4*)(ST + m * 128 + n) = *(const u32x4*)(Xw + m * 136 + n);
  }
  __syncthreads();
}

DEV void ret_kv_item(const Params& p, int it, char* smem) {
  const int tid = get_tid(), lane = tid & 63, w = tid >> 6, wm = w >> 1, wn = w & 1, r = lane & 31, h = lane >> 5;
  const int sc = it >> 5, rem = it & 31, hd = rem >> 3, dt2 = (rem >> 2) & 1, et = rem & 3;
  u16* Vt = (u16*)smem;
  u16* Kt = Vt + 128 * 136;
  const u16* Vg = (const u16*)(p.ws + OFF_V);
  const u16* Kg = (const u16*)(p.ws + OFF_K);
  const float lg = log_gamma(hd);
  f32x16 acc[2][2];
#pragma unroll
  for (int mi = 0; mi < 2; ++mi)
#pragma unroll
    for (int ni = 0; ni < 2; ++ni) acc[mi][ni] = zero16();
  for (int half = 0; half < 2; ++half) {
#pragma unroll
    for (int i = 0; i < 8; ++i) {
      const int cidx = tid + i * 256, row = cidx >> 4, cc = cidx & 15;
      const int tok = sc * 256 + half * 128 + row;
      u32x4 v = *(const u32x4*)(Vg + (size_t)tok * 2048 + hd * 512 + et * 128 + cc * 8);
      *(u32x4*)(Vt + row * 136 + cc * 8) = v;
      u32x4 kk = *(const u32x4*)(Kg + (size_t)tok * 1024 + hd * 256 + dt2 * 128 + cc * 8);
      const float dec = __expf((float)(255 - (half * 128 + row)) * lg);
      u32x4 ko;
#pragma unroll
      for (int j = 0; j < 4; ++j) ko[j] = pack2(lo_f(kk[j]) * dec, hi_f(kk[j]) * dec);
      *(u32x4*)(Kt + row * 136 + cc * 8) = ko;
    }
    __syncthreads();
#pragma unroll
    for (int ks = 0; ks < 8; ++ks) {
      bf16x8 a[2], bq[2];
#pragma unroll
      for (int mi = 0; mi < 2; ++mi) a[mi] = frag_tr(Vt, 136, ks * 16, wm * 64 + mi * 32, lane);
#pragma unroll
      for (int ni = 0; ni < 2; ++ni) bq[ni] = frag_tr(Kt, 136, ks * 16, wn * 64 + ni * 32, lane);
#pragma unroll
      for (int mi = 0; mi < 2; ++mi)
#pragma unroll
        for (int ni = 0; ni < 2; ++ni) acc[mi][ni] = mfma(a[mi], bq[ni], acc[mi][ni]);
    }
    __syncthreads();
  }
  u16* RST = (u16*)((char*)p.out + OUT_HALF) + ((size_t)(sc * 4 + hd) * 512 + et * 128) * 256 + dt2 * 128;
#pragma unroll
  for (int mi = 0; mi < 2; ++mi)
#pragma unroll
    for (int ni = 0; ni < 2; ++ni)
#pragma unroll
      for (int i = 0; i < 16; ++i) Vt[(wm * 64 + mi * 32 + acc_row(i, h)) * 136 + wn * 64 + ni * 32 + r] = f2bf(acc[mi][ni][i]);
  asm volatile("s_waitcnt lgkmcnt(0)" ::: "memory");
#pragma unroll
  for (int j = 0; j < 8; ++j) {
    const int e = wm * 64 + (lane >> 3) + 8 * j, d = wn * 64 + (lane & 7) * 8;
    *(u32x4*)(RST + (size_t)e * 256 + d) = *(const u32x4*)(Vt + e * 136 + d);
  }
  __syncthreads();
}

DEV void phase_scan(const Params& p) {
  const int gt = get_bid() * 256 + get_tid(), nth = nworkers() * 256;
  const float* CD = (const float*)(p.ws + OFF_CD);
  for (int v = gt; v < 32768 + 65536; v += nth) {
    float st[8];
#pragma unroll
    for (int j = 0; j < 8; ++j) st[j] = 0.f;
    if (v < 32768) {
      const int e0 = v * 8, H = e0 >> 13;
      u16* base = (u16*)(p.ws + OFF_S1) + e0;
      for (int c0 = 0; c0 < 64; c0 += 4) {
        u32x4 x[4];
#pragma unroll
        for (int u = 0; u < 4; ++u) x[u] = *(const u32x4*)(base + (size_t)(c0 + u) * 262144);
#pragma unroll
        for (int u = 0; u < 4; ++u) {
          const float dcy = CD[(c0 + u) * 32 + H];
          u32x4 o;
#pragma unroll
          for (int j = 0; j < 4; ++j) {
            st[2 * j] = st[2 * j] * dcy + lo_f(x[u][j]);
            st[2 * j + 1] = st[2 * j + 1] * dcy + hi_f(x[u][j]);
            o[j] = pack2(st[2 * j], st[2 * j + 1]);
          }
          *(u32x4*)(base + (size_t)(c0 + u) * 262144) = o;
        }
      }
    } else {
      const int e0 = (v - 32768) * 8, hd = e0 >> 17;
      const float g256 = __expf(256.f * log_gamma(hd));
      u16* base = (u16*)((char*)p.out + OUT_HALF) + e0;
      for (int c0 = 0; c0 < 32; c0 += 4) {
        u32x4 x[4];
#pragma unroll
        for (int u = 0; u < 4; ++u) x[u] = *(const u32x4*)(base + (size_t)(c0 + u) * 524288);
#pragma unroll
        for (int u = 0; u < 4; ++u) {
          u32x4 o;
#pragma unroll
          for (int j = 0; j < 4; ++j) {
            st[2 * j] = st[2 * j] * g256 + lo_f(x[u][j]);
            st[2 * j + 1] = st[2 * j + 1] * g256 + hi_f(x[u][j]);
            o[j] = pack2(st[2 * j], st[2 * j + 1]);
          }
          *(u32x4*)(base + (size_t)(c0 + u) * 524288) = o;
        }
      }
    }
  }
}

DEV void ssd_out_item(const Params& p, int it, char* smem) {
  const int tid = get_tid(), lane = tid & 63, w = tid >> 6, wm = w >> 1, wn = w & 1, r = lane & 31, h = lane >> 5;
  const int c = it >> 3, rem = it & 7, g = rem & 3, lh = rem >> 2;
  if (c == 64 && lh == 1) return;
  u16* Ct = (u16*)smem;
  u16* Bt = Ct + 64 * 136;
  u16* Lt = Bt;
  u16* Xt = Bt + 128 * 136;
  float* acs = (float*)(Xt + 128 * 72);
  float* dts = acs + 128;
  float* rowsq = dts + 128;
  const u16* XBC = (const u16*)(p.ws + OFF_XBC);
  const float* DT = (const float*)(p.ws + OFF_DT);
  u16* Z = (u16*)(p.ws + OFF_Z);
  const int tok0 = c * 128;
  stage_conv<64, 128, false>(Ct, 136, XBC, tok0 + lh * 64, 2560 + g * 128, p.in[4], p.in[5], nullptr);
  stage_conv<128, 128, false>(Bt, 136, XBC, tok0, 2048 + g * 128, p.in[4], p.in[5], nullptr);
  if (tid < 64) rowsq[tid] = 0.f;
  __syncthreads();
  f32x16 cb[2];
  cb[0] = zero16(); cb[1] = zero16();
#pragma unroll
  for (int ks = 0; ks < 8; ++ks) {
    bf16x8 a = frag_row(Ct, 136, wm * 32 + r, ks * 16 + h * 8);
#pragma unroll
    for (int ni = 0; ni < 2; ++ni) {
      bf16x8 bq = frag_row(Bt, 136, wn * 64 + ni * 32 + r, ks * 16 + h * 8);
      cb[ni] = mfma(a, bq, cb[ni]);
    }
  }
  for (int hh = 0; hh < 8; ++hh) {
    const int H = g * 8 + hh;
    u32x4 zv[2];
    {
      int tz = tok0 + lh * 64 + (tid >> 2); tz = tz < L ? tz : L - 1;
      const u16* zp0 = Z + (size_t)tz * 2048 + H * 64 + (tid & 3) * 16;
      zv[0] = *(const u32x4*)zp0; zv[1] = *(const u32x4*)(zp0 + 8);
    }
    __syncthreads();
    if (w == 0) {
      const float A = -expf(p.in[7][H]);
      chunk_cumsum(DT, c, H, A, acs, dts, lane);
    }
    stage_conv<128, 64, false>(Xt, 72, XBC, tok0, H * 64, p.in[4], p.in[5], nullptr);
    __syncthreads();
#pragma unroll
    for (int ni = 0; ni < 2; ++ni)
#pragma unroll
      for (int i = 0; i < 16; ++i) {
        const int ll = wm * 32 + acc_row(i, h), l = lh * 64 + ll, s = wn * 64 + ni * 32 + r;
        float val = 0.f;
        if (s <= l) val = cb[ni][i] * __expf(acs[l] - acs[s]) * dts[s];
        Lt[ll * 136 + s] = f2bf(val);
      }
    f32x16 y = zero16();
    if (c > 0) {
      const u16* pv = (const u16*)(p.ws + OFF_S1) + ((size_t)((c - 1) * 32 + H) * 64 + wn * 32 + r) * 128 + h * 8;
#pragma unroll
      for (int ks = 0; ks < 8; ++ks) {
        bf16x8 a = frag_row(Ct, 136, wm * 32 + r, ks * 16 + h * 8);
        bf16x8 bq = *(const bf16x8*)(pv + ks * 16);
        y = mfma(a, bq, y);
      }
#pragma unroll
      for (int i = 0; i < 16; ++i) { const int l = lh * 64 + wm * 32 + acc_row(i, h); y[i] *= __expf(acs[l]); }
    }
    __syncthreads();
#pragma unroll
    for (int ks = 0; ks < 8; ++ks) {
      bf16x8 a = frag_row(Lt, 136, wm * 32 + r, ks * 16 + h * 8);
      bf16x8 bq = frag_tr(Xt, 72, ks * 16, wn * 32, lane);
      y = mfma(a, bq, y);
    }
    const float Dsk = p.in[8][H];
    float* Ys = (float*)(Bt + 64 * 136);
#pragma unroll
    for (int i = 0; i < 16; ++i) Ys[(wm * 32 + acc_row(i, h)) * 68 + wn * 32 + r] = y[i];
    __syncthreads();
    {
      const int row = tid >> 2, q = tid & 3, l = lh * 64 + row, t = tok0 + l;
      float sq = 0.f;
      if (t < L) {
        u16* zp = Z + (size_t)t * 2048 + H * 64 + q * 16;
        u32x4 xv[2], ov[2];
        xv[0] = *(const u32x4*)(Xt + l * 72 + q * 16); xv[1] = *(const u32x4*)(Xt + l * 72 + q * 16 + 8);
#pragma unroll
        for (int k = 0; k < 2; ++k) {
          const f32x4 ya = *(const f32x4*)(Ys + row * 68 + q * 16 + k * 8), yb = *(const f32x4*)(Ys + row * 68 + q * 16 + k * 8 + 4);
          float o[8];
#pragma unroll
          for (int j = 0; j < 4; ++j) {
            const float y0 = (j < 2) ? ya[2 * j] : yb[2 * j - 4], y1 = (j < 2) ? ya[2 * j + 1] : yb[2 * j - 3];
            o[2 * j] = (y0 + Dsk * lo_f(xv[k][j])) * silu_f(lo_f(zv[k][j]));
            o[2 * j + 1] = (y1 + Dsk * hi_f(xv[k][j])) * silu_f(hi_f(zv[k][j]));
            sq += o[2 * j] * o[2 * j] + o[2 * j + 1] * o[2 * j + 1];
            ov[k][j] = pack2(o[2 * j], o[2 * j + 1]);
          }
        }
        *(u32x4*)zp = ov[0]; *(u32x4*)(zp + 8) = ov[1];
      }
      sq += __shfl_xor(sq, 1); sq += __shfl_xor(sq, 2);
      if (q == 0) rowsq[row] += sq;
    }
  }
  __syncthreads();
  {
    const int row = tid >> 2, q = tid & 3, t = tok0 + lh * 64 + row;
    if (t < L) {
      const float rn = rsqrtf(rowsq[row] * (1.f / 512.f) + EPS);
      u32x4 v[16];
#pragma unroll
      for (int hh = 0; hh < 8; ++hh) {
        const u16* zp = Z + (size_t)t * 2048 + (g * 8 + hh) * 64 + q * 16;
        v[2 * hh] = *(const u32x4*)zp; v[2 * hh + 1] = *(const u32x4*)(zp + 8);
      }
#pragma unroll
      for (int hh = 0; hh < 8; ++hh) {
        u16* zp = Z + (size_t)t * 2048 + (g * 8 + hh) * 64 + q * 16;
        const float* nwp = p.in[9] + (g * 8 + hh) * 64 + q * 16;
#pragma unroll
        for (int k = 0; k < 2; ++k) {
          const f32x4 wa = *(const f32x4*)(nwp + k * 8), wb = *(const f32x4*)(nwp + k * 8 + 4);
          u32x4 o;
          o[0] = pack2(lo_f(v[2 * hh + k][0]) * rn * wa[0], hi_f(v[2 * hh + k][0]) * rn * wa[1]);
          o[1] = pack2(lo_f(v[2 * hh + k][1]) * rn * wa[2], hi_f(v[2 * hh + k][1]) * rn * wa[3]);
          o[2] = pack2(lo_f(v[2 * hh + k][2]) * rn * wb[0], hi_f(v[2 * hh + k][2]) * rn * wb[1]);
          o[3] = pack2(lo_f(v[2 * hh + k][3]) * rn * wb[2], hi_f(v[2 * hh + k][3]) * rn * wb[3]);
          *(u32x4*)(zp + k * 8) = o;
        }
      }
    }
  }
  __syncthreads();
}

DEV void ret_out_item(const Params& p, int it, char* smem) {
  const int tid = get_tid(), lane = tid & 63, w = tid >> 6, wm = w >> 1, wn = w & 1, r = lane & 31, h = lane >> 5;
  const int rt = it >> 2, hd = it & 3;
  const int t0 = rt * 64, sc = rt >> 2, qtr = rt & 3;
  u16* P = (u16*)smem;
  char* gsm = smem + 33792;
  u16* Vt = (u16*)gsm;
  float* rowsq = (float*)(smem + 33792 + 27648);
  const u16* Qg = (const u16*)(p.ws + OFF_Q) + hd * 256;
  const u16* Kg = (const u16*)(p.ws + OFF_K) + hd * 256;
  const u16* Vg = (const u16*)(p.ws + OFF_V);
  u16* Gg = (u16*)(p.ws + OFF_G);
  const u16* RST = (const u16*)((char*)p.out + OUT_HALF);
  const float lg = log_gamma(hd);
  if (tid < 64) rowsq[tid] = 0.f;
  const int nkb = (qtr >= 2) ? 2 : 1;
  for (int kb = 0; kb < nkb; ++kb) {
    f32x16 acc[1][2];
    acc[0][0] = zero16(); acc[0][1] = zero16();
    gemm_tile<1>(acc, Qg, 1024, t0, L - 1, Kg, 1024, sc * 256 + kb * 128, 256, gsm);
#pragma unroll
    for (int ni = 0; ni < 2; ++ni)
#pragma unroll
      for (int i = 0; i < 16; ++i) {
        const int ll = wm * 32 + acc_row(i, h), lp = qtr * 64 + ll, s = kb * 128 + wn * 64 + ni * 32 + r;
        float val = 0.f;
        if (s <= lp) val = acc[0][ni][i] * __expf((float)(lp - s) * lg);
        P[ll * 264 + s] = f2bf(val);
      }
  }
  float rs[16];
#pragma unroll
  for (int i = 0; i < 16; ++i) rs[i] = 0.f;
  for (int et = 0; et < 4; ++et) {
    f32x16 acc[1][2];
    acc[0][0] = zero16(); acc[0][1] = zero16();
    u32x4 gv[4], vreg[4];
    {
      int tg = t0 + (tid >> 2); tg = tg < L ? tg : L - 1;
      const u16* gp0 = Gg + (size_t)tg * 2048 + hd * 512 + et * 128 + (tid & 3) * 32;
#pragma unroll
      for (int k = 0; k < 4; ++k) gv[k] = *(const u32x4*)(gp0 + k * 8);
#pragma unroll
      for (int i = 0; i < 4; ++i) {
        const int cidx = tid + i * 256, row = cidx >> 4, cc = cidx & 15;
        int tok = sc * 256 + row; tok = tok < L ? tok : L - 1;
        vreg[i] = *(const u32x4*)(Vg + (size_t)tok * 2048 + hd * 512 + et * 128 + cc * 8);
      }
    }
    if (sc > 0) {
      gemm_tile<1>(acc, Qg, 1024, t0, L - 1, RST + ((size_t)((sc - 1) * 4 + hd) * 512 + et * 128) * 256, 256, 0, 256, gsm);
#pragma unroll
      for (int ni = 0; ni < 2; ++ni)
#pragma unroll
        for (int i = 0; i < 16; ++i) {
          const int lp = qtr * 64 + wm * 32 + acc_row(i, h);
          acc[0][ni][i] *= __expf((float)(lp + 1) * lg);
        }
    }
    for (int kb64 = 0; kb64 <= qtr; ++kb64) {
#pragma unroll
      for (int i = 0; i < 4; ++i) {
        const int cidx = tid + i * 256, row = cidx >> 4, cc = cidx & 15;
        const int tok = sc * 256 + kb64 * 64 + row;
        u32x4 v = {0u, 0u, 0u, 0u};
        if (tok < L) v = vreg[i];
        *(u32x4*)(Vt + row * 136 + cc * 8) = v;
      }
      __syncthreads();
      if (kb64 < qtr) {
#pragma unroll
        for (int i = 0; i < 4; ++i) {
          const int cidx = tid + i * 256, row = cidx >> 4, cc = cidx & 15;
          int tok = sc * 256 + (kb64 + 1) * 64 + row; tok = tok < L ? tok : L - 1;
          vreg[i] = *(const u32x4*)(Vg + (size_t)tok * 2048 + hd * 512 + et * 128 + cc * 8);
        }
      }
#pragma unroll
      for (int ks = 0; ks < 4; ++ks) {
        bf16x8 a = frag_row(P, 264, wm * 32 + r, kb64 * 64 + ks * 16 + h * 8);
#pragma unroll
        for (int ni = 0; ni < 2; ++ni) {
          bf16x8 bq = frag_tr(Vt, 136, ks * 16, wn * 64 + ni * 32, lane);
          acc[0][ni] = mfma(a, bq, acc[0][ni]);
        }
      }
      __syncthreads();
    }
    u16* Os = (u16*)gsm;
#pragma unroll
    for (int ni = 0; ni < 2; ++ni)
#pragma unroll
      for (int i = 0; i < 16; ++i) {
        const float o = acc[0][ni][i];
        if (t0 + wm * 32 + acc_row(i, h) < L) rs[i] += o * o;
        Os[(wm * 32 + acc_row(i, h)) * 136 + wn * 64 + ni * 32 + r] = f2bf(o);
      }
    __syncthreads();
    {
      const int row = tid >> 2, q = tid & 3, t = t0 + row;
      if (t < L) {
        u16* gp = Gg + (size_t)t * 2048 + hd * 512 + et * 128 + q * 32;
        u32x4 ov[4];
#pragma unroll
        for (int k = 0; k < 4; ++k) ov[k] = *(const u32x4*)(Os + row * 136 + q * 32 + k * 8);
#pragma unroll
        for (int k = 0; k < 4; ++k) {
          u32x4 o;
#pragma unroll
          for (int j = 0; j < 4; ++j) o[j] = pack2(silu_f(lo_f(gv[k][j])) * lo_f(ov[k][j]), silu_f(hi_f(gv[k][j])) * hi_f(ov[k][j]));
          *(u32x4*)(gp + k * 8) = o;
        }
      }
    }
    __syncthreads();
  }
#pragma unroll
  for (int i = 0; i < 16; ++i) {
    const float v = half_sum(rs[i]);
    if (r == 0) atomicAdd(&rowsq[wm * 32 + acc_row(i, h)], v);
  }
  __syncthreads();
  {
    const int row = tid >> 2, q = tid & 3, t = t0 + row;
    if (t < L) {
      const float rn = rsqrtf(rowsq[row] * (1.f / 512.f) + EPS);
      u32x4 v[16];
#pragma unroll
      for (int et = 0; et < 4; ++et)
#pragma unroll
        for (int k = 0; k < 4; ++k) v[et * 4 + k] = *(const u32x4*)(Gg + (size_t)t * 2048 + hd * 512 + et * 128 + q * 32 + k * 8);
#pragma unroll
      for (int et = 0; et < 4; ++et)
#pragma unroll
        for (int k = 0; k < 4; ++k) {
          u32x4 o;
#pragma unroll
          for (int j = 0; j < 4; ++j) o[j] = pack2(lo_f(v[et * 4 + k][j]) * rn, hi_f(v[et * 4 + k][j]) * rn);
          *(u32x4*)(Gg + (size_t)t * 2048 + hd * 512 + et * 128 + q * 32 + k * 8) = o;
        }
    }
  }
  __syncthreads();
}

DEV void merge_tile(const Params& p, int it, char* smem) {
  const int tid = get_tid(), lane = tid & 63, w = tid >> 6, wm = w >> 1, wn = w & 1, r = lane & 31, h = lane >> 5;
  const int nt = it / 65, mt = it % 65;
  u16* GS = (u16*)(p.ws + OFF_GS);
  const u16* GR = (const u16*)(p.ws + OFF_GR);
  f32x16 acc[2][2];
#pragma unroll
  for (int mi = 0; mi < 2; ++mi)
#pragma unroll
    for (int ni = 0; ni < 2; ++ni) acc[mi][ni] = zero16();
  gemm_tile<2>(acc, (const u16*)(p.ws + OFF_Z), 2048, mt * 128, L - 1, (const u16*)(p.ws + OFF_S2), 2048, nt * 128, 2048, smem);
#pragma unroll
  for (int mi = 0; mi < 2; ++mi)
#pragma unroll
    for (int ni = 0; ni < 2; ++ni)
#pragma unroll
      for (int i = 0; i < 16; ++i) {
        const int t = mt * 128 + wm * 64 + mi * 32 + acc_row(i, h);
        if (t < L) {
          const size_t idx = (size_t)t * 1024 + nt * 128 + wn * 64 + ni * 32 + r;
          GS[idx] = f2bf(bf2f(GS[idx]) * acc[mi][ni][i]);
        }
        acc[mi][ni][i] = 0.f;
      }
  gemm_tile<2>(acc, (const u16*)(p.ws + OFF_G), 2048, mt * 128, L - 1, (const u16*)(p.ws + OFF_S2 + 4194304), 2048, nt * 128, 2048, smem);
#pragma unroll
  for (int mi = 0; mi < 2; ++mi)
#pragma unroll
    for (int ni = 0; ni < 2; ++ni)
#pragma unroll
      for (int i = 0; i < 16; ++i) {
        const int t = mt * 128 + wm * 64 + mi * 32 + acc_row(i, h);
        if (t < L) {
          const size_t idx = (size_t)t * 1024 + nt * 128 + wn * 64 + ni * 32 + r;
          GS[idx] = f2bf(bf2f(GS[idx]) + bf2f(GR[idx]) * acc[mi][ni][i]);
        }
      }
}

DEV void phase_merge(const Params& p, char* smem) {
  const int n_tiles = 65 * 8;
  const int n_wout = 16 * 16, n_wup = 16 * 88, n_wdown = 44 * 16;
  const int total = n_tiles + n_wout + n_wup + n_wdown;
  for (int it = get_bid(); it < total; it += nworkers()) {
    if (it < n_tiles) merge_tile(p, it, smem);
    else if (it < n_tiles + n_wout) { const int j = it - n_tiles; convert_tile(p.in[12], 1024, 1024, (u16*)(p.ws + OFF_WOUT), j & 15, j >> 4, 0, smem); }
    else if (it < n_tiles + n_wout + n_wup) { const int j = it - n_tiles - n_wout; convert_tile(p.in[14], 5632, 1024, (u16*)(p.ws + OFF_WUP), j & 15, j >> 4, 0, smem); }
    else { const int j = it - n_tiles - n_wout - n_wup; convert_tile(p.in[17], 1024, 2816, (u16*)(p.ws + OFF_WDOWN), j % 44, j / 44, 0, smem); }
  }
}

DEV void phase_outproj(const Params& p, int b, char* smem) {
  const int tid = get_tid(), lane = tid & 63, w = tid >> 6, wm = w >> 1, wn = w & 1, r = lane & 31, h = lane >> 5;
  float* HM = (float*)(p.ws + OFF_HM);
  for (int it = get_bid(); it < 65 * 8; it += gridDim.x) {
    const int nt = it / 65, mt = it % 65;
    f32x16 acc[2][2];
#pragma unroll
    for (int mi = 0; mi < 2; ++mi)
#pragma unroll
      for (int ni = 0; ni < 2; ++ni) acc[mi][ni] = zero16();
    gemm_tile<2>(acc, (const u16*)(p.ws + OFF_GS), 1024, mt * 128, L - 1, (const u16*)(p.ws + OFF_WOUT), 1024, nt * 128, 1024, smem);
#pragma unroll
    for (int mi = 0; mi < 2; ++mi)
#pragma unroll
      for (int ni = 0; ni < 2; ++ni)
#pragma unroll
        for (int i = 0; i < 16; ++i) {
          const int t = mt * 128 + wm * 64 + mi * 32 + acc_row(i, h);
          const int col = nt * 128 + wn * 64 + ni * 32 + r;
          if (t < NMETA) HM[t * 1024 + col] = p.in[1][t * 1024 + col] + acc[mi][ni][i];
          else if (t < L) {
            const size_t idx = ((size_t)b * SEQ + (t - NMETA)) * 1024 + col;
            p.out[idx] = p.in[0][idx] + acc[mi][ni][i];
          }
        }
  }
}

DEV void phase_norm2(const Params& p, int b) {
  const int lane = get_tid() & 63, w = get_tid() >> 6;
  u16* U2 = (u16*)(p.ws + OFF_U2);
  for (int it = get_bid(); it < L / 4; it += nworkers()) {
    const int t = it * 4 + w;
    const float* src = (t < NMETA) ? ((const float*)(p.ws + OFF_HM) + (size_t)t * D) : (p.out + ((size_t)b * SEQ + (t - NMETA)) * D);
    rmsnorm_row_bf16(src, p.in[13], U2 + (size_t)t * D, lane);
  }
}

DEV void phase_up(const Params& p, char* smem) {
  const int tid = get_tid(), lane = tid & 63, w = tid >> 6, wm = w >> 1, wn = w & 1, r = lane & 31, h = lane >> 5;
  u16* UP = (u16*)(p.ws + OFF_UP);
  for (int it = get_bid(); it < 65 * 44; it += gridDim.x) {
    const int nt = it / 65, mt = it % 65;
    f32x16 acc[2][2];
#pragma unroll
    for (int mi = 0; mi < 2; ++mi)
#pragma unroll
      for (int ni = 0; ni < 2; ++ni) acc[mi][ni] = zero16();
    gemm_tile<2>(acc, (const u16*)(p.ws + OFF_U2), 1024, mt * 128, L - 1, (const u16*)(p.ws + OFF_WUP), 1024, nt * 128, 1024, smem);
#pragma unroll
    for (int mi = 0; mi < 2; ++mi)
#pragma unroll
      for (int ni = 0; ni < 2; ++ni)
#pragma unroll
        for (int i = 0; i < 16; ++i) {
          const int t = mt * 128 + wm * 64 + mi * 32 + acc_row(i, h);
          if (t < L) UP[(size_t)t * 5632 + nt * 128 + wn * 64 + ni * 32 + r] = f2bf(acc[mi][ni][i]);
        }
  }
}

DEV void phase_ffn_act(const Params& p) {
  const int gt = get_bid() * 256 + get_tid(), nth = nworkers() * 256;
  const u16* UP = (const u16*)(p.ws + OFF_UP);
  u16* ACT = (u16*)(p.ws + OFF_ACT);
  const float* cw = p.in[15];
  const float* cbias = p.in[16];
  for (int u = gt; u < 513 * 352; u += nth) {
    const int rb = u / 352, cgp = u % 352, ch = cgp * 8, t0 = rb * 16;
    float wg[3][8], wv[3][8], bg[8], bv[8], g2[8], g1[8], v2[8], v1[8];
#pragma unroll
    for (int k = 0; k < 3; ++k)
#pragma unroll
      for (int j = 0; j < 8; ++j) { wg[k][j] = cw[k * 5632 + ch + j]; wv[k][j] = cw[k * 5632 + 2816 + ch + j]; }
#pragma unroll
    for (int j = 0; j < 8; ++j) { bg[j] = cbias[ch + j]; bv[j] = cbias[2816 + ch + j]; }
    {
      u32x4 a = {0u, 0u, 0u, 0u}, bq = {0u, 0u, 0u, 0u}, c2 = {0u, 0u, 0u, 0u}, d2 = {0u, 0u, 0u, 0u};
      if (t0 >= 2) {
        a = *(const u32x4*)(UP + (size_t)(t0 - 2) * 5632 + ch); bq = *(const u32x4*)(UP + (size_t)(t0 - 1) * 5632 + ch);
        c2 = *(const u32x4*)(UP + (size_t)(t0 - 2) * 5632 + 2816 + ch); d2 = *(const u32x4*)(UP + (size_t)(t0 - 1) * 5632 + 2816 + ch);
      }
#pragma unroll
      for (int j = 0; j < 4; ++j) {
        g2[2 * j] = lo_f(a[j]); g2[2 * j + 1] = hi_f(a[j]); g1[2 * j] = lo_f(bq[j]); g1[2 * j + 1] = hi_f(bq[j]);
        v2[2 * j] = lo_f(c2[j]); v2[2 * j + 1] = hi_f(c2[j]); v1[2 * j] = lo_f(d2[j]); v1[2 * j + 1] = hi_f(d2[j]);
      }
    }
#pragma unroll 4
    for (int i = 0; i < 16; ++i) {
      const int t = t0 + i;
      const u32x4 a = *(const u32x4*)(UP + (size_t)t * 5632 + ch);
      const u32x4 c2 = *(const u32x4*)(UP + (size_t)t * 5632 + 2816 + ch);
      float o[8];
#pragma unroll
      for (int j = 0; j < 8; ++j) {
        const float gx = (j & 1) ? hi_f(a[j >> 1]) : lo_f(a[j >> 1]);
        const float vx = (j & 1) ? hi_f(c2[j >> 1]) : lo_f(c2[j >> 1]);
        const float ag = bg[j] + wg[0][j] * g2[j] + wg[1][j] * g1[j] + wg[2][j] * gx;
        const float av = bv[j] + wv[0][j] * v2[j] + wv[1][j] * v1[j] + wv[2][j] * vx;
        o[j] = silu_f(ag) * av;
        g2[j] = g1[j]; g1[j] = gx; v2[j] = v1[j]; v1[j] = vx;
      }
      u32x4 pk; pk[0] = pack2(o[0], o[1]); pk[1] = pack2(o[2], o[3]); pk[2] = pack2(o[4], o[5]); pk[3] = pack2(o[6], o[7]);
      *(u32x4*)(ACT + (size_t)t * 2816 + ch) = pk;
    }
  }
}

DEV void phase_down(const Params& p, int b, char* smem) {
  const int tid = get_tid(), lane = tid & 63, w = tid >> 6, wm = w >> 1, wn = w & 1, r = lane & 31, h = lane >> 5;
  for (int it = get_bid(); it < 64 * 8; it += gridDim.x) {
    const int nt = it / 64, mt = it % 64;
    f32x16 acc[2][2];
#pragma unroll
    for (int mi = 0; mi < 2; ++mi)
#pragma unroll
      for (int ni = 0; ni < 2; ++ni) acc[mi][ni] = zero16();
    gemm_tile<2>(acc, (const u16*)(p.ws + OFF_ACT), 2816, NMETA + mt * 128, L - 1, (const u16*)(p.ws + OFF_WDOWN), 2816, nt * 128, 2816, smem);
#pragma unroll
    for (int mi = 0; mi < 2; ++mi)
#pragma unroll
      for (int ni = 0; ni < 2; ++ni)
#pragma unroll
        for (int i = 0; i < 16; ++i) {
          const int rr = mt * 128 + wm * 64 + mi * 32 + acc_row(i, h);
          const size_t idx = ((size_t)b * SEQ + rr) * 1024 + nt * 128 + wn * 64 + ni * 32 + r;
          p.out[idx] += acc[mi][ni][i];
        }
  }
}

DEV void phase_final_norm(const Params& p, int b) {
  const int lane = get_tid() & 63, w = get_tid() >> 6;
  for (int it = get_bid(); it < SEQ / 4; it += nworkers()) {
    const int rr = it * 4 + w;
    rmsnorm_row_f32_inplace(p.out + ((size_t)b * SEQ + rr) * D, p.in[18], lane);
  }
}


template <int NJ>
DEV void gemm_tile8(f32x4 (&acc)[4][NJ], const u16* __restrict__ A, int lda, int arow0, int arow_max,
                    const u16* __restrict__ B, int ldb, int brow0, int K, char* smem) {
  constexpr int BN = NJ * 32;
  constexpr int BCH = BN / 64;
  constexpr int STAGE = (256 + BN) * 64;
  u16* S = (u16*)smem;
  const int tid = get_tid8(), lane = tid & 63, w = tid >> 6, wm = w >> 1, wn = w & 1;
  u32x4 ra[4], rb[BCH];
  unsigned aoff[4], boff[BCH];
  const char* Ab = (const char*)A;
  const char* Bb = (const char*)(B + (size_t)brow0 * ldb);
  const int crow = tid >> 3, kc = tid & 7;
  const unsigned sto = (unsigned)(crow * 64 + ((kc ^ ((crow >> 1) & 7)) * 8));
#pragma unroll
  for (int i = 0; i < 4; ++i) {
    int gr = arow0 + crow + i * 64; gr = gr > arow_max ? arow_max : gr; gr = gr < 0 ? 0 : gr;
    aoff[i] = ((unsigned)gr * (unsigned)lda + kc * 8) * 2u;
  }
#pragma unroll
  for (int i = 0; i < BCH; ++i) boff[i] = ((unsigned)(crow + i * 64) * (unsigned)ldb + kc * 8) * 2u;
  const int fr = lane & 15, swz = fr >> 1, cq = lane >> 4;
  const unsigned fa = (unsigned)((wm * 64 + fr) * 64), fb = (unsigned)((256 + wn * (NJ * 16) + fr) * 64);
  const unsigned c0 = (unsigned)(((cq) ^ swz) * 8), c1 = (unsigned)(((4 + cq) ^ swz) * 8);
  const int nk = K >> 6;
#pragma unroll
  for (int i = 0; i < 4; ++i) ra[i] = *(const u32x4*)(Ab + aoff[i]);
#pragma unroll
  for (int i = 0; i < BCH; ++i) rb[i] = *(const u32x4*)(Bb + boff[i]);
#pragma unroll
  for (int i = 0; i < 4; ++i) *(u32x4*)(S + sto + i * 64 * 64) = ra[i];
#pragma unroll
  for (int i = 0; i < BCH; ++i) *(u32x4*)(S + sto + (256 + i * 64) * 64) = rb[i];
  if (nk > 1) {
#pragma unroll
    for (int i = 0; i < 4; ++i) ra[i] = *(const u32x4*)(Ab + aoff[i] + 128);
#pragma unroll
    for (int i = 0; i < BCH; ++i) rb[i] = *(const u32x4*)(Bb + boff[i] + 128);
  }
  __syncthreads();
  for (int kt = 0; kt < nk; ++kt) {
    const u16* Sc = S + (kt & 1) * STAGE;
    {
      bf16x8 a[4], b[NJ];
#pragma unroll
      for (int m = 0; m < 4; ++m) a[m] = *(const bf16x8*)(Sc + fa + m * 16 * 64 + c0);
#pragma unroll
      for (int n = 0; n < NJ; ++n) b[n] = *(const bf16x8*)(Sc + fb + n * 16 * 64 + c0);
      __builtin_amdgcn_s_setprio(1);
#pragma unroll
      for (int m = 0; m < 4; ++m)
#pragma unroll
        for (int n = 0; n < NJ; ++n) acc[m][n] = __builtin_amdgcn_mfma_f32_16x16x32_bf16(a[m], b[n], acc[m][n], 0, 0, 0);
      __builtin_amdgcn_s_setprio(0);
    }
    __builtin_amdgcn_sched_barrier(0);
    if (kt + 1 < nk) {
      u16* Aw = S + ((kt + 1) & 1) * STAGE;
#pragma unroll
      for (int i = 0; i < 4; ++i) *(u32x4*)(Aw + sto + i * 64 * 64) = ra[i];
#pragma unroll
      for (int i = 0; i < BCH; ++i) *(u32x4*)(Aw + sto + (256 + i * 64) * 64) = rb[i];
      if (kt + 2 < nk) {
        const unsigned ko = (unsigned)(kt + 2) * 128u;
#pragma unroll
        for (int i = 0; i < 4; ++i) ra[i] = *(const u32x4*)(Ab + aoff[i] + ko);
#pragma unroll
        for (int i = 0; i < BCH; ++i) rb[i] = *(const u32x4*)(Bb + boff[i] + ko);
      }
    }
    __builtin_amdgcn_sched_barrier(0);
    {
      bf16x8 a[4], b[NJ];
#pragma unroll
      for (int m = 0; m < 4; ++m) a[m] = *(const bf16x8*)(Sc + fa + m * 16 * 64 + c1);
#pragma unroll
      for (int n = 0; n < NJ; ++n) b[n] = *(const bf16x8*)(Sc + fb + n * 16 * 64 + c1);
      __builtin_amdgcn_s_setprio(1);
#pragma unroll
      for (int m = 0; m < 4; ++m)
#pragma unroll
        for (int n = 0; n < NJ; ++n) acc[m][n] = __builtin_amdgcn_mfma_f32_16x16x32_bf16(a[m], b[n], acc[m][n], 0, 0, 0);
      __builtin_amdgcn_s_setprio(0);
    }
    __syncthreads();
  }
}

DEV f32x4 thin16(const u16* __restrict__ A, int lda, int row0, const u16* __restrict__ BT, int ldb, int col0, int K, int lane) {
  const u16* ap = A + (size_t)(row0 + (lane & 15)) * lda + 8 * (lane >> 4);
  const u16* bp = BT + (size_t)(col0 + (lane & 15)) * ldb + 8 * (lane >> 4);
  f32x4 acc = {0.f, 0.f, 0.f, 0.f};
  for (int k0 = 0; k0 < K; k0 += 128) {
    bf16x8 a[4], b[4];
#pragma unroll
    for (int j = 0; j < 4; ++j) { a[j] = *(const bf16x8*)(ap + k0 + j * 32); b[j] = *(const bf16x8*)(bp + k0 + j * 32); }
#pragma unroll
    for (int j = 0; j < 4; ++j) acc = __builtin_amdgcn_mfma_f32_16x16x32_bf16(a[j], b[j], acc, 0, 0, 0);
  }
  return acc;
}

DEV int tile_index(int k) { const int G = gridDim.x, rb = get_rbid(); return k * G + (rb & 7) * (G >> 3) + (rb >> 3); }
DEV void tile_decode(int T, int MT, int NT, int& mt, int& nt) {
  const int per = MT * 8;
  const int nb = T / per, rem = T - nb * per;
  int width = NT - nb * 8; width = width > 8 ? 8 : width;
  mt = rem / width; nt = nb * 8 + (rem - mt * width);
}

#define ZERO_ACC(acc, NJ_) _Pragma("unroll") for (int m_ = 0; m_ < 4; ++m_) _Pragma("unroll") for (int n_ = 0; n_ < NJ_; ++n_) { acc[m_][n_][0] = 0.f; acc[m_][n_][1] = 0.f; acc[m_][n_][2] = 0.f; acc[m_][n_][3] = 0.f; }

constexpr int EPI_WAVE_BYTES = 17408;
#define EPI_FENCE() asm volatile("s_waitcnt lgkmcnt(0)" ::: "memory")
DEV void epi_store_bf16_128(const u16* reg, u16* __restrict__ dst, int ld, int trow, int col0, int lane) {
#pragma unroll
  for (int j = 0; j < 16; ++j) {
    const int row = (lane >> 4) + 4 * j, t = trow + row;
    const u32x4 v = *(const u32x4*)(reg + row * 136 + (lane & 15) * 8);
    if (t < L) *(u32x4*)(dst + (size_t)t * ld + col0 + (lane & 15) * 8) = v;
  }
}

DEV void phase_inproj8(const Params& p, int b, char* smem) {
  const u16* U = (const u16*)((char*)p.out + OUT_HALF);
  const u16* WT = (const u16*)(p.ws + OFF_S1);
  const int MT = 33, NT = 53;
  for (int kk = 0;; ++kk) {
    const int it = tile_index(kk);
    if (it >= MT * NT) break;
    int mt, nt; tile_decode(it, MT, NT, mt, nt);
    f32x4 acc[4][8];
    ZERO_ACC(acc, 8)
    gemm_tile8<8>(acc, U, 1024, mt * 256, L - 1, WT, 1024, nt * 256, 1024, smem);
    const int tid = get_tid8(), lane = tid & 63, w = tid >> 6, wm = w >> 1, wn = w & 1, r = lane & 31, h = lane >> 5;
    u16* reg = (u16*)(smem + w * EPI_WAVE_BYTES);
    const int n0 = nt * 256;
    const int trow = mt * 256 + wm * 64;
    if (nt >= 20 && nt < 28) {
      const bool isk = nt >= 24;
      const int cq = n0 - (isk ? 6144 : 5120);
      const float sc = isk ? 0.0625f : 1.f;
      u16* dst = (u16*)(p.ws + (isk ? OFF_K : OFF_Q));
#pragma unroll
      for (int pr = 0; pr < 4; ++pr) {
        const int n1 = 4 * (pr >> 1) + (pr & 1);
        const int jf = (wn * 2 + (pr >> 1)) * 32 + (pr & 1) * 16 + (lane & 15);
        const double invf_rev = (double)(exp2f(-(float)jf * 0.10462765653f) * 0.15915494309189535f);
#pragma unroll
        for (int m = 0; m < 4; ++m)
#pragma unroll
          for (int j = 0; j < 4; ++j) {
            const int row = m * 16 + (lane >> 4) * 4 + j;
            double rev = (double)(trow + row) * invf_rev;
            rev -= floor(rev);
            const float fr = (float)rev;
            const float sn = __builtin_amdgcn_sinf(fr), cs = __builtin_amdgcn_cosf(fr);
            const float x1 = acc[m][n1][j], x2 = acc[m][n1 + 2][j];
            reg[row * 136 + n1 * 16 + (lane & 15)] = f2bf((x1 * cs - x2 * sn) * sc);
            reg[row * 136 + n1 * 16 + 32 + (lane & 15)] = f2bf((x2 * cs + x1 * sn) * sc);
          }
      }
      EPI_FENCE();
      epi_store_bf16_128(reg, dst, 1024, trow, cq + wn * 128, lane);
    } else if (nt == 52) {
      float* DT = (float*)(p.ws + OFF_DT);
      if (wn == 0) {
#pragma unroll
        for (int n = 0; n < 2; ++n) {
          const int col = n * 16 + (lane & 15);
          const float bias = p.in[6][col];
#pragma unroll
          for (int m = 0; m < 4; ++m)
#pragma unroll
            for (int j = 0; j < 4; ++j) {
              const int t = trow + m * 16 + (lane >> 4) * 4 + j;
              if (t < L) {
                const float x = acc[m][n][j] + bias;
                const float e = __expf(x);
                DT[(size_t)t * 32 + col] = (x > 20.f) ? x : (e < 0.01f ? e * (1.f - 0.5f * e + e * e * (1.f / 3.f)) : __logf(1.f + e));
              }
            }
        }
      }
    } else {
      u16* dst; int ld, c0; bool sig = false;
      if (nt < 8) { dst = (u16*)(p.ws + OFF_Z); ld = 2048; c0 = n0; }
      else if (nt < 20) { dst = (u16*)(p.ws + OFF_XBC); ld = 3072; c0 = n0 - 2048; }
      else if (nt < 36) { dst = (u16*)(p.ws + OFF_V); ld = 2048; c0 = n0 - 7168; }
      else if (nt < 44) { dst = (u16*)(p.ws + OFF_G); ld = 2048; c0 = n0 - 9216; }
      else if (nt < 48) { dst = (u16*)(p.ws + OFF_GS); ld = 1024; c0 = n0 - 11264; sig = true; }
      else { dst = (u16*)(p.ws + OFF_GR); ld = 1024; c0 = n0 - 12288; sig = true; }
#pragma unroll
      for (int m = 0; m < 4; ++m)
#pragma unroll
        for (int n = 0; n < 8; ++n)
#pragma unroll
          for (int j = 0; j < 4; ++j) {
            float v = acc[m][n][j];
            if (sig) v = sigmoid_f(v);
            reg[(m * 16 + (lane >> 4) * 4 + j) * 136 + n * 16 + (lane & 15)] = f2bf(v);
          }
      EPI_FENCE();
      epi_store_bf16_128(reg, dst, ld, trow, c0 + wn * 128, lane);
    }
    __syncthreads();
  }
}

DEV void phase_merge8(const Params& p, char* smem, char* smem_team) {
  const int tid = get_tid8(), lane = tid & 63, w = tid >> 6, wm = w >> 1, wn = w & 1, r = lane & 31, h = lane >> 5;
  u16* GS = (u16*)(p.ws + OFF_GS);
  const u16* GR = (const u16*)(p.ws + OFF_GR);
  const u16* Zb = (const u16*)(p.ws + OFF_Z);
  const u16* Gb = (const u16*)(p.ws + OFF_G);
  const u16* WBS = (const u16*)(p.ws + OFF_S2);
  const u16* WBR = (const u16*)(p.ws + OFF_S2 + 4194304);
  float* reg = (float*)(smem + w * EPI_WAVE_BYTES);
  for (int kk = 0;; ++kk) {
    const int it = tile_index(kk);
    if (it >= 256) break;
    const int mt = it >> 3, nt = it & 7;
    f32x4 acc[4][4];
    ZERO_ACC(acc, 4)
    gemm_tile8<4>(acc, Zb, 2048, mt * 256, L - 1, WBS, 2048, nt * 128, 2048, smem);
#pragma unroll
    for (int m = 0; m < 4; ++m)
#pragma unroll
      for (int n = 0; n < 4; ++n)
#pragma unroll
        for (int j = 0; j < 4; ++j) { reg[(m * 16 + (lane >> 4) * 4 + j) * 68 + n * 16 + (lane & 15)] = acc[m][n][j]; acc[m][n][j] = 0.f; }
    EPI_FENCE();
#pragma unroll
    for (int j = 0; j < 16; ++j) {
      const int row = (lane >> 4) + 4 * j, c4 = (lane & 15) * 4;
      const f32x4 a = *(const f32x4*)(reg + row * 68 + c4);
      const size_t idx = (size_t)(mt * 256 + wm * 64 + row) * 1024 + nt * 128 + wn * 64 + c4;
      const u32x2 g = *(const u32x2*)(GS + idx);
      u32x2 o; o[0] = pack2(lo_f(g[0]) * a[0], hi_f(g[0]) * a[1]); o[1] = pack2(lo_f(g[1]) * a[2], hi_f(g[1]) * a[3]);
      *(u32x2*)(GS + idx) = o;
    }
    __syncthreads();
    gemm_tile8<4>(acc, Gb, 2048, mt * 256, L - 1, WBR, 2048, nt * 128, 2048, smem);
#pragma unroll
    for (int m = 0; m < 4; ++m)
#pragma unroll
      for (int n = 0; n < 4; ++n)
#pragma unroll
        for (int j = 0; j < 4; ++j) reg[(m * 16 + (lane >> 4) * 4 + j) * 68 + n * 16 + (lane & 15)] = acc[m][n][j];
    EPI_FENCE();
#pragma unroll
    for (int j = 0; j < 16; ++j) {
      const int row = (lane >> 4) + 4 * j, c4 = (lane & 15) * 4;
      const f32x4 a = *(const f32x4*)(reg + row * 68 + c4);
      const size_t idx = (size_t)(mt * 256 + wm * 64 + row) * 1024 + nt * 128 + wn * 64 + c4;
      const u32x2 g = *(const u32x2*)(GS + idx);
      const u32x2 q = *(const u32x2*)(GR + idx);
      u32x2 o; o[0] = pack2(lo_f(g[0]) + lo_f(q[0]) * a[0], hi_f(g[0]) + hi_f(q[0]) * a[1]); o[1] = pack2(lo_f(g[1]) + lo_f(q[1]) * a[2], hi_f(g[1]) + hi_f(q[1]) * a[3]);
      *(u32x2*)(GS + idx) = o;
    }
    __syncthreads();
  }
  for (int ct = get_rbid(); ct < 64; ct += gridDim.x) {
    const int tid = get_tid8(), lane = tid & 63, w = tid >> 6;
    f32x4* red = (f32x4*)smem;
    red[w * 64 + lane] = thin16(Zb + w * 256, 2048, 8192, WBS + w * 256, 2048, ct * 16, 256, lane);
    red[512 + w * 64 + lane] = thin16(Gb + w * 256, 2048, 8192, WBR + w * 256, 2048, ct * 16, 256, lane);
    __syncthreads();
    if (w == 0) {
      f32x4 a1 = red[lane], a2 = red[512 + lane];
#pragma unroll
      for (int q = 1; q < 8; ++q) { a1 += red[q * 64 + lane]; a2 += red[512 + q * 64 + lane]; }
#pragma unroll
      for (int j = 0; j < 4; ++j) {
        const size_t idx = (size_t)(8192 + (lane >> 4) * 4 + j) * 1024 + ct * 16 + (lane & 15);
        GS[idx] = f2bf(bf2f(GS[idx]) * a1[j] + bf2f(GR[idx]) * a2[j]);
      }
    }
    __syncthreads();
  }
  const int n_wout = 16 * 16, n_wup = 16 * 88, n_wdown = 44 * 16;
  for (int it = get_bid(); it < n_wout + n_wup + n_wdown; it += nworkers()) {
    if (it < n_wout) { convert_tile(p.in[12], 1024, 1024, (u16*)(p.ws + OFF_WOUT), it & 15, it >> 4, 0, smem_team); }
    else if (it < n_wout + n_wup) { const int j = it - n_wout; convert_tile(p.in[14], 5632, 1024, (u16*)(p.ws + OFF_WUP), j & 15, j >> 4, 2, smem_team); }
    else { const int j = it - n_wout - n_wup; convert_tile(p.in[17], 1024, 2816, (u16*)(p.ws + OFF_WDOWN), j % 44, j / 44, 0, smem_team); }
  }
}

DEV void phase_outproj8(const Params& p, int b, char* smem) {
  const int tid = get_tid8(), lane = tid & 63, w = tid >> 6, wm = w >> 1, wn = w & 1, r = lane & 31, h = lane >> 5;
  float* HM = (float*)(p.ws + OFF_HM);
  const u16* Mg = (const u16*)(p.ws + OFF_GS);
  const u16* WO = (const u16*)(p.ws + OFF_WOUT);
  float* reg = (float*)(smem + w * EPI_WAVE_BYTES);
  for (int kk = 0;; ++kk) {
    const int it = tile_index(kk);
    if (it >= 256) break;
    const int mt = it >> 3, nt = it & 7;
    f32x4 acc[4][4];
    ZERO_ACC(acc, 4)
    gemm_tile8<4>(acc, Mg, 1024, mt * 256, L - 1, WO, 1024, nt * 128, 1024, smem);
#pragma unroll
    for (int m = 0; m < 4; ++m)
#pragma unroll
      for (int n = 0; n < 4; ++n)
#pragma unroll
        for (int j = 0; j < 4; ++j) reg[(m * 16 + (lane >> 4) * 4 + j) * 68 + n * 16 + (lane & 15)] = acc[m][n][j];
    EPI_FENCE();
#pragma unroll
    for (int j = 0; j < 16; ++j) {
      const int row = (lane >> 4) + 4 * j, c4 = (lane & 15) * 4;
      const f32x4 a = *(const f32x4*)(reg + row * 68 + c4);
      const int t = mt * 256 + wm * 64 + row, col = nt * 128 + wn * 64 + c4;
      if (t < NMETA) {
        const f32x4 x = *(const f32x4*)(p.in[1] + t * 1024 + col);
        *(f32x4*)(HM + t * 1024 + col) = x + a;
      } else {
        const size_t idx = ((size_t)b * SEQ + (t - NMETA)) * 1024 + col;
        const f32x4 x = *(const f32x4*)(p.in[0] + idx);
        *(f32x4*)(p.out + idx) = x + a;
      }
    }
    __syncthreads();
  }
  for (int ct = get_rbid(); ct < 64; ct += gridDim.x) {
    const int tid = get_tid8(), lane = tid & 63, w = tid >> 6;
    f32x4* red = (f32x4*)smem;
    red[w * 64 + lane] = thin16(Mg + w * 128, 1024, 8192, WO + w * 128, 1024, ct * 16, 128, lane);
    __syncthreads();
    if (w == 0) {
      f32x4 a1 = red[lane];
#pragma unroll
      for (int q = 1; q < 8; ++q) a1 += red[q * 64 + lane];
#pragma unroll
      for (int j = 0; j < 4; ++j) {
        const int t = 8192 + (lane >> 4) * 4 + j;
        const size_t idx = ((size_t)b * SEQ + (t - NMETA)) * 1024 + ct * 16 + (lane & 15);
        p.out[idx] = p.in[0][idx] + a1[j];
      }
    }
    __syncthreads();
  }
}

DEV void phase_up8(const Params& p, char* smem) {
  u16* ACT = (u16*)(p.ws + OFF_ACT);
  const float* cw = p.in[15];
  const float* cbias = p.in[16];
  for (int kk = 0;; ++kk) {
    const int it = tile_index(kk);
    if (it >= 33 * 22) break;
    int mt, nt; tile_decode(it, 33, 22, mt, nt);
    f32x4 acc[4][8];
    ZERO_ACC(acc, 8)
    gemm_tile8<8>(acc, (const u16*)(p.ws + OFF_U2), 1024, mt * 254 - 2, L - 1, (const u16*)(p.ws + OFF_WUP), 1024, nt * 256, 1024, smem);
    const int tid = get_tid8(), lane = tid & 63, w = tid >> 6;
    u16* reg = (u16*)(smem + w * EPI_WAVE_BYTES);
#pragma unroll
    for (int m = 0; m < 4; ++m)
#pragma unroll
      for (int n = 0; n < 8; ++n)
#pragma unroll
        for (int j = 0; j < 4; ++j) reg[(m * 16 + (lane >> 4) * 4 + j) * 136 + n * 16 + (lane & 15)] = f2bf(acc[m][n][j]);
    __syncthreads();
    {
      const int cg = tid & 15, rg = tid >> 4;
      const int ch = nt * 128 + cg * 8;
      float wg[3][8], wv[3][8], bg[8], bv[8], g2[8], g1[8], v2[8], v1[8];
#pragma unroll
      for (int k = 0; k < 3; ++k) {
        const f32x4 a0 = *(const f32x4*)(cw + k * 5632 + ch), a1 = *(const f32x4*)(cw + k * 5632 + ch + 4);
        const f32x4 c0 = *(const f32x4*)(cw + k * 5632 + 2816 + ch), c1 = *(const f32x4*)(cw + k * 5632 + 2816 + ch + 4);
#pragma unroll
        for (int j = 0; j < 4; ++j) { wg[k][j] = a0[j]; wg[k][4 + j] = a1[j]; wv[k][j] = c0[j]; wv[k][4 + j] = c1[j]; }
      }
      {
        const f32x4 a0 = *(const f32x4*)(cbias + ch), a1 = *(const f32x4*)(cbias + ch + 4);
        const f32x4 c0 = *(const f32x4*)(cbias + 2816 + ch), c1 = *(const f32x4*)(cbias + 2816 + ch + 4);
#pragma unroll
        for (int j = 0; j < 4; ++j) { bg[j] = a0[j]; bg[4 + j] = a1[j]; bv[j] = c0[j]; bv[4 + j] = c1[j]; }
      }
      const int R0 = rg * 8;
#pragma unroll
      for (int q = 0; q < 2; ++q) {
        const int R = R0 - 2 + q;
        u32x4 gvv = {0u, 0u, 0u, 0u}, vvv = {0u, 0u, 0u, 0u};
        if (R >= 0 && mt * 254 - 2 + R >= 0) {
          const char* sl = smem + ((R >> 6) * 2) * EPI_WAVE_BYTES + ((R & 63) * 136 + cg * 8) * 2;
          gvv = *(const u32x4*)sl; vvv = *(const u32x4*)(sl + EPI_WAVE_BYTES);
        }
#pragma unroll
        for (int j = 0; j < 4; ++j) {
          if (q == 0) { g2[2 * j] = lo_f(gvv[j]); g2[2 * j + 1] = hi_f(gvv[j]); v2[2 * j] = lo_f(vvv[j]); v2[2 * j + 1] = hi_f(vvv[j]); }
          else { g1[2 * j] = lo_f(gvv[j]); g1[2 * j + 1] = hi_f(gvv[j]); v1[2 * j] = lo_f(vvv[j]); v1[2 * j + 1] = hi_f(vvv[j]); }
        }
      }
#pragma unroll 2
      for (int i = 0; i < 8; ++i) {
        const int R = R0 + i, t = mt * 254 - 2 + R;
        u32x4 gvv = {0u, 0u, 0u, 0u}, vvv = {0u, 0u, 0u, 0u};
        if (t >= 0) {
          const char* sl = smem + ((R >> 6) * 2) * EPI_WAVE_BYTES + ((R & 63) * 136 + cg * 8) * 2;
          gvv = *(const u32x4*)sl; vvv = *(const u32x4*)(sl + EPI_WAVE_BYTES);
        }
        float o[8];
#pragma unroll
        for (int j = 0; j < 8; ++j) {
          const float gx = (j & 1) ? hi_f(gvv[j >> 1]) : lo_f(gvv[j >> 1]);
          const float vx = (j & 1) ? hi_f(vvv[j >> 1]) : lo_f(vvv[j >> 1]);
          const float ag = bg[j] + wg[0][j] * g2[j] + wg[1][j] * g1[j] + wg[2][j] * gx;
          const float av = bv[j] + wv[0][j] * v2[j] + wv[1][j] * v1[j] + wv[2][j] * vx;
          o[j] = silu_f(ag) * av;
          g2[j] = g1[j]; g1[j] = gx; v2[j] = v1[j]; v1[j] = vx;
        }
        if (R >= 2 && t < L) {
          u32x4 pk; pk[0] = pack2(o[0], o[1]); pk[1] = pack2(o[2], o[3]); pk[2] = pack2(o[4], o[5]); pk[3] = pack2(o[6], o[7]);
          *(u32x4*)(ACT + (size_t)t * 2816 + ch) = pk;
        }
      }
    }
    __syncthreads();
  }
}

DEV void phase_down8(const Params& p, int b, char* smem) {
  for (int kk = 0;; ++kk) {
    const int it = tile_index(kk);
    if (it >= 256) break;
    const int mt = it >> 3, nt = it & 7;
    f32x4 acc[4][4];
    ZERO_ACC(acc, 4)
    gemm_tile8<4>(acc, (const u16*)(p.ws + OFF_ACT), 2816, NMETA + mt * 256, L - 1, (const u16*)(p.ws + OFF_WDOWN), 2816, nt * 128, 2816, smem);
    const int tid = get_tid8(), lane = tid & 63, w = tid >> 6, wm = w >> 1, wn = w & 1, r = lane & 31, h = lane >> 5;
    float* reg = (float*)(smem + w * EPI_WAVE_BYTES);
#pragma unroll
    for (int m = 0; m < 4; ++m)
#pragma unroll
      for (int n = 0; n < 4; ++n)
#pragma unroll
        for (int j = 0; j < 4; ++j) reg[(m * 16 + (lane >> 4) * 4 + j) * 68 + n * 16 + (lane & 15)] = acc[m][n][j];
    EPI_FENCE();
#pragma unroll
    for (int j = 0; j < 16; ++j) {
      const int row = (lane >> 4) + 4 * j, c4 = (lane & 15) * 4;
      const f32x4 a = *(const f32x4*)(reg + row * 68 + c4);
      const size_t idx = ((size_t)b * SEQ + mt * 256 + wm * 64 + row) * 1024 + nt * 128 + wn * 64 + c4;
      const f32x4 x = *(const f32x4*)(p.out + idx);
      *(f32x4*)(p.out + idx) = x + a;
    }
    __syncthreads();
  }
}

#define XB_TMO      128
#define XB_XCNT(j)  (256  + 64 * (j))
#define XB_XSUB(j)  (1280 + 64 * (j))
#define XB_XGEN(j)  (2304 + 64 * (j))
#define XB_TOP      3328
#define XB_TOPGEN   3392
#define XCD_BAR_WORDS 3456
#define XB_SPIN_CAP (1u << 24)
DEV unsigned xb_ld(unsigned* p)              { return __hip_atomic_load(p, __ATOMIC_RELAXED, __HIP_MEMORY_SCOPE_AGENT); }
DEV unsigned xb_add(unsigned* p, unsigned v) { return __hip_atomic_fetch_add(p, v, __ATOMIC_RELAXED, __HIP_MEMORY_SCOPE_AGENT); }
DEV unsigned xb_xcc_id() { return (unsigned)__builtin_amdgcn_s_getreg((3 << 11) | 20) & 0xFu; }
#define XB_SPIN(cond, bar) do { unsigned _sp = 0; while (cond) { __builtin_amdgcn_s_sleep(1); \
    if ((++_sp & 255u) == 0u) { if (xb_ld(&(bar)[XB_TMO])) break; if (_sp > XB_SPIN_CAP) { atomicAdd(&(bar)[XB_TMO], 1u); break; } } } } while (0)
struct XcdBarrier { unsigned* bar; unsigned x; volatile LDSP unsigned* st; };
DEV XcdBarrier xcd_barrier_post(unsigned* bar, volatile LDSP unsigned* st) {
  XcdBarrier b; b.bar = bar; b.x = xb_xcc_id(); b.st = st;
  if (threadIdx.x == 0) (void)xb_add(&bar[XB_XCNT(b.x)], 1u);
  return b;
}
DEV void xcd_barrier_complete(unsigned* bar, unsigned x, unsigned& nloc, unsigned& nx) {
  const unsigned G = gridDim.x * gridDim.y * gridDim.z;
  unsigned sum, cnt, mine, sp = 0u;
  for (;;) {
    sum = 0u; cnt = 0u; mine = 0u;
#pragma unroll
    for (unsigned j = 0; j < 16; ++j) { const unsigned c = xb_ld(&bar[XB_XCNT(j)]); sum += c; cnt += (c > 0u) ? 1u : 0u; mine = (j == x) ? c : mine; }
    if (sum == G) break;
    __builtin_amdgcn_s_sleep(1);
    if ((++sp & 255u) == 0u) { if (xb_ld(&bar[XB_TMO])) break; if (sp > XB_SPIN_CAP) { atomicAdd(&bar[XB_TMO], 1u); break; } }
  }
  nloc = mine > 0u ? mine : 1u; nx = cnt > 0u ? cnt : 1u;
}
DEV void xcd_barrier(const XcdBarrier& b) {
  asm volatile("s_waitcnt vmcnt(0)" ::: "memory");
  __syncthreads();
  if (threadIdx.x == 0) {
    unsigned* bar = b.bar;
    __builtin_amdgcn_s_waitcnt(0);
    unsigned nloc = b.st[0], nx = b.st[1];
    if (nloc == 0u) { xcd_barrier_complete(bar, b.x, nloc, nx); b.st[0] = nloc; b.st[1] = nx; }
    const unsigned old = xb_add(&bar[XB_XSUB(b.x)], 1u);
    const unsigned gen = old / nloc;
    if (old + 1u == (gen + 1u) * nloc) {
      __builtin_amdgcn_fence(__ATOMIC_RELEASE, "agent");
      asm volatile("s_waitcnt vmcnt(0)" ::: "memory");
      const unsigned og = xb_add(&bar[XB_TOP], 1u);
      const unsigned tg = og / nx;
      if (og + 1u == (tg + 1u) * nx) xb_add(&bar[XB_TOPGEN], 1u);
      else XB_SPIN(xb_ld(&bar[XB_TOPGEN]) == tg, bar);
      __builtin_amdgcn_fence(__ATOMIC_ACQUIRE, "agent");
      xb_add(&bar[XB_XGEN(b.x)], 1u);
      asm volatile("s_waitcnt vmcnt(0)" ::: "memory");
    } else {
      XB_SPIN(xb_ld(&bar[XB_XGEN(b.x)]) == gen, bar);
      __builtin_amdgcn_fence(__ATOMIC_ACQUIRE, "agent");
      asm volatile("s_waitcnt vmcnt(0)" ::: "memory");
    }
  }
  __syncthreads();
}

constexpr int N_PHASES = 21;

__global__ void __launch_bounds__(512) fwd_kernel(Params p, int ph0, int ph1) {
  __shared__ __attribute__((aligned(16))) char smem[SMEM_BYTES];
  __shared__ uint4 xb_words;
  if (threadIdx.x == 0) xb_words = make_uint4(0u, 0u, 0u, 0u);
  __syncthreads();
  XcdBarrier xb = xcd_barrier_post((unsigned*)(p.ws + OFF_BAR), (volatile LDSP unsigned*)&xb_words);
  if (ph1 < 0) cg::this_grid().sync();
  for (int ph = ph0; ph < ph1; ++ph) {
    char* tsm = smem + (get_tid8() >> 8) * SMEM_TEAM;
    const int b = ph >= 11 ? 1 : 0;
    const int lp = (ph == 0) ? 0 : (ph == 20 ? 10 : (ph >= 11 ? ph - 10 : ph));
    switch (lp) {
      case 0: phase_prep(p, 0, true, tsm); break;
      case 1: phase_inproj8(p, b, smem); break;
      case 2: {
        int it = get_bid();
        for (; it < 1024; it += nworkers()) ret_kv_item(p, it, tsm);
        for (; it < 2048; it += nworkers()) ssd_state_item(p, it - 1024, tsm);
      } break;
      case 3: phase_scan(p); break;
      case 4: {
        {
          const int rb = get_rbid(), team = get_tid8() >> 8;
          for (int j = 0; j < 3; ++j) {
            int kind = -1, idx = 0;
            if (rb < 4) {
              const int q = rb * 3 + j;
              const int rt = (q < 2) ? 128 : ((q >> 1) - 1) * 4;
              kind = 0; idx = rt * 4 + (q & 1) * 2 + team;
            } else if (rb < 10) {
              if (j < 2) { kind = 1; idx = (246 + (rb - 4) * 2 + j) * 2 + team; }
            } else if (j < 2) {
              const int k = rb - 10, ri = k >> 1;
              const int rt = (ri < 12) ? ((ri / 3) * 4 + 1 + ri % 3) : (17 + ri - 12);
              kind = j; idx = (j == 0) ? (rt * 4 + (k & 1) * 2 + team) : (k * 2 + team);
            }
            if (kind == 0) ret_out_item(p, idx, tsm);
            else if (kind == 1) ssd_out_item(p, idx, tsm);
          }
        }
      } break;
      case 5: phase_merge8(p, smem, tsm); break;
      case 6: phase_outproj8(p, b, smem); break;
      case 7: phase_norm2(p, b); break;
      case 8: phase_up8(p, smem); break;
      case 9: phase_down8(p, b, smem); break;
      case 10: {
        if (ph == 10) { phase_final_norm(p, 0); phase_prep(p, 1, false, tsm); }
        else phase_final_norm(p, 1);
      } break;
    }
    if (ph + 1 < ph1) xcd_barrier(xb);
  }
}

#ifndef MK_SINGLE
#define MK_SINGLE 1
#endif

extern "C" void kernel_launch(void* const* d_in, const int* in_sizes, int n_in, void* d_out, int out_size, void* d_ws, size_t ws_size,
                              hipStream_t stream) {
  static int grid_blocks = 0;
  if (!grid_blocks) {
    int dev = 0, cus = 0, per_cu = 0;
    hipGetDevice(&dev);
    hipDeviceGetAttribute(&cus, hipDeviceAttributeMultiprocessorCount, dev);
    hipOccupancyMaxActiveBlocksPerMultiprocessor(&per_cu, fwd_kernel, 512, 0);
    per_cu = 1;
    if (cus != 256) fprintf(stderr, "kernel_launch: built for a 256-CU device (static phase schedules assume 256 workgroups), found %d CUs\n", cus);
    cus = 256;
    grid_blocks = cus * per_cu;
  }
  Params p{};
  for (int i = 0; i < 19; ++i) p.in[i] = (const float*)d_in[i];
  p.out = (float*)d_out;
  p.ws = (char*)d_ws;
#if MK_SINGLE
  (void)hipMemsetAsync((char*)d_ws + OFF_BAR, 0, XCD_BAR_WORDS * 4, stream);
  int ph0 = 0, ph1 = N_PHASES;
  void* args[] = {&p, &ph0, &ph1};
  hipError_t e = hipLaunchCooperativeKernel((void*)fwd_kernel, dim3(grid_blocks), dim3(512), args, 0, stream);
  if (e != hipSuccess) fprintf(stderr, "cooperative launch failed: %s (grid %d)\n", hipGetErrorString(e), grid_blocks);
#else
  for (int ph = 0; ph < N_PHASES; ++ph) {
    hipLaunchKernelGGL(fwd_kernel, dim3(grid_blocks), dim3(512), 0, stream, p, ph, ph + 1);
  }
#endif
}
```

```cpp
#include <hip/hip_runtime.h>
#include <hip/hip_cooperative_groups.h>
#include <cstdio>
namespace cg = cooperative_groups;

typedef unsigned short u16;
typedef __bf16 bf16x8 __attribute__((ext_vector_type(8)));
typedef short s16x4 __attribute__((ext_vector_type(4)));
typedef short s16x8 __attribute__((ext_vector_type(8)));
typedef float f32x16 __attribute__((ext_vector_type(16)));
typedef unsigned int u32x4 __attribute__((ext_vector_type(4)));
typedef unsigned int u32x2 __attribute__((ext_vector_type(2)));
typedef float f32x4 __attribute__((ext_vector_type(4)));

#define DEV __device__ __forceinline__
#define LDSP __attribute__((address_space(3)))

constexpr int D = 1024;
constexpr int L = 8208;
constexpr int SEQ = 8192;
constexpr int NMETA = 16;
constexpr int NPROJ = 13344;
constexpr int NPROJ_PAD = 13568;
constexpr int DFF = 2816;
constexpr float EPS = 1e-6f;

constexpr size_t OFF_Z = 0;
constexpr size_t OFF_G = 33619968;
constexpr size_t OFF_GS = 67239936;
constexpr size_t OFF_GR = 84049920;
constexpr size_t OFF_Q = 100859904;
constexpr size_t OFF_XBC = 117669888;
constexpr size_t OFF_K = 168099840;
constexpr size_t OFF_V = 184909824;
constexpr size_t OFF_DT = 218529792;
constexpr size_t OFF_S2 = 219580416;
constexpr size_t OFF_S1 = 227969024;
constexpr size_t OFF_CD = 261523456;
constexpr size_t OFF_HM = 261531648;
constexpr size_t OFF_BAR = 261597184;
constexpr size_t OFF_WOUT = OFF_S1;
constexpr size_t OFF_WUP = OFF_S1 + 2097152;
constexpr size_t OFF_WDOWN = OFF_S1 + 13631488;
constexpr size_t OFF_UP = OFF_XBC;
constexpr size_t OFF_ACT = OFF_Z;
constexpr size_t OFF_U2 = OFF_Q;
constexpr size_t OUT_HALF = 33554432;

constexpr int SMEM_TEAM = 73728;
constexpr int SMEM_BYTES = 2 * SMEM_TEAM;

struct Params {
  const float* in[19];
  float* out;
  char* ws;
};

DEV int get_tid8() { int t = threadIdx.x; asm volatile("" : "+v"(t)); return t; }
DEV int get_tid() { int t = threadIdx.x & 255; asm volatile("" : "+v"(t)); return t; }
DEV int get_rbid() { int t = blockIdx.x; asm volatile("" : "+s"(t)); return t; }
DEV int get_bid() { int t = get_rbid() * 2 + (get_tid8() >> 8); return __builtin_amdgcn_readfirstlane(t); }
DEV int nworkers() { return (int)gridDim.x * 2; }
DEV float bf2f(u16 h) { return __uint_as_float(((unsigned)h) << 16); }
DEV u16 f2bf(float f) { unsigned u = __float_as_uint(f); u += 0x7fffu + ((u >> 16) & 1u); return (u16)(u >> 16); }
DEV unsigned pack2(float a, float b) { return (unsigned)f2bf(a) | ((unsigned)f2bf(b) << 16); }
DEV float silu_f(float x) { return x / (1.f + __expf(-x)); }
DEV float sigmoid_f(float x) { return 1.f / (1.f + __expf(-x)); }
DEV float lo_f(unsigned u) { return __uint_as_float(u << 16); }
DEV float hi_f(unsigned u) { return __uint_as_float(u & 0xffff0000u); }
DEV float wave_sum(float v) {
#pragma unroll
  for (int o = 32; o > 0; o >>= 1) v += __shfl_xor(v, o);
  return v;
}
DEV float half_sum(float v) {
#pragma unroll
  for (int o = 16; o > 0; o >>= 1) v += __shfl_xor(v, o);
  return v;
}
DEV float log_gamma(int h) {
  return h == 0 ? -0.0317486983145803f : (h == 1 ? -0.015748356968139168f : (h == 2 ? -0.007843177461025893f : -0.003913899321136329f));
}
DEV f32x16 mfma(bf16x8 a, bf16x8 b, f32x16 c) { return __builtin_amdgcn_mfma_f32_32x32x16_bf16(a, b, c, 0, 0, 0); }
DEV f32x16 zero16() { f32x16 z;
#pragma unroll
  for (int i = 0; i < 16; ++i) z[i] = 0.f;
  return z; }
DEV int acc_row(int i, int h) { return (i & 3) + 8 * (i >> 2) + 4 * h; }

DEV bf16x8 frag_tr(const u16* T, int ld, int k0, int x0, int lane) {
  const int h = lane >> 5, blk = (lane >> 4) & 1, q = (lane & 15) >> 2, pp = lane & 3;
  const u16* a0 = T + (k0 + 8 * h + q) * ld + x0 + 16 * blk + 4 * pp;
  s16x4 lo = __builtin_amdgcn_ds_read_tr16_b64_v4i16((LDSP s16x4*)a0);
  s16x4 hi = __builtin_amdgcn_ds_read_tr16_b64_v4i16((LDSP s16x4*)(a0 + 4 * ld));
  s16x8 v = {lo[0], lo[1], lo[2], lo[3], hi[0], hi[1], hi[2], hi[3]};
  return __builtin_bit_cast(bf16x8, v);
}
DEV bf16x8 frag_row(const u16* T, int ld, int row, int k) {
  return *(const bf16x8*)(T + row * ld + k);
}

template <int MI>
DEV void gemm_tile(f32x16 (&acc)[MI][2], const u16* __restrict__ A, int lda, int arow0, int arow_max,
                   const u16* __restrict__ B, int ldb, int brow0, int K, char* smem) {
  constexpr int BM = MI * 64;
  constexpr int LD = 72;
  constexpr int ACH = BM * 8 / 256;
  u16* As = (u16*)smem;
  u16* Bs = As + BM * LD;
  const int tid = get_tid(), lane = tid & 63, w = tid >> 6, wm = w >> 1, wn = w & 1, r = lane & 31, h = lane >> 5;
  u32x4 ra[ACH], rb[4];
  const u16* ap[ACH];
  const u16* bp[4];
#pragma unroll
  for (int i = 0; i < ACH; ++i) {
    int c = tid + i * 256, row = c >> 3, kc = c & 7;
    int gr = arow0 + row; gr = gr > arow_max ? arow_max : gr;
    ap[i] = A + (size_t)gr * lda + kc * 8;
  }
#pragma unroll
  for (int i = 0; i < 4; ++i) {
    int c = tid + i * 256, row = c >> 3, kc = c & 7;
    bp[i] = B + (size_t)(brow0 + row) * ldb + kc * 8;
  }
#pragma unroll
  for (int i = 0; i < ACH; ++i) ra[i] = *(const u32x4*)(ap[i]);
#pragma unroll
  for (int i = 0; i < 4; ++i) rb[i] = *(const u32x4*)(bp[i]);
  const int nk = K >> 6;
  for (int kt = 0; kt < nk; ++kt) {
#pragma unroll
    for (int i = 0; i < ACH; ++i) { int c = tid + i * 256, row = c >> 3, kc = c & 7; *(u32x4*)(As + row * LD + kc * 8) = ra[i]; }
#pragma unroll
    for (int i = 0; i < 4; ++i) { int c = tid + i * 256, row = c >> 3, kc = c & 7; *(u32x4*)(Bs + row * LD + kc * 8) = rb[i]; }
    __syncthreads();
    if (kt + 1 < nk) {
#pragma unroll
      for (int i = 0; i < ACH; ++i) ra[i] = *(const u32x4*)(ap[i] + (kt + 1) * 64);
#pragma unroll
      for (int i = 0; i < 4; ++i) rb[i] = *(const u32x4*)(bp[i] + (kt + 1) * 64);
    }
#pragma unroll
    for (int ks = 0; ks < 4; ++ks) {
      bf16x8 a[MI], b[2];
#pragma unroll
      for (int mi = 0; mi < MI; ++mi) a[mi] = frag_row(As, LD, wm * MI * 32 + mi * 32 + r, ks * 16 + h * 8);
#pragma unroll
      for (int ni = 0; ni < 2; ++ni) b[ni] = frag_row(Bs, LD, wn * 64 + ni * 32 + r, ks * 16 + h * 8);
#pragma unroll
      for (int mi = 0; mi < MI; ++mi)
#pragma unroll
        for (int ni = 0; ni < 2; ++ni) acc[mi][ni] = mfma(a[mi], b[ni], acc[mi][ni]);
    }
    __syncthreads();
  }
}

DEV int orig_col(int n) {
  if (n < 5120) return n;
  if (n < 7168) {
    int q = n - 5120; int which = q >> 10; int c = q & 1023; int head = c >> 8; int ip = c & 255; int blk = ip >> 6; int wi = ip & 63;
    int j = (wi < 32) ? (blk * 32 + wi) : (128 + blk * 32 + wi - 32);
    return 5152 + which * 1024 + head * 256 + j;
  }
  if (n < 13312) return n + 32;
  if (n < 13344) return 5120 + (n - 13312);
  return -1;
}
DEV void convert_tile(const float* __restrict__ W, int Nsrc, int K, u16* __restrict__ WT, int kt, int ntile, int mode, char* smem) {
  float* t = (float*)smem;
  const int tid = get_tid();
  {
    const int tx = tid & 15, ty = tid >> 4;
    const int n = ntile * 64 + tx * 4;
    int on = n;
    if (mode == 1) on = orig_col(n);
    else if (mode == 2) { const int tl = n >> 8, wi = n & 255; on = (wi < 128) ? (tl * 128 + wi) : (2816 + tl * 128 + wi - 128); }
#pragma unroll
    for (int kk = ty; kk < 64; kk += 16) {
      f32x4 v = {0.f, 0.f, 0.f, 0.f};
      if (on >= 0) v = *(const f32x4*)(W + (size_t)(kt * 64 + kk) * Nsrc + on);
      *(f32x4*)(t + kk * 68 + tx * 4) = v;
    }
  }
  __syncthreads();
  {
    const int nn = tid >> 2, kq = (tid & 3) * 16;
    u32x4 o[2];
#pragma unroll
    for (int j = 0; j < 8; ++j) o[j >> 2][j & 3] = pack2(t[(kq + 2 * j) * 68 + nn], t[(kq + 2 * j + 1) * 68 + nn]);
    u16* d = WT + (size_t)(ntile * 64 + nn) * K + kt * 64 + kq;
    *(u32x4*)d = o[0]; *(u32x4*)(d + 8) = o[1];
  }
  __syncthreads();
}

DEV void rmsnorm_row_bf16(const float* __restrict__ src, const float* __restrict__ w, u16* __restrict__ dst, int lane) {
  f32x4 v[4]; float ss = 0.f;
#pragma unroll
  for (int j = 0; j < 4; ++j) { v[j] = *(const f32x4*)(src + j * 256 + lane * 4); ss += v[j][0] * v[j][0] + v[j][1] * v[j][1] + v[j][2] * v[j][2] + v[j][3] * v[j][3]; }
  ss = wave_sum(ss);
  const float rstd = rsqrtf(ss * (1.f / 1024.f) + EPS);
#pragma unroll
  for (int j = 0; j < 4; ++j) {
    f32x4 ww = *(const f32x4*)(w + j * 256 + lane * 4);
    u32x2 o; o[0] = pack2(v[j][0] * rstd * ww[0], v[j][1] * rstd * ww[1]); o[1] = pack2(v[j][2] * rstd * ww[2], v[j][3] * rstd * ww[3]);
    *(u32x2*)(dst + j * 256 + lane * 4) = o;
  }
}
DEV void rmsnorm_row_f32_inplace(float* __restrict__ row, const float* __restrict__ w, int lane) {
  f32x4 v[4]; float ss = 0.f;
#pragma unroll
  for (int j = 0; j < 4; ++j) { v[j] = *(const f32x4*)(row + j * 256 + lane * 4); ss += v[j][0] * v[j][0] + v[j][1] * v[j][1] + v[j][2] * v[j][2] + v[j][3] * v[j][3]; }
  ss = wave_sum(ss);
  const float rstd = rsqrtf(ss * (1.f / 1024.f) + EPS);
#pragma unroll
  for (int j = 0; j < 4; ++j) {
    f32x4 ww = *(const f32x4*)(w + j * 256 + lane * 4);
    f32x4 o; o[0] = v[j][0] * rstd * ww[0]; o[1] = v[j][1] * rstd * ww[1]; o[2] = v[j][2] * rstd * ww[2]; o[3] = v[j][3] * rstd * ww[3];
    *(f32x4*)(row + j * 256 + lane * 4) = o;
  }
}

template <int R, int C, bool SCALE>
DEV void stage_conv(u16* dst, int ld, const u16* __restrict__ xbc, int row0, int ch0, const float* __restrict__ cw, const float* __restrict__ cb, const float* rs) {
  constexpr int CG = C / 8, RG = 256 / CG, RPT = R / RG;
  const int tid = get_tid();
  const int cgi = tid % CG, rgi = tid / CG;
  const int ch = ch0 + cgi * 8, r0 = rgi * RPT;
  float w[4][8], bias[8], xw[3][8];
#pragma unroll
  for (int k = 0; k < 4; ++k) {
    f32x4 a = *(const f32x4*)(cw + k * 3072 + ch), b = *(const f32x4*)(cw + k * 3072 + ch + 4);
#pragma unroll
    for (int j = 0; j < 4; ++j) { w[k][j] = a[j]; w[k][4 + j] = b[j]; }
  }
  {
    f32x4 a = *(const f32x4*)(cb + ch), b = *(const f32x4*)(cb + ch + 4);
#pragma unroll
    for (int j = 0; j < 4; ++j) { bias[j] = a[j]; bias[4 + j] = b[j]; }
  }
#pragma unroll
  for (int k = 0; k < 3; ++k) {
    const int tr = row0 + r0 - 3 + k;
    u32x4 v = {0u, 0u, 0u, 0u};
    if (tr >= 0 && tr < L) v = *(const u32x4*)(xbc + (size_t)tr * 3072 + ch);
#pragma unroll
    for (int j = 0; j < 4; ++j) { xw[k][2 * j] = lo_f(v[j]); xw[k][2 * j + 1] = hi_f(v[j]); }
  }
#pragma unroll
  for (int i = 0; i < RPT; ++i) {
    const int tr = row0 + r0 + i;
    const bool valid = tr < L;
    u32x4 v = {0u, 0u, 0u, 0u};
    if (valid) v = *(const u32x4*)(xbc + (size_t)tr * 3072 + ch);
    float xc[8], o[8];
#pragma unroll
    for (int j = 0; j < 4; ++j) { xc[2 * j] = lo_f(v[j]); xc[2 * j + 1] = hi_f(v[j]); }
    float sc = 1.f;
    if (SCALE) sc = rs[(cgi >> 3) * 128 + r0 + i];
#pragma unroll
    for (int j = 0; j < 8; ++j) {
      float a = bias[j] + w[0][j] * xw[0][j] + w[1][j] * xw[1][j] + w[2][j] * xw[2][j] + w[3][j] * xc[j];
      a = silu_f(a) * sc;
      o[j] = valid ? a : 0.f;
      xw[0][j] = xw[1][j]; xw[1][j] = xw[2][j]; xw[2][j] = xc[j];
    }
    u32x4 pk; pk[0] = pack2(o[0], o[1]); pk[1] = pack2(o[2], o[3]); pk[2] = pack2(o[4], o[5]); pk[3] = pack2(o[6], o[7]);
    *(u32x4*)(dst + (r0 + i) * ld + cgi * 8) = pk;
  }
}

DEV float chunk_cumsum(const float* __restrict__ DT, int c, int H, float A, float* acs, float* dts, int lane) {
  const int s0 = 2 * lane;
  const int t0 = c * 128 + s0;
  const float d0 = (t0 < L) ? DT[(size_t)t0 * 32 + H] : 0.f;
  const float d1 = (t0 + 1 < L) ? DT[(size_t)(t0 + 1) * 32 + H] : 0.f;
  const float a0 = d0 * A, a1 = a0 + d1 * A;
  float tot = a1;
#pragma unroll
  for (int o = 1; o < 64; o <<= 1) { float n = __shfl_up(tot, o); if (lane >= o) tot += n; }
  const float excl = tot - a1;
  acs[s0] = excl + a0; acs[s0 + 1] = excl + a1;
  dts[s0] = d0; dts[s0 + 1] = d1;
  return __shfl(tot, 63);
}

DEV void phase_prep(const Params& p, int b, bool first, char* smem) {
  const int tid = get_tid(), lane = tid & 63, w = tid >> 6;
  u16* U = (u16*)((char*)p.out + OUT_HALF);
  const int n_norm = L / 4;
  const int n_win = 16 * (NPROJ_PAD / 64);
  const int n_wb = first ? 2 * 32 * 16 : 0;
  const int total = n_norm + n_win + n_wb;
  for (int it = get_bid(); it < total; it += nworkers()) {
    if (it < n_norm) {
      const int t = it * 4 + w;
      const float* src = (t < NMETA) ? (p.in[1] + (size_t)t * D) : (p.in[0] + ((size_t)b * SEQ + (t - NMETA)) * D);
      rmsnorm_row_bf16(src, p.in[2], U + (size_t)t * D, lane);
    } else if (it < n_norm + n_win) {
      const int j = it - n_norm; const int ntile = j >> 4, kt = j & 15;
      convert_tile(p.in[3], NPROJ, 1024, (u16*)(p.ws + OFF_S1), kt, ntile, 1, smem);
    } else {
      int j = it - n_norm - n_win; const int which = j >> 9; j &= 511; const int ntile = j >> 5, kt = j & 31;
      convert_tile(p.in[10 + which], 1024, 2048, (u16*)(p.ws + OFF_S2 + (size_t)which * 4194304), kt, ntile, 0, smem);
    }
  }
}

DEV void phase_inproj(const Params& p, int b, char* smem) {
  const int tid = get_tid(), lane = tid & 63, w = tid >> 6, wm = w >> 1, wn = w & 1, r = lane & 31, h = lane >> 5;
  const u16* U = (const u16*)((char*)p.out + OUT_HALF);
  const u16* WT = (const u16*)(p.ws + OFF_S1);
  const int MT = 65, NT = 105;
  for (int it = get_bid(); it < MT * NT; it += gridDim.x) {
    const int nt = it / MT, mt = it % MT;
    f32x16 acc[2][2];
#pragma unroll
    for (int mi = 0; mi < 2; ++mi)
#pragma unroll
      for (int ni = 0; ni < 2; ++ni) acc[mi][ni] = zero16();
    gemm_tile<2>(acc, U, 1024, mt * 128, L - 1, WT, 1024, nt * 128, 1024, smem);
    const int n0 = nt * 128;
    if (nt >= 40 && nt < 56) {
      const bool isk = nt >= 48;
      const int cq = n0 - (isk ? 6144 : 5120);
      const int blk = ((cq & 255) >> 6) + wn;
      const int jf = blk * 32 + r;
      const double invf_rev = exp(-(double)jf * 0.07252236513367073) * 0.15915494309189535;
      const float sc = isk ? 0.0625f : 1.f;
      u16* dst = (u16*)(p.ws + (isk ? OFF_K : OFF_Q));
#pragma unroll
      for (int mi = 0; mi < 2; ++mi)
#pragma unroll
        for (int i = 0; i < 16; ++i) {
          const int t = mt * 128 + wm * 64 + mi * 32 + acc_row(i, h);
          if (t < L) {
            double rev = (double)t * invf_rev;
            rev -= floor(rev);
            const float fr = (float)rev;
            const float sn = __builtin_amdgcn_sinf(fr), cs = __builtin_amdgcn_cosf(fr);
            const float x1 = acc[mi][0][i], x2 = acc[mi][1][i];
            const float o1 = (x1 * cs - x2 * sn) * sc, o2 = (x2 * cs + x1 * sn) * sc;
            u16* d = dst + (size_t)t * 1024 + cq + wn * 64 + r;
            d[0] = f2bf(o1); d[32] = f2bf(o2);
          }
        }
    } else if (nt == 104) {
      float* DT = (float*)(p.ws + OFF_DT);
      if (wn == 0) {
        const float bias = p.in[6][r];
#pragma unroll
        for (int mi = 0; mi < 2; ++mi)
#pragma unroll
          for (int i = 0; i < 16; ++i) {
            const int t = mt * 128 + wm * 64 + mi * 32 + acc_row(i, h);
            if (t < L) {
              const float x = acc[mi][0][i] + bias;
              const float e = __expf(x);
              DT[(size_t)t * 32 + r] = (x > 20.f) ? x : (e < 0.01f ? e * (1.f - 0.5f * e + e * e * (1.f / 3.f)) : __logf(1.f + e));
            }
          }
      }
    } else {
      u16* dst; int ld, c0; bool sig = false;
      if (nt < 16) { dst = (u16*)(p.ws + OFF_Z); ld = 2048; c0 = n0; }
      else if (nt < 40) { dst = (u16*)(p.ws + OFF_XBC); ld = 3072; c0 = n0 - 2048; }
      else if (nt < 72) { dst = (u16*)(p.ws + OFF_V); ld = 2048; c0 = n0 - 7168; }
      else if (nt < 88) { dst = (u16*)(p.ws + OFF_G); ld = 2048; c0 = n0 - 9216; }
      else if (nt < 96) { dst = (u16*)(p.ws + OFF_GS); ld = 1024; c0 = n0 - 11264; sig = true; }
      else { dst = (u16*)(p.ws + OFF_GR); ld = 1024; c0 = n0 - 12288; sig = true; }
#pragma unroll
      for (int mi = 0; mi < 2; ++mi)
#pragma unroll
        for (int ni = 0; ni < 2; ++ni)
#pragma unroll
          for (int i = 0; i < 16; ++i) {
            const int t = mt * 128 + wm * 64 + mi * 32 + acc_row(i, h);
            if (t < L) {
              float v = acc[mi][ni][i];
              if (sig) v = sigmoid_f(v);
              dst[(size_t)t * ld + c0 + wn * 64 + ni * 32 + r] = f2bf(v);
            }
          }
    }
  }
}

DEV void ssd_state_item(const Params& p, int it, char* smem) {
  const int tid = get_tid(), lane = tid & 63, w = tid >> 6, wm = w >> 1, wn = w & 1, r = lane & 31, h = lane >> 5;
  const int c = it >> 4, hp = it & 15, H0 = hp * 2, g = H0 >> 3;
  u16* Xw = (u16*)smem;
  u16* Bc = Xw + 128 * 136;
  float* wsc = (float*)(Bc + 128 * 136);
  float* tmp = wsc + 256;
  const float* DT = (const float*)(p.ws + OFF_DT);
  float* CD = (float*)(p.ws + OFF_CD);
  const u16* XBC = (const u16*)(p.ws + OFF_XBC);
  if (w < 2) {
    const int H = H0 + w;
    const float A = -expf(p.in[7][H]);
    float* acs = tmp + w * 128;
    float* dts = wsc + w * 128;
    const float aend = chunk_cumsum(DT, c, H, A, acs, dts, lane);
    const int s0 = 2 * lane;
    const float w0 = __expf(aend - acs[s0]) * dts[s0], w1 = __expf(aend - acs[s0 + 1]) * dts[s0 + 1];
    dts[s0] = w0; dts[s0 + 1] = w1;
    if (lane == 0) CD[c * 32 + H] = __expf(aend);
  }
  __syncthreads();
  stage_conv<128, 128, true>(Xw, 136, XBC, c * 128, H0 * 64, p.in[4], p.in[5], wsc);
  stage_conv<128, 128, false>(Bc, 136, XBC, c * 128, 2048 + g * 128, p.in[4], p.in[5], nullptr);
  __syncthreads();
  f32x16 acc[2][2];
#pragma unroll
  for (int mi = 0; mi < 2; ++mi)
#pragma unroll
    for (int ni = 0; ni < 2; ++ni) acc[mi][ni] = zero16();
#pragma unroll
  for (int ks = 0; ks < 8; ++ks) {
    bf16x8 a[2], bq[2];
#pragma unroll
    for (int mi = 0; mi < 2; ++mi) a[mi] = frag_tr(Xw, 136, ks * 16, wm * 64 + mi * 32, lane);
#pragma unroll
    for (int ni = 0; ni < 2; ++ni) bq[ni] = frag_tr(Bc, 136, ks * 16, wn * 64 + ni * 32, lane);
#pragma unroll
    for (int mi = 0; mi < 2; ++mi)
#pragma unroll
      for (int ni = 0; ni < 2; ++ni) acc[mi][ni] = mfma(a[mi], bq[ni], acc[mi][ni]);
  }
  u16* ST = (u16*)(p.ws + OFF_S1) + (size_t)(c * 32 + H0) * 8192;
  __syncthreads();
#pragma unroll
  for (int mi = 0; mi < 2; ++mi)
#pragma unroll
    for (int ni = 0; ni < 2; ++ni)
#pragma unroll
      for (int i = 0; i < 16; ++i) Xw[(wm * 64 + mi * 32 + acc_row(i, h)) * 136 + wn * 64 + ni * 32 + r] = f2bf(acc[mi][ni][i]);
  asm volatile("s_waitcnt lgkmcnt(0)" ::: "memory");
#pragma unroll
  for (int j = 0; j < 8; ++j) {
    const int m = wm * 64 + (lane >> 3) + 8 * j, n = wn * 64 + (lane & 7) * 8;
    *(u32x4*)(ST + m * 128 + n) = *(const u32x4*)(Xw + m * 136 + n);
  }
  __syncthreads();
}

DEV void ret_kv_item(const Params& p, int it, char* smem) {
  const int tid = get_tid(), lane = tid & 63, w = tid >> 6, wm = w >> 1, wn = w & 1, r = lane & 31, h = lane >> 5;
  const int sc = it >> 5, rem = it & 31, hd = rem >> 3, dt2 = (rem >> 2) & 1, et = rem & 3;
  u16* Vt = (u16*)smem;
  u16* Kt = Vt + 128 * 136;
  const u16* Vg = (const u16*)(p.ws + OFF_V);
  const u16* Kg = (const u16*)(p.ws + OFF_K);
  const float lg = log_gamma(hd);
  f32x16 acc[2][2];
#pragma unroll
  for (int mi = 0; mi < 2; ++mi)
#pragma unroll
    for (int ni = 0; ni < 2; ++ni) acc[mi][ni] = zero16();
  for (int half = 0; half < 2; ++half) {
#pragma unroll
    for (int i = 0; i < 8; ++i) {
      const int cidx = tid + i * 256, row = cidx >> 4, cc = cidx & 15;
      const int tok = sc * 256 + half * 128 + row;
      u32x4 v = *(const u32x4*)(Vg + (size_t)tok * 2048 + hd * 512 + et * 128 + cc * 8);
      *(u32x4*)(Vt + row * 136 + cc * 8) = v;
      u32x4 kk = *(const u32x4*)(Kg + (size_t)tok * 1024 + hd * 256 + dt2 * 128 + cc * 8);
      const float dec = __expf((float)(255 - (half * 128 + row)) * lg);
      u32x4 ko;
#pragma unroll
      for (int j = 0; j < 4; ++j) ko[j] = pack2(lo_f(kk[j]) * dec, hi_f(kk[j]) * dec);
      *(u32x4*)(Kt + row * 136 + cc * 8) = ko;
    }
    __syncthreads();
#pragma unroll
    for (int ks = 0; ks < 8; ++ks) {
      bf16x8 a[2], bq[2];
#pragma unroll
      for (int mi = 0; mi < 2; ++mi) a[mi] = frag_tr(Vt, 136, ks * 16, wm * 64 + mi * 32, lane);
#pragma unroll
      for (int ni = 0; ni < 2; ++ni) bq[ni] = frag_tr(Kt, 136, ks * 16, wn * 64 + ni * 32, lane);
#pragma unroll
      for (int mi = 0; mi < 2; ++mi)
#pragma unroll
        for (int ni = 0; ni < 2; ++ni) acc[mi][ni] = mfma(a[mi], bq[ni], acc[mi][ni]);
    }
    __syncthreads();
  }
  u16* RST = (u16*)((char*)p.out + OUT_HALF) + ((size_t)(sc * 4 + hd) * 512 + et * 128) * 256 + dt2 * 128;
#pragma unroll
  for (int mi = 0; mi < 2; ++mi)
#pragma unroll
    for (int ni = 0; ni < 2; ++ni)
#pragma unroll
      for (int i = 0; i < 16; ++i) Vt[(wm * 64 + mi * 32 + acc_row(i, h)) * 136 + wn * 64 + ni * 32 + r] = f2bf(acc[mi][ni][i]);
  asm volatile("s_waitcnt lgkmcnt(0)" ::: "memory");
#pragma unroll
  for (int j = 0; j < 8; ++j) {
    const int e = wm * 64 + (lane >> 3) + 8 * j, d = wn * 64 + (lane & 7) * 8;
    *(u32x4*)(RST + (size_t)e * 256 + d) = *(const u32x4*)(Vt + e * 136 + d);
  }
  __syncthreads();
}

DEV void phase_scan(const Params& p) {
  const int gt = get_bid() * 256 + get_tid(), nth = nworkers() * 256;
  const float* CD = (const float*)(p.ws + OFF_CD);
  for (int v = gt; v < 32768 + 65536; v += nth) {
    float st[8];
#pragma unroll
    for (int j = 0; j < 8; ++j) st[j] = 0.f;
    if (v < 32768) {
      const int e0 = v * 8, H = e0 >> 13;
      u16* base = (u16*)(p.ws + OFF_S1) + e0;
      for (int c0 = 0; c0 < 64; c0 += 4) {
        u32x4 x[4];
#pragma unroll
        for (int u = 0; u < 4; ++u) x[u] = *(const u32x4*)(base + (size_t)(c0 + u) * 262144);
#pragma unroll
        for (int u = 0; u < 4; ++u) {
          const float dcy = CD[(c0 + u) * 32 + H];
          u32x4 o;
#pragma unroll
          for (int j = 0; j < 4; ++j) {
            st[2 * j] = st[2 * j] * dcy + lo_f(x[u][j]);
            st[2 * j + 1] = st[2 * j + 1] * dcy + hi_f(x[u][j]);
            o[j] = pack2(st[2 * j], st[2 * j + 1]);
          }
          *(u32x4*)(base + (size_t)(c0 + u) * 262144) = o;
        }
      }
    } else {
      const int e0 = (v - 32768) * 8, hd = e0 >> 17;
      const float g256 = __expf(256.f * log_gamma(hd));
      u16* base = (u16*)((char*)p.out + OUT_HALF) + e0;
      for (int c0 = 0; c0 < 32; c0 += 4) {
        u32x4 x[4];
#pragma unroll
        for (int u = 0; u < 4; ++u) x[u] = *(const u32x4*)(base + (size_t)(c0 + u) * 524288);
#pragma unroll
        for (int u = 0; u < 4; ++u) {
          u32x4 o;
#pragma unroll
          for (int j = 0; j < 4; ++j) {
            st[2 * j] = st[2 * j] * g256 + lo_f(x[u][j]);
            st[2 * j + 1] = st[2 * j + 1] * g256 + hi_f(x[u][j]);
            o[j] = pack2(st[2 * j], st[2 * j + 1]);
          }
          *(u32x4*)(base + (size_t)(c0 + u) * 524288) = o;
        }
      }
    }
  }
}

DEV void ssd_out_item(const Params& p, int it, char* smem) {
  const int tid = get_tid(), lane = tid & 63, w = tid >> 6, wm = w >> 1, wn = w & 1, r = lane & 31, h = lane >> 5;
  const int c = it >> 3, rem = it & 7, g = rem & 3, lh = rem >> 2;
  if (c == 64 && lh == 1) return;
  u16* Ct = (u16*)smem;
  u16* Bt = Ct + 64 * 136;
  u16* Lt = Bt;
  u16* Xt = Bt + 128 * 136;
  float* acs = (float*)(Xt + 128 * 72);
  float* dts = acs + 128;
  float* rowsq = dts + 128;
  const u16* XBC = (const u16*)(p.ws + OFF_XBC);
  const float* DT = (const float*)(p.ws + OFF_DT);
  u16* Z = (u16*)(p.ws + OFF_Z);
  const int tok0 = c * 128;
  stage_conv<64, 128, false>(Ct, 136, XBC, tok0 + lh * 64, 2560 + g * 128, p.in[4], p.in[5], nullptr);
  stage_conv<128, 128, false>(Bt, 136, XBC, tok0, 2048 + g * 128, p.in[4], p.in[5], nullptr);
  if (tid < 64) rowsq[tid] = 0.f;
  __syncthreads();
  f32x16 cb[2];
  cb[0] = zero16(); cb[1] = zero16();
#pragma unroll
  for (int ks = 0; ks < 8; ++ks) {
    bf16x8 a = frag_row(Ct, 136, wm * 32 + r, ks * 16 + h * 8);
#pragma unroll
    for (int ni = 0; ni < 2; ++ni) {
      bf16x8 bq = frag_row(Bt, 136, wn * 64 + ni * 32 + r, ks * 16 + h * 8);
      cb[ni] = mfma(a, bq, cb[ni]);
    }
  }
  for (int hh = 0; hh < 8; ++hh) {
    const int H = g * 8 + hh;
    u32x4 zv[2];
    {
      int tz = tok0 + lh * 64 + (tid >> 2); tz = tz < L ? tz : L - 1;
      const u16* zp0 = Z + (size_t)tz * 2048 + H * 64 + (tid & 3) * 16;
      zv[0] = *(const u32x4*)zp0; zv[1] = *(const u32x4*)(zp0 + 8);
    }
    __syncthreads();
    if (w == 0) {
      const float A = -expf(p.in[7][H]);
      chunk_cumsum(DT, c, H, A, acs, dts, lane);
    }
    stage_conv<128, 64, false>(Xt, 72, XBC, tok0, H * 64, p.in[4], p.in[5], nullptr);
    __syncthreads();
#pragma unroll
    for (int ni = 0; ni < 2; ++ni)
#pragma unroll
      for (int i = 0; i < 16; ++i) {
        const int ll = wm * 32 + acc_row(i, h), l = lh * 64 + ll, s = wn * 64 + ni * 32 + r;
        float val = 0.f;
        if (s <= l) val = cb[ni][i] * __expf(acs[l] - acs[s]) * dts[s];
        Lt[ll * 136 + s] = f2bf(val);
      }
    f32x16 y = zero16();
    if (c > 0) {
      const u16* pv = (const u16*)(p.ws + OFF_S1) + ((size_t)((c - 1) * 32 + H) * 64 + wn * 32 + r) * 128 + h * 8;
#pragma unroll
      for (int ks = 0; ks < 8; ++ks) {
        bf16x8 a = frag_row(Ct, 136, wm * 32 + r, ks * 16 + h * 8);
        bf16x8 bq = *(const bf16x8*)(pv + ks * 16);
        y = mfma(a, bq, y);
      }
#pragma unroll
      for (int i = 0; i < 16; ++i) { const int l = lh * 64 + wm * 32 + acc_row(i, h); y[i] *= __expf(acs[l]); }
    }
    __syncthreads();
#pragma unroll
    for (int ks = 0; ks < 8; ++ks) {
      bf16x8 a = frag_row(Lt, 136, wm * 32 + r, ks * 16 + h * 8);
      bf16x8 bq = frag_tr(Xt, 72, ks * 16, wn * 32, lane);
      y = mfma(a, bq, y);
    }
    const float Dsk = p.in[8][H];
    float* Ys = (float*)(Bt + 64 * 136);
#pragma unroll
    for (int i = 0; i < 16; ++i) Ys[(wm * 32 + acc_row(i, h)) * 68 + wn * 32 + r] = y[i];
    __syncthreads();
    {
      const int row = tid >> 2, q = tid & 3, l = lh * 64 + row, t = tok0 + l;
      float sq = 0.f;
      if (t < L) {
        u16* zp = Z + (size_t)t * 2048 + H * 64 + q * 16;
        u32x4 xv[2], ov[2];
        xv[0] = *(const u32x4*)(Xt + l * 72 + q * 16); xv[1] = *(const u32x4*)(Xt + l * 72 + q * 16 + 8);
#pragma unroll
        for (int k = 0; k < 2; ++k) {
          const f32x4 ya = *(const f32x4*)(Ys + row * 68 + q * 16 + k * 8), yb = *(const f32x4*)(Ys + row * 68 + q * 16 + k * 8 + 4);
          float o[8];
#pragma unroll
          for (int j = 0; j < 4; ++j) {
            const float y0 = (j < 2) ? ya[2 * j] : yb[2 * j - 4], y1 = (j < 2) ? ya[2 * j + 1] : yb[2 * j - 3];
            o[2 * j] = (y0 + Dsk * lo_f(xv[k][j])) * silu_f(lo_f(zv[k][j]));
            o[2 * j + 1] = (y1 + Dsk * hi_f(xv[k][j])) * silu_f(hi_f(zv[k][j]));
            sq += o[2 * j] * o[2 * j] + o[2 * j + 1] * o[2 * j + 1];
            ov[k][j] = pack2(o[2 * j], o[2 * j + 1]);
          }
        }
        *(u32x4*)zp = ov[0]; *(u32x4*)(zp + 8) = ov[1];
      }
      sq += __shfl_xor(sq, 1); sq += __shfl_xor(sq, 2);
      if (q == 0) rowsq[row] += sq;
    }
  }
  __syncthreads();
  {
    const int row = tid >> 2, q = tid & 3, t = tok0 + lh * 64 + row;
    if (t < L) {
      const float rn = rsqrtf(rowsq[row] * (1.f / 512.f) + EPS);
      u32x4 v[16];
#pragma unroll
      for (int hh = 0; hh < 8; ++hh) {
        const u16* zp = Z + (size_t)t * 2048 + (g * 8 + hh) * 64 + q * 16;
        v[2 * hh] = *(const u32x4*)zp; v[2 * hh + 1] = *(const u32x4*)(zp + 8);
      }
#pragma unroll
      for (int hh = 0; hh < 8; ++hh) {
        u16* zp = Z + (size_t)t * 2048 + (g * 8 + hh) * 64 + q * 16;
        const float* nwp = p.in[9] + (g * 8 + hh) * 64 + q * 16;
#pragma unroll
        for (int k = 0; k < 2; ++k) {
          const f32x4 wa = *(const f32x4*)(nwp + k * 8), wb = *(const f32x4*)(nwp + k * 8 + 4);
          u32x4 o;
          o[0] = pack2(lo_f(v[2 * hh + k][0]) * rn * wa[0], hi_f(v[2 * hh + k][0]) * rn * wa[1]);
          o[1] = pack2(lo_f(v[2 * hh + k][1]) * rn * wa[2], hi_f(v[2 * hh + k][1]) * rn * wa[3]);
          o[2] = pack2(lo_f(v[2 * hh + k][2]) * rn * wb[0], hi_f(v[2 * hh + k][2]) * rn * wb[1]);
          o[3] = pack2(lo_f(v[2 * hh + k][3]) * rn * wb[2], hi_f(v[2 * hh + k][3]) * rn * wb[3]);
          *(u32x4*)(zp + k * 8) = o;
        }
      }
    }
  }
  __syncthreads();
}

DEV void ret_out_item(const Params& p, int it, char* smem) {
  const int tid = get_tid(), lane = tid & 63, w = tid >> 6, wm = w >> 1, wn = w & 1, r = lane & 31, h = lane >> 5;
  const int rt = it >> 2, hd = it & 3;
  const int t0 = rt * 64, sc = rt >> 2, qtr = rt & 3;
  u16* P = (u16*)smem;
  char* gsm = smem + 33792;
  u16* Vt = (u16*)gsm;
  float* rowsq = (float*)(smem + 33792 + 27648);
  const u16* Qg = (const u16*)(p.ws + OFF_Q) + hd * 256;
  const u16* Kg = (const u16*)(p.ws + OFF_K) + hd * 256;
  const u16* Vg = (const u16*)(p.ws + OFF_V);
  u16* Gg = (u16*)(p.ws + OFF_G);
  const u16* RST = (const u16*)((char*)p.out + OUT_HALF);
  const float lg = log_gamma(hd);
  if (tid < 64) rowsq[tid] = 0.f;
  const int nkb = (qtr >= 2) ? 2 : 1;
  for (int kb = 0; kb < nkb; ++kb) {
    f32x16 acc[1][2];
    acc[0][0] = zero16(); acc[0][1] = zero16();
    gemm_tile<1>(acc, Qg, 1024, t0, L - 1, Kg, 1024, sc * 256 + kb * 128, 256, gsm);
#pragma unroll
    for (int ni = 0; ni < 2; ++ni)
#pragma unroll
      for (int i = 0; i < 16; ++i) {
        const int ll = wm * 32 + acc_row(i, h), lp = qtr * 64 + ll, s = kb * 128 + wn * 64 + ni * 32 + r;
        float val = 0.f;
        if (s <= lp) val = acc[0][ni][i] * __expf((float)(lp - s) * lg);
        P[ll * 264 + s] = f2bf(val);
      }
  }
  float rs[16];
#pragma unroll
  for (int i = 0; i < 16; ++i) rs[i] = 0.f;
  for (int et = 0; et < 4; ++et) {
    f32x16 acc[1][2];
    acc[0][0] = zero16(); acc[0][1] = zero16();
    u32x4 gv[4], vreg[4];
    {
      int tg = t0 + (tid >> 2); tg = tg < L ? tg : L - 1;
      const u16* gp0 = Gg + (size_t)tg * 2048 + hd * 512 + et * 128 + (tid & 3) * 32;
#pragma unroll
      for (int k = 0; k < 4; ++k) gv[k] = *(const u32x4*)(gp0 + k * 8);
#pragma unroll
      for (int i = 0; i < 4; ++i) {
        const int cidx = tid + i * 256, row = cidx >> 4, cc = cidx & 15;
        int tok = sc * 256 + row; tok = tok < L ? tok : L - 1;
        vreg[i] = *(const u32x4*)(Vg + (size_t)tok * 2048 + hd * 512 + et * 128 + cc * 8);
      }
    }
    if (sc > 0) {
      gemm_tile<1>(acc, Qg, 1024, t0, L - 1, RST + ((size_t)((sc - 1) * 4 + hd) * 512 + et * 128) * 256, 256, 0, 256, gsm);
#pragma unroll
      for (int ni = 0; ni < 2; ++ni)
#pragma unroll
        for (int i = 0; i < 16; ++i) {
          const int lp = qtr * 64 + wm * 32 + acc_row(i, h);
          acc[0][ni][i] *= __expf((float)(lp + 1) * lg);
        }
    }
    for (int kb64 = 0; kb64 <= qtr; ++kb64) {
#pragma unroll
      for (int i = 0; i < 4; ++i) {
        const int cidx = tid + i * 256, row = cidx >> 4, cc = cidx & 15;
        const int tok = sc * 256 + kb64 * 64 + row;
        u32x4 v = {0u, 0u, 0u, 0u};
        if (tok < L) v = vreg[i];
        *(u32x4*)(Vt + row * 136 + cc * 8) = v;
      }
      __syncthreads();
      if (kb64 < qtr) {
#pragma unroll
        for (int i = 0; i < 4; ++i) {
          const int cidx = tid + i * 256, row = cidx >> 4, cc = cidx & 15;
          int tok = sc * 256 + (kb64 + 1) * 64 + row; tok = tok < L ? tok : L - 1;
          vreg[i] = *(const u32x4*)(Vg + (size_t)tok * 2048 + hd * 512 + et * 128 + cc * 8);
        }
      }
#pragma unroll
      for (int ks = 0; ks < 4; ++ks) {
        bf16x8 a = frag_row(P, 264, wm * 32 + r, kb64 * 64 + ks * 16 + h * 8);
#pragma unroll
        for (int ni = 0; ni < 2; ++ni) {
          bf16x8 bq = frag_tr(Vt, 136, ks * 16, wn * 64 + ni * 32, lane);
          acc[0][ni] = mfma(a, bq, acc[0][ni]);
        }
      }
      __syncthreads();
    }
    u16* Os = (u16*)gsm;
#pragma unroll
    for (int ni = 0; ni < 2; ++ni)
#pragma unroll
      for (int i = 0; i < 16; ++i) {
        const float o = acc[0][ni][i];
        if (t0 + wm * 32 + acc_row(i, h) < L) rs[i] += o * o;
        Os[(wm * 32 + acc_row(i, h)) * 136 + wn * 64 + ni * 32 + r] = f2bf(o);
      }
    __syncthreads();
    {
      const int row = tid >> 2, q = tid & 3, t = t0 + row;
      if (t < L) {
        u16* gp = Gg + (size_t)t * 2048 + hd * 512 + et * 128 + q * 32;
        u32x4 ov[4];
#pragma unroll
        for (int k = 0; k < 4; ++k) ov[k] = *(const u32x4*)(Os + row * 136 + q * 32 + k * 8);
#pragma unroll
        for (int k = 0; k < 4; ++k) {
          u32x4 o;
#pragma unroll
          for (int j = 0; j < 4; ++j) o[j] = pack2(silu_f(lo_f(gv[k][j])) * lo_f(ov[k][j]), silu_f(hi_f(gv[k][j])) * hi_f(ov[k][j]));
          *(u32x4*)(gp + k * 8) = o;
        }
      }
    }
    __syncthreads();
  }
#pragma unroll
  for (int i = 0; i < 16; ++i) {
    const float v = half_sum(rs[i]);
    if (r == 0) atomicAdd(&rowsq[wm * 32 + acc_row(i, h)], v);
  }
  __syncthreads();
  {
    const int row = tid >> 2, q = tid & 3, t = t0 + row;
    if (t < L) {
      const float rn = rsqrtf(rowsq[row] * (1.f / 512.f) + EPS);
      u32x4 v[16];
#pragma unroll
      for (int et = 0; et < 4; ++et)
#pragma unroll
        for (int k = 0; k < 4; ++k) v[et * 4 + k] = *(const u32x4*)(Gg + (size_t)t * 2048 + hd * 512 + et * 128 + q * 32 + k * 8);
#pragma unroll
      for (int et = 0; et < 4; ++et)
#pragma unroll
        for (int k = 0; k < 4; ++k) {
          u32x4 o;
#pragma unroll
          for (int j = 0; j < 4; ++j) o[j] = pack2(lo_f(v[et * 4 + k][j]) * rn, hi_f(v[et * 4 + k][j]) * rn);
          *(u32x4*)(Gg + (size_t)t * 2048 + hd * 512 + et * 128 + q * 32 + k * 8) = o;
        }
    }
  }
  __syncthreads();
}

DEV void merge_tile(const Params& p, int it, char* smem) {
  const int tid = get_tid(), lane = tid & 63, w = tid >> 6, wm = w >> 1, wn = w & 1, r = lane & 31, h = lane >> 5;
  const int nt = it / 65, mt = it % 65;
  u16* GS = (u16*)(p.ws + OFF_GS);
  const u16* GR = (const u16*)(p.ws + OFF_GR);
  f32x16 acc[2][2];
#pragma unroll
  for (int mi = 0; mi < 2; ++mi)
#pragma unroll
    for (int ni = 0; ni < 2; ++ni) acc[mi][ni] = zero16();
  gemm_tile<2>(acc, (const u16*)(p.ws + OFF_Z), 2048, mt * 128, L - 1, (const u16*)(p.ws + OFF_S2), 2048, nt * 128, 2048, smem);
#pragma unroll
  for (int mi = 0; mi < 2; ++mi)
#pragma unroll
    for (int ni = 0; ni < 2; ++ni)
#pragma unroll
      for (int i = 0; i < 16; ++i) {
        const int t = mt * 128 + wm * 64 + mi * 32 + acc_row(i, h);
        if (t < L) {
          const size_t idx = (size_t)t * 1024 + nt * 128 + wn * 64 + ni * 32 + r;
          GS[idx] = f2bf(bf2f(GS[idx]) * acc[mi][ni][i]);
        }
        acc[mi][ni][i] = 0.f;
      }
  gemm_tile<2>(acc, (const u16*)(p.ws + OFF_G), 2048, mt * 128, L - 1, (const u16*)(p.ws + OFF_S2 + 4194304), 2048, nt * 128, 2048, smem);
#pragma unroll
  for (int mi = 0; mi < 2; ++mi)
#pragma unroll
    for (int ni = 0; ni < 2; ++ni)
#pragma unroll
      for (int i = 0; i < 16; ++i) {
        const int t = mt * 128 + wm * 64 + mi * 32 + acc_row(i, h);
        if (t < L) {
          const size_t idx = (size_t)t * 1024 + nt * 128 + wn * 64 + ni * 32 + r;
          GS[idx] = f2bf(bf2f(GS[idx]) + bf2f(GR[idx]) * acc[mi][ni][i]);
        }
      }
}

DEV void phase_merge(const Params& p, char* smem) {
  const int n_tiles = 65 * 8;
  const int n_wout = 16 * 16, n_wup = 16 * 88, n_wdown = 44 * 16;
  const int total = n_tiles + n_wout + n_wup + n_wdown;
  for (int it = get_bid(); it < total; it += nworkers()) {
    if (it < n_tiles) merge_tile(p, it, smem);
    else if (it < n_tiles + n_wout) { const int j = it - n_tiles; convert_tile(p.in[12], 1024, 1024, (u16*)(p.ws + OFF_WOUT), j & 15, j >> 4, 0, smem); }
    else if (it < n_tiles + n_wout + n_wup) { const int j = it - n_tiles - n_wout; convert_tile(p.in[14], 5632, 1024, (u16*)(p.ws + OFF_WUP), j & 15, j >> 4, 0, smem); }
    else { const int j = it - n_tiles - n_wout - n_wup; convert_tile(p.in[17], 1024, 2816, (u16*)(p.ws + OFF_WDOWN), j % 44, j / 44, 0, smem); }
  }
}

DEV void phase_outproj(const Params& p, int b, char* smem) {
  const int tid = get_tid(), lane = tid & 63, w = tid >> 6, wm = w >> 1, wn = w & 1, r = lane & 31, h = lane >> 5;
  float* HM = (float*)(p.ws + OFF_HM);
  for (int it = get_bid(); it < 65 * 8; it += gridDim.x) {
    const int nt = it / 65, mt = it % 65;
    f32x16 acc[2][2];
#pragma unroll
    for (int mi = 0; mi < 2; ++mi)
#pragma unroll
      for (int ni = 0; ni < 2; ++ni) acc[mi][ni] = zero16();
    gemm_tile<2>(acc, (const u16*)(p.ws + OFF_GS), 1024, mt * 128, L - 1, (const u16*)(p.ws + OFF_WOUT), 1024, nt * 128, 1024, smem);
#pragma unroll
    for (int mi = 0; mi < 2; ++mi)
#pragma unroll
      for (int ni = 0; ni < 2; ++ni)
#pragma unroll
        for (int i = 0; i < 16; ++i) {
          const int t = mt * 128 + wm * 64 + mi * 32 + acc_row(i, h);
          const int col = nt * 128 + wn * 64 + ni * 32 + r;
          if (t < NMETA) HM[t * 1024 + col] = p.in[1][t * 1024 + col] + acc[mi][ni][i];
          else if (t < L) {
            const size_t idx = ((size_t)b * SEQ + (t - NMETA)) * 1024 + col;
            p.out[idx] = p.in[0][idx] + acc[mi][ni][i];
          }
        }
  }
}

DEV void phase_norm2(const Params& p, int b) {
  const int lane = get_tid() & 63, w = get_tid() >> 6;
  u16* U2 = (u16*)(p.ws + OFF_U2);
  for (int it = get_bid(); it < L / 4; it += nworkers()) {
    const int t = it * 4 + w;
    const float* src = (t < NMETA) ? ((const float*)(p.ws + OFF_HM) + (size_t)t * D) : (p.out + ((size_t)b * SEQ + (t - NMETA)) * D);
    rmsnorm_row_bf16(src, p.in[13], U2 + (size_t)t * D, lane);
  }
}

DEV void phase_up(const Params& p, char* smem) {
  const int tid = get_tid(), lane = tid & 63, w = tid >> 6, wm = w >> 1, wn = w & 1, r = lane & 31, h = lane >> 5;
  u16* UP = (u16*)(p.ws + OFF_UP);
  for (int it = get_bid(); it < 65 * 44; it += gridDim.x) {
    const int nt = it / 65, mt = it % 65;
    f32x16 acc[2][2];
#pragma unroll
    for (int mi = 0; mi < 2; ++mi)
#pragma unroll
      for (int ni = 0; ni < 2; ++ni) acc[mi][ni] = zero16();
    gemm_tile<2>(acc, (const u16*)(p.ws + OFF_U2), 1024, mt * 128, L - 1, (const u16*)(p.ws + OFF_WUP), 1024, nt * 128, 1024, smem);
#pragma unroll
    for (int mi = 0; mi < 2; ++mi)
#pragma unroll
      for (int ni = 0; ni < 2; ++ni)
#pragma unroll
        for (int i = 0; i < 16; ++i) {
          const int t = mt * 128 + wm * 64 + mi * 32 + acc_row(i, h);
          if (t < L) UP[(size_t)t * 5632 + nt * 128 + wn * 64 + ni * 32 + r] = f2bf(acc[mi][ni][i]);
        }
  }
}

DEV void phase_ffn_act(const Params& p) {
  const int gt = get_bid() * 256 + get_tid(), nth = nworkers() * 256;
  const u16* UP = (const u16*)(p.ws + OFF_UP);
  u16* ACT = (u16*)(p.ws + OFF_ACT);
  const float* cw = p.in[15];
  const float* cbias = p.in[16];
  for (int u = gt; u < 513 * 352; u += nth) {
    const int rb = u / 352, cgp = u % 352, ch = cgp * 8, t0 = rb * 16;
    float wg[3][8], wv[3][8], bg[8], bv[8], g2[8], g1[8], v2[8], v1[8];
#pragma unroll
    for (int k = 0; k < 3; ++k)
#pragma unroll
      for (int j = 0; j < 8; ++j) { wg[k][j] = cw[k * 5632 + ch + j]; wv[k][j] = cw[k * 5632 + 2816 + ch + j]; }
#pragma unroll
    for (int j = 0; j < 8; ++j) { bg[j] = cbias[ch + j]; bv[j] = cbias[2816 + ch + j]; }
    {
      u32x4 a = {0u, 0u, 0u, 0u}, bq = {0u, 0u, 0u, 0u}, c2 = {0u, 0u, 0u, 0u}, d2 = {0u, 0u, 0u, 0u};
      if (t0 >= 2) {
        a = *(const u32x4*)(UP + (size_t)(t0 - 2) * 5632 + ch); bq = *(const u32x4*)(UP + (size_t)(t0 - 1) * 5632 + ch);
        c2 = *(const u32x4*)(UP + (size_t)(t0 - 2) * 5632 + 2816 + ch); d2 = *(const u32x4*)(UP + (size_t)(t0 - 1) * 5632 + 2816 + ch);
      }
#pragma unroll
      for (int j = 0; j < 4; ++j) {
        g2[2 * j] = lo_f(a[j]); g2[2 * j + 1] = hi_f(a[j]); g1[2 * j] = lo_f(bq[j]); g1[2 * j + 1] = hi_f(bq[j]);
        v2[2 * j] = lo_f(c2[j]); v2[2 * j + 1] = hi_f(c2[j]); v1[2 * j] = lo_f(d2[j]); v1[2 * j + 1] = hi_f(d2[j]);
      }
    }
#pragma unroll 4
    for (int i = 0; i < 16; ++i) {
      const int t = t0 + i;
      const u32x4 a = *(const u32x4*)(UP + (size_t)t * 5632 + ch);
      const u32x4 c2 = *(const u32x4*)(UP + (size_t)t * 5632 + 2816 + ch);
      float o[8];
#pragma unroll
      for (int j = 0; j < 8; ++j) {
        const float gx = (j & 1) ? hi_f(a[j >> 1]) : lo_f(a[j >> 1]);
        const float vx = (j & 1) ? hi_f(c2[j >> 1]) : lo_f(c2[j >> 1]);
        const float ag = bg[j] + wg[0][j] * g2[j] + wg[1][j] * g1[j] + wg[2][j] * gx;
        const float av = bv[j] + wv[0][j] * v2[j] + wv[1][j] * v1[j] + wv[2][j] * vx;
        o[j] = silu_f(ag) * av;
        g2[j] = g1[j]; g1[j] = gx; v2[j] = v1[j]; v1[j] = vx;
      }
      u32x4 pk; pk[0] = pack2(o[0], o[1]); pk[1] = pack2(o[2], o[3]); pk[2] = pack2(o[4], o[5]); pk[3] = pack2(o[6], o[7]);
      *(u32x4*)(ACT + (size_t)t * 2816 + ch) = pk;
    }
  }
}

DEV void phase_down(const Params& p, int b, char* smem) {
  const int tid = get_tid(), lane = tid & 63, w = tid >> 6, wm = w >> 1, wn = w & 1, r = lane & 31, h = lane >> 5;
  for (int it = get_bid(); it < 64 * 8; it += gridDim.x) {
    const int nt = it / 64, mt = it % 64;
    f32x16 acc[2][2];
#pragma unroll
    for (int mi = 0; mi < 2; ++mi)
#pragma unroll
      for (int ni = 0; ni < 2; ++ni) acc[mi][ni] = zero16();
    gemm_tile<2>(acc, (const u16*)(p.ws + OFF_ACT), 2816, NMETA + mt * 128, L - 1, (const u16*)(p.ws + OFF_WDOWN), 2816, nt * 128, 2816, smem);
#pragma unroll
    for (int mi = 0; mi < 2; ++mi)
#pragma unroll
      for (int ni = 0; ni < 2; ++ni)
#pragma unroll
        for (int i = 0; i < 16; ++i) {
          const int rr = mt * 128 + wm * 64 + mi * 32 + acc_row(i, h);
          const size_t idx = ((size_t)b * SEQ + rr) * 1024 + nt * 128 + wn * 64 + ni * 32 + r;
          p.out[idx] += acc[mi][ni][i];
        }
  }
}

DEV void phase_final_norm(const Params& p, int b) {
  const int lane = get_tid() & 63, w = get_tid() >> 6;
  for (int it = get_bid(); it < SEQ / 4; it += nworkers()) {
    const int rr = it * 4 + w;
    rmsnorm_row_f32_inplace(p.out + ((size_t)b * SEQ + rr) * D, p.in[18], lane);
  }
}


DEV u32x4 add_bf16x8(u32x4 a, u32x4 b) {
  u32x4 o;
#pragma unroll
  for (int j = 0; j < 4; ++j) o[j] = pack2(lo_f(a[j]) + lo_f(b[j]), hi_f(a[j]) + hi_f(b[j]));
  return o;
}
template <int NJ, bool ADD2 = false>
DEV void gemm_tile8(f32x4 (&acc)[4][NJ], const u16* __restrict__ A, int lda, int arow0, int arow_max,
                    const u16* __restrict__ B, int ldb, int brow0, int K, char* smem, const u16* __restrict__ A2 = nullptr) {
  constexpr int BN = NJ * 32;
  constexpr int BCH = BN / 64;
  constexpr int STAGE = (256 + BN) * 64;
  u16* S = (u16*)smem;
  const int tid = get_tid8(), lane = tid & 63, w = tid >> 6, wm = w >> 1, wn = w & 1;
  u32x4 ra[4], rb[BCH], ra2[ADD2 ? 4 : 1];
  unsigned aoff[4], boff[BCH];
  const char* Ab = (const char*)A;
  const char* Ab2 = (const char*)A2;
  const char* Bb = (const char*)(B + (size_t)brow0 * ldb);
  const int crow = tid >> 3, kc = tid & 7;
  const unsigned sto = (unsigned)(crow * 64 + ((kc ^ ((crow >> 1) & 7)) * 8));
#pragma unroll
  for (int i = 0; i < 4; ++i) {
    int gr = arow0 + crow + i * 64; gr = gr > arow_max ? arow_max : gr; gr = gr < 0 ? 0 : gr;
    aoff[i] = ((unsigned)gr * (unsigned)lda + kc * 8) * 2u;
  }
#pragma unroll
  for (int i = 0; i < BCH; ++i) boff[i] = ((unsigned)(crow + i * 64) * (unsigned)ldb + kc * 8) * 2u;
  const int fr = lane & 15, swz = fr >> 1, cq = lane >> 4;
  const unsigned fa = (unsigned)((wm * 64 + fr) * 64), fb = (unsigned)((256 + wn * (NJ * 16) + fr) * 64);
  const unsigned c0 = (unsigned)(((cq) ^ swz) * 8), c1 = (unsigned)(((4 + cq) ^ swz) * 8);
  const int nk = K >> 6;
#pragma unroll
  for (int i = 0; i < 4; ++i) { ra[i] = *(const u32x4*)(Ab + aoff[i]); if (ADD2) ra2[i] = *(const u32x4*)(Ab2 + aoff[i]); }
#pragma unroll
  for (int i = 0; i < BCH; ++i) rb[i] = *(const u32x4*)(Bb + boff[i]);
#pragma unroll
  for (int i = 0; i < 4; ++i) *(u32x4*)(S + sto + i * 64 * 64) = ADD2 ? add_bf16x8(ra[i], ra2[i]) : ra[i];
#pragma unroll
  for (int i = 0; i < BCH; ++i) *(u32x4*)(S + sto + (256 + i * 64) * 64) = rb[i];
  if (nk > 1) {
#pragma unroll
    for (int i = 0; i < 4; ++i) { ra[i] = *(const u32x4*)(Ab + aoff[i] + 128); if (ADD2) ra2[i] = *(const u32x4*)(Ab2 + aoff[i] + 128); }
#pragma unroll
    for (int i = 0; i < BCH; ++i) rb[i] = *(const u32x4*)(Bb + boff[i] + 128);
  }
  __syncthreads();
  for (int kt = 0; kt < nk; ++kt) {
    const u16* Sc = S + (kt & 1) * STAGE;
    {
      bf16x8 a[4], b[NJ];
#pragma unroll
      for (int m = 0; m < 4; ++m) a[m] = *(const bf16x8*)(Sc + fa + m * 16 * 64 + c0);
#pragma unroll
      for (int n = 0; n < NJ; ++n) b[n] = *(const bf16x8*)(Sc + fb + n * 16 * 64 + c0);
      __builtin_amdgcn_s_setprio(1);
#pragma unroll
      for (int m = 0; m < 4; ++m)
#pragma unroll
        for (int n = 0; n < NJ; ++n) acc[m][n] = __builtin_amdgcn_mfma_f32_16x16x32_bf16(a[m], b[n], acc[m][n], 0, 0, 0);
      __builtin_amdgcn_s_setprio(0);
    }
    __builtin_amdgcn_sched_barrier(0);
    if (kt + 1 < nk) {
      u16* Aw = S + ((kt + 1) & 1) * STAGE;
#pragma unroll
      for (int i = 0; i < 4; ++i) *(u32x4*)(Aw + sto + i * 64 * 64) = ADD2 ? add_bf16x8(ra[i], ra2[i]) : ra[i];
#pragma unroll
      for (int i = 0; i < BCH; ++i) *(u32x4*)(Aw + sto + (256 + i * 64) * 64) = rb[i];
      if (kt + 2 < nk) {
        const unsigned ko = (unsigned)(kt + 2) * 128u;
#pragma unroll
        for (int i = 0; i < 4; ++i) { ra[i] = *(const u32x4*)(Ab + aoff[i] + ko); if (ADD2) ra2[i] = *(const u32x4*)(Ab2 + aoff[i] + ko); }
#pragma unroll
        for (int i = 0; i < BCH; ++i) rb[i] = *(const u32x4*)(Bb + boff[i] + ko);
      }
    }
    __builtin_amdgcn_sched_barrier(0);
    {
      bf16x8 a[4], b[NJ];
#pragma unroll
      for (int m = 0; m < 4; ++m) a[m] = *(const bf16x8*)(Sc + fa + m * 16 * 64 + c1);
#pragma unroll
      for (int n = 0; n < NJ; ++n) b[n] = *(const bf16x8*)(Sc + fb + n * 16 * 64 + c1);
      __builtin_amdgcn_s_setprio(1);
#pragma unroll
      for (int m = 0; m < 4; ++m)
#pragma unroll
        for (int n = 0; n < NJ; ++n) acc[m][n] = __builtin_amdgcn_mfma_f32_16x16x32_bf16(a[m], b[n], acc[m][n], 0, 0, 0);
      __builtin_amdgcn_s_setprio(0);
    }
    __syncthreads();
  }
}

DEV f32x4 thin16(const u16* __restrict__ A, int lda, int row0, const u16* __restrict__ BT, int ldb, int col0, int K, int lane) {
  const u16* ap = A + (size_t)(row0 + (lane & 15)) * lda + 8 * (lane >> 4);
  const u16* bp = BT + (size_t)(col0 + (lane & 15)) * ldb + 8 * (lane >> 4);
  f32x4 acc = {0.f, 0.f, 0.f, 0.f};
  for (int k0 = 0; k0 < K; k0 += 128) {
    bf16x8 a[4], b[4];
#pragma unroll
    for (int j = 0; j < 4; ++j) { a[j] = *(const bf16x8*)(ap + k0 + j * 32); b[j] = *(const bf16x8*)(bp + k0 + j * 32); }
#pragma unroll
    for (int j = 0; j < 4; ++j) acc = __builtin_amdgcn_mfma_f32_16x16x32_bf16(a[j], b[j], acc, 0, 0, 0);
  }
  return acc;
}

DEV int tile_index(int k) { const int G = gridDim.x, rb = get_rbid(); return k * G + (rb & 7) * (G >> 3) + (rb >> 3); }
DEV void tile_decode(int T, int MT, int NT, int& mt, int& nt) {
  const int per = MT * 8;
  const int nb = T / per, rem = T - nb * per;
  int width = NT - nb * 8; width = width > 8 ? 8 : width;
  mt = rem / width; nt = nb * 8 + (rem - mt * width);
}

#define ZERO_ACC(acc, NJ_) _Pragma("unroll") for (int m_ = 0; m_ < 4; ++m_) _Pragma("unroll") for (int n_ = 0; n_ < NJ_; ++n_) { acc[m_][n_][0] = 0.f; acc[m_][n_][1] = 0.f; acc[m_][n_][2] = 0.f; acc[m_][n_][3] = 0.f; }

constexpr int EPI_WAVE_BYTES = 17408;
#define EPI_FENCE() asm volatile("s_waitcnt lgkmcnt(0)" ::: "memory")
DEV void epi_store_bf16_128(const u16* reg, u16* __restrict__ dst, int ld, int trow, int col0, int lane) {
#pragma unroll
  for (int j = 0; j < 16; ++j) {
    const int row = (lane >> 4) + 4 * j, t = trow + row;
    const u32x4 v = *(const u32x4*)(reg + row * 136 + (lane & 15) * 8);
    if (t < L) *(u32x4*)(dst + (size_t)t * ld + col0 + (lane & 15) * 8) = v;
  }
}

DEV void phase_inproj8(const Params& p, int b, char* smem) {
  const u16* U = (const u16*)((char*)p.out + OUT_HALF);
  const u16* WT = (const u16*)(p.ws + OFF_S1);
  const int MT = 33, NT = 53;
  for (int kk = 0;; ++kk) {
    const int it = tile_index(kk);
    if (it >= MT * NT) break;
    int mt, nt; tile_decode(it, MT, NT, mt, nt);
    f32x4 acc[4][8];
    ZERO_ACC(acc, 8)
    gemm_tile8<8>(acc, U, 1024, mt * 256, L - 1, WT, 1024, nt * 256, 1024, smem);
    const int tid = get_tid8(), lane = tid & 63, w = tid >> 6, wm = w >> 1, wn = w & 1, r = lane & 31, h = lane >> 5;
    u16* reg = (u16*)(smem + w * EPI_WAVE_BYTES);
    const int n0 = nt * 256;
    const int trow = mt * 256 + wm * 64;
    if (nt >= 20 && nt < 28) {
      const bool isk = nt >= 24;
      const int cq = n0 - (isk ? 6144 : 5120);
      const float sc = isk ? 0.0625f : 1.f;
      u16* dst = (u16*)(p.ws + (isk ? OFF_K : OFF_Q));
#pragma unroll
      for (int pr = 0; pr < 4; ++pr) {
        const int n1 = 4 * (pr >> 1) + (pr & 1);
        const int jf = (wn * 2 + (pr >> 1)) * 32 + (pr & 1) * 16 + (lane & 15);
        const float invf_rev = exp2f(-(float)jf * 0.10462765653f) * 0.15915494309189535f;
#pragma unroll
        for (int m = 0; m < 4; ++m)
#pragma unroll
          for (int j = 0; j < 4; ++j) {
            const int row = m * 16 + (lane >> 4) * 4 + j;
            const float tf = (float)(trow + row);
            const float ph = tf * invf_rev, pl = fmaf(tf, invf_rev, -ph);
            const float fr = (ph - floorf(ph)) + pl;
            const float sn = __builtin_amdgcn_sinf(fr), cs = __builtin_amdgcn_cosf(fr);
            const float x1 = acc[m][n1][j], x2 = acc[m][n1 + 2][j];
            reg[row * 136 + n1 * 16 + (lane & 15)] = f2bf((x1 * cs - x2 * sn) * sc);
            reg[row * 136 + n1 * 16 + 32 + (lane & 15)] = f2bf((x2 * cs + x1 * sn) * sc);
          }
      }
      EPI_FENCE();
      epi_store_bf16_128(reg, dst, 1024, trow, cq + wn * 128, lane);
    } else if (nt == 52) {
      float* DT = (float*)(p.ws + OFF_DT);
      if (wn == 0) {
#pragma unroll
        for (int n = 0; n < 2; ++n) {
          const int col = n * 16 + (lane & 15);
          const float bias = p.in[6][col];
#pragma unroll
          for (int m = 0; m < 4; ++m)
#pragma unroll
            for (int j = 0; j < 4; ++j) {
              const int t = trow + m * 16 + (lane >> 4) * 4 + j;
              if (t < L) {
                const float x = acc[m][n][j] + bias;
                const float e = __expf(x);
                DT[(size_t)t * 32 + col] = (x > 20.f) ? x : (e < 0.01f ? e * (1.f - 0.5f * e + e * e * (1.f / 3.f)) : __logf(1.f + e));
              }
            }
        }
      }
    } else {
      u16* dst; int ld, c0; bool sig = false;
      if (nt < 8) { dst = (u16*)(p.ws + OFF_Z); ld = 2048; c0 = n0; }
      else if (nt < 20) { dst = (u16*)(p.ws + OFF_XBC); ld = 3072; c0 = n0 - 2048; }
      else if (nt < 36) { dst = (u16*)(p.ws + OFF_V); ld = 2048; c0 = n0 - 7168; }
      else if (nt < 44) { dst = (u16*)(p.ws + OFF_G); ld = 2048; c0 = n0 - 9216; }
      else if (nt < 48) { dst = (u16*)(p.ws + OFF_GS); ld = 1024; c0 = n0 - 11264; sig = true; }
      else { dst = (u16*)(p.ws + OFF_GR); ld = 1024; c0 = n0 - 12288; sig = true; }
#pragma unroll
      for (int m = 0; m < 4; ++m)
#pragma unroll
        for (int n = 0; n < 8; ++n)
#pragma unroll
          for (int j = 0; j < 4; ++j) {
            float v = acc[m][n][j];
            if (sig) v = sigmoid_f(v);
            reg[(m * 16 + (lane >> 4) * 4 + j) * 136 + n * 16 + (lane & 15)] = f2bf(v);
          }
      EPI_FENCE();
      epi_store_bf16_128(reg, dst, ld, trow, c0 + wn * 128, lane);
    }
    __syncthreads();
  }
}

DEV void phase_merge8(const Params& p, char* smem, char* smem_team) {
  u16* GS = (u16*)(p.ws + OFF_GS);
  u16* GR = (u16*)(p.ws + OFF_GR);
  const u16* Zb = (const u16*)(p.ws + OFF_Z);
  const u16* Gb = (const u16*)(p.ws + OFF_G);
  const u16* WBS = (const u16*)(p.ws + OFF_S2);
  const u16* WBR = (const u16*)(p.ws + OFF_S2 + 4194304);
  for (int kk = 0;; ++kk) {
    const int it = tile_index(kk);
    if (it >= 256) break;
    const int branch = it >> 7, tl = it & 127, mt = tl >> 2, nt = tl & 3;
    f32x4 acc[4][8];
    ZERO_ACC(acc, 8)
    gemm_tile8<8>(acc, branch ? Gb : Zb, 2048, mt * 256, L - 1, branch ? WBR : WBS, 2048, nt * 256, 2048, smem);
    const int tid = get_tid8(), lane = tid & 63, w = tid >> 6, wm = w >> 1, wn = w & 1;
    float* reg = (float*)(smem + w * EPI_WAVE_BYTES);
    u16* GT = branch ? GR : GS;
#pragma unroll
    for (int hf = 0; hf < 2; ++hf) {
#pragma unroll
      for (int m = 0; m < 4; ++m)
#pragma unroll
        for (int n = 0; n < 4; ++n)
#pragma unroll
          for (int j = 0; j < 4; ++j) reg[(m * 16 + (lane >> 4) * 4 + j) * 68 + n * 16 + (lane & 15)] = acc[m][hf * 4 + n][j];
      EPI_FENCE();
#pragma unroll
      for (int j = 0; j < 16; ++j) {
        const int row = (lane >> 4) + 4 * j, c4 = (lane & 15) * 4;
        const f32x4 a = *(const f32x4*)(reg + row * 68 + c4);
        const size_t idx = (size_t)(mt * 256 + wm * 64 + row) * 1024 + nt * 256 + wn * 128 + hf * 64 + c4;
        const u32x2 g = *(const u32x2*)(GT + idx);
        u32x2 o; o[0] = pack2(lo_f(g[0]) * a[0], hi_f(g[0]) * a[1]); o[1] = pack2(lo_f(g[1]) * a[2], hi_f(g[1]) * a[3]);
        *(u32x2*)(GT + idx) = o;
      }
      EPI_FENCE();
    }
    __syncthreads();
  }
  for (int ct = get_rbid(); ct < 128; ct += gridDim.x) {
    const int tid = get_tid8(), lane = tid & 63, w = tid >> 6;
    const int branch = ct >> 6, c16 = ct & 63;
    f32x4* red = (f32x4*)smem;
    red[w * 64 + lane] = thin16((branch ? Gb : Zb) + w * 256, 2048, 8192, (branch ? WBR : WBS) + w * 256, 2048, c16 * 16, 256, lane);
    __syncthreads();
    if (w == 0) {
      u16* GT = branch ? GR : GS;
      f32x4 a1 = red[lane];
#pragma unroll
      for (int q = 1; q < 8; ++q) a1 += red[q * 64 + lane];
#pragma unroll
      for (int j = 0; j < 4; ++j) {
        const size_t idx = (size_t)(8192 + (lane >> 4) * 4 + j) * 1024 + c16 * 16 + (lane & 15);
        GT[idx] = f2bf(bf2f(GT[idx]) * a1[j]);
      }
    }
    __syncthreads();
  }
  const int n_wout = 16 * 16, n_wup = 16 * 88, n_wdown = 44 * 16;
  for (int it = get_bid(); it < n_wout + n_wup + n_wdown; it += nworkers()) {
    if (it < n_wout) { convert_tile(p.in[12], 1024, 1024, (u16*)(p.ws + OFF_WOUT), it & 15, it >> 4, 0, smem_team); }
    else if (it < n_wout + n_wup) { const int j = it - n_wout; convert_tile(p.in[14], 5632, 1024, (u16*)(p.ws + OFF_WUP), j & 15, j >> 4, 2, smem_team); }
    else { const int j = it - n_wout - n_wup; convert_tile(p.in[17], 1024, 2816, (u16*)(p.ws + OFF_WDOWN), j % 44, j / 44, 0, smem_team); }
  }
}

DEV void phase_outproj8(const Params& p, int b, char* smem) {
  const int tid = get_tid8(), lane = tid & 63, w = tid >> 6, wm = w >> 1, wn = w & 1, r = lane & 31, h = lane >> 5;
  float* HM = (float*)(p.ws + OFF_HM);
  const u16* Mg = (const u16*)(p.ws + OFF_GS);
  const u16* WO = (const u16*)(p.ws + OFF_WOUT);
  float* reg = (float*)(smem + w * EPI_WAVE_BYTES);
  for (int kk = 0;; ++kk) {
    const int it = tile_index(kk);
    if (it >= 256) break;
    const int mt = it >> 3, nt = it & 7;
    f32x4 acc[4][4];
    ZERO_ACC(acc, 4)
    gemm_tile8<4, true>(acc, Mg, 1024, mt * 256, L - 1, WO, 1024, nt * 128, 1024, smem, (const u16*)(p.ws + OFF_GR));
#pragma unroll
    for (int m = 0; m < 4; ++m)
#pragma unroll
      for (int n = 0; n < 4; ++n)
#pragma unroll
        for (int j = 0; j < 4; ++j) reg[(m * 16 + (lane >> 4) * 4 + j) * 68 + n * 16 + (lane & 15)] = acc[m][n][j];
    EPI_FENCE();
#pragma unroll
    for (int j = 0; j < 16; ++j) {
      const int row = (lane >> 4) + 4 * j, c4 = (lane & 15) * 4;
      const f32x4 a = *(const f32x4*)(reg + row * 68 + c4);
      const int t = mt * 256 + wm * 64 + row, col = nt * 128 + wn * 64 + c4;
      if (t < NMETA) {
        const f32x4 x = *(const f32x4*)(p.in[1] + t * 1024 + col);
        *(f32x4*)(HM + t * 1024 + col) = x + a;
      } else {
        const size_t idx = ((size_t)b * SEQ + (t - NMETA)) * 1024 + col;
        const f32x4 x = *(const f32x4*)(p.in[0] + idx);
        *(f32x4*)(p.out + idx) = x + a;
      }
    }
    __syncthreads();
  }
  for (int ct = get_rbid(); ct < 64; ct += gridDim.x) {
    const int tid = get_tid8(), lane = tid & 63, w = tid >> 6;
    f32x4* red = (f32x4*)smem;
    red[w * 64 + lane] = thin16(Mg + w * 128, 1024, 8192, WO + w * 128, 1024, ct * 16, 128, lane)
                       + thin16((const u16*)(p.ws + OFF_GR) + w * 128, 1024, 8192, WO + w * 128, 1024, ct * 16, 128, lane);
    __syncthreads();
    if (w == 0) {
      f32x4 a1 = red[lane];
#pragma unroll
      for (int q = 1; q < 8; ++q) a1 += red[q * 64 + lane];
#pragma unroll
      for (int j = 0; j < 4; ++j) {
        const int t = 8192 + (lane >> 4) * 4 + j;
        const size_t idx = ((size_t)b * SEQ + (t - NMETA)) * 1024 + ct * 16 + (lane & 15);
        p.out[idx] = p.in[0][idx] + a1[j];
      }
    }
    __syncthreads();
  }
}

DEV void phase_up8(const Params& p, char* smem) {
  u16* ACT = (u16*)(p.ws + OFF_ACT);
  const float* cw = p.in[15];
  const float* cbias = p.in[16];
  for (int kk = 0;; ++kk) {
    const int it = tile_index(kk);
    if (it >= 33 * 22) break;
    int mt, nt; tile_decode(it, 33, 22, mt, nt);
    f32x4 acc[4][8];
    ZERO_ACC(acc, 8)
    gemm_tile8<8>(acc, (const u16*)(p.ws + OFF_U2), 1024, mt * 254 - 2, L - 1, (const u16*)(p.ws + OFF_WUP), 1024, nt * 256, 1024, smem);
    const int tid = get_tid8(), lane = tid & 63, w = tid >> 6;
    u16* reg = (u16*)(smem + w * EPI_WAVE_BYTES);
#pragma unroll
    for (int m = 0; m < 4; ++m)
#pragma unroll
      for (int n = 0; n < 8; ++n)
#pragma unroll
        for (int j = 0; j < 4; ++j) reg[(m * 16 + (lane >> 4) * 4 + j) * 136 + n * 16 + (lane & 15)] = f2bf(acc[m][n][j]);
    __syncthreads();
    {
      const int cg = tid & 15, rg = tid >> 4;
      const int ch = nt * 128 + cg * 8;
      float wg[3][8], wv[3][8], bg[8], bv[8], g2[8], g1[8], v2[8], v1[8];
#pragma unroll
      for (int k = 0; k < 3; ++k) {
        const f32x4 a0 = *(const f32x4*)(cw + k * 5632 + ch), a1 = *(const f32x4*)(cw + k * 5632 + ch + 4);
        const f32x4 c0 = *(const f32x4*)(cw + k * 5632 + 2816 + ch), c1 = *(const f32x4*)(cw + k * 5632 + 2816 + ch + 4);
#pragma unroll
        for (int j = 0; j < 4; ++j) { wg[k][j] = a0[j]; wg[k][4 + j] = a1[j]; wv[k][j] = c0[j]; wv[k][4 + j] = c1[j]; }
      }
      {
        const f32x4 a0 = *(const f32x4*)(cbias + ch), a1 = *(const f32x4*)(cbias + ch + 4);
        const f32x4 c0 = *(const f32x4*)(cbias + 2816 + ch), c1 = *(const f32x4*)(cbias + 2816 + ch + 4);
#pragma unroll
        for (int j = 0; j < 4; ++j) { bg[j] = a0[j]; bg[4 + j] = a1[j]; bv[j] = c0[j]; bv[4 + j] = c1[j]; }
      }
      const int R0 = rg * 8;
#pragma unroll
      for (int q = 0; q < 2; ++q) {
        const int R = R0 - 2 + q;
        u32x4 gvv = {0u, 0u, 0u, 0u}, vvv = {0u, 0u, 0u, 0u};
        if (R >= 0 && mt * 254 - 2 + R >= 0) {
          const char* sl = smem + ((R >> 6) * 2) * EPI_WAVE_BYTES + ((R & 63) * 136 + cg * 8) * 2;
          gvv = *(const u32x4*)sl; vvv = *(const u32x4*)(sl + EPI_WAVE_BYTES);
        }
#pragma unroll
        for (int j = 0; j < 4; ++j) {
          if (q == 0) { g2[2 * j] = lo_f(gvv[j]); g2[2 * j + 1] = hi_f(gvv[j]); v2[2 * j] = lo_f(vvv[j]); v2[2 * j + 1] = hi_f(vvv[j]); }
          else { g1[2 * j] = lo_f(gvv[j]); g1[2 * j + 1] = hi_f(gvv[j]); v1[2 * j] = lo_f(vvv[j]); v1[2 * j + 1] = hi_f(vvv[j]); }
        }
      }
#pragma unroll 2
      for (int i = 0; i < 8; ++i) {
        const int R = R0 + i, t = mt * 254 - 2 + R;
        u32x4 gvv = {0u, 0u, 0u, 0u}, vvv = {0u, 0u, 0u, 0u};
        if (t >= 0) {
          const char* sl = smem + ((R >> 6) * 2) * EPI_WAVE_BYTES + ((R & 63) * 136 + cg * 8) * 2;
          gvv = *(const u32x4*)sl; vvv = *(const u32x4*)(sl + EPI_WAVE_BYTES);
        }
        float o[8];
#pragma unroll
        for (int j = 0; j < 8; ++j) {
          const float gx = (j & 1) ? hi_f(gvv[j >> 1]) : lo_f(gvv[j >> 1]);
          const float vx = (j & 1) ? hi_f(vvv[j >> 1]) : lo_f(vvv[j >> 1]);
          const float ag = bg[j] + wg[0][j] * g2[j] + wg[1][j] * g1[j] + wg[2][j] * gx;
          const float av = bv[j] + wv[0][j] * v2[j] + wv[1][j] * v1[j] + wv[2][j] * vx;
          o[j] = silu_f(ag) * av;
          g2[j] = g1[j]; g1[j] = gx; v2[j] = v1[j]; v1[j] = vx;
        }
        if (R >= 2 && t < L) {
          u32x4 pk; pk[0] = pack2(o[0], o[1]); pk[1] = pack2(o[2], o[3]); pk[2] = pack2(o[4], o[5]); pk[3] = pack2(o[6], o[7]);
          *(u32x4*)(ACT + (size_t)t * 2816 + ch) = pk;
        }
      }
    }
    __syncthreads();
  }
}

DEV void phase_down8(const Params& p, int b, char* smem) {
  for (int kk = 0;; ++kk) {
    const int it = tile_index(kk);
    if (it >= 256) break;
    const int mt = it >> 3, nt = it & 7;
    f32x4 acc[4][4];
    ZERO_ACC(acc, 4)
    gemm_tile8<4>(acc, (const u16*)(p.ws + OFF_ACT), 2816, NMETA + mt * 256, L - 1, (const u16*)(p.ws + OFF_WDOWN), 2816, nt * 128, 2816, smem);
    const int tid = get_tid8(), lane = tid & 63, w = tid >> 6, wm = w >> 1, wn = w & 1, r = lane & 31, h = lane >> 5;
    float* reg = (float*)(smem + w * EPI_WAVE_BYTES);
#pragma unroll
    for (int m = 0; m < 4; ++m)
#pragma unroll
      for (int n = 0; n < 4; ++n)
#pragma unroll
        for (int j = 0; j < 4; ++j) reg[(m * 16 + (lane >> 4) * 4 + j) * 68 + n * 16 + (lane & 15)] = acc[m][n][j];
    EPI_FENCE();
#pragma unroll
    for (int j = 0; j < 16; ++j) {
      const int row = (lane >> 4) + 4 * j, c4 = (lane & 15) * 4;
      const f32x4 a = *(const f32x4*)(reg + row * 68 + c4);
      const size_t idx = ((size_t)b * SEQ + mt * 256 + wm * 64 + row) * 1024 + nt * 128 + wn * 64 + c4;
      const f32x4 x = *(const f32x4*)(p.out + idx);
      *(f32x4*)(p.out + idx) = x + a;
    }
    __syncthreads();
  }
}

#define XB_TMO      128
#define XB_XCNT(j)  (256  + 64 * (j))
#define XB_XSUB(j)  (1280 + 64 * (j))
#define XB_XGEN(j)  (2304 + 64 * (j))
#define XB_TOP      3328
#define XB_TOPGEN   3392
#define XCD_BAR_WORDS 3456
#define XB_SPIN_CAP (1u << 24)
DEV unsigned xb_ld(unsigned* p)              { return __hip_atomic_load(p, __ATOMIC_RELAXED, __HIP_MEMORY_SCOPE_AGENT); }
DEV unsigned xb_add(unsigned* p, unsigned v) { return __hip_atomic_fetch_add(p, v, __ATOMIC_RELAXED, __HIP_MEMORY_SCOPE_AGENT); }
DEV unsigned xb_xcc_id() { return (unsigned)__builtin_amdgcn_s_getreg((3 << 11) | 20) & 0xFu; }
#define XB_SPIN(cond, bar) do { unsigned _sp = 0; while (cond) { __builtin_amdgcn_s_sleep(1); \
    if ((++_sp & 255u) == 0u) { if (xb_ld(&(bar)[XB_TMO])) break; if (_sp > XB_SPIN_CAP) { atomicAdd(&(bar)[XB_TMO], 1u); break; } } } } while (0)
struct XcdBarrier { unsigned* bar; unsigned x; volatile LDSP unsigned* st; };
DEV XcdBarrier xcd_barrier_post(unsigned* bar, volatile LDSP unsigned* st) {
  XcdBarrier b; b.bar = bar; b.x = xb_xcc_id(); b.st = st;
  if (threadIdx.x == 0) (void)xb_add(&bar[XB_XCNT(b.x)], 1u);
  return b;
}
DEV void xcd_barrier_complete(unsigned* bar, unsigned x, unsigned& nloc, unsigned& nx) {
  const unsigned G = gridDim.x * gridDim.y * gridDim.z;
  unsigned sum, cnt, mine, sp = 0u;
  for (;;) {
    sum = 0u; cnt = 0u; mine = 0u;
#pragma unroll
    for (unsigned j = 0; j < 16; ++j) { const unsigned c = xb_ld(&bar[XB_XCNT(j)]); sum += c; cnt += (c > 0u) ? 1u : 0u; mine = (j == x) ? c : mine; }
    if (sum == G) break;
    __builtin_amdgcn_s_sleep(1);
    if ((++sp & 255u) == 0u) { if (xb_ld(&bar[XB_TMO])) break; if (sp > XB_SPIN_CAP) { atomicAdd(&bar[XB_TMO], 1u); break; } }
  }
  nloc = mine > 0u ? mine : 1u; nx = cnt > 0u ? cnt : 1u;
}
DEV void xcd_barrier(const XcdBarrier& b) {
  asm volatile("s_waitcnt vmcnt(0)" ::: "memory");
  __syncthreads();
  if (threadIdx.x == 0) {
    unsigned* bar = b.bar;
    __builtin_amdgcn_s_waitcnt(0);
    unsigned nloc = b.st[0], nx = b.st[1];
    if (nloc == 0u) { xcd_barrier_complete(bar, b.x, nloc, nx); b.st[0] = nloc; b.st[1] = nx; }
    const unsigned old = xb_add(&bar[XB_XSUB(b.x)], 1u);
    const unsigned gen = old / nloc;
    if (old + 1u == (gen + 1u) * nloc) {
      __builtin_amdgcn_fence(__ATOMIC_RELEASE, "agent");
      asm volatile("s_waitcnt vmcnt(0)" ::: "memory");
      const unsigned og = xb_add(&bar[XB_TOP], 1u);
      const unsigned tg = og / nx;
      if (og + 1u == (tg + 1u) * nx) xb_add(&bar[XB_TOPGEN], 1u);
      else XB_SPIN(xb_ld(&bar[XB_TOPGEN]) == tg, bar);
      __builtin_amdgcn_fence(__ATOMIC_ACQUIRE, "agent");
      xb_add(&bar[XB_XGEN(b.x)], 1u);
      asm volatile("s_waitcnt vmcnt(0)" ::: "memory");
    } else {
      XB_SPIN(xb_ld(&bar[XB_XGEN(b.x)]) == gen, bar);
      __builtin_amdgcn_fence(__ATOMIC_ACQUIRE, "agent");
      asm volatile("s_waitcnt vmcnt(0)" ::: "memory");
    }
  }
  __syncthreads();
}

constexpr int N_PHASES = 21;

__global__ void __launch_bounds__(512) fwd_kernel(Params p, int ph0, int ph1) {
  __shared__ __attribute__((aligned(16))) char smem[SMEM_BYTES];
  __shared__ uint4 xb_words;
  if (threadIdx.x == 0) xb_words = make_uint4(0u, 0u, 0u, 0u);
  __syncthreads();
  XcdBarrier xb = xcd_barrier_post((unsigned*)(p.ws + OFF_BAR), (volatile LDSP unsigned*)&xb_words);
  if (ph1 < 0) cg::this_grid().sync();
  for (int ph = ph0; ph < ph1; ++ph) {
    char* tsm = smem + (get_tid8() >> 8) * SMEM_TEAM;
    const int b = ph >= 11 ? 1 : 0;
    const int lp = (ph == 0) ? 0 : (ph == 20 ? 10 : (ph >= 11 ? ph - 10 : ph));
    switch (lp) {
      case 0: phase_prep(p, 0, true, tsm); break;
      case 1: phase_inproj8(p, b, smem); break;
      case 2: {
        int it = get_bid();
        for (; it < 1024; it += nworkers()) ret_kv_item(p, it, tsm);
        for (; it < 2048; it += nworkers()) ssd_state_item(p, it - 1024, tsm);
      } break;
      case 3: phase_scan(p); break;
      case 4: {
        {
          const int rb = get_rbid(), team = get_tid8() >> 8;
          for (int j = 0; j < 3; ++j) {
            int kind = -1, idx = 0;
            if (rb < 4) {
              const int q = rb * 3 + j;
              const int rt = (q < 2) ? 128 : ((q >> 1) - 1) * 4;
              kind = 0; idx = rt * 4 + (q & 1) * 2 + team;
            } else if (rb < 10) {
              if (j < 2) { kind = 1; idx = (246 + (rb - 4) * 2 + j) * 2 + team; }
            } else if (j < 2) {
              const int k = rb - 10, ri = k >> 1;
              const int rt = (ri < 12) ? ((ri / 3) * 4 + 1 + ri % 3) : (17 + ri - 12);
              kind = j; idx = (j == 0) ? (rt * 4 + (k & 1) * 2 + team) : (k * 2 + team);
            }
            if (kind == 0) ret_out_item(p, idx, tsm);
            else if (kind == 1) ssd_out_item(p, idx, tsm);
          }
        }
      } break;
      case 5: phase_merge8(p, smem, tsm); break;
      case 6: phase_outproj8(p, b, smem); break;
      case 7: phase_norm2(p, b); break;
      case 8: phase_up8(p, smem); break;
      case 9: phase_down8(p, b, smem); break;
      case 10: {
        if (ph == 10) { phase_final_norm(p, 0); phase_prep(p, 1, false, tsm); }
        else phase_final_norm(p, 1);
      } break;
    }
    if (ph + 1 < ph1) xcd_barrier(xb);
  }
}

#ifndef MK_SINGLE
#define MK_SINGLE 1
#endif

extern "C" void kernel_launch(void* const* d_in, const int* in_sizes, int n_in, void* d_out, int out_size, void* d_ws, size_t ws_size,
                              hipStream_t stream) {
  static int grid_blocks = 0;
  if (!grid_blocks) {
    int dev = 0, cus = 0, per_cu = 0;
    hipGetDevice(&dev);
    hipDeviceGetAttribute(&cus, hipDeviceAttributeMultiprocessorCount, dev);
    hipOccupancyMaxActiveBlocksPerMultiprocessor(&per_cu, fwd_kernel, 512, 0);
    per_cu = 1;
    if (cus != 256) fprintf(stderr, "kernel_launch: built for a 256-CU device (static phase schedules assume 256 workgroups), found %d CUs\n", cus);
    cus = 256;
    grid_blocks = cus * per_cu;
  }
  Params p{};
  for (int i = 0; i < 19; ++i) p.in[i] = (const float*)d_in[i];
  p.out = (float*)d_out;
  p.ws = (char*)d_ws;
#if MK_SINGLE
  (void)hipMemsetAsync((char*)d_ws + OFF_BAR, 0, XCD_BAR_WORDS * 4, stream);
  int ph0 = 0, ph1 = N_PHASES;
  void* args[] = {&p, &ph0, &ph1};
  hipError_t e = hipLaunchCooperativeKernel((void*)fwd_kernel, dim3(grid_blocks), dim3(512), args, 0, stream);
  if (e != hipSuccess) fprintf(stderr, "cooperative launch failed: %s (grid %d)\n", hipGetErrorString(e), grid_blocks);
#else
  for (int ph = 0; ph < N_PHASES; ++ph) {
    hipLaunchKernelGGL(fwd_kernel, dim3(grid_blocks), dim3(512), 0, stream, p, ph, ph + 1);
  }
#endif
}
```

```cpp
#include <hip/hip_runtime.h>
#include <hip/hip_cooperative_groups.h>
#include <cstdio>
namespace cg = cooperative_groups;

typedef unsigned short u16;
typedef __bf16 bf16x8 __attribute__((ext_vector_type(8)));
typedef short s16x4 __attribute__((ext_vector_type(4)));
typedef short s16x8 __attribute__((ext_vector_type(8)));
typedef float f32x16 __attribute__((ext_vector_type(16)));
typedef unsigned int u32x4 __attribute__((ext_vector_type(4)));
typedef unsigned int u32x2 __attribute__((ext_vector_type(2)));
typedef float f32x4 __attribute__((ext_vector_type(4)));

#define DEV __device__ __forceinline__
#define LDSP __attribute__((address_space(3)))

constexpr int D = 1024;
constexpr int L = 8208;
constexpr int SEQ = 8192;
constexpr int NMETA = 16;
constexpr int NPROJ = 13344;
constexpr int NPROJ_PAD = 13568;
constexpr int DFF = 2816;
constexpr float EPS = 1e-6f;

constexpr size_t OFF_Z = 0;
constexpr size_t OFF_G = 33619968;
constexpr size_t OFF_GS = 67239936;
constexpr size_t OFF_GR = 84049920;
constexpr size_t OFF_Q = 100859904;
constexpr size_t OFF_XBC = 117669888;
constexpr size_t OFF_K = 168099840;
constexpr size_t OFF_V = 184909824;
constexpr size_t OFF_DT = 218529792;
constexpr size_t OFF_S2 = 219580416;
constexpr size_t OFF_S1 = 227969024;
constexpr size_t OFF_CD = 261523456;
constexpr size_t OFF_HM = 261531648;
constexpr size_t OFF_BAR = 261597184;
constexpr size_t OFF_RSS = 261611520;
constexpr size_t OFF_WOUT = OFF_S1;
constexpr size_t OFF_WUP = OFF_S1 + 2097152;
constexpr size_t OFF_WDOWN = OFF_S1 + 13631488;
constexpr size_t OFF_UP = OFF_XBC;
constexpr size_t OFF_ACT = OFF_Z;
constexpr size_t OFF_U2 = OFF_Q;
constexpr size_t OUT_HALF = 33554432;

constexpr int SMEM_TEAM = 73728;
constexpr int SMEM_BYTES = 2 * SMEM_TEAM;

struct Params {
  const float* in[19];
  float* out;
  char* ws;
};

DEV int get_tid8() { int t = threadIdx.x; asm volatile("" : "+v"(t)); return t; }
DEV int get_tid() { int t = threadIdx.x & 255; asm volatile("" : "+v"(t)); return t; }
DEV int get_rbid() { int t = blockIdx.x; asm volatile("" : "+s"(t)); return t; }
DEV int get_bid() { int t = get_rbid() * 2 + (get_tid8() >> 8); return __builtin_amdgcn_readfirstlane(t); }
DEV int nworkers() { return (int)gridDim.x * 2; }
DEV float bf2f(u16 h) { return __uint_as_float(((unsigned)h) << 16); }
DEV u16 f2bf(float f) { unsigned u = __float_as_uint(f); u += 0x7fffu + ((u >> 16) & 1u); return (u16)(u >> 16); }
DEV unsigned pack2(float a, float b) { return (unsigned)f2bf(a) | ((unsigned)f2bf(b) << 16); }
DEV float silu_f(float x) { return x / (1.f + __expf(-x)); }
DEV float sigmoid_f(float x) { return 1.f / (1.f + __expf(-x)); }
DEV float lo_f(unsigned u) { return __uint_as_float(u << 16); }
DEV float hi_f(unsigned u) { return __uint_as_float(u & 0xffff0000u); }
DEV float wave_sum(float v) {
#pragma unroll
  for (int o = 32; o > 0; o >>= 1) v += __shfl_xor(v, o);
  return v;
}
DEV float half_sum(float v) {
#pragma unroll
  for (int o = 16; o > 0; o >>= 1) v += __shfl_xor(v, o);
  return v;
}
DEV float log_gamma(int h) {
  return h == 0 ? -0.0317486983145803f : (h == 1 ? -0.015748356968139168f : (h == 2 ? -0.007843177461025893f : -0.003913899321136329f));
}
DEV f32x16 mfma(bf16x8 a, bf16x8 b, f32x16 c) { return __builtin_amdgcn_mfma_f32_32x32x16_bf16(a, b, c, 0, 0, 0); }
DEV f32x16 zero16() { f32x16 z;
#pragma unroll
  for (int i = 0; i < 16; ++i) z[i] = 0.f;
  return z; }
DEV int acc_row(int i, int h) { return (i & 3) + 8 * (i >> 2) + 4 * h; }

DEV bf16x8 frag_tr(const u16* T, int ld, int k0, int x0, int lane) {
  const int h = lane >> 5, blk = (lane >> 4) & 1, q = (lane & 15) >> 2, pp = lane & 3;
  const u16* a0 = T + (k0 + 8 * h + q) * ld + x0 + 16 * blk + 4 * pp;
  s16x4 lo = __builtin_amdgcn_ds_read_tr16_b64_v4i16((LDSP s16x4*)a0);
  s16x4 hi = __builtin_amdgcn_ds_read_tr16_b64_v4i16((LDSP s16x4*)(a0 + 4 * ld));
  s16x8 v = {lo[0], lo[1], lo[2], lo[3], hi[0], hi[1], hi[2], hi[3]};
  return __builtin_bit_cast(bf16x8, v);
}
DEV bf16x8 frag_row(const u16* T, int ld, int row, int k) {
  return *(const bf16x8*)(T + row * ld + k);
}

template <int MI>
DEV void gemm_tile(f32x16 (&acc)[MI][2], const u16* __restrict__ A, int lda, int arow0, int arow_max,
                   const u16* __restrict__ B, int ldb, int brow0, int K, char* smem) {
  constexpr int BM = MI * 64;
  constexpr int LD = 72;
  constexpr int ACH = BM * 8 / 256;
  u16* As = (u16*)smem;
  u16* Bs = As + BM * LD;
  const int tid = get_tid(), lane = tid & 63, w = tid >> 6, wm = w >> 1, wn = w & 1, r = lane & 31, h = lane >> 5;
  u32x4 ra[ACH], rb[4];
  const u16* ap[ACH];
  const u16* bp[4];
#pragma unroll
  for (int i = 0; i < ACH; ++i) {
    int c = tid + i * 256, row = c >> 3, kc = c & 7;
    int gr = arow0 + row; gr = gr > arow_max ? arow_max : gr;
    ap[i] = A + (size_t)gr * lda + kc * 8;
  }
#pragma unroll
  for (int i = 0; i < 4; ++i) {
    int c = tid + i * 256, row = c >> 3, kc = c & 7;
    bp[i] = B + (size_t)(brow0 + row) * ldb + kc * 8;
  }
#pragma unroll
  for (int i = 0; i < ACH; ++i) ra[i] = *(const u32x4*)(ap[i]);
#pragma unroll
  for (int i = 0; i < 4; ++i) rb[i] = *(const u32x4*)(bp[i]);
  const int nk = K >> 6;
  for (int kt = 0; kt < nk; ++kt) {
#pragma unroll
    for (int i = 0; i < ACH; ++i) { int c = tid + i * 256, row = c >> 3, kc = c & 7; *(u32x4*)(As + row * LD + kc * 8) = ra[i]; }
#pragma unroll
    for (int i = 0; i < 4; ++i) { int c = tid + i * 256, row = c >> 3, kc = c & 7; *(u32x4*)(Bs + row * LD + kc * 8) = rb[i]; }
    __syncthreads();
    if (kt + 1 < nk) {
#pragma unroll
      for (int i = 0; i < ACH; ++i) ra[i] = *(const u32x4*)(ap[i] + (kt + 1) * 64);
#pragma unroll
      for (int i = 0; i < 4; ++i) rb[i] = *(const u32x4*)(bp[i] + (kt + 1) * 64);
    }
#pragma unroll
    for (int ks = 0; ks < 4; ++ks) {
      bf16x8 a[MI], b[2];
#pragma unroll
      for (int mi = 0; mi < MI; ++mi) a[mi] = frag_row(As, LD, wm * MI * 32 + mi * 32 + r, ks * 16 + h * 8);
#pragma unroll
      for (int ni = 0; ni < 2; ++ni) b[ni] = frag_row(Bs, LD, wn * 64 + ni * 32 + r, ks * 16 + h * 8);
#pragma unroll
      for (int mi = 0; mi < MI; ++mi)
#pragma unroll
        for (int ni = 0; ni < 2; ++ni) acc[mi][ni] = mfma(a[mi], b[ni], acc[mi][ni]);
    }
    __syncthreads();
  }
}

DEV int orig_col(int n) {
  if (n < 5120) return n;
  if (n < 7168) {
    int q = n - 5120; int which = q >> 10; int c = q & 1023; int head = c >> 8; int ip = c & 255; int blk = ip >> 6; int wi = ip & 63;
    int j = (wi < 32) ? (blk * 32 + wi) : (128 + blk * 32 + wi - 32);
    return 5152 + which * 1024 + head * 256 + j;
  }
  if (n < 13312) return n + 32;
  if (n < 13344) return 5120 + (n - 13312);
  return -1;
}
DEV void convert_tile(const float* __restrict__ W, int Nsrc, int K, u16* __restrict__ WT, int kt, int ntile, int mode, char* smem, const float* __restrict__ kscale = nullptr) {
  float* t = (float*)smem;
  const int tid = get_tid();
  {
    const int tx = tid & 15, ty = tid >> 4;
    const int n = ntile * 64 + tx * 4;
    int on = n;
    if (mode == 1) on = orig_col(n);
    else if (mode == 2) { const int tl = n >> 8, wi = n & 255; on = (wi < 128) ? (tl * 128 + wi) : (2816 + tl * 128 + wi - 128); }
#pragma unroll
    for (int kk = ty; kk < 64; kk += 16) {
      f32x4 v = {0.f, 0.f, 0.f, 0.f};
      if (on >= 0) v = *(const f32x4*)(W + (size_t)(kt * 64 + kk) * Nsrc + on);
      if (kscale) v = v * kscale[kt * 64 + kk];
      *(f32x4*)(t + kk * 68 + tx * 4) = v;
    }
  }
  __syncthreads();
  {
    const int nn = tid >> 2, kq = (tid & 3) * 16;
    u32x4 o[2];
#pragma unroll
    for (int j = 0; j < 8; ++j) o[j >> 2][j & 3] = pack2(t[(kq + 2 * j) * 68 + nn], t[(kq + 2 * j + 1) * 68 + nn]);
    u16* d = WT + (size_t)(ntile * 64 + nn) * K + kt * 64 + kq;
    *(u32x4*)d = o[0]; *(u32x4*)(d + 8) = o[1];
  }
  __syncthreads();
}

DEV void rmsnorm_row_bf16(const float* __restrict__ src, const float* __restrict__ w, u16* __restrict__ dst, int lane) {
  f32x4 v[4]; float ss = 0.f;
#pragma unroll
  for (int j = 0; j < 4; ++j) { v[j] = *(const f32x4*)(src + j * 256 + lane * 4); ss += v[j][0] * v[j][0] + v[j][1] * v[j][1] + v[j][2] * v[j][2] + v[j][3] * v[j][3]; }
  ss = wave_sum(ss);
  const float rstd = rsqrtf(ss * (1.f / 1024.f) + EPS);
#pragma unroll
  for (int j = 0; j < 4; ++j) {
    f32x4 ww = *(const f32x4*)(w + j * 256 + lane * 4);
    u32x2 o; o[0] = pack2(v[j][0] * rstd * ww[0], v[j][1] * rstd * ww[1]); o[1] = pack2(v[j][2] * rstd * ww[2], v[j][3] * rstd * ww[3]);
    *(u32x2*)(dst + j * 256 + lane * 4) = o;
  }
}
DEV void rmsnorm_row_f32_inplace(float* __restrict__ row, const float* __restrict__ w, int lane) {
  f32x4 v[4]; float ss = 0.f;
#pragma unroll
  for (int j = 0; j < 4; ++j) { v[j] = *(const f32x4*)(row + j * 256 + lane * 4); ss += v[j][0] * v[j][0] + v[j][1] * v[j][1] + v[j][2] * v[j][2] + v[j][3] * v[j][3]; }
  ss = wave_sum(ss);
  const float rstd = rsqrtf(ss * (1.f / 1024.f) + EPS);
#pragma unroll
  for (int j = 0; j < 4; ++j) {
    f32x4 ww = *(const f32x4*)(w + j * 256 + lane * 4);
    f32x4 o; o[0] = v[j][0] * rstd * ww[0]; o[1] = v[j][1] * rstd * ww[1]; o[2] = v[j][2] * rstd * ww[2]; o[3] = v[j][3] * rstd * ww[3];
    *(f32x4*)(row + j * 256 + lane * 4) = o;
  }
}

template <int R, int C, bool SCALE>
DEV void stage_conv(u16* dst, int ld, const u16* __restrict__ xbc, int row0, int ch0, const float* __restrict__ cw, const float* __restrict__ cb, const float* rs) {
  constexpr int CG = C / 8, RG = 256 / CG, RPT = R / RG;
  const int tid = get_tid();
  const int cgi = tid % CG, rgi = tid / CG;
  const int ch = ch0 + cgi * 8, r0 = rgi * RPT;
  float w[4][8], bias[8], xw[3][8];
#pragma unroll
  for (int k = 0; k < 4; ++k) {
    f32x4 a = *(const f32x4*)(cw + k * 3072 + ch), b = *(const f32x4*)(cw + k * 3072 + ch + 4);
#pragma unroll
    for (int j = 0; j < 4; ++j) { w[k][j] = a[j]; w[k][4 + j] = b[j]; }
  }
  {
    f32x4 a = *(const f32x4*)(cb + ch), b = *(const f32x4*)(cb + ch + 4);
#pragma unroll
    for (int j = 0; j < 4; ++j) { bias[j] = a[j]; bias[4 + j] = b[j]; }
  }
#pragma unroll
  for (int k = 0; k < 3; ++k) {
    const int tr = row0 + r0 - 3 + k;
    u32x4 v = {0u, 0u, 0u, 0u};
    if (tr >= 0 && tr < L) v = *(const u32x4*)(xbc + (size_t)tr * 3072 + ch);
#pragma unroll
    for (int j = 0; j < 4; ++j) { xw[k][2 * j] = lo_f(v[j]); xw[k][2 * j + 1] = hi_f(v[j]); }
  }
#pragma unroll
  for (int i = 0; i < RPT; ++i) {
    const int tr = row0 + r0 + i;
    const bool valid = tr < L;
    u32x4 v = {0u, 0u, 0u, 0u};
    if (valid) v = *(const u32x4*)(xbc + (size_t)tr * 3072 + ch);
    float xc[8], o[8];
#pragma unroll
    for (int j = 0; j < 4; ++j) { xc[2 * j] = lo_f(v[j]); xc[2 * j + 1] = hi_f(v[j]); }
    float sc = 1.f;
    if (SCALE) sc = rs[(cgi >> 3) * 128 + r0 + i];
#pragma unroll
    for (int j = 0; j < 8; ++j) {
      float a = bias[j] + w[0][j] * xw[0][j] + w[1][j] * xw[1][j] + w[2][j] * xw[2][j] + w[3][j] * xc[j];
      a = silu_f(a) * sc;
      o[j] = valid ? a : 0.f;
      xw[0][j] = xw[1][j]; xw[1][j] = xw[2][j]; xw[2][j] = xc[j];
    }
    u32x4 pk; pk[0] = pack2(o[0], o[1]); pk[1] = pack2(o[2], o[3]); pk[2] = pack2(o[4], o[5]); pk[3] = pack2(o[6], o[7]);
    *(u32x4*)(dst + (r0 + i) * ld + cgi * 8) = pk;
  }
}

DEV float chunk_cumsum(const float* __restrict__ DT, int c, int H, float A, float* acs, float* dts, int lane) {
  const int s0 = 2 * lane;
  const int t0 = c * 128 + s0;
  const float d0 = (t0 < L) ? DT[(size_t)t0 * 32 + H] : 0.f;
  const float d1 = (t0 + 1 < L) ? DT[(size_t)(t0 + 1) * 32 + H] : 0.f;
  const float a0 = d0 * A, a1 = a0 + d1 * A;
  float tot = a1;
#pragma unroll
  for (int o = 1; o < 64; o <<= 1) { float n = __shfl_up(tot, o); if (lane >= o) tot += n; }
  const float excl = tot - a1;
  acs[s0] = excl + a0; acs[s0 + 1] = excl + a1;
  dts[s0] = d0; dts[s0 + 1] = d1;
  return __shfl(tot, 63);
}

DEV void phase_prep(const Params& p, int b, bool first, char* smem) {
  const int tid = get_tid(), lane = tid & 63, w = tid >> 6;
  u16* U = (u16*)((char*)p.out + OUT_HALF);
  const int n_norm = L / 4;
  const int n_win = 16 * (NPROJ_PAD / 64);
  const int n_wb = first ? 2 * 32 * 16 : 0;
  const int total = n_norm + n_win + n_wb;
  for (int it = get_bid(); it < total; it += nworkers()) {
    if (it < n_norm) {
      const int t = it * 4 + w;
      const float* src = (t < NMETA) ? (p.in[1] + (size_t)t * D) : (p.in[0] + ((size_t)b * SEQ + (t - NMETA)) * D);
      rmsnorm_row_bf16(src, p.in[2], U + (size_t)t * D, lane);
    } else if (it < n_norm + n_win) {
      const int j = it - n_norm; const int ntile = j >> 4, kt = j & 15;
      convert_tile(p.in[3], NPROJ, 1024, (u16*)(p.ws + OFF_S1), kt, ntile, 1, smem);
    } else {
      int j = it - n_norm - n_win; const int which = j >> 9; j &= 511; const int ntile = j >> 5, kt = j & 31;
      convert_tile(p.in[10 + which], 1024, 2048, (u16*)(p.ws + OFF_S2 + (size_t)which * 4194304), kt, ntile, 0, smem);
    }
  }
}

DEV void phase_inproj(const Params& p, int b, char* smem) {
  const int tid = get_tid(), lane = tid & 63, w = tid >> 6, wm = w >> 1, wn = w & 1, r = lane & 31, h = lane >> 5;
  const u16* U = (const u16*)((char*)p.out + OUT_HALF);
  const u16* WT = (const u16*)(p.ws + OFF_S1);
  const int MT = 65, NT = 105;
  for (int it = get_bid(); it < MT * NT; it += gridDim.x) {
    const int nt = it / MT, mt = it % MT;
    f32x16 acc[2][2];
#pragma unroll
    for (int mi = 0; mi < 2; ++mi)
#pragma unroll
      for (int ni = 0; ni < 2; ++ni) acc[mi][ni] = zero16();
    gemm_tile<2>(acc, U, 1024, mt * 128, L - 1, WT, 1024, nt * 128, 1024, smem);
    const int n0 = nt * 128;
    if (nt >= 40 && nt < 56) {
      const bool isk = nt >= 48;
      const int cq = n0 - (isk ? 6144 : 5120);
      const int blk = ((cq & 255) >> 6) + wn;
      const int jf = blk * 32 + r;
      const double invf_rev = exp(-(double)jf * 0.07252236513367073) * 0.15915494309189535;
      const float sc = isk ? 0.0625f : 1.f;
      u16* dst = (u16*)(p.ws + (isk ? OFF_K : OFF_Q));
#pragma unroll
      for (int mi = 0; mi < 2; ++mi)
#pragma unroll
        for (int i = 0; i < 16; ++i) {
          const int t = mt * 128 + wm * 64 + mi * 32 + acc_row(i, h);
          if (t < L) {
            double rev = (double)t * invf_rev;
            rev -= floor(rev);
            const float fr = (float)rev;
            const float sn = __builtin_amdgcn_sinf(fr), cs = __builtin_amdgcn_cosf(fr);
            const float x1 = acc[mi][0][i], x2 = acc[mi][1][i];
            const float o1 = (x1 * cs - x2 * sn) * sc, o2 = (x2 * cs + x1 * sn) * sc;
            u16* d = dst + (size_t)t * 1024 + cq + wn * 64 + r;
            d[0] = f2bf(o1); d[32] = f2bf(o2);
          }
        }
    } else if (nt == 104) {
      float* DT = (float*)(p.ws + OFF_DT);
      if (wn == 0) {
        const float bias = p.in[6][r];
#pragma unroll
        for (int mi = 0; mi < 2; ++mi)
#pragma unroll
          for (int i = 0; i < 16; ++i) {
            const int t = mt * 128 + wm * 64 + mi * 32 + acc_row(i, h);
            if (t < L) {
              const float x = acc[mi][0][i] + bias;
              const float e = __expf(x);
              DT[(size_t)t * 32 + r] = (x > 20.f) ? x : (e < 0.01f ? e * (1.f - 0.5f * e + e * e * (1.f / 3.f)) : __logf(1.f + e));
            }
          }
      }
    } else {
      u16* dst; int ld, c0; bool sig = false;
      if (nt < 16) { dst = (u16*)(p.ws + OFF_Z); ld = 2048; c0 = n0; }
      else if (nt < 40) { dst = (u16*)(p.ws + OFF_XBC); ld = 3072; c0 = n0 - 2048; }
      else if (nt < 72) { dst = (u16*)(p.ws + OFF_V); ld = 2048; c0 = n0 - 7168; }
      else if (nt < 88) { dst = (u16*)(p.ws + OFF_G); ld = 2048; c0 = n0 - 9216; }
      else if (nt < 96) { dst = (u16*)(p.ws + OFF_GS); ld = 1024; c0 = n0 - 11264; sig = true; }
      else { dst = (u16*)(p.ws + OFF_GR); ld = 1024; c0 = n0 - 12288; sig = true; }
#pragma unroll
      for (int mi = 0; mi < 2; ++mi)
#pragma unroll
        for (int ni = 0; ni < 2; ++ni)
#pragma unroll
          for (int i = 0; i < 16; ++i) {
            const int t = mt * 128 + wm * 64 + mi * 32 + acc_row(i, h);
            if (t < L) {
              float v = acc[mi][ni][i];
              if (sig) v = sigmoid_f(v);
              dst[(size_t)t * ld + c0 + wn * 64 + ni * 32 + r] = f2bf(v);
            }
          }
    }
  }
}

DEV void ssd_state_item(const Params& p, int it, char* smem) {
  const int tid = get_tid(), lane = tid & 63, w = tid >> 6, wm = w >> 1, wn = w & 1, r = lane & 31, h = lane >> 5;
  const int c = it >> 4, hp = it & 15, H0 = hp * 2, g = H0 >> 3;
  u16* Xw = (u16*)smem;
  u16* Bc = Xw + 128 * 136;
  float* wsc = (float*)(Bc + 128 * 136);
  float* tmp = wsc + 256;
  const float* DT = (const float*)(p.ws + OFF_DT);
  float* CD = (float*)(p.ws + OFF_CD);
  const u16* XBC = (const u16*)(p.ws + OFF_XBC);
  if (w < 2) {
    const int H = H0 + w;
    const float A = -expf(p.in[7][H]);
    float* acs = tmp + w * 128;
    float* dts = wsc + w * 128;
    const float aend = chunk_cumsum(DT, c, H, A, acs, dts, lane);
    const int s0 = 2 * lane;
    const float w0 = __expf(aend - acs[s0]) * dts[s0], w1 = __expf(aend - acs[s0 + 1]) * dts[s0 + 1];
    dts[s0] = w0; dts[s0 + 1] = w1;
    if (lane == 0) CD[c * 32 + H] = __expf(aend);
  }
  __syncthreads();
  stage_conv<128, 128, true>(Xw, 136, XBC, c * 128, H0 * 64, p.in[4], p.in[5], wsc);
  stage_conv<128, 128, false>(Bc, 136, XBC, c * 128, 2048 + g * 128, p.in[4], p.in[5], nullptr);
  __syncthreads();
  f32x16 acc[2][2];
#pragma unroll
  for (int mi = 0; mi < 2; ++mi)
#pragma unroll
    for (int ni = 0; ni < 2; ++ni) acc[mi][ni] = zero16();
#pragma unroll
  for (int ks = 0; ks < 8; ++ks) {
    bf16x8 a[2], bq[2];
#pragma unroll
    for (int mi = 0; mi < 2; ++mi) a[mi] = frag_tr(Xw, 136, ks * 16, wm * 64 + mi * 32, lane);
#pragma unroll
    for (int ni = 0; ni < 2; ++ni) bq[ni] = frag_tr(Bc, 136, ks * 16, wn * 64 + ni * 32, lane);
#pragma unroll
    for (int mi = 0; mi < 2; ++mi)
#pragma unroll
      for (int ni = 0; ni < 2; ++ni) acc[mi][ni] = mfma(a[mi], bq[ni], acc[mi][ni]);
  }
  u16* ST = (u16*)(p.ws + OFF_S1) + (size_t)(c * 32 + H0) * 8192;
  __syncthreads();
#pragma unroll
  for (int mi = 0; mi < 2; ++mi)
#pragma unroll
    for (int ni = 0; ni < 2; ++ni)
#pragma unroll
      for (int i = 0; i < 16; ++i) Xw[(wm * 64 + mi * 32 + acc_row(i, h)) * 136 + wn * 64 + ni * 32 + r] = f2bf(acc[mi][ni][i]);
  asm volatile("s_waitcnt lgkmcnt(0)" ::: "memory");
#pragma unroll
  for (int j = 0; j < 8; ++j) {
    const int m = wm * 64 + (lane >> 3) + 8 * j, n = wn * 64 + (lane & 7) * 8;
    *(u32x4*)(ST + m * 128 + n) = *(const u32x4*)(Xw + m * 136 + n);
  }
  __syncthreads();
}

DEV void ret_kv_item(const Params& p, int it, char* smem) {
  const int tid = get_tid(), lane = tid & 63, w = tid >> 6, wm = w >> 1, wn = w & 1, r = lane & 31, h = lane >> 5;
  const int sc = it >> 5, rem = it & 31, hd = rem >> 3, dt2 = (rem >> 2) & 1, et = rem & 3;
  u16* Vt = (u16*)smem;
  u16* Kt = Vt + 128 * 136;
  const u16* Vg = (const u16*)(p.ws + OFF_V);
  const u16* Kg = (const u16*)(p.ws + OFF_K);
  const float lg = log_gamma(hd);
  f32x16 acc[2][2];
#pragma unroll
  for (int mi = 0; mi < 2; ++mi)
#pragma unroll
    for (int ni = 0; ni < 2; ++ni) acc[mi][ni] = zero16();
  for (int half = 0; half < 2; ++half) {
#pragma unroll
    for (int i = 0; i < 8; ++i) {
      const int cidx = tid + i * 256, row = cidx >> 4, cc = cidx & 15;
      const int tok = sc * 256 + half * 128 + row;
      u32x4 v = *(const u32x4*)(Vg + (size_t)tok * 2048 + hd * 512 + et * 128 + cc * 8);
      *(u32x4*)(Vt + row * 136 + cc * 8) = v;
      u32x4 kk = *(const u32x4*)(Kg + (size_t)tok * 1024 + hd * 256 + dt2 * 128 + cc * 8);
      const float dec = __expf((float)(255 - (half * 128 + row)) * lg);
      u32x4 ko;
#pragma unroll
      for (int j = 0; j < 4; ++j) ko[j] = pack2(lo_f(kk[j]) * dec, hi_f(kk[j]) * dec);
      *(u32x4*)(Kt + row * 136 + cc * 8) = ko;
    }
    __syncthreads();
#pragma unroll
    for (int ks = 0; ks < 8; ++ks) {
      bf16x8 a[2], bq[2];
#pragma unroll
      for (int mi = 0; mi < 2; ++mi) a[mi] = frag_tr(Vt, 136, ks * 16, wm * 64 + mi * 32, lane);
#pragma unroll
      for (int ni = 0; ni < 2; ++ni) bq[ni] = frag_tr(Kt, 136, ks * 16, wn * 64 + ni * 32, lane);
#pragma unroll
      for (int mi = 0; mi < 2; ++mi)
#pragma unroll
        for (int ni = 0; ni < 2; ++ni) acc[mi][ni] = mfma(a[mi], bq[ni], acc[mi][ni]);
    }
    __syncthreads();
  }
  u16* RST = (u16*)((char*)p.out + OUT_HALF) + ((size_t)(sc * 4 + hd) * 512 + et * 128) * 256 + dt2 * 128;
#pragma unroll
  for (int mi = 0; mi < 2; ++mi)
#pragma unroll
    for (int ni = 0; ni < 2; ++ni)
#pragma unroll
      for (int i = 0; i < 16; ++i) Vt[(wm * 64 + mi * 32 + acc_row(i, h)) * 136 + wn * 64 + ni * 32 + r] = f2bf(acc[mi][ni][i]);
  asm volatile("s_waitcnt lgkmcnt(0)" ::: "memory");
#pragma unroll
  for (int j = 0; j < 8; ++j) {
    const int e = wm * 64 + (lane >> 3) + 8 * j, d = wn * 64 + (lane & 7) * 8;
    *(u32x4*)(RST + (size_t)e * 256 + d) = *(const u32x4*)(Vt + e * 136 + d);
  }
  __syncthreads();
}

DEV void phase_scan(const Params& p) {
  const int gt = get_bid() * 256 + get_tid(), nth = nworkers() * 256;
  const float* CD = (const float*)(p.ws + OFF_CD);
  for (int v = gt; v < 32768 + 65536; v += nth) {
    float st[8];
#pragma unroll
    for (int j = 0; j < 8; ++j) st[j] = 0.f;
    if (v < 32768) {
      const int e0 = v * 8, H = e0 >> 13;
      u16* base = (u16*)(p.ws + OFF_S1) + e0;
      for (int c0 = 0; c0 < 64; c0 += 4) {
        u32x4 x[4];
#pragma unroll
        for (int u = 0; u < 4; ++u) x[u] = *(const u32x4*)(base + (size_t)(c0 + u) * 262144);
#pragma unroll
        for (int u = 0; u < 4; ++u) {
          const float dcy = CD[(c0 + u) * 32 + H];
          u32x4 o;
#pragma unroll
          for (int j = 0; j < 4; ++j) {
            st[2 * j] = st[2 * j] * dcy + lo_f(x[u][j]);
            st[2 * j + 1] = st[2 * j + 1] * dcy + hi_f(x[u][j]);
            o[j] = pack2(st[2 * j], st[2 * j + 1]);
          }
          *(u32x4*)(base + (size_t)(c0 + u) * 262144) = o;
        }
      }
    } else {
      const int e0 = (v - 32768) * 8, hd = e0 >> 17;
      const float g256 = __expf(256.f * log_gamma(hd));
      u16* base = (u16*)((char*)p.out + OUT_HALF) + e0;
      for (int c0 = 0; c0 < 32; c0 += 4) {
        u32x4 x[4];
#pragma unroll
        for (int u = 0; u < 4; ++u) x[u] = *(const u32x4*)(base + (size_t)(c0 + u) * 524288);
#pragma unroll
        for (int u = 0; u < 4; ++u) {
          u32x4 o;
#pragma unroll
          for (int j = 0; j < 4; ++j) {
            st[2 * j] = st[2 * j] * g256 + lo_f(x[u][j]);
            st[2 * j + 1] = st[2 * j + 1] * g256 + hi_f(x[u][j]);
            o[j] = pack2(st[2 * j], st[2 * j + 1]);
          }
          *(u32x4*)(base + (size_t)(c0 + u) * 524288) = o;
        }
      }
    }
  }
}

DEV void ssd_out_item(const Params& p, int it, char* smem) {
  const int tid = get_tid(), lane = tid & 63, w = tid >> 6, wm = w >> 1, wn = w & 1, r = lane & 31, h = lane >> 5;
  const int c = it >> 3, rem = it & 7, g = rem & 3, lh = rem >> 2;
  if (c == 64 && lh == 1) return;
  u16* Ct = (u16*)smem;
  u16* Bt = Ct + 64 * 136;
  u16* Lt = Bt;
  u16* Xt = Bt + 128 * 136;
  float* acs = (float*)(Xt + 128 * 72);
  float* dts = acs + 128;
  float* rowsq = dts + 128;
  const u16* XBC = (const u16*)(p.ws + OFF_XBC);
  const float* DT = (const float*)(p.ws + OFF_DT);
  u16* Z = (u16*)(p.ws + OFF_Z);
  const int tok0 = c * 128;
  stage_conv<64, 128, false>(Ct, 136, XBC, tok0 + lh * 64, 2560 + g * 128, p.in[4], p.in[5], nullptr);
  stage_conv<128, 128, false>(Bt, 136, XBC, tok0, 2048 + g * 128, p.in[4], p.in[5], nullptr);
  if (tid < 64) rowsq[tid] = 0.f;
  __syncthreads();
  f32x16 cb[2];
  cb[0] = zero16(); cb[1] = zero16();
#pragma unroll
  for (int ks = 0; ks < 8; ++ks) {
    bf16x8 a = frag_row(Ct, 136, wm * 32 + r, ks * 16 + h * 8);
#pragma unroll
    for (int ni = 0; ni < 2; ++ni) {
      bf16x8 bq = frag_row(Bt, 136, wn * 64 + ni * 32 + r, ks * 16 + h * 8);
      cb[ni] = mfma(a, bq, cb[ni]);
    }
  }
  for (int hh = 0; hh < 8; ++hh) {
    const int H = g * 8 + hh;
    u32x4 zv[2];
    {
      int tz = tok0 + lh * 64 + (tid >> 2); tz = tz < L ? tz : L - 1;
      const u16* zp0 = Z + (size_t)tz * 2048 + H * 64 + (tid & 3) * 16;
      zv[0] = *(const u32x4*)zp0; zv[1] = *(const u32x4*)(zp0 + 8);
    }
    __syncthreads();
    if (w == 0) {
      const float A = -expf(p.in[7][H]);
      chunk_cumsum(DT, c, H, A, acs, dts, lane);
    }
    stage_conv<128, 64, false>(Xt, 72, XBC, tok0, H * 64, p.in[4], p.in[5], nullptr);
    __syncthreads();
#pragma unroll
    for (int ni = 0; ni < 2; ++ni)
#pragma unroll
      for (int i = 0; i < 16; ++i) {
        const int ll = wm * 32 + acc_row(i, h), l = lh * 64 + ll, s = wn * 64 + ni * 32 + r;
        float val = 0.f;
        if (s <= l) val = cb[ni][i] * __expf(acs[l] - acs[s]) * dts[s];
        Lt[ll * 136 + s] = f2bf(val);
      }
    f32x16 y = zero16();
    if (c > 0) {
      const u16* pv = (const u16*)(p.ws + OFF_S1) + ((size_t)((c - 1) * 32 + H) * 64 + wn * 32 + r) * 128 + h * 8;
#pragma unroll
      for (int ks = 0; ks < 8; ++ks) {
        bf16x8 a = frag_row(Ct, 136, wm * 32 + r, ks * 16 + h * 8);
        bf16x8 bq = *(const bf16x8*)(pv + ks * 16);
        y = mfma(a, bq, y);
      }
#pragma unroll
      for (int i = 0; i < 16; ++i) { const int l = lh * 64 + wm * 32 + acc_row(i, h); y[i] *= __expf(acs[l]); }
    }
    __syncthreads();
#pragma unroll
    for (int ks = 0; ks < 8; ++ks) {
      bf16x8 a = frag_row(Lt, 136, wm * 32 + r, ks * 16 + h * 8);
      bf16x8 bq = frag_tr(Xt, 72, ks * 16, wn * 32, lane);
      y = mfma(a, bq, y);
    }
    const float Dsk = p.in[8][H];
    float* Ys = (float*)(Bt + 64 * 136);
#pragma unroll
    for (int i = 0; i < 16; ++i) Ys[(wm * 32 + acc_row(i, h)) * 68 + wn * 32 + r] = y[i];
    __syncthreads();
    {
      const int row = tid >> 2, q = tid & 3, l = lh * 64 + row, t = tok0 + l;
      float sq = 0.f;
      if (t < L) {
        u16* zp = Z + (size_t)t * 2048 + H * 64 + q * 16;
        u32x4 xv[2], ov[2];
        xv[0] = *(const u32x4*)(Xt + l * 72 + q * 16); xv[1] = *(const u32x4*)(Xt + l * 72 + q * 16 + 8);
#pragma unroll
        for (int k = 0; k < 2; ++k) {
          const f32x4 ya = *(const f32x4*)(Ys + row * 68 + q * 16 + k * 8), yb = *(const f32x4*)(Ys + row * 68 + q * 16 + k * 8 + 4);
          float o[8];
#pragma unroll
          for (int j = 0; j < 4; ++j) {
            const float y0 = (j < 2) ? ya[2 * j] : yb[2 * j - 4], y1 = (j < 2) ? ya[2 * j + 1] : yb[2 * j - 3];
            o[2 * j] = (y0 + Dsk * lo_f(xv[k][j])) * silu_f(lo_f(zv[k][j]));
            o[2 * j + 1] = (y1 + Dsk * hi_f(xv[k][j])) * silu_f(hi_f(zv[k][j]));
            sq += o[2 * j] * o[2 * j] + o[2 * j + 1] * o[2 * j + 1];
            ov[k][j] = pack2(o[2 * j], o[2 * j + 1]);
          }
        }
        *(u32x4*)zp = ov[0]; *(u32x4*)(zp + 8) = ov[1];
      }
      sq += __shfl_xor(sq, 1); sq += __shfl_xor(sq, 2);
      if (q == 0) rowsq[row] += sq;
    }
  }
  __syncthreads();
  {
    const int row = tid >> 2, q = tid & 3, t = tok0 + lh * 64 + row;
    if (t < L) {
      const float rn = rsqrtf(rowsq[row] * (1.f / 512.f) + EPS);
      u32x4 v[16];
#pragma unroll
      for (int hh = 0; hh < 8; ++hh) {
        const u16* zp = Z + (size_t)t * 2048 + (g * 8 + hh) * 64 + q * 16;
        v[2 * hh] = *(const u32x4*)zp; v[2 * hh + 1] = *(const u32x4*)(zp + 8);
      }
#pragma unroll
      for (int hh = 0; hh < 8; ++hh) {
        u16* zp = Z + (size_t)t * 2048 + (g * 8 + hh) * 64 + q * 16;
        const float* nwp = p.in[9] + (g * 8 + hh) * 64 + q * 16;
#pragma unroll
        for (int k = 0; k < 2; ++k) {
          const f32x4 wa = *(const f32x4*)(nwp + k * 8), wb = *(const f32x4*)(nwp + k * 8 + 4);
          u32x4 o;
          o[0] = pack2(lo_f(v[2 * hh + k][0]) * rn * wa[0], hi_f(v[2 * hh + k][0]) * rn * wa[1]);
          o[1] = pack2(lo_f(v[2 * hh + k][1]) * rn * wa[2], hi_f(v[2 * hh + k][1]) * rn * wa[3]);
          o[2] = pack2(lo_f(v[2 * hh + k][2]) * rn * wb[0], hi_f(v[2 * hh + k][2]) * rn * wb[1]);
          o[3] = pack2(lo_f(v[2 * hh + k][3]) * rn * wb[2], hi_f(v[2 * hh + k][3]) * rn * wb[3]);
          *(u32x4*)(zp + k * 8) = o;
        }
      }
    }
  }
  __syncthreads();
}

DEV void ret_out_item(const Params& p, int it, char* smem) {
  const int tid = get_tid(), lane = tid & 63, w = tid >> 6, wm = w >> 1, wn = w & 1, r = lane & 31, h = lane >> 5;
  const int rt = it >> 2, hd = it & 3;
  const int t0 = rt * 64, sc = rt >> 2, qtr = rt & 3;
  u16* P = (u16*)smem;
  char* gsm = smem + 33792;
  u16* Vt = (u16*)gsm;
  float* rowsq = (float*)(smem + 33792 + 27648);
  const u16* Qg = (const u16*)(p.ws + OFF_Q) + hd * 256;
  const u16* Kg = (const u16*)(p.ws + OFF_K) + hd * 256;
  const u16* Vg = (const u16*)(p.ws + OFF_V);
  u16* Gg = (u16*)(p.ws + OFF_G);
  const u16* RST = (const u16*)((char*)p.out + OUT_HALF);
  const float lg = log_gamma(hd);
  if (tid < 64) rowsq[tid] = 0.f;
  const int nkb = (qtr >= 2) ? 2 : 1;
  for (int kb = 0; kb < nkb; ++kb) {
    f32x16 acc[1][2];
    acc[0][0] = zero16(); acc[0][1] = zero16();
    gemm_tile<1>(acc, Qg, 1024, t0, L - 1, Kg, 1024, sc * 256 + kb * 128, 256, gsm);
#pragma unroll
    for (int ni = 0; ni < 2; ++ni)
#pragma unroll
      for (int i = 0; i < 16; ++i) {
        const int ll = wm * 32 + acc_row(i, h), lp = qtr * 64 + ll, s = kb * 128 + wn * 64 + ni * 32 + r;
        float val = 0.f;
        if (s <= lp) val = acc[0][ni][i] * __expf((float)(lp - s) * lg);
        P[ll * 264 + s] = f2bf(val);
      }
  }
  float rs[16];
#pragma unroll
  for (int i = 0; i < 16; ++i) rs[i] = 0.f;
  for (int et = 0; et < 4; ++et) {
    f32x16 acc[1][2];
    acc[0][0] = zero16(); acc[0][1] = zero16();
    u32x4 gv[4], vreg[4];
    {
      int tg = t0 + (tid >> 2); tg = tg < L ? tg : L - 1;
      const u16* gp0 = Gg + (size_t)tg * 2048 + hd * 512 + et * 128 + (tid & 3) * 32;
#pragma unroll
      for (int k = 0; k < 4; ++k) gv[k] = *(const u32x4*)(gp0 + k * 8);
#pragma unroll
      for (int i = 0; i < 4; ++i) {
        const int cidx = tid + i * 256, row = cidx >> 4, cc = cidx & 15;
        int tok = sc * 256 + row; tok = tok < L ? tok : L - 1;
        vreg[i] = *(const u32x4*)(Vg + (size_t)tok * 2048 + hd * 512 + et * 128 + cc * 8);
      }
    }
    if (sc > 0) {
      gemm_tile<1>(acc, Qg, 1024, t0, L - 1, RST + ((size_t)((sc - 1) * 4 + hd) * 512 + et * 128) * 256, 256, 0, 256, gsm);
#pragma unroll
      for (int ni = 0; ni < 2; ++ni)
#pragma unroll
        for (int i = 0; i < 16; ++i) {
          const int lp = qtr * 64 + wm * 32 + acc_row(i, h);
          acc[0][ni][i] *= __expf((float)(lp + 1) * lg);
        }
    }
    for (int kb64 = 0; kb64 <= qtr; ++kb64) {
#pragma unroll
      for (int i = 0; i < 4; ++i) {
        const int cidx = tid + i * 256, row = cidx >> 4, cc = cidx & 15;
        const int tok = sc * 256 + kb64 * 64 + row;
        u32x4 v = {0u, 0u, 0u, 0u};
        if (tok < L) v = vreg[i];
        *(u32x4*)(Vt + row * 136 + cc * 8) = v;
      }
      __syncthreads();
      if (kb64 < qtr) {
#pragma unroll
        for (int i = 0; i < 4; ++i) {
          const int cidx = tid + i * 256, row = cidx >> 4, cc = cidx & 15;
          int tok = sc * 256 + (kb64 + 1) * 64 + row; tok = tok < L ? tok : L - 1;
          vreg[i] = *(const u32x4*)(Vg + (size_t)tok * 2048 + hd * 512 + et * 128 + cc * 8);
        }
      }
#pragma unroll
      for (int ks = 0; ks < 4; ++ks) {
        bf16x8 a = frag_row(P, 264, wm * 32 + r, kb64 * 64 + ks * 16 + h * 8);
#pragma unroll
        for (int ni = 0; ni < 2; ++ni) {
          bf16x8 bq = frag_tr(Vt, 136, ks * 16, wn * 64 + ni * 32, lane);
          acc[0][ni] = mfma(a, bq, acc[0][ni]);
        }
      }
      __syncthreads();
    }
    u16* Os = (u16*)gsm;
#pragma unroll
    for (int ni = 0; ni < 2; ++ni)
#pragma unroll
      for (int i = 0; i < 16; ++i) {
        const float o = acc[0][ni][i];
        if (t0 + wm * 32 + acc_row(i, h) < L) rs[i] += o * o;
        Os[(wm * 32 + acc_row(i, h)) * 136 + wn * 64 + ni * 32 + r] = f2bf(o);
      }
    __syncthreads();
    {
      const int row = tid >> 2, q = tid & 3, t = t0 + row;
      if (t < L) {
        u16* gp = Gg + (size_t)t * 2048 + hd * 512 + et * 128 + q * 32;
        u32x4 ov[4];
#pragma unroll
        for (int k = 0; k < 4; ++k) ov[k] = *(const u32x4*)(Os + row * 136 + q * 32 + k * 8);
#pragma unroll
        for (int k = 0; k < 4; ++k) {
          u32x4 o;
#pragma unroll
          for (int j = 0; j < 4; ++j) o[j] = pack2(silu_f(lo_f(gv[k][j])) * lo_f(ov[k][j]), silu_f(hi_f(gv[k][j])) * hi_f(ov[k][j]));
          *(u32x4*)(gp + k * 8) = o;
        }
      }
    }
    __syncthreads();
  }
#pragma unroll
  for (int i = 0; i < 16; ++i) {
    const float v = half_sum(rs[i]);
    if (r == 0) atomicAdd(&rowsq[wm * 32 + acc_row(i, h)], v);
  }
  __syncthreads();
  {
    const int row = tid >> 2, q = tid & 3, t = t0 + row;
    if (t < L) {
      const float rn = rsqrtf(rowsq[row] * (1.f / 512.f) + EPS);
      u32x4 v[16];
#pragma unroll
      for (int et = 0; et < 4; ++et)
#pragma unroll
        for (int k = 0; k < 4; ++k) v[et * 4 + k] = *(const u32x4*)(Gg + (size_t)t * 2048 + hd * 512 + et * 128 + q * 32 + k * 8);
#pragma unroll
      for (int et = 0; et < 4; ++et)
#pragma unroll
        for (int k = 0; k < 4; ++k) {
          u32x4 o;
#pragma unroll
          for (int j = 0; j < 4; ++j) o[j] = pack2(lo_f(v[et * 4 + k][j]) * rn, hi_f(v[et * 4 + k][j]) * rn);
          *(u32x4*)(Gg + (size_t)t * 2048 + hd * 512 + et * 128 + q * 32 + k * 8) = o;
        }
    }
  }
  __syncthreads();
}

DEV void merge_tile(const Params& p, int it, char* smem) {
  const int tid = get_tid(), lane = tid & 63, w = tid >> 6, wm = w >> 1, wn = w & 1, r = lane & 31, h = lane >> 5;
  const int nt = it / 65, mt = it % 65;
  u16* GS = (u16*)(p.ws + OFF_GS);
  const u16* GR = (const u16*)(p.ws + OFF_GR);
  f32x16 acc[2][2];
#pragma unroll
  for (int mi = 0; mi < 2; ++mi)
#pragma unroll
    for (int ni = 0; ni < 2; ++ni) acc[mi][ni] = zero16();
  gemm_tile<2>(acc, (const u16*)(p.ws + OFF_Z), 2048, mt * 128, L - 1, (const u16*)(p.ws + OFF_S2), 2048, nt * 128, 2048, smem);
#pragma unroll
  for (int mi = 0; mi < 2; ++mi)
#pragma unroll
    for (int ni = 0; ni < 2; ++ni)
#pragma unroll
      for (int i = 0; i < 16; ++i) {
        const int t = mt * 128 + wm * 64 + mi * 32 + acc_row(i, h);
        if (t < L) {
          const size_t idx = (size_t)t * 1024 + nt * 128 + wn * 64 + ni * 32 + r;
          GS[idx] = f2bf(bf2f(GS[idx]) * acc[mi][ni][i]);
        }
        acc[mi][ni][i] = 0.f;
      }
  gemm_tile<2>(acc, (const u16*)(p.ws + OFF_G), 2048, mt * 128, L - 1, (const u16*)(p.ws + OFF_S2 + 4194304), 2048, nt * 128, 2048, smem);
#pragma unroll
  for (int mi = 0; mi < 2; ++mi)
#pragma unroll
    for (int ni = 0; ni < 2; ++ni)
#pragma unroll
      for (int i = 0; i < 16; ++i) {
        const int t = mt * 128 + wm * 64 + mi * 32 + acc_row(i, h);
        if (t < L) {
          const size_t idx = (size_t)t * 1024 + nt * 128 + wn * 64 + ni * 32 + r;
          GS[idx] = f2bf(bf2f(GS[idx]) + bf2f(GR[idx]) * acc[mi][ni][i]);
        }
      }
}

DEV void phase_merge(const Params& p, char* smem) {
  const int n_tiles = 65 * 8;
  const int n_wout = 16 * 16, n_wup = 16 * 88, n_wdown = 44 * 16;
  const int total = n_tiles + n_wout + n_wup + n_wdown;
  for (int it = get_bid(); it < total; it += nworkers()) {
    if (it < n_tiles) merge_tile(p, it, smem);
    else if (it < n_tiles + n_wout) { const int j = it - n_tiles; convert_tile(p.in[12], 1024, 1024, (u16*)(p.ws + OFF_WOUT), j & 15, j >> 4, 0, smem); }
    else if (it < n_tiles + n_wout + n_wup) { const int j = it - n_tiles - n_wout; convert_tile(p.in[14], 5632, 1024, (u16*)(p.ws + OFF_WUP), j & 15, j >> 4, 0, smem); }
    else { const int j = it - n_tiles - n_wout - n_wup; convert_tile(p.in[17], 1024, 2816, (u16*)(p.ws + OFF_WDOWN), j % 44, j / 44, 0, smem); }
  }
}

DEV void phase_outproj(const Params& p, int b, char* smem) {
  const int tid = get_tid(), lane = tid & 63, w = tid >> 6, wm = w >> 1, wn = w & 1, r = lane & 31, h = lane >> 5;
  float* HM = (float*)(p.ws + OFF_HM);
  for (int it = get_bid(); it < 65 * 8; it += gridDim.x) {
    const int nt = it / 65, mt = it % 65;
    f32x16 acc[2][2];
#pragma unroll
    for (int mi = 0; mi < 2; ++mi)
#pragma unroll
      for (int ni = 0; ni < 2; ++ni) acc[mi][ni] = zero16();
    gemm_tile<2>(acc, (const u16*)(p.ws + OFF_GS), 1024, mt * 128, L - 1, (const u16*)(p.ws + OFF_WOUT), 1024, nt * 128, 1024, smem);
#pragma unroll
    for (int mi = 0; mi < 2; ++mi)
#pragma unroll
      for (int ni = 0; ni < 2; ++ni)
#pragma unroll
        for (int i = 0; i < 16; ++i) {
          const int t = mt * 128 + wm * 64 + mi * 32 + acc_row(i, h);
          const int col = nt * 128 + wn * 64 + ni * 32 + r;
          if (t < NMETA) HM[t * 1024 + col] = p.in[1][t * 1024 + col] + acc[mi][ni][i];
          else if (t < L) {
            const size_t idx = ((size_t)b * SEQ + (t - NMETA)) * 1024 + col;
            p.out[idx] = p.in[0][idx] + acc[mi][ni][i];
          }
        }
  }
}

DEV void phase_norm2(const Params& p, int b) {
  const int lane = get_tid() & 63, w = get_tid() >> 6;
  u16* U2 = (u16*)(p.ws + OFF_U2);
  for (int it = get_bid(); it < L / 4; it += nworkers()) {
    const int t = it * 4 + w;
    const float* src = (t < NMETA) ? ((const float*)(p.ws + OFF_HM) + (size_t)t * D) : (p.out + ((size_t)b * SEQ + (t - NMETA)) * D);
    rmsnorm_row_bf16(src, p.in[13], U2 + (size_t)t * D, lane);
  }
}

DEV void phase_up(const Params& p, char* smem) {
  const int tid = get_tid(), lane = tid & 63, w = tid >> 6, wm = w >> 1, wn = w & 1, r = lane & 31, h = lane >> 5;
  u16* UP = (u16*)(p.ws + OFF_UP);
  for (int it = get_bid(); it < 65 * 44; it += gridDim.x) {
    const int nt = it / 65, mt = it % 65;
    f32x16 acc[2][2];
#pragma unroll
    for (int mi = 0; mi < 2; ++mi)
#pragma unroll
      for (int ni = 0; ni < 2; ++ni) acc[mi][ni] = zero16();
    gemm_tile<2>(acc, (const u16*)(p.ws + OFF_U2), 1024, mt * 128, L - 1, (const u16*)(p.ws + OFF_WUP), 1024, nt * 128, 1024, smem);
#pragma unroll
    for (int mi = 0; mi < 2; ++mi)
#pragma unroll
      for (int ni = 0; ni < 2; ++ni)
#pragma unroll
        for (int i = 0; i < 16; ++i) {
          const int t = mt * 128 + wm * 64 + mi * 32 + acc_row(i, h);
          if (t < L) UP[(size_t)t * 5632 + nt * 128 + wn * 64 + ni * 32 + r] = f2bf(acc[mi][ni][i]);
        }
  }
}

DEV void phase_ffn_act(const Params& p) {
  const int gt = get_bid() * 256 + get_tid(), nth = nworkers() * 256;
  const u16* UP = (const u16*)(p.ws + OFF_UP);
  u16* ACT = (u16*)(p.ws + OFF_ACT);
  const float* cw = p.in[15];
  const float* cbias = p.in[16];
  for (int u = gt; u < 513 * 352; u += nth) {
    const int rb = u / 352, cgp = u % 352, ch = cgp * 8, t0 = rb * 16;
    float wg[3][8], wv[3][8], bg[8], bv[8], g2[8], g1[8], v2[8], v1[8];
#pragma unroll
    for (int k = 0; k < 3; ++k)
#pragma unroll
      for (int j = 0; j < 8; ++j) { wg[k][j] = cw[k * 5632 + ch + j]; wv[k][j] = cw[k * 5632 + 2816 + ch + j]; }
#pragma unroll
    for (int j = 0; j < 8; ++j) { bg[j] = cbias[ch + j]; bv[j] = cbias[2816 + ch + j]; }
    {
      u32x4 a = {0u, 0u, 0u, 0u}, bq = {0u, 0u, 0u, 0u}, c2 = {0u, 0u, 0u, 0u}, d2 = {0u, 0u, 0u, 0u};
      if (t0 >= 2) {
        a = *(const u32x4*)(UP + (size_t)(t0 - 2) * 5632 + ch); bq = *(const u32x4*)(UP + (size_t)(t0 - 1) * 5632 + ch);
        c2 = *(const u32x4*)(UP + (size_t)(t0 - 2) * 5632 + 2816 + ch); d2 = *(const u32x4*)(UP + (size_t)(t0 - 1) * 5632 + 2816 + ch);
      }
#pragma unroll
      for (int j = 0; j < 4; ++j) {
        g2[2 * j] = lo_f(a[j]); g2[2 * j + 1] = hi_f(a[j]); g1[2 * j] = lo_f(bq[j]); g1[2 * j + 1] = hi_f(bq[j]);
        v2[2 * j] = lo_f(c2[j]); v2[2 * j + 1] = hi_f(c2[j]); v1[2 * j] = lo_f(d2[j]); v1[2 * j + 1] = hi_f(d2[j]);
      }
    }
#pragma unroll 4
    for (int i = 0; i < 16; ++i) {
      const int t = t0 + i;
      const u32x4 a = *(const u32x4*)(UP + (size_t)t * 5632 + ch);
      const u32x4 c2 = *(const u32x4*)(UP + (size_t)t * 5632 + 2816 + ch);
      float o[8];
#pragma unroll
      for (int j = 0; j < 8; ++j) {
        const float gx = (j & 1) ? hi_f(a[j >> 1]) : lo_f(a[j >> 1]);
        const float vx = (j & 1) ? hi_f(c2[j >> 1]) : lo_f(c2[j >> 1]);
        const float ag = bg[j] + wg[0][j] * g2[j] + wg[1][j] * g1[j] + wg[2][j] * gx;
        const float av = bv[j] + wv[0][j] * v2[j] + wv[1][j] * v1[j] + wv[2][j] * vx;
        o[j] = silu_f(ag) * av;
        g2[j] = g1[j]; g1[j] = gx; v2[j] = v1[j]; v1[j] = vx;
      }
      u32x4 pk; pk[0] = pack2(o[0], o[1]); pk[1] = pack2(o[2], o[3]); pk[2] = pack2(o[4], o[5]); pk[3] = pack2(o[6], o[7]);
      *(u32x4*)(ACT + (size_t)t * 2816 + ch) = pk;
    }
  }
}

DEV void phase_down(const Params& p, int b, char* smem) {
  const int tid = get_tid(), lane = tid & 63, w = tid >> 6, wm = w >> 1, wn = w & 1, r = lane & 31, h = lane >> 5;
  for (int it = get_bid(); it < 64 * 8; it += gridDim.x) {
    const int nt = it / 64, mt = it % 64;
    f32x16 acc[2][2];
#pragma unroll
    for (int mi = 0; mi < 2; ++mi)
#pragma unroll
      for (int ni = 0; ni < 2; ++ni) acc[mi][ni] = zero16();
    gemm_tile<2>(acc, (const u16*)(p.ws + OFF_ACT), 2816, NMETA + mt * 128, L - 1, (const u16*)(p.ws + OFF_WDOWN), 2816, nt * 128, 2816, smem);
#pragma unroll
    for (int mi = 0; mi < 2; ++mi)
#pragma unroll
      for (int ni = 0; ni < 2; ++ni)
#pragma unroll
        for (int i = 0; i < 16; ++i) {
          const int rr = mt * 128 + wm * 64 + mi * 32 + acc_row(i, h);
          const size_t idx = ((size_t)b * SEQ + rr) * 1024 + nt * 128 + wn * 64 + ni * 32 + r;
          p.out[idx] += acc[mi][ni][i];
        }
  }
}

DEV void phase_final_norm(const Params& p, int b) {
  const int lane = get_tid() & 63, w = get_tid() >> 6;
  for (int it = get_bid(); it < SEQ / 4; it += nworkers()) {
    const int rr = it * 4 + w;
    rmsnorm_row_f32_inplace(p.out + ((size_t)b * SEQ + rr) * D, p.in[18], lane);
  }
}


DEV u32x4 add_bf16x8(u32x4 a, u32x4 b) {
  u32x4 o;
#pragma unroll
  for (int j = 0; j < 4; ++j) o[j] = pack2(lo_f(a[j]) + lo_f(b[j]), hi_f(a[j]) + hi_f(b[j]));
  return o;
}
template <int NJ, bool ADD2 = false>
DEV void gemm_tile8(f32x4 (&acc)[4][NJ], const u16* __restrict__ A, int lda, int arow0, int arow_max,
                    const u16* __restrict__ B, int ldb, int brow0, int K, char* smem, const u16* __restrict__ A2 = nullptr) {
  constexpr int BN = NJ * 32;
  constexpr int BCH = BN / 64;
  constexpr int STAGE = (256 + BN) * 64;
  u16* S = (u16*)smem;
  const int tid = get_tid8(), lane = tid & 63, w = tid >> 6, wm = w >> 1, wn = w & 1;
  u32x4 ra[4], rb[BCH], ra2[ADD2 ? 4 : 1];
  unsigned aoff[4], boff[BCH];
  const char* Ab = (const char*)A;
  const char* Ab2 = (const char*)A2;
  const char* Bb = (const char*)(B + (size_t)brow0 * ldb);
  const int crow = tid >> 3, kc = tid & 7;
  const unsigned sto = (unsigned)(crow * 64 + ((kc ^ ((crow >> 1) & 7)) * 8));
#pragma unroll
  for (int i = 0; i < 4; ++i) {
    int gr = arow0 + crow + i * 64; gr = gr > arow_max ? arow_max : gr; gr = gr < 0 ? 0 : gr;
    aoff[i] = ((unsigned)gr * (unsigned)lda + kc * 8) * 2u;
  }
#pragma unroll
  for (int i = 0; i < BCH; ++i) boff[i] = ((unsigned)(crow + i * 64) * (unsigned)ldb + kc * 8) * 2u;
  const int fr = lane & 15, swz = fr >> 1, cq = lane >> 4;
  const unsigned fa = (unsigned)((wm * 64 + fr) * 64), fb = (unsigned)((256 + wn * (NJ * 16) + fr) * 64);
  const unsigned c0 = (unsigned)(((cq) ^ swz) * 8), c1 = (unsigned)(((4 + cq) ^ swz) * 8);
  const int nk = K >> 6;
#pragma unroll
  for (int i = 0; i < 4; ++i) { ra[i] = *(const u32x4*)(Ab + aoff[i]); if (ADD2) ra2[i] = *(const u32x4*)(Ab2 + aoff[i]); }
#pragma unroll
  for (int i = 0; i < BCH; ++i) rb[i] = *(const u32x4*)(Bb + boff[i]);
#pragma unroll
  for (int i = 0; i < 4; ++i) *(u32x4*)(S + sto + i * 64 * 64) = ADD2 ? add_bf16x8(ra[i], ra2[i]) : ra[i];
#pragma unroll
  for (int i = 0; i < BCH; ++i) *(u32x4*)(S + sto + (256 + i * 64) * 64) = rb[i];
  if (nk > 1) {
#pragma unroll
    for (int i = 0; i < 4; ++i) { ra[i] = *(const u32x4*)(Ab + aoff[i] + 128); if (ADD2) ra2[i] = *(const u32x4*)(Ab2 + aoff[i] + 128); }
#pragma unroll
    for (int i = 0; i < BCH; ++i) rb[i] = *(const u32x4*)(Bb + boff[i] + 128);
  }
  __syncthreads();
  for (int kt = 0; kt < nk; ++kt) {
    const u16* Sc = S + (kt & 1) * STAGE;
    {
      bf16x8 a[4], b[NJ];
#pragma unroll
      for (int m = 0; m < 4; ++m) a[m] = *(const bf16x8*)(Sc + fa + m * 16 * 64 + c0);
#pragma unroll
      for (int n = 0; n < NJ; ++n) b[n] = *(const bf16x8*)(Sc + fb + n * 16 * 64 + c0);
      __builtin_amdgcn_s_setprio(1);
#pragma unroll
      for (int m = 0; m < 4; ++m)
#pragma unroll
        for (int n = 0; n < NJ; ++n) acc[m][n] = __builtin_amdgcn_mfma_f32_16x16x32_bf16(a[m], b[n], acc[m][n], 0, 0, 0);
      __builtin_amdgcn_s_setprio(0);
    }
    __builtin_amdgcn_sched_barrier(0);
    if (kt + 1 < nk) {
      u16* Aw = S + ((kt + 1) & 1) * STAGE;
#pragma unroll
      for (int i = 0; i < 4; ++i) *(u32x4*)(Aw + sto + i * 64 * 64) = ADD2 ? add_bf16x8(ra[i], ra2[i]) : ra[i];
#pragma unroll
      for (int i = 0; i < BCH; ++i) *(u32x4*)(Aw + sto + (256 + i * 64) * 64) = rb[i];
      if (kt + 2 < nk) {
        const unsigned ko = (unsigned)(kt + 2) * 128u;
#pragma unroll
        for (int i = 0; i < 4; ++i) { ra[i] = *(const u32x4*)(Ab + aoff[i] + ko); if (ADD2) ra2[i] = *(const u32x4*)(Ab2 + aoff[i] + ko); }
#pragma unroll
        for (int i = 0; i < BCH; ++i) rb[i] = *(const u32x4*)(Bb + boff[i] + ko);
      }
    }
    __builtin_amdgcn_sched_barrier(0);
    {
      bf16x8 a[4], b[NJ];
#pragma unroll
      for (int m = 0; m < 4; ++m) a[m] = *(const bf16x8*)(Sc + fa + m * 16 * 64 + c1);
#pragma unroll
      for (int n = 0; n < NJ; ++n) b[n] = *(const bf16x8*)(Sc + fb + n * 16 * 64 + c1);
      __builtin_amdgcn_s_setprio(1);
#pragma unroll
      for (int m = 0; m < 4; ++m)
#pragma unroll
        for (int n = 0; n < NJ; ++n) acc[m][n] = __builtin_amdgcn_mfma_f32_16x16x32_bf16(a[m], b[n], acc[m][n], 0, 0, 0);
      __builtin_amdgcn_s_setprio(0);
    }
    __syncthreads();
  }
}

DEV f32x4 thin16(const u16* __restrict__ A, int lda, int row0, const u16* __restrict__ BT, int ldb, int col0, int K, int lane) {
  const u16* ap = A + (size_t)(row0 + (lane & 15)) * lda + 8 * (lane >> 4);
  const u16* bp = BT + (size_t)(col0 + (lane & 15)) * ldb + 8 * (lane >> 4);
  f32x4 acc = {0.f, 0.f, 0.f, 0.f};
  for (int k0 = 0; k0 < K; k0 += 128) {
    bf16x8 a[4], b[4];
#pragma unroll
    for (int j = 0; j < 4; ++j) { a[j] = *(const bf16x8*)(ap + k0 + j * 32); b[j] = *(const bf16x8*)(bp + k0 + j * 32); }
#pragma unroll
    for (int j = 0; j < 4; ++j) acc = __builtin_amdgcn_mfma_f32_16x16x32_bf16(a[j], b[j], acc, 0, 0, 0);
  }
  return acc;
}

DEV int tile_index(int k) { const int G = gridDim.x, rb = get_rbid(); return k * G + (rb & 7) * (G >> 3) + (rb >> 3); }
DEV void tile_decode(int T, int MT, int NT, int& mt, int& nt) {
  const int per = MT * 8;
  const int nb = T / per, rem = T - nb * per;
  int width = NT - nb * 8; width = width > 8 ? 8 : width;
  mt = rem / width; nt = nb * 8 + (rem - mt * width);
}

#define ZERO_ACC(acc, NJ_) _Pragma("unroll") for (int m_ = 0; m_ < 4; ++m_) _Pragma("unroll") for (int n_ = 0; n_ < NJ_; ++n_) { acc[m_][n_][0] = 0.f; acc[m_][n_][1] = 0.f; acc[m_][n_][2] = 0.f; acc[m_][n_][3] = 0.f; }

constexpr int EPI_WAVE_BYTES = 17408;
#define EPI_FENCE() asm volatile("s_waitcnt lgkmcnt(0)" ::: "memory")
DEV void epi_store_bf16_128(const u16* reg, u16* __restrict__ dst, int ld, int trow, int col0, int lane) {
#pragma unroll
  for (int j = 0; j < 16; ++j) {
    const int row = (lane >> 4) + 4 * j, t = trow + row;
    const u32x4 v = *(const u32x4*)(reg + row * 136 + (lane & 15) * 8);
    if (t < L) *(u32x4*)(dst + (size_t)t * ld + col0 + (lane & 15) * 8) = v;
  }
}

DEV void phase_inproj8(const Params& p, int b, char* smem) {
  const u16* U = (const u16*)((char*)p.out + OUT_HALF);
  const u16* WT = (const u16*)(p.ws + OFF_S1);
  const int MT = 33, NT = 53;
  for (int kk = 0;; ++kk) {
    const int it = tile_index(kk);
    if (it >= MT * NT) break;
    int mt, nt; tile_decode(it, MT, NT, mt, nt);
    f32x4 acc[4][8];
    ZERO_ACC(acc, 8)
    gemm_tile8<8>(acc, U, 1024, mt * 256, L - 1, WT, 1024, nt * 256, 1024, smem);
    const int tid = get_tid8(), lane = tid & 63, w = tid >> 6, wm = w >> 1, wn = w & 1, r = lane & 31, h = lane >> 5;
    u16* reg = (u16*)(smem + w * EPI_WAVE_BYTES);
    const int n0 = nt * 256;
    const int trow = mt * 256 + wm * 64;
    if (nt >= 20 && nt < 28) {
      const bool isk = nt >= 24;
      const int cq = n0 - (isk ? 6144 : 5120);
      const float sc = isk ? 0.0625f : 1.f;
      u16* dst = (u16*)(p.ws + (isk ? OFF_K : OFF_Q));
#pragma unroll
      for (int pr = 0; pr < 4; ++pr) {
        const int n1 = 4 * (pr >> 1) + (pr & 1);
        const int jf = (wn * 2 + (pr >> 1)) * 32 + (pr & 1) * 16 + (lane & 15);
        const float invf_rev = exp2f(-(float)jf * 0.10462765653f) * 0.15915494309189535f;
#pragma unroll
        for (int m = 0; m < 4; ++m)
#pragma unroll
          for (int j = 0; j < 4; ++j) {
            const int row = m * 16 + (lane >> 4) * 4 + j;
            const float tf = (float)(trow + row);
            const float ph = tf * invf_rev, pl = fmaf(tf, invf_rev, -ph);
            const float fr = (ph - floorf(ph)) + pl;
            const float sn = __builtin_amdgcn_sinf(fr), cs = __builtin_amdgcn_cosf(fr);
            const float x1 = acc[m][n1][j], x2 = acc[m][n1 + 2][j];
            reg[row * 136 + n1 * 16 + (lane & 15)] = f2bf((x1 * cs - x2 * sn) * sc);
            reg[row * 136 + n1 * 16 + 32 + (lane & 15)] = f2bf((x2 * cs + x1 * sn) * sc);
          }
      }
      EPI_FENCE();
      epi_store_bf16_128(reg, dst, 1024, trow, cq + wn * 128, lane);
    } else if (nt == 52) {
      float* DT = (float*)(p.ws + OFF_DT);
      if (wn == 0) {
#pragma unroll
        for (int n = 0; n < 2; ++n) {
          const int col = n * 16 + (lane & 15);
          const float bias = p.in[6][col];
#pragma unroll
          for (int m = 0; m < 4; ++m)
#pragma unroll
            for (int j = 0; j < 4; ++j) {
              const int t = trow + m * 16 + (lane >> 4) * 4 + j;
              if (t < L) {
                const float x = acc[m][n][j] + bias;
                const float e = __expf(x);
                DT[(size_t)t * 32 + col] = (x > 20.f) ? x : (e < 0.01f ? e * (1.f - 0.5f * e + e * e * (1.f / 3.f)) : __logf(1.f + e));
              }
            }
        }
      }
    } else {
      u16* dst; int ld, c0; bool sig = false;
      if (nt < 8) { dst = (u16*)(p.ws + OFF_Z); ld = 2048; c0 = n0; }
      else if (nt < 20) { dst = (u16*)(p.ws + OFF_XBC); ld = 3072; c0 = n0 - 2048; }
      else if (nt < 36) { dst = (u16*)(p.ws + OFF_V); ld = 2048; c0 = n0 - 7168; }
      else if (nt < 44) { dst = (u16*)(p.ws + OFF_G); ld = 2048; c0 = n0 - 9216; }
      else if (nt < 48) { dst = (u16*)(p.ws + OFF_GS); ld = 1024; c0 = n0 - 11264; sig = true; }
      else { dst = (u16*)(p.ws + OFF_GR); ld = 1024; c0 = n0 - 12288; sig = true; }
#pragma unroll
      for (int m = 0; m < 4; ++m)
#pragma unroll
        for (int n = 0; n < 8; ++n)
#pragma unroll
          for (int j = 0; j < 4; ++j) {
            float v = acc[m][n][j];
            if (sig) v = sigmoid_f(v);
            reg[(m * 16 + (lane >> 4) * 4 + j) * 136 + n * 16 + (lane & 15)] = f2bf(v);
          }
      EPI_FENCE();
      epi_store_bf16_128(reg, dst, ld, trow, c0 + wn * 128, lane);
    }
    __syncthreads();
  }
}

DEV void phase_merge8(const Params& p, char* smem, char* smem_team) {
  u16* GS = (u16*)(p.ws + OFF_GS);
  u16* GR = (u16*)(p.ws + OFF_GR);
  const u16* Zb = (const u16*)(p.ws + OFF_Z);
  const u16* Gb = (const u16*)(p.ws + OFF_G);
  const u16* WBS = (const u16*)(p.ws + OFF_S2);
  const u16* WBR = (const u16*)(p.ws + OFF_S2 + 4194304);
  for (int kk = 0;; ++kk) {
    const int it = tile_index(kk);
    if (it >= 256) break;
    const int branch = it >> 7, tl = it & 127, mt = tl >> 2, nt = tl & 3;
    f32x4 acc[4][8];
    ZERO_ACC(acc, 8)
    gemm_tile8<8>(acc, branch ? Gb : Zb, 2048, mt * 256, L - 1, branch ? WBR : WBS, 2048, nt * 256, 2048, smem);
    const int tid = get_tid8(), lane = tid & 63, w = tid >> 6, wm = w >> 1, wn = w & 1;
    float* reg = (float*)(smem + w * EPI_WAVE_BYTES);
    u16* GT = branch ? GR : GS;
#pragma unroll
    for (int hf = 0; hf < 2; ++hf) {
#pragma unroll
      for (int m = 0; m < 4; ++m)
#pragma unroll
        for (int n = 0; n < 4; ++n)
#pragma unroll
          for (int j = 0; j < 4; ++j) reg[(m * 16 + (lane >> 4) * 4 + j) * 68 + n * 16 + (lane & 15)] = acc[m][hf * 4 + n][j];
      EPI_FENCE();
#pragma unroll
      for (int j = 0; j < 16; ++j) {
        const int row = (lane >> 4) + 4 * j, c4 = (lane & 15) * 4;
        const f32x4 a = *(const f32x4*)(reg + row * 68 + c4);
        const size_t idx = (size_t)(mt * 256 + wm * 64 + row) * 1024 + nt * 256 + wn * 128 + hf * 64 + c4;
        const u32x2 g = *(const u32x2*)(GT + idx);
        u32x2 o; o[0] = pack2(lo_f(g[0]) * a[0], hi_f(g[0]) * a[1]); o[1] = pack2(lo_f(g[1]) * a[2], hi_f(g[1]) * a[3]);
        *(u32x2*)(GT + idx) = o;
      }
      EPI_FENCE();
    }
    __syncthreads();
  }
  for (int ct = get_rbid(); ct < 128; ct += gridDim.x) {
    const int tid = get_tid8(), lane = tid & 63, w = tid >> 6;
    const int branch = ct >> 6, c16 = ct & 63;
    f32x4* red = (f32x4*)smem;
    red[w * 64 + lane] = thin16((branch ? Gb : Zb) + w * 256, 2048, 8192, (branch ? WBR : WBS) + w * 256, 2048, c16 * 16, 256, lane);
    __syncthreads();
    if (w == 0) {
      u16* GT = branch ? GR : GS;
      f32x4 a1 = red[lane];
#pragma unroll
      for (int q = 1; q < 8; ++q) a1 += red[q * 64 + lane];
#pragma unroll
      for (int j = 0; j < 4; ++j) {
        const size_t idx = (size_t)(8192 + (lane >> 4) * 4 + j) * 1024 + c16 * 16 + (lane & 15);
        GT[idx] = f2bf(bf2f(GT[idx]) * a1[j]);
      }
    }
    __syncthreads();
  }
  {
    float* RSS = (float*)(p.ws + OFF_RSS);
    for (int i = get_bid() * 256 + get_tid(); i < L; i += nworkers() * 256) RSS[i] = 0.f;
  }
  const int n_wout = 16 * 16, n_wup = 16 * 88, n_wdown = 44 * 16;
  for (int it = get_bid(); it < n_wout + n_wup + n_wdown; it += nworkers()) {
    if (it < n_wout) { convert_tile(p.in[12], 1024, 1024, (u16*)(p.ws + OFF_WOUT), it & 15, it >> 4, 0, smem_team); }
    else if (it < n_wout + n_wup) { const int j = it - n_wout; convert_tile(p.in[14], 5632, 1024, (u16*)(p.ws + OFF_WUP), j & 15, j >> 4, 2, smem_team, p.in[13]);   }
    else { const int j = it - n_wout - n_wup; convert_tile(p.in[17], 1024, 2816, (u16*)(p.ws + OFF_WDOWN), j % 44, j / 44, 0, smem_team); }
  }
}

DEV void phase_outproj8(const Params& p, int b, char* smem) {
  const int tid = get_tid8(), lane = tid & 63, w = tid >> 6, wm = w >> 1, wn = w & 1, r = lane & 31, h = lane >> 5;
  u16* U2 = (u16*)(p.ws + OFF_U2);
  float* RSS = (float*)(p.ws + OFF_RSS);
  const u16* Mg = (const u16*)(p.ws + OFF_GS);
  const u16* WO = (const u16*)(p.ws + OFF_WOUT);
  float* reg = (float*)(smem + w * EPI_WAVE_BYTES);
  for (int kk = 0;; ++kk) {
    const int it = tile_index(kk);
    if (it >= 256) break;
    const int mt = it >> 3, nt = it & 7;
    f32x4 acc[4][4];
    ZERO_ACC(acc, 4)
    gemm_tile8<4, true>(acc, Mg, 1024, mt * 256, L - 1, WO, 1024, nt * 128, 1024, smem, (const u16*)(p.ws + OFF_GR));
#pragma unroll
    for (int m = 0; m < 4; ++m)
#pragma unroll
      for (int n = 0; n < 4; ++n)
#pragma unroll
        for (int j = 0; j < 4; ++j) reg[(m * 16 + (lane >> 4) * 4 + j) * 68 + n * 16 + (lane & 15)] = acc[m][n][j];
    EPI_FENCE();
#pragma unroll
    for (int j = 0; j < 16; ++j) {
      const int row = (lane >> 4) + 4 * j, c4 = (lane & 15) * 4;
      const f32x4 a = *(const f32x4*)(reg + row * 68 + c4);
      const int t = mt * 256 + wm * 64 + row, col = nt * 128 + wn * 64 + c4;
      f32x4 hv;
      if (t < NMETA) {
        hv = *(const f32x4*)(p.in[1] + t * 1024 + col) + a;
      } else {
        const size_t idx = ((size_t)b * SEQ + (t - NMETA)) * 1024 + col;
        hv = *(const f32x4*)(p.in[0] + idx) + a;
        *(f32x4*)(p.out + idx) = hv;
      }
      u32x2 hb; hb[0] = pack2(hv[0], hv[1]); hb[1] = pack2(hv[2], hv[3]);
      *(u32x2*)(U2 + (size_t)t * 1024 + col) = hb;
      float sq = hv[0] * hv[0] + hv[1] * hv[1] + hv[2] * hv[2] + hv[3] * hv[3];
      sq += __shfl_xor(sq, 1); sq += __shfl_xor(sq, 2); sq += __shfl_xor(sq, 4); sq += __shfl_xor(sq, 8);
      if ((lane & 15) == 0) atomicAdd(&RSS[t], sq);
    }
    __syncthreads();
  }
  for (int ct = get_rbid(); ct < 64; ct += gridDim.x) {
    const int tid = get_tid8(), lane = tid & 63, w = tid >> 6;
    f32x4* red = (f32x4*)smem;
    red[w * 64 + lane] = thin16(Mg + w * 128, 1024, 8192, WO + w * 128, 1024, ct * 16, 128, lane)
                       + thin16((const u16*)(p.ws + OFF_GR) + w * 128, 1024, 8192, WO + w * 128, 1024, ct * 16, 128, lane);
    __syncthreads();
    if (w == 0) {
      f32x4 a1 = red[lane];
#pragma unroll
      for (int q = 1; q < 8; ++q) a1 += red[q * 64 + lane];
#pragma unroll
      for (int j = 0; j < 4; ++j) {
        const int t = 8192 + (lane >> 4) * 4 + j;
        const size_t idx = ((size_t)b * SEQ + (t - NMETA)) * 1024 + ct * 16 + (lane & 15);
        const float hv = p.in[0][idx] + a1[j];
        p.out[idx] = hv;
        U2[(size_t)t * 1024 + ct * 16 + (lane & 15)] = f2bf(hv);
        float sq = hv * hv;
        sq += __shfl_xor(sq, 1); sq += __shfl_xor(sq, 2); sq += __shfl_xor(sq, 4); sq += __shfl_xor(sq, 8);
        if ((lane & 15) == 0) atomicAdd(&RSS[t], sq);
      }
    }
    __syncthreads();
  }
}

DEV void phase_up8(const Params& p, char* smem) {
  u16* ACT = (u16*)(p.ws + OFF_ACT);
  const float* cw = p.in[15];
  const float* cbias = p.in[16];
  for (int kk = 0;; ++kk) {
    const int it = tile_index(kk);
    if (it >= 33 * 22) break;
    int mt, nt; tile_decode(it, 33, 22, mt, nt);
    f32x4 acc[4][8];
    ZERO_ACC(acc, 8)
    gemm_tile8<8>(acc, (const u16*)(p.ws + OFF_U2), 1024, mt * 254 - 2, L - 1, (const u16*)(p.ws + OFF_WUP), 1024, nt * 256, 1024, smem);
    const int tid = get_tid8(), lane = tid & 63, w = tid >> 6;
    u16* reg = (u16*)(smem + w * EPI_WAVE_BYTES);
    {
      const float* RSS = (const float*)(p.ws + OFF_RSS);
      const int wm = w >> 1;
#pragma unroll
      for (int m = 0; m < 4; ++m)
#pragma unroll
        for (int j = 0; j < 4; ++j) {
          int t = mt * 254 - 2 + wm * 64 + m * 16 + (lane >> 4) * 4 + j; t = t < 0 ? 0 : (t > L - 1 ? L - 1 : t);
          const float rstd = rsqrtf(RSS[t] * (1.f / 1024.f) + EPS);
#pragma unroll
          for (int n = 0; n < 8; ++n) reg[(m * 16 + (lane >> 4) * 4 + j) * 136 + n * 16 + (lane & 15)] = f2bf(acc[m][n][j] * rstd);
        }
    }
    __syncthreads();
    {
      const int cg = tid & 15, rg = tid >> 4;
      const int ch = nt * 128 + cg * 8;
      float wg[3][8], wv[3][8], bg[8], bv[8], g2[8], g1[8], v2[8], v1[8];
#pragma unroll
      for (int k = 0; k < 3; ++k) {
        const f32x4 a0 = *(const f32x4*)(cw + k * 5632 + ch), a1 = *(const f32x4*)(cw + k * 5632 + ch + 4);
        const f32x4 c0 = *(const f32x4*)(cw + k * 5632 + 2816 + ch), c1 = *(const f32x4*)(cw + k * 5632 + 2816 + ch + 4);
#pragma unroll
        for (int j = 0; j < 4; ++j) { wg[k][j] = a0[j]; wg[k][4 + j] = a1[j]; wv[k][j] = c0[j]; wv[k][4 + j] = c1[j]; }
      }
      {
        const f32x4 a0 = *(const f32x4*)(cbias + ch), a1 = *(const f32x4*)(cbias + ch + 4);
        const f32x4 c0 = *(const f32x4*)(cbias + 2816 + ch), c1 = *(const f32x4*)(cbias + 2816 + ch + 4);
#pragma unroll
        for (int j = 0; j < 4; ++j) { bg[j] = a0[j]; bg[4 + j] = a1[j]; bv[j] = c0[j]; bv[4 + j] = c1[j]; }
      }
      const int R0 = rg * 8;
#pragma unroll
      for (int q = 0; q < 2; ++q) {
        const int R = R0 - 2 + q;
        u32x4 gvv = {0u, 0u, 0u, 0u}, vvv = {0u, 0u, 0u, 0u};
        if (R >= 0 && mt * 254 - 2 + R >= 0) {
          const char* sl = smem + ((R >> 6) * 2) * EPI_WAVE_BYTES + ((R & 63) * 136 + cg * 8) * 2;
          gvv = *(const u32x4*)sl; vvv = *(const u32x4*)(sl + EPI_WAVE_BYTES);
        }
#pragma unroll
        for (int j = 0; j < 4; ++j) {
          if (q == 0) { g2[2 * j] = lo_f(gvv[j]); g2[2 * j + 1] = hi_f(gvv[j]); v2[2 * j] = lo_f(vvv[j]); v2[2 * j + 1] = hi_f(vvv[j]); }
          else { g1[2 * j] = lo_f(gvv[j]); g1[2 * j + 1] = hi_f(gvv[j]); v1[2 * j] = lo_f(vvv[j]); v1[2 * j + 1] = hi_f(vvv[j]); }
        }
      }
#pragma unroll 2
      for (int i = 0; i < 8; ++i) {
        const int R = R0 + i, t = mt * 254 - 2 + R;
        u32x4 gvv = {0u, 0u, 0u, 0u}, vvv = {0u, 0u, 0u, 0u};
        if (t >= 0) {
          const char* sl = smem + ((R >> 6) * 2) * EPI_WAVE_BYTES + ((R & 63) * 136 + cg * 8) * 2;
          gvv = *(const u32x4*)sl; vvv = *(const u32x4*)(sl + EPI_WAVE_BYTES);
        }
        float o[8];
#pragma unroll
        for (int j = 0; j < 8; ++j) {
          const float gx = (j & 1) ? hi_f(gvv[j >> 1]) : lo_f(gvv[j >> 1]);
          const float vx = (j & 1) ? hi_f(vvv[j >> 1]) : lo_f(vvv[j >> 1]);
          const float ag = bg[j] + wg[0][j] * g2[j] + wg[1][j] * g1[j] + wg[2][j] * gx;
          const float av = bv[j] + wv[0][j] * v2[j] + wv[1][j] * v1[j] + wv[2][j] * vx;
          o[j] = silu_f(ag) * av;
          g2[j] = g1[j]; g1[j] = gx; v2[j] = v1[j]; v1[j] = vx;
        }
        if (R >= 2 && t < L) {
          u32x4 pk; pk[0] = pack2(o[0], o[1]); pk[1] = pack2(o[2], o[3]); pk[2] = pack2(o[4], o[5]); pk[3] = pack2(o[6], o[7]);
          *(u32x4*)(ACT + (size_t)t * 2816 + ch) = pk;
        }
      }
    }
    __syncthreads();
  }
}

DEV void phase_down8(const Params& p, int b, char* smem) {
  for (int kk = 0;; ++kk) {
    const int it = tile_index(kk);
    if (it >= 256) break;
    const int mt = it >> 3, nt = it & 7;
    f32x4 acc[4][4];
    ZERO_ACC(acc, 4)
    gemm_tile8<4>(acc, (const u16*)(p.ws + OFF_ACT), 2816, NMETA + mt * 256, L - 1, (const u16*)(p.ws + OFF_WDOWN), 2816, nt * 128, 2816, smem);
    const int tid = get_tid8(), lane = tid & 63, w = tid >> 6, wm = w >> 1, wn = w & 1, r = lane & 31, h = lane >> 5;
    float* reg = (float*)(smem + w * EPI_WAVE_BYTES);
#pragma unroll
    for (int m = 0; m < 4; ++m)
#pragma unroll
      for (int n = 0; n < 4; ++n)
#pragma unroll
        for (int j = 0; j < 4; ++j) reg[(m * 16 + (lane >> 4) * 4 + j) * 68 + n * 16 + (lane & 15)] = acc[m][n][j];
    EPI_FENCE();
#pragma unroll
    for (int j = 0; j < 16; ++j) {
      const int row = (lane >> 4) + 4 * j, c4 = (lane & 15) * 4;
      const f32x4 a = *(const f32x4*)(reg + row * 68 + c4);
      const size_t idx = ((size_t)b * SEQ + mt * 256 + wm * 64 + row) * 1024 + nt * 128 + wn * 64 + c4;
      const f32x4 x = *(const f32x4*)(p.out + idx);
      *(f32x4*)(p.out + idx) = x + a;
    }
    __syncthreads();
  }
}

#define XB_TMO      128
#define XB_XCNT(j)  (256  + 64 * (j))
#define XB_XSUB(j)  (1280 + 64 * (j))
#define XB_XGEN(j)  (2304 + 64 * (j))
#define XB_TOP      3328
#define XB_TOPGEN   3392
#define XCD_BAR_WORDS 3456
#define XB_SPIN_CAP (1u << 24)
DEV unsigned xb_ld(unsigned* p)              { return __hip_atomic_load(p, __ATOMIC_RELAXED, __HIP_MEMORY_SCOPE_AGENT); }
DEV unsigned xb_add(unsigned* p, unsigned v) { return __hip_atomic_fetch_add(p, v, __ATOMIC_RELAXED, __HIP_MEMORY_SCOPE_AGENT); }
DEV unsigned xb_xcc_id() { return (unsigned)__builtin_amdgcn_s_getreg((3 << 11) | 20) & 0xFu; }
#define XB_SPIN(cond, bar) do { unsigned _sp = 0; while (cond) { __builtin_amdgcn_s_sleep(1); \
    if ((++_sp & 255u) == 0u) { if (xb_ld(&(bar)[XB_TMO])) break; if (_sp > XB_SPIN_CAP) { atomicAdd(&(bar)[XB_TMO], 1u); break; } } } } while (0)
struct XcdBarrier { unsigned* bar; unsigned x; volatile LDSP unsigned* st; };
DEV XcdBarrier xcd_barrier_post(unsigned* bar, volatile LDSP unsigned* st) {
  XcdBarrier b; b.bar = bar; b.x = xb_xcc_id(); b.st = st;
  if (threadIdx.x == 0) (void)xb_add(&bar[XB_XCNT(b.x)], 1u);
  return b;
}
DEV void xcd_barrier_complete(unsigned* bar, unsigned x, unsigned& nloc, unsigned& nx) {
  const unsigned G = gridDim.x * gridDim.y * gridDim.z;
  unsigned sum, cnt, mine, sp = 0u;
  for (;;) {
    sum = 0u; cnt = 0u; mine = 0u;
#pragma unroll
    for (unsigned j = 0; j < 16; ++j) { const unsigned c = xb_ld(&bar[XB_XCNT(j)]); sum += c; cnt += (c > 0u) ? 1u : 0u; mine = (j == x) ? c : mine; }
    if (sum == G) break;
    __builtin_amdgcn_s_sleep(1);
    if ((++sp & 255u) == 0u) { if (xb_ld(&bar[XB_TMO])) break; if (sp > XB_SPIN_CAP) { atomicAdd(&bar[XB_TMO], 1u); break; } }
  }
  nloc = mine > 0u ? mine : 1u; nx = cnt > 0u ? cnt : 1u;
}
DEV void xcd_barrier(const XcdBarrier& b) {
  asm volatile("s_waitcnt vmcnt(0)" ::: "memory");
  __syncthreads();
  if (threadIdx.x == 0) {
    unsigned* bar = b.bar;
    __builtin_amdgcn_s_waitcnt(0);
    unsigned nloc = b.st[0], nx = b.st[1];
    if (nloc == 0u) { xcd_barrier_complete(bar, b.x, nloc, nx); b.st[0] = nloc; b.st[1] = nx; }
    const unsigned old = xb_add(&bar[XB_XSUB(b.x)], 1u);
    const unsigned gen = old / nloc;
    if (old + 1u == (gen + 1u) * nloc) {
      __builtin_amdgcn_fence(__ATOMIC_RELEASE, "agent");
      asm volatile("s_waitcnt vmcnt(0)" ::: "memory");
      const unsigned og = xb_add(&bar[XB_TOP], 1u);
      const unsigned tg = og / nx;
      if (og + 1u == (tg + 1u) * nx) xb_add(&bar[XB_TOPGEN], 1u);
      else XB_SPIN(xb_ld(&bar[XB_TOPGEN]) == tg, bar);
      __builtin_amdgcn_fence(__ATOMIC_ACQUIRE, "agent");
      xb_add(&bar[XB_XGEN(b.x)], 1u);
      asm volatile("s_waitcnt vmcnt(0)" ::: "memory");
    } else {
      XB_SPIN(xb_ld(&bar[XB_XGEN(b.x)]) == gen, bar);
      __builtin_amdgcn_fence(__ATOMIC_ACQUIRE, "agent");
      asm volatile("s_waitcnt vmcnt(0)" ::: "memory");
    }
  }
  __syncthreads();
}

constexpr int N_PHASES = 19;

__global__ void __launch_bounds__(512) fwd_kernel(Params p, int ph0, int ph1) {
  __shared__ __attribute__((aligned(16))) char smem[SMEM_BYTES];
  __shared__ uint4 xb_words;
  if (threadIdx.x == 0) xb_words = make_uint4(0u, 0u, 0u, 0u);
  __syncthreads();
  XcdBarrier xb = xcd_barrier_post((unsigned*)(p.ws + OFF_BAR), (volatile LDSP unsigned*)&xb_words);
  if (ph1 < 0) cg::this_grid().sync();
  for (int ph = ph0; ph < ph1; ++ph) {
    char* tsm = smem + (get_tid8() >> 8) * SMEM_TEAM;
    const int b = ph >= 10 ? 1 : 0;
    const int lp = (ph == 0) ? 0 : (ph == 18 ? 9 : (ph >= 10 ? ph - 9 : ph));
    switch (lp) {
      case 0: phase_prep(p, 0, true, tsm); break;
      case 1: phase_inproj8(p, b, smem); break;
      case 2: {
        int it = get_bid();
        for (; it < 1024; it += nworkers()) ret_kv_item(p, it, tsm);
        for (; it < 2048; it += nworkers()) ssd_state_item(p, it - 1024, tsm);
      } break;
      case 3: phase_scan(p); break;
      case 4: {
        {
          const int rb = get_rbid(), team = get_tid8() >> 8;
          for (int j = 0; j < 3; ++j) {
            int kind = -1, idx = 0;
            if (rb < 4) {
              const int q = rb * 3 + j;
              const int rt = (q < 2) ? 128 : ((q >> 1) - 1) * 4;
              kind = 0; idx = rt * 4 + (q & 1) * 2 + team;
            } else if (rb < 10) {
              if (j < 2) { kind = 1; idx = (246 + (rb - 4) * 2 + j) * 2 + team; }
            } else if (j < 2) {
              const int k = rb - 10, ri = k >> 1;
              const int rt = (ri < 12) ? ((ri / 3) * 4 + 1 + ri % 3) : (17 + ri - 12);
              kind = j; idx = (j == 0) ? (rt * 4 + (k & 1) * 2 + team) : (k * 2 + team);
            }
            if (kind == 0) ret_out_item(p, idx, tsm);
            else if (kind == 1) ssd_out_item(p, idx, tsm);
          }
        }
      } break;
      case 5: phase_merge8(p, smem, tsm); break;
      case 6: phase_outproj8(p, b, smem); break;
      case 7: phase_up8(p, smem); break;
      case 8: phase_down8(p, b, smem); break;
      case 9: {
        if (ph == 9) { phase_final_norm(p, 0); phase_prep(p, 1, false, tsm); }
        else phase_final_norm(p, 1);
      } break;
    }
    if (ph + 1 < ph1) xcd_barrier(xb);
  }
}

#ifndef MK_SINGLE
#define MK_SINGLE 1
#endif

extern "C" void kernel_launch(void* const* d_in, const int* in_sizes, int n_in, void* d_out, int out_size, void* d_ws, size_t ws_size,
                              hipStream_t stream) {
  static int grid_blocks = 0;
  if (!grid_blocks) {
    int dev = 0, cus = 0, per_cu = 0;
    hipGetDevice(&dev);
    hipDeviceGetAttribute(&cus, hipDeviceAttributeMultiprocessorCount, dev);
    hipOccupancyMaxActiveBlocksPerMultiprocessor(&per_cu, fwd_kernel, 512, 0);
    per_cu = 1;
    if (cus != 256) fprintf(stderr, "kernel_launch: built for a 256-CU device (static phase schedules assume 256 workgroups), found %d CUs\n", cus);
    cus = 256;
    grid_blocks = cus * per_cu;
  }
  Params p{};
  for (int i = 0; i < 19; ++i) p.in[i] = (const float*)d_in[i];
  p.out = (float*)d_out;
  p.ws = (char*)d_ws;
#if MK_SINGLE
  (void)hipMemsetAsync((char*)d_ws + OFF_BAR, 0, XCD_BAR_WORDS * 4, stream);
  int ph0 = 0, ph1 = N_PHASES;
  void* args[] = {&p, &ph0, &ph1};
  hipError_t e = hipLaunchCooperativeKernel((void*)fwd_kernel, dim3(grid_blocks), dim3(512), args, 0, stream);
  if (e != hipSuccess) fprintf(stderr, "cooperative launch failed: %s (grid %d)\n", hipGetErrorString(e), grid_blocks);
#else
  for (int ph = 0; ph < N_PHASES; ++ph) {
    hipLaunchKernelGGL(fwd_kernel, dim3(grid_blocks), dim3(512), 0, stream, p, ph, ph + 1);
  }
#endif
}
```

```cpp
#include <hip/hip_runtime.h>
#include <hip/hip_cooperative_groups.h>
#include <cstdio>
namespace cg = cooperative_groups;

typedef unsigned short u16;
typedef __bf16 bf16x8 __attribute__((ext_vector_type(8)));
typedef short s16x4 __attribute__((ext_vector_type(4)));
typedef short s16x8 __attribute__((ext_vector_type(8)));
typedef float f32x16 __attribute__((ext_vector_type(16)));
typedef unsigned int u32x4 __attribute__((ext_vector_type(4)));
typedef unsigned int u32x2 __attribute__((ext_vector_type(2)));
typedef float f32x4 __attribute__((ext_vector_type(4)));

#define DEV __device__ __forceinline__
#define LDSP __attribute__((address_space(3)))

constexpr int D = 1024;
constexpr int L = 8208;
constexpr int SEQ = 8192;
constexpr int NMETA = 16;
constexpr int NPROJ = 13344;
constexpr int NPROJ_PAD = 13568;
constexpr int DFF = 2816;
constexpr float EPS = 1e-6f;

constexpr size_t OFF_Z = 0;
constexpr size_t OFF_G = 33619968;
constexpr size_t OFF_GS = 67239936;
constexpr size_t OFF_GR = 84049920;
constexpr size_t OFF_Q = 100859904;
constexpr size_t OFF_XBC = 117669888;
constexpr size_t OFF_K = 168099840;
constexpr size_t OFF_V = 184909824;
constexpr size_t OFF_DT = 218529792;
constexpr size_t OFF_S2 = 219580416;
constexpr size_t OFF_S1 = 227969024;
constexpr size_t OFF_CD = 261523456;
constexpr size_t OFF_HM = 261531648;
constexpr size_t OFF_BAR = 261597184;
constexpr size_t OFF_RSS = 261611520;
constexpr size_t OFF_WOUT = OFF_S1;
constexpr size_t OFF_WUP = OFF_S1 + 2097152;
constexpr size_t OFF_WDOWN = OFF_S1 + 13631488;
constexpr size_t OFF_UP = OFF_XBC;
constexpr size_t OFF_ACT = OFF_Z;
constexpr size_t OFF_U2 = OFF_Q;
constexpr size_t OUT_HALF = 33554432;

constexpr int SMEM_TEAM = 73728;
constexpr int SMEM_BYTES = 2 * SMEM_TEAM;

struct Params {
  const float* in[19];
  float* out;
  char* ws;
};

DEV int get_tid8() { int t = threadIdx.x; asm volatile("" : "+v"(t)); return t; }
DEV int get_tid() { int t = threadIdx.x & 255; asm volatile("" : "+v"(t)); return t; }
DEV int get_rbid() { int t = blockIdx.x; asm volatile("" : "+s"(t)); return t; }
DEV int get_bid() { int t = get_rbid() * 2 + (get_tid8() >> 8); return __builtin_amdgcn_readfirstlane(t); }
DEV int nworkers() { return (int)gridDim.x * 2; }
DEV float bf2f(u16 h) { return __uint_as_float(((unsigned)h) << 16); }
DEV u16 f2bf(float f) { unsigned u = __float_as_uint(f); u += 0x7fffu + ((u >> 16) & 1u); return (u16)(u >> 16); }
DEV unsigned pack2(float a, float b) { return (unsigned)f2bf(a) | ((unsigned)f2bf(b) << 16); }
DEV float silu_f(float x) { return x / (1.f + __expf(-x)); }
DEV float sigmoid_f(float x) { return 1.f / (1.f + __expf(-x)); }
DEV float lo_f(unsigned u) { return __uint_as_float(u << 16); }
DEV float hi_f(unsigned u) { return __uint_as_float(u & 0xffff0000u); }
DEV float wave_sum(float v) {
#pragma unroll
  for (int o = 32; o > 0; o >>= 1) v += __shfl_xor(v, o);
  return v;
}
DEV float half_sum(float v) {
#pragma unroll
  for (int o = 16; o > 0; o >>= 1) v += __shfl_xor(v, o);
  return v;
}
DEV float log_gamma(int h) {
  return h == 0 ? -0.0317486983145803f : (h == 1 ? -0.015748356968139168f : (h == 2 ? -0.007843177461025893f : -0.003913899321136329f));
}
DEV f32x16 mfma(bf16x8 a, bf16x8 b, f32x16 c) { return __builtin_amdgcn_mfma_f32_32x32x16_bf16(a, b, c, 0, 0, 0); }
DEV f32x16 zero16() { f32x16 z;
#pragma unroll
  for (int i = 0; i < 16; ++i) z[i] = 0.f;
  return z; }
DEV int acc_row(int i, int h) { return (i & 3) + 8 * (i >> 2) + 4 * h; }

DEV bf16x8 frag_tr(const u16* T, int ld, int k0, int x0, int lane) {
  const int h = lane >> 5, blk = (lane >> 4) & 1, q = (lane & 15) >> 2, pp = lane & 3;
  const u16* a0 = T + (k0 + 8 * h + q) * ld + x0 + 16 * blk + 4 * pp;
  s16x4 lo = __builtin_amdgcn_ds_read_tr16_b64_v4i16((LDSP s16x4*)a0);
  s16x4 hi = __builtin_amdgcn_ds_read_tr16_b64_v4i16((LDSP s16x4*)(a0 + 4 * ld));
  s16x8 v = {lo[0], lo[1], lo[2], lo[3], hi[0], hi[1], hi[2], hi[3]};
  return __builtin_bit_cast(bf16x8, v);
}
DEV bf16x8 frag_row(const u16* T, int ld, int row, int k) {
  return *(const bf16x8*)(T + row * ld + k);
}

template <int MI>
DEV void gemm_tile(f32x16 (&acc)[MI][2], const u16* __restrict__ A, int lda, int arow0, int arow_max,
                   const u16* __restrict__ B, int ldb, int brow0, int K, char* smem) {
  constexpr int BM = MI * 64;
  constexpr int LD = 72;
  constexpr int ACH = BM * 8 / 256;
  u16* As = (u16*)smem;
  u16* Bs = As + BM * LD;
  const int tid = get_tid(), lane = tid & 63, w = tid >> 6, wm = w >> 1, wn = w & 1, r = lane & 31, h = lane >> 5;
  u32x4 ra[ACH], rb[4];
  const u16* ap[ACH];
  const u16* bp[4];
#pragma unroll
  for (int i = 0; i < ACH; ++i) {
    int c = tid + i * 256, row = c >> 3, kc = c & 7;
    int gr = arow0 + row; gr = gr > arow_max ? arow_max : gr;
    ap[i] = A + (size_t)gr * lda + kc * 8;
  }
#pragma unroll
  for (int i = 0; i < 4; ++i) {
    int c = tid + i * 256, row = c >> 3, kc = c & 7;
    bp[i] = B + (size_t)(brow0 + row) * ldb + kc * 8;
  }
#pragma unroll
  for (int i = 0; i < ACH; ++i) ra[i] = *(const u32x4*)(ap[i]);
#pragma unroll
  for (int i = 0; i < 4; ++i) rb[i] = *(const u32x4*)(bp[i]);
  const int nk = K >> 6;
  for (int kt = 0; kt < nk; ++kt) {
#pragma unroll
    for (int i = 0; i < ACH; ++i) { int c = tid + i * 256, row = c >> 3, kc = c & 7; *(u32x4*)(As + row * LD + kc * 8) = ra[i]; }
#pragma unroll
    for (int i = 0; i < 4; ++i) { int c = tid + i * 256, row = c >> 3, kc = c & 7; *(u32x4*)(Bs + row * LD + kc * 8) = rb[i]; }
    __syncthreads();
    if (kt + 1 < nk) {
#pragma unroll
      for (int i = 0; i < ACH; ++i) ra[i] = *(const u32x4*)(ap[i] + (kt + 1) * 64);
#pragma unroll
      for (int i = 0; i < 4; ++i) rb[i] = *(const u32x4*)(bp[i] + (kt + 1) * 64);
    }
#pragma unroll
    for (int ks = 0; ks < 4; ++ks) {
      bf16x8 a[MI], b[2];
#pragma unroll
      for (int mi = 0; mi < MI; ++mi) a[mi] = frag_row(As, LD, wm * MI * 32 + mi * 32 + r, ks * 16 + h * 8);
#pragma unroll
      for (int ni = 0; ni < 2; ++ni) b[ni] = frag_row(Bs, LD, wn * 64 + ni * 32 + r, ks * 16 + h * 8);
#pragma unroll
      for (int mi = 0; mi < MI; ++mi)
#pragma unroll
        for (int ni = 0; ni < 2; ++ni) acc[mi][ni] = mfma(a[mi], b[ni], acc[mi][ni]);
    }
    __syncthreads();
  }
}

DEV int orig_col(int n) {
  if (n < 5120) return n;
  if (n < 7168) {
    int q = n - 5120; int which = q >> 10; int c = q & 1023; int head = c >> 8; int ip = c & 255; int blk = ip >> 6; int wi = ip & 63;
    int j = (wi < 32) ? (blk * 32 + wi) : (128 + blk * 32 + wi - 32);
    return 5152 + which * 1024 + head * 256 + j;
  }
  if (n < 13312) return n + 32;
  if (n < 13344) return 5120 + (n - 13312);
  return -1;
}
DEV void convert_tile(const float* __restrict__ W, int Nsrc, int K, u16* __restrict__ WT, int kt, int ntile, int mode, char* smem, const float* __restrict__ kscale = nullptr) {
  float* t = (float*)smem;
  const int tid = get_tid();
  {
    const int tx = tid & 15, ty = tid >> 4;
    const int n = ntile * 64 + tx * 4;
    int on = n;
    if (mode == 1) on = orig_col(n);
    else if (mode == 2) { const int tl = n >> 8, wi = n & 255; on = (wi < 128) ? (tl * 128 + wi) : (2816 + tl * 128 + wi - 128); }
#pragma unroll
    for (int kk = ty; kk < 64; kk += 16) {
      f32x4 v = {0.f, 0.f, 0.f, 0.f};
      if (on >= 0) v = *(const f32x4*)(W + (size_t)(kt * 64 + kk) * Nsrc + on);
      if (kscale) v = v * kscale[kt * 64 + kk];
      *(f32x4*)(t + kk * 68 + tx * 4) = v;
    }
  }
  __syncthreads();
  {
    const int nn = tid >> 2, kq = (tid & 3) * 16;
    u32x4 o[2];
#pragma unroll
    for (int j = 0; j < 8; ++j) o[j >> 2][j & 3] = pack2(t[(kq + 2 * j) * 68 + nn], t[(kq + 2 * j + 1) * 68 + nn]);
    u16* d = WT + (size_t)(ntile * 64 + nn) * K + kt * 64 + kq;
    *(u32x4*)d = o[0]; *(u32x4*)(d + 8) = o[1];
  }
  __syncthreads();
}

DEV void rmsnorm_row_bf16(const float* __restrict__ src, const float* __restrict__ w, u16* __restrict__ dst, int lane) {
  f32x4 v[4]; float ss = 0.f;
#pragma unroll
  for (int j = 0; j < 4; ++j) { v[j] = *(const f32x4*)(src + j * 256 + lane * 4); ss += v[j][0] * v[j][0] + v[j][1] * v[j][1] + v[j][2] * v[j][2] + v[j][3] * v[j][3]; }
  ss = wave_sum(ss);
  const float rstd = rsqrtf(ss * (1.f / 1024.f) + EPS);
#pragma unroll
  for (int j = 0; j < 4; ++j) {
    f32x4 ww = *(const f32x4*)(w + j * 256 + lane * 4);
    u32x2 o; o[0] = pack2(v[j][0] * rstd * ww[0], v[j][1] * rstd * ww[1]); o[1] = pack2(v[j][2] * rstd * ww[2], v[j][3] * rstd * ww[3]);
    *(u32x2*)(dst + j * 256 + lane * 4) = o;
  }
}
DEV void rmsnorm_row_f32_inplace(float* __restrict__ row, const float* __restrict__ w, int lane) {
  f32x4 v[4]; float ss = 0.f;
#pragma unroll
  for (int j = 0; j < 4; ++j) { v[j] = *(const f32x4*)(row + j * 256 + lane * 4); ss += v[j][0] * v[j][0] + v[j][1] * v[j][1] + v[j][2] * v[j][2] + v[j][3] * v[j][3]; }
  ss = wave_sum(ss);
  const float rstd = rsqrtf(ss * (1.f / 1024.f) + EPS);
#pragma unroll
  for (int j = 0; j < 4; ++j) {
    f32x4 ww = *(const f32x4*)(w + j * 256 + lane * 4);
    f32x4 o; o[0] = v[j][0] * rstd * ww[0]; o[1] = v[j][1] * rstd * ww[1]; o[2] = v[j][2] * rstd * ww[2]; o[3] = v[j][3] * rstd * ww[3];
    *(f32x4*)(row + j * 256 + lane * 4) = o;
  }
}

template <int R, int C, bool SCALE>
DEV void stage_conv(u16* dst, int ld, const u16* __restrict__ xbc, int row0, int ch0, const float* __restrict__ cw, const float* __restrict__ cb, const float* rs) {
  constexpr int CG = C / 8, RG = 256 / CG, RPT = R / RG;
  const int tid = get_tid();
  const int cgi = tid % CG, rgi = tid / CG;
  const int ch = ch0 + cgi * 8, r0 = rgi * RPT;
  float w[4][8], bias[8], xw[3][8];
#pragma unroll
  for (int k = 0; k < 4; ++k) {
    f32x4 a = *(const f32x4*)(cw + k * 3072 + ch), b = *(const f32x4*)(cw + k * 3072 + ch + 4);
#pragma unroll
    for (int j = 0; j < 4; ++j) { w[k][j] = a[j]; w[k][4 + j] = b[j]; }
  }
  {
    f32x4 a = *(const f32x4*)(cb + ch), b = *(const f32x4*)(cb + ch + 4);
#pragma unroll
    for (int j = 0; j < 4; ++j) { bias[j] = a[j]; bias[4 + j] = b[j]; }
  }
#pragma unroll
  for (int k = 0; k < 3; ++k) {
    const int tr = row0 + r0 - 3 + k;
    u32x4 v = {0u, 0u, 0u, 0u};
    if (tr >= 0 && tr < L) v = *(const u32x4*)(xbc + (size_t)tr * 3072 + ch);
#pragma unroll
    for (int j = 0; j < 4; ++j) { xw[k][2 * j] = lo_f(v[j]); xw[k][2 * j + 1] = hi_f(v[j]); }
  }
#pragma unroll
  for (int i = 0; i < RPT; ++i) {
    const int tr = row0 + r0 + i;
    const bool valid = tr < L;
    u32x4 v = {0u, 0u, 0u, 0u};
    if (valid) v = *(const u32x4*)(xbc + (size_t)tr * 3072 + ch);
    float xc[8], o[8];
#pragma unroll
    for (int j = 0; j < 4; ++j) { xc[2 * j] = lo_f(v[j]); xc[2 * j + 1] = hi_f(v[j]); }
    float sc = 1.f;
    if (SCALE) sc = rs[(cgi >> 3) * 128 + r0 + i];
#pragma unroll
    for (int j = 0; j < 8; ++j) {
      float a = bias[j] + w[0][j] * xw[0][j] + w[1][j] * xw[1][j] + w[2][j] * xw[2][j] + w[3][j] * xc[j];
      a = silu_f(a) * sc;
      o[j] = valid ? a : 0.f;
      xw[0][j] = xw[1][j]; xw[1][j] = xw[2][j]; xw[2][j] = xc[j];
    }
    u32x4 pk; pk[0] = pack2(o[0], o[1]); pk[1] = pack2(o[2], o[3]); pk[2] = pack2(o[4], o[5]); pk[3] = pack2(o[6], o[7]);
    *(u32x4*)(dst + (r0 + i) * ld + cgi * 8) = pk;
  }
}

DEV float chunk_cumsum(const float* __restrict__ DT, int c, int H, float A, float* acs, float* dts, int lane) {
  const int s0 = 2 * lane;
  const int t0 = c * 128 + s0;
  const float d0 = (t0 < L) ? DT[(size_t)t0 * 32 + H] : 0.f;
  const float d1 = (t0 + 1 < L) ? DT[(size_t)(t0 + 1) * 32 + H] : 0.f;
  const float a0 = d0 * A, a1 = a0 + d1 * A;
  float tot = a1;
#pragma unroll
  for (int o = 1; o < 64; o <<= 1) { float n = __shfl_up(tot, o); if (lane >= o) tot += n; }
  const float excl = tot - a1;
  acs[s0] = excl + a0; acs[s0 + 1] = excl + a1;
  dts[s0] = d0; dts[s0 + 1] = d1;
  return __shfl(tot, 63);
}

DEV void phase_prep(const Params& p, int b, bool first, char* smem) {
  const int tid = get_tid(), lane = tid & 63, w = tid >> 6;
  u16* U = (u16*)((char*)p.out + OUT_HALF);
  const int n_norm = L / 4;
  const int n_win = 16 * (NPROJ_PAD / 64);
  const int n_wb = first ? 2 * 32 * 16 : 0;
  const int total = n_norm + n_win + n_wb;
  for (int it = get_bid(); it < total; it += nworkers()) {
    if (it < n_norm) {
      const int t = it * 4 + w;
      const float* src = (t < NMETA) ? (p.in[1] + (size_t)t * D) : (p.in[0] + ((size_t)b * SEQ + (t - NMETA)) * D);
      rmsnorm_row_bf16(src, p.in[2], U + (size_t)t * D, lane);
    } else if (it < n_norm + n_win) {
      const int j = it - n_norm; const int ntile = j >> 4, kt = j & 15;
      convert_tile(p.in[3], NPROJ, 1024, (u16*)(p.ws + OFF_S1), kt, ntile, 1, smem);
    } else {
      int j = it - n_norm - n_win; const int which = j >> 9; j &= 511; const int ntile = j >> 5, kt = j & 31;
      convert_tile(p.in[10 + which], 1024, 2048, (u16*)(p.ws + OFF_S2 + (size_t)which * 4194304), kt, ntile, 0, smem);
    }
  }
}

DEV void phase_inproj(const Params& p, int b, char* smem) {
  const int tid = get_tid(), lane = tid & 63, w = tid >> 6, wm = w >> 1, wn = w & 1, r = lane & 31, h = lane >> 5;
  const u16* U = (const u16*)((char*)p.out + OUT_HALF);
  const u16* WT = (const u16*)(p.ws + OFF_S1);
  const int MT = 65, NT = 105;
  for (int it = get_bid(); it < MT * NT; it += gridDim.x) {
    const int nt = it / MT, mt = it % MT;
    f32x16 acc[2][2];
#pragma unroll
    for (int mi = 0; mi < 2; ++mi)
#pragma unroll
      for (int ni = 0; ni < 2; ++ni) acc[mi][ni] = zero16();
    gemm_tile<2>(acc, U, 1024, mt * 128, L - 1, WT, 1024, nt * 128, 1024, smem);
    const int n0 = nt * 128;
    if (nt >= 40 && nt < 56) {
      const bool isk = nt >= 48;
      const int cq = n0 - (isk ? 6144 : 5120);
      const int blk = ((cq & 255) >> 6) + wn;
      const int jf = blk * 32 + r;
      const double invf_rev = exp(-(double)jf * 0.07252236513367073) * 0.15915494309189535;
      const float sc = isk ? 0.0625f : 1.f;
      u16* dst = (u16*)(p.ws + (isk ? OFF_K : OFF_Q));
#pragma unroll
      for (int mi = 0; mi < 2; ++mi)
#pragma unroll
        for (int i = 0; i < 16; ++i) {
          const int t = mt * 128 + wm * 64 + mi * 32 + acc_row(i, h);
          if (t < L) {
            double rev = (double)t * invf_rev;
            rev -= floor(rev);
            const float fr = (float)rev;
            const float sn = __builtin_amdgcn_sinf(fr), cs = __builtin_amdgcn_cosf(fr);
            const float x1 = acc[mi][0][i], x2 = acc[mi][1][i];
            const float o1 = (x1 * cs - x2 * sn) * sc, o2 = (x2 * cs + x1 * sn) * sc;
            u16* d = dst + (size_t)t * 1024 + cq + wn * 64 + r;
            d[0] = f2bf(o1); d[32] = f2bf(o2);
          }
        }
    } else if (nt == 104) {
      float* DT = (float*)(p.ws + OFF_DT);
      if (wn == 0) {
        const float bias = p.in[6][r];
#pragma unroll
        for (int mi = 0; mi < 2; ++mi)
#pragma unroll
          for (int i = 0; i < 16; ++i) {
            const int t = mt * 128 + wm * 64 + mi * 32 + acc_row(i, h);
            if (t < L) {
              const float x = acc[mi][0][i] + bias;
              const float e = __expf(x);
              DT[(size_t)t * 32 + r] = (x > 20.f) ? x : (e < 0.01f ? e * (1.f - 0.5f * e + e * e * (1.f / 3.f)) : __logf(1.f + e));
            }
          }
      }
    } else {
      u16* dst; int ld, c0; bool sig = false;
      if (nt < 16) { dst = (u16*)(p.ws + OFF_Z); ld = 2048; c0 = n0; }
      else if (nt < 40) { dst = (u16*)(p.ws + OFF_XBC); ld = 3072; c0 = n0 - 2048; }
      else if (nt < 72) { dst = (u16*)(p.ws + OFF_V); ld = 2048; c0 = n0 - 7168; }
      else if (nt < 88) { dst = (u16*)(p.ws + OFF_G); ld = 2048; c0 = n0 - 9216; }
      else if (nt < 96) { dst = (u16*)(p.ws + OFF_GS); ld = 1024; c0 = n0 - 11264; sig = true; }
      else { dst = (u16*)(p.ws + OFF_GR); ld = 1024; c0 = n0 - 12288; sig = true; }
#pragma unroll
      for (int mi = 0; mi < 2; ++mi)
#pragma unroll
        for (int ni = 0; ni < 2; ++ni)
#pragma unroll
          for (int i = 0; i < 16; ++i) {
            const int t = mt * 128 + wm * 64 + mi * 32 + acc_row(i, h);
            if (t < L) {
              float v = acc[mi][ni][i];
              if (sig) v = sigmoid_f(v);
              dst[(size_t)t * ld + c0 + wn * 64 + ni * 32 + r] = f2bf(v);
            }
          }
    }
  }
}

DEV void ssd_state_item(const Params& p, int it, char* smem) {
  const int tid = get_tid(), lane = tid & 63, w = tid >> 6, wm = w >> 1, wn = w & 1, r = lane & 31, h = lane >> 5;
  const int c = it >> 4, hp = it & 15, H0 = hp * 2, g = H0 >> 3;
  u16* Xw = (u16*)smem;
  u16* Bc = Xw + 128 * 136;
  float* wsc = (float*)(Bc + 128 * 136);
  float* tmp = wsc + 256;
  const float* DT = (const float*)(p.ws + OFF_DT);
  float* CD = (float*)(p.ws + OFF_CD);
  const u16* XBC = (const u16*)(p.ws + OFF_XBC);
  if (w < 2) {
    const int H = H0 + w;
    const float A = -expf(p.in[7][H]);
    float* acs = tmp + w * 128;
    float* dts = wsc + w * 128;
    const float aend = chunk_cumsum(DT, c, H, A, acs, dts, lane);
    const int s0 = 2 * lane;
    const float w0 = __expf(aend - acs[s0]) * dts[s0], w1 = __expf(aend - acs[s0 + 1]) * dts[s0 + 1];
    dts[s0] = w0; dts[s0 + 1] = w1;
    if (lane == 0) CD[c * 32 + H] = __expf(aend);
  }
  __syncthreads();
  stage_conv<128, 128, true>(Xw, 136, XBC, c * 128, H0 * 64, p.in[4], p.in[5], wsc);
  stage_conv<128, 128, false>(Bc, 136, XBC, c * 128, 2048 + g * 128, p.in[4], p.in[5], nullptr);
  __syncthreads();
  f32x16 acc[2][2];
#pragma unroll
  for (int mi = 0; mi < 2; ++mi)
#pragma unroll
    for (int ni = 0; ni < 2; ++ni) acc[mi][ni] = zero16();
#pragma unroll
  for (int ks = 0; ks < 8; ++ks) {
    bf16x8 a[2], bq[2];
#pragma unroll
    for (int mi = 0; mi < 2; ++mi) a[mi] = frag_tr(Xw, 136, ks * 16, wm * 64 + mi * 32, lane);
#pragma unroll
    for (int ni = 0; ni < 2; ++ni) bq[ni] = frag_tr(Bc, 136, ks * 16, wn * 64 + ni * 32, lane);
#pragma unroll
    for (int mi = 0; mi < 2; ++mi)
#pragma unroll
      for (int ni = 0; ni < 2; ++ni) acc[mi][ni] = mfma(a[mi], bq[ni], acc[mi][ni]);
  }
  u16* ST = (u16*)(p.ws + OFF_S1) + (size_t)(c * 32 + H0) * 8192;
  __syncthreads();
#pragma unroll
  for (int mi = 0; mi < 2; ++mi)
#pragma unroll
    for (int ni = 0; ni < 2; ++ni)
#pragma unroll
      for (int i = 0; i < 16; ++i) Xw[(wm * 64 + mi * 32 + acc_row(i, h)) * 136 + wn * 64 + ni * 32 + r] = f2bf(acc[mi][ni][i]);
  asm volatile("s_waitcnt lgkmcnt(0)" ::: "memory");
#pragma unroll
  for (int j = 0; j < 8; ++j) {
    const int m = wm * 64 + (lane >> 3) + 8 * j, n = wn * 64 + (lane & 7) * 8;
    *(u32x4*)(ST + m * 128 + n) = *(const u32x4*)(Xw + m * 136 + n);
  }
  __syncthreads();
}

DEV void ret_kv_item(const Params& p, int it, char* smem) {
  const int tid = get_tid(), lane = tid & 63, w = tid >> 6, wm = w >> 1, wn = w & 1, r = lane & 31, h = lane >> 5;
  const int sc = it >> 5, rem = it & 31, hd = rem >> 3, dt2 = (rem >> 2) & 1, et = rem & 3;
  u16* Vt = (u16*)smem;
  u16* Kt = Vt + 128 * 136;
  const u16* Vg = (const u16*)(p.ws + OFF_V);
  const u16* Kg = (const u16*)(p.ws + OFF_K);
  const float lg = log_gamma(hd);
  f32x16 acc[2][2];
#pragma unroll
  for (int mi = 0; mi < 2; ++mi)
#pragma unroll
    for (int ni = 0; ni < 2; ++ni) acc[mi][ni] = zero16();
  for (int half = 0; half < 2; ++half) {
#pragma unroll
    for (int i = 0; i < 8; ++i) {
      const int cidx = tid + i * 256, row = cidx >> 4, cc = cidx & 15;
      const int tok = sc * 256 + half * 128 + row;
      u32x4 v = *(const u32x4*)(Vg + (size_t)tok * 2048 + hd * 512 + et * 128 + cc * 8);
      *(u32x4*)(Vt + row * 136 + cc * 8) = v;
      u32x4 kk = *(const u32x4*)(Kg + (size_t)tok * 1024 + hd * 256 + dt2 * 128 + cc * 8);
      const float dec = __expf((float)(255 - (half * 128 + row)) * lg);
      u32x4 ko;
#pragma unroll
      for (int j = 0; j < 4; ++j) ko[j] = pack2(lo_f(kk[j]) * dec, hi_f(kk[j]) * dec);
      *(u32x4*)(Kt + row * 136 + cc * 8) = ko;
    }
    __syncthreads();
#pragma unroll
    for (int ks = 0; ks < 8; ++ks) {
      bf16x8 a[2], bq[2];
#pragma unroll
      for (int mi = 0; mi < 2; ++mi) a[mi] = frag_tr(Vt, 136, ks * 16, wm * 64 + mi * 32, lane);
#pragma unroll
      for (int ni = 0; ni < 2; ++ni) bq[ni] = frag_tr(Kt, 136, ks * 16, wn * 64 + ni * 32, lane);
#pragma unroll
      for (int mi = 0; mi < 2; ++mi)
#pragma unroll
        for (int ni = 0; ni < 2; ++ni) acc[mi][ni] = mfma(a[mi], bq[ni], acc[mi][ni]);
    }
    __syncthreads();
  }
  u16* RST = (u16*)((char*)p.out + OUT_HALF) + ((size_t)(sc * 4 + hd) * 512 + et * 128) * 256 + dt2 * 128;
#pragma unroll
  for (int mi = 0; mi < 2; ++mi)
#pragma unroll
    for (int ni = 0; ni < 2; ++ni)
#pragma unroll
      for (int i = 0; i < 16; ++i) Vt[(wm * 64 + mi * 32 + acc_row(i, h)) * 136 + wn * 64 + ni * 32 + r] = f2bf(acc[mi][ni][i]);
  asm volatile("s_waitcnt lgkmcnt(0)" ::: "memory");
#pragma unroll
  for (int j = 0; j < 8; ++j) {
    const int e = wm * 64 + (lane >> 3) + 8 * j, d = wn * 64 + (lane & 7) * 8;
    *(u32x4*)(RST + (size_t)e * 256 + d) = *(const u32x4*)(Vt + e * 136 + d);
  }
  __syncthreads();
}

DEV void phase_scan(const Params& p) {
  const int gt = get_bid() * 256 + get_tid(), nth = nworkers() * 256;
  const float* CD = (const float*)(p.ws + OFF_CD);
  for (int v = gt; v < 32768 + 65536; v += nth) {
    float st[8];
#pragma unroll
    for (int j = 0; j < 8; ++j) st[j] = 0.f;
    if (v < 32768) {
      const int e0 = v * 8, H = e0 >> 13;
      u16* base = (u16*)(p.ws + OFF_S1) + e0;
      for (int c0 = 0; c0 < 64; c0 += 4) {
        u32x4 x[4];
#pragma unroll
        for (int u = 0; u < 4; ++u) x[u] = *(const u32x4*)(base + (size_t)(c0 + u) * 262144);
#pragma unroll
        for (int u = 0; u < 4; ++u) {
          const float dcy = CD[(c0 + u) * 32 + H];
          u32x4 o;
#pragma unroll
          for (int j = 0; j < 4; ++j) {
            st[2 * j] = st[2 * j] * dcy + lo_f(x[u][j]);
            st[2 * j + 1] = st[2 * j + 1] * dcy + hi_f(x[u][j]);
            o[j] = pack2(st[2 * j], st[2 * j + 1]);
          }
          *(u32x4*)(base + (size_t)(c0 + u) * 262144) = o;
        }
      }
    } else {
      const int e0 = (v - 32768) * 8, hd = e0 >> 17;
      const float g256 = __expf(256.f * log_gamma(hd));
      u16* base = (u16*)((char*)p.out + OUT_HALF) + e0;
      for (int c0 = 0; c0 < 32; c0 += 4) {
        u32x4 x[4];
#pragma unroll
        for (int u = 0; u < 4; ++u) x[u] = *(const u32x4*)(base + (size_t)(c0 + u) * 524288);
#pragma unroll
        for (int u = 0; u < 4; ++u) {
          u32x4 o;
#pragma unroll
          for (int j = 0; j < 4; ++j) {
            st[2 * j] = st[2 * j] * g256 + lo_f(x[u][j]);
            st[2 * j + 1] = st[2 * j + 1] * g256 + hi_f(x[u][j]);
            o[j] = pack2(st[2 * j], st[2 * j + 1]);
          }
          *(u32x4*)(base + (size_t)(c0 + u) * 524288) = o;
        }
      }
    }
  }
}

DEV void ssd_out_item(const Params& p, int it, char* smem) {
  const int tid = get_tid(), lane = tid & 63, w = tid >> 6, wm = w >> 1, wn = w & 1, r = lane & 31, h = lane >> 5;
  const int c = it >> 3, rem = it & 7, g = rem & 3, lh = rem >> 2;
  if (c == 64 && lh == 1) return;
  u16* Ct = (u16*)smem;
  u16* Bt = Ct + 64 * 136;
  u16* Lt = Bt;
  u16* Xt = Bt + 128 * 136;
  float* acs = (float*)(Xt + 128 * 72);
  float* dts = acs + 128;
  float* rowsq = dts + 128;
  const u16* XBC = (const u16*)(p.ws + OFF_XBC);
  const float* DT = (const float*)(p.ws + OFF_DT);
  u16* Z = (u16*)(p.ws + OFF_Z);
  const int tok0 = c * 128;
  stage_conv<64, 128, false>(Ct, 136, XBC, tok0 + lh * 64, 2560 + g * 128, p.in[4], p.in[5], nullptr);
  stage_conv<128, 128, false>(Bt, 136, XBC, tok0, 2048 + g * 128, p.in[4], p.in[5], nullptr);
  if (tid < 64) rowsq[tid] = 0.f;
  __syncthreads();
  f32x16 cb[2];
  cb[0] = zero16(); cb[1] = zero16();
#pragma unroll
  for (int ks = 0; ks < 8; ++ks) {
    bf16x8 a = frag_row(Ct, 136, wm * 32 + r, ks * 16 + h * 8);
#pragma unroll
    for (int ni = 0; ni < 2; ++ni) {
      bf16x8 bq = frag_row(Bt, 136, wn * 64 + ni * 32 + r, ks * 16 + h * 8);
      cb[ni] = mfma(a, bq, cb[ni]);
    }
  }
  for (int hh = 0; hh < 8; ++hh) {
    const int H = g * 8 + hh;
    u32x4 zv[2];
    {
      int tz = tok0 + lh * 64 + (tid >> 2); tz = tz < L ? tz : L - 1;
      const u16* zp0 = Z + (size_t)tz * 2048 + H * 64 + (tid & 3) * 16;
      zv[0] = *(const u32x4*)zp0; zv[1] = *(const u32x4*)(zp0 + 8);
    }
    __syncthreads();
    if (w == 0) {
      const float A = -expf(p.in[7][H]);
      chunk_cumsum(DT, c, H, A, acs, dts, lane);
    }
    stage_conv<128, 64, false>(Xt, 72, XBC, tok0, H * 64, p.in[4], p.in[5], nullptr);
    __syncthreads();
#pragma unroll
    for (int ni = 0; ni < 2; ++ni)
#pragma unroll
      for (int i = 0; i < 16; ++i) {
        const int ll = wm * 32 + acc_row(i, h), l = lh * 64 + ll, s = wn * 64 + ni * 32 + r;
        float val = 0.f;
        if (s <= l) val = cb[ni][i] * __expf(acs[l] - acs[s]) * dts[s];
        Lt[ll * 136 + s] = f2bf(val);
      }
    f32x16 y = zero16();
    if (c > 0) {
      const u16* pv = (const u16*)(p.ws + OFF_S1) + ((size_t)((c - 1) * 32 + H) * 64 + wn * 32 + r) * 128 + h * 8;
#pragma unroll
      for (int ks = 0; ks < 8; ++ks) {
        bf16x8 a = frag_row(Ct, 136, wm * 32 + r, ks * 16 + h * 8);
        bf16x8 bq = *(const bf16x8*)(pv + ks * 16);
        y = mfma(a, bq, y);
      }
#pragma unroll
      for (int i = 0; i < 16; ++i) { const int l = lh * 64 + wm * 32 + acc_row(i, h); y[i] *= __expf(acs[l]); }
    }
    __syncthreads();
#pragma unroll
    for (int ks = 0; ks < 8; ++ks) {
      bf16x8 a = frag_row(Lt, 136, wm * 32 + r, ks * 16 + h * 8);
      bf16x8 bq = frag_tr(Xt, 72, ks * 16, wn * 32, lane);
      y = mfma(a, bq, y);
    }
    const float Dsk = p.in[8][H];
    float* Ys = (float*)(Bt + 64 * 136);
#pragma unroll
    for (int i = 0; i < 16; ++i) Ys[(wm * 32 + acc_row(i, h)) * 68 + wn * 32 + r] = y[i];
    __syncthreads();
    {
      const int row = tid >> 2, q = tid & 3, l = lh * 64 + row, t = tok0 + l;
      float sq = 0.f;
      if (t < L) {
        u16* zp = Z + (size_t)t * 2048 + H * 64 + q * 16;
        u32x4 xv[2], ov[2];
        xv[0] = *(const u32x4*)(Xt + l * 72 + q * 16); xv[1] = *(const u32x4*)(Xt + l * 72 + q * 16 + 8);
#pragma unroll
        for (int k = 0; k < 2; ++k) {
          const f32x4 ya = *(const f32x4*)(Ys + row * 68 + q * 16 + k * 8), yb = *(const f32x4*)(Ys + row * 68 + q * 16 + k * 8 + 4);
          float o[8];
#pragma unroll
          for (int j = 0; j < 4; ++j) {
            const float y0 = (j < 2) ? ya[2 * j] : yb[2 * j - 4], y1 = (j < 2) ? ya[2 * j + 1] : yb[2 * j - 3];
            o[2 * j] = (y0 + Dsk * lo_f(xv[k][j])) * silu_f(lo_f(zv[k][j]));
            o[2 * j + 1] = (y1 + Dsk * hi_f(xv[k][j])) * silu_f(hi_f(zv[k][j]));
            sq += o[2 * j] * o[2 * j] + o[2 * j + 1] * o[2 * j + 1];
            ov[k][j] = pack2(o[2 * j], o[2 * j + 1]);
          }
        }
        *(u32x4*)zp = ov[0]; *(u32x4*)(zp + 8) = ov[1];
      }
      sq += __shfl_xor(sq, 1); sq += __shfl_xor(sq, 2);
      if (q == 0) rowsq[row] += sq;
    }
  }
  __syncthreads();
  {
    const int row = tid >> 2, q = tid & 3, t = tok0 + lh * 64 + row;
    if (t < L) {
      const float rn = rsqrtf(rowsq[row] * (1.f / 512.f) + EPS);
      u32x4 v[16];
#pragma unroll
      for (int hh = 0; hh < 8; ++hh) {
        const u16* zp = Z + (size_t)t * 2048 + (g * 8 + hh) * 64 + q * 16;
        v[2 * hh] = *(const u32x4*)zp; v[2 * hh + 1] = *(const u32x4*)(zp + 8);
      }
#pragma unroll
      for (int hh = 0; hh < 8; ++hh) {
        u16* zp = Z + (size_t)t * 2048 + (g * 8 + hh) * 64 + q * 16;
        const float* nwp = p.in[9] + (g * 8 + hh) * 64 + q * 16;
#pragma unroll
        for (int k = 0; k < 2; ++k) {
          const f32x4 wa = *(const f32x4*)(nwp + k * 8), wb = *(const f32x4*)(nwp + k * 8 + 4);
          u32x4 o;
          o[0] = pack2(lo_f(v[2 * hh + k][0]) * rn * wa[0], hi_f(v[2 * hh + k][0]) * rn * wa[1]);
          o[1] = pack2(lo_f(v[2 * hh + k][1]) * rn * wa[2], hi_f(v[2 * hh + k][1]) * rn * wa[3]);
          o[2] = pack2(lo_f(v[2 * hh + k][2]) * rn * wb[0], hi_f(v[2 * hh + k][2]) * rn * wb[1]);
          o[3] = pack2(lo_f(v[2 * hh + k][3]) * rn * wb[2], hi_f(v[2 * hh + k][3]) * rn * wb[3]);
          *(u32x4*)(zp + k * 8) = o;
        }
      }
    }
  }
  __syncthreads();
}

DEV void ret_out_item(const Params& p, int it, char* smem) {
  const int tid = get_tid(), lane = tid & 63, w = tid >> 6, wm = w >> 1, wn = w & 1, r = lane & 31, h = lane >> 5;
  const int rt = it >> 2, hd = it & 3;
  const int t0 = rt * 64, sc = rt >> 2, qtr = rt & 3;
  u16* P = (u16*)smem;
  char* gsm = smem + 33792;
  u16* Vt = (u16*)gsm;
  float* rowsq = (float*)(smem + 33792 + 27648);
  const u16* Qg = (const u16*)(p.ws + OFF_Q) + hd * 256;
  const u16* Kg = (const u16*)(p.ws + OFF_K) + hd * 256;
  const u16* Vg = (const u16*)(p.ws + OFF_V);
  u16* Gg = (u16*)(p.ws + OFF_G);
  const u16* RST = (const u16*)((char*)p.out + OUT_HALF);
  const float lg = log_gamma(hd);
  if (tid < 64) rowsq[tid] = 0.f;
  const int nkb = (qtr >= 2) ? 2 : 1;
  for (int kb = 0; kb < nkb; ++kb) {
    f32x16 acc[1][2];
    acc[0][0] = zero16(); acc[0][1] = zero16();
    gemm_tile<1>(acc, Qg, 1024, t0, L - 1, Kg, 1024, sc * 256 + kb * 128, 256, gsm);
#pragma unroll
    for (int ni = 0; ni < 2; ++ni)
#pragma unroll
      for (int i = 0; i < 16; ++i) {
        const int ll = wm * 32 + acc_row(i, h), lp = qtr * 64 + ll, s = kb * 128 + wn * 64 + ni * 32 + r;
        float val = 0.f;
        if (s <= lp) val = acc[0][ni][i] * __expf((float)(lp - s) * lg);
        P[ll * 264 + s] = f2bf(val);
      }
  }
  float rs[16];
#pragma unroll
  for (int i = 0; i < 16; ++i) rs[i] = 0.f;
  for (int et = 0; et < 4; ++et) {
    f32x16 acc[1][2];
    acc[0][0] = zero16(); acc[0][1] = zero16();
    u32x4 gv[4], vreg[4];
    {
      int tg = t0 + (tid >> 2); tg = tg < L ? tg : L - 1;
      const u16* gp0 = Gg + (size_t)tg * 2048 + hd * 512 + et * 128 + (tid & 3) * 32;
#pragma unroll
      for (int k = 0; k < 4; ++k) gv[k] = *(const u32x4*)(gp0 + k * 8);
#pragma unroll
      for (int i = 0; i < 4; ++i) {
        const int cidx = tid + i * 256, row = cidx >> 4, cc = cidx & 15;
        int tok = sc * 256 + row; tok = tok < L ? tok : L - 1;
        vreg[i] = *(const u32x4*)(Vg + (size_t)tok * 2048 + hd * 512 + et * 128 + cc * 8);
      }
    }
    if (sc > 0) {
      gemm_tile<1>(acc, Qg, 1024, t0, L - 1, RST + ((size_t)((sc - 1) * 4 + hd) * 512 + et * 128) * 256, 256, 0, 256, gsm);
#pragma unroll
      for (int ni = 0; ni < 2; ++ni)
#pragma unroll
        for (int i = 0; i < 16; ++i) {
          const int lp = qtr * 64 + wm * 32 + acc_row(i, h);
          acc[0][ni][i] *= __expf((float)(lp + 1) * lg);
        }
    }
    for (int kb64 = 0; kb64 <= qtr; ++kb64) {
#pragma unroll
      for (int i = 0; i < 4; ++i) {
        const int cidx = tid + i * 256, row = cidx >> 4, cc = cidx & 15;
        const int tok = sc * 256 + kb64 * 64 + row;
        u32x4 v = {0u, 0u, 0u, 0u};
        if (tok < L) v = vreg[i];
        *(u32x4*)(Vt + row * 136 + cc * 8) = v;
      }
      __syncthreads();
      if (kb64 < qtr) {
#pragma unroll
        for (int i = 0; i < 4; ++i) {
          const int cidx = tid + i * 256, row = cidx >> 4, cc = cidx & 15;
          int tok = sc * 256 + (kb64 + 1) * 64 + row; tok = tok < L ? tok : L - 1;
          vreg[i] = *(const u32x4*)(Vg + (size_t)tok * 2048 + hd * 512 + et * 128 + cc * 8);
        }
      }
#pragma unroll
      for (int ks = 0; ks < 4; ++ks) {
        bf16x8 a = frag_row(P, 264, wm * 32 + r, kb64 * 64 + ks * 16 + h * 8);
#pragma unroll
        for (int ni = 0; ni < 2; ++ni) {
          bf16x8 bq = frag_tr(Vt, 136, ks * 16, wn * 64 + ni * 32, lane);
          acc[0][ni] = mfma(a, bq, acc[0][ni]);
        }
      }
      __syncthreads();
    }
    u16* Os = (u16*)gsm;
#pragma unroll
    for (int ni = 0; ni < 2; ++ni)
#pragma unroll
      for (int i = 0; i < 16; ++i) {
        const float o = acc[0][ni][i];
        if (t0 + wm * 32 + acc_row(i, h) < L) rs[i] += o * o;
        Os[(wm * 32 + acc_row(i, h)) * 136 + wn * 64 + ni * 32 + r] = f2bf(o);
      }
    __syncthreads();
    {
      const int row = tid >> 2, q = tid & 3, t = t0 + row;
      if (t < L) {
        u16* gp = Gg + (size_t)t * 2048 + hd * 512 + et * 128 + q * 32;
        u32x4 ov[4];
#pragma unroll
        for (int k = 0; k < 4; ++k) ov[k] = *(const u32x4*)(Os + row * 136 + q * 32 + k * 8);
#pragma unroll
        for (int k = 0; k < 4; ++k) {
          u32x4 o;
#pragma unroll
          for (int j = 0; j < 4; ++j) o[j] = pack2(silu_f(lo_f(gv[k][j])) * lo_f(ov[k][j]), silu_f(hi_f(gv[k][j])) * hi_f(ov[k][j]));
          *(u32x4*)(gp + k * 8) = o;
        }
      }
    }
    __syncthreads();
  }
#pragma unroll
  for (int i = 0; i < 16; ++i) {
    const float v = half_sum(rs[i]);
    if (r == 0) atomicAdd(&rowsq[wm * 32 + acc_row(i, h)], v);
  }
  __syncthreads();
  {
    const int row = tid >> 2, q = tid & 3, t = t0 + row;
    if (t < L) {
      const float rn = rsqrtf(rowsq[row] * (1.f / 512.f) + EPS);
      u32x4 v[16];
#pragma unroll
      for (int et = 0; et < 4; ++et)
#pragma unroll
        for (int k = 0; k < 4; ++k) v[et * 4 + k] = *(const u32x4*)(Gg + (size_t)t * 2048 + hd * 512 + et * 128 + q * 32 + k * 8);
#pragma unroll
      for (int et = 0; et < 4; ++et)
#pragma unroll
        for (int k = 0; k < 4; ++k) {
          u32x4 o;
#pragma unroll
          for (int j = 0; j < 4; ++j) o[j] = pack2(lo_f(v[et * 4 + k][j]) * rn, hi_f(v[et * 4 + k][j]) * rn);
          *(u32x4*)(Gg + (size_t)t * 2048 + hd * 512 + et * 128 + q * 32 + k * 8) = o;
        }
    }
  }
  __syncthreads();
}

DEV void merge_tile(const Params& p, int it, char* smem) {
  const int tid = get_tid(), lane = tid & 63, w = tid >> 6, wm = w >> 1, wn = w & 1, r = lane & 31, h = lane >> 5;
  const int nt = it / 65, mt = it % 65;
  u16* GS = (u16*)(p.ws + OFF_GS);
  const u16* GR = (const u16*)(p.ws + OFF_GR);
  f32x16 acc[2][2];
#pragma unroll
  for (int mi = 0; mi < 2; ++mi)
#pragma unroll
    for (int ni = 0; ni < 2; ++ni) acc[mi][ni] = zero16();
  gemm_tile<2>(acc, (const u16*)(p.ws + OFF_Z), 2048, mt * 128, L - 1, (const u16*)(p.ws + OFF_S2), 2048, nt * 128, 2048, smem);
#pragma unroll
  for (int mi = 0; mi < 2; ++mi)
#pragma unroll
    for (int ni = 0; ni < 2; ++ni)
#pragma unroll
      for (int i = 0; i < 16; ++i) {
        const int t = mt * 128 + wm * 64 + mi * 32 + acc_row(i, h);
        if (t < L) {
          const size_t idx = (size_t)t * 1024 + nt * 128 + wn * 64 + ni * 32 + r;
          GS[idx] = f2bf(bf2f(GS[idx]) * acc[mi][ni][i]);
        }
        acc[mi][ni][i] = 0.f;
      }
  gemm_tile<2>(acc, (const u16*)(p.ws + OFF_G), 2048, mt * 128, L - 1, (const u16*)(p.ws + OFF_S2 + 4194304), 2048, nt * 128, 2048, smem);
#pragma unroll
  for (int mi = 0; mi < 2; ++mi)
#pragma unroll
    for (int ni = 0; ni < 2; ++ni)
#pragma unroll
      for (int i = 0; i < 16; ++i) {
        const int t = mt * 128 + wm * 64 + mi * 32 + acc_row(i, h);
        if (t < L) {
          const size_t idx = (size_t)t * 1024 + nt * 128 + wn * 64 + ni * 32 + r;
          GS[idx] = f2bf(bf2f(GS[idx]) + bf2f(GR[idx]) * acc[mi][ni][i]);
        }
      }
}

DEV void phase_merge(const Params& p, char* smem) {
  const int n_tiles = 65 * 8;
  const int n_wout = 16 * 16, n_wup = 16 * 88, n_wdown = 44 * 16;
  const int total = n_tiles + n_wout + n_wup + n_wdown;
  for (int it = get_bid(); it < total; it += nworkers()) {
    if (it < n_tiles) merge_tile(p, it, smem);
    else if (it < n_tiles + n_wout) { const int j = it - n_tiles; convert_tile(p.in[12], 1024, 1024, (u16*)(p.ws + OFF_WOUT), j & 15, j >> 4, 0, smem); }
    else if (it < n_tiles + n_wout + n_wup) { const int j = it - n_tiles - n_wout; convert_tile(p.in[14], 5632, 1024, (u16*)(p.ws + OFF_WUP), j & 15, j >> 4, 0, smem); }
    else { const int j = it - n_tiles - n_wout - n_wup; convert_tile(p.in[17], 1024, 2816, (u16*)(p.ws + OFF_WDOWN), j % 44, j / 44, 0, smem); }
  }
}

DEV void phase_outproj(const Params& p, int b, char* smem) {
  const int tid = get_tid(), lane = tid & 63, w = tid >> 6, wm = w >> 1, wn = w & 1, r = lane & 31, h = lane >> 5;
  float* HM = (float*)(p.ws + OFF_HM);
  for (int it = get_bid(); it < 65 * 8; it += gridDim.x) {
    const int nt = it / 65, mt = it % 65;
    f32x16 acc[2][2];
#pragma unroll
    for (int mi = 0; mi < 2; ++mi)
#pragma unroll
      for (int ni = 0; ni < 2; ++ni) acc[mi][ni] = zero16();
    gemm_tile<2>(acc, (const u16*)(p.ws + OFF_GS), 1024, mt * 128, L - 1, (const u16*)(p.ws + OFF_WOUT), 1024, nt * 128, 1024, smem);
#pragma unroll
    for (int mi = 0; mi < 2; ++mi)
#pragma unroll
      for (int ni = 0; ni < 2; ++ni)
#pragma unroll
        for (int i = 0; i < 16; ++i) {
          const int t = mt * 128 + wm * 64 + mi * 32 + acc_row(i, h);
          const int col = nt * 128 + wn * 64 + ni * 32 + r;
          if (t < NMETA) HM[t * 1024 + col] = p.in[1][t * 1024 + col] + acc[mi][ni][i];
          else if (t < L) {
            const size_t idx = ((size_t)b * SEQ + (t - NMETA)) * 1024 + col;
            p.out[idx] = p.in[0][idx] + acc[mi][ni][i];
          }
        }
  }
}

DEV void phase_norm2(const Params& p, int b) {
  const int lane = get_tid() & 63, w = get_tid() >> 6;
  u16* U2 = (u16*)(p.ws + OFF_U2);
  for (int it = get_bid(); it < L / 4; it += nworkers()) {
    const int t = it * 4 + w;
    const float* src = (t < NMETA) ? ((const float*)(p.ws + OFF_HM) + (size_t)t * D) : (p.out + ((size_t)b * SEQ + (t - NMETA)) * D);
    rmsnorm_row_bf16(src, p.in[13], U2 + (size_t)t * D, lane);
  }
}

DEV void phase_up(const Params& p, char* smem) {
  const int tid = get_tid(), lane = tid & 63, w = tid >> 6, wm = w >> 1, wn = w & 1, r = lane & 31, h = lane >> 5;
  u16* UP = (u16*)(p.ws + OFF_UP);
  for (int it = get_bid(); it < 65 * 44; it += gridDim.x) {
    const int nt = it / 65, mt = it % 65;
    f32x16 acc[2][2];
#pragma unroll
    for (int mi = 0; mi < 2; ++mi)
#pragma unroll
      for (int ni = 0; ni < 2; ++ni) acc[mi][ni] = zero16();
    gemm_tile<2>(acc, (const u16*)(p.ws + OFF_U2), 1024, mt * 128, L - 1, (const u16*)(p.ws + OFF_WUP), 1024, nt * 128, 1024, smem);
#pragma unroll
    for (int mi = 0; mi < 2; ++mi)
#pragma unroll
      for (int ni = 0; ni < 2; ++ni)
#pragma unroll
        for (int i = 0; i < 16; ++i) {
          const int t = mt * 128 + wm * 64 + mi * 32 + acc_row(i, h);
          if (t < L) UP[(size_t)t * 5632 + nt * 128 + wn * 64 + ni * 32 + r] = f2bf(acc[mi][ni][i]);
        }
  }
}

DEV void phase_ffn_act(const Params& p) {
  const int gt = get_bid() * 256 + get_tid(), nth = nworkers() * 256;
  const u16* UP = (const u16*)(p.ws + OFF_UP);
  u16* ACT = (u16*)(p.ws + OFF_ACT);
  const float* cw = p.in[15];
  const float* cbias = p.in[16];
  for (int u = gt; u < 513 * 352; u += nth) {
    const int rb = u / 352, cgp = u % 352, ch = cgp * 8, t0 = rb * 16;
    float wg[3][8], wv[3][8], bg[8], bv[8], g2[8], g1[8], v2[8], v1[8];
#pragma unroll
    for (int k = 0; k < 3; ++k)
#pragma unroll
      for (int j = 0; j < 8; ++j) { wg[k][j] = cw[k * 5632 + ch + j]; wv[k][j] = cw[k * 5632 + 2816 + ch + j]; }
#pragma unroll
    for (int j = 0; j < 8; ++j) { bg[j] = cbias[ch + j]; bv[j] = cbias[2816 + ch + j]; }
    {
      u32x4 a = {0u, 0u, 0u, 0u}, bq = {0u, 0u, 0u, 0u}, c2 = {0u, 0u, 0u, 0u}, d2 = {0u, 0u, 0u, 0u};
      if (t0 >= 2) {
        a = *(const u32x4*)(UP + (size_t)(t0 - 2) * 5632 + ch); bq = *(const u32x4*)(UP + (size_t)(t0 - 1) * 5632 + ch);
        c2 = *(const u32x4*)(UP + (size_t)(t0 - 2) * 5632 + 2816 + ch); d2 = *(const u32x4*)(UP + (size_t)(t0 - 1) * 5632 + 2816 + ch);
      }
#pragma unroll
      for (int j = 0; j < 4; ++j) {
        g2[2 * j] = lo_f(a[j]); g2[2 * j + 1] = hi_f(a[j]); g1[2 * j] = lo_f(bq[j]); g1[2 * j + 1] = hi_f(bq[j]);
        v2[2 * j] = lo_f(c2[j]); v2[2 * j + 1] = hi_f(c2[j]); v1[2 * j] = lo_f(d2[j]); v1[2 * j + 1] = hi_f(d2[j]);
      }
    }
#pragma unroll 4
    for (int i = 0; i < 16; ++i) {
      const int t = t0 + i;
      const u32x4 a = *(const u32x4*)(UP + (size_t)t * 5632 + ch);
      const u32x4 c2 = *(const u32x4*)(UP + (size_t)t * 5632 + 2816 + ch);
      float o[8];
#pragma unroll
      for (int j = 0; j < 8; ++j) {
        const float gx = (j & 1) ? hi_f(a[j >> 1]) : lo_f(a[j >> 1]);
        const float vx = (j & 1) ? hi_f(c2[j >> 1]) : lo_f(c2[j >> 1]);
        const float ag = bg[j] + wg[0][j] * g2[j] + wg[1][j] * g1[j] + wg[2][j] * gx;
        const float av = bv[j] + wv[0][j] * v2[j] + wv[1][j] * v1[j] + wv[2][j] * vx;
        o[j] = silu_f(ag) * av;
        g2[j] = g1[j]; g1[j] = gx; v2[j] = v1[j]; v1[j] = vx;
      }
      u32x4 pk; pk[0] = pack2(o[0], o[1]); pk[1] = pack2(o[2], o[3]); pk[2] = pack2(o[4], o[5]); pk[3] = pack2(o[6], o[7]);
      *(u32x4*)(ACT + (size_t)t * 2816 + ch) = pk;
    }
  }
}

DEV void phase_down(const Params& p, int b, char* smem) {
  const int tid = get_tid(), lane = tid & 63, w = tid >> 6, wm = w >> 1, wn = w & 1, r = lane & 31, h = lane >> 5;
  for (int it = get_bid(); it < 64 * 8; it += gridDim.x) {
    const int nt = it / 64, mt = it % 64;
    f32x16 acc[2][2];
#pragma unroll
    for (int mi = 0; mi < 2; ++mi)
#pragma unroll
      for (int ni = 0; ni < 2; ++ni) acc[mi][ni] = zero16();
    gemm_tile<2>(acc, (const u16*)(p.ws + OFF_ACT), 2816, NMETA + mt * 128, L - 1, (const u16*)(p.ws + OFF_WDOWN), 2816, nt * 128, 2816, smem);
#pragma unroll
    for (int mi = 0; mi < 2; ++mi)
#pragma unroll
      for (int ni = 0; ni < 2; ++ni)
#pragma unroll
        for (int i = 0; i < 16; ++i) {
          const int rr = mt * 128 + wm * 64 + mi * 32 + acc_row(i, h);
          const size_t idx = ((size_t)b * SEQ + rr) * 1024 + nt * 128 + wn * 64 + ni * 32 + r;
          p.out[idx] += acc[mi][ni][i];
        }
  }
}

DEV void phase_final_norm(const Params& p, int b) {
  const int lane = get_tid() & 63, w = get_tid() >> 6;
  for (int it = get_bid(); it < SEQ / 4; it += nworkers()) {
    const int rr = it * 4 + w;
    rmsnorm_row_f32_inplace(p.out + ((size_t)b * SEQ + rr) * D, p.in[18], lane);
  }
}


DEV u32x4 add_bf16x8(u32x4 a, u32x4 b) {
  u32x4 o;
#pragma unroll
  for (int j = 0; j < 4; ++j) o[j] = pack2(lo_f(a[j]) + lo_f(b[j]), hi_f(a[j]) + hi_f(b[j]));
  return o;
}
template <int NJ, bool ADD2 = false>
DEV void gemm_tile8(f32x4 (&acc)[4][NJ], const u16* __restrict__ A, int lda, int arow0, int arow_max,
                    const u16* __restrict__ B, int ldb, int brow0, int K, char* smem, const u16* __restrict__ A2 = nullptr) {
  constexpr int BN = NJ * 32;
  constexpr int BCH = BN / 64;
  constexpr int STAGE = (256 + BN) * 64;
  u16* S = (u16*)smem;
  const int tid = get_tid8(), lane = tid & 63, w = tid >> 6, wm = w >> 1, wn = w & 1;
  u32x4 ra[4], rb[BCH], ra2[ADD2 ? 4 : 1];
  unsigned aoff[4], boff[BCH];
  const char* Ab = (const char*)A;
  const char* Ab2 = (const char*)A2;
  const char* Bb = (const char*)(B + (size_t)brow0 * ldb);
  const int crow = tid >> 3, kc = tid & 7;
  const unsigned sto = (unsigned)(crow * 64 + ((kc ^ ((crow >> 1) & 7)) * 8));
#pragma unroll
  for (int i = 0; i < 4; ++i) {
    int gr = arow0 + crow + i * 64; gr = gr > arow_max ? arow_max : gr; gr = gr < 0 ? 0 : gr;
    aoff[i] = ((unsigned)gr * (unsigned)lda + kc * 8) * 2u;
  }
#pragma unroll
  for (int i = 0; i < BCH; ++i) boff[i] = ((unsigned)(crow + i * 64) * (unsigned)ldb + kc * 8) * 2u;
  const int fr = lane & 15, swz = fr >> 1, cq = lane >> 4;
  const unsigned fa = (unsigned)((wm * 64 + fr) * 64), fb = (unsigned)((256 + wn * (NJ * 16) + fr) * 64);
  const unsigned c0 = (unsigned)(((cq) ^ swz) * 8), c1 = (unsigned)(((4 + cq) ^ swz) * 8);
  const int nk = K >> 6;
#pragma unroll
  for (int i = 0; i < 4; ++i) { ra[i] = *(const u32x4*)(Ab + aoff[i]); if (ADD2) ra2[i] = *(const u32x4*)(Ab2 + aoff[i]); }
#pragma unroll
  for (int i = 0; i < BCH; ++i) rb[i] = *(const u32x4*)(Bb + boff[i]);
#pragma unroll
  for (int i = 0; i < 4; ++i) *(u32x4*)(S + sto + i * 64 * 64) = ADD2 ? add_bf16x8(ra[i], ra2[i]) : ra[i];
#pragma unroll
  for (int i = 0; i < BCH; ++i) *(u32x4*)(S + sto + (256 + i * 64) * 64) = rb[i];
  if (nk > 1) {
#pragma unroll
    for (int i = 0; i < 4; ++i) { ra[i] = *(const u32x4*)(Ab + aoff[i] + 128); if (ADD2) ra2[i] = *(const u32x4*)(Ab2 + aoff[i] + 128); }
#pragma unroll
    for (int i = 0; i < BCH; ++i) rb[i] = *(const u32x4*)(Bb + boff[i] + 128);
  }
  __syncthreads();
  for (int kt = 0; kt < nk; ++kt) {
    const u16* Sc = S + (kt & 1) * STAGE;
    {
      bf16x8 a[4], b[NJ];
#pragma unroll
      for (int m = 0; m < 4; ++m) a[m] = *(const bf16x8*)(Sc + fa + m * 16 * 64 + c0);
#pragma unroll
      for (int n = 0; n < NJ; ++n) b[n] = *(const bf16x8*)(Sc + fb + n * 16 * 64 + c0);
      __builtin_amdgcn_s_setprio(1);
#pragma unroll
      for (int m = 0; m < 4; ++m)
#pragma unroll
        for (int n = 0; n < NJ; ++n) acc[m][n] = __builtin_amdgcn_mfma_f32_16x16x32_bf16(a[m], b[n], acc[m][n], 0, 0, 0);
      __builtin_amdgcn_s_setprio(0);
    }
    __builtin_amdgcn_sched_barrier(0);
    bf16x8 a1[4], b1[NJ];
#pragma unroll
    for (int m = 0; m < 4; ++m) a1[m] = *(const bf16x8*)(Sc + fa + m * 16 * 64 + c1);
#pragma unroll
    for (int n = 0; n < NJ; ++n) b1[n] = *(const bf16x8*)(Sc + fb + n * 16 * 64 + c1);
    __builtin_amdgcn_sched_barrier(0);
    if (kt + 1 < nk) {
      u16* Aw = S + ((kt + 1) & 1) * STAGE;
#pragma unroll
      for (int i = 0; i < 4; ++i) *(u32x4*)(Aw + sto + i * 64 * 64) = ADD2 ? add_bf16x8(ra[i], ra2[i]) : ra[i];
#pragma unroll
      for (int i = 0; i < BCH; ++i) *(u32x4*)(Aw + sto + (256 + i * 64) * 64) = rb[i];
      if (kt + 2 < nk) {
        const unsigned ko = (unsigned)(kt + 2) * 128u;
#pragma unroll
        for (int i = 0; i < 4; ++i) { ra[i] = *(const u32x4*)(Ab + aoff[i] + ko); if (ADD2) ra2[i] = *(const u32x4*)(Ab2 + aoff[i] + ko); }
#pragma unroll
        for (int i = 0; i < BCH; ++i) rb[i] = *(const u32x4*)(Bb + boff[i] + ko);
      }
    }
    __builtin_amdgcn_sched_barrier(0);
    {
      __builtin_amdgcn_s_setprio(1);
#pragma unroll
      for (int m = 0; m < 4; ++m)
#pragma unroll
        for (int n = 0; n < NJ; ++n) acc[m][n] = __builtin_amdgcn_mfma_f32_16x16x32_bf16(a1[m], b1[n], acc[m][n], 0, 0, 0);
      __builtin_amdgcn_s_setprio(0);
    }
    __syncthreads();
  }
}

DEV f32x4 thin16(const u16* __restrict__ A, int lda, int row0, const u16* __restrict__ BT, int ldb, int col0, int K, int lane) {
  const u16* ap = A + (size_t)(row0 + (lane & 15)) * lda + 8 * (lane >> 4);
  const u16* bp = BT + (size_t)(col0 + (lane & 15)) * ldb + 8 * (lane >> 4);
  f32x4 acc = {0.f, 0.f, 0.f, 0.f};
  for (int k0 = 0; k0 < K; k0 += 128) {
    bf16x8 a[4], b[4];
#pragma unroll
    for (int j = 0; j < 4; ++j) { a[j] = *(const bf16x8*)(ap + k0 + j * 32); b[j] = *(const bf16x8*)(bp + k0 + j * 32); }
#pragma unroll
    for (int j = 0; j < 4; ++j) acc = __builtin_amdgcn_mfma_f32_16x16x32_bf16(a[j], b[j], acc, 0, 0, 0);
  }
  return acc;
}

DEV int tile_index(int k) { const int G = gridDim.x, rb = get_rbid(); return k * G + (rb & 7) * (G >> 3) + (rb >> 3); }
DEV void tile_decode(int T, int MT, int NT, int& mt, int& nt) {
  const int per = MT * 8;
  const int nb = T / per, rem = T - nb * per;
  int width = NT - nb * 8; width = width > 8 ? 8 : width;
  mt = rem / width; nt = nb * 8 + (rem - mt * width);
}

#define ZERO_ACC(acc, NJ_) _Pragma("unroll") for (int m_ = 0; m_ < 4; ++m_) _Pragma("unroll") for (int n_ = 0; n_ < NJ_; ++n_) { acc[m_][n_][0] = 0.f; acc[m_][n_][1] = 0.f; acc[m_][n_][2] = 0.f; acc[m_][n_][3] = 0.f; }

constexpr int EPI_WAVE_BYTES = 17408;
#define EPI_FENCE() asm volatile("s_waitcnt lgkmcnt(0)" ::: "memory")
DEV void epi_store_bf16_128(const u16* reg, u16* __restrict__ dst, int ld, int trow, int col0, int lane) {
#pragma unroll
  for (int j = 0; j < 16; ++j) {
    const int row = (lane >> 4) + 4 * j, t = trow + row;
    const u32x4 v = *(const u32x4*)(reg + row * 136 + (lane & 15) * 8);
    if (t < L) *(u32x4*)(dst + (size_t)t * ld + col0 + (lane & 15) * 8) = v;
  }
}

DEV void phase_inproj8(const Params& p, int b, char* smem) {
  const u16* U = (const u16*)((char*)p.out + OUT_HALF);
  const u16* WT = (const u16*)(p.ws + OFF_S1);
  const int MT = 33, NT = 53;
  for (int kk = 0;; ++kk) {
    const int it = tile_index(kk);
    if (it >= MT * NT) break;
    int mt, nt; tile_decode(it, MT, NT, mt, nt);
    f32x4 acc[4][8];
    ZERO_ACC(acc, 8)
    gemm_tile8<8>(acc, U, 1024, mt * 256, L - 1, WT, 1024, nt * 256, 1024, smem);
    const int tid = get_tid8(), lane = tid & 63, w = tid >> 6, wm = w >> 1, wn = w & 1, r = lane & 31, h = lane >> 5;
    u16* reg = (u16*)(smem + w * EPI_WAVE_BYTES);
    const int n0 = nt * 256;
    const int trow = mt * 256 + wm * 64;
    if (nt >= 20 && nt < 28) {
      const bool isk = nt >= 24;
      const int cq = n0 - (isk ? 6144 : 5120);
      const float sc = isk ? 0.0625f : 1.f;
      u16* dst = (u16*)(p.ws + (isk ? OFF_K : OFF_Q));
#pragma unroll
      for (int pr = 0; pr < 4; ++pr) {
        const int n1 = 4 * (pr >> 1) + (pr & 1);
        const int jf = (wn * 2 + (pr >> 1)) * 32 + (pr & 1) * 16 + (lane & 15);
        const float invf_rev = exp2f(-(float)jf * 0.10462765653f) * 0.15915494309189535f;
#pragma unroll
        for (int m = 0; m < 4; ++m)
#pragma unroll
          for (int j = 0; j < 4; ++j) {
            const int row = m * 16 + (lane >> 4) * 4 + j;
            const float tf = (float)(trow + row);
            const float ph = tf * invf_rev, pl = fmaf(tf, invf_rev, -ph);
            const float fr = (ph - floorf(ph)) + pl;
            const float sn = __builtin_amdgcn_sinf(fr), cs = __builtin_amdgcn_cosf(fr);
            const float x1 = acc[m][n1][j], x2 = acc[m][n1 + 2][j];
            reg[row * 136 + n1 * 16 + (lane & 15)] = f2bf((x1 * cs - x2 * sn) * sc);
            reg[row * 136 + n1 * 16 + 32 + (lane & 15)] = f2bf((x2 * cs + x1 * sn) * sc);
          }
      }
      EPI_FENCE();
      epi_store_bf16_128(reg, dst, 1024, trow, cq + wn * 128, lane);
    } else if (nt == 52) {
      float* DT = (float*)(p.ws + OFF_DT);
      if (wn == 0) {
#pragma unroll
        for (int n = 0; n < 2; ++n) {
          const int col = n * 16 + (lane & 15);
          const float bias = p.in[6][col];
#pragma unroll
          for (int m = 0; m < 4; ++m)
#pragma unroll
            for (int j = 0; j < 4; ++j) {
              const int t = trow + m * 16 + (lane >> 4) * 4 + j;
              if (t < L) {
                const float x = acc[m][n][j] + bias;
                const float e = __expf(x);
                DT[(size_t)t * 32 + col] = (x > 20.f) ? x : (e < 0.01f ? e * (1.f - 0.5f * e + e * e * (1.f / 3.f)) : __logf(1.f + e));
              }
            }
        }
      }
    } else {
      u16* dst; int ld, c0; bool sig = false;
      if (nt < 8) { dst = (u16*)(p.ws + OFF_Z); ld = 2048; c0 = n0; }
      else if (nt < 20) { dst = (u16*)(p.ws + OFF_XBC); ld = 3072; c0 = n0 - 2048; }
      else if (nt < 36) { dst = (u16*)(p.ws + OFF_V); ld = 2048; c0 = n0 - 7168; }
      else if (nt < 44) { dst = (u16*)(p.ws + OFF_G); ld = 2048; c0 = n0 - 9216; }
      else if (nt < 48) { dst = (u16*)(p.ws + OFF_GS); ld = 1024; c0 = n0 - 11264; sig = true; }
      else { dst = (u16*)(p.ws + OFF_GR); ld = 1024; c0 = n0 - 12288; sig = true; }
#pragma unroll
      for (int m = 0; m < 4; ++m)
#pragma unroll
        for (int n = 0; n < 8; ++n)
#pragma unroll
          for (int j = 0; j < 4; ++j) {
            float v = acc[m][n][j];
            if (sig) v = sigmoid_f(v);
            reg[(m * 16 + (lane >> 4) * 4 + j) * 136 + n * 16 + (lane & 15)] = f2bf(v);
          }
      EPI_FENCE();
      epi_store_bf16_128(reg, dst, ld, trow, c0 + wn * 128, lane);
    }
    __syncthreads();
  }
}

DEV void phase_merge8(const Params& p, char* smem, char* smem_team) {
  u16* GS = (u16*)(p.ws + OFF_GS);
  u16* GR = (u16*)(p.ws + OFF_GR);
  const u16* Zb = (const u16*)(p.ws + OFF_Z);
  const u16* Gb = (const u16*)(p.ws + OFF_G);
  const u16* WBS = (const u16*)(p.ws + OFF_S2);
  const u16* WBR = (const u16*)(p.ws + OFF_S2 + 4194304);
  for (int kk = 0;; ++kk) {
    const int it = tile_index(kk);
    if (it >= 256) break;
    const int branch = it >> 7, tl = it & 127, mt = tl >> 2, nt = tl & 3;
    f32x4 acc[4][8];
    ZERO_ACC(acc, 8)
    gemm_tile8<8>(acc, branch ? Gb : Zb, 2048, mt * 256, L - 1, branch ? WBR : WBS, 2048, nt * 256, 2048, smem);
    const int tid = get_tid8(), lane = tid & 63, w = tid >> 6, wm = w >> 1, wn = w & 1;
    float* reg = (float*)(smem + w * EPI_WAVE_BYTES);
    u16* GT = branch ? GR : GS;
#pragma unroll
    for (int hf = 0; hf < 2; ++hf) {
#pragma unroll
      for (int m = 0; m < 4; ++m)
#pragma unroll
        for (int n = 0; n < 4; ++n)
#pragma unroll
          for (int j = 0; j < 4; ++j) reg[(m * 16 + (lane >> 4) * 4 + j) * 68 + n * 16 + (lane & 15)] = acc[m][hf * 4 + n][j];
      EPI_FENCE();
#pragma unroll
      for (int j = 0; j < 16; ++j) {
        const int row = (lane >> 4) + 4 * j, c4 = (lane & 15) * 4;
        const f32x4 a = *(const f32x4*)(reg + row * 68 + c4);
        const size_t idx = (size_t)(mt * 256 + wm * 64 + row) * 1024 + nt * 256 + wn * 128 + hf * 64 + c4;
        const u32x2 g = *(const u32x2*)(GT + idx);
        u32x2 o; o[0] = pack2(lo_f(g[0]) * a[0], hi_f(g[0]) * a[1]); o[1] = pack2(lo_f(g[1]) * a[2], hi_f(g[1]) * a[3]);
        *(u32x2*)(GT + idx) = o;
      }
      EPI_FENCE();
    }
    __syncthreads();
  }
  for (int ct = get_rbid(); ct < 128; ct += gridDim.x) {
    const int tid = get_tid8(), lane = tid & 63, w = tid >> 6;
    const int branch = ct >> 6, c16 = ct & 63;
    f32x4* red = (f32x4*)smem;
    red[w * 64 + lane] = thin16((branch ? Gb : Zb) + w * 256, 2048, 8192, (branch ? WBR : WBS) + w * 256, 2048, c16 * 16, 256, lane);
    __syncthreads();
    if (w == 0) {
      u16* GT = branch ? GR : GS;
      f32x4 a1 = red[lane];
#pragma unroll
      for (int q = 1; q < 8; ++q) a1 += red[q * 64 + lane];
#pragma unroll
      for (int j = 0; j < 4; ++j) {
        const size_t idx = (size_t)(8192 + (lane >> 4) * 4 + j) * 1024 + c16 * 16 + (lane & 15);
        GT[idx] = f2bf(bf2f(GT[idx]) * a1[j]);
      }
    }
    __syncthreads();
  }
  {
    float* RSS = (float*)(p.ws + OFF_RSS);
    for (int i = get_bid() * 256 + get_tid(); i < L; i += nworkers() * 256) RSS[i] = 0.f;
  }
  const int n_wout = 16 * 16, n_wup = 16 * 88, n_wdown = 44 * 16;
  for (int it = get_bid(); it < n_wout + n_wup + n_wdown; it += nworkers()) {
    if (it < n_wout) { convert_tile(p.in[12], 1024, 1024, (u16*)(p.ws + OFF_WOUT), it & 15, it >> 4, 0, smem_team); }
    else if (it < n_wout + n_wup) { const int j = it - n_wout; convert_tile(p.in[14], 5632, 1024, (u16*)(p.ws + OFF_WUP), j & 15, j >> 4, 2, smem_team, p.in[13]);   }
    else { const int j = it - n_wout - n_wup; convert_tile(p.in[17], 1024, 2816, (u16*)(p.ws + OFF_WDOWN), j % 44, j / 44, 0, smem_team); }
  }
}

DEV void phase_outproj8(const Params& p, int b, char* smem) {
  const int tid = get_tid8(), lane = tid & 63, w = tid >> 6, wm = w >> 1, wn = w & 1, r = lane & 31, h = lane >> 5;
  u16* U2 = (u16*)(p.ws + OFF_U2);
  float* RSS = (float*)(p.ws + OFF_RSS);
  const u16* Mg = (const u16*)(p.ws + OFF_GS);
  const u16* WO = (const u16*)(p.ws + OFF_WOUT);
  float* reg = (float*)(smem + w * EPI_WAVE_BYTES);
  for (int kk = 0;; ++kk) {
    const int it = tile_index(kk);
    if (it >= 256) break;
    const int mt = it >> 3, nt = it & 7;
    f32x4 acc[4][4];
    ZERO_ACC(acc, 4)
    gemm_tile8<4, true>(acc, Mg, 1024, mt * 256, L - 1, WO, 1024, nt * 128, 1024, smem, (const u16*)(p.ws + OFF_GR));
#pragma unroll
    for (int m = 0; m < 4; ++m)
#pragma unroll
      for (int n = 0; n < 4; ++n)
#pragma unroll
        for (int j = 0; j < 4; ++j) reg[(m * 16 + (lane >> 4) * 4 + j) * 68 + n * 16 + (lane & 15)] = acc[m][n][j];
    EPI_FENCE();
#pragma unroll
    for (int j = 0; j < 16; ++j) {
      const int row = (lane >> 4) + 4 * j, c4 = (lane & 15) * 4;
      const f32x4 a = *(const f32x4*)(reg + row * 68 + c4);
      const int t = mt * 256 + wm * 64 + row, col = nt * 128 + wn * 64 + c4;
      f32x4 hv;
      if (t < NMETA) {
        hv = *(const f32x4*)(p.in[1] + t * 1024 + col) + a;
      } else {
        const size_t idx = ((size_t)b * SEQ + (t - NMETA)) * 1024 + col;
        hv = *(const f32x4*)(p.in[0] + idx) + a;
        *(f32x4*)(p.out + idx) = hv;
      }
      u32x2 hb; hb[0] = pack2(hv[0], hv[1]); hb[1] = pack2(hv[2], hv[3]);
      *(u32x2*)(U2 + (size_t)t * 1024 + col) = hb;
      float sq = hv[0] * hv[0] + hv[1] * hv[1] + hv[2] * hv[2] + hv[3] * hv[3];
      sq += __shfl_xor(sq, 1); sq += __shfl_xor(sq, 2); sq += __shfl_xor(sq, 4); sq += __shfl_xor(sq, 8);
      if ((lane & 15) == 0) atomicAdd(&RSS[t], sq);
    }
    __syncthreads();
  }
  for (int ct = get_rbid(); ct < 64; ct += gridDim.x) {
    const int tid = get_tid8(), lane = tid & 63, w = tid >> 6;
    f32x4* red = (f32x4*)smem;
    red[w * 64 + lane] = thin16(Mg + w * 128, 1024, 8192, WO + w * 128, 1024, ct * 16, 128, lane)
                       + thin16((const u16*)(p.ws + OFF_GR) + w * 128, 1024, 8192, WO + w * 128, 1024, ct * 16, 128, lane);
    __syncthreads();
    if (w == 0) {
      f32x4 a1 = red[lane];
#pragma unroll
      for (int q = 1; q < 8; ++q) a1 += red[q * 64 + lane];
#pragma unroll
      for (int j = 0; j < 4; ++j) {
        const int t = 8192 + (lane >> 4) * 4 + j;
        const size_t idx = ((size_t)b * SEQ + (t - NMETA)) * 1024 + ct * 16 + (lane & 15);
        const float hv = p.in[0][idx] + a1[j];
        p.out[idx] = hv;
        U2[(size_t)t * 1024 + ct * 16 + (lane & 15)] = f2bf(hv);
        float sq = hv * hv;
        sq += __shfl_xor(sq, 1); sq += __shfl_xor(sq, 2); sq += __shfl_xor(sq, 4); sq += __shfl_xor(sq, 8);
        if ((lane & 15) == 0) atomicAdd(&RSS[t], sq);
      }
    }
    __syncthreads();
  }
}

DEV void phase_up8(const Params& p, char* smem) {
  u16* ACT = (u16*)(p.ws + OFF_ACT);
  const float* cw = p.in[15];
  const float* cbias = p.in[16];
  for (int kk = 0;; ++kk) {
    const int it = tile_index(kk);
    if (it >= 33 * 22) break;
    int mt, nt; tile_decode(it, 33, 22, mt, nt);
    f32x4 acc[4][8];
    ZERO_ACC(acc, 8)
    gemm_tile8<8>(acc, (const u16*)(p.ws + OFF_U2), 1024, mt * 254 - 2, L - 1, (const u16*)(p.ws + OFF_WUP), 1024, nt * 256, 1024, smem);
    const int tid = get_tid8(), lane = tid & 63, w = tid >> 6;
    u16* reg = (u16*)(smem + w * EPI_WAVE_BYTES);
    {
      const float* RSS = (const float*)(p.ws + OFF_RSS);
      const int wm = w >> 1;
#pragma unroll
      for (int m = 0; m < 4; ++m)
#pragma unroll
        for (int j = 0; j < 4; ++j) {
          int t = mt * 254 - 2 + wm * 64 + m * 16 + (lane >> 4) * 4 + j; t = t < 0 ? 0 : (t > L - 1 ? L - 1 : t);
          const float rstd = rsqrtf(RSS[t] * (1.f / 1024.f) + EPS);
#pragma unroll
          for (int n = 0; n < 8; ++n) reg[(m * 16 + (lane >> 4) * 4 + j) * 136 + n * 16 + (lane & 15)] = f2bf(acc[m][n][j] * rstd);
        }
    }
    __syncthreads();
    {
      const int cg = tid & 15, rg = tid >> 4;
      const int ch = nt * 128 + cg * 8;
      float wg[3][8], wv[3][8], bg[8], bv[8], g2[8], g1[8], v2[8], v1[8];
#pragma unroll
      for (int k = 0; k < 3; ++k) {
        const f32x4 a0 = *(const f32x4*)(cw + k * 5632 + ch), a1 = *(const f32x4*)(cw + k * 5632 + ch + 4);
        const f32x4 c0 = *(const f32x4*)(cw + k * 5632 + 2816 + ch), c1 = *(const f32x4*)(cw + k * 5632 + 2816 + ch + 4);
#pragma unroll
        for (int j = 0; j < 4; ++j) { wg[k][j] = a0[j]; wg[k][4 + j] = a1[j]; wv[k][j] = c0[j]; wv[k][4 + j] = c1[j]; }
      }
      {
        const f32x4 a0 = *(const f32x4*)(cbias + ch), a1 = *(const f32x4*)(cbias + ch + 4);
        const f32x4 c0 = *(const f32x4*)(cbias + 2816 + ch), c1 = *(const f32x4*)(cbias + 2816 + ch + 4);
#pragma unroll
        for (int j = 0; j < 4; ++j) { bg[j] = a0[j]; bg[4 + j] = a1[j]; bv[j] = c0[j]; bv[4 + j] = c1[j]; }
      }
      const int R0 = rg * 8;
#pragma unroll
      for (int q = 0; q < 2; ++q) {
        const int R = R0 - 2 + q;
        u32x4 gvv = {0u, 0u, 0u, 0u}, vvv = {0u, 0u, 0u, 0u};
        if (R >= 0 && mt * 254 - 2 + R >= 0) {
          const char* sl = smem + ((R >> 6) * 2) * EPI_WAVE_BYTES + ((R & 63) * 136 + cg * 8) * 2;
          gvv = *(const u32x4*)sl; vvv = *(const u32x4*)(sl + EPI_WAVE_BYTES);
        }
#pragma unroll
        for (int j = 0; j < 4; ++j) {
          if (q == 0) { g2[2 * j] = lo_f(gvv[j]); g2[2 * j + 1] = hi_f(gvv[j]); v2[2 * j] = lo_f(vvv[j]); v2[2 * j + 1] = hi_f(vvv[j]); }
          else { g1[2 * j] = lo_f(gvv[j]); g1[2 * j + 1] = hi_f(gvv[j]); v1[2 * j] = lo_f(vvv[j]); v1[2 * j + 1] = hi_f(vvv[j]); }
        }
      }
#pragma unroll 2
      for (int i = 0; i < 8; ++i) {
        const int R = R0 + i, t = mt * 254 - 2 + R;
        u32x4 gvv = {0u, 0u, 0u, 0u}, vvv = {0u, 0u, 0u, 0u};
        if (t >= 0) {
          const char* sl = smem + ((R >> 6) * 2) * EPI_WAVE_BYTES + ((R & 63) * 136 + cg * 8) * 2;
          gvv = *(const u32x4*)sl; vvv = *(const u32x4*)(sl + EPI_WAVE_BYTES);
        }
        float o[8];
#pragma unroll
        for (int j = 0; j < 8; ++j) {
          const float gx = (j & 1) ? hi_f(gvv[j >> 1]) : lo_f(gvv[j >> 1]);
          const float vx = (j & 1) ? hi_f(vvv[j >> 1]) : lo_f(vvv[j >> 1]);
          const float ag = bg[j] + wg[0][j] * g2[j] + wg[1][j] * g1[j] + wg[2][j] * gx;
          const float av = bv[j] + wv[0][j] * v2[j] + wv[1][j] * v1[j] + wv[2][j] * vx;
          o[j] = silu_f(ag) * av;
          g2[j] = g1[j]; g1[j] = gx; v2[j] = v1[j]; v1[j] = vx;
        }
        if (R >= 2 && t < L) {
          u32x4 pk; pk[0] = pack2(o[0], o[1]); pk[1] = pack2(o[2], o[3]); pk[2] = pack2(o[4], o[5]); pk[3] = pack2(o[6], o[7]);
          *(u32x4*)(ACT + (size_t)t * 2816 + ch) = pk;
        }
      }
    }
    __syncthreads();
  }
}

DEV void phase_down8(const Params& p, int b, char* smem) {
  for (int kk = 0;; ++kk) {
    const int it = tile_index(kk);
    if (it >= 256) break;
    const int mt = it >> 3, nt = it & 7;
    f32x4 acc[4][4];
    ZERO_ACC(acc, 4)
    gemm_tile8<4>(acc, (const u16*)(p.ws + OFF_ACT), 2816, NMETA + mt * 256, L - 1, (const u16*)(p.ws + OFF_WDOWN), 2816, nt * 128, 2816, smem);
    const int tid = get_tid8(), lane = tid & 63, w = tid >> 6, wm = w >> 1, wn = w & 1, r = lane & 31, h = lane >> 5;
    float* reg = (float*)(smem + w * EPI_WAVE_BYTES);
#pragma unroll
    for (int m = 0; m < 4; ++m)
#pragma unroll
      for (int n = 0; n < 4; ++n)
#pragma unroll
        for (int j = 0; j < 4; ++j) reg[(m * 16 + (lane >> 4) * 4 + j) * 68 + n * 16 + (lane & 15)] = acc[m][n][j];
    EPI_FENCE();
#pragma unroll
    for (int j = 0; j < 16; ++j) {
      const int row = (lane >> 4) + 4 * j, c4 = (lane & 15) * 4;
      const f32x4 a = *(const f32x4*)(reg + row * 68 + c4);
      const size_t idx = ((size_t)b * SEQ + mt * 256 + wm * 64 + row) * 1024 + nt * 128 + wn * 64 + c4;
      const f32x4 x = *(const f32x4*)(p.out + idx);
      *(f32x4*)(p.out + idx) = x + a;
    }
    __syncthreads();
  }
}

#define XB_TMO      128
#define XB_XCNT(j)  (256  + 64 * (j))
#define XB_XSUB(j)  (1280 + 64 * (j))
#define XB_XGEN(j)  (2304 + 64 * (j))
#define XB_TOP      3328
#define XB_TOPGEN   3392
#define XCD_BAR_WORDS 3456
#define XB_SPIN_CAP (1u << 24)
DEV unsigned xb_ld(unsigned* p)              { return __hip_atomic_load(p, __ATOMIC_RELAXED, __HIP_MEMORY_SCOPE_AGENT); }
DEV unsigned xb_add(unsigned* p, unsigned v) { return __hip_atomic_fetch_add(p, v, __ATOMIC_RELAXED, __HIP_MEMORY_SCOPE_AGENT); }
DEV unsigned xb_xcc_id() { return (unsigned)__builtin_amdgcn_s_getreg((3 << 11) | 20) & 0xFu; }
#define XB_SPIN(cond, bar) do { unsigned _sp = 0; while (cond) { __builtin_amdgcn_s_sleep(1); \
    if ((++_sp & 255u) == 0u) { if (xb_ld(&(bar)[XB_TMO])) break; if (_sp > XB_SPIN_CAP) { atomicAdd(&(bar)[XB_TMO], 1u); break; } } } } while (0)
struct XcdBarrier { unsigned* bar; unsigned x; volatile LDSP unsigned* st; };
DEV XcdBarrier xcd_barrier_post(unsigned* bar, volatile LDSP unsigned* st) {
  XcdBarrier b; b.bar = bar; b.x = xb_xcc_id(); b.st = st;
  if (threadIdx.x == 0) (void)xb_add(&bar[XB_XCNT(b.x)], 1u);
  return b;
}
DEV void xcd_barrier_complete(unsigned* bar, unsigned x, unsigned& nloc, unsigned& nx) {
  const unsigned G = gridDim.x * gridDim.y * gridDim.z;
  unsigned sum, cnt, mine, sp = 0u;
  for (;;) {
    sum = 0u; cnt = 0u; mine = 0u;
#pragma unroll
    for (unsigned j = 0; j < 16; ++j) { const unsigned c = xb_ld(&bar[XB_XCNT(j)]); sum += c; cnt += (c > 0u) ? 1u : 0u; mine = (j == x) ? c : mine; }
    if (sum == G) break;
    __builtin_amdgcn_s_sleep(1);
    if ((++sp & 255u) == 0u) { if (xb_ld(&bar[XB_TMO])) break; if (sp > XB_SPIN_CAP) { atomicAdd(&bar[XB_TMO], 1u); break; } }
  }
  nloc = mine > 0u ? mine : 1u; nx = cnt > 0u ? cnt : 1u;
}
DEV void xcd_barrier(const XcdBarrier& b) {
  asm volatile("s_waitcnt vmcnt(0)" ::: "memory");
  __syncthreads();
  if (threadIdx.x == 0) {
    unsigned* bar = b.bar;
    __builtin_amdgcn_s_waitcnt(0);
    unsigned nloc = b.st[0], nx = b.st[1];
    if (nloc == 0u) { xcd_barrier_complete(bar, b.x, nloc, nx); b.st[0] = nloc; b.st[1] = nx; }
    const unsigned old = xb_add(&bar[XB_XSUB(b.x)], 1u);
    const unsigned gen = old / nloc;
    if (old + 1u == (gen + 1u) * nloc) {
      __builtin_amdgcn_fence(__ATOMIC_RELEASE, "agent");
      asm volatile("s_waitcnt vmcnt(0)" ::: "memory");
      const unsigned og = xb_add(&bar[XB_TOP], 1u);
      const unsigned tg = og / nx;
      if (og + 1u == (tg + 1u) * nx) xb_add(&bar[XB_TOPGEN], 1u);
      else XB_SPIN(xb_ld(&bar[XB_TOPGEN]) == tg, bar);
      __builtin_amdgcn_fence(__ATOMIC_ACQUIRE, "agent");
      xb_add(&bar[XB_XGEN(b.x)], 1u);
      asm volatile("s_waitcnt vmcnt(0)" ::: "memory");
    } else {
      XB_SPIN(xb_ld(&bar[XB_XGEN(b.x)]) == gen, bar);
      __builtin_amdgcn_fence(__ATOMIC_ACQUIRE, "agent");
      asm volatile("s_waitcnt vmcnt(0)" ::: "memory");
    }
  }
  __syncthreads();
}

constexpr int N_PHASES = 19;

__global__ void __launch_bounds__(512) fwd_kernel(Params p, int ph0, int ph1) {
  __shared__ __attribute__((aligned(16))) char smem[SMEM_BYTES];
  __shared__ uint4 xb_words;
  if (threadIdx.x == 0) xb_words = make_uint4(0u, 0u, 0u, 0u);
  __syncthreads();
  XcdBarrier xb = xcd_barrier_post((unsigned*)(p.ws + OFF_BAR), (volatile LDSP unsigned*)&xb_words);
  if (ph1 < 0) cg::this_grid().sync();
  for (int ph = ph0; ph < ph1; ++ph) {
    char* tsm = smem + (get_tid8() >> 8) * SMEM_TEAM;
    const int b = ph >= 10 ? 1 : 0;
    const int lp = (ph == 0) ? 0 : (ph == 18 ? 9 : (ph >= 10 ? ph - 9 : ph));
    switch (lp) {
      case 0: phase_prep(p, 0, true, tsm); break;
      case 1: phase_inproj8(p, b, smem); break;
      case 2: {
        int it = get_bid();
        for (; it < 1024; it += nworkers()) ret_kv_item(p, it, tsm);
        for (; it < 2048; it += nworkers()) ssd_state_item(p, it - 1024, tsm);
      } break;
      case 3: phase_scan(p); break;
      case 4: {
        {
          const int rb = get_rbid(), team = get_tid8() >> 8;
          for (int j = 0; j < 3; ++j) {
            int kind = -1, idx = 0;
            if (rb < 4) {
              const int q = rb * 3 + j;
              const int rt = (q < 2) ? 128 : ((q >> 1) - 1) * 4;
              kind = 0; idx = rt * 4 + (q & 1) * 2 + team;
            } else if (rb < 10) {
              if (j < 2) { kind = 1; idx = (246 + (rb - 4) * 2 + j) * 2 + team; }
            } else if (j < 2) {
              const int k = rb - 10, ri = k >> 1;
              const int rt = (ri < 12) ? ((ri / 3) * 4 + 1 + ri % 3) : (17 + ri - 12);
              kind = j; idx = (j == 0) ? (rt * 4 + (k & 1) * 2 + team) : (k * 2 + team);
            }
            if (kind == 0) ret_out_item(p, idx, tsm);
            else if (kind == 1) ssd_out_item(p, idx, tsm);
          }
        }
      } break;
      case 5: phase_merge8(p, smem, tsm); break;
      case 6: phase_outproj8(p, b, smem); break;
      case 7: phase_up8(p, smem); break;
      case 8: phase_down8(p, b, smem); break;
      case 9: {
        if (ph == 9) { phase_final_norm(p, 0); phase_prep(p, 1, false, tsm); }
        else phase_final_norm(p, 1);
      } break;
    }
    if (ph + 1 < ph1) xcd_barrier(xb);
  }
}

#ifndef MK_SINGLE
#define MK_SINGLE 1
#endif

extern "C" void kernel_launch(void* const* d_in, const int* in_sizes, int n_in, void* d_out, int out_size, void* d_ws, size_t ws_size,
                              hipStream_t stream) {
  static int grid_blocks = 0;
  if (!grid_blocks) {
    int dev = 0, cus = 0, per_cu = 0;
    hipGetDevice(&dev);
    hipDeviceGetAttribute(&cus, hipDeviceAttributeMultiprocessorCount, dev);
    hipOccupancyMaxActiveBlocksPerMultiprocessor(&per_cu, fwd_kernel, 512, 0);
    per_cu = 1;
    if (cus != 256) fprintf(stderr, "kernel_launch: built for a 256-CU device (static phase schedules assume 256 workgroups), found %d CUs\n", cus);
    cus = 256;
    grid_blocks = cus * per_cu;
  }
  Params p{};
  for (int i = 0; i < 19; ++i) p.in[i] = (const float*)d_in[i];
  p.out = (float*)d_out;
  p.ws = (char*)d_ws;
#if MK_SINGLE
  (void)hipMemsetAsync((char*)d_ws + OFF_BAR, 0, XCD_BAR_WORDS * 4, stream);
  int ph0 = 0, ph1 = N_PHASES;
  void* args[] = {&p, &ph0, &ph1};
  hipError_t e = hipLaunchCooperativeKernel((void*)fwd_kernel, dim3(grid_blocks), dim3(512), args, 0, stream);
  if (e != hipSuccess) fprintf(stderr, "cooperative launch failed: %s (grid %d)\n", hipGetErrorString(e), grid_blocks);
#else
  for (int ph = 0; ph < N_PHASES; ++ph) {
    hipLaunchKernelGGL(fwd_kernel, dim3(grid_blocks), dim3(512), 0, stream, p, ph, ph + 1);
  }
#endif
}
```

```cpp
#include <hip/hip_runtime.h>
#include <hip/hip_cooperative_groups.h>
#include <cstdio>
namespace cg = cooperative_groups;

typedef unsigned short u16;
typedef __bf16 bf16x8 __attribute__((ext_vector_type(8)));
typedef short s16x4 __attribute__((ext_vector_type(4)));
typedef short s16x8 __attribute__((ext_vector_type(8)));
typedef float f32x16 __attribute__((ext_vector_type(16)));
typedef unsigned int u32x4 __attribute__((ext_vector_type(4)));
typedef unsigned int u32x2 __attribute__((ext_vector_type(2)));
typedef float f32x4 __attribute__((ext_vector_type(4)));

#define DEV __device__ __forceinline__
#define LDSP __attribute__((address_space(3)))

constexpr int D = 1024;
constexpr int L = 8208;
constexpr int SEQ = 8192;
constexpr int NMETA = 16;
constexpr int NPROJ = 13344;
constexpr int NPROJ_PAD = 13568;
constexpr int DFF = 2816;
constexpr float EPS = 1e-6f;

constexpr size_t OFF_Z = 0;
constexpr size_t OFF_G = 33619968;
constexpr size_t OFF_GS = 67239936;
constexpr size_t OFF_GR = 84049920;
constexpr size_t OFF_Q = 100859904;
constexpr size_t OFF_XBC = 117669888;
constexpr size_t OFF_K = 168099840;
constexpr size_t OFF_V = 184909824;
constexpr size_t OFF_DT = 218529792;
constexpr size_t OFF_S2 = 219580416;
constexpr size_t OFF_S1 = 227969024;
constexpr size_t OFF_CD = 261523456;
constexpr size_t OFF_HM = 261531648;
constexpr size_t OFF_BAR = 261597184;
constexpr size_t OFF_RSS = 261611520;
constexpr size_t OFF_WOUT = OFF_S1;
constexpr size_t OFF_WUP = OFF_S1 + 2097152;
constexpr size_t OFF_WDOWN = OFF_S1 + 13631488;
constexpr size_t OFF_UP = OFF_XBC;
constexpr size_t OFF_ACT = OFF_Z;
constexpr size_t OFF_U2 = OFF_Q;
constexpr size_t OUT_HALF = 33554432;

constexpr int SMEM_TEAM = 73728;
constexpr int SMEM_BYTES = 2 * SMEM_TEAM;

struct Params {
  const float* in[19];
  float* out;
  char* ws;
};

DEV int get_tid8() { int t = threadIdx.x; asm volatile("" : "+v"(t)); return t; }
DEV int get_tid() { int t = threadIdx.x & 255; asm volatile("" : "+v"(t)); return t; }
DEV int get_rbid() { int t = blockIdx.x; asm volatile("" : "+s"(t)); return t; }
DEV int get_bid() { int t = get_rbid() * 2 + (get_tid8() >> 8); return __builtin_amdgcn_readfirstlane(t); }
DEV int nworkers() { return (int)gridDim.x * 2; }
DEV float bf2f(u16 h) { return __uint_as_float(((unsigned)h) << 16); }
DEV u16 f2bf(float f) { unsigned u = __float_as_uint(f); u += 0x7fffu + ((u >> 16) & 1u); return (u16)(u >> 16); }
DEV unsigned pack2(float a, float b) { return (unsigned)f2bf(a) | ((unsigned)f2bf(b) << 16); }
DEV float silu_f(float x) { return x / (1.f + __expf(-x)); }
DEV float sigmoid_f(float x) { return 1.f / (1.f + __expf(-x)); }
DEV float lo_f(unsigned u) { return __uint_as_float(u << 16); }
DEV float hi_f(unsigned u) { return __uint_as_float(u & 0xffff0000u); }
DEV float wave_sum(float v) {
#pragma unroll
  for (int o = 32; o > 0; o >>= 1) v += __shfl_xor(v, o);
  return v;
}
DEV float half_sum(float v) {
#pragma unroll
  for (int o = 16; o > 0; o >>= 1) v += __shfl_xor(v, o);
  return v;
}
DEV float log_gamma(int h) {
  return h == 0 ? -0.0317486983145803f : (h == 1 ? -0.015748356968139168f : (h == 2 ? -0.007843177461025893f : -0.003913899321136329f));
}
DEV f32x16 mfma(bf16x8 a, bf16x8 b, f32x16 c) { return __builtin_amdgcn_mfma_f32_32x32x16_bf16(a, b, c, 0, 0, 0); }
DEV f32x16 zero16() { f32x16 z;
#pragma unroll
  for (int i = 0; i < 16; ++i) z[i] = 0.f;
  return z; }
DEV int acc_row(int i, int h) { return (i & 3) + 8 * (i >> 2) + 4 * h; }

DEV bf16x8 frag_tr(const u16* T, int ld, int k0, int x0, int lane) {
  const int h = lane >> 5, blk = (lane >> 4) & 1, q = (lane & 15) >> 2, pp = lane & 3;
  const u16* a0 = T + (k0 + 8 * h + q) * ld + x0 + 16 * blk + 4 * pp;
  s16x4 lo = __builtin_amdgcn_ds_read_tr16_b64_v4i16((LDSP s16x4*)a0);
  s16x4 hi = __builtin_amdgcn_ds_read_tr16_b64_v4i16((LDSP s16x4*)(a0 + 4 * ld));
  s16x8 v = {lo[0], lo[1], lo[2], lo[3], hi[0], hi[1], hi[2], hi[3]};
  return __builtin_bit_cast(bf16x8, v);
}
DEV bf16x8 frag_row(const u16* T, int ld, int row, int k) {
  return *(const bf16x8*)(T + row * ld + k);
}

template <int MI>
DEV void gemm_tile(f32x16 (&acc)[MI][2], const u16* __restrict__ A, int lda, int arow0, int arow_max,
                   const u16* __restrict__ B, int ldb, int brow0, int K, char* smem) {
  constexpr int BM = MI * 64;
  constexpr int LD = 72;
  constexpr int ACH = BM * 8 / 256;
  u16* As = (u16*)smem;
  u16* Bs = As + BM * LD;
  const int tid = get_tid(), lane = tid & 63, w = tid >> 6, wm = w >> 1, wn = w & 1, r = lane & 31, h = lane >> 5;
  u32x4 ra[ACH], rb[4];
  const u16* ap[ACH];
  const u16* bp[4];
#pragma unroll
  for (int i = 0; i < ACH; ++i) {
    int c = tid + i * 256, row = c >> 3, kc = c & 7;
    int gr = arow0 + row; gr = gr > arow_max ? arow_max : gr;
    ap[i] = A + (size_t)gr * lda + kc * 8;
  }
#pragma unroll
  for (int i = 0; i < 4; ++i) {
    int c = tid + i * 256, row = c >> 3, kc = c & 7;
    bp[i] = B + (size_t)(brow0 + row) * ldb + kc * 8;
  }
#pragma unroll
  for (int i = 0; i < ACH; ++i) ra[i] = *(const u32x4*)(ap[i]);
#pragma unroll
  for (int i = 0; i < 4; ++i) rb[i] = *(const u32x4*)(bp[i]);
  const int nk = K >> 6;
  for (int kt = 0; kt < nk; ++kt) {
#pragma unroll
    for (int i = 0; i < ACH; ++i) { int c = tid + i * 256, row = c >> 3, kc = c & 7; *(u32x4*)(As + row * LD + kc * 8) = ra[i]; }
#pragma unroll
    for (int i = 0; i < 4; ++i) { int c = tid + i * 256, row = c >> 3, kc = c & 7; *(u32x4*)(Bs + row * LD + kc * 8) = rb[i]; }
    __syncthreads();
    if (kt + 1 < nk) {
#pragma unroll
      for (int i = 0; i < ACH; ++i) ra[i] = *(const u32x4*)(ap[i] + (kt + 1) * 64);
#pragma unroll
      for (int i = 0; i < 4; ++i) rb[i] = *(const u32x4*)(bp[i] + (kt + 1) * 64);
    }
#pragma unroll
    for (int ks = 0; ks < 4; ++ks) {
      bf16x8 a[MI], b[2];
#pragma unroll
      for (int mi = 0; mi < MI; ++mi) a[mi] = frag_row(As, LD, wm * MI * 32 + mi * 32 + r, ks * 16 + h * 8);
#pragma unroll
      for (int ni = 0; ni < 2; ++ni) b[ni] = frag_row(Bs, LD, wn * 64 + ni * 32 + r, ks * 16 + h * 8);
#pragma unroll
      for (int mi = 0; mi < MI; ++mi)
#pragma unroll
        for (int ni = 0; ni < 2; ++ni) acc[mi][ni] = mfma(a[mi], b[ni], acc[mi][ni]);
    }
    __syncthreads();
  }
}

DEV int orig_col(int n) {
  if (n < 5120) return n;
  if (n < 7168) {
    int q = n - 5120; int which = q >> 10; int c = q & 1023; int head = c >> 8; int ip = c & 255; int blk = ip >> 6; int wi = ip & 63;
    int j = (wi < 32) ? (blk * 32 + wi) : (128 + blk * 32 + wi - 32);
    return 5152 + which * 1024 + head * 256 + j;
  }
  if (n < 13312) return n + 32;
  if (n < 13344) return 5120 + (n - 13312);
  return -1;
}
DEV void convert_tile(const float* __restrict__ W, int Nsrc, int K, u16* __restrict__ WT, int kt, int ntile, int mode, char* smem, const float* __restrict__ kscale = nullptr) {
  float* t = (float*)smem;
  const int tid = get_tid();
  {
    const int tx = tid & 15, ty = tid >> 4;
    const int n = ntile * 64 + tx * 4;
    int on = n;
    if (mode == 1) on = orig_col(n);
    else if (mode == 2) { const int tl = n >> 8, wi = n & 255; on = (wi < 128) ? (tl * 128 + wi) : (2816 + tl * 128 + wi - 128); }
#pragma unroll
    for (int kk = ty; kk < 64; kk += 16) {
      f32x4 v = {0.f, 0.f, 0.f, 0.f};
      if (on >= 0) v = *(const f32x4*)(W + (size_t)(kt * 64 + kk) * Nsrc + on);
      if (kscale) v = v * kscale[kt * 64 + kk];
      *(f32x4*)(t + kk * 68 + tx * 4) = v;
    }
  }
  __syncthreads();
  {
    const int nn = tid >> 2, kq = (tid & 3) * 16;
    u32x4 o[2];
#pragma unroll
    for (int j = 0; j < 8; ++j) o[j >> 2][j & 3] = pack2(t[(kq + 2 * j) * 68 + nn], t[(kq + 2 * j + 1) * 68 + nn]);
    u16* d = WT + (size_t)(ntile * 64 + nn) * K + kt * 64 + kq;
    *(u32x4*)d = o[0]; *(u32x4*)(d + 8) = o[1];
  }
  __syncthreads();
}

DEV void rmsnorm_row_bf16(const float* __restrict__ src, const float* __restrict__ w, u16* __restrict__ dst, int lane) {
  f32x4 v[4]; float ss = 0.f;
#pragma unroll
  for (int j = 0; j < 4; ++j) { v[j] = *(const f32x4*)(src + j * 256 + lane * 4); ss += v[j][0] * v[j][0] + v[j][1] * v[j][1] + v[j][2] * v[j][2] + v[j][3] * v[j][3]; }
  ss = wave_sum(ss);
  const float rstd = rsqrtf(ss * (1.f / 1024.f) + EPS);
#pragma unroll
  for (int j = 0; j < 4; ++j) {
    f32x4 ww = *(const f32x4*)(w + j * 256 + lane * 4);
    u32x2 o; o[0] = pack2(v[j][0] * rstd * ww[0], v[j][1] * rstd * ww[1]); o[1] = pack2(v[j][2] * rstd * ww[2], v[j][3] * rstd * ww[3]);
    *(u32x2*)(dst + j * 256 + lane * 4) = o;
  }
}
DEV void rmsnorm_row_f32_inplace(float* __restrict__ row, const float* __restrict__ w, int lane) {
  f32x4 v[4]; float ss = 0.f;
#pragma unroll
  for (int j = 0; j < 4; ++j) { v[j] = *(const f32x4*)(row + j * 256 + lane * 4); ss += v[j][0] * v[j][0] + v[j][1] * v[j][1] + v[j][2] * v[j][2] + v[j][3] * v[j][3]; }
  ss = wave_sum(ss);
  const float rstd = rsqrtf(ss * (1.f / 1024.f) + EPS);
#pragma unroll
  for (int j = 0; j < 4; ++j) {
    f32x4 ww = *(const f32x4*)(w + j * 256 + lane * 4);
    f32x4 o; o[0] = v[j][0] * rstd * ww[0]; o[1] = v[j][1] * rstd * ww[1]; o[2] = v[j][2] * rstd * ww[2]; o[3] = v[j][3] * rstd * ww[3];
    *(f32x4*)(row + j * 256 + lane * 4) = o;
  }
}

template <int R, int C, bool SCALE>
DEV void stage_conv(u16* dst, int ld, const u16* __restrict__ xbc, int row0, int ch0, const float* __restrict__ cw, const float* __restrict__ cb, const float* rs) {
  constexpr int CG = C / 8, RG = 256 / CG, RPT = R / RG;
  const int tid = get_tid();
  const int cgi = tid % CG, rgi = tid / CG;
  const int ch = ch0 + cgi * 8, r0 = rgi * RPT;
  float w[4][8], bias[8], xw[3][8];
#pragma unroll
  for (int k = 0; k < 4; ++k) {
    f32x4 a = *(const f32x4*)(cw + k * 3072 + ch), b = *(const f32x4*)(cw + k * 3072 + ch + 4);
#pragma unroll
    for (int j = 0; j < 4; ++j) { w[k][j] = a[j]; w[k][4 + j] = b[j]; }
  }
  {
    f32x4 a = *(const f32x4*)(cb + ch), b = *(const f32x4*)(cb + ch + 4);
#pragma unroll
    for (int j = 0; j < 4; ++j) { bias[j] = a[j]; bias[4 + j] = b[j]; }
  }
#pragma unroll
  for (int k = 0; k < 3; ++k) {
    const int tr = row0 + r0 - 3 + k;
    u32x4 v = {0u, 0u, 0u, 0u};
    if (tr >= 0 && tr < L) v = *(const u32x4*)(xbc + (size_t)tr * 3072 + ch);
#pragma unroll
    for (int j = 0; j < 4; ++j) { xw[k][2 * j] = lo_f(v[j]); xw[k][2 * j + 1] = hi_f(v[j]); }
  }
#pragma unroll
  for (int i = 0; i < RPT; ++i) {
    const int tr = row0 + r0 + i;
    const bool valid = tr < L;
    u32x4 v = {0u, 0u, 0u, 0u};
    if (valid) v = *(const u32x4*)(xbc + (size_t)tr * 3072 + ch);
    float xc[8], o[8];
#pragma unroll
    for (int j = 0; j < 4; ++j) { xc[2 * j] = lo_f(v[j]); xc[2 * j + 1] = hi_f(v[j]); }
    float sc = 1.f;
    if (SCALE) sc = rs[(cgi >> 3) * 128 + r0 + i];
#pragma unroll
    for (int j = 0; j < 8; ++j) {
      float a = bias[j] + w[0][j] * xw[0][j] + w[1][j] * xw[1][j] + w[2][j] * xw[2][j] + w[3][j] * xc[j];
      a = silu_f(a) * sc;
      o[j] = valid ? a : 0.f;
      xw[0][j] = xw[1][j]; xw[1][j] = xw[2][j]; xw[2][j] = xc[j];
    }
    u32x4 pk; pk[0] = pack2(o[0], o[1]); pk[1] = pack2(o[2], o[3]); pk[2] = pack2(o[4], o[5]); pk[3] = pack2(o[6], o[7]);
    *(u32x4*)(dst + (r0 + i) * ld + cgi * 8) = pk;
  }
}

DEV float chunk_cumsum(const float* __restrict__ DT, int c, int H, float A, float* acs, float* dts, int lane) {
  const int s0 = 2 * lane;
  const int t0 = c * 128 + s0;
  const float d0 = (t0 < L) ? DT[(size_t)t0 * 32 + H] : 0.f;
  const float d1 = (t0 + 1 < L) ? DT[(size_t)(t0 + 1) * 32 + H] : 0.f;
  const float a0 = d0 * A, a1 = a0 + d1 * A;
  float tot = a1;
#pragma unroll
  for (int o = 1; o < 64; o <<= 1) { float n = __shfl_up(tot, o); if (lane >= o) tot += n; }
  const float excl = tot - a1;
  acs[s0] = excl + a0; acs[s0 + 1] = excl + a1;
  dts[s0] = d0; dts[s0 + 1] = d1;
  return __shfl(tot, 63);
}

DEV void phase_prep(const Params& p, int b, bool first, char* smem) {
  const int tid = get_tid(), lane = tid & 63, w = tid >> 6;
  u16* U = (u16*)((char*)p.out + OUT_HALF);
  const int n_norm = L / 4;
  const int n_win = 16 * (NPROJ_PAD / 64);
  const int n_wb = first ? 2 * 32 * 16 : 0;
  const int total = n_norm + n_win + n_wb;
  for (int it = get_bid(); it < total; it += nworkers()) {
    if (it < n_norm) {
      const int t = it * 4 + w;
      const float* src = (t < NMETA) ? (p.in[1] + (size_t)t * D) : (p.in[0] + ((size_t)b * SEQ + (t - NMETA)) * D);
      rmsnorm_row_bf16(src, p.in[2], U + (size_t)t * D, lane);
    } else if (it < n_norm + n_win) {
      const int j = it - n_norm; const int ntile = j >> 4, kt = j & 15;
      convert_tile(p.in[3], NPROJ, 1024, (u16*)(p.ws + OFF_S1), kt, ntile, 1, smem);
    } else {
      int j = it - n_norm - n_win; const int which = j >> 9; j &= 511; const int ntile = j >> 5, kt = j & 31;
      convert_tile(p.in[10 + which], 1024, 2048, (u16*)(p.ws + OFF_S2 + (size_t)which * 4194304), kt, ntile, 0, smem);
    }
  }
}

DEV void phase_inproj(const Params& p, int b, char* smem) {
  const int tid = get_tid(), lane = tid & 63, w = tid >> 6, wm = w >> 1, wn = w & 1, r = lane & 31, h = lane >> 5;
  const u16* U = (const u16*)((char*)p.out + OUT_HALF);
  const u16* WT = (const u16*)(p.ws + OFF_S1);
  const int MT = 65, NT = 105;
  for (int it = get_bid(); it < MT * NT; it += gridDim.x) {
    const int nt = it / MT, mt = it % MT;
    f32x16 acc[2][2];
#pragma unroll
    for (int mi = 0; mi < 2; ++mi)
#pragma unroll
      for (int ni = 0; ni < 2; ++ni) acc[mi][ni] = zero16();
    gemm_tile<2>(acc, U, 1024, mt * 128, L - 1, WT, 1024, nt * 128, 1024, smem);
    const int n0 = nt * 128;
    if (nt >= 40 && nt < 56) {
      const bool isk = nt >= 48;
      const int cq = n0 - (isk ? 6144 : 5120);
      const int blk = ((cq & 255) >> 6) + wn;
      const int jf = blk * 32 + r;
      const double invf_rev = exp(-(double)jf * 0.07252236513367073) * 0.15915494309189535;
      const float sc = isk ? 0.0625f : 1.f;
      u16* dst = (u16*)(p.ws + (isk ? OFF_K : OFF_Q));
#pragma unroll
      for (int mi = 0; mi < 2; ++mi)
#pragma unroll
        for (int i = 0; i < 16; ++i) {
          const int t = mt * 128 + wm * 64 + mi * 32 + acc_row(i, h);
          if (t < L) {
            double rev = (double)t * invf_rev;
            rev -= floor(rev);
            const float fr = (float)rev;
            const float sn = __builtin_amdgcn_sinf(fr), cs = __builtin_amdgcn_cosf(fr);
            const float x1 = acc[mi][0][i], x2 = acc[mi][1][i];
            const float o1 = (x1 * cs - x2 * sn) * sc, o2 = (x2 * cs + x1 * sn) * sc;
            u16* d = dst + (size_t)t * 1024 + cq + wn * 64 + r;
            d[0] = f2bf(o1); d[32] = f2bf(o2);
          }
        }
    } else if (nt == 104) {
      float* DT = (float*)(p.ws + OFF_DT);
      if (wn == 0) {
        const float bias = p.in[6][r];
#pragma unroll
        for (int mi = 0; mi < 2; ++mi)
#pragma unroll
          for (int i = 0; i < 16; ++i) {
            const int t = mt * 128 + wm * 64 + mi * 32 + acc_row(i, h);
            if (t < L) {
              const float x = acc[mi][0][i] + bias;
              const float e = __expf(x);
              DT[(size_t)t * 32 + r] = (x > 20.f) ? x : (e < 0.01f ? e * (1.f - 0.5f * e + e * e * (1.f / 3.f)) : __logf(1.f + e));
            }
          }
      }
    } else {
      u16* dst; int ld, c0; bool sig = false;
      if (nt < 16) { dst = (u16*)(p.ws + OFF_Z); ld = 2048; c0 = n0; }
      else if (nt < 40) { dst = (u16*)(p.ws + OFF_XBC); ld = 3072; c0 = n0 - 2048; }
      else if (nt < 72) { dst = (u16*)(p.ws + OFF_V); ld = 2048; c0 = n0 - 7168; }
      else if (nt < 88) { dst = (u16*)(p.ws + OFF_G); ld = 2048; c0 = n0 - 9216; }
      else if (nt < 96) { dst = (u16*)(p.ws + OFF_GS); ld = 1024; c0 = n0 - 11264; sig = true; }
      else { dst = (u16*)(p.ws + OFF_GR); ld = 1024; c0 = n0 - 12288; sig = true; }
#pragma unroll
      for (int mi = 0; mi < 2; ++mi)
#pragma unroll
        for (int ni = 0; ni < 2; ++ni)
#pragma unroll
          for (int i = 0; i < 16; ++i) {
            const int t = mt * 128 + wm * 64 + mi * 32 + acc_row(i, h);
            if (t < L) {
              float v = acc[mi][ni][i];
              if (sig) v = sigmoid_f(v);
              dst[(size_t)t * ld + c0 + wn * 64 + ni * 32 + r] = f2bf(v);
            }
          }
    }
  }
}

DEV void ssd_state_item(const Params& p, int it, char* smem) {
  const int tid = get_tid(), lane = tid & 63, w = tid >> 6, wm = w >> 1, wn = w & 1, r = lane & 31, h = lane >> 5;
  const int c = it >> 4, hp = it & 15, H0 = hp * 2, g = H0 >> 3;
  u16* Xw = (u16*)smem;
  u16* Bc = Xw + 128 * 136;
  float* wsc = (float*)(Bc + 128 * 136);
  float* tmp = wsc + 256;
  const float* DT = (const float*)(p.ws + OFF_DT);
  float* CD = (float*)(p.ws + OFF_CD);
  const u16* XBC = (const u16*)(p.ws + OFF_XBC);
  if (w < 2) {
    const int H = H0 + w;
    const float A = -expf(p.in[7][H]);
    float* acs = tmp + w * 128;
    float* dts = wsc + w * 128;
    const float aend = chunk_cumsum(DT, c, H, A, acs, dts, lane);
    const int s0 = 2 * lane;
    const float w0 = __expf(aend - acs[s0]) * dts[s0], w1 = __expf(aend - acs[s0 + 1]) * dts[s0 + 1];
    dts[s0] = w0; dts[s0 + 1] = w1;
    if (lane == 0) CD[c * 32 + H] = __expf(aend);
  }
  __syncthreads();
  stage_conv<128, 128, true>(Xw, 136, XBC, c * 128, H0 * 64, p.in[4], p.in[5], wsc);
  stage_conv<128, 128, false>(Bc, 136, XBC, c * 128, 2048 + g * 128, p.in[4], p.in[5], nullptr);
  __syncthreads();
  f32x16 acc[2][2];
#pragma unroll
  for (int mi = 0; mi < 2; ++mi)
#pragma unroll
    for (int ni = 0; ni < 2; ++ni) acc[mi][ni] = zero16();
#pragma unroll
  for (int ks = 0; ks < 8; ++ks) {
    bf16x8 a[2], bq[2];
#pragma unroll
    for (int mi = 0; mi < 2; ++mi) a[mi] = frag_tr(Xw, 136, ks * 16, wm * 64 + mi * 32, lane);
#pragma unroll
    for (int ni = 0; ni < 2; ++ni) bq[ni] = frag_tr(Bc, 136, ks * 16, wn * 64 + ni * 32, lane);
#pragma unroll
    for (int mi = 0; mi < 2; ++mi)
#pragma unroll
      for (int ni = 0; ni < 2; ++ni) acc[mi][ni] = mfma(a[mi], bq[ni], acc[mi][ni]);
  }
  u16* ST = (u16*)(p.ws + OFF_S1) + (size_t)(c * 32 + H0) * 8192;
  __syncthreads();
#pragma unroll
  for (int mi = 0; mi < 2; ++mi)
#pragma unroll
    for (int ni = 0; ni < 2; ++ni)
#pragma unroll
      for (int i = 0; i < 16; ++i) Xw[(wm * 64 + mi * 32 + acc_row(i, h)) * 136 + wn * 64 + ni * 32 + r] = f2bf(acc[mi][ni][i]);
  asm volatile("s_waitcnt lgkmcnt(0)" ::: "memory");
#pragma unroll
  for (int j = 0; j < 8; ++j) {
    const int m = wm * 64 + (lane >> 3) + 8 * j, n = wn * 64 + (lane & 7) * 8;
    *(u32x4*)(ST + m * 128 + n) = *(const u32x4*)(Xw + m * 136 + n);
  }
  __syncthreads();
}

DEV void ret_kv_item(const Params& p, int it, char* smem) {
  const int tid = get_tid(), lane = tid & 63, w = tid >> 6, wm = w >> 1, wn = w & 1, r = lane & 31, h = lane >> 5;
  const int sc = it >> 5, rem = it & 31, hd = rem >> 3, dt2 = (rem >> 2) & 1, et = rem & 3;
  u16* Vt = (u16*)smem;
  u16* Kt = Vt + 128 * 136;
  const u16* Vg = (const u16*)(p.ws + OFF_V);
  const u16* Kg = (const u16*)(p.ws + OFF_K);
  const float lg = log_gamma(hd);
  f32x16 acc[2][2];
#pragma unroll
  for (int mi = 0; mi < 2; ++mi)
#pragma unroll
    for (int ni = 0; ni < 2; ++ni) acc[mi][ni] = zero16();
  for (int half = 0; half < 2; ++half) {
#pragma unroll
    for (int i = 0; i < 8; ++i) {
      const int cidx = tid + i * 256, row = cidx >> 4, cc = cidx & 15;
      const int tok = sc * 256 + half * 128 + row;
      u32x4 v = *(const u32x4*)(Vg + (size_t)tok * 2048 + hd * 512 + et * 128 + cc * 8);
      *(u32x4*)(Vt + row * 136 + cc * 8) = v;
      u32x4 kk = *(const u32x4*)(Kg + (size_t)tok * 1024 + hd * 256 + dt2 * 128 + cc * 8);
      const float dec = __expf((float)(255 - (half * 128 + row)) * lg);
      u32x4 ko;
#pragma unroll
      for (int j = 0; j < 4; ++j) ko[j] = pack2(lo_f(kk[j]) * dec, hi_f(kk[j]) * dec);
      *(u32x4*)(Kt + row * 136 + cc * 8) = ko;
    }
    __syncthreads();
#pragma unroll
    for (int ks = 0; ks < 8; ++ks) {
      bf16x8 a[2], bq[2];
#pragma unroll
      for (int mi = 0; mi < 2; ++mi) a[mi] = frag_tr(Vt, 136, ks * 16, wm * 64 + mi * 32, lane);
#pragma unroll
      for (int ni = 0; ni < 2; ++ni) bq[ni] = frag_tr(Kt, 136, ks * 16, wn * 64 + ni * 32, lane);
#pragma unroll
      for (int mi = 0; mi < 2; ++mi)
#pragma unroll
        for (int ni = 0; ni < 2; ++ni) acc[mi][ni] = mfma(a[mi], bq[ni], acc[mi][ni]);
    }
    __syncthreads();
  }
  u16* RST = (u16*)((char*)p.out + OUT_HALF) + ((size_t)(sc * 4 + hd) * 512 + et * 128) * 256 + dt2 * 128;
#pragma unroll
  for (int mi = 0; mi < 2; ++mi)
#pragma unroll
    for (int ni = 0; ni < 2; ++ni)
#pragma unroll
      for (int i = 0; i < 16; ++i) Vt[(wm * 64 + mi * 32 + acc_row(i, h)) * 136 + wn * 64 + ni * 32 + r] = f2bf(acc[mi][ni][i]);
  asm volatile("s_waitcnt lgkmcnt(0)" ::: "memory");
#pragma unroll
  for (int j = 0; j < 8; ++j) {
    const int e = wm * 64 + (lane >> 3) + 8 * j, d = wn * 64 + (lane & 7) * 8;
    *(u32x4*)(RST + (size_t)e * 256 + d) = *(const u32x4*)(Vt + e * 136 + d);
  }
  __syncthreads();
}

DEV void phase_scan(const Params& p) {
  const int gt = get_bid() * 256 + get_tid(), nth = nworkers() * 256;
  const float* CD = (const float*)(p.ws + OFF_CD);
  for (int v = gt; v < 32768 + 65536; v += nth) {
    float st[8];
#pragma unroll
    for (int j = 0; j < 8; ++j) st[j] = 0.f;
    if (v < 32768) {
      const int e0 = v * 8, H = e0 >> 13;
      u16* base = (u16*)(p.ws + OFF_S1) + e0;
      for (int c0 = 0; c0 < 64; c0 += 8) {
        u32x4 x[8];
#pragma unroll
        for (int u = 0; u < 8; ++u) x[u] = *(const u32x4*)(base + (size_t)(c0 + u) * 262144);
#pragma unroll
        for (int u = 0; u < 8; ++u) {
          const float dcy = CD[(c0 + u) * 32 + H];
          u32x4 o;
#pragma unroll
          for (int j = 0; j < 4; ++j) {
            st[2 * j] = st[2 * j] * dcy + lo_f(x[u][j]);
            st[2 * j + 1] = st[2 * j + 1] * dcy + hi_f(x[u][j]);
            o[j] = pack2(st[2 * j], st[2 * j + 1]);
          }
          *(u32x4*)(base + (size_t)(c0 + u) * 262144) = o;
        }
      }
    } else {
      const int e0 = (v - 32768) * 8, hd = e0 >> 17;
      const float g256 = __expf(256.f * log_gamma(hd));
      u16* base = (u16*)((char*)p.out + OUT_HALF) + e0;
      for (int c0 = 0; c0 < 32; c0 += 8) {
        u32x4 x[8];
#pragma unroll
        for (int u = 0; u < 8; ++u) x[u] = *(const u32x4*)(base + (size_t)(c0 + u) * 524288);
#pragma unroll
        for (int u = 0; u < 8; ++u) {
          u32x4 o;
#pragma unroll
          for (int j = 0; j < 4; ++j) {
            st[2 * j] = st[2 * j] * g256 + lo_f(x[u][j]);
            st[2 * j + 1] = st[2 * j + 1] * g256 + hi_f(x[u][j]);
            o[j] = pack2(st[2 * j], st[2 * j + 1]);
          }
          *(u32x4*)(base + (size_t)(c0 + u) * 524288) = o;
        }
      }
    }
  }
}

DEV void ssd_out_item(const Params& p, int it, char* smem) {
  const int tid = get_tid(), lane = tid & 63, w = tid >> 6, wm = w >> 1, wn = w & 1, r = lane & 31, h = lane >> 5;
  const int c = it >> 3, rem = it & 7, g = rem & 3, lh = rem >> 2;
  if (c == 64 && lh == 1) return;
  u16* Ct = (u16*)smem;
  u16* Bt = Ct + 64 * 136;
  u16* Lt = Bt;
  u16* Xt = Bt + 128 * 136;
  float* acs = (float*)(Xt + 128 * 72);
  float* dts = acs + 128;
  float* rowsq = dts + 128;
  const u16* XBC = (const u16*)(p.ws + OFF_XBC);
  const float* DT = (const float*)(p.ws + OFF_DT);
  u16* Z = (u16*)(p.ws + OFF_Z);
  const int tok0 = c * 128;
  stage_conv<64, 128, false>(Ct, 136, XBC, tok0 + lh * 64, 2560 + g * 128, p.in[4], p.in[5], nullptr);
  stage_conv<128, 128, false>(Bt, 136, XBC, tok0, 2048 + g * 128, p.in[4], p.in[5], nullptr);
  if (tid < 64) rowsq[tid] = 0.f;
  __syncthreads();
  f32x16 cb[2];
  cb[0] = zero16(); cb[1] = zero16();
#pragma unroll
  for (int ks = 0; ks < 8; ++ks) {
    bf16x8 a = frag_row(Ct, 136, wm * 32 + r, ks * 16 + h * 8);
#pragma unroll
    for (int ni = 0; ni < 2; ++ni) {
      bf16x8 bq = frag_row(Bt, 136, wn * 64 + ni * 32 + r, ks * 16 + h * 8);
      cb[ni] = mfma(a, bq, cb[ni]);
    }
  }
  for (int hh = 0; hh < 8; ++hh) {
    const int H = g * 8 + hh;
    u32x4 zv[2];
    {
      int tz = tok0 + lh * 64 + (tid >> 2); tz = tz < L ? tz : L - 1;
      const u16* zp0 = Z + (size_t)tz * 2048 + H * 64 + (tid & 3) * 16;
      zv[0] = *(const u32x4*)zp0; zv[1] = *(const u32x4*)(zp0 + 8);
    }
    __syncthreads();
    if (w == 0) {
      const float A = -expf(p.in[7][H]);
      chunk_cumsum(DT, c, H, A, acs, dts, lane);
    }
    stage_conv<128, 64, false>(Xt, 72, XBC, tok0, H * 64, p.in[4], p.in[5], nullptr);
    __syncthreads();
#pragma unroll
    for (int ni = 0; ni < 2; ++ni)
#pragma unroll
      for (int i = 0; i < 16; ++i) {
        const int ll = wm * 32 + acc_row(i, h), l = lh * 64 + ll, s = wn * 64 + ni * 32 + r;
        float val = 0.f;
        if (s <= l) val = cb[ni][i] * __expf(acs[l] - acs[s]) * dts[s];
        Lt[ll * 136 + s] = f2bf(val);
      }
    f32x16 y = zero16();
    if (c > 0) {
      const u16* pv = (const u16*)(p.ws + OFF_S1) + ((size_t)((c - 1) * 32 + H) * 64 + wn * 32 + r) * 128 + h * 8;
#pragma unroll
      for (int ks = 0; ks < 8; ++ks) {
        bf16x8 a = frag_row(Ct, 136, wm * 32 + r, ks * 16 + h * 8);
        bf16x8 bq = *(const bf16x8*)(pv + ks * 16);
        y = mfma(a, bq, y);
      }
#pragma unroll
      for (int i = 0; i < 16; ++i) { const int l = lh * 64 + wm * 32 + acc_row(i, h); y[i] *= __expf(acs[l]); }
    }
    __syncthreads();
#pragma unroll
    for (int ks = 0; ks < 8; ++ks) {
      bf16x8 a = frag_row(Lt, 136, wm * 32 + r, ks * 16 + h * 8);
      bf16x8 bq = frag_tr(Xt, 72, ks * 16, wn * 32, lane);
      y = mfma(a, bq, y);
    }
    const float Dsk = p.in[8][H];
    float* Ys = (float*)(Bt + 64 * 136);
#pragma unroll
    for (int i = 0; i < 16; ++i) Ys[(wm * 32 + acc_row(i, h)) * 68 + wn * 32 + r] = y[i];
    __syncthreads();
    {
      const int row = tid >> 2, q = tid & 3, l = lh * 64 + row, t = tok0 + l;
      float sq = 0.f;
      if (t < L) {
        u16* zp = Z + (size_t)t * 2048 + H * 64 + q * 16;
        u32x4 xv[2], ov[2];
        xv[0] = *(const u32x4*)(Xt + l * 72 + q * 16); xv[1] = *(const u32x4*)(Xt + l * 72 + q * 16 + 8);
#pragma unroll
        for (int k = 0; k < 2; ++k) {
          const f32x4 ya = *(const f32x4*)(Ys + row * 68 + q * 16 + k * 8), yb = *(const f32x4*)(Ys + row * 68 + q * 16 + k * 8 + 4);
          float o[8];
#pragma unroll
          for (int j = 0; j < 4; ++j) {
            const float y0 = (j < 2) ? ya[2 * j] : yb[2 * j - 4], y1 = (j < 2) ? ya[2 * j + 1] : yb[2 * j - 3];
            o[2 * j] = (y0 + Dsk * lo_f(xv[k][j])) * silu_f(lo_f(zv[k][j]));
            o[2 * j + 1] = (y1 + Dsk * hi_f(xv[k][j])) * silu_f(hi_f(zv[k][j]));
            sq += o[2 * j] * o[2 * j] + o[2 * j + 1] * o[2 * j + 1];
            ov[k][j] = pack2(o[2 * j], o[2 * j + 1]);
          }
        }
        *(u32x4*)zp = ov[0]; *(u32x4*)(zp + 8) = ov[1];
      }
      sq += __shfl_xor(sq, 1); sq += __shfl_xor(sq, 2);
      if (q == 0) rowsq[row] += sq;
    }
  }
  __syncthreads();
  {
    const int row = tid >> 2, q = tid & 3, t = tok0 + lh * 64 + row;
    if (t < L) {
      const float rn = rsqrtf(rowsq[row] * (1.f / 512.f) + EPS);
      u32x4 v[16];
#pragma unroll
      for (int hh = 0; hh < 8; ++hh) {
        const u16* zp = Z + (size_t)t * 2048 + (g * 8 + hh) * 64 + q * 16;
        v[2 * hh] = *(const u32x4*)zp; v[2 * hh + 1] = *(const u32x4*)(zp + 8);
      }
#pragma unroll
      for (int hh = 0; hh < 8; ++hh) {
        u16* zp = Z + (size_t)t * 2048 + (g * 8 + hh) * 64 + q * 16;
        const float* nwp = p.in[9] + (g * 8 + hh) * 64 + q * 16;
#pragma unroll
        for (int k = 0; k < 2; ++k) {
          const f32x4 wa = *(const f32x4*)(nwp + k * 8), wb = *(const f32x4*)(nwp + k * 8 + 4);
          u32x4 o;
          o[0] = pack2(lo_f(v[2 * hh + k][0]) * rn * wa[0], hi_f(v[2 * hh + k][0]) * rn * wa[1]);
          o[1] = pack2(lo_f(v[2 * hh + k][1]) * rn * wa[2], hi_f(v[2 * hh + k][1]) * rn * wa[3]);
          o[2] = pack2(lo_f(v[2 * hh + k][2]) * rn * wb[0], hi_f(v[2 * hh + k][2]) * rn * wb[1]);
          o[3] = pack2(lo_f(v[2 * hh + k][3]) * rn * wb[2], hi_f(v[2 * hh + k][3]) * rn * wb[3]);
          *(u32x4*)(zp + k * 8) = o;
        }
      }
    }
  }
  __syncthreads();
}

DEV void ret_out_item(const Params& p, int it, char* smem) {
  const int tid = get_tid(), lane = tid & 63, w = tid >> 6, wm = w >> 1, wn = w & 1, r = lane & 31, h = lane >> 5;
  const int rt = it >> 2, hd = it & 3;
  const int t0 = rt * 64, sc = rt >> 2, qtr = rt & 3;
  u16* P = (u16*)smem;
  char* gsm = smem + 33792;
  u16* Vt = (u16*)gsm;
  float* rowsq = (float*)(smem + 33792 + 27648);
  const u16* Qg = (const u16*)(p.ws + OFF_Q) + hd * 256;
  const u16* Kg = (const u16*)(p.ws + OFF_K) + hd * 256;
  const u16* Vg = (const u16*)(p.ws + OFF_V);
  u16* Gg = (u16*)(p.ws + OFF_G);
  const u16* RST = (const u16*)((char*)p.out + OUT_HALF);
  const float lg = log_gamma(hd);
  if (tid < 64) rowsq[tid] = 0.f;
  const int nkb = (qtr >= 2) ? 2 : 1;
  for (int kb = 0; kb < nkb; ++kb) {
    f32x16 acc[1][2];
    acc[0][0] = zero16(); acc[0][1] = zero16();
    gemm_tile<1>(acc, Qg, 1024, t0, L - 1, Kg, 1024, sc * 256 + kb * 128, 256, gsm);
#pragma unroll
    for (int ni = 0; ni < 2; ++ni)
#pragma unroll
      for (int i = 0; i < 16; ++i) {
        const int ll = wm * 32 + acc_row(i, h), lp = qtr * 64 + ll, s = kb * 128 + wn * 64 + ni * 32 + r;
        float val = 0.f;
        if (s <= lp) val = acc[0][ni][i] * __expf((float)(lp - s) * lg);
        P[ll * 264 + s] = f2bf(val);
      }
  }
  float rs[16];
#pragma unroll
  for (int i = 0; i < 16; ++i) rs[i] = 0.f;
  for (int et = 0; et < 4; ++et) {
    f32x16 acc[1][2];
    acc[0][0] = zero16(); acc[0][1] = zero16();
    u32x4 gv[4], vreg[4];
    {
      int tg = t0 + (tid >> 2); tg = tg < L ? tg : L - 1;
      const u16* gp0 = Gg + (size_t)tg * 2048 + hd * 512 + et * 128 + (tid & 3) * 32;
#pragma unroll
      for (int k = 0; k < 4; ++k) gv[k] = *(const u32x4*)(gp0 + k * 8);
#pragma unroll
      for (int i = 0; i < 4; ++i) {
        const int cidx = tid + i * 256, row = cidx >> 4, cc = cidx & 15;
        int tok = sc * 256 + row; tok = tok < L ? tok : L - 1;
        vreg[i] = *(const u32x4*)(Vg + (size_t)tok * 2048 + hd * 512 + et * 128 + cc * 8);
      }
    }
    if (sc > 0) {
      gemm_tile<1>(acc, Qg, 1024, t0, L - 1, RST + ((size_t)((sc - 1) * 4 + hd) * 512 + et * 128) * 256, 256, 0, 256, gsm);
#pragma unroll
      for (int ni = 0; ni < 2; ++ni)
#pragma unroll
        for (int i = 0; i < 16; ++i) {
          const int lp = qtr * 64 + wm * 32 + acc_row(i, h);
          acc[0][ni][i] *= __expf((float)(lp + 1) * lg);
        }
    }
    for (int kb64 = 0; kb64 <= qtr; ++kb64) {
#pragma unroll
      for (int i = 0; i < 4; ++i) {
        const int cidx = tid + i * 256, row = cidx >> 4, cc = cidx & 15;
        const int tok = sc * 256 + kb64 * 64 + row;
        u32x4 v = {0u, 0u, 0u, 0u};
        if (tok < L) v = vreg[i];
        *(u32x4*)(Vt + row * 136 + cc * 8) = v;
      }
      __syncthreads();
      if (kb64 < qtr) {
#pragma unroll
        for (int i = 0; i < 4; ++i) {
          const int cidx = tid + i * 256, row = cidx >> 4, cc = cidx & 15;
          int tok = sc * 256 + (kb64 + 1) * 64 + row; tok = tok < L ? tok : L - 1;
          vreg[i] = *(const u32x4*)(Vg + (size_t)tok * 2048 + hd * 512 + et * 128 + cc * 8);
        }
      }
#pragma unroll
      for (int ks = 0; ks < 4; ++ks) {
        bf16x8 a = frag_row(P, 264, wm * 32 + r, kb64 * 64 + ks * 16 + h * 8);
#pragma unroll
        for (int ni = 0; ni < 2; ++ni) {
          bf16x8 bq = frag_tr(Vt, 136, ks * 16, wn * 64 + ni * 32, lane);
          acc[0][ni] = mfma(a, bq, acc[0][ni]);
        }
      }
      __syncthreads();
    }
    u16* Os = (u16*)gsm;
#pragma unroll
    for (int ni = 0; ni < 2; ++ni)
#pragma unroll
      for (int i = 0; i < 16; ++i) {
        const float o = acc[0][ni][i];
        if (t0 + wm * 32 + acc_row(i, h) < L) rs[i] += o * o;
        Os[(wm * 32 + acc_row(i, h)) * 136 + wn * 64 + ni * 32 + r] = f2bf(o);
      }
    __syncthreads();
    {
      const int row = tid >> 2, q = tid & 3, t = t0 + row;
      if (t < L) {
        u16* gp = Gg + (size_t)t * 2048 + hd * 512 + et * 128 + q * 32;
        u32x4 ov[4];
#pragma unroll
        for (int k = 0; k < 4; ++k) ov[k] = *(const u32x4*)(Os + row * 136 + q * 32 + k * 8);
#pragma unroll
        for (int k = 0; k < 4; ++k) {
          u32x4 o;
#pragma unroll
          for (int j = 0; j < 4; ++j) o[j] = pack2(silu_f(lo_f(gv[k][j])) * lo_f(ov[k][j]), silu_f(hi_f(gv[k][j])) * hi_f(ov[k][j]));
          *(u32x4*)(gp + k * 8) = o;
        }
      }
    }
    __syncthreads();
  }
#pragma unroll
  for (int i = 0; i < 16; ++i) {
    const float v = half_sum(rs[i]);
    if (r == 0) atomicAdd(&rowsq[wm * 32 + acc_row(i, h)], v);
  }
  __syncthreads();
  {
    const int row = tid >> 2, q = tid & 3, t = t0 + row;
    if (t < L) {
      const float rn = rsqrtf(rowsq[row] * (1.f / 512.f) + EPS);
      u32x4 v[16];
#pragma unroll
      for (int et = 0; et < 4; ++et)
#pragma unroll
        for (int k = 0; k < 4; ++k) v[et * 4 + k] = *(const u32x4*)(Gg + (size_t)t * 2048 + hd * 512 + et * 128 + q * 32 + k * 8);
#pragma unroll
      for (int et = 0; et < 4; ++et)
#pragma unroll
        for (int k = 0; k < 4; ++k) {
          u32x4 o;
#pragma unroll
          for (int j = 0; j < 4; ++j) o[j] = pack2(lo_f(v[et * 4 + k][j]) * rn, hi_f(v[et * 4 + k][j]) * rn);
          *(u32x4*)(Gg + (size_t)t * 2048 + hd * 512 + et * 128 + q * 32 + k * 8) = o;
        }
    }
  }
  __syncthreads();
}

DEV void merge_tile(const Params& p, int it, char* smem) {
  const int tid = get_tid(), lane = tid & 63, w = tid >> 6, wm = w >> 1, wn = w & 1, r = lane & 31, h = lane >> 5;
  const int nt = it / 65, mt = it % 65;
  u16* GS = (u16*)(p.ws + OFF_GS);
  const u16* GR = (const u16*)(p.ws + OFF_GR);
  f32x16 acc[2][2];
#pragma unroll
  for (int mi = 0; mi < 2; ++mi)
#pragma unroll
    for (int ni = 0; ni < 2; ++ni) acc[mi][ni] = zero16();
  gemm_tile<2>(acc, (const u16*)(p.ws + OFF_Z), 2048, mt * 128, L - 1, (const u16*)(p.ws + OFF_S2), 2048, nt * 128, 2048, smem);
#pragma unroll
  for (int mi = 0; mi < 2; ++mi)
#pragma unroll
    for (int ni = 0; ni < 2; ++ni)
#pragma unroll
      for (int i = 0; i < 16; ++i) {
        const int t = mt * 128 + wm * 64 + mi * 32 + acc_row(i, h);
        if (t < L) {
          const size_t idx = (size_t)t * 1024 + nt * 128 + wn * 64 + ni * 32 + r;
          GS[idx] = f2bf(bf2f(GS[idx]) * acc[mi][ni][i]);
        }
        acc[mi][ni][i] = 0.f;
      }
  gemm_tile<2>(acc, (const u16*)(p.ws + OFF_G), 2048, mt * 128, L - 1, (const u16*)(p.ws + OFF_S2 + 4194304), 2048, nt * 128, 2048, smem);
#pragma unroll
  for (int mi = 0; mi < 2; ++mi)
#pragma unroll
    for (int ni = 0; ni < 2; ++ni)
#pragma unroll
      for (int i = 0; i < 16; ++i) {
        const int t = mt * 128 + wm * 64 + mi * 32 + acc_row(i, h);
        if (t < L) {
          const size_t idx = (size_t)t * 1024 + nt * 128 + wn * 64 + ni * 32 + r;
          GS[idx] = f2bf(bf2f(GS[idx]) + bf2f(GR[idx]) * acc[mi][ni][i]);
        }
      }
}

DEV void phase_merge(const Params& p, char* smem) {
  const int n_tiles = 65 * 8;
  const int n_wout = 16 * 16, n_wup = 16 * 88, n_wdown = 44 * 16;
  const int total = n_tiles + n_wout + n_wup + n_wdown;
  for (int it = get_bid(); it < total; it += nworkers()) {
    if (it < n_tiles) merge_tile(p, it, smem);
    else if (it < n_tiles + n_wout) { const int j = it - n_tiles; convert_tile(p.in[12], 1024, 1024, (u16*)(p.ws + OFF_WOUT), j & 15, j >> 4, 0, smem); }
    else if (it < n_tiles + n_wout + n_wup) { const int j = it - n_tiles - n_wout; convert_tile(p.in[14], 5632, 1024, (u16*)(p.ws + OFF_WUP), j & 15, j >> 4, 0, smem); }
    else { const int j = it - n_tiles - n_wout - n_wup; convert_tile(p.in[17], 1024, 2816, (u16*)(p.ws + OFF_WDOWN), j % 44, j / 44, 0, smem); }
  }
}

DEV void phase_outproj(const Params& p, int b, char* smem) {
  const int tid = get_tid(), lane = tid & 63, w = tid >> 6, wm = w >> 1, wn = w & 1, r = lane & 31, h = lane >> 5;
  float* HM = (float*)(p.ws + OFF_HM);
  for (int it = get_bid(); it < 65 * 8; it += gridDim.x) {
    const int nt = it / 65, mt = it % 65;
    f32x16 acc[2][2];
#pragma unroll
    for (int mi = 0; mi < 2; ++mi)
#pragma unroll
      for (int ni = 0; ni < 2; ++ni) acc[mi][ni] = zero16();
    gemm_tile<2>(acc, (const u16*)(p.ws + OFF_GS), 1024, mt * 128, L - 1, (const u16*)(p.ws + OFF_WOUT), 1024, nt * 128, 1024, smem);
#pragma unroll
    for (int mi = 0; mi < 2; ++mi)
#pragma unroll
      for (int ni = 0; ni < 2; ++ni)
#pragma unroll
        for (int i = 0; i < 16; ++i) {
          const int t = mt * 128 + wm * 64 + mi * 32 + acc_row(i, h);
          const int col = nt * 128 + wn * 64 + ni * 32 + r;
          if (t < NMETA) HM[t * 1024 + col] = p.in[1][t * 1024 + col] + acc[mi][ni][i];
          else if (t < L) {
            const size_t idx = ((size_t)b * SEQ + (t - NMETA)) * 1024 + col;
            p.out[idx] = p.in[0][idx] + acc[mi][ni][i];
          }
        }
  }
}

DEV void phase_norm2(const Params& p, int b) {
  const int lane = get_tid() & 63, w = get_tid() >> 6;
  u16* U2 = (u16*)(p.ws + OFF_U2);
  for (int it = get_bid(); it < L / 4; it += nworkers()) {
    const int t = it * 4 + w;
    const float* src = (t < NMETA) ? ((const float*)(p.ws + OFF_HM) + (size_t)t * D) : (p.out + ((size_t)b * SEQ + (t - NMETA)) * D);
    rmsnorm_row_bf16(src, p.in[13], U2 + (size_t)t * D, lane);
  }
}

DEV void phase_up(const Params& p, char* smem) {
  const int tid = get_tid(), lane = tid & 63, w = tid >> 6, wm = w >> 1, wn = w & 1, r = lane & 31, h = lane >> 5;
  u16* UP = (u16*)(p.ws + OFF_UP);
  for (int it = get_bid(); it < 65 * 44; it += gridDim.x) {
    const int nt = it / 65, mt = it % 65;
    f32x16 acc[2][2];
#pragma unroll
    for (int mi = 0; mi < 2; ++mi)
#pragma unroll
      for (int ni = 0; ni < 2; ++ni) acc[mi][ni] = zero16();
    gemm_tile<2>(acc, (const u16*)(p.ws + OFF_U2), 1024, mt * 128, L - 1, (const u16*)(p.ws + OFF_WUP), 1024, nt * 128, 1024, smem);
#pragma unroll
    for (int mi = 0; mi < 2; ++mi)
#pragma unroll
      for (int ni = 0; ni < 2; ++ni)
#pragma unroll
        for (int i = 0; i < 16; ++i) {
          const int t = mt * 128 + wm * 64 + mi * 32 + acc_row(i, h);
          if (t < L) UP[(size_t)t * 5632 + nt * 128 + wn * 64 + ni * 32 + r] = f2bf(acc[mi][ni][i]);
        }
  }
}

DEV void phase_ffn_act(const Params& p) {
  const int gt = get_bid() * 256 + get_tid(), nth = nworkers() * 256;
  const u16* UP = (const u16*)(p.ws + OFF_UP);
  u16* ACT = (u16*)(p.ws + OFF_ACT);
  const float* cw = p.in[15];
  const float* cbias = p.in[16];
  for (int u = gt; u < 513 * 352; u += nth) {
    const int rb = u / 352, cgp = u % 352, ch = cgp * 8, t0 = rb * 16;
    float wg[3][8], wv[3][8], bg[8], bv[8], g2[8], g1[8], v2[8], v1[8];
#pragma unroll
    for (int k = 0; k < 3; ++k)
#pragma unroll
      for (int j = 0; j < 8; ++j) { wg[k][j] = cw[k * 5632 + ch + j]; wv[k][j] = cw[k * 5632 + 2816 + ch + j]; }
#pragma unroll
    for (int j = 0; j < 8; ++j) { bg[j] = cbias[ch + j]; bv[j] = cbias[2816 + ch + j]; }
    {
      u32x4 a = {0u, 0u, 0u, 0u}, bq = {0u, 0u, 0u, 0u}, c2 = {0u, 0u, 0u, 0u}, d2 = {0u, 0u, 0u, 0u};
      if (t0 >= 2) {
        a = *(const u32x4*)(UP + (size_t)(t0 - 2) * 5632 + ch); bq = *(const u32x4*)(UP + (size_t)(t0 - 1) * 5632 + ch);
        c2 = *(const u32x4*)(UP + (size_t)(t0 - 2) * 5632 + 2816 + ch); d2 = *(const u32x4*)(UP + (size_t)(t0 - 1) * 5632 + 2816 + ch);
      }
#pragma unroll
      for (int j = 0; j < 4; ++j) {
        g2[2 * j] = lo_f(a[j]); g2[2 * j + 1] = hi_f(a[j]); g1[2 * j] = lo_f(bq[j]); g1[2 * j + 1] = hi_f(bq[j]);
        v2[2 * j] = lo_f(c2[j]); v2[2 * j + 1] = hi_f(c2[j]); v1[2 * j] = lo_f(d2[j]); v1[2 * j + 1] = hi_f(d2[j]);
      }
    }
#pragma unroll 4
    for (int i = 0; i < 16; ++i) {
      const int t = t0 + i;
      const u32x4 a = *(const u32x4*)(UP + (size_t)t * 5632 + ch);
      const u32x4 c2 = *(const u32x4*)(UP + (size_t)t * 5632 + 2816 + ch);
      float o[8];
#pragma unroll
      for (int j = 0; j < 8; ++j) {
        const float gx = (j & 1) ? hi_f(a[j >> 1]) : lo_f(a[j >> 1]);
        const float vx = (j & 1) ? hi_f(c2[j >> 1]) : lo_f(c2[j >> 1]);
        const float ag = bg[j] + wg[0][j] * g2[j] + wg[1][j] * g1[j] + wg[2][j] * gx;
        const float av = bv[j] + wv[0][j] * v2[j] + wv[1][j] * v1[j] + wv[2][j] * vx;
        o[j] = silu_f(ag) * av;
        g2[j] = g1[j]; g1[j] = gx; v2[j] = v1[j]; v1[j] = vx;
      }
      u32x4 pk; pk[0] = pack2(o[0], o[1]); pk[1] = pack2(o[2], o[3]); pk[2] = pack2(o[4], o[5]); pk[3] = pack2(o[6], o[7]);
      *(u32x4*)(ACT + (size_t)t * 2816 + ch) = pk;
    }
  }
}

DEV void phase_down(const Params& p, int b, char* smem) {
  const int tid = get_tid(), lane = tid & 63, w = tid >> 6, wm = w >> 1, wn = w & 1, r = lane & 31, h = lane >> 5;
  for (int it = get_bid(); it < 64 * 8; it += gridDim.x) {
    const int nt = it / 64, mt = it % 64;
    f32x16 acc[2][2];
#pragma unroll
    for (int mi = 0; mi < 2; ++mi)
#pragma unroll
      for (int ni = 0; ni < 2; ++ni) acc[mi][ni] = zero16();
    gemm_tile<2>(acc, (const u16*)(p.ws + OFF_ACT), 2816, NMETA + mt * 128, L - 1, (const u16*)(p.ws + OFF_WDOWN), 2816, nt * 128, 2816, smem);
#pragma unroll
    for (int mi = 0; mi < 2; ++mi)
#pragma unroll
      for (int ni = 0; ni < 2; ++ni)
#pragma unroll
        for (int i = 0; i < 16; ++i) {
          const int rr = mt * 128 + wm * 64 + mi * 32 + acc_row(i, h);
          const size_t idx = ((size_t)b * SEQ + rr) * 1024 + nt * 128 + wn * 64 + ni * 32 + r;
          p.out[idx] += acc[mi][ni][i];
        }
  }
}

DEV void phase_final_norm(const Params& p, int b) {
  const int lane = get_tid() & 63, w = get_tid() >> 6;
  for (int it = get_bid(); it < SEQ / 4; it += nworkers()) {
    const int rr = it * 4 + w;
    rmsnorm_row_f32_inplace(p.out + ((size_t)b * SEQ + rr) * D, p.in[18], lane);
  }
}


DEV u32x4 add_bf16x8(u32x4 a, u32x4 b) {
  u32x4 o;
#pragma unroll
  for (int j = 0; j < 4; ++j) o[j] = pack2(lo_f(a[j]) + lo_f(b[j]), hi_f(a[j]) + hi_f(b[j]));
  return o;
}
template <int NJ, bool ADD2 = false>
DEV void gemm_tile8(f32x4 (&acc)[4][NJ], const u16* __restrict__ A, int lda, int arow0, int arow_max,
                    const u16* __restrict__ B, int ldb, int brow0, int K, char* smem, const u16* __restrict__ A2 = nullptr) {
  constexpr int BN = NJ * 32;
  constexpr int BCH = BN / 64;
  constexpr int STAGE = (256 + BN) * 64;
  u16* S = (u16*)smem;
  const int tid = get_tid8(), lane = tid & 63, w = tid >> 6, wm = w >> 1, wn = w & 1;
  u32x4 ra[4], rb[BCH], ra2[ADD2 ? 4 : 1];
  unsigned aoff[4], boff[BCH];
  const char* Ab = (const char*)A;
  const char* Ab2 = (const char*)A2;
  const char* Bb = (const char*)(B + (size_t)brow0 * ldb);
  const int crow = tid >> 3, kc = tid & 7;
  const unsigned sto = (unsigned)(crow * 64 + ((kc ^ ((crow >> 1) & 7)) * 8));
#pragma unroll
  for (int i = 0; i < 4; ++i) {
    int gr = arow0 + crow + i * 64; gr = gr > arow_max ? arow_max : gr; gr = gr < 0 ? 0 : gr;
    aoff[i] = ((unsigned)gr * (unsigned)lda + kc * 8) * 2u;
  }
#pragma unroll
  for (int i = 0; i < BCH; ++i) boff[i] = ((unsigned)(crow + i * 64) * (unsigned)ldb + kc * 8) * 2u;
  const int fr = lane & 15, swz = fr >> 1, cq = lane >> 4;
  const unsigned fa = (unsigned)((wm * 64 + fr) * 64), fb = (unsigned)((256 + wn * (NJ * 16) + fr) * 64);
  const unsigned c0 = (unsigned)(((cq) ^ swz) * 8), c1 = (unsigned)(((4 + cq) ^ swz) * 8);
  const int nk = K >> 6;
#pragma unroll
  for (int i = 0; i < 4; ++i) { ra[i] = *(const u32x4*)(Ab + aoff[i]); if (ADD2) ra2[i] = *(const u32x4*)(Ab2 + aoff[i]); }
#pragma unroll
  for (int i = 0; i < BCH; ++i) rb[i] = *(const u32x4*)(Bb + boff[i]);
#pragma unroll
  for (int i = 0; i < 4; ++i) *(u32x4*)(S + sto + i * 64 * 64) = ADD2 ? add_bf16x8(ra[i], ra2[i]) : ra[i];
#pragma unroll
  for (int i = 0; i < BCH; ++i) *(u32x4*)(S + sto + (256 + i * 64) * 64) = rb[i];
  if (nk > 1) {
#pragma unroll
    for (int i = 0; i < 4; ++i) { ra[i] = *(const u32x4*)(Ab + aoff[i] + 128); if (ADD2) ra2[i] = *(const u32x4*)(Ab2 + aoff[i] + 128); }
#pragma unroll
    for (int i = 0; i < BCH; ++i) rb[i] = *(const u32x4*)(Bb + boff[i] + 128);
  }
  __syncthreads();
  for (int kt = 0; kt < nk; ++kt) {
    const u16* Sc = S + (kt & 1) * STAGE;
    {
      bf16x8 a[4], b[NJ];
#pragma unroll
      for (int m = 0; m < 4; ++m) a[m] = *(const bf16x8*)(Sc + fa + m * 16 * 64 + c0);
#pragma unroll
      for (int n = 0; n < NJ; ++n) b[n] = *(const bf16x8*)(Sc + fb + n * 16 * 64 + c0);
      __builtin_amdgcn_s_setprio(1);
#pragma unroll
      for (int m = 0; m < 4; ++m)
#pragma unroll
        for (int n = 0; n < NJ; ++n) acc[m][n] = __builtin_amdgcn_mfma_f32_16x16x32_bf16(a[m], b[n], acc[m][n], 0, 0, 0);
      __builtin_amdgcn_s_setprio(0);
    }
    __builtin_amdgcn_sched_barrier(0);
    bf16x8 a1[4], b1[NJ];
#pragma unroll
    for (int m = 0; m < 4; ++m) a1[m] = *(const bf16x8*)(Sc + fa + m * 16 * 64 + c1);
#pragma unroll
    for (int n = 0; n < NJ; ++n) b1[n] = *(const bf16x8*)(Sc + fb + n * 16 * 64 + c1);
    __builtin_amdgcn_sched_barrier(0);
    if (kt + 1 < nk) {
      u16* Aw = S + ((kt + 1) & 1) * STAGE;
#pragma unroll
      for (int i = 0; i < 4; ++i) *(u32x4*)(Aw + sto + i * 64 * 64) = ADD2 ? add_bf16x8(ra[i], ra2[i]) : ra[i];
#pragma unroll
      for (int i = 0; i < BCH; ++i) *(u32x4*)(Aw + sto + (256 + i * 64) * 64) = rb[i];
      if (kt + 2 < nk) {
        const unsigned ko = (unsigned)(kt + 2) * 128u;
#pragma unroll
        for (int i = 0; i < 4; ++i) { ra[i] = *(const u32x4*)(Ab + aoff[i] + ko); if (ADD2) ra2[i] = *(const u32x4*)(Ab2 + aoff[i] + ko); }
#pragma unroll
        for (int i = 0; i < BCH; ++i) rb[i] = *(const u32x4*)(Bb + boff[i] + ko);
      }
    }
    __builtin_amdgcn_sched_barrier(0);
    {
      __builtin_amdgcn_s_setprio(1);
#pragma unroll
      for (int m = 0; m < 4; ++m)
#pragma unroll
        for (int n = 0; n < NJ; ++n) acc[m][n] = __builtin_amdgcn_mfma_f32_16x16x32_bf16(a1[m], b1[n], acc[m][n], 0, 0, 0);
      __builtin_amdgcn_s_setprio(0);
    }
    __syncthreads();
  }
}

DEV f32x4 thin16(const u16* __restrict__ A, int lda, int row0, const u16* __restrict__ BT, int ldb, int col0, int K, int lane) {
  const u16* ap = A + (size_t)(row0 + (lane & 15)) * lda + 8 * (lane >> 4);
  const u16* bp = BT + (size_t)(col0 + (lane & 15)) * ldb + 8 * (lane >> 4);
  f32x4 acc = {0.f, 0.f, 0.f, 0.f};
  for (int k0 = 0; k0 < K; k0 += 128) {
    bf16x8 a[4], b[4];
#pragma unroll
    for (int j = 0; j < 4; ++j) { a[j] = *(const bf16x8*)(ap + k0 + j * 32); b[j] = *(const bf16x8*)(bp + k0 + j * 32); }
#pragma unroll
    for (int j = 0; j < 4; ++j) acc = __builtin_amdgcn_mfma_f32_16x16x32_bf16(a[j], b[j], acc, 0, 0, 0);
  }
  return acc;
}

DEV int tile_index(int k) { const int G = gridDim.x, rb = get_rbid(); return k * G + (rb & 7) * (G >> 3) + (rb >> 3); }
DEV void tile_decode(int T, int MT, int NT, int& mt, int& nt) {
  const int per = MT * 8;
  const int nb = T / per, rem = T - nb * per;
  int width = NT - nb * 8; width = width > 8 ? 8 : width;
  mt = rem / width; nt = nb * 8 + (rem - mt * width);
}

#define ZERO_ACC(acc, NJ_) _Pragma("unroll") for (int m_ = 0; m_ < 4; ++m_) _Pragma("unroll") for (int n_ = 0; n_ < NJ_; ++n_) { acc[m_][n_][0] = 0.f; acc[m_][n_][1] = 0.f; acc[m_][n_][2] = 0.f; acc[m_][n_][3] = 0.f; }

constexpr int EPI_WAVE_BYTES = 17408;
#define EPI_FENCE() asm volatile("s_waitcnt lgkmcnt(0)" ::: "memory")
DEV void epi_store_bf16_128(const u16* reg, u16* __restrict__ dst, int ld, int trow, int col0, int lane) {
#pragma unroll
  for (int j = 0; j < 16; ++j) {
    const int row = (lane >> 4) + 4 * j, t = trow + row;
    const u32x4 v = *(const u32x4*)(reg + row * 136 + (lane & 15) * 8);
    if (t < L) *(u32x4*)(dst + (size_t)t * ld + col0 + (lane & 15) * 8) = v;
  }
}

DEV void phase_inproj8(const Params& p, int b, char* smem) {
  const u16* U = (const u16*)((char*)p.out + OUT_HALF);
  const u16* WT = (const u16*)(p.ws + OFF_S1);
  const int MT = 33, NT = 53;
  for (int kk = 0;; ++kk) {
    const int it = tile_index(kk);
    if (it >= MT * NT) break;
    int mt, nt; tile_decode(it, MT, NT, mt, nt);
    f32x4 acc[4][8];
    ZERO_ACC(acc, 8)
    gemm_tile8<8>(acc, U, 1024, mt * 256, L - 1, WT, 1024, nt * 256, 1024, smem);
    const int tid = get_tid8(), lane = tid & 63, w = tid >> 6, wm = w >> 1, wn = w & 1, r = lane & 31, h = lane >> 5;
    u16* reg = (u16*)(smem + w * EPI_WAVE_BYTES);
    const int n0 = nt * 256;
    const int trow = mt * 256 + wm * 64;
    if (nt >= 20 && nt < 28) {
      const bool isk = nt >= 24;
      const int cq = n0 - (isk ? 6144 : 5120);
      const float sc = isk ? 0.0625f : 1.f;
      u16* dst = (u16*)(p.ws + (isk ? OFF_K : OFF_Q));
#pragma unroll
      for (int pr = 0; pr < 4; ++pr) {
        const int n1 = 4 * (pr >> 1) + (pr & 1);
        const int jf = (wn * 2 + (pr >> 1)) * 32 + (pr & 1) * 16 + (lane & 15);
        const float invf_rev = exp2f(-(float)jf * 0.10462765653f) * 0.15915494309189535f;
#pragma unroll
        for (int m = 0; m < 4; ++m)
#pragma unroll
          for (int j = 0; j < 4; ++j) {
            const int row = m * 16 + (lane >> 4) * 4 + j;
            const float tf = (float)(trow + row);
            const float ph = tf * invf_rev, pl = fmaf(tf, invf_rev, -ph);
            const float fr = (ph - floorf(ph)) + pl;
            const float sn = __builtin_amdgcn_sinf(fr), cs = __builtin_amdgcn_cosf(fr);
            const float x1 = acc[m][n1][j], x2 = acc[m][n1 + 2][j];
            reg[row * 136 + n1 * 16 + (lane & 15)] = f2bf((x1 * cs - x2 * sn) * sc);
            reg[row * 136 + n1 * 16 + 32 + (lane & 15)] = f2bf((x2 * cs + x1 * sn) * sc);
          }
      }
      EPI_FENCE();
      epi_store_bf16_128(reg, dst, 1024, trow, cq + wn * 128, lane);
    } else if (nt == 52) {
      float* DT = (float*)(p.ws + OFF_DT);
      if (wn == 0) {
#pragma unroll
        for (int n = 0; n < 2; ++n) {
          const int col = n * 16 + (lane & 15);
          const float bias = p.in[6][col];
#pragma unroll
          for (int m = 0; m < 4; ++m)
#pragma unroll
            for (int j = 0; j < 4; ++j) {
              const int t = trow + m * 16 + (lane >> 4) * 4 + j;
              if (t < L) {
                const float x = acc[m][n][j] + bias;
                const float e = __expf(x);
                DT[(size_t)t * 32 + col] = (x > 20.f) ? x : (e < 0.01f ? e * (1.f - 0.5f * e + e * e * (1.f / 3.f)) : __logf(1.f + e));
              }
            }
        }
      }
    } else {
      u16* dst; int ld, c0; bool sig = false;
      if (nt < 8) { dst = (u16*)(p.ws + OFF_Z); ld = 2048; c0 = n0; }
      else if (nt < 20) { dst = (u16*)(p.ws + OFF_XBC); ld = 3072; c0 = n0 - 2048; }
      else if (nt < 36) { dst = (u16*)(p.ws + OFF_V); ld = 2048; c0 = n0 - 7168; }
      else if (nt < 44) { dst = (u16*)(p.ws + OFF_G); ld = 2048; c0 = n0 - 9216; }
      else if (nt < 48) { dst = (u16*)(p.ws + OFF_GS); ld = 1024; c0 = n0 - 11264; sig = true; }
      else { dst = (u16*)(p.ws + OFF_GR); ld = 1024; c0 = n0 - 12288; sig = true; }
#pragma unroll
      for (int m = 0; m < 4; ++m)
#pragma unroll
        for (int n = 0; n < 8; ++n)
#pragma unroll
          for (int j = 0; j < 4; ++j) {
            float v = acc[m][n][j];
            if (sig) v = sigmoid_f(v);
            reg[(m * 16 + (lane >> 4) * 4 + j) * 136 + n * 16 + (lane & 15)] = f2bf(v);
          }
      EPI_FENCE();
      epi_store_bf16_128(reg, dst, ld, trow, c0 + wn * 128, lane);
    }
    __syncthreads();
  }
}

DEV void phase_merge8(const Params& p, char* smem, char* smem_team) {
  u16* GS = (u16*)(p.ws + OFF_GS);
  u16* GR = (u16*)(p.ws + OFF_GR);
  const u16* Zb = (const u16*)(p.ws + OFF_Z);
  const u16* Gb = (const u16*)(p.ws + OFF_G);
  const u16* WBS = (const u16*)(p.ws + OFF_S2);
  const u16* WBR = (const u16*)(p.ws + OFF_S2 + 4194304);
  for (int kk = 0;; ++kk) {
    const int it = tile_index(kk);
    if (it >= 256) break;
    const int branch = it >> 7, tl = it & 127, mt = tl >> 2, nt = tl & 3;
    f32x4 acc[4][8];
    ZERO_ACC(acc, 8)
    gemm_tile8<8>(acc, branch ? Gb : Zb, 2048, mt * 256, L - 1, branch ? WBR : WBS, 2048, nt * 256, 2048, smem);
    const int tid = get_tid8(), lane = tid & 63, w = tid >> 6, wm = w >> 1, wn = w & 1;
    float* reg = (float*)(smem + w * EPI_WAVE_BYTES);
    u16* GT = branch ? GR : GS;
#pragma unroll
    for (int hf = 0; hf < 2; ++hf) {
#pragma unroll
      for (int m = 0; m < 4; ++m)
#pragma unroll
        for (int n = 0; n < 4; ++n)
#pragma unroll
          for (int j = 0; j < 4; ++j) reg[(m * 16 + (lane >> 4) * 4 + j) * 68 + n * 16 + (lane & 15)] = acc[m][hf * 4 + n][j];
      EPI_FENCE();
#pragma unroll
      for (int j = 0; j < 16; ++j) {
        const int row = (lane >> 4) + 4 * j, c4 = (lane & 15) * 4;
        const f32x4 a = *(const f32x4*)(reg + row * 68 + c4);
        const size_t idx = (size_t)(mt * 256 + wm * 64 + row) * 1024 + nt * 256 + wn * 128 + hf * 64 + c4;
        const u32x2 g = *(const u32x2*)(GT + idx);
        u32x2 o; o[0] = pack2(lo_f(g[0]) * a[0], hi_f(g[0]) * a[1]); o[1] = pack2(lo_f(g[1]) * a[2], hi_f(g[1]) * a[3]);
        *(u32x2*)(GT + idx) = o;
      }
      EPI_FENCE();
    }
    __syncthreads();
  }
  for (int ct = get_rbid(); ct < 128; ct += gridDim.x) {
    const int tid = get_tid8(), lane = tid & 63, w = tid >> 6;
    const int branch = ct >> 6, c16 = ct & 63;
    f32x4* red = (f32x4*)smem;
    red[w * 64 + lane] = thin16((branch ? Gb : Zb) + w * 256, 2048, 8192, (branch ? WBR : WBS) + w * 256, 2048, c16 * 16, 256, lane);
    __syncthreads();
    if (w == 0) {
      u16* GT = branch ? GR : GS;
      f32x4 a1 = red[lane];
#pragma unroll
      for (int q = 1; q < 8; ++q) a1 += red[q * 64 + lane];
#pragma unroll
      for (int j = 0; j < 4; ++j) {
        const size_t idx = (size_t)(8192 + (lane >> 4) * 4 + j) * 1024 + c16 * 16 + (lane & 15);
        GT[idx] = f2bf(bf2f(GT[idx]) * a1[j]);
      }
    }
    __syncthreads();
  }
  {
    float* RSS = (float*)(p.ws + OFF_RSS);
    for (int i = get_bid() * 256 + get_tid(); i < L; i += nworkers() * 256) RSS[i] = 0.f;
  }
  const int n_wout = 16 * 16, n_wup = 16 * 88, n_wdown = 44 * 16;
  for (int it = get_bid(); it < n_wout + n_wup + n_wdown; it += nworkers()) {
    if (it < n_wout) { convert_tile(p.in[12], 1024, 1024, (u16*)(p.ws + OFF_WOUT), it & 15, it >> 4, 0, smem_team); }
    else if (it < n_wout + n_wup) { const int j = it - n_wout; convert_tile(p.in[14], 5632, 1024, (u16*)(p.ws + OFF_WUP), j & 15, j >> 4, 2, smem_team, p.in[13]);   }
    else { const int j = it - n_wout - n_wup; convert_tile(p.in[17], 1024, 2816, (u16*)(p.ws + OFF_WDOWN), j % 44, j / 44, 0, smem_team); }
  }
}

DEV void phase_outproj8(const Params& p, int b, char* smem) {
  const int tid = get_tid8(), lane = tid & 63, w = tid >> 6, wm = w >> 1, wn = w & 1, r = lane & 31, h = lane >> 5;
  u16* U2 = (u16*)(p.ws + OFF_U2);
  float* RSS = (float*)(p.ws + OFF_RSS);
  const u16* Mg = (const u16*)(p.ws + OFF_GS);
  const u16* WO = (const u16*)(p.ws + OFF_WOUT);
  float* reg = (float*)(smem + w * EPI_WAVE_BYTES);
  for (int kk = 0;; ++kk) {
    const int it = tile_index(kk);
    if (it >= 256) break;
    const int mt = it >> 3, nt = it & 7;
    f32x4 acc[4][4];
    ZERO_ACC(acc, 4)
    gemm_tile8<4, true>(acc, Mg, 1024, mt * 256, L - 1, WO, 1024, nt * 128, 1024, smem, (const u16*)(p.ws + OFF_GR));
#pragma unroll
    for (int m = 0; m < 4; ++m)
#pragma unroll
      for (int n = 0; n < 4; ++n)
#pragma unroll
        for (int j = 0; j < 4; ++j) reg[(m * 16 + (lane >> 4) * 4 + j) * 68 + n * 16 + (lane & 15)] = acc[m][n][j];
    EPI_FENCE();
#pragma unroll
    for (int j = 0; j < 16; ++j) {
      const int row = (lane >> 4) + 4 * j, c4 = (lane & 15) * 4;
      const f32x4 a = *(const f32x4*)(reg + row * 68 + c4);
      const int t = mt * 256 + wm * 64 + row, col = nt * 128 + wn * 64 + c4;
      f32x4 hv;
      if (t < NMETA) {
        hv = *(const f32x4*)(p.in[1] + t * 1024 + col) + a;
      } else {
        const size_t idx = ((size_t)b * SEQ + (t - NMETA)) * 1024 + col;
        hv = *(const f32x4*)(p.in[0] + idx) + a;
        *(f32x4*)(p.out + idx) = hv;
      }
      u32x2 hb; hb[0] = pack2(hv[0], hv[1]); hb[1] = pack2(hv[2], hv[3]);
      *(u32x2*)(U2 + (size_t)t * 1024 + col) = hb;
      float sq = hv[0] * hv[0] + hv[1] * hv[1] + hv[2] * hv[2] + hv[3] * hv[3];
      sq += __shfl_xor(sq, 1); sq += __shfl_xor(sq, 2); sq += __shfl_xor(sq, 4); sq += __shfl_xor(sq, 8);
      if ((lane & 15) == 0) atomicAdd(&RSS[t], sq);
    }
    __syncthreads();
  }
  for (int ct = get_rbid(); ct < 64; ct += gridDim.x) {
    const int tid = get_tid8(), lane = tid & 63, w = tid >> 6;
    f32x4* red = (f32x4*)smem;
    red[w * 64 + lane] = thin16(Mg + w * 128, 1024, 8192, WO + w * 128, 1024, ct * 16, 128, lane)
                       + thin16((const u16*)(p.ws + OFF_GR) + w * 128, 1024, 8192, WO + w * 128, 1024, ct * 16, 128, lane);
    __syncthreads();
    if (w == 0) {
      f32x4 a1 = red[lane];
#pragma unroll
      for (int q = 1; q < 8; ++q) a1 += red[q * 64 + lane];
#pragma unroll
      for (int j = 0; j < 4; ++j) {
        const int t = 8192 + (lane >> 4) * 4 + j;
        const size_t idx = ((size_t)b * SEQ + (t - NMETA)) * 1024 + ct * 16 + (lane & 15);
        const float hv = p.in[0][idx] + a1[j];
        p.out[idx] = hv;
        U2[(size_t)t * 1024 + ct * 16 + (lane & 15)] = f2bf(hv);
        float sq = hv * hv;
        sq += __shfl_xor(sq, 1); sq += __shfl_xor(sq, 2); sq += __shfl_xor(sq, 4); sq += __shfl_xor(sq, 8);
        if ((lane & 15) == 0) atomicAdd(&RSS[t], sq);
      }
    }
    __syncthreads();
  }
}

DEV void phase_up8(const Params& p, char* smem) {
  u16* ACT = (u16*)(p.ws + OFF_ACT);
  const float* cw = p.in[15];
  const float* cbias = p.in[16];
  for (int kk = 0;; ++kk) {
    const int it = tile_index(kk);
    if (it >= 33 * 22) break;
    int mt, nt; tile_decode(it, 33, 22, mt, nt);
    f32x4 acc[4][8];
    ZERO_ACC(acc, 8)
    gemm_tile8<8>(acc, (const u16*)(p.ws + OFF_U2), 1024, mt * 254 - 2, L - 1, (const u16*)(p.ws + OFF_WUP), 1024, nt * 256, 1024, smem);
    const int tid = get_tid8(), lane = tid & 63, w = tid >> 6;
    u16* reg = (u16*)(smem + w * EPI_WAVE_BYTES);
    {
      const float* RSS = (const float*)(p.ws + OFF_RSS);
      const int wm = w >> 1;
#pragma unroll
      for (int m = 0; m < 4; ++m)
#pragma unroll
        for (int j = 0; j < 4; ++j) {
          int t = mt * 254 - 2 + wm * 64 + m * 16 + (lane >> 4) * 4 + j; t = t < 0 ? 0 : (t > L - 1 ? L - 1 : t);
          const float rstd = rsqrtf(RSS[t] * (1.f / 1024.f) + EPS);
#pragma unroll
          for (int n = 0; n < 8; ++n) reg[(m * 16 + (lane >> 4) * 4 + j) * 136 + n * 16 + (lane & 15)] = f2bf(acc[m][n][j] * rstd);
        }
    }
    __syncthreads();
    {
      const int cg = tid & 15, rg = tid >> 4;
      const int ch = nt * 128 + cg * 8;
      float wg[3][8], wv[3][8], bg[8], bv[8], g2[8], g1[8], v2[8], v1[8];
#pragma unroll
      for (int k = 0; k < 3; ++k) {
        const f32x4 a0 = *(const f32x4*)(cw + k * 5632 + ch), a1 = *(const f32x4*)(cw + k * 5632 + ch + 4);
        const f32x4 c0 = *(const f32x4*)(cw + k * 5632 + 2816 + ch), c1 = *(const f32x4*)(cw + k * 5632 + 2816 + ch + 4);
#pragma unroll
        for (int j = 0; j < 4; ++j) { wg[k][j] = a0[j]; wg[k][4 + j] = a1[j]; wv[k][j] = c0[j]; wv[k][4 + j] = c1[j]; }
      }
      {
        const f32x4 a0 = *(const f32x4*)(cbias + ch), a1 = *(const f32x4*)(cbias + ch + 4);
        const f32x4 c0 = *(const f32x4*)(cbias + 2816 + ch), c1 = *(const f32x4*)(cbias + 2816 + ch + 4);
#pragma unroll
        for (int j = 0; j < 4; ++j) { bg[j] = a0[j]; bg[4 + j] = a1[j]; bv[j] = c0[j]; bv[4 + j] = c1[j]; }
      }
      const int R0 = rg * 8;
#pragma unroll
      for (int q = 0; q < 2; ++q) {
        const int R = R0 - 2 + q;
        u32x4 gvv = {0u, 0u, 0u, 0u}, vvv = {0u, 0u, 0u, 0u};
        if (R >= 0 && mt * 254 - 2 + R >= 0) {
          const char* sl = smem + ((R >> 6) * 2) * EPI_WAVE_BYTES + ((R & 63) * 136 + cg * 8) * 2;
          gvv = *(const u32x4*)sl; vvv = *(const u32x4*)(sl + EPI_WAVE_BYTES);
        }
#pragma unroll
        for (int j = 0; j < 4; ++j) {
          if (q == 0) { g2[2 * j] = lo_f(gvv[j]); g2[2 * j + 1] = hi_f(gvv[j]); v2[2 * j] = lo_f(vvv[j]); v2[2 * j + 1] = hi_f(vvv[j]); }
          else { g1[2 * j] = lo_f(gvv[j]); g1[2 * j + 1] = hi_f(gvv[j]); v1[2 * j] = lo_f(vvv[j]); v1[2 * j + 1] = hi_f(vvv[j]); }
        }
      }
#pragma unroll 2
      for (int i = 0; i < 8; ++i) {
        const int R = R0 + i, t = mt * 254 - 2 + R;
        u32x4 gvv = {0u, 0u, 0u, 0u}, vvv = {0u, 0u, 0u, 0u};
        if (t >= 0) {
          const char* sl = smem + ((R >> 6) * 2) * EPI_WAVE_BYTES + ((R & 63) * 136 + cg * 8) * 2;
          gvv = *(const u32x4*)sl; vvv = *(const u32x4*)(sl + EPI_WAVE_BYTES);
        }
        float o[8];
#pragma unroll
        for (int j = 0; j < 8; ++j) {
          const float gx = (j & 1) ? hi_f(gvv[j >> 1]) : lo_f(gvv[j >> 1]);
          const float vx = (j & 1) ? hi_f(vvv[j >> 1]) : lo_f(vvv[j >> 1]);
          const float ag = bg[j] + wg[0][j] * g2[j] + wg[1][j] * g1[j] + wg[2][j] * gx;
          const float av = bv[j] + wv[0][j] * v2[j] + wv[1][j] * v1[j] + wv[2][j] * vx;
          o[j] = silu_f(ag) * av;
          g2[j] = g1[j]; g1[j] = gx; v2[j] = v1[j]; v1[j] = vx;
        }
        if (R >= 2 && t < L) {
          u32x4 pk; pk[0] = pack2(o[0], o[1]); pk[1] = pack2(o[2], o[3]); pk[2] = pack2(o[4], o[5]); pk[3] = pack2(o[6], o[7]);
          *(u32x4*)(ACT + (size_t)t * 2816 + ch) = pk;
        }
      }
    }
    __syncthreads();
  }
}

DEV void phase_down8(const Params& p, int b, char* smem) {
  for (int kk = 0;; ++kk) {
    const int it = tile_index(kk);
    if (it >= 256) break;
    const int mt = it >> 3, nt = it & 7;
    f32x4 acc[4][4];
    ZERO_ACC(acc, 4)
    gemm_tile8<4>(acc, (const u16*)(p.ws + OFF_ACT), 2816, NMETA + mt * 256, L - 1, (const u16*)(p.ws + OFF_WDOWN), 2816, nt * 128, 2816, smem);
    const int tid = get_tid8(), lane = tid & 63, w = tid >> 6, wm = w >> 1, wn = w & 1, r = lane & 31, h = lane >> 5;
    float* reg = (float*)(smem + w * EPI_WAVE_BYTES);
#pragma unroll
    for (int m = 0; m < 4; ++m)
#pragma unroll
      for (int n = 0; n < 4; ++n)
#pragma unroll
        for (int j = 0; j < 4; ++j) reg[(m * 16 + (lane >> 4) * 4 + j) * 68 + n * 16 + (lane & 15)] = acc[m][n][j];
    EPI_FENCE();
#pragma unroll
    for (int j = 0; j < 16; ++j) {
      const int row = (lane >> 4) + 4 * j, c4 = (lane & 15) * 4;
      const f32x4 a = *(const f32x4*)(reg + row * 68 + c4);
      const size_t idx = ((size_t)b * SEQ + mt * 256 + wm * 64 + row) * 1024 + nt * 128 + wn * 64 + c4;
      const f32x4 x = *(const f32x4*)(p.out + idx);
      *(f32x4*)(p.out + idx) = x + a;
    }
    __syncthreads();
  }
}

#define XB_TMO      128
#define XB_XCNT(j)  (256  + 64 * (j))
#define XB_XSUB(j)  (1280 + 64 * (j))
#define XB_XGEN(j)  (2304 + 64 * (j))
#define XB_TOP      3328
#define XB_TOPGEN   3392
#define XCD_BAR_WORDS 3456
#define XB_SPIN_CAP (1u << 24)
DEV unsigned xb_ld(unsigned* p)              { return __hip_atomic_load(p, __ATOMIC_RELAXED, __HIP_MEMORY_SCOPE_AGENT); }
DEV unsigned xb_add(unsigned* p, unsigned v) { return __hip_atomic_fetch_add(p, v, __ATOMIC_RELAXED, __HIP_MEMORY_SCOPE_AGENT); }
DEV unsigned xb_xcc_id() { return (unsigned)__builtin_amdgcn_s_getreg((3 << 11) | 20) & 0xFu; }
#define XB_SPIN(cond, bar) do { unsigned _sp = 0; while (cond) { __builtin_amdgcn_s_sleep(1); \
    if ((++_sp & 255u) == 0u) { if (xb_ld(&(bar)[XB_TMO])) break; if (_sp > XB_SPIN_CAP) { atomicAdd(&(bar)[XB_TMO], 1u); break; } } } } while (0)
struct XcdBarrier { unsigned* bar; unsigned x; volatile LDSP unsigned* st; };
DEV XcdBarrier xcd_barrier_post(unsigned* bar, volatile LDSP unsigned* st) {
  XcdBarrier b; b.bar = bar; b.x = xb_xcc_id(); b.st = st;
  if (threadIdx.x == 0) (void)xb_add(&bar[XB_XCNT(b.x)], 1u);
  return b;
}
DEV void xcd_barrier_complete(unsigned* bar, unsigned x, unsigned& nloc, unsigned& nx) {
  const unsigned G = gridDim.x * gridDim.y * gridDim.z;
  unsigned sum, cnt, mine, sp = 0u;
  for (;;) {
    sum = 0u; cnt = 0u; mine = 0u;
#pragma unroll
    for (unsigned j = 0; j < 16; ++j) { const unsigned c = xb_ld(&bar[XB_XCNT(j)]); sum += c; cnt += (c > 0u) ? 1u : 0u; mine = (j == x) ? c : mine; }
    if (sum == G) break;
    __builtin_amdgcn_s_sleep(1);
    if ((++sp & 255u) == 0u) { if (xb_ld(&bar[XB_TMO])) break; if (sp > XB_SPIN_CAP) { atomicAdd(&bar[XB_TMO], 1u); break; } }
  }
  nloc = mine > 0u ? mine : 1u; nx = cnt > 0u ? cnt : 1u;
}
DEV void xcd_barrier(const XcdBarrier& b) {
  asm volatile("s_waitcnt vmcnt(0)" ::: "memory");
  __syncthreads();
  if (threadIdx.x == 0) {
    unsigned* bar = b.bar;
    __builtin_amdgcn_s_waitcnt(0);
    unsigned nloc = b.st[0], nx = b.st[1];
    if (nloc == 0u) { xcd_barrier_complete(bar, b.x, nloc, nx); b.st[0] = nloc; b.st[1] = nx; }
    const unsigned old = xb_add(&bar[XB_XSUB(b.x)], 1u);
    const unsigned gen = old / nloc;
    if (old + 1u == (gen + 1u) * nloc) {
      __builtin_amdgcn_fence(__ATOMIC_RELEASE, "agent");
      asm volatile("s_waitcnt vmcnt(0)" ::: "memory");
      const unsigned og = xb_add(&bar[XB_TOP], 1u);
      const unsigned tg = og / nx;
      if (og + 1u == (tg + 1u) * nx) xb_add(&bar[XB_TOPGEN], 1u);
      else XB_SPIN(xb_ld(&bar[XB_TOPGEN]) == tg, bar);
      __builtin_amdgcn_fence(__ATOMIC_ACQUIRE, "agent");
      xb_add(&bar[XB_XGEN(b.x)], 1u);
      asm volatile("s_waitcnt vmcnt(0)" ::: "memory");
    } else {
      XB_SPIN(xb_ld(&bar[XB_XGEN(b.x)]) == gen, bar);
      __builtin_amdgcn_fence(__ATOMIC_ACQUIRE, "agent");
      asm volatile("s_waitcnt vmcnt(0)" ::: "memory");
    }
  }
  __syncthreads();
}

constexpr int N_PHASES = 19;

__global__ void __launch_bounds__(512) fwd_kernel(Params p, int ph0, int ph1) {
  __shared__ __attribute__((aligned(16))) char smem[SMEM_BYTES];
  __shared__ uint4 xb_words;
  if (threadIdx.x == 0) xb_words = make_uint4(0u, 0u, 0u, 0u);
  __syncthreads();
  XcdBarrier xb = xcd_barrier_post((unsigned*)(p.ws + OFF_BAR), (volatile LDSP unsigned*)&xb_words);
  if (ph1 < 0) cg::this_grid().sync();
  for (int ph = ph0; ph < ph1; ++ph) {
    char* tsm = smem + (get_tid8() >> 8) * SMEM_TEAM;
    const int b = ph >= 10 ? 1 : 0;
    const int lp = (ph == 0) ? 0 : (ph == 18 ? 9 : (ph >= 10 ? ph - 9 : ph));
    switch (lp) {
      case 0: phase_prep(p, 0, true, tsm); break;
      case 1: phase_inproj8(p, b, smem); break;
      case 2: {
        int it = get_bid();
        for (; it < 1024; it += nworkers()) ret_kv_item(p, it, tsm);
        for (; it < 2048; it += nworkers()) ssd_state_item(p, it - 1024, tsm);
      } break;
      case 3: phase_scan(p); break;
      case 4: {
        {
          const int rb0 = get_rbid(), rb = (rb0 & 7) * 32 + (rb0 >> 3), team = get_tid8() >> 8;
          for (int j = 0; j < 3; ++j) {
            int kind = -1, idx = 0;
            if (rb < 4) {
              const int q = rb * 3 + j;
              const int rt = (q < 2) ? 128 : ((q >> 1) - 1) * 4;
              kind = 0; idx = rt * 4 + (q & 1) * 2 + team;
            } else if (rb < 10) {
              if (j < 2) { kind = 1; idx = (246 + (rb - 4) * 2 + j) * 2 + team; }
            } else if (j < 2) {
              const int k = rb - 10, ri = k >> 1;
              const int rt = (ri < 12) ? ((ri / 3) * 4 + 1 + ri % 3) : (17 + ri - 12);
              kind = j; idx = (j == 0) ? (rt * 4 + (k & 1) * 2 + team) : (k * 2 + team);
            }
            if (kind == 0) ret_out_item(p, idx, tsm);
            else if (kind == 1) ssd_out_item(p, idx, tsm);
          }
        }
      } break;
      case 5: phase_merge8(p, smem, tsm); break;
      case 6: phase_outproj8(p, b, smem); break;
      case 7: phase_up8(p, smem); break;
      case 8: phase_down8(p, b, smem); break;
      case 9: {
        if (ph == 9) { phase_final_norm(p, 0); phase_prep(p, 1, false, tsm); }
        else phase_final_norm(p, 1);
      } break;
    }
    if (ph + 1 < ph1) xcd_barrier(xb);
  }
}

#ifndef MK_SINGLE
#define MK_SINGLE 1
#endif

extern "C" void kernel_launch(void* const* d_in, const int* in_sizes, int n_in, void* d_out, int out_size, void* d_ws, size_t ws_size,
                              hipStream_t stream) {
  static int grid_blocks = 0;
  if (!grid_blocks) {
    int dev = 0, cus = 0, per_cu = 0;
    hipGetDevice(&dev);
    hipDeviceGetAttribute(&cus, hipDeviceAttributeMultiprocessorCount, dev);
    hipOccupancyMaxActiveBlocksPerMultiprocessor(&per_cu, fwd_kernel, 512, 0);
    per_cu = 1;
    if (cus != 256) fprintf(stderr, "kernel_launch: built for a 256-CU device (static phase schedules assume 256 workgroups), found %d CUs\n", cus);
    cus = 256;
    grid_blocks = cus * per_cu;
  }
  Params p{};
  for (int i = 0; i < 19; ++i) p.in[i] = (const float*)d_in[i];
  p.out = (float*)d_out;
  p.ws = (char*)d_ws;
#if MK_SINGLE
  (void)hipMemsetAsync((char*)d_ws + OFF_BAR, 0, XCD_BAR_WORDS * 4, stream);
  int ph0 = 0, ph1 = N_PHASES;
  void* args[] = {&p, &ph0, &ph1};
  hipError_t e = hipLaunchCooperativeKernel((void*)fwd_kernel, dim3(grid_blocks), dim3(512), args, 0, stream);
  if (e != hipSuccess) fprintf(stderr, "cooperative launch failed: %s (grid %d)\n", hipGetErrorString(e), grid_blocks);
#else
  for (int ph = 0; ph < N_PHASES; ++ph) {
    hipLaunchKernelGGL(fwd_kernel, dim3(grid_blocks), dim3(512), 0, stream, p, ph, ph + 1);
  }
#endif
}
```

```cpp
#include <hip/hip_runtime.h>
#include <hip/hip_cooperative_groups.h>
#include <cstdio>
namespace cg = cooperative_groups;

typedef unsigned short u16;
typedef __bf16 bf16x8 __attribute__((ext_vector_type(8)));
typedef short s16x4 __attribute__((ext_vector_type(4)));
typedef short s16x8 __attribute__((ext_vector_type(8)));
typedef float f32x16 __attribute__((ext_vector_type(16)));
typedef unsigned int u32x4 __attribute__((ext_vector_type(4)));
typedef unsigned int u32x2 __attribute__((ext_vector_type(2)));
typedef float f32x4 __attribute__((ext_vector_type(4)));

#define DEV __device__ __forceinline__
#define LDSP __attribute__((address_space(3)))

constexpr int D = 1024;
constexpr int L = 8208;
constexpr int SEQ = 8192;
constexpr int NMETA = 16;
constexpr int NPROJ = 13344;
constexpr int NPROJ_PAD = 13568;
constexpr int DFF = 2816;
constexpr float EPS = 1e-6f;

constexpr size_t OFF_Z = 0;
constexpr size_t OFF_G = 33619968;
constexpr size_t OFF_GS = 67239936;
constexpr size_t OFF_GR = 84049920;
constexpr size_t OFF_Q = 100859904;
constexpr size_t OFF_XBC = 117669888;
constexpr size_t OFF_K = 168099840;
constexpr size_t OFF_V = 184909824;
constexpr size_t OFF_DT = 218529792;
constexpr size_t OFF_S2 = 219580416;
constexpr size_t OFF_S1 = 227969024;
constexpr size_t OFF_CD = 261523456;
constexpr size_t OFF_HM = 261531648;
constexpr size_t OFF_BAR = 261597184;
constexpr size_t OFF_RSS = 261611520;
constexpr size_t OFF_WOUT = OFF_S1;
constexpr size_t OFF_WUP = OFF_S1 + 2097152;
constexpr size_t OFF_WDOWN = OFF_S1 + 13631488;
constexpr size_t OFF_UP = OFF_XBC;
constexpr size_t OFF_ACT = OFF_Z;
constexpr size_t OFF_U2 = OFF_Q;
constexpr size_t OUT_HALF = 33554432;

constexpr int SMEM_TEAM = 73728;
constexpr int SMEM_BYTES = 2 * SMEM_TEAM;

struct Params {
  const float* in[19];
  float* out;
  char* ws;
};

DEV int get_tid8() { int t = threadIdx.x; asm volatile("" : "+v"(t)); return t; }
DEV int get_tid() { int t = threadIdx.x & 255; asm volatile("" : "+v"(t)); return t; }
DEV int get_rbid() { int t = blockIdx.x; asm volatile("" : "+s"(t)); return t; }
DEV int get_bid() { int t = get_rbid() * 2 + (get_tid8() >> 8); return __builtin_amdgcn_readfirstlane(t); }
DEV int nworkers() { return (int)gridDim.x * 2; }
DEV float bf2f(u16 h) { return __uint_as_float(((unsigned)h) << 16); }
DEV u16 f2bf(float f) { unsigned u = __float_as_uint(f); u += 0x7fffu + ((u >> 16) & 1u); return (u16)(u >> 16); }
DEV unsigned pack2(float a, float b) { return (unsigned)f2bf(a) | ((unsigned)f2bf(b) << 16); }
DEV float silu_f(float x) { return x / (1.f + __expf(-x)); }
DEV float sigmoid_f(float x) { return 1.f / (1.f + __expf(-x)); }
DEV float lo_f(unsigned u) { return __uint_as_float(u << 16); }
DEV float hi_f(unsigned u) { return __uint_as_float(u & 0xffff0000u); }
DEV float wave_sum(float v) {
#pragma unroll
  for (int o = 32; o > 0; o >>= 1) v += __shfl_xor(v, o);
  return v;
}
DEV float half_sum(float v) {
#pragma unroll
  for (int o = 16; o > 0; o >>= 1) v += __shfl_xor(v, o);
  return v;
}
DEV float log_gamma(int h) {
  return h == 0 ? -0.0317486983145803f : (h == 1 ? -0.015748356968139168f : (h == 2 ? -0.007843177461025893f : -0.003913899321136329f));
}
DEV f32x16 mfma(bf16x8 a, bf16x8 b, f32x16 c) { return __builtin_amdgcn_mfma_f32_32x32x16_bf16(a, b, c, 0, 0, 0); }
DEV f32x16 zero16() { f32x16 z;
#pragma unroll
  for (int i = 0; i < 16; ++i) z[i] = 0.f;
  return z; }
DEV int acc_row(int i, int h) { return (i & 3) + 8 * (i >> 2) + 4 * h; }

DEV bf16x8 frag_tr(const u16* T, int ld, int k0, int x0, int lane) {
  const int h = lane >> 5, blk = (lane >> 4) & 1, q = (lane & 15) >> 2, pp = lane & 3;
  const u16* a0 = T + (k0 + 8 * h + q) * ld + x0 + 16 * blk + 4 * pp;
  s16x4 lo = __builtin_amdgcn_ds_read_tr16_b64_v4i16((LDSP s16x4*)a0);
  s16x4 hi = __builtin_amdgcn_ds_read_tr16_b64_v4i16((LDSP s16x4*)(a0 + 4 * ld));
  s16x8 v = {lo[0], lo[1], lo[2], lo[3], hi[0], hi[1], hi[2], hi[3]};
  return __builtin_bit_cast(bf16x8, v);
}
DEV bf16x8 frag_row(const u16* T, int ld, int row, int k) {
  return *(const bf16x8*)(T + row * ld + k);
}

template <int MI>
DEV void gemm_tile(f32x16 (&acc)[MI][2], const u16* __restrict__ A, int lda, int arow0, int arow_max,
                   const u16* __restrict__ B, int ldb, int brow0, int K, char* smem) {
  constexpr int BM = MI * 64;
  constexpr int LD = 72;
  constexpr int ACH = BM * 8 / 256;
  u16* As = (u16*)smem;
  u16* Bs = As + BM * LD;
  const int tid = get_tid(), lane = tid & 63, w = tid >> 6, wm = w >> 1, wn = w & 1, r = lane & 31, h = lane >> 5;
  u32x4 ra[ACH], rb[4];
  const u16* ap[ACH];
  const u16* bp[4];
#pragma unroll
  for (int i = 0; i < ACH; ++i) {
    int c = tid + i * 256, row = c >> 3, kc = c & 7;
    int gr = arow0 + row; gr = gr > arow_max ? arow_max : gr;
    ap[i] = A + (size_t)gr * lda + kc * 8;
  }
#pragma unroll
  for (int i = 0; i < 4; ++i) {
    int c = tid + i * 256, row = c >> 3, kc = c & 7;
    bp[i] = B + (size_t)(brow0 + row) * ldb + kc * 8;
  }
#pragma unroll
  for (int i = 0; i < ACH; ++i) ra[i] = *(const u32x4*)(ap[i]);
#pragma unroll
  for (int i = 0; i < 4; ++i) rb[i] = *(const u32x4*)(bp[i]);
  const int nk = K >> 6;
  for (int kt = 0; kt < nk; ++kt) {
#pragma unroll
    for (int i = 0; i < ACH; ++i) { int c = tid + i * 256, row = c >> 3, kc = c & 7; *(u32x4*)(As + row * LD + kc * 8) = ra[i]; }
#pragma unroll
    for (int i = 0; i < 4; ++i) { int c = tid + i * 256, row = c >> 3, kc = c & 7; *(u32x4*)(Bs + row * LD + kc * 8) = rb[i]; }
    __syncthreads();
    if (kt + 1 < nk) {
#pragma unroll
      for (int i = 0; i < ACH; ++i) ra[i] = *(const u32x4*)(ap[i] + (kt + 1) * 64);
#pragma unroll
      for (int i = 0; i < 4; ++i) rb[i] = *(const u32x4*)(bp[i] + (kt + 1) * 64);
    }
#pragma unroll
    for (int ks = 0; ks < 4; ++ks) {
      bf16x8 a[MI], b[2];
#pragma unroll
      for (int mi = 0; mi < MI; ++mi) a[mi] = frag_row(As, LD, wm * MI * 32 + mi * 32 + r, ks * 16 + h * 8);
#pragma unroll
      for (int ni = 0; ni < 2; ++ni) b[ni] = frag_row(Bs, LD, wn * 64 + ni * 32 + r, ks * 16 + h * 8);
#pragma unroll
      for (int mi = 0; mi < MI; ++mi)
#pragma unroll
        for (int ni = 0; ni < 2; ++ni) acc[mi][ni] = mfma(a[mi], b[ni], acc[mi][ni]);
    }
    __syncthreads();
  }
}

DEV int orig_col(int n) {
  if (n < 5120) return n;
  if (n < 7168) {
    int q = n - 5120; int which = q >> 10; int c = q & 1023; int head = c >> 8; int ip = c & 255; int blk = ip >> 6; int wi = ip & 63;
    int j = (wi < 32) ? (blk * 32 + wi) : (128 + blk * 32 + wi - 32);
    return 5152 + which * 1024 + head * 256 + j;
  }
  if (n < 13312) return n + 32;
  if (n < 13344) return 5120 + (n - 13312);
  return -1;
}
DEV void convert_tile(const float* __restrict__ W, int Nsrc, int K, u16* __restrict__ WT, int kt, int ntile, int mode, char* smem, const float* __restrict__ kscale = nullptr) {
  float* t = (float*)smem;
  const int tid = get_tid();
  {
    const int tx = tid & 15, ty = tid >> 4;
    const int n = ntile * 64 + tx * 4;
    int on = n;
    if (mode == 1) on = orig_col(n);
    else if (mode == 2) { const int tl = n >> 8, wi = n & 255; on = (wi < 128) ? (tl * 128 + wi) : (2816 + tl * 128 + wi - 128); }
#pragma unroll
    for (int kk = ty; kk < 64; kk += 16) {
      f32x4 v = {0.f, 0.f, 0.f, 0.f};
      if (on >= 0) v = *(const f32x4*)(W + (size_t)(kt * 64 + kk) * Nsrc + on);
      if (kscale) v = v * kscale[kt * 64 + kk];
      *(f32x4*)(t + kk * 68 + tx * 4) = v;
    }
  }
  __syncthreads();
  {
    const int nn = tid >> 2, kq = (tid & 3) * 16;
    u32x4 o[2];
#pragma unroll
    for (int j = 0; j < 8; ++j) o[j >> 2][j & 3] = pack2(t[(kq + 2 * j) * 68 + nn], t[(kq + 2 * j + 1) * 68 + nn]);
    u16* d = WT + (size_t)(ntile * 64 + nn) * K + kt * 64 + kq;
    *(u32x4*)d = o[0]; *(u32x4*)(d + 8) = o[1];
  }
  __syncthreads();
}

DEV void rmsnorm_row_bf16(const float* __restrict__ src, const float* __restrict__ w, u16* __restrict__ dst, int lane) {
  f32x4 v[4]; float ss = 0.f;
#pragma unroll
  for (int j = 0; j < 4; ++j) { v[j] = *(const f32x4*)(src + j * 256 + lane * 4); ss += v[j][0] * v[j][0] + v[j][1] * v[j][1] + v[j][2] * v[j][2] + v[j][3] * v[j][3]; }
  ss = wave_sum(ss);
  const float rstd = rsqrtf(ss * (1.f / 1024.f) + EPS);
#pragma unroll
  for (int j = 0; j < 4; ++j) {
    f32x4 ww = *(const f32x4*)(w + j * 256 + lane * 4);
    u32x2 o; o[0] = pack2(v[j][0] * rstd * ww[0], v[j][1] * rstd * ww[1]); o[1] = pack2(v[j][2] * rstd * ww[2], v[j][3] * rstd * ww[3]);
    *(u32x2*)(dst + j * 256 + lane * 4) = o;
  }
}
DEV void rmsnorm_row_f32_inplace(float* __restrict__ row, const float* __restrict__ w, int lane) {
  f32x4 v[4]; float ss = 0.f;
#pragma unroll
  for (int j = 0; j < 4; ++j) { v[j] = *(const f32x4*)(row + j * 256 + lane * 4); ss += v[j][0] * v[j][0] + v[j][1] * v[j][1] + v[j][2] * v[j][2] + v[j][3] * v[j][3]; }
  ss = wave_sum(ss);
  const float rstd = rsqrtf(ss * (1.f / 1024.f) + EPS);
#pragma unroll
  for (int j = 0; j < 4; ++j) {
    f32x4 ww = *(const f32x4*)(w + j * 256 + lane * 4);
    f32x4 o; o[0] = v[j][0] * rstd * ww[0]; o[1] = v[j][1] * rstd * ww[1]; o[2] = v[j][2] * rstd * ww[2]; o[3] = v[j][3] * rstd * ww[3];
    *(f32x4*)(row + j * 256 + lane * 4) = o;
  }
}

template <int R, int C, bool SCALE>
DEV void stage_conv(u16* dst, int ld, const u16* __restrict__ xbc, int row0, int ch0, const float* __restrict__ cw, const float* __restrict__ cb, const float* rs) {
  constexpr int CG = C / 8, RG = 256 / CG, RPT = R / RG;
  const int tid = get_tid();
  const int cgi = tid % CG, rgi = tid / CG;
  const int ch = ch0 + cgi * 8, r0 = rgi * RPT;
  float w[4][8], bias[8], xw[3][8];
#pragma unroll
  for (int k = 0; k < 4; ++k) {
    f32x4 a = *(const f32x4*)(cw + k * 3072 + ch), b = *(const f32x4*)(cw + k * 3072 + ch + 4);
#pragma unroll
    for (int j = 0; j < 4; ++j) { w[k][j] = a[j]; w[k][4 + j] = b[j]; }
  }
  {
    f32x4 a = *(const f32x4*)(cb + ch), b = *(const f32x4*)(cb + ch + 4);
#pragma unroll
    for (int j = 0; j < 4; ++j) { bias[j] = a[j]; bias[4 + j] = b[j]; }
  }
#pragma unroll
  for (int k = 0; k < 3; ++k) {
    const int tr = row0 + r0 - 3 + k;
    u32x4 v = {0u, 0u, 0u, 0u};
    if (tr >= 0 && tr < L) v = *(const u32x4*)(xbc + (size_t)tr * 3072 + ch);
#pragma unroll
    for (int j = 0; j < 4; ++j) { xw[k][2 * j] = lo_f(v[j]); xw[k][2 * j + 1] = hi_f(v[j]); }
  }
#pragma unroll
  for (int i = 0; i < RPT; ++i) {
    const int tr = row0 + r0 + i;
    const bool valid = tr < L;
    u32x4 v = {0u, 0u, 0u, 0u};
    if (valid) v = *(const u32x4*)(xbc + (size_t)tr * 3072 + ch);
    float xc[8], o[8];
#pragma unroll
    for (int j = 0; j < 4; ++j) { xc[2 * j] = lo_f(v[j]); xc[2 * j + 1] = hi_f(v[j]); }
    float sc = 1.f;
    if (SCALE) sc = rs[(cgi >> 3) * 128 + r0 + i];
#pragma unroll
    for (int j = 0; j < 8; ++j) {
      float a = bias[j] + w[0][j] * xw[0][j] + w[1][j] * xw[1][j] + w[2][j] * xw[2][j] + w[3][j] * xc[j];
      a = silu_f(a) * sc;
      o[j] = valid ? a : 0.f;
      xw[0][j] = xw[1][j]; xw[1][j] = xw[2][j]; xw[2][j] = xc[j];
    }
    u32x4 pk; pk[0] = pack2(o[0], o[1]); pk[1] = pack2(o[2], o[3]); pk[2] = pack2(o[4], o[5]); pk[3] = pack2(o[6], o[7]);
    *(u32x4*)(dst + (r0 + i) * ld + cgi * 8) = pk;
  }
}

DEV float chunk_cumsum(const float* __restrict__ DT, int c, int H, float A, float* acs, float* dts, int lane) {
  const int s0 = 2 * lane;
  const int t0 = c * 128 + s0;
  const float d0 = (t0 < L) ? DT[(size_t)t0 * 32 + H] : 0.f;
  const float d1 = (t0 + 1 < L) ? DT[(size_t)(t0 + 1) * 32 + H] : 0.f;
  const float a0 = d0 * A, a1 = a0 + d1 * A;
  float tot = a1;
#pragma unroll
  for (int o = 1; o < 64; o <<= 1) { float n = __shfl_up(tot, o); if (lane >= o) tot += n; }
  const float excl = tot - a1;
  acs[s0] = excl + a0; acs[s0 + 1] = excl + a1;
  dts[s0] = d0; dts[s0 + 1] = d1;
  return __shfl(tot, 63);
}

DEV void phase_prep(const Params& p, int b, bool first, char* smem) {
  const int tid = get_tid(), lane = tid & 63, w = tid >> 6;
  u16* U = (u16*)((char*)p.out + OUT_HALF);
  const int n_norm = L / 4;
  const int n_win = 16 * (NPROJ_PAD / 64);
  const int n_wb = first ? 2 * 32 * 16 : 0;
  const int total = n_norm + n_win + n_wb;
  for (int it = get_bid(); it < total; it += nworkers()) {
    if (it < n_norm) {
      const int t = it * 4 + w;
      const float* src = (t < NMETA) ? (p.in[1] + (size_t)t * D) : (p.in[0] + ((size_t)b * SEQ + (t - NMETA)) * D);
      rmsnorm_row_bf16(src, p.in[2], U + (size_t)t * D, lane);
    } else if (it < n_norm + n_win) {
      const int j = it - n_norm; const int ntile = j >> 4, kt = j & 15;
      convert_tile(p.in[3], NPROJ, 1024, (u16*)(p.ws + OFF_S1), kt, ntile, 1, smem);
    } else {
      int j = it - n_norm - n_win; const int which = j >> 9; j &= 511; const int ntile = j >> 5, kt = j & 31;
      convert_tile(p.in[10 + which], 1024, 2048, (u16*)(p.ws + OFF_S2 + (size_t)which * 4194304), kt, ntile, 0, smem);
    }
  }
}

DEV void phase_inproj(const Params& p, int b, char* smem) {
  const int tid = get_tid(), lane = tid & 63, w = tid >> 6, wm = w >> 1, wn = w & 1, r = lane & 31, h = lane >> 5;
  const u16* U = (const u16*)((char*)p.out + OUT_HALF);
  const u16* WT = (const u16*)(p.ws + OFF_S1);
  const int MT = 65, NT = 105;
  for (int it = get_bid(); it < MT * NT; it += gridDim.x) {
    const int nt = it / MT, mt = it % MT;
    f32x16 acc[2][2];
#pragma unroll
    for (int mi = 0; mi < 2; ++mi)
#pragma unroll
      for (int ni = 0; ni < 2; ++ni) acc[mi][ni] = zero16();
    gemm_tile<2>(acc, U, 1024, mt * 128, L - 1, WT, 1024, nt * 128, 1024, smem);
    const int n0 = nt * 128;
    if (nt >= 40 && nt < 56) {
      const bool isk = nt >= 48;
      const int cq = n0 - (isk ? 6144 : 5120);
      const int blk = ((cq & 255) >> 6) + wn;
      const int jf = blk * 32 + r;
      const double invf_rev = exp(-(double)jf * 0.07252236513367073) * 0.15915494309189535;
      const float sc = isk ? 0.0625f : 1.f;
      u16* dst = (u16*)(p.ws + (isk ? OFF_K : OFF_Q));
#pragma unroll
      for (int mi = 0; mi < 2; ++mi)
#pragma unroll
        for (int i = 0; i < 16; ++i) {
          const int t = mt * 128 + wm * 64 + mi * 32 + acc_row(i, h);
          if (t < L) {
            double rev = (double)t * invf_rev;
            rev -= floor(rev);
            const float fr = (float)rev;
            const float sn = __builtin_amdgcn_sinf(fr), cs = __builtin_amdgcn_cosf(fr);
            const float x1 = acc[mi][0][i], x2 = acc[mi][1][i];
            const float o1 = (x1 * cs - x2 * sn) * sc, o2 = (x2 * cs + x1 * sn) * sc;
            u16* d = dst + (size_t)t * 1024 + cq + wn * 64 + r;
            d[0] = f2bf(o1); d[32] = f2bf(o2);
          }
        }
    } else if (nt == 104) {
      float* DT = (float*)(p.ws + OFF_DT);
      if (wn == 0) {
        const float bias = p.in[6][r];
#pragma unroll
        for (int mi = 0; mi < 2; ++mi)
#pragma unroll
          for (int i = 0; i < 16; ++i) {
            const int t = mt * 128 + wm * 64 + mi * 32 + acc_row(i, h);
            if (t < L) {
              const float x = acc[mi][0][i] + bias;
              const float e = __expf(x);
              DT[(size_t)t * 32 + r] = (x > 20.f) ? x : (e < 0.01f ? e * (1.f - 0.5f * e + e * e * (1.f / 3.f)) : __logf(1.f + e));
            }
          }
      }
    } else {
      u16* dst; int ld, c0; bool sig = false;
      if (nt < 16) { dst = (u16*)(p.ws + OFF_Z); ld = 2048; c0 = n0; }
      else if (nt < 40) { dst = (u16*)(p.ws + OFF_XBC); ld = 3072; c0 = n0 - 2048; }
      else if (nt < 72) { dst = (u16*)(p.ws + OFF_V); ld = 2048; c0 = n0 - 7168; }
      else if (nt < 88) { dst = (u16*)(p.ws + OFF_G); ld = 2048; c0 = n0 - 9216; }
      else if (nt < 96) { dst = (u16*)(p.ws + OFF_GS); ld = 1024; c0 = n0 - 11264; sig = true; }
      else { dst = (u16*)(p.ws + OFF_GR); ld = 1024; c0 = n0 - 12288; sig = true; }
#pragma unroll
      for (int mi = 0; mi < 2; ++mi)
#pragma unroll
        for (int ni = 0; ni < 2; ++ni)
#pragma unroll
          for (int i = 0; i < 16; ++i) {
            const int t = mt * 128 + wm * 64 + mi * 32 + acc_row(i, h);
            if (t < L) {
              float v = acc[mi][ni][i];
              if (sig) v = sigmoid_f(v);
              dst[(size_t)t * ld + c0 + wn * 64 + ni * 32 + r] = f2bf(v);
            }
          }
    }
  }
}

DEV void ssd_state_item(const Params& p, int it, char* smem) {
  const int tid = get_tid(), lane = tid & 63, w = tid >> 6, wm = w >> 1, wn = w & 1, r = lane & 31, h = lane >> 5;
  const int c = it >> 4, hp = it & 15, H0 = hp * 2, g = H0 >> 3;
  u16* Xw = (u16*)smem;
  u16* Bc = Xw + 128 * 136;
  float* wsc = (float*)(Bc + 128 * 136);
  float* tmp = wsc + 256;
  const float* DT = (const float*)(p.ws + OFF_DT);
  float* CD = (float*)(p.ws + OFF_CD);
  const u16* XBC = (const u16*)(p.ws + OFF_XBC);
  if (w < 2) {
    const int H = H0 + w;
    const float A = -expf(p.in[7][H]);
    float* acs = tmp + w * 128;
    float* dts = wsc + w * 128;
    const float aend = chunk_cumsum(DT, c, H, A, acs, dts, lane);
    const int s0 = 2 * lane;
    const float w0 = __expf(aend - acs[s0]) * dts[s0], w1 = __expf(aend - acs[s0 + 1]) * dts[s0 + 1];
    dts[s0] = w0; dts[s0 + 1] = w1;
    if (lane == 0) CD[c * 32 + H] = __expf(aend);
  }
  __syncthreads();
  stage_conv<128, 128, true>(Xw, 136, XBC, c * 128, H0 * 64, p.in[4], p.in[5], wsc);
  stage_conv<128, 128, false>(Bc, 136, XBC, c * 128, 2048 + g * 128, p.in[4], p.in[5], nullptr);
  __syncthreads();
  f32x16 acc[2][2];
#pragma unroll
  for (int mi = 0; mi < 2; ++mi)
#pragma unroll
    for (int ni = 0; ni < 2; ++ni) acc[mi][ni] = zero16();
#pragma unroll
  for (int ks = 0; ks < 8; ++ks) {
    bf16x8 a[2], bq[2];
#pragma unroll
    for (int mi = 0; mi < 2; ++mi) a[mi] = frag_tr(Xw, 136, ks * 16, wm * 64 + mi * 32, lane);
#pragma unroll
    for (int ni = 0; ni < 2; ++ni) bq[ni] = frag_tr(Bc, 136, ks * 16, wn * 64 + ni * 32, lane);
#pragma unroll
    for (int mi = 0; mi < 2; ++mi)
#pragma unroll
      for (int ni = 0; ni < 2; ++ni) acc[mi][ni] = mfma(a[mi], bq[ni], acc[mi][ni]);
  }
  u16* ST = (u16*)(p.ws + OFF_S1) + (size_t)(c * 32 + H0) * 8192;
  __syncthreads();
#pragma unroll
  for (int mi = 0; mi < 2; ++mi)
#pragma unroll
    for (int ni = 0; ni < 2; ++ni)
#pragma unroll
      for (int i = 0; i < 16; ++i) Xw[(wm * 64 + mi * 32 + acc_row(i, h)) * 136 + wn * 64 + ni * 32 + r] = f2bf(acc[mi][ni][i]);
  asm volatile("s_waitcnt lgkmcnt(0)" ::: "memory");
#pragma unroll
  for (int j = 0; j < 8; ++j) {
    const int m = wm * 64 + (lane >> 3) + 8 * j, n = wn * 64 + (lane & 7) * 8;
    *(u32x4*)(ST + m * 128 + n) = *(const u32x4*)(Xw + m * 136 + n);
  }
  __syncthreads();
}

DEV void ret_kv_item(const Params& p, int it, char* smem) {
  const int tid = get_tid(), lane = tid & 63, w = tid >> 6, wm = w >> 1, wn = w & 1, r = lane & 31, h = lane >> 5;
  const int sc = it >> 5, rem = it & 31, hd = rem >> 3, dt2 = (rem >> 2) & 1, et = rem & 3;
  u16* Vt = (u16*)smem;
  u16* Kt = Vt + 128 * 136;
  const u16* Vg = (const u16*)(p.ws + OFF_V);
  const u16* Kg = (const u16*)(p.ws + OFF_K);
  const float lg = log_gamma(hd);
  f32x16 acc[2][2];
#pragma unroll
  for (int mi = 0; mi < 2; ++mi)
#pragma unroll
    for (int ni = 0; ni < 2; ++ni) acc[mi][ni] = zero16();
  for (int half = 0; half < 2; ++half) {
#pragma unroll
    for (int i = 0; i < 8; ++i) {
      const int cidx = tid + i * 256, row = cidx >> 4, cc = cidx & 15;
      const int tok = sc * 256 + half * 128 + row;
      u32x4 v = *(const u32x4*)(Vg + (size_t)tok * 2048 + hd * 512 + et * 128 + cc * 8);
      *(u32x4*)(Vt + row * 136 + cc * 8) = v;
      u32x4 kk = *(const u32x4*)(Kg + (size_t)tok * 1024 + hd * 256 + dt2 * 128 + cc * 8);
      const float dec = __expf((float)(255 - (half * 128 + row)) * lg);
      u32x4 ko;
#pragma unroll
      for (int j = 0; j < 4; ++j) ko[j] = pack2(lo_f(kk[j]) * dec, hi_f(kk[j]) * dec);
      *(u32x4*)(Kt + row * 136 + cc * 8) = ko;
    }
    __syncthreads();
#pragma unroll
    for (int ks = 0; ks < 8; ++ks) {
      bf16x8 a[2], bq[2];
#pragma unroll
      for (int mi = 0; mi < 2; ++mi) a[mi] = frag_tr(Vt, 136, ks * 16, wm * 64 + mi * 32, lane);
#pragma unroll
      for (int ni = 0; ni < 2; ++ni) bq[ni] = frag_tr(Kt, 136, ks * 16, wn * 64 + ni * 32, lane);
#pragma unroll
      for (int mi = 0; mi < 2; ++mi)
#pragma unroll
        for (int ni = 0; ni < 2; ++ni) acc[mi][ni] = mfma(a[mi], bq[ni], acc[mi][ni]);
    }
    __syncthreads();
  }
  u16* RST = (u16*)((char*)p.out + OUT_HALF) + ((size_t)(sc * 4 + hd) * 512 + et * 128) * 256 + dt2 * 128;
#pragma unroll
  for (int mi = 0; mi < 2; ++mi)
#pragma unroll
    for (int ni = 0; ni < 2; ++ni)
#pragma unroll
      for (int i = 0; i < 16; ++i) Vt[(wm * 64 + mi * 32 + acc_row(i, h)) * 136 + wn * 64 + ni * 32 + r] = f2bf(acc[mi][ni][i]);
  asm volatile("s_waitcnt lgkmcnt(0)" ::: "memory");
#pragma unroll
  for (int j = 0; j < 8; ++j) {
    const int e = wm * 64 + (lane >> 3) + 8 * j, d = wn * 64 + (lane & 7) * 8;
    *(u32x4*)(RST + (size_t)e * 256 + d) = *(const u32x4*)(Vt + e * 136 + d);
  }
  __syncthreads();
}

DEV void phase_scan(const Params& p) {
  const int gt = get_bid() * 256 + get_tid(), nth = nworkers() * 256;
  const float* CD = (const float*)(p.ws + OFF_CD);
  for (int v = gt; v < 32768 + 65536; v += nth) {
    float st[8];
#pragma unroll
    for (int j = 0; j < 8; ++j) st[j] = 0.f;
    if (v < 32768) {
      const int e0 = v * 8, H = e0 >> 13;
      u16* base = (u16*)(p.ws + OFF_S1) + e0;
      for (int c0 = 0; c0 < 64; c0 += 8) {
        u32x4 x[8];
#pragma unroll
        for (int u = 0; u < 8; ++u) x[u] = *(const u32x4*)(base + (size_t)(c0 + u) * 262144);
#pragma unroll
        for (int u = 0; u < 8; ++u) {
          const float dcy = CD[(c0 + u) * 32 + H];
          u32x4 o;
#pragma unroll
          for (int j = 0; j < 4; ++j) {
            st[2 * j] = st[2 * j] * dcy + lo_f(x[u][j]);
            st[2 * j + 1] = st[2 * j + 1] * dcy + hi_f(x[u][j]);
            o[j] = pack2(st[2 * j], st[2 * j + 1]);
          }
          *(u32x4*)(base + (size_t)(c0 + u) * 262144) = o;
        }
      }
    } else {
      const int e0 = (v - 32768) * 8, hd = e0 >> 17;
      const float g256 = __expf(256.f * log_gamma(hd));
      u16* base = (u16*)((char*)p.out + OUT_HALF) + e0;
      for (int c0 = 0; c0 < 32; c0 += 8) {
        u32x4 x[8];
#pragma unroll
        for (int u = 0; u < 8; ++u) x[u] = *(const u32x4*)(base + (size_t)(c0 + u) * 524288);
#pragma unroll
        for (int u = 0; u < 8; ++u) {
          u32x4 o;
#pragma unroll
          for (int j = 0; j < 4; ++j) {
            st[2 * j] = st[2 * j] * g256 + lo_f(x[u][j]);
            st[2 * j + 1] = st[2 * j + 1] * g256 + hi_f(x[u][j]);
            o[j] = pack2(st[2 * j], st[2 * j + 1]);
          }
          *(u32x4*)(base + (size_t)(c0 + u) * 524288) = o;
        }
      }
    }
  }
}

DEV void ssd_out_item(const Params& p, int it, char* smem) {
  const int tid = get_tid(), lane = tid & 63, w = tid >> 6, wm = w >> 1, wn = w & 1, r = lane & 31, h = lane >> 5;
  const int c = it >> 3, rem = it & 7, g = rem & 3, lh = rem >> 2;
  if (c == 64 && lh == 1) return;
  u16* Ct = (u16*)smem;
  u16* Bt = Ct + 64 * 136;
  u16* Lt = Bt;
  u16* Xt = Bt + 128 * 136;
  float* acs = (float*)(Xt + 128 * 72);
  float* dts = acs + 128;
  float* rowsq = dts + 128;
  const u16* XBC = (const u16*)(p.ws + OFF_XBC);
  const float* DT = (const float*)(p.ws + OFF_DT);
  u16* Z = (u16*)(p.ws + OFF_Z);
  const int tok0 = c * 128;
  stage_conv<64, 128, false>(Ct, 136, XBC, tok0 + lh * 64, 2560 + g * 128, p.in[4], p.in[5], nullptr);
  stage_conv<128, 128, false>(Bt, 136, XBC, tok0, 2048 + g * 128, p.in[4], p.in[5], nullptr);
  if (tid < 64) rowsq[tid] = 0.f;
  __syncthreads();
  f32x16 cb[2];
  cb[0] = zero16(); cb[1] = zero16();
#pragma unroll
  for (int ks = 0; ks < 8; ++ks) {
    bf16x8 a = frag_row(Ct, 136, wm * 32 + r, ks * 16 + h * 8);
#pragma unroll
    for (int ni = 0; ni < 2; ++ni) {
      bf16x8 bq = frag_row(Bt, 136, wn * 64 + ni * 32 + r, ks * 16 + h * 8);
      cb[ni] = mfma(a, bq, cb[ni]);
    }
  }
  for (int hh = 0; hh < 8; ++hh) {
    const int H = g * 8 + hh;
    u32x4 zv[2];
    {
      int tz = tok0 + lh * 64 + (tid >> 2); tz = tz < L ? tz : L - 1;
      const u16* zp0 = Z + (size_t)tz * 2048 + H * 64 + (tid & 3) * 16;
      zv[0] = *(const u32x4*)zp0; zv[1] = *(const u32x4*)(zp0 + 8);
    }
    __syncthreads();
    if (w == 0) {
      const float A = -expf(p.in[7][H]);
      chunk_cumsum(DT, c, H, A, acs, dts, lane);
    }
    stage_conv<128, 64, false>(Xt, 72, XBC, tok0, H * 64, p.in[4], p.in[5], nullptr);
    __syncthreads();
#pragma unroll
    for (int ni = 0; ni < 2; ++ni)
#pragma unroll
      for (int i = 0; i < 16; ++i) {
        const int ll = wm * 32 + acc_row(i, h), l = lh * 64 + ll, s = wn * 64 + ni * 32 + r;
        float val = 0.f;
        if (s <= l) val = cb[ni][i] * __expf(acs[l] - acs[s]) * dts[s];
        Lt[ll * 136 + s] = f2bf(val);
      }
    f32x16 y = zero16();
    if (c > 0) {
      const u16* pv = (const u16*)(p.ws + OFF_S1) + ((size_t)((c - 1) * 32 + H) * 64 + wn * 32 + r) * 128 + h * 8;
#pragma unroll
      for (int ks = 0; ks < 8; ++ks) {
        bf16x8 a = frag_row(Ct, 136, wm * 32 + r, ks * 16 + h * 8);
        bf16x8 bq = *(const bf16x8*)(pv + ks * 16);
        y = mfma(a, bq, y);
      }
#pragma unroll
      for (int i = 0; i < 16; ++i) { const int l = lh * 64 + wm * 32 + acc_row(i, h); y[i] *= __expf(acs[l]); }
    }
    __syncthreads();
#pragma unroll
    for (int ks = 0; ks < 8; ++ks) {
      bf16x8 a = frag_row(Lt, 136, wm * 32 + r, ks * 16 + h * 8);
      bf16x8 bq = frag_tr(Xt, 72, ks * 16, wn * 32, lane);
      y = mfma(a, bq, y);
    }
    const float Dsk = p.in[8][H];
    float* Ys = (float*)(Bt + 64 * 136);
#pragma unroll
    for (int i = 0; i < 16; ++i) Ys[(wm * 32 + acc_row(i, h)) * 68 + wn * 32 + r] = y[i];
    __syncthreads();
    {
      const int row = tid >> 2, q = tid & 3, l = lh * 64 + row, t = tok0 + l;
      float sq = 0.f;
      if (t < L) {
        u16* zp = Z + (size_t)t * 2048 + H * 64 + q * 16;
        u32x4 xv[2], ov[2];
        xv[0] = *(const u32x4*)(Xt + l * 72 + q * 16); xv[1] = *(const u32x4*)(Xt + l * 72 + q * 16 + 8);
#pragma unroll
        for (int k = 0; k < 2; ++k) {
          const f32x4 ya = *(const f32x4*)(Ys + row * 68 + q * 16 + k * 8), yb = *(const f32x4*)(Ys + row * 68 + q * 16 + k * 8 + 4);
          float o[8];
#pragma unroll
          for (int j = 0; j < 4; ++j) {
            const float y0 = (j < 2) ? ya[2 * j] : yb[2 * j - 4], y1 = (j < 2) ? ya[2 * j + 1] : yb[2 * j - 3];
            o[2 * j] = (y0 + Dsk * lo_f(xv[k][j])) * silu_f(lo_f(zv[k][j]));
            o[2 * j + 1] = (y1 + Dsk * hi_f(xv[k][j])) * silu_f(hi_f(zv[k][j]));
            sq += o[2 * j] * o[2 * j] + o[2 * j + 1] * o[2 * j + 1];
            ov[k][j] = pack2(o[2 * j], o[2 * j + 1]);
          }
        }
        *(u32x4*)zp = ov[0]; *(u32x4*)(zp + 8) = ov[1];
      }
      sq += __shfl_xor(sq, 1); sq += __shfl_xor(sq, 2);
      if (q == 0) rowsq[row] += sq;
    }
  }
  __syncthreads();
  {
    const int row = tid >> 2, q = tid & 3, t = tok0 + lh * 64 + row;
    if (t < L) {
      const float rn = rsqrtf(rowsq[row] * (1.f / 512.f) + EPS);
      u32x4 v[16];
#pragma unroll
      for (int hh = 0; hh < 8; ++hh) {
        const u16* zp = Z + (size_t)t * 2048 + (g * 8 + hh) * 64 + q * 16;
        v[2 * hh] = *(const u32x4*)zp; v[2 * hh + 1] = *(const u32x4*)(zp + 8);
      }
#pragma unroll
      for (int hh = 0; hh < 8; ++hh) {
        u16* zp = Z + (size_t)t * 2048 + (g * 8 + hh) * 64 + q * 16;
        const float* nwp = p.in[9] + (g * 8 + hh) * 64 + q * 16;
#pragma unroll
        for (int k = 0; k < 2; ++k) {
          const f32x4 wa = *(const f32x4*)(nwp + k * 8), wb = *(const f32x4*)(nwp + k * 8 + 4);
          u32x4 o;
          o[0] = pack2(lo_f(v[2 * hh + k][0]) * rn * wa[0], hi_f(v[2 * hh + k][0]) * rn * wa[1]);
          o[1] = pack2(lo_f(v[2 * hh + k][1]) * rn * wa[2], hi_f(v[2 * hh + k][1]) * rn * wa[3]);
          o[2] = pack2(lo_f(v[2 * hh + k][2]) * rn * wb[0], hi_f(v[2 * hh + k][2]) * rn * wb[1]);
          o[3] = pack2(lo_f(v[2 * hh + k][3]) * rn * wb[2], hi_f(v[2 * hh + k][3]) * rn * wb[3]);
          *(u32x4*)(zp + k * 8) = o;
        }
      }
    }
  }
  __syncthreads();
}

DEV void ret_out_item(const Params& p, int it, char* smem) {
  const int tid = get_tid(), lane = tid & 63, w = tid >> 6, wm = w >> 1, wn = w & 1, r = lane & 31, h = lane >> 5;
  const int rt = it >> 2, hd = it & 3;
  const int t0 = rt * 64, sc = rt >> 2, qtr = rt & 3;
  u16* P = (u16*)smem;
  char* gsm = smem + 33792;
  u16* Vt = (u16*)gsm;
  float* rowsq = (float*)(smem + 33792 + 27648);
  const u16* Qg = (const u16*)(p.ws + OFF_Q) + hd * 256;
  const u16* Kg = (const u16*)(p.ws + OFF_K) + hd * 256;
  const u16* Vg = (const u16*)(p.ws + OFF_V);
  u16* Gg = (u16*)(p.ws + OFF_G);
  const u16* RST = (const u16*)((char*)p.out + OUT_HALF);
  const float lg = log_gamma(hd);
  if (tid < 64) rowsq[tid] = 0.f;
  const int nkb = (qtr >= 2) ? 2 : 1;
  for (int kb = 0; kb < nkb; ++kb) {
    f32x16 acc[1][2];
    acc[0][0] = zero16(); acc[0][1] = zero16();
    gemm_tile<1>(acc, Qg, 1024, t0, L - 1, Kg, 1024, sc * 256 + kb * 128, 256, gsm);
#pragma unroll
    for (int ni = 0; ni < 2; ++ni)
#pragma unroll
      for (int i = 0; i < 16; ++i) {
        const int ll = wm * 32 + acc_row(i, h), lp = qtr * 64 + ll, s = kb * 128 + wn * 64 + ni * 32 + r;
        float val = 0.f;
        if (s <= lp) val = acc[0][ni][i] * __expf((float)(lp - s) * lg);
        P[ll * 264 + s] = f2bf(val);
      }
  }
  float rs[16];
#pragma unroll
  for (int i = 0; i < 16; ++i) rs[i] = 0.f;
  for (int et = 0; et < 4; ++et) {
    f32x16 acc[1][2];
    acc[0][0] = zero16(); acc[0][1] = zero16();
    u32x4 gv[4], vreg[4];
    {
      int tg = t0 + (tid >> 2); tg = tg < L ? tg : L - 1;
      const u16* gp0 = Gg + (size_t)tg * 2048 + hd * 512 + et * 128 + (tid & 3) * 32;
#pragma unroll
      for (int k = 0; k < 4; ++k) gv[k] = *(const u32x4*)(gp0 + k * 8);
#pragma unroll
      for (int i = 0; i < 4; ++i) {
        const int cidx = tid + i * 256, row = cidx >> 4, cc = cidx & 15;
        int tok = sc * 256 + row; tok = tok < L ? tok : L - 1;
        vreg[i] = *(const u32x4*)(Vg + (size_t)tok * 2048 + hd * 512 + et * 128 + cc * 8);
      }
    }
    if (sc > 0) {
      gemm_tile<1>(acc, Qg, 1024, t0, L - 1, RST + ((size_t)((sc - 1) * 4 + hd) * 512 + et * 128) * 256, 256, 0, 256, gsm);
#pragma unroll
      for (int ni = 0; ni < 2; ++ni)
#pragma unroll
        for (int i = 0; i < 16; ++i) {
          const int lp = qtr * 64 + wm * 32 + acc_row(i, h);
          acc[0][ni][i] *= __expf((float)(lp + 1) * lg);
        }
    }
    for (int kb64 = 0; kb64 <= qtr; ++kb64) {
#pragma unroll
      for (int i = 0; i < 4; ++i) {
        const int cidx = tid + i * 256, row = cidx >> 4, cc = cidx & 15;
        const int tok = sc * 256 + kb64 * 64 + row;
        u32x4 v = {0u, 0u, 0u, 0u};
        if (tok < L) v = vreg[i];
        *(u32x4*)(Vt + row * 136 + cc * 8) = v;
      }
      __syncthreads();
      if (kb64 < qtr) {
#pragma unroll
        for (int i = 0; i < 4; ++i) {
          const int cidx = tid + i * 256, row = cidx >> 4, cc = cidx & 15;
          int tok = sc * 256 + (kb64 + 1) * 64 + row; tok = tok < L ? tok : L - 1;
          vreg[i] = *(const u32x4*)(Vg + (size_t)tok * 2048 + hd * 512 + et * 128 + cc * 8);
        }
      }
#pragma unroll
      for (int ks = 0; ks < 4; ++ks) {
        bf16x8 a = frag_row(P, 264, wm * 32 + r, kb64 * 64 + ks * 16 + h * 8);
#pragma unroll
        for (int ni = 0; ni < 2; ++ni) {
          bf16x8 bq = frag_tr(Vt, 136, ks * 16, wn * 64 + ni * 32, lane);
          acc[0][ni] = mfma(a, bq, acc[0][ni]);
        }
      }
      __syncthreads();
    }
    u16* Os = (u16*)gsm;
#pragma unroll
    for (int ni = 0; ni < 2; ++ni)
#pragma unroll
      for (int i = 0; i < 16; ++i) {
        const float o = acc[0][ni][i];
        if (t0 + wm * 32 + acc_row(i, h) < L) rs[i] += o * o;
        Os[(wm * 32 + acc_row(i, h)) * 136 + wn * 64 + ni * 32 + r] = f2bf(o);
      }
    __syncthreads();
    {
      const int row = tid >> 2, q = tid & 3, t = t0 + row;
      if (t < L) {
        u16* gp = Gg + (size_t)t * 2048 + hd * 512 + et * 128 + q * 32;
        u32x4 ov[4];
#pragma unroll
        for (int k = 0; k < 4; ++k) ov[k] = *(const u32x4*)(Os + row * 136 + q * 32 + k * 8);
#pragma unroll
        for (int k = 0; k < 4; ++k) {
          u32x4 o;
#pragma unroll
          for (int j = 0; j < 4; ++j) o[j] = pack2(silu_f(lo_f(gv[k][j])) * lo_f(ov[k][j]), silu_f(hi_f(gv[k][j])) * hi_f(ov[k][j]));
          *(u32x4*)(gp + k * 8) = o;
        }
      }
    }
    __syncthreads();
  }
#pragma unroll
  for (int i = 0; i < 16; ++i) {
    const float v = half_sum(rs[i]);
    if (r == 0) atomicAdd(&rowsq[wm * 32 + acc_row(i, h)], v);
  }
  __syncthreads();
  {
    const int row = tid >> 2, q = tid & 3, t = t0 + row;
    if (t < L) {
      const float rn = rsqrtf(rowsq[row] * (1.f / 512.f) + EPS);
      u32x4 v[16];
#pragma unroll
      for (int et = 0; et < 4; ++et)
#pragma unroll
        for (int k = 0; k < 4; ++k) v[et * 4 + k] = *(const u32x4*)(Gg + (size_t)t * 2048 + hd * 512 + et * 128 + q * 32 + k * 8);
#pragma unroll
      for (int et = 0; et < 4; ++et)
#pragma unroll
        for (int k = 0; k < 4; ++k) {
          u32x4 o;
#pragma unroll
          for (int j = 0; j < 4; ++j) o[j] = pack2(lo_f(v[et * 4 + k][j]) * rn, hi_f(v[et * 4 + k][j]) * rn);
          *(u32x4*)(Gg + (size_t)t * 2048 + hd * 512 + et * 128 + q * 32 + k * 8) = o;
        }
    }
  }
  __syncthreads();
}

DEV void merge_tile(const Params& p, int it, char* smem) {
  const int tid = get_tid(), lane = tid & 63, w = tid >> 6, wm = w >> 1, wn = w & 1, r = lane & 31, h = lane >> 5;
  const int nt = it / 65, mt = it % 65;
  u16* GS = (u16*)(p.ws + OFF_GS);
  const u16* GR = (const u16*)(p.ws + OFF_GR);
  f32x16 acc[2][2];
#pragma unroll
  for (int mi = 0; mi < 2; ++mi)
#pragma unroll
    for (int ni = 0; ni < 2; ++ni) acc[mi][ni] = zero16();
  gemm_tile<2>(acc, (const u16*)(p.ws + OFF_Z), 2048, mt * 128, L - 1, (const u16*)(p.ws + OFF_S2), 2048, nt * 128, 2048, smem);
#pragma unroll
  for (int mi = 0; mi < 2; ++mi)
#pragma unroll
    for (int ni = 0; ni < 2; ++ni)
#pragma unroll
      for (int i = 0; i < 16; ++i) {
        const int t = mt * 128 + wm * 64 + mi * 32 + acc_row(i, h);
        if (t < L) {
          const size_t idx = (size_t)t * 1024 + nt * 128 + wn * 64 + ni * 32 + r;
          GS[idx] = f2bf(bf2f(GS[idx]) * acc[mi][ni][i]);
        }
        acc[mi][ni][i] = 0.f;
      }
  gemm_tile<2>(acc, (const u16*)(p.ws + OFF_G), 2048, mt * 128, L - 1, (const u16*)(p.ws + OFF_S2 + 4194304), 2048, nt * 128, 2048, smem);
#pragma unroll
  for (int mi = 0; mi < 2; ++mi)
#pragma unroll
    for (int ni = 0; ni < 2; ++ni)
#pragma unroll
      for (int i = 0; i < 16; ++i) {
        const int t = mt * 128 + wm * 64 + mi * 32 + acc_row(i, h);
        if (t < L) {
          const size_t idx = (size_t)t * 1024 + nt * 128 + wn * 64 + ni * 32 + r;
          GS[idx] = f2bf(bf2f(GS[idx]) + bf2f(GR[idx]) * acc[mi][ni][i]);
        }
      }
}

DEV void phase_merge(const Params& p, char* smem) {
  const int n_tiles = 65 * 8;
  const int n_wout = 16 * 16, n_wup = 16 * 88, n_wdown = 44 * 16;
  const int total = n_tiles + n_wout + n_wup + n_wdown;
  for (int it = get_bid(); it < total; it += nworkers()) {
    if (it < n_tiles) merge_tile(p, it, smem);
    else if (it < n_tiles + n_wout) { const int j = it - n_tiles; convert_tile(p.in[12], 1024, 1024, (u16*)(p.ws + OFF_WOUT), j & 15, j >> 4, 0, smem); }
    else if (it < n_tiles + n_wout + n_wup) { const int j = it - n_tiles - n_wout; convert_tile(p.in[14], 5632, 1024, (u16*)(p.ws + OFF_WUP), j & 15, j >> 4, 0, smem); }
    else { const int j = it - n_tiles - n_wout - n_wup; convert_tile(p.in[17], 1024, 2816, (u16*)(p.ws + OFF_WDOWN), j % 44, j / 44, 0, smem); }
  }
}

DEV void phase_outproj(const Params& p, int b, char* smem) {
  const int tid = get_tid(), lane = tid & 63, w = tid >> 6, wm = w >> 1, wn = w & 1, r = lane & 31, h = lane >> 5;
  float* HM = (float*)(p.ws + OFF_HM);
  for (int it = get_bid(); it < 65 * 8; it += gridDim.x) {
    const int nt = it / 65, mt = it % 65;
    f32x16 acc[2][2];
#pragma unroll
    for (int mi = 0; mi < 2; ++mi)
#pragma unroll
      for (int ni = 0; ni < 2; ++ni) acc[mi][ni] = zero16();
    gemm_tile<2>(acc, (const u16*)(p.ws + OFF_GS), 1024, mt * 128, L - 1, (const u16*)(p.ws + OFF_WOUT), 1024, nt * 128, 1024, smem);
#pragma unroll
    for (int mi = 0; mi < 2; ++mi)
#pragma unroll
      for (int ni = 0; ni < 2; ++ni)
#pragma unroll
        for (int i = 0; i < 16; ++i) {
          const int t = mt * 128 + wm * 64 + mi * 32 + acc_row(i, h);
          const int col = nt * 128 + wn * 64 + ni * 32 + r;
          if (t < NMETA) HM[t * 1024 + col] = p.in[1][t * 1024 + col] + acc[mi][ni][i];
          else if (t < L) {
            const size_t idx = ((size_t)b * SEQ + (t - NMETA)) * 1024 + col;
            p.out[idx] = p.in[0][idx] + acc[mi][ni][i];
          }
        }
  }
}

DEV void phase_norm2(const Params& p, int b) {
  const int lane = get_tid() & 63, w = get_tid() >> 6;
  u16* U2 = (u16*)(p.ws + OFF_U2);
  for (int it = get_bid(); it < L / 4; it += nworkers()) {
    const int t = it * 4 + w;
    const float* src = (t < NMETA) ? ((const float*)(p.ws + OFF_HM) + (size_t)t * D) : (p.out + ((size_t)b * SEQ + (t - NMETA)) * D);
    rmsnorm_row_bf16(src, p.in[13], U2 + (size_t)t * D, lane);
  }
}

DEV void phase_up(const Params& p, char* smem) {
  const int tid = get_tid(), lane = tid & 63, w = tid >> 6, wm = w >> 1, wn = w & 1, r = lane & 31, h = lane >> 5;
  u16* UP = (u16*)(p.ws + OFF_UP);
  for (int it = get_bid(); it < 65 * 44; it += gridDim.x) {
    const int nt = it / 65, mt = it % 65;
    f32x16 acc[2][2];
#pragma unroll
    for (int mi = 0; mi < 2; ++mi)
#pragma unroll
      for (int ni = 0; ni < 2; ++ni) acc[mi][ni] = zero16();
    gemm_tile<2>(acc, (const u16*)(p.ws + OFF_U2), 1024, mt * 128, L - 1, (const u16*)(p.ws + OFF_WUP), 1024, nt * 128, 1024, smem);
#pragma unroll
    for (int mi = 0; mi < 2; ++mi)
#pragma unroll
      for (int ni = 0; ni < 2; ++ni)
#pragma unroll
        for (int i = 0; i < 16; ++i) {
          const int t = mt * 128 + wm * 64 + mi * 32 + acc_row(i, h);
          if (t < L) UP[(size_t)t * 5632 + nt * 128 + wn * 64 + ni * 32 + r] = f2bf(acc[mi][ni][i]);
        }
  }
}

DEV void phase_ffn_act(const Params& p) {
  const int gt = get_bid() * 256 + get_tid(), nth = nworkers() * 256;
  const u16* UP = (const u16*)(p.ws + OFF_UP);
  u16* ACT = (u16*)(p.ws + OFF_ACT);
  const float* cw = p.in[15];
  const float* cbias = p.in[16];
  for (int u = gt; u < 513 * 352; u += nth) {
    const int rb = u / 352, cgp = u % 352, ch = cgp * 8, t0 = rb * 16;
    float wg[3][8], wv[3][8], bg[8], bv[8], g2[8], g1[8], v2[8], v1[8];
#pragma unroll
    for (int k = 0; k < 3; ++k)
#pragma unroll
      for (int j = 0; j < 8; ++j) { wg[k][j] = cw[k * 5632 + ch + j]; wv[k][j] = cw[k * 5632 + 2816 + ch + j]; }
#pragma unroll
    for (int j = 0; j < 8; ++j) { bg[j] = cbias[ch + j]; bv[j] = cbias[2816 + ch + j]; }
    {
      u32x4 a = {0u, 0u, 0u, 0u}, bq = {0u, 0u, 0u, 0u}, c2 = {0u, 0u, 0u, 0u}, d2 = {0u, 0u, 0u, 0u};
      if (t0 >= 2) {
        a = *(const u32x4*)(UP + (size_t)(t0 - 2) * 5632 + ch); bq = *(const u32x4*)(UP + (size_t)(t0 - 1) * 5632 + ch);
        c2 = *(const u32x4*)(UP + (size_t)(t0 - 2) * 5632 + 2816 + ch); d2 = *(const u32x4*)(UP + (size_t)(t0 - 1) * 5632 + 2816 + ch);
      }
#pragma unroll
      for (int j = 0; j < 4; ++j) {
        g2[2 * j] = lo_f(a[j]); g2[2 * j + 1] = hi_f(a[j]); g1[2 * j] = lo_f(bq[j]); g1[2 * j + 1] = hi_f(bq[j]);
        v2[2 * j] = lo_f(c2[j]); v2[2 * j + 1] = hi_f(c2[j]); v1[2 * j] = lo_f(d2[j]); v1[2 * j + 1] = hi_f(d2[j]);
      }
    }
#pragma unroll 4
    for (int i = 0; i < 16; ++i) {
      const int t = t0 + i;
      const u32x4 a = *(const u32x4*)(UP + (size_t)t * 5632 + ch);
      const u32x4 c2 = *(const u32x4*)(UP + (size_t)t * 5632 + 2816 + ch);
      float o[8];
#pragma unroll
      for (int j = 0; j < 8; ++j) {
        const float gx = (j & 1) ? hi_f(a[j >> 1]) : lo_f(a[j >> 1]);
        const float vx = (j & 1) ? hi_f(c2[j >> 1]) : lo_f(c2[j >> 1]);
        const float ag = bg[j] + wg[0][j] * g2[j] + wg[1][j] * g1[j] + wg[2][j] * gx;
        const float av = bv[j] + wv[0][j] * v2[j] + wv[1][j] * v1[j] + wv[2][j] * vx;
        o[j] = silu_f(ag) * av;
        g2[j] = g1[j]; g1[j] = gx; v2[j] = v1[j]; v1[j] = vx;
      }
      u32x4 pk; pk[0] = pack2(o[0], o[1]); pk[1] = pack2(o[2], o[3]); pk[2] = pack2(o[4], o[5]); pk[3] = pack2(o[6], o[7]);
      *(u32x4*)(ACT + (size_t)t * 2816 + ch) = pk;
    }
  }
}

DEV void phase_down(const Params& p, int b, char* smem) {
  const int tid = get_tid(), lane = tid & 63, w = tid >> 6, wm = w >> 1, wn = w & 1, r = lane & 31, h = lane >> 5;
  for (int it = get_bid(); it < 64 * 8; it += gridDim.x) {
    const int nt = it / 64, mt = it % 64;
    f32x16 acc[2][2];
#pragma unroll
    for (int mi = 0; mi < 2; ++mi)
#pragma unroll
      for (int ni = 0; ni < 2; ++ni) acc[mi][ni] = zero16();
    gemm_tile<2>(acc, (const u16*)(p.ws + OFF_ACT), 2816, NMETA + mt * 128, L - 1, (const u16*)(p.ws + OFF_WDOWN), 2816, nt * 128, 2816, smem);
#pragma unroll
    for (int mi = 0; mi < 2; ++mi)
#pragma unroll
      for (int ni = 0; ni < 2; ++ni)
#pragma unroll
        for (int i = 0; i < 16; ++i) {
          const int rr = mt * 128 + wm * 64 + mi * 32 + acc_row(i, h);
          const size_t idx = ((size_t)b * SEQ + rr) * 1024 + nt * 128 + wn * 64 + ni * 32 + r;
          p.out[idx] += acc[mi][ni][i];
        }
  }
}

DEV void phase_final_norm(const Params& p, int b) {
  const int lane = get_tid() & 63, w = get_tid() >> 6;
  for (int it = get_bid(); it < SEQ / 4; it += nworkers()) {
    const int rr = it * 4 + w;
    rmsnorm_row_f32_inplace(p.out + ((size_t)b * SEQ + rr) * D, p.in[18], lane);
  }
}


DEV u32x4 add_bf16x8(u32x4 a, u32x4 b) {
  u32x4 o;
#pragma unroll
  for (int j = 0; j < 4; ++j) o[j] = pack2(lo_f(a[j]) + lo_f(b[j]), hi_f(a[j]) + hi_f(b[j]));
  return o;
}
template <int NJ, bool ADD2 = false>
DEV void gemm_tile8(f32x4 (&acc)[4][NJ], const u16* __restrict__ A, int lda, int arow0, int arow_max,
                    const u16* __restrict__ B, int ldb, int brow0, int K, char* smem, const u16* __restrict__ A2 = nullptr) {
  constexpr int BN = NJ * 32;
  constexpr int BCH = BN / 64;
  constexpr int STAGE = (256 + BN) * 64;
  u16* S = (u16*)smem;
  const int tid = get_tid8(), lane = tid & 63, w = tid >> 6, wm = w >> 1, wn = w & 1;
  u32x4 ra[4], rb[BCH], ra2[ADD2 ? 4 : 1];
  unsigned aoff[4], boff[BCH];
  const char* Ab = (const char*)A;
  const char* Ab2 = (const char*)A2;
  const char* Bb = (const char*)(B + (size_t)brow0 * ldb);
  const int crow = tid >> 3, kc = tid & 7;
  const unsigned sto = (unsigned)(crow * 64 + ((kc ^ ((crow >> 1) & 7)) * 8));
#pragma unroll
  for (int i = 0; i < 4; ++i) {
    int gr = arow0 + crow + i * 64; gr = gr > arow_max ? arow_max : gr; gr = gr < 0 ? 0 : gr;
    aoff[i] = ((unsigned)gr * (unsigned)lda + kc * 8) * 2u;
  }
#pragma unroll
  for (int i = 0; i < BCH; ++i) boff[i] = ((unsigned)(crow + i * 64) * (unsigned)ldb + kc * 8) * 2u;
  const int fr = lane & 15, swz = fr >> 1, cq = lane >> 4;
  const unsigned fa = (unsigned)((wm * 64 + fr) * 64), fb = (unsigned)((256 + wn * (NJ * 16) + fr) * 64);
  const unsigned c0 = (unsigned)(((cq) ^ swz) * 8), c1 = (unsigned)(((4 + cq) ^ swz) * 8);
  const int nk = K >> 6;
#pragma unroll
  for (int i = 0; i < 4; ++i) { ra[i] = *(const u32x4*)(Ab + aoff[i]); if (ADD2) ra2[i] = *(const u32x4*)(Ab2 + aoff[i]); }
#pragma unroll
  for (int i = 0; i < BCH; ++i) rb[i] = *(const u32x4*)(Bb + boff[i]);
#pragma unroll
  for (int i = 0; i < 4; ++i) *(u32x4*)(S + sto + i * 64 * 64) = ADD2 ? add_bf16x8(ra[i], ra2[i]) : ra[i];
#pragma unroll
  for (int i = 0; i < BCH; ++i) *(u32x4*)(S + sto + (256 + i * 64) * 64) = rb[i];
  if (nk > 1) {
#pragma unroll
    for (int i = 0; i < 4; ++i) { ra[i] = *(const u32x4*)(Ab + aoff[i] + 128); if (ADD2) ra2[i] = *(const u32x4*)(Ab2 + aoff[i] + 128); }
#pragma unroll
    for (int i = 0; i < BCH; ++i) rb[i] = *(const u32x4*)(Bb + boff[i] + 128);
  }
  __syncthreads();
  for (int kt = 0; kt < nk; ++kt) {
    const u16* Sc = S + (kt & 1) * STAGE;
    {
      bf16x8 a[4], b[NJ];
#pragma unroll
      for (int m = 0; m < 4; ++m) a[m] = *(const bf16x8*)(Sc + fa + m * 16 * 64 + c0);
#pragma unroll
      for (int n = 0; n < NJ; ++n) b[n] = *(const bf16x8*)(Sc + fb + n * 16 * 64 + c0);
      __builtin_amdgcn_s_setprio(1);
#pragma unroll
      for (int m = 0; m < 4; ++m)
#pragma unroll
        for (int n = 0; n < NJ; ++n) acc[m][n] = __builtin_amdgcn_mfma_f32_16x16x32_bf16(a[m], b[n], acc[m][n], 0, 0, 0);
      __builtin_amdgcn_s_setprio(0);
    }
    bf16x8 a1[4], b1[NJ];
#pragma unroll
    for (int m = 0; m < 4; ++m) a1[m] = *(const bf16x8*)(Sc + fa + m * 16 * 64 + c1);
#pragma unroll
    for (int n = 0; n < NJ; ++n) b1[n] = *(const bf16x8*)(Sc + fb + n * 16 * 64 + c1);
    if (kt + 1 < nk) {
      u16* Aw = S + ((kt + 1) & 1) * STAGE;
#pragma unroll
      for (int i = 0; i < 4; ++i) *(u32x4*)(Aw + sto + i * 64 * 64) = ADD2 ? add_bf16x8(ra[i], ra2[i]) : ra[i];
#pragma unroll
      for (int i = 0; i < BCH; ++i) *(u32x4*)(Aw + sto + (256 + i * 64) * 64) = rb[i];
      if (kt + 2 < nk) {
        const unsigned ko = (unsigned)(kt + 2) * 128u;
#pragma unroll
        for (int i = 0; i < 4; ++i) { ra[i] = *(const u32x4*)(Ab + aoff[i] + ko); if (ADD2) ra2[i] = *(const u32x4*)(Ab2 + aoff[i] + ko); }
#pragma unroll
        for (int i = 0; i < BCH; ++i) rb[i] = *(const u32x4*)(Bb + boff[i] + ko);
      }
    }
    {
      __builtin_amdgcn_s_setprio(1);
#pragma unroll
      for (int m = 0; m < 4; ++m)
#pragma unroll
        for (int n = 0; n < NJ; ++n) acc[m][n] = __builtin_amdgcn_mfma_f32_16x16x32_bf16(a1[m], b1[n], acc[m][n], 0, 0, 0);
      __builtin_amdgcn_s_setprio(0);
    }
    __syncthreads();
  }
}

DEV f32x4 thin16(const u16* __restrict__ A, int lda, int row0, const u16* __restrict__ BT, int ldb, int col0, int K, int lane) {
  const u16* ap = A + (size_t)(row0 + (lane & 15)) * lda + 8 * (lane >> 4);
  const u16* bp = BT + (size_t)(col0 + (lane & 15)) * ldb + 8 * (lane >> 4);
  f32x4 acc = {0.f, 0.f, 0.f, 0.f};
  for (int k0 = 0; k0 < K; k0 += 128) {
    bf16x8 a[4], b[4];
#pragma unroll
    for (int j = 0; j < 4; ++j) { a[j] = *(const bf16x8*)(ap + k0 + j * 32); b[j] = *(const bf16x8*)(bp + k0 + j * 32); }
#pragma unroll
    for (int j = 0; j < 4; ++j) acc = __builtin_amdgcn_mfma_f32_16x16x32_bf16(a[j], b[j], acc, 0, 0, 0);
  }
  return acc;
}

DEV int tile_index(int k) { const int G = gridDim.x, rb = get_rbid(); return k * G + (rb & 7) * (G >> 3) + (rb >> 3); }
DEV void tile_decode(int T, int MT, int NT, int& mt, int& nt) {
  const int per = MT * 8;
  const int nb = T / per, rem = T - nb * per;
  int width = NT - nb * 8; width = width > 8 ? 8 : width;
  mt = rem / width; nt = nb * 8 + (rem - mt * width);
}

#define ZERO_ACC(acc, NJ_) _Pragma("unroll") for (int m_ = 0; m_ < 4; ++m_) _Pragma("unroll") for (int n_ = 0; n_ < NJ_; ++n_) { acc[m_][n_][0] = 0.f; acc[m_][n_][1] = 0.f; acc[m_][n_][2] = 0.f; acc[m_][n_][3] = 0.f; }

constexpr int EPI_WAVE_BYTES = 17408;
#define EPI_FENCE() asm volatile("s_waitcnt lgkmcnt(0)" ::: "memory")
DEV void epi_store_bf16_128(const u16* reg, u16* __restrict__ dst, int ld, int trow, int col0, int lane) {
#pragma unroll
  for (int j = 0; j < 16; ++j) {
    const int row = (lane >> 4) + 4 * j, t = trow + row;
    const u32x4 v = *(const u32x4*)(reg + row * 136 + (lane & 15) * 8);
    if (t < L) *(u32x4*)(dst + (size_t)t * ld + col0 + (lane & 15) * 8) = v;
  }
}

DEV void phase_inproj8(const Params& p, int b, char* smem) {
  const u16* U = (const u16*)((char*)p.out + OUT_HALF);
  const u16* WT = (const u16*)(p.ws + OFF_S1);
  const int MT = 33, NT = 53;
  for (int kk = 0;; ++kk) {
    const int it = tile_index(kk);
    if (it >= MT * NT) break;
    int mt, nt; tile_decode(it, MT, NT, mt, nt);
    f32x4 acc[4][8];
    ZERO_ACC(acc, 8)
    gemm_tile8<8>(acc, U, 1024, mt * 256, L - 1, WT, 1024, nt * 256, 1024, smem);
    const int tid = get_tid8(), lane = tid & 63, w = tid >> 6, wm = w >> 1, wn = w & 1, r = lane & 31, h = lane >> 5;
    u16* reg = (u16*)(smem + w * EPI_WAVE_BYTES);
    const int n0 = nt * 256;
    const int trow = mt * 256 + wm * 64;
    if (nt >= 20 && nt < 28) {
      const bool isk = nt >= 24;
      const int cq = n0 - (isk ? 6144 : 5120);
      const float sc = isk ? 0.0625f : 1.f;
      u16* dst = (u16*)(p.ws + (isk ? OFF_K : OFF_Q));
#pragma unroll
      for (int pr = 0; pr < 4; ++pr) {
        const int n1 = 4 * (pr >> 1) + (pr & 1);
        const int jf = (wn * 2 + (pr >> 1)) * 32 + (pr & 1) * 16 + (lane & 15);
        const float invf_rev = exp2f(-(float)jf * 0.10462765653f) * 0.15915494309189535f;
#pragma unroll
        for (int m = 0; m < 4; ++m)
#pragma unroll
          for (int j = 0; j < 4; ++j) {
            const int row = m * 16 + (lane >> 4) * 4 + j;
            const float tf = (float)(trow + row);
            const float ph = tf * invf_rev, pl = fmaf(tf, invf_rev, -ph);
            const float fr = (ph - floorf(ph)) + pl;
            const float sn = __builtin_amdgcn_sinf(fr), cs = __builtin_amdgcn_cosf(fr);
            const float x1 = acc[m][n1][j], x2 = acc[m][n1 + 2][j];
            reg[row * 136 + n1 * 16 + (lane & 15)] = f2bf((x1 * cs - x2 * sn) * sc);
            reg[row * 136 + n1 * 16 + 32 + (lane & 15)] = f2bf((x2 * cs + x1 * sn) * sc);
          }
      }
      EPI_FENCE();
      epi_store_bf16_128(reg, dst, 1024, trow, cq + wn * 128, lane);
    } else if (nt == 52) {
      float* DT = (float*)(p.ws + OFF_DT);
      if (wn == 0) {
#pragma unroll
        for (int n = 0; n < 2; ++n) {
          const int col = n * 16 + (lane & 15);
          const float bias = p.in[6][col];
#pragma unroll
          for (int m = 0; m < 4; ++m)
#pragma unroll
            for (int j = 0; j < 4; ++j) {
              const int t = trow + m * 16 + (lane >> 4) * 4 + j;
              if (t < L) {
                const float x = acc[m][n][j] + bias;
                const float e = __expf(x);
                DT[(size_t)t * 32 + col] = (x > 20.f) ? x : (e < 0.01f ? e * (1.f - 0.5f * e + e * e * (1.f / 3.f)) : __logf(1.f + e));
              }
            }
        }
      }
    } else {
      u16* dst; int ld, c0; bool sig = false;
      if (nt < 8) { dst = (u16*)(p.ws + OFF_Z); ld = 2048; c0 = n0; }
      else if (nt < 20) { dst = (u16*)(p.ws + OFF_XBC); ld = 3072; c0 = n0 - 2048; }
      else if (nt < 36) { dst = (u16*)(p.ws + OFF_V); ld = 2048; c0 = n0 - 7168; }
      else if (nt < 44) { dst = (u16*)(p.ws + OFF_G); ld = 2048; c0 = n0 - 9216; }
      else if (nt < 48) { dst = (u16*)(p.ws + OFF_GS); ld = 1024; c0 = n0 - 11264; sig = true; }
      else { dst = (u16*)(p.ws + OFF_GR); ld = 1024; c0 = n0 - 12288; sig = true; }
#pragma unroll
      for (int m = 0; m < 4; ++m)
#pragma unroll
        for (int n = 0; n < 8; ++n)
#pragma unroll
          for (int j = 0; j < 4; ++j) {
            float v = acc[m][n][j];
            if (sig) v = sigmoid_f(v);
            reg[(m * 16 + (lane >> 4) * 4 + j) * 136 + n * 16 + (lane & 15)] = f2bf(v);
          }
      EPI_FENCE();
      epi_store_bf16_128(reg, dst, ld, trow, c0 + wn * 128, lane);
    }
    __syncthreads();
  }
}

DEV void phase_merge8(const Params& p, char* smem, char* smem_team) {
  u16* GS = (u16*)(p.ws + OFF_GS);
  u16* GR = (u16*)(p.ws + OFF_GR);
  const u16* Zb = (const u16*)(p.ws + OFF_Z);
  const u16* Gb = (const u16*)(p.ws + OFF_G);
  const u16* WBS = (const u16*)(p.ws + OFF_S2);
  const u16* WBR = (const u16*)(p.ws + OFF_S2 + 4194304);
  for (int kk = 0;; ++kk) {
    const int it = tile_index(kk);
    if (it >= 256) break;
    const int branch = it >> 7, tl = it & 127, mt = tl >> 2, nt = tl & 3;
    f32x4 acc[4][8];
    ZERO_ACC(acc, 8)
    gemm_tile8<8>(acc, branch ? Gb : Zb, 2048, mt * 256, L - 1, branch ? WBR : WBS, 2048, nt * 256, 2048, smem);
    const int tid = get_tid8(), lane = tid & 63, w = tid >> 6, wm = w >> 1, wn = w & 1;
    float* reg = (float*)(smem + w * EPI_WAVE_BYTES);
    u16* GT = branch ? GR : GS;
#pragma unroll
    for (int hf = 0; hf < 2; ++hf) {
#pragma unroll
      for (int m = 0; m < 4; ++m)
#pragma unroll
        for (int n = 0; n < 4; ++n)
#pragma unroll
          for (int j = 0; j < 4; ++j) reg[(m * 16 + (lane >> 4) * 4 + j) * 68 + n * 16 + (lane & 15)] = acc[m][hf * 4 + n][j];
      EPI_FENCE();
#pragma unroll
      for (int j = 0; j < 16; ++j) {
        const int row = (lane >> 4) + 4 * j, c4 = (lane & 15) * 4;
        const f32x4 a = *(const f32x4*)(reg + row * 68 + c4);
        const size_t idx = (size_t)(mt * 256 + wm * 64 + row) * 1024 + nt * 256 + wn * 128 + hf * 64 + c4;
        const u32x2 g = *(const u32x2*)(GT + idx);
        u32x2 o; o[0] = pack2(lo_f(g[0]) * a[0], hi_f(g[0]) * a[1]); o[1] = pack2(lo_f(g[1]) * a[2], hi_f(g[1]) * a[3]);
        *(u32x2*)(GT + idx) = o;
      }
      EPI_FENCE();
    }
    __syncthreads();
  }
  for (int ct = get_rbid(); ct < 128; ct += gridDim.x) {
    const int tid = get_tid8(), lane = tid & 63, w = tid >> 6;
    const int branch = ct >> 6, c16 = ct & 63;
    f32x4* red = (f32x4*)smem;
    red[w * 64 + lane] = thin16((branch ? Gb : Zb) + w * 256, 2048, 8192, (branch ? WBR : WBS) + w * 256, 2048, c16 * 16, 256, lane);
    __syncthreads();
    if (w == 0) {
      u16* GT = branch ? GR : GS;
      f32x4 a1 = red[lane];
#pragma unroll
      for (int q = 1; q < 8; ++q) a1 += red[q * 64 + lane];
#pragma unroll
      for (int j = 0; j < 4; ++j) {
        const size_t idx = (size_t)(8192 + (lane >> 4) * 4 + j) * 1024 + c16 * 16 + (lane & 15);
        GT[idx] = f2bf(bf2f(GT[idx]) * a1[j]);
      }
    }
    __syncthreads();
  }
  {
    float* RSS = (float*)(p.ws + OFF_RSS);
    for (int i = get_bid() * 256 + get_tid(); i < L; i += nworkers() * 256) RSS[i] = 0.f;
  }
  const int n_wout = 16 * 16, n_wup = 16 * 88, n_wdown = 44 * 16;
  for (int it = get_bid(); it < n_wout + n_wup + n_wdown; it += nworkers()) {
    if (it < n_wout) { convert_tile(p.in[12], 1024, 1024, (u16*)(p.ws + OFF_WOUT), it & 15, it >> 4, 0, smem_team); }
    else if (it < n_wout + n_wup) { const int j = it - n_wout; convert_tile(p.in[14], 5632, 1024, (u16*)(p.ws + OFF_WUP), j & 15, j >> 4, 2, smem_team, p.in[13]);   }
    else { const int j = it - n_wout - n_wup; convert_tile(p.in[17], 1024, 2816, (u16*)(p.ws + OFF_WDOWN), j % 44, j / 44, 0, smem_team); }
  }
}

DEV void phase_outproj8(const Params& p, int b, char* smem) {
  const int tid = get_tid8(), lane = tid & 63, w = tid >> 6, wm = w >> 1, wn = w & 1, r = lane & 31, h = lane >> 5;
  u16* U2 = (u16*)(p.ws + OFF_U2);
  float* RSS = (float*)(p.ws + OFF_RSS);
  const u16* Mg = (const u16*)(p.ws + OFF_GS);
  const u16* WO = (const u16*)(p.ws + OFF_WOUT);
  float* reg = (float*)(smem + w * EPI_WAVE_BYTES);
  for (int kk = 0;; ++kk) {
    const int it = tile_index(kk);
    if (it >= 256) break;
    const int mt = it >> 3, nt = it & 7;
    f32x4 acc[4][4];
    ZERO_ACC(acc, 4)
    gemm_tile8<4, true>(acc, Mg, 1024, mt * 256, L - 1, WO, 1024, nt * 128, 1024, smem, (const u16*)(p.ws + OFF_GR));
#pragma unroll
    for (int m = 0; m < 4; ++m)
#pragma unroll
      for (int n = 0; n < 4; ++n)
#pragma unroll
        for (int j = 0; j < 4; ++j) reg[(m * 16 + (lane >> 4) * 4 + j) * 68 + n * 16 + (lane & 15)] = acc[m][n][j];
    EPI_FENCE();
#pragma unroll
    for (int j = 0; j < 16; ++j) {
      const int row = (lane >> 4) + 4 * j, c4 = (lane & 15) * 4;
      const f32x4 a = *(const f32x4*)(reg + row * 68 + c4);
      const int t = mt * 256 + wm * 64 + row, col = nt * 128 + wn * 64 + c4;
      f32x4 hv;
      if (t < NMETA) {
        hv = *(const f32x4*)(p.in[1] + t * 1024 + col) + a;
      } else {
        const size_t idx = ((size_t)b * SEQ + (t - NMETA)) * 1024 + col;
        hv = *(const f32x4*)(p.in[0] + idx) + a;
        *(f32x4*)(p.out + idx) = hv;
      }
      u32x2 hb; hb[0] = pack2(hv[0], hv[1]); hb[1] = pack2(hv[2], hv[3]);
      *(u32x2*)(U2 + (size_t)t * 1024 + col) = hb;
      float sq = hv[0] * hv[0] + hv[1] * hv[1] + hv[2] * hv[2] + hv[3] * hv[3];
      sq += __shfl_xor(sq, 1); sq += __shfl_xor(sq, 2); sq += __shfl_xor(sq, 4); sq += __shfl_xor(sq, 8);
      if ((lane & 15) == 0) atomicAdd(&RSS[t], sq);
    }
    __syncthreads();
  }
  for (int ct = get_rbid(); ct < 64; ct += gridDim.x) {
    const int tid = get_tid8(), lane = tid & 63, w = tid >> 6;
    f32x4* red = (f32x4*)smem;
    red[w * 64 + lane] = thin16(Mg + w * 128, 1024, 8192, WO + w * 128, 1024, ct * 16, 128, lane)
                       + thin16((const u16*)(p.ws + OFF_GR) + w * 128, 1024, 8192, WO + w * 128, 1024, ct * 16, 128, lane);
    __syncthreads();
    if (w == 0) {
      f32x4 a1 = red[lane];
#pragma unroll
      for (int q = 1; q < 8; ++q) a1 += red[q * 64 + lane];
#pragma unroll
      for (int j = 0; j < 4; ++j) {
        const int t = 8192 + (lane >> 4) * 4 + j;
        const size_t idx = ((size_t)b * SEQ + (t - NMETA)) * 1024 + ct * 16 + (lane & 15);
        const float hv = p.in[0][idx] + a1[j];
        p.out[idx] = hv;
        U2[(size_t)t * 1024 + ct * 16 + (lane & 15)] = f2bf(hv);
        float sq = hv * hv;
        sq += __shfl_xor(sq, 1); sq += __shfl_xor(sq, 2); sq += __shfl_xor(sq, 4); sq += __shfl_xor(sq, 8);
        if ((lane & 15) == 0) atomicAdd(&RSS[t], sq);
      }
    }
    __syncthreads();
  }
}

DEV void phase_up8(const Params& p, char* smem) {
  u16* ACT = (u16*)(p.ws + OFF_ACT);
  const float* cw = p.in[15];
  const float* cbias = p.in[16];
  for (int kk = 0;; ++kk) {
    const int it = tile_index(kk);
    if (it >= 33 * 22) break;
    int mt, nt; tile_decode(it, 33, 22, mt, nt);
    f32x4 acc[4][8];
    ZERO_ACC(acc, 8)
    gemm_tile8<8>(acc, (const u16*)(p.ws + OFF_U2), 1024, mt * 254 - 2, L - 1, (const u16*)(p.ws + OFF_WUP), 1024, nt * 256, 1024, smem);
    const int tid = get_tid8(), lane = tid & 63, w = tid >> 6;
    u16* reg = (u16*)(smem + w * EPI_WAVE_BYTES);
    {
      const float* RSS = (const float*)(p.ws + OFF_RSS);
      const int wm = w >> 1;
#pragma unroll
      for (int m = 0; m < 4; ++m)
#pragma unroll
        for (int j = 0; j < 4; ++j) {
          int t = mt * 254 - 2 + wm * 64 + m * 16 + (lane >> 4) * 4 + j; t = t < 0 ? 0 : (t > L - 1 ? L - 1 : t);
          const float rstd = rsqrtf(RSS[t] * (1.f / 1024.f) + EPS);
#pragma unroll
          for (int n = 0; n < 8; ++n) reg[(m * 16 + (lane >> 4) * 4 + j) * 136 + n * 16 + (lane & 15)] = f2bf(acc[m][n][j] * rstd);
        }
    }
    __syncthreads();
    {
      const int cg = tid & 15, rg = tid >> 4;
      const int ch = nt * 128 + cg * 8;
      float wg[3][8], wv[3][8], bg[8], bv[8], g2[8], g1[8], v2[8], v1[8];
#pragma unroll
      for (int k = 0; k < 3; ++k) {
        const f32x4 a0 = *(const f32x4*)(cw + k * 5632 + ch), a1 = *(const f32x4*)(cw + k * 5632 + ch + 4);
        const f32x4 c0 = *(const f32x4*)(cw + k * 5632 + 2816 + ch), c1 = *(const f32x4*)(cw + k * 5632 + 2816 + ch + 4);
#pragma unroll
        for (int j = 0; j < 4; ++j) { wg[k][j] = a0[j]; wg[k][4 + j] = a1[j]; wv[k][j] = c0[j]; wv[k][4 + j] = c1[j]; }
      }
      {
        const f32x4 a0 = *(const f32x4*)(cbias + ch), a1 = *(const f32x4*)(cbias + ch + 4);
        const f32x4 c0 = *(const f32x4*)(cbias + 2816 + ch), c1 = *(const f32x4*)(cbias + 2816 + ch + 4);
#pragma unroll
        for (int j = 0; j < 4; ++j) { bg[j] = a0[j]; bg[4 + j] = a1[j]; bv[j] = c0[j]; bv[4 + j] = c1[j]; }
      }
      const int R0 = rg * 8;
#pragma unroll
      for (int q = 0; q < 2; ++q) {
        const int R = R0 - 2 + q;
        u32x4 gvv = {0u, 0u, 0u, 0u}, vvv = {0u, 0u, 0u, 0u};
        if (R >= 0 && mt * 254 - 2 + R >= 0) {
          const char* sl = smem + ((R >> 6) * 2) * EPI_WAVE_BYTES + ((R & 63) * 136 + cg * 8) * 2;
          gvv = *(const u32x4*)sl; vvv = *(const u32x4*)(sl + EPI_WAVE_BYTES);
        }
#pragma unroll
        for (int j = 0; j < 4; ++j) {
          if (q == 0) { g2[2 * j] = lo_f(gvv[j]); g2[2 * j + 1] = hi_f(gvv[j]); v2[2 * j] = lo_f(vvv[j]); v2[2 * j + 1] = hi_f(vvv[j]); }
          else { g1[2 * j] = lo_f(gvv[j]); g1[2 * j + 1] = hi_f(gvv[j]); v1[2 * j] = lo_f(vvv[j]); v1[2 * j + 1] = hi_f(vvv[j]); }
        }
      }
#pragma unroll 2
      for (int i = 0; i < 8; ++i) {
        const int R = R0 + i, t = mt * 254 - 2 + R;
        u32x4 gvv = {0u, 0u, 0u, 0u}, vvv = {0u, 0u, 0u, 0u};
        if (t >= 0) {
          const char* sl = smem + ((R >> 6) * 2) * EPI_WAVE_BYTES + ((R & 63) * 136 + cg * 8) * 2;
          gvv = *(const u32x4*)sl; vvv = *(const u32x4*)(sl + EPI_WAVE_BYTES);
        }
        float o[8];
#pragma unroll
        for (int j = 0; j < 8; ++j) {
          const float gx = (j & 1) ? hi_f(gvv[j >> 1]) : lo_f(gvv[j >> 1]);
          const float vx = (j & 1) ? hi_f(vvv[j >> 1]) : lo_f(vvv[j >> 1]);
          const float ag = bg[j] + wg[0][j] * g2[j] + wg[1][j] * g1[j] + wg[2][j] * gx;
          const float av = bv[j] + wv[0][j] * v2[j] + wv[1][j] * v1[j] + wv[2][j] * vx;
          o[j] = silu_f(ag) * av;
          g2[j] = g1[j]; g1[j] = gx; v2[j] = v1[j]; v1[j] = vx;
        }
        if (R >= 2 && t < L) {
          u32x4 pk; pk[0] = pack2(o[0], o[1]); pk[1] = pack2(o[2], o[3]); pk[2] = pack2(o[4], o[5]); pk[3] = pack2(o[6], o[7]);
          *(u32x4*)(ACT + (size_t)t * 2816 + ch) = pk;
        }
      }
    }
    __syncthreads();
  }
}

DEV void phase_down8(const Params& p, int b, char* smem) {
  for (int kk = 0;; ++kk) {
    const int it = tile_index(kk);
    if (it >= 256) break;
    const int mt = it >> 3, nt = it & 7;
    f32x4 acc[4][4];
    ZERO_ACC(acc, 4)
    gemm_tile8<4>(acc, (const u16*)(p.ws + OFF_ACT), 2816, NMETA + mt * 256, L - 1, (const u16*)(p.ws + OFF_WDOWN), 2816, nt * 128, 2816, smem);
    const int tid = get_tid8(), lane = tid & 63, w = tid >> 6, wm = w >> 1, wn = w & 1, r = lane & 31, h = lane >> 5;
    float* reg = (float*)(smem + w * EPI_WAVE_BYTES);
#pragma unroll
    for (int m = 0; m < 4; ++m)
#pragma unroll
      for (int n = 0; n < 4; ++n)
#pragma unroll
        for (int j = 0; j < 4; ++j) reg[(m * 16 + (lane >> 4) * 4 + j) * 68 + n * 16 + (lane & 15)] = acc[m][n][j];
    EPI_FENCE();
#pragma unroll
    for (int j = 0; j < 16; ++j) {
      const int row = (lane >> 4) + 4 * j, c4 = (lane & 15) * 4;
      const f32x4 a = *(const f32x4*)(reg + row * 68 + c4);
      const size_t idx = ((size_t)b * SEQ + mt * 256 + wm * 64 + row) * 1024 + nt * 128 + wn * 64 + c4;
      const f32x4 x = *(const f32x4*)(p.out + idx);
      *(f32x4*)(p.out + idx) = x + a;
    }
    __syncthreads();
  }
}

#define XB_TMO      128
#define XB_XCNT(j)  (256  + 64 * (j))
#define XB_XSUB(j)  (1280 + 64 * (j))
#define XB_XGEN(j)  (2304 + 64 * (j))
#define XB_TOP      3328
#define XB_TOPGEN   3392
#define XCD_BAR_WORDS 3456
#define XB_SPIN_CAP (1u << 24)
DEV unsigned xb_ld(unsigned* p)              { return __hip_atomic_load(p, __ATOMIC_RELAXED, __HIP_MEMORY_SCOPE_AGENT); }
DEV unsigned xb_add(unsigned* p, unsigned v) { return __hip_atomic_fetch_add(p, v, __ATOMIC_RELAXED, __HIP_MEMORY_SCOPE_AGENT); }
DEV unsigned xb_xcc_id() { return (unsigned)__builtin_amdgcn_s_getreg((3 << 11) | 20) & 0xFu; }
#define XB_SPIN(cond, bar) do { unsigned _sp = 0; while (cond) { __builtin_amdgcn_s_sleep(1); \
    if ((++_sp & 255u) == 0u) { if (xb_ld(&(bar)[XB_TMO])) break; if (_sp > XB_SPIN_CAP) { atomicAdd(&(bar)[XB_TMO], 1u); break; } } } } while (0)
struct XcdBarrier { unsigned* bar; unsigned x; volatile LDSP unsigned* st; };
DEV XcdBarrier xcd_barrier_post(unsigned* bar, volatile LDSP unsigned* st) {
  XcdBarrier b; b.bar = bar; b.x = xb_xcc_id(); b.st = st;
  if (threadIdx.x == 0) (void)xb_add(&bar[XB_XCNT(b.x)], 1u);
  return b;
}
DEV void xcd_barrier_complete(unsigned* bar, unsigned x, unsigned& nloc, unsigned& nx) {
  const unsigned G = gridDim.x * gridDim.y * gridDim.z;
  unsigned sum, cnt, mine, sp = 0u;
  for (;;) {
    sum = 0u; cnt = 0u; mine = 0u;
#pragma unroll
    for (unsigned j = 0; j < 16; ++j) { const unsigned c = xb_ld(&bar[XB_XCNT(j)]); sum += c; cnt += (c > 0u) ? 1u : 0u; mine = (j == x) ? c : mine; }
    if (sum == G) break;
    __builtin_amdgcn_s_sleep(1);
    if ((++sp & 255u) == 0u) { if (xb_ld(&bar[XB_TMO])) break; if (sp > XB_SPIN_CAP) { atomicAdd(&bar[XB_TMO], 1u); break; } }
  }
  nloc = mine > 0u ? mine : 1u; nx = cnt > 0u ? cnt : 1u;
}
DEV void xcd_barrier(const XcdBarrier& b) {
  asm volatile("s_waitcnt vmcnt(0)" ::: "memory");
  __syncthreads();
  if (threadIdx.x == 0) {
    unsigned* bar = b.bar;
    __builtin_amdgcn_s_waitcnt(0);
    unsigned nloc = b.st[0], nx = b.st[1];
    if (nloc == 0u) { xcd_barrier_complete(bar, b.x, nloc, nx); b.st[0] = nloc; b.st[1] = nx; }
    const unsigned old = xb_add(&bar[XB_XSUB(b.x)], 1u);
    const unsigned gen = old / nloc;
    if (old + 1u == (gen + 1u) * nloc) {
      __builtin_amdgcn_fence(__ATOMIC_RELEASE, "agent");
      asm volatile("s_waitcnt vmcnt(0)" ::: "memory");
      const unsigned og = xb_add(&bar[XB_TOP], 1u);
      const unsigned tg = og / nx;
      if (og + 1u == (tg + 1u) * nx) xb_add(&bar[XB_TOPGEN], 1u);
      else XB_SPIN(xb_ld(&bar[XB_TOPGEN]) == tg, bar);
      __builtin_amdgcn_fence(__ATOMIC_ACQUIRE, "agent");
      xb_add(&bar[XB_XGEN(b.x)], 1u);
      asm volatile("s_waitcnt vmcnt(0)" ::: "memory");
    } else {
      XB_SPIN(xb_ld(&bar[XB_XGEN(b.x)]) == gen, bar);
      __builtin_amdgcn_fence(__ATOMIC_ACQUIRE, "agent");
      asm volatile("s_waitcnt vmcnt(0)" ::: "memory");
    }
  }
  __syncthreads();
}

constexpr int N_PHASES = 19;

__global__ void __launch_bounds__(512) fwd_kernel(Params p, int ph0, int ph1) {
  __shared__ __attribute__((aligned(16))) char smem[SMEM_BYTES];
  __shared__ uint4 xb_words;
  if (threadIdx.x == 0) xb_words = make_uint4(0u, 0u, 0u, 0u);
  __syncthreads();
  XcdBarrier xb = xcd_barrier_post((unsigned*)(p.ws + OFF_BAR), (volatile LDSP unsigned*)&xb_words);
  if (ph1 < 0) cg::this_grid().sync();
  for (int ph = ph0; ph < ph1; ++ph) {
    char* tsm = smem + (get_tid8() >> 8) * SMEM_TEAM;
    const int b = ph >= 10 ? 1 : 0;
    const int lp = (ph == 0) ? 0 : (ph == 18 ? 9 : (ph >= 10 ? ph - 9 : ph));
    switch (lp) {
      case 0: phase_prep(p, 0, true, tsm); break;
      case 1: phase_inproj8(p, b, smem); break;
      case 2: {
        int it = get_bid();
        for (; it < 1024; it += nworkers()) ret_kv_item(p, it, tsm);
        for (; it < 2048; it += nworkers()) ssd_state_item(p, it - 1024, tsm);
      } break;
      case 3: phase_scan(p); break;
      case 4: {
        {
          const int rb0 = get_rbid(), rb = (rb0 & 7) * 32 + (rb0 >> 3), team = get_tid8() >> 8;
          for (int j = 0; j < 3; ++j) {
            int kind = -1, idx = 0;
            if (rb < 4) {
              const int q = rb * 3 + j;
              const int rt = (q < 2) ? 128 : ((q >> 1) - 1) * 4;
              kind = 0; idx = rt * 4 + (q & 1) * 2 + team;
            } else if (rb < 10) {
              if (j < 2) { kind = 1; idx = (246 + (rb - 4) * 2 + j) * 2 + team; }
            } else if (j < 2) {
              const int k = rb - 10, ri = k >> 1;
              const int rt = (ri < 12) ? ((ri / 3) * 4 + 1 + ri % 3) : (17 + ri - 12);
              kind = j; idx = (j == 0) ? (rt * 4 + (k & 1) * 2 + team) : (k * 2 + team);
            }
            if (kind == 0) ret_out_item(p, idx, tsm);
            else if (kind == 1) ssd_out_item(p, idx, tsm);
          }
        }
      } break;
      case 5: phase_merge8(p, smem, tsm); break;
      case 6: phase_outproj8(p, b, smem); break;
      case 7: phase_up8(p, smem); break;
      case 8: phase_down8(p, b, smem); break;
      case 9: {
        if (ph == 9) { phase_final_norm(p, 0); phase_prep(p, 1, false, tsm); }
        else phase_final_norm(p, 1);
      } break;
    }
    if (ph + 1 < ph1) xcd_barrier(xb);
  }
}

#ifndef MK_SINGLE
#define MK_SINGLE 1
#endif

extern "C" void kernel_launch(void* const* d_in, const int* in_sizes, int n_in, void* d_out, int out_size, void* d_ws, size_t ws_size,
                              hipStream_t stream) {
  static int grid_blocks = 0;
  if (!grid_blocks) {
    int dev = 0, cus = 0, per_cu = 0;
    hipGetDevice(&dev);
    hipDeviceGetAttribute(&cus, hipDeviceAttributeMultiprocessorCount, dev);
    hipOccupancyMaxActiveBlocksPerMultiprocessor(&per_cu, fwd_kernel, 512, 0);
    per_cu = 1;
    if (cus != 256) fprintf(stderr, "kernel_launch: built for a 256-CU device (static phase schedules assume 256 workgroups), found %d CUs\n", cus);
    cus = 256;
    grid_blocks = cus * per_cu;
  }
  Params p{};
  for (int i = 0; i < 19; ++i) p.in[i] = (const float*)d_in[i];
  p.out = (float*)d_out;
  p.ws = (char*)d_ws;
#if MK_SINGLE
  (void)hipMemsetAsync((char*)d_ws + OFF_BAR, 0, XCD_BAR_WORDS * 4, stream);
  int ph0 = 0, ph1 = N_PHASES;
  void* args[] = {&p, &ph0, &ph1};
  hipError_t e = hipLaunchCooperativeKernel((void*)fwd_kernel, dim3(grid_blocks), dim3(512), args, 0, stream);
  if (e != hipSuccess) fprintf(stderr, "cooperative launch failed: %s (grid %d)\n", hipGetErrorString(e), grid_blocks);
#else
  for (int ph = 0; ph < N_PHASES; ++ph) {
    hipLaunchKernelGGL(fwd_kernel, dim3(grid_blocks), dim3(512), 0, stream, p, ph, ph + 1);
  }
#endif
}
```

```cpp
#include <hip/hip_runtime.h>
#include <hip/hip_cooperative_groups.h>
#include <cstdio>
namespace cg = cooperative_groups;

typedef unsigned short u16;
typedef __bf16 bf16x8 __attribute__((ext_vector_type(8)));
typedef short s16x4 __attribute__((ext_vector_type(4)));
typedef short s16x8 __attribute__((ext_vector_type(8)));
typedef float f32x16 __attribute__((ext_vector_type(16)));
typedef unsigned int u32x4 __attribute__((ext_vector_type(4)));
typedef unsigned int u32x2 __attribute__((ext_vector_type(2)));
typedef float f32x4 __attribute__((ext_vector_type(4)));

#define DEV __device__ __forceinline__
#define LDSP __attribute__((address_space(3)))

constexpr int D = 1024;
constexpr int L = 8208;
constexpr int SEQ = 8192;
constexpr int NMETA = 16;
constexpr int NPROJ = 13344;
constexpr int NPROJ_PAD = 13568;
constexpr int DFF = 2816;
constexpr float EPS = 1e-6f;

constexpr size_t OFF_Z = 0;
constexpr size_t OFF_G = 33619968;
constexpr size_t OFF_GS = 67239936;
constexpr size_t OFF_GR = 84049920;
constexpr size_t OFF_Q = 100859904;
constexpr size_t OFF_XBC = 117669888;
constexpr size_t OFF_K = 168099840;
constexpr size_t OFF_V = 184909824;
constexpr size_t OFF_DT = 218529792;
constexpr size_t OFF_S2 = 219580416;
constexpr size_t OFF_S1 = 227969024;
constexpr size_t OFF_CD = 261523456;
constexpr size_t OFF_HM = 261531648;
constexpr size_t OFF_BAR = 261597184;
constexpr size_t OFF_RSS = 261611520;
constexpr size_t OFF_WOUT = OFF_S1;
constexpr size_t OFF_WUP = OFF_S1 + 2097152;
constexpr size_t OFF_WDOWN = OFF_S1 + 13631488;
constexpr size_t OFF_UP = OFF_XBC;
constexpr size_t OFF_ACT = OFF_Z;
constexpr size_t OFF_U2 = OFF_Q;
constexpr size_t OUT_HALF = 33554432;

constexpr int SMEM_TEAM = 73728;
constexpr int SMEM_BYTES = 2 * SMEM_TEAM;

struct Params {
  const float* in[19];
  float* out;
  char* ws;
};

DEV int get_tid8() { int t = threadIdx.x; asm volatile("" : "+v"(t)); return t; }
DEV int get_tid() { int t = threadIdx.x & 255; asm volatile("" : "+v"(t)); return t; }
DEV int get_rbid() { int t = blockIdx.x; asm volatile("" : "+s"(t)); return t; }
DEV int get_bid() { int t = get_rbid() * 2 + (get_tid8() >> 8); return __builtin_amdgcn_readfirstlane(t); }
DEV int nworkers() { return (int)gridDim.x * 2; }
DEV float bf2f(u16 h) { return __uint_as_float(((unsigned)h) << 16); }
typedef __bf16 bf16x2_t __attribute__((ext_vector_type(2)));
typedef float f32x2_t __attribute__((ext_vector_type(2)));
DEV u16 f2bf(float f) { const __bf16 h = (__bf16)f; return __builtin_bit_cast(u16, h); }
DEV unsigned pack2(float a, float b) { const f32x2_t v = {a, b}; return __builtin_bit_cast(unsigned, __builtin_convertvector(v, bf16x2_t)); }
DEV float silu_f(float x) { return x / (1.f + __expf(-x)); }
DEV float sigmoid_f(float x) { return 1.f / (1.f + __expf(-x)); }
DEV float lo_f(unsigned u) { return __uint_as_float(u << 16); }
DEV float hi_f(unsigned u) { return __uint_as_float(u & 0xffff0000u); }
DEV float wave_sum(float v) {
#pragma unroll
  for (int o = 32; o > 0; o >>= 1) v += __shfl_xor(v, o);
  return v;
}
DEV float half_sum(float v) {
#pragma unroll
  for (int o = 16; o > 0; o >>= 1) v += __shfl_xor(v, o);
  return v;
}
DEV float log_gamma(int h) {
  return h == 0 ? -0.0317486983145803f : (h == 1 ? -0.015748356968139168f : (h == 2 ? -0.007843177461025893f : -0.003913899321136329f));
}
DEV f32x16 mfma(bf16x8 a, bf16x8 b, f32x16 c) { return __builtin_amdgcn_mfma_f32_32x32x16_bf16(a, b, c, 0, 0, 0); }
DEV f32x16 zero16() { f32x16 z;
#pragma unroll
  for (int i = 0; i < 16; ++i) z[i] = 0.f;
  return z; }
DEV int acc_row(int i, int h) { return (i & 3) + 8 * (i >> 2) + 4 * h; }

DEV bf16x8 frag_tr(const u16* T, int ld, int k0, int x0, int lane) {
  const int h = lane >> 5, blk = (lane >> 4) & 1, q = (lane & 15) >> 2, pp = lane & 3;
  const u16* a0 = T + (k0 + 8 * h + q) * ld + x0 + 16 * blk + 4 * pp;
  s16x4 lo = __builtin_amdgcn_ds_read_tr16_b64_v4i16((LDSP s16x4*)a0);
  s16x4 hi = __builtin_amdgcn_ds_read_tr16_b64_v4i16((LDSP s16x4*)(a0 + 4 * ld));
  s16x8 v = {lo[0], lo[1], lo[2], lo[3], hi[0], hi[1], hi[2], hi[3]};
  return __builtin_bit_cast(bf16x8, v);
}
DEV bf16x8 frag_row(const u16* T, int ld, int row, int k) {
  return *(const bf16x8*)(T + row * ld + k);
}

template <int MI>
DEV void gemm_tile(f32x16 (&acc)[MI][2], const u16* __restrict__ A, int lda, int arow0, int arow_max,
                   const u16* __restrict__ B, int ldb, int brow0, int K, char* smem) {
  constexpr int BM = MI * 64;
  constexpr int LD = 72;
  constexpr int ACH = BM * 8 / 256;
  u16* As = (u16*)smem;
  u16* Bs = As + BM * LD;
  const int tid = get_tid(), lane = tid & 63, w = tid >> 6, wm = w >> 1, wn = w & 1, r = lane & 31, h = lane >> 5;
  u32x4 ra[ACH], rb[4];
  const u16* ap[ACH];
  const u16* bp[4];
#pragma unroll
  for (int i = 0; i < ACH; ++i) {
    int c = tid + i * 256, row = c >> 3, kc = c & 7;
    int gr = arow0 + row; gr = gr > arow_max ? arow_max : gr;
    ap[i] = A + (size_t)gr * lda + kc * 8;
  }
#pragma unroll
  for (int i = 0; i < 4; ++i) {
    int c = tid + i * 256, row = c >> 3, kc = c & 7;
    bp[i] = B + (size_t)(brow0 + row) * ldb + kc * 8;
  }
#pragma unroll
  for (int i = 0; i < ACH; ++i) ra[i] = *(const u32x4*)(ap[i]);
#pragma unroll
  for (int i = 0; i < 4; ++i) rb[i] = *(const u32x4*)(bp[i]);
  const int nk = K >> 6;
  for (int kt = 0; kt < nk; ++kt) {
#pragma unroll
    for (int i = 0; i < ACH; ++i) { int c = tid + i * 256, row = c >> 3, kc = c & 7; *(u32x4*)(As + row * LD + kc * 8) = ra[i]; }
#pragma unroll
    for (int i = 0; i < 4; ++i) { int c = tid + i * 256, row = c >> 3, kc = c & 7; *(u32x4*)(Bs + row * LD + kc * 8) = rb[i]; }
    __syncthreads();
    if (kt + 1 < nk) {
#pragma unroll
      for (int i = 0; i < ACH; ++i) ra[i] = *(const u32x4*)(ap[i] + (kt + 1) * 64);
#pragma unroll
      for (int i = 0; i < 4; ++i) rb[i] = *(const u32x4*)(bp[i] + (kt + 1) * 64);
    }
#pragma unroll
    for (int ks = 0; ks < 4; ++ks) {
      bf16x8 a[MI], b[2];
#pragma unroll
      for (int mi = 0; mi < MI; ++mi) a[mi] = frag_row(As, LD, wm * MI * 32 + mi * 32 + r, ks * 16 + h * 8);
#pragma unroll
      for (int ni = 0; ni < 2; ++ni) b[ni] = frag_row(Bs, LD, wn * 64 + ni * 32 + r, ks * 16 + h * 8);
#pragma unroll
      for (int mi = 0; mi < MI; ++mi)
#pragma unroll
        for (int ni = 0; ni < 2; ++ni) acc[mi][ni] = mfma(a[mi], b[ni], acc[mi][ni]);
    }
    __syncthreads();
  }
}

DEV int orig_col(int n) {
  if (n < 5120) return n;
  if (n < 7168) {
    int q = n - 5120; int which = q >> 10; int c = q & 1023; int head = c >> 8; int ip = c & 255; int blk = ip >> 6; int wi = ip & 63;
    int j = (wi < 32) ? (blk * 32 + wi) : (128 + blk * 32 + wi - 32);
    return 5152 + which * 1024 + head * 256 + j;
  }
  if (n < 13312) return n + 32;
  if (n < 13344) return 5120 + (n - 13312);
  return -1;
}
DEV void convert_tile(const float* __restrict__ W, int Nsrc, int K, u16* __restrict__ WT, int kt, int ntile, int mode, char* smem, const float* __restrict__ kscale = nullptr) {
  float* t = (float*)smem;
  const int tid = get_tid();
  {
    const int tx = tid & 15, ty = tid >> 4;
    const int n = ntile * 64 + tx * 4;
    int on = n;
    if (mode == 1) on = orig_col(n);
    else if (mode == 2) { const int tl = n >> 8, wi = n & 255; on = (wi < 128) ? (tl * 128 + wi) : (2816 + tl * 128 + wi - 128); }
#pragma unroll
    for (int kk = ty; kk < 64; kk += 16) {
      f32x4 v = {0.f, 0.f, 0.f, 0.f};
      if (on >= 0) v = *(const f32x4*)(W + (size_t)(kt * 64 + kk) * Nsrc + on);
      if (kscale) v = v * kscale[kt * 64 + kk];
      *(f32x4*)(t + kk * 68 + tx * 4) = v;
    }
  }
  __syncthreads();
  {
    const int nn = tid >> 2, kq = (tid & 3) * 16;
    u32x4 o[2];
#pragma unroll
    for (int j = 0; j < 8; ++j) o[j >> 2][j & 3] = pack2(t[(kq + 2 * j) * 68 + nn], t[(kq + 2 * j + 1) * 68 + nn]);
    u16* d = WT + (size_t)(ntile * 64 + nn) * K + kt * 64 + kq;
    *(u32x4*)d = o[0]; *(u32x4*)(d + 8) = o[1];
  }
  __syncthreads();
}

DEV void rmsnorm_row_bf16(const float* __restrict__ src, const float* __restrict__ w, u16* __restrict__ dst, int lane) {
  f32x4 v[4]; float ss = 0.f;
#pragma unroll
  for (int j = 0; j < 4; ++j) { v[j] = *(const f32x4*)(src + j * 256 + lane * 4); ss += v[j][0] * v[j][0] + v[j][1] * v[j][1] + v[j][2] * v[j][2] + v[j][3] * v[j][3]; }
  ss = wave_sum(ss);
  const float rstd = rsqrtf(ss * (1.f / 1024.f) + EPS);
#pragma unroll
  for (int j = 0; j < 4; ++j) {
    f32x4 ww = *(const f32x4*)(w + j * 256 + lane * 4);
    u32x2 o; o[0] = pack2(v[j][0] * rstd * ww[0], v[j][1] * rstd * ww[1]); o[1] = pack2(v[j][2] * rstd * ww[2], v[j][3] * rstd * ww[3]);
    *(u32x2*)(dst + j * 256 + lane * 4) = o;
  }
}
DEV void rmsnorm_row_f32_inplace(float* __restrict__ row, const float* __restrict__ w, int lane) {
  f32x4 v[4]; float ss = 0.f;
#pragma unroll
  for (int j = 0; j < 4; ++j) { v[j] = *(const f32x4*)(row + j * 256 + lane * 4); ss += v[j][0] * v[j][0] + v[j][1] * v[j][1] + v[j][2] * v[j][2] + v[j][3] * v[j][3]; }
  ss = wave_sum(ss);
  const float rstd = rsqrtf(ss * (1.f / 1024.f) + EPS);
#pragma unroll
  for (int j = 0; j < 4; ++j) {
    f32x4 ww = *(const f32x4*)(w + j * 256 + lane * 4);
    f32x4 o; o[0] = v[j][0] * rstd * ww[0]; o[1] = v[j][1] * rstd * ww[1]; o[2] = v[j][2] * rstd * ww[2]; o[3] = v[j][3] * rstd * ww[3];
    *(f32x4*)(row + j * 256 + lane * 4) = o;
  }
}

template <int R, int C, bool SCALE>
DEV void stage_conv(u16* dst, int ld, const u16* __restrict__ xbc, int row0, int ch0, const float* __restrict__ cw, const float* __restrict__ cb, const float* rs) {
  constexpr int CG = C / 8, RG = 256 / CG, RPT = R / RG;
  const int tid = get_tid();
  const int cgi = tid % CG, rgi = tid / CG;
  const int ch = ch0 + cgi * 8, r0 = rgi * RPT;
  float w[4][8], bias[8], xw[3][8];
#pragma unroll
  for (int k = 0; k < 4; ++k) {
    f32x4 a = *(const f32x4*)(cw + k * 3072 + ch), b = *(const f32x4*)(cw + k * 3072 + ch + 4);
#pragma unroll
    for (int j = 0; j < 4; ++j) { w[k][j] = a[j]; w[k][4 + j] = b[j]; }
  }
  {
    f32x4 a = *(const f32x4*)(cb + ch), b = *(const f32x4*)(cb + ch + 4);
#pragma unroll
    for (int j = 0; j < 4; ++j) { bias[j] = a[j]; bias[4 + j] = b[j]; }
  }
#pragma unroll
  for (int k = 0; k < 3; ++k) {
    const int tr = row0 + r0 - 3 + k;
    u32x4 v = {0u, 0u, 0u, 0u};
    if (tr >= 0 && tr < L) v = *(const u32x4*)(xbc + (size_t)tr * 3072 + ch);
#pragma unroll
    for (int j = 0; j < 4; ++j) { xw[k][2 * j] = lo_f(v[j]); xw[k][2 * j + 1] = hi_f(v[j]); }
  }
#pragma unroll
  for (int i = 0; i < RPT; ++i) {
    const int tr = row0 + r0 + i;
    const bool valid = tr < L;
    u32x4 v = {0u, 0u, 0u, 0u};
    if (valid) v = *(const u32x4*)(xbc + (size_t)tr * 3072 + ch);
    float xc[8], o[8];
#pragma unroll
    for (int j = 0; j < 4; ++j) { xc[2 * j] = lo_f(v[j]); xc[2 * j + 1] = hi_f(v[j]); }
    float sc = 1.f;
    if (SCALE) sc = rs[(cgi >> 3) * 128 + r0 + i];
#pragma unroll
    for (int j = 0; j < 8; ++j) {
      float a = bias[j] + w[0][j] * xw[0][j] + w[1][j] * xw[1][j] + w[2][j] * xw[2][j] + w[3][j] * xc[j];
      a = silu_f(a) * sc;
      o[j] = valid ? a : 0.f;
      xw[0][j] = xw[1][j]; xw[1][j] = xw[2][j]; xw[2][j] = xc[j];
    }
    u32x4 pk; pk[0] = pack2(o[0], o[1]); pk[1] = pack2(o[2], o[3]); pk[2] = pack2(o[4], o[5]); pk[3] = pack2(o[6], o[7]);
    *(u32x4*)(dst + (r0 + i) * ld + cgi * 8) = pk;
  }
}

DEV float chunk_cumsum(const float* __restrict__ DT, int c, int H, float A, float* acs, float* dts, int lane) {
  const int s0 = 2 * lane;
  const int t0 = c * 128 + s0;
  const float d0 = (t0 < L) ? DT[(size_t)t0 * 32 + H] : 0.f;
  const float d1 = (t0 + 1 < L) ? DT[(size_t)(t0 + 1) * 32 + H] : 0.f;
  const float a0 = d0 * A, a1 = a0 + d1 * A;
  float tot = a1;
#pragma unroll
  for (int o = 1; o < 64; o <<= 1) { float n = __shfl_up(tot, o); if (lane >= o) tot += n; }
  const float excl = tot - a1;
  acs[s0] = excl + a0; acs[s0 + 1] = excl + a1;
  dts[s0] = d0; dts[s0 + 1] = d1;
  return __shfl(tot, 63);
}

DEV void phase_prep(const Params& p, int b, bool first, char* smem) {
  const int tid = get_tid(), lane = tid & 63, w = tid >> 6;
  u16* U = (u16*)((char*)p.out + OUT_HALF);
  const int n_norm = L / 4;
  const int n_win = 16 * (NPROJ_PAD / 64);
  const int n_wb = first ? 2 * 32 * 16 : 0;
  const int total = n_norm + n_win + n_wb;
  for (int it = get_bid(); it < total; it += nworkers()) {
    if (it < n_norm) {
      const int t = it * 4 + w;
      const float* src = (t < NMETA) ? (p.in[1] + (size_t)t * D) : (p.in[0] + ((size_t)b * SEQ + (t - NMETA)) * D);
      rmsnorm_row_bf16(src, p.in[2], U + (size_t)t * D, lane);
    } else if (it < n_norm + n_win) {
      const int j = it - n_norm; const int ntile = j >> 4, kt = j & 15;
      convert_tile(p.in[3], NPROJ, 1024, (u16*)(p.ws + OFF_S1), kt, ntile, 1, smem);
    } else {
      int j = it - n_norm - n_win; const int which = j >> 9; j &= 511; const int ntile = j >> 5, kt = j & 31;
      convert_tile(p.in[10 + which], 1024, 2048, (u16*)(p.ws + OFF_S2 + (size_t)which * 4194304), kt, ntile, 0, smem);
    }
  }
}

DEV void phase_inproj(const Params& p, int b, char* smem) {
  const int tid = get_tid(), lane = tid & 63, w = tid >> 6, wm = w >> 1, wn = w & 1, r = lane & 31, h = lane >> 5;
  const u16* U = (const u16*)((char*)p.out + OUT_HALF);
  const u16* WT = (const u16*)(p.ws + OFF_S1);
  const int MT = 65, NT = 105;
  for (int it = get_bid(); it < MT * NT; it += gridDim.x) {
    const int nt = it / MT, mt = it % MT;
    f32x16 acc[2][2];
#pragma unroll
    for (int mi = 0; mi < 2; ++mi)
#pragma unroll
      for (int ni = 0; ni < 2; ++ni) acc[mi][ni] = zero16();
    gemm_tile<2>(acc, U, 1024, mt * 128, L - 1, WT, 1024, nt * 128, 1024, smem);
    const int n0 = nt * 128;
    if (nt >= 40 && nt < 56) {
      const bool isk = nt >= 48;
      const int cq = n0 - (isk ? 6144 : 5120);
      const int blk = ((cq & 255) >> 6) + wn;
      const int jf = blk * 32 + r;
      const double invf_rev = exp(-(double)jf * 0.07252236513367073) * 0.15915494309189535;
      const float sc = isk ? 0.0625f : 1.f;
      u16* dst = (u16*)(p.ws + (isk ? OFF_K : OFF_Q));
#pragma unroll
      for (int mi = 0; mi < 2; ++mi)
#pragma unroll
        for (int i = 0; i < 16; ++i) {
          const int t = mt * 128 + wm * 64 + mi * 32 + acc_row(i, h);
          if (t < L) {
            double rev = (double)t * invf_rev;
            rev -= floor(rev);
            const float fr = (float)rev;
            const float sn = __builtin_amdgcn_sinf(fr), cs = __builtin_amdgcn_cosf(fr);
            const float x1 = acc[mi][0][i], x2 = acc[mi][1][i];
            const float o1 = (x1 * cs - x2 * sn) * sc, o2 = (x2 * cs + x1 * sn) * sc;
            u16* d = dst + (size_t)t * 1024 + cq + wn * 64 + r;
            d[0] = f2bf(o1); d[32] = f2bf(o2);
          }
        }
    } else if (nt == 104) {
      float* DT = (float*)(p.ws + OFF_DT);
      if (wn == 0) {
        const float bias = p.in[6][r];
#pragma unroll
        for (int mi = 0; mi < 2; ++mi)
#pragma unroll
          for (int i = 0; i < 16; ++i) {
            const int t = mt * 128 + wm * 64 + mi * 32 + acc_row(i, h);
            if (t < L) {
              const float x = acc[mi][0][i] + bias;
              const float e = __expf(x);
              DT[(size_t)t * 32 + r] = (x > 20.f) ? x : (e < 0.01f ? e * (1.f - 0.5f * e + e * e * (1.f / 3.f)) : __logf(1.f + e));
            }
          }
      }
    } else {
      u16* dst; int ld, c0; bool sig = false;
      if (nt < 16) { dst = (u16*)(p.ws + OFF_Z); ld = 2048; c0 = n0; }
      else if (nt < 40) { dst = (u16*)(p.ws + OFF_XBC); ld = 3072; c0 = n0 - 2048; }
      else if (nt < 72) { dst = (u16*)(p.ws + OFF_V); ld = 2048; c0 = n0 - 7168; }
      else if (nt < 88) { dst = (u16*)(p.ws + OFF_G); ld = 2048; c0 = n0 - 9216; }
      else if (nt < 96) { dst = (u16*)(p.ws + OFF_GS); ld = 1024; c0 = n0 - 11264; sig = true; }
      else { dst = (u16*)(p.ws + OFF_GR); ld = 1024; c0 = n0 - 12288; sig = true; }
#pragma unroll
      for (int mi = 0; mi < 2; ++mi)
#pragma unroll
        for (int ni = 0; ni < 2; ++ni)
#pragma unroll
          for (int i = 0; i < 16; ++i) {
            const int t = mt * 128 + wm * 64 + mi * 32 + acc_row(i, h);
            if (t < L) {
              float v = acc[mi][ni][i];
              if (sig) v = sigmoid_f(v);
              dst[(size_t)t * ld + c0 + wn * 64 + ni * 32 + r] = f2bf(v);
            }
          }
    }
  }
}

DEV void ssd_state_item(const Params& p, int it, char* smem) {
  const int tid = get_tid(), lane = tid & 63, w = tid >> 6, wm = w >> 1, wn = w & 1, r = lane & 31, h = lane >> 5;
  const int c = it >> 4, hp = it & 15, H0 = hp * 2, g = H0 >> 3;
  u16* Xw = (u16*)smem;
  u16* Bc = Xw + 128 * 136;
  float* wsc = (float*)(Bc + 128 * 136);
  float* tmp = wsc + 256;
  const float* DT = (const float*)(p.ws + OFF_DT);
  float* CD = (float*)(p.ws + OFF_CD);
  const u16* XBC = (const u16*)(p.ws + OFF_XBC);
  if (w < 2) {
    const int H = H0 + w;
    const float A = -expf(p.in[7][H]);
    float* acs = tmp + w * 128;
    float* dts = wsc + w * 128;
    const float aend = chunk_cumsum(DT, c, H, A, acs, dts, lane);
    const int s0 = 2 * lane;
    const float w0 = __expf(aend - acs[s0]) * dts[s0], w1 = __expf(aend - acs[s0 + 1]) * dts[s0 + 1];
    dts[s0] = w0; dts[s0 + 1] = w1;
    if (lane == 0) CD[c * 32 + H] = __expf(aend);
  }
  __syncthreads();
  stage_conv<128, 128, true>(Xw, 136, XBC, c * 128, H0 * 64, p.in[4], p.in[5], wsc);
  stage_conv<128, 128, false>(Bc, 136, XBC, c * 128, 2048 + g * 128, p.in[4], p.in[5], nullptr);
  __syncthreads();
  f32x16 acc[2][2];
#pragma unroll
  for (int mi = 0; mi < 2; ++mi)
#pragma unroll
    for (int ni = 0; ni < 2; ++ni) acc[mi][ni] = zero16();
#pragma unroll
  for (int ks = 0; ks < 8; ++ks) {
    bf16x8 a[2], bq[2];
#pragma unroll
    for (int mi = 0; mi < 2; ++mi) a[mi] = frag_tr(Xw, 136, ks * 16, wm * 64 + mi * 32, lane);
#pragma unroll
    for (int ni = 0; ni < 2; ++ni) bq[ni] = frag_tr(Bc, 136, ks * 16, wn * 64 + ni * 32, lane);
#pragma unroll
    for (int mi = 0; mi < 2; ++mi)
#pragma unroll
      for (int ni = 0; ni < 2; ++ni) acc[mi][ni] = mfma(a[mi], bq[ni], acc[mi][ni]);
  }
  u16* ST = (u16*)(p.ws + OFF_S1) + (size_t)(c * 32 + H0) * 8192;
  __syncthreads();
#pragma unroll
  for (int mi = 0; mi < 2; ++mi)
#pragma unroll
    for (int ni = 0; ni < 2; ++ni)
#pragma unroll
      for (int i = 0; i < 16; ++i) Xw[(wm * 64 + mi * 32 + acc_row(i, h)) * 136 + wn * 64 + ni * 32 + r] = f2bf(acc[mi][ni][i]);
  asm volatile("s_waitcnt lgkmcnt(0)" ::: "memory");
#pragma unroll
  for (int j = 0; j < 8; ++j) {
    const int m = wm * 64 + (lane >> 3) + 8 * j, n = wn * 64 + (lane & 7) * 8;
    *(u32x4*)(ST + m * 128 + n) = *(const u32x4*)(Xw + m * 136 + n);
  }
  __syncthreads();
}

DEV void ret_kv_item(const Params& p, int it, char* smem) {
  const int tid = get_tid(), lane = tid & 63, w = tid >> 6, wm = w >> 1, wn = w & 1, r = lane & 31, h = lane >> 5;
  const int sc = it >> 5, rem = it & 31, hd = rem >> 3, dt2 = (rem >> 2) & 1, et = rem & 3;
  u16* Vt = (u16*)smem;
  u16* Kt = Vt + 128 * 136;
  const u16* Vg = (const u16*)(p.ws + OFF_V);
  const u16* Kg = (const u16*)(p.ws + OFF_K);
  const float lg = log_gamma(hd);
  f32x16 acc[2][2];
#pragma unroll
  for (int mi = 0; mi < 2; ++mi)
#pragma unroll
    for (int ni = 0; ni < 2; ++ni) acc[mi][ni] = zero16();
  for (int half = 0; half < 2; ++half) {
#pragma unroll
    for (int i = 0; i < 8; ++i) {
      const int cidx = tid + i * 256, row = cidx >> 4, cc = cidx & 15;
      const int tok = sc * 256 + half * 128 + row;
      u32x4 v = *(const u32x4*)(Vg + (size_t)tok * 2048 + hd * 512 + et * 128 + cc * 8);
      *(u32x4*)(Vt + row * 136 + cc * 8) = v;
      u32x4 kk = *(const u32x4*)(Kg + (size_t)tok * 1024 + hd * 256 + dt2 * 128 + cc * 8);
      const float dec = __expf((float)(255 - (half * 128 + row)) * lg);
      u32x4 ko;
#pragma unroll
      for (int j = 0; j < 4; ++j) ko[j] = pack2(lo_f(kk[j]) * dec, hi_f(kk[j]) * dec);
      *(u32x4*)(Kt + row * 136 + cc * 8) = ko;
    }
    __syncthreads();
#pragma unroll
    for (int ks = 0; ks < 8; ++ks) {
      bf16x8 a[2], bq[2];
#pragma unroll
      for (int mi = 0; mi < 2; ++mi) a[mi] = frag_tr(Vt, 136, ks * 16, wm * 64 + mi * 32, lane);
#pragma unroll
      for (int ni = 0; ni < 2; ++ni) bq[ni] = frag_tr(Kt, 136, ks * 16, wn * 64 + ni * 32, lane);
#pragma unroll
      for (int mi = 0; mi < 2; ++mi)
#pragma unroll
        for (int ni = 0; ni < 2; ++ni) acc[mi][ni] = mfma(a[mi], bq[ni], acc[mi][ni]);
    }
    __syncthreads();
  }
  u16* RST = (u16*)((char*)p.out + OUT_HALF) + ((size_t)(sc * 4 + hd) * 512 + et * 128) * 256 + dt2 * 128;
#pragma unroll
  for (int mi = 0; mi < 2; ++mi)
#pragma unroll
    for (int ni = 0; ni < 2; ++ni)
#pragma unroll
      for (int i = 0; i < 16; ++i) Vt[(wm * 64 + mi * 32 + acc_row(i, h)) * 136 + wn * 64 + ni * 32 + r] = f2bf(acc[mi][ni][i]);
  asm volatile("s_waitcnt lgkmcnt(0)" ::: "memory");
#pragma unroll
  for (int j = 0; j < 8; ++j) {
    const int e = wm * 64 + (lane >> 3) + 8 * j, d = wn * 64 + (lane & 7) * 8;
    *(u32x4*)(RST + (size_t)e * 256 + d) = *(const u32x4*)(Vt + e * 136 + d);
  }
  __syncthreads();
}

DEV void phase_scan(const Params& p) {
  const int gt = get_bid() * 256 + get_tid(), nth = nworkers() * 256;
  const float* CD = (const float*)(p.ws + OFF_CD);
  for (int v = gt; v < 32768 + 65536; v += nth) {
    float st[8];
#pragma unroll
    for (int j = 0; j < 8; ++j) st[j] = 0.f;
    if (v < 32768) {
      const int e0 = v * 8, H = e0 >> 13;
      u16* base = (u16*)(p.ws + OFF_S1) + e0;
      for (int c0 = 0; c0 < 64; c0 += 8) {
        u32x4 x[8];
#pragma unroll
        for (int u = 0; u < 8; ++u) x[u] = *(const u32x4*)(base + (size_t)(c0 + u) * 262144);
#pragma unroll
        for (int u = 0; u < 8; ++u) {
          const float dcy = CD[(c0 + u) * 32 + H];
          u32x4 o;
#pragma unroll
          for (int j = 0; j < 4; ++j) {
            st[2 * j] = st[2 * j] * dcy + lo_f(x[u][j]);
            st[2 * j + 1] = st[2 * j + 1] * dcy + hi_f(x[u][j]);
            o[j] = pack2(st[2 * j], st[2 * j + 1]);
          }
          *(u32x4*)(base + (size_t)(c0 + u) * 262144) = o;
        }
      }
    } else {
      const int e0 = (v - 32768) * 8, hd = e0 >> 17;
      const float g256 = __expf(256.f * log_gamma(hd));
      u16* base = (u16*)((char*)p.out + OUT_HALF) + e0;
      for (int c0 = 0; c0 < 32; c0 += 8) {
        u32x4 x[8];
#pragma unroll
        for (int u = 0; u < 8; ++u) x[u] = *(const u32x4*)(base + (size_t)(c0 + u) * 524288);
#pragma unroll
        for (int u = 0; u < 8; ++u) {
          u32x4 o;
#pragma unroll
          for (int j = 0; j < 4; ++j) {
            st[2 * j] = st[2 * j] * g256 + lo_f(x[u][j]);
            st[2 * j + 1] = st[2 * j + 1] * g256 + hi_f(x[u][j]);
            o[j] = pack2(st[2 * j], st[2 * j + 1]);
          }
          *(u32x4*)(base + (size_t)(c0 + u) * 524288) = o;
        }
      }
    }
  }
}

DEV void ssd_out_item(const Params& p, int it, char* smem) {
  const int tid = get_tid(), lane = tid & 63, w = tid >> 6, wm = w >> 1, wn = w & 1, r = lane & 31, h = lane >> 5;
  const int c = it >> 3, rem = it & 7, g = rem & 3, lh = rem >> 2;
  if (c == 64 && lh == 1) return;
  u16* Ct = (u16*)smem;
  u16* Bt = Ct + 64 * 136;
  u16* Lt = Bt;
  u16* Xt = Bt + 128 * 136;
  float* acs = (float*)(Xt + 128 * 72);
  float* dts = acs + 128;
  float* rowsq = dts + 128;
  const u16* XBC = (const u16*)(p.ws + OFF_XBC);
  const float* DT = (const float*)(p.ws + OFF_DT);
  u16* Z = (u16*)(p.ws + OFF_Z);
  const int tok0 = c * 128;
  stage_conv<64, 128, false>(Ct, 136, XBC, tok0 + lh * 64, 2560 + g * 128, p.in[4], p.in[5], nullptr);
  stage_conv<128, 128, false>(Bt, 136, XBC, tok0, 2048 + g * 128, p.in[4], p.in[5], nullptr);
  if (tid < 64) rowsq[tid] = 0.f;
  __syncthreads();
  f32x16 cb[2];
  cb[0] = zero16(); cb[1] = zero16();
#pragma unroll
  for (int ks = 0; ks < 8; ++ks) {
    bf16x8 a = frag_row(Ct, 136, wm * 32 + r, ks * 16 + h * 8);
#pragma unroll
    for (int ni = 0; ni < 2; ++ni) {
      bf16x8 bq = frag_row(Bt, 136, wn * 64 + ni * 32 + r, ks * 16 + h * 8);
      cb[ni] = mfma(a, bq, cb[ni]);
    }
  }
  for (int hh = 0; hh < 8; ++hh) {
    const int H = g * 8 + hh;
    u32x4 zv[2];
    {
      int tz = tok0 + lh * 64 + (tid >> 2); tz = tz < L ? tz : L - 1;
      const u16* zp0 = Z + (size_t)tz * 2048 + H * 64 + (tid & 3) * 16;
      zv[0] = *(const u32x4*)zp0; zv[1] = *(const u32x4*)(zp0 + 8);
    }
    __syncthreads();
    if (w == 0) {
      const float A = -expf(p.in[7][H]);
      chunk_cumsum(DT, c, H, A, acs, dts, lane);
    }
    stage_conv<128, 64, false>(Xt, 72, XBC, tok0, H * 64, p.in[4], p.in[5], nullptr);
    __syncthreads();
#pragma unroll
    for (int ni = 0; ni < 2; ++ni)
#pragma unroll
      for (int i = 0; i < 16; ++i) {
        const int ll = wm * 32 + acc_row(i, h), l = lh * 64 + ll, s = wn * 64 + ni * 32 + r;
        float val = 0.f;
        if (s <= l) val = cb[ni][i] * __expf(acs[l] - acs[s]) * dts[s];
        Lt[ll * 136 + s] = f2bf(val);
      }
    f32x16 y = zero16();
    if (c > 0) {
      const u16* pv = (const u16*)(p.ws + OFF_S1) + ((size_t)((c - 1) * 32 + H) * 64 + wn * 32 + r) * 128 + h * 8;
#pragma unroll
      for (int ks = 0; ks < 8; ++ks) {
        bf16x8 a = frag_row(Ct, 136, wm * 32 + r, ks * 16 + h * 8);
        bf16x8 bq = *(const bf16x8*)(pv + ks * 16);
        y = mfma(a, bq, y);
      }
#pragma unroll
      for (int i = 0; i < 16; ++i) { const int l = lh * 64 + wm * 32 + acc_row(i, h); y[i] *= __expf(acs[l]); }
    }
    __syncthreads();
#pragma unroll
    for (int ks = 0; ks < 8; ++ks) {
      bf16x8 a = frag_row(Lt, 136, wm * 32 + r, ks * 16 + h * 8);
      bf16x8 bq = frag_tr(Xt, 72, ks * 16, wn * 32, lane);
      y = mfma(a, bq, y);
    }
    const float Dsk = p.in[8][H];
    float* Ys = (float*)(Bt + 64 * 136);
#pragma unroll
    for (int i = 0; i < 16; ++i) Ys[(wm * 32 + acc_row(i, h)) * 68 + wn * 32 + r] = y[i];
    __syncthreads();
    {
      const int row = tid >> 2, q = tid & 3, l = lh * 64 + row, t = tok0 + l;
      float sq = 0.f;
      if (t < L) {
        u16* zp = Z + (size_t)t * 2048 + H * 64 + q * 16;
        u32x4 xv[2], ov[2];
        xv[0] = *(const u32x4*)(Xt + l * 72 + q * 16); xv[1] = *(const u32x4*)(Xt + l * 72 + q * 16 + 8);
#pragma unroll
        for (int k = 0; k < 2; ++k) {
          const f32x4 ya = *(const f32x4*)(Ys + row * 68 + q * 16 + k * 8), yb = *(const f32x4*)(Ys + row * 68 + q * 16 + k * 8 + 4);
          float o[8];
#pragma unroll
          for (int j = 0; j < 4; ++j) {
            const float y0 = (j < 2) ? ya[2 * j] : yb[2 * j - 4], y1 = (j < 2) ? ya[2 * j + 1] : yb[2 * j - 3];
            o[2 * j] = (y0 + Dsk * lo_f(xv[k][j])) * silu_f(lo_f(zv[k][j]));
            o[2 * j + 1] = (y1 + Dsk * hi_f(xv[k][j])) * silu_f(hi_f(zv[k][j]));
            sq += o[2 * j] * o[2 * j] + o[2 * j + 1] * o[2 * j + 1];
            ov[k][j] = pack2(o[2 * j], o[2 * j + 1]);
          }
        }
        *(u32x4*)zp = ov[0]; *(u32x4*)(zp + 8) = ov[1];
      }
      sq += __shfl_xor(sq, 1); sq += __shfl_xor(sq, 2);
      if (q == 0) rowsq[row] += sq;
    }
  }
  __syncthreads();
  {
    const int row = tid >> 2, q = tid & 3, t = tok0 + lh * 64 + row;
    if (t < L) {
      const float rn = rsqrtf(rowsq[row] * (1.f / 512.f) + EPS);
      u32x4 v[16];
#pragma unroll
      for (int hh = 0; hh < 8; ++hh) {
        const u16* zp = Z + (size_t)t * 2048 + (g * 8 + hh) * 64 + q * 16;
        v[2 * hh] = *(const u32x4*)zp; v[2 * hh + 1] = *(const u32x4*)(zp + 8);
      }
#pragma unroll
      for (int hh = 0; hh < 8; ++hh) {
        u16* zp = Z + (size_t)t * 2048 + (g * 8 + hh) * 64 + q * 16;
        const float* nwp = p.in[9] + (g * 8 + hh) * 64 + q * 16;
#pragma unroll
        for (int k = 0; k < 2; ++k) {
          const f32x4 wa = *(const f32x4*)(nwp + k * 8), wb = *(const f32x4*)(nwp + k * 8 + 4);
          u32x4 o;
          o[0] = pack2(lo_f(v[2 * hh + k][0]) * rn * wa[0], hi_f(v[2 * hh + k][0]) * rn * wa[1]);
          o[1] = pack2(lo_f(v[2 * hh + k][1]) * rn * wa[2], hi_f(v[2 * hh + k][1]) * rn * wa[3]);
          o[2] = pack2(lo_f(v[2 * hh + k][2]) * rn * wb[0], hi_f(v[2 * hh + k][2]) * rn * wb[1]);
          o[3] = pack2(lo_f(v[2 * hh + k][3]) * rn * wb[2], hi_f(v[2 * hh + k][3]) * rn * wb[3]);
          *(u32x4*)(zp + k * 8) = o;
        }
      }
    }
  }
  __syncthreads();
}

DEV void ret_out_item(const Params& p, int it, char* smem) {
  const int tid = get_tid(), lane = tid & 63, w = tid >> 6, wm = w >> 1, wn = w & 1, r = lane & 31, h = lane >> 5;
  const int rt = it >> 2, hd = it & 3;
  const int t0 = rt * 64, sc = rt >> 2, qtr = rt & 3;
  u16* P = (u16*)smem;
  char* gsm = smem + 33792;
  u16* Vt = (u16*)gsm;
  float* rowsq = (float*)(smem + 33792 + 27648);
  const u16* Qg = (const u16*)(p.ws + OFF_Q) + hd * 256;
  const u16* Kg = (const u16*)(p.ws + OFF_K) + hd * 256;
  const u16* Vg = (const u16*)(p.ws + OFF_V);
  u16* Gg = (u16*)(p.ws + OFF_G);
  const u16* RST = (const u16*)((char*)p.out + OUT_HALF);
  const float lg = log_gamma(hd);
  if (tid < 64) rowsq[tid] = 0.f;
  const int nkb = (qtr >= 2) ? 2 : 1;
  for (int kb = 0; kb < nkb; ++kb) {
    f32x16 acc[1][2];
    acc[0][0] = zero16(); acc[0][1] = zero16();
    gemm_tile<1>(acc, Qg, 1024, t0, L - 1, Kg, 1024, sc * 256 + kb * 128, 256, gsm);
#pragma unroll
    for (int ni = 0; ni < 2; ++ni)
#pragma unroll
      for (int i = 0; i < 16; ++i) {
        const int ll = wm * 32 + acc_row(i, h), lp = qtr * 64 + ll, s = kb * 128 + wn * 64 + ni * 32 + r;
        float val = 0.f;
        if (s <= lp) val = acc[0][ni][i] * __expf((float)(lp - s) * lg);
        P[ll * 264 + s] = f2bf(val);
      }
  }
  float rs[16];
#pragma unroll
  for (int i = 0; i < 16; ++i) rs[i] = 0.f;
  for (int et = 0; et < 4; ++et) {
    f32x16 acc[1][2];
    acc[0][0] = zero16(); acc[0][1] = zero16();
    u32x4 gv[4], vreg[4];
    {
      int tg = t0 + (tid >> 2); tg = tg < L ? tg : L - 1;
      const u16* gp0 = Gg + (size_t)tg * 2048 + hd * 512 + et * 128 + (tid & 3) * 32;
#pragma unroll
      for (int k = 0; k < 4; ++k) gv[k] = *(const u32x4*)(gp0 + k * 8);
#pragma unroll
      for (int i = 0; i < 4; ++i) {
        const int cidx = tid + i * 256, row = cidx >> 4, cc = cidx & 15;
        int tok = sc * 256 + row; tok = tok < L ? tok : L - 1;
        vreg[i] = *(const u32x4*)(Vg + (size_t)tok * 2048 + hd * 512 + et * 128 + cc * 8);
      }
    }
    if (sc > 0) {
      gemm_tile<1>(acc, Qg, 1024, t0, L - 1, RST + ((size_t)((sc - 1) * 4 + hd) * 512 + et * 128) * 256, 256, 0, 256, gsm);
#pragma unroll
      for (int ni = 0; ni < 2; ++ni)
#pragma unroll
        for (int i = 0; i < 16; ++i) {
          const int lp = qtr * 64 + wm * 32 + acc_row(i, h);
          acc[0][ni][i] *= __expf((float)(lp + 1) * lg);
        }
    }
    for (int kb64 = 0; kb64 <= qtr; ++kb64) {
#pragma unroll
      for (int i = 0; i < 4; ++i) {
        const int cidx = tid + i * 256, row = cidx >> 4, cc = cidx & 15;
        const int tok = sc * 256 + kb64 * 64 + row;
        u32x4 v = {0u, 0u, 0u, 0u};
        if (tok < L) v = vreg[i];
        *(u32x4*)(Vt + row * 136 + cc * 8) = v;
      }
      __syncthreads();
      if (kb64 < qtr) {
#pragma unroll
        for (int i = 0; i < 4; ++i) {
          const int cidx = tid + i * 256, row = cidx >> 4, cc = cidx & 15;
          int tok = sc * 256 + (kb64 + 1) * 64 + row; tok = tok < L ? tok : L - 1;
          vreg[i] = *(const u32x4*)(Vg + (size_t)tok * 2048 + hd * 512 + et * 128 + cc * 8);
        }
      }
#pragma unroll
      for (int ks = 0; ks < 4; ++ks) {
        bf16x8 a = frag_row(P, 264, wm * 32 + r, kb64 * 64 + ks * 16 + h * 8);
#pragma unroll
        for (int ni = 0; ni < 2; ++ni) {
          bf16x8 bq = frag_tr(Vt, 136, ks * 16, wn * 64 + ni * 32, lane);
          acc[0][ni] = mfma(a, bq, acc[0][ni]);
        }
      }
      __syncthreads();
    }
    u16* Os = (u16*)gsm;
#pragma unroll
    for (int ni = 0; ni < 2; ++ni)
#pragma unroll
      for (int i = 0; i < 16; ++i) {
        const float o = acc[0][ni][i];
        if (t0 + wm * 32 + acc_row(i, h) < L) rs[i] += o * o;
        Os[(wm * 32 + acc_row(i, h)) * 136 + wn * 64 + ni * 32 + r] = f2bf(o);
      }
    __syncthreads();
    {
      const int row = tid >> 2, q = tid & 3, t = t0 + row;
      if (t < L) {
        u16* gp = Gg + (size_t)t * 2048 + hd * 512 + et * 128 + q * 32;
        u32x4 ov[4];
#pragma unroll
        for (int k = 0; k < 4; ++k) ov[k] = *(const u32x4*)(Os + row * 136 + q * 32 + k * 8);
#pragma unroll
        for (int k = 0; k < 4; ++k) {
          u32x4 o;
#pragma unroll
          for (int j = 0; j < 4; ++j) o[j] = pack2(silu_f(lo_f(gv[k][j])) * lo_f(ov[k][j]), silu_f(hi_f(gv[k][j])) * hi_f(ov[k][j]));
          *(u32x4*)(gp + k * 8) = o;
        }
      }
    }
    __syncthreads();
  }
#pragma unroll
  for (int i = 0; i < 16; ++i) {
    const float v = half_sum(rs[i]);
    if (r == 0) atomicAdd(&rowsq[wm * 32 + acc_row(i, h)], v);
  }
  __syncthreads();
  {
    const int row = tid >> 2, q = tid & 3, t = t0 + row;
    if (t < L) {
      const float rn = rsqrtf(rowsq[row] * (1.f / 512.f) + EPS);
      u32x4 v[16];
#pragma unroll
      for (int et = 0; et < 4; ++et)
#pragma unroll
        for (int k = 0; k < 4; ++k) v[et * 4 + k] = *(const u32x4*)(Gg + (size_t)t * 2048 + hd * 512 + et * 128 + q * 32 + k * 8);
#pragma unroll
      for (int et = 0; et < 4; ++et)
#pragma unroll
        for (int k = 0; k < 4; ++k) {
          u32x4 o;
#pragma unroll
          for (int j = 0; j < 4; ++j) o[j] = pack2(lo_f(v[et * 4 + k][j]) * rn, hi_f(v[et * 4 + k][j]) * rn);
          *(u32x4*)(Gg + (size_t)t * 2048 + hd * 512 + et * 128 + q * 32 + k * 8) = o;
        }
    }
  }
  __syncthreads();
}

DEV void merge_tile(const Params& p, int it, char* smem) {
  const int tid = get_tid(), lane = tid & 63, w = tid >> 6, wm = w >> 1, wn = w & 1, r = lane & 31, h = lane >> 5;
  const int nt = it / 65, mt = it % 65;
  u16* GS = (u16*)(p.ws + OFF_GS);
  const u16* GR = (const u16*)(p.ws + OFF_GR);
  f32x16 acc[2][2];
#pragma unroll
  for (int mi = 0; mi < 2; ++mi)
#pragma unroll
    for (int ni = 0; ni < 2; ++ni) acc[mi][ni] = zero16();
  gemm_tile<2>(acc, (const u16*)(p.ws + OFF_Z), 2048, mt * 128, L - 1, (const u16*)(p.ws + OFF_S2), 2048, nt * 128, 2048, smem);
#pragma unroll
  for (int mi = 0; mi < 2; ++mi)
#pragma unroll
    for (int ni = 0; ni < 2; ++ni)
#pragma unroll
      for (int i = 0; i < 16; ++i) {
        const int t = mt * 128 + wm * 64 + mi * 32 + acc_row(i, h);
        if (t < L) {
          const size_t idx = (size_t)t * 1024 + nt * 128 + wn * 64 + ni * 32 + r;
          GS[idx] = f2bf(bf2f(GS[idx]) * acc[mi][ni][i]);
        }
        acc[mi][ni][i] = 0.f;
      }
  gemm_tile<2>(acc, (const u16*)(p.ws + OFF_G), 2048, mt * 128, L - 1, (const u16*)(p.ws + OFF_S2 + 4194304), 2048, nt * 128, 2048, smem);
#pragma unroll
  for (int mi = 0; mi < 2; ++mi)
#pragma unroll
    for (int ni = 0; ni < 2; ++ni)
#pragma unroll
      for (int i = 0; i < 16; ++i) {
        const int t = mt * 128 + wm * 64 + mi * 32 + acc_row(i, h);
        if (t < L) {
          const size_t idx = (size_t)t * 1024 + nt * 128 + wn * 64 + ni * 32 + r;
          GS[idx] = f2bf(bf2f(GS[idx]) + bf2f(GR[idx]) * acc[mi][ni][i]);
        }
      }
}

DEV void phase_merge(const Params& p, char* smem) {
  const int n_tiles = 65 * 8;
  const int n_wout = 16 * 16, n_wup = 16 * 88, n_wdown = 44 * 16;
  const int total = n_tiles + n_wout + n_wup + n_wdown;
  for (int it = get_bid(); it < total; it += nworkers()) {
    if (it < n_tiles) merge_tile(p, it, smem);
    else if (it < n_tiles + n_wout) { const int j = it - n_tiles; convert_tile(p.in[12], 1024, 1024, (u16*)(p.ws + OFF_WOUT), j & 15, j >> 4, 0, smem); }
    else if (it < n_tiles + n_wout + n_wup) { const int j = it - n_tiles - n_wout; convert_tile(p.in[14], 5632, 1024, (u16*)(p.ws + OFF_WUP), j & 15, j >> 4, 0, smem); }
    else { const int j = it - n_tiles - n_wout - n_wup; convert_tile(p.in[17], 1024, 2816, (u16*)(p.ws + OFF_WDOWN), j % 44, j / 44, 0, smem); }
  }
}

DEV void phase_outproj(const Params& p, int b, char* smem) {
  const int tid = get_tid(), lane = tid & 63, w = tid >> 6, wm = w >> 1, wn = w & 1, r = lane & 31, h = lane >> 5;
  float* HM = (float*)(p.ws + OFF_HM);
  for (int it = get_bid(); it < 65 * 8; it += gridDim.x) {
    const int nt = it / 65, mt = it % 65;
    f32x16 acc[2][2];
#pragma unroll
    for (int mi = 0; mi < 2; ++mi)
#pragma unroll
      for (int ni = 0; ni < 2; ++ni) acc[mi][ni] = zero16();
    gemm_tile<2>(acc, (const u16*)(p.ws + OFF_GS), 1024, mt * 128, L - 1, (const u16*)(p.ws + OFF_WOUT), 1024, nt * 128, 1024, smem);
#pragma unroll
    for (int mi = 0; mi < 2; ++mi)
#pragma unroll
      for (int ni = 0; ni < 2; ++ni)
#pragma unroll
        for (int i = 0; i < 16; ++i) {
          const int t = mt * 128 + wm * 64 + mi * 32 + acc_row(i, h);
          const int col = nt * 128 + wn * 64 + ni * 32 + r;
          if (t < NMETA) HM[t * 1024 + col] = p.in[1][t * 1024 + col] + acc[mi][ni][i];
          else if (t < L) {
            const size_t idx = ((size_t)b * SEQ + (t - NMETA)) * 1024 + col;
            p.out[idx] = p.in[0][idx] + acc[mi][ni][i];
          }
        }
  }
}

DEV void phase_norm2(const Params& p, int b) {
  const int lane = get_tid() & 63, w = get_tid() >> 6;
  u16* U2 = (u16*)(p.ws + OFF_U2);
  for (int it = get_bid(); it < L / 4; it += nworkers()) {
    const int t = it * 4 + w;
    const float* src = (t < NMETA) ? ((const float*)(p.ws + OFF_HM) + (size_t)t * D) : (p.out + ((size_t)b * SEQ + (t - NMETA)) * D);
    rmsnorm_row_bf16(src, p.in[13], U2 + (size_t)t * D, lane);
  }
}

DEV void phase_up(const Params& p, char* smem) {
  const int tid = get_tid(), lane = tid & 63, w = tid >> 6, wm = w >> 1, wn = w & 1, r = lane & 31, h = lane >> 5;
  u16* UP = (u16*)(p.ws + OFF_UP);
  for (int it = get_bid(); it < 65 * 44; it += gridDim.x) {
    const int nt = it / 65, mt = it % 65;
    f32x16 acc[2][2];
#pragma unroll
    for (int mi = 0; mi < 2; ++mi)
#pragma unroll
      for (int ni = 0; ni < 2; ++ni) acc[mi][ni] = zero16();
    gemm_tile<2>(acc, (const u16*)(p.ws + OFF_U2), 1024, mt * 128, L - 1, (const u16*)(p.ws + OFF_WUP), 1024, nt * 128, 1024, smem);
#pragma unroll
    for (int mi = 0; mi < 2; ++mi)
#pragma unroll
      for (int ni = 0; ni < 2; ++ni)
#pragma unroll
        for (int i = 0; i < 16; ++i) {
          const int t = mt * 128 + wm * 64 + mi * 32 + acc_row(i, h);
          if (t < L) UP[(size_t)t * 5632 + nt * 128 + wn * 64 + ni * 32 + r] = f2bf(acc[mi][ni][i]);
        }
  }
}

DEV void phase_ffn_act(const Params& p) {
  const int gt = get_bid() * 256 + get_tid(), nth = nworkers() * 256;
  const u16* UP = (const u16*)(p.ws + OFF_UP);
  u16* ACT = (u16*)(p.ws + OFF_ACT);
  const float* cw = p.in[15];
  const float* cbias = p.in[16];
  for (int u = gt; u < 513 * 352; u += nth) {
    const int rb = u / 352, cgp = u % 352, ch = cgp * 8, t0 = rb * 16;
    float wg[3][8], wv[3][8], bg[8], bv[8], g2[8], g1[8], v2[8], v1[8];
#pragma unroll
    for (int k = 0; k < 3; ++k)
#pragma unroll
      for (int j = 0; j < 8; ++j) { wg[k][j] = cw[k * 5632 + ch + j]; wv[k][j] = cw[k * 5632 + 2816 + ch + j]; }
#pragma unroll
    for (int j = 0; j < 8; ++j) { bg[j] = cbias[ch + j]; bv[j] = cbias[2816 + ch + j]; }
    {
      u32x4 a = {0u, 0u, 0u, 0u}, bq = {0u, 0u, 0u, 0u}, c2 = {0u, 0u, 0u, 0u}, d2 = {0u, 0u, 0u, 0u};
      if (t0 >= 2) {
        a = *(const u32x4*)(UP + (size_t)(t0 - 2) * 5632 + ch); bq = *(const u32x4*)(UP + (size_t)(t0 - 1) * 5632 + ch);
        c2 = *(const u32x4*)(UP + (size_t)(t0 - 2) * 5632 + 2816 + ch); d2 = *(const u32x4*)(UP + (size_t)(t0 - 1) * 5632 + 2816 + ch);
      }
#pragma unroll
      for (int j = 0; j < 4; ++j) {
        g2[2 * j] = lo_f(a[j]); g2[2 * j + 1] = hi_f(a[j]); g1[2 * j] = lo_f(bq[j]); g1[2 * j + 1] = hi_f(bq[j]);
        v2[2 * j] = lo_f(c2[j]); v2[2 * j + 1] = hi_f(c2[j]); v1[2 * j] = lo_f(d2[j]); v1[2 * j + 1] = hi_f(d2[j]);
      }
    }
#pragma unroll 4
    for (int i = 0; i < 16; ++i) {
      const int t = t0 + i;
      const u32x4 a = *(const u32x4*)(UP + (size_t)t * 5632 + ch);
      const u32x4 c2 = *(const u32x4*)(UP + (size_t)t * 5632 + 2816 + ch);
      float o[8];
#pragma unroll
      for (int j = 0; j < 8; ++j) {
        const float gx = (j & 1) ? hi_f(a[j >> 1]) : lo_f(a[j >> 1]);
        const float vx = (j & 1) ? hi_f(c2[j >> 1]) : lo_f(c2[j >> 1]);
        const float ag = bg[j] + wg[0][j] * g2[j] + wg[1][j] * g1[j] + wg[2][j] * gx;
        const float av = bv[j] + wv[0][j] * v2[j] + wv[1][j] * v1[j] + wv[2][j] * vx;
        o[j] = silu_f(ag) * av;
        g2[j] = g1[j]; g1[j] = gx; v2[j] = v1[j]; v1[j] = vx;
      }
      u32x4 pk; pk[0] = pack2(o[0], o[1]); pk[1] = pack2(o[2], o[3]); pk[2] = pack2(o[4], o[5]); pk[3] = pack2(o[6], o[7]);
      *(u32x4*)(ACT + (size_t)t * 2816 + ch) = pk;
    }
  }
}

DEV void phase_down(const Params& p, int b, char* smem) {
  const int tid = get_tid(), lane = tid & 63, w = tid >> 6, wm = w >> 1, wn = w & 1, r = lane & 31, h = lane >> 5;
  for (int it = get_bid(); it < 64 * 8; it += gridDim.x) {
    const int nt = it / 64, mt = it % 64;
    f32x16 acc[2][2];
#pragma unroll
    for (int mi = 0; mi < 2; ++mi)
#pragma unroll
      for (int ni = 0; ni < 2; ++ni) acc[mi][ni] = zero16();
    gemm_tile<2>(acc, (const u16*)(p.ws + OFF_ACT), 2816, NMETA + mt * 128, L - 1, (const u16*)(p.ws + OFF_WDOWN), 2816, nt * 128, 2816, smem);
#pragma unroll
    for (int mi = 0; mi < 2; ++mi)
#pragma unroll
      for (int ni = 0; ni < 2; ++ni)
#pragma unroll
        for (int i = 0; i < 16; ++i) {
          const int rr = mt * 128 + wm * 64 + mi * 32 + acc_row(i, h);
          const size_t idx = ((size_t)b * SEQ + rr) * 1024 + nt * 128 + wn * 64 + ni * 32 + r;
          p.out[idx] += acc[mi][ni][i];
        }
  }
}

DEV void phase_final_norm(const Params& p, int b) {
  const int lane = get_tid() & 63, w = get_tid() >> 6;
  for (int it = get_bid(); it < SEQ / 4; it += nworkers()) {
    const int rr = it * 4 + w;
    rmsnorm_row_f32_inplace(p.out + ((size_t)b * SEQ + rr) * D, p.in[18], lane);
  }
}


DEV u32x4 add_bf16x8(u32x4 a, u32x4 b) {
  u32x4 o;
#pragma unroll
  for (int j = 0; j < 4; ++j) o[j] = pack2(lo_f(a[j]) + lo_f(b[j]), hi_f(a[j]) + hi_f(b[j]));
  return o;
}
template <int NJ, bool ADD2 = false>
DEV void gemm_tile8(f32x4 (&acc)[4][NJ], const u16* __restrict__ A, int lda, int arow0, int arow_max,
                    const u16* __restrict__ B, int ldb, int brow0, int K, char* smem, const u16* __restrict__ A2 = nullptr) {
  constexpr int BN = NJ * 32;
  constexpr int BCH = BN / 64;
  constexpr int STAGE = (256 + BN) * 64;
  u16* S = (u16*)smem;
  const int tid = get_tid8(), lane = tid & 63, w = tid >> 6, wm = w >> 1, wn = w & 1;
  u32x4 ra[4], rb[BCH], ra2[ADD2 ? 4 : 1];
  unsigned aoff[4], boff[BCH];
  const char* Ab = (const char*)A;
  const char* Ab2 = (const char*)A2;
  const char* Bb = (const char*)(B + (size_t)brow0 * ldb);
  const int crow = tid >> 3, kc = tid & 7;
  const unsigned sto = (unsigned)(crow * 64 + ((kc ^ ((crow >> 1) & 7)) * 8));
#pragma unroll
  for (int i = 0; i < 4; ++i) {
    int gr = arow0 + crow + i * 64; gr = gr > arow_max ? arow_max : gr; gr = gr < 0 ? 0 : gr;
    aoff[i] = ((unsigned)gr * (unsigned)lda + kc * 8) * 2u;
  }
#pragma unroll
  for (int i = 0; i < BCH; ++i) boff[i] = ((unsigned)(crow + i * 64) * (unsigned)ldb + kc * 8) * 2u;
  const int fr = lane & 15, swz = fr >> 1, cq = lane >> 4;
  const unsigned fa = (unsigned)((wm * 64 + fr) * 64), fb = (unsigned)((256 + wn * (NJ * 16) + fr) * 64);
  const unsigned c0 = (unsigned)(((cq) ^ swz) * 8), c1 = (unsigned)(((4 + cq) ^ swz) * 8);
  const int nk = K >> 6;
#pragma unroll
  for (int i = 0; i < 4; ++i) { ra[i] = *(const u32x4*)(Ab + aoff[i]); if (ADD2) ra2[i] = *(const u32x4*)(Ab2 + aoff[i]); }
#pragma unroll
  for (int i = 0; i < BCH; ++i) rb[i] = *(const u32x4*)(Bb + boff[i]);
#pragma unroll
  for (int i = 0; i < 4; ++i) *(u32x4*)(S + sto + i * 64 * 64) = ADD2 ? add_bf16x8(ra[i], ra2[i]) : ra[i];
#pragma unroll
  for (int i = 0; i < BCH; ++i) *(u32x4*)(S + sto + (256 + i * 64) * 64) = rb[i];
  if (nk > 1) {
#pragma unroll
    for (int i = 0; i < 4; ++i) { ra[i] = *(const u32x4*)(Ab + aoff[i] + 128); if (ADD2) ra2[i] = *(const u32x4*)(Ab2 + aoff[i] + 128); }
#pragma unroll
    for (int i = 0; i < BCH; ++i) rb[i] = *(const u32x4*)(Bb + boff[i] + 128);
  }
  __syncthreads();
  for (int kt = 0; kt < nk; ++kt) {
    const u16* Sc = S + (kt & 1) * STAGE;
    {
      bf16x8 a[4], b[NJ];
#pragma unroll
      for (int m = 0; m < 4; ++m) a[m] = *(const bf16x8*)(Sc + fa + m * 16 * 64 + c0);
#pragma unroll
      for (int n = 0; n < NJ; ++n) b[n] = *(const bf16x8*)(Sc + fb + n * 16 * 64 + c0);
      __builtin_amdgcn_s_setprio(1);
#pragma unroll
      for (int m = 0; m < 4; ++m)
#pragma unroll
        for (int n = 0; n < NJ; ++n) acc[m][n] = __builtin_amdgcn_mfma_f32_16x16x32_bf16(a[m], b[n], acc[m][n], 0, 0, 0);
      __builtin_amdgcn_s_setprio(0);
    }
    bf16x8 a1[4], b1[NJ];
#pragma unroll
    for (int m = 0; m < 4; ++m) a1[m] = *(const bf16x8*)(Sc + fa + m * 16 * 64 + c1);
#pragma unroll
    for (int n = 0; n < NJ; ++n) b1[n] = *(const bf16x8*)(Sc + fb + n * 16 * 64 + c1);
    if (kt + 1 < nk) {
      u16* Aw = S + ((kt + 1) & 1) * STAGE;
#pragma unroll
      for (int i = 0; i < 4; ++i) *(u32x4*)(Aw + sto + i * 64 * 64) = ADD2 ? add_bf16x8(ra[i], ra2[i]) : ra[i];
#pragma unroll
      for (int i = 0; i < BCH; ++i) *(u32x4*)(Aw + sto + (256 + i * 64) * 64) = rb[i];
      if (kt + 2 < nk) {
        const unsigned ko = (unsigned)(kt + 2) * 128u;
#pragma unroll
        for (int i = 0; i < 4; ++i) { ra[i] = *(const u32x4*)(Ab + aoff[i] + ko); if (ADD2) ra2[i] = *(const u32x4*)(Ab2 + aoff[i] + ko); }
#pragma unroll
        for (int i = 0; i < BCH; ++i) rb[i] = *(const u32x4*)(Bb + boff[i] + ko);
      }
    }
    {
      __builtin_amdgcn_s_setprio(1);
#pragma unroll
      for (int m = 0; m < 4; ++m)
#pragma unroll
        for (int n = 0; n < NJ; ++n) acc[m][n] = __builtin_amdgcn_mfma_f32_16x16x32_bf16(a1[m], b1[n], acc[m][n], 0, 0, 0);
      __builtin_amdgcn_s_setprio(0);
    }
    __syncthreads();
  }
}

DEV f32x4 thin16(const u16* __restrict__ A, int lda, int row0, const u16* __restrict__ BT, int ldb, int col0, int K, int lane) {
  const u16* ap = A + (size_t)(row0 + (lane & 15)) * lda + 8 * (lane >> 4);
  const u16* bp = BT + (size_t)(col0 + (lane & 15)) * ldb + 8 * (lane >> 4);
  f32x4 acc = {0.f, 0.f, 0.f, 0.f};
  for (int k0 = 0; k0 < K; k0 += 128) {
    bf16x8 a[4], b[4];
#pragma unroll
    for (int j = 0; j < 4; ++j) { a[j] = *(const bf16x8*)(ap + k0 + j * 32); b[j] = *(const bf16x8*)(bp + k0 + j * 32); }
#pragma unroll
    for (int j = 0; j < 4; ++j) acc = __builtin_amdgcn_mfma_f32_16x16x32_bf16(a[j], b[j], acc, 0, 0, 0);
  }
  return acc;
}

DEV int tile_index(int k) { const int G = gridDim.x, rb = get_rbid(); return k * G + (rb & 7) * (G >> 3) + (rb >> 3); }
DEV void tile_decode(int T, int MT, int NT, int& mt, int& nt) {
  const int per = MT * 8;
  const int nb = T / per, rem = T - nb * per;
  int width = NT - nb * 8; width = width > 8 ? 8 : width;
  mt = rem / width; nt = nb * 8 + (rem - mt * width);
}

#define ZERO_ACC(acc, NJ_) _Pragma("unroll") for (int m_ = 0; m_ < 4; ++m_) _Pragma("unroll") for (int n_ = 0; n_ < NJ_; ++n_) { acc[m_][n_][0] = 0.f; acc[m_][n_][1] = 0.f; acc[m_][n_][2] = 0.f; acc[m_][n_][3] = 0.f; }

constexpr int EPI_WAVE_BYTES = 17408;
#define EPI_FENCE() asm volatile("s_waitcnt lgkmcnt(0)" ::: "memory")
DEV void epi_store_bf16_128(const u16* reg, u16* __restrict__ dst, int ld, int trow, int col0, int lane) {
#pragma unroll
  for (int j = 0; j < 16; ++j) {
    const int row = (lane >> 4) + 4 * j, t = trow + row;
    const u32x4 v = *(const u32x4*)(reg + row * 136 + (lane & 15) * 8);
    if (t < L) *(u32x4*)(dst + (size_t)t * ld + col0 + (lane & 15) * 8) = v;
  }
}

DEV void phase_inproj8(const Params& p, int b, char* smem) {
  const u16* U = (const u16*)((char*)p.out + OUT_HALF);
  const u16* WT = (const u16*)(p.ws + OFF_S1);
  const int MT = 33, NT = 53;
  for (int kk = 0;; ++kk) {
    const int it = tile_index(kk);
    if (it >= MT * NT) break;
    int mt, nt; tile_decode(it, MT, NT, mt, nt);
    f32x4 acc[4][8];
    ZERO_ACC(acc, 8)
    gemm_tile8<8>(acc, U, 1024, mt * 256, L - 1, WT, 1024, nt * 256, 1024, smem);
    const int tid = get_tid8(), lane = tid & 63, w = tid >> 6, wm = w >> 1, wn = w & 1, r = lane & 31, h = lane >> 5;
    u16* reg = (u16*)(smem + w * EPI_WAVE_BYTES);
    const int n0 = nt * 256;
    const int trow = mt * 256 + wm * 64;
    if (nt >= 20 && nt < 28) {
      const bool isk = nt >= 24;
      const int cq = n0 - (isk ? 6144 : 5120);
      const float sc = isk ? 0.0625f : 1.f;
      u16* dst = (u16*)(p.ws + (isk ? OFF_K : OFF_Q));
#pragma unroll
      for (int pr = 0; pr < 4; ++pr) {
        const int n1 = 4 * (pr >> 1) + (pr & 1);
        const int jf = (wn * 2 + (pr >> 1)) * 32 + (pr & 1) * 16 + (lane & 15);
        const float invf_rev = exp2f(-(float)jf * 0.10462765653f) * 0.15915494309189535f;
#pragma unroll
        for (int m = 0; m < 4; ++m)
#pragma unroll
          for (int j = 0; j < 4; ++j) {
            const int row = m * 16 + (lane >> 4) * 4 + j;
            const float tf = (float)(trow + row);
            const float ph = tf * invf_rev, pl = fmaf(tf, invf_rev, -ph);
            const float fr = (ph - floorf(ph)) + pl;
            const float sn = __builtin_amdgcn_sinf(fr), cs = __builtin_amdgcn_cosf(fr);
            const float x1 = acc[m][n1][j], x2 = acc[m][n1 + 2][j];
            reg[row * 136 + n1 * 16 + (lane & 15)] = f2bf((x1 * cs - x2 * sn) * sc);
            reg[row * 136 + n1 * 16 + 32 + (lane & 15)] = f2bf((x2 * cs + x1 * sn) * sc);
          }
      }
      EPI_FENCE();
      epi_store_bf16_128(reg, dst, 1024, trow, cq + wn * 128, lane);
    } else if (nt == 52) {
      float* DT = (float*)(p.ws + OFF_DT);
      if (wn == 0) {
#pragma unroll
        for (int n = 0; n < 2; ++n) {
          const int col = n * 16 + (lane & 15);
          const float bias = p.in[6][col];
#pragma unroll
          for (int m = 0; m < 4; ++m)
#pragma unroll
            for (int j = 0; j < 4; ++j) {
              const int t = trow + m * 16 + (lane >> 4) * 4 + j;
              if (t < L) {
                const float x = acc[m][n][j] + bias;
                const float e = __expf(x);
                DT[(size_t)t * 32 + col] = (x > 20.f) ? x : (e < 0.01f ? e * (1.f - 0.5f * e + e * e * (1.f / 3.f)) : __logf(1.f + e));
              }
            }
        }
      }
    } else {
      u16* dst; int ld, c0; bool sig = false;
      if (nt < 8) { dst = (u16*)(p.ws + OFF_Z); ld = 2048; c0 = n0; }
      else if (nt < 20) { dst = (u16*)(p.ws + OFF_XBC); ld = 3072; c0 = n0 - 2048; }
      else if (nt < 36) { dst = (u16*)(p.ws + OFF_V); ld = 2048; c0 = n0 - 7168; }
      else if (nt < 44) { dst = (u16*)(p.ws + OFF_G); ld = 2048; c0 = n0 - 9216; }
      else if (nt < 48) { dst = (u16*)(p.ws + OFF_GS); ld = 1024; c0 = n0 - 11264; sig = true; }
      else { dst = (u16*)(p.ws + OFF_GR); ld = 1024; c0 = n0 - 12288; sig = true; }
#pragma unroll
      for (int m = 0; m < 4; ++m)
#pragma unroll
        for (int n = 0; n < 8; ++n)
#pragma unroll
          for (int j = 0; j < 4; ++j) {
            float v = acc[m][n][j];
            if (sig) v = sigmoid_f(v);
            reg[(m * 16 + (lane >> 4) * 4 + j) * 136 + n * 16 + (lane & 15)] = f2bf(v);
          }
      EPI_FENCE();
      epi_store_bf16_128(reg, dst, ld, trow, c0 + wn * 128, lane);
    }
    __syncthreads();
  }
}

DEV void phase_merge8(const Params& p, char* smem, char* smem_team) {
  u16* GS = (u16*)(p.ws + OFF_GS);
  u16* GR = (u16*)(p.ws + OFF_GR);
  const u16* Zb = (const u16*)(p.ws + OFF_Z);
  const u16* Gb = (const u16*)(p.ws + OFF_G);
  const u16* WBS = (const u16*)(p.ws + OFF_S2);
  const u16* WBR = (const u16*)(p.ws + OFF_S2 + 4194304);
  for (int kk = 0;; ++kk) {
    const int it = tile_index(kk);
    if (it >= 256) break;
    const int branch = it >> 7, tl = it & 127, mt = tl >> 2, nt = tl & 3;
    f32x4 acc[4][8];
    ZERO_ACC(acc, 8)
    gemm_tile8<8>(acc, branch ? Gb : Zb, 2048, mt * 256, L - 1, branch ? WBR : WBS, 2048, nt * 256, 2048, smem);
    const int tid = get_tid8(), lane = tid & 63, w = tid >> 6, wm = w >> 1, wn = w & 1;
    float* reg = (float*)(smem + w * EPI_WAVE_BYTES);
    u16* GT = branch ? GR : GS;
#pragma unroll
    for (int hf = 0; hf < 2; ++hf) {
#pragma unroll
      for (int m = 0; m < 4; ++m)
#pragma unroll
        for (int n = 0; n < 4; ++n)
#pragma unroll
          for (int j = 0; j < 4; ++j) reg[(m * 16 + (lane >> 4) * 4 + j) * 68 + n * 16 + (lane & 15)] = acc[m][hf * 4 + n][j];
      EPI_FENCE();
#pragma unroll
      for (int j = 0; j < 16; ++j) {
        const int row = (lane >> 4) + 4 * j, c4 = (lane & 15) * 4;
        const f32x4 a = *(const f32x4*)(reg + row * 68 + c4);
        const size_t idx = (size_t)(mt * 256 + wm * 64 + row) * 1024 + nt * 256 + wn * 128 + hf * 64 + c4;
        const u32x2 g = *(const u32x2*)(GT + idx);
        u32x2 o; o[0] = pack2(lo_f(g[0]) * a[0], hi_f(g[0]) * a[1]); o[1] = pack2(lo_f(g[1]) * a[2], hi_f(g[1]) * a[3]);
        *(u32x2*)(GT + idx) = o;
      }
      EPI_FENCE();
    }
    __syncthreads();
  }
  for (int ct = get_rbid(); ct < 128; ct += gridDim.x) {
    const int tid = get_tid8(), lane = tid & 63, w = tid >> 6;
    const int branch = ct >> 6, c16 = ct & 63;
    f32x4* red = (f32x4*)smem;
    red[w * 64 + lane] = thin16((branch ? Gb : Zb) + w * 256, 2048, 8192, (branch ? WBR : WBS) + w * 256, 2048, c16 * 16, 256, lane);
    __syncthreads();
    if (w == 0) {
      u16* GT = branch ? GR : GS;
      f32x4 a1 = red[lane];
#pragma unroll
      for (int q = 1; q < 8; ++q) a1 += red[q * 64 + lane];
#pragma unroll
      for (int j = 0; j < 4; ++j) {
        const size_t idx = (size_t)(8192 + (lane >> 4) * 4 + j) * 1024 + c16 * 16 + (lane & 15);
        GT[idx] = f2bf(bf2f(GT[idx]) * a1[j]);
      }
    }
    __syncthreads();
  }
  {
    float* RSS = (float*)(p.ws + OFF_RSS);
    for (int i = get_bid() * 256 + get_tid(); i < L; i += nworkers() * 256) RSS[i] = 0.f;
  }
  const int n_wout = 16 * 16, n_wup = 16 * 88, n_wdown = 44 * 16;
  for (int it = get_bid(); it < n_wout + n_wup + n_wdown; it += nworkers()) {
    if (it < n_wout) { convert_tile(p.in[12], 1024, 1024, (u16*)(p.ws + OFF_WOUT), it & 15, it >> 4, 0, smem_team); }
    else if (it < n_wout + n_wup) { const int j = it - n_wout; convert_tile(p.in[14], 5632, 1024, (u16*)(p.ws + OFF_WUP), j & 15, j >> 4, 2, smem_team, p.in[13]);   }
    else { const int j = it - n_wout - n_wup; convert_tile(p.in[17], 1024, 2816, (u16*)(p.ws + OFF_WDOWN), j % 44, j / 44, 0, smem_team); }
  }
}

DEV void phase_outproj8(const Params& p, int b, char* smem) {
  const int tid = get_tid8(), lane = tid & 63, w = tid >> 6, wm = w >> 1, wn = w & 1, r = lane & 31, h = lane >> 5;
  u16* U2 = (u16*)(p.ws + OFF_U2);
  float* RSS = (float*)(p.ws + OFF_RSS);
  const u16* Mg = (const u16*)(p.ws + OFF_GS);
  const u16* WO = (const u16*)(p.ws + OFF_WOUT);
  float* reg = (float*)(smem + w * EPI_WAVE_BYTES);
  for (int kk = 0;; ++kk) {
    const int it = tile_index(kk);
    if (it >= 256) break;
    const int mt = it >> 3, nt = it & 7;
    f32x4 acc[4][4];
    ZERO_ACC(acc, 4)
    gemm_tile8<4, true>(acc, Mg, 1024, mt * 256, L - 1, WO, 1024, nt * 128, 1024, smem, (const u16*)(p.ws + OFF_GR));
#pragma unroll
    for (int m = 0; m < 4; ++m)
#pragma unroll
      for (int n = 0; n < 4; ++n)
#pragma unroll
        for (int j = 0; j < 4; ++j) reg[(m * 16 + (lane >> 4) * 4 + j) * 68 + n * 16 + (lane & 15)] = acc[m][n][j];
    EPI_FENCE();
#pragma unroll
    for (int j = 0; j < 16; ++j) {
      const int row = (lane >> 4) + 4 * j, c4 = (lane & 15) * 4;
      const f32x4 a = *(const f32x4*)(reg + row * 68 + c4);
      const int t = mt * 256 + wm * 64 + row, col = nt * 128 + wn * 64 + c4;
      f32x4 hv;
      if (t < NMETA) {
        hv = *(const f32x4*)(p.in[1] + t * 1024 + col) + a;
      } else {
        const size_t idx = ((size_t)b * SEQ + (t - NMETA)) * 1024 + col;
        hv = *(const f32x4*)(p.in[0] + idx) + a;
        *(f32x4*)(p.out + idx) = hv;
      }
      u32x2 hb; hb[0] = pack2(hv[0], hv[1]); hb[1] = pack2(hv[2], hv[3]);
      *(u32x2*)(U2 + (size_t)t * 1024 + col) = hb;
      float sq = hv[0] * hv[0] + hv[1] * hv[1] + hv[2] * hv[2] + hv[3] * hv[3];
      sq += __shfl_xor(sq, 1); sq += __shfl_xor(sq, 2); sq += __shfl_xor(sq, 4); sq += __shfl_xor(sq, 8);
      if ((lane & 15) == 0) atomicAdd(&RSS[t], sq);
    }
    __syncthreads();
  }
  for (int ct = get_rbid(); ct < 64; ct += gridDim.x) {
    const int tid = get_tid8(), lane = tid & 63, w = tid >> 6;
    f32x4* red = (f32x4*)smem;
    red[w * 64 + lane] = thin16(Mg + w * 128, 1024, 8192, WO + w * 128, 1024, ct * 16, 128, lane)
                       + thin16((const u16*)(p.ws + OFF_GR) + w * 128, 1024, 8192, WO + w * 128, 1024, ct * 16, 128, lane);
    __syncthreads();
    if (w == 0) {
      f32x4 a1 = red[lane];
#pragma unroll
      for (int q = 1; q < 8; ++q) a1 += red[q * 64 + lane];
#pragma unroll
      for (int j = 0; j < 4; ++j) {
        const int t = 8192 + (lane >> 4) * 4 + j;
        const size_t idx = ((size_t)b * SEQ + (t - NMETA)) * 1024 + ct * 16 + (lane & 15);
        const float hv = p.in[0][idx] + a1[j];
        p.out[idx] = hv;
        U2[(size_t)t * 1024 + ct * 16 + (lane & 15)] = f2bf(hv);
        float sq = hv * hv;
        sq += __shfl_xor(sq, 1); sq += __shfl_xor(sq, 2); sq += __shfl_xor(sq, 4); sq += __shfl_xor(sq, 8);
        if ((lane & 15) == 0) atomicAdd(&RSS[t], sq);
      }
    }
    __syncthreads();
  }
}

DEV void phase_up8(const Params& p, char* smem) {
  u16* ACT = (u16*)(p.ws + OFF_ACT);
  const float* cw = p.in[15];
  const float* cbias = p.in[16];
  for (int kk = 0;; ++kk) {
    const int it = tile_index(kk);
    if (it >= 33 * 22) break;
    int mt, nt; tile_decode(it, 33, 22, mt, nt);
    f32x4 acc[4][8];
    ZERO_ACC(acc, 8)
    gemm_tile8<8>(acc, (const u16*)(p.ws + OFF_U2), 1024, mt * 254 - 2, L - 1, (const u16*)(p.ws + OFF_WUP), 1024, nt * 256, 1024, smem);
    const int tid = get_tid8(), lane = tid & 63, w = tid >> 6;
    u16* reg = (u16*)(smem + w * EPI_WAVE_BYTES);
    {
      const float* RSS = (const float*)(p.ws + OFF_RSS);
      const int wm = w >> 1;
#pragma unroll
      for (int m = 0; m < 4; ++m)
#pragma unroll
        for (int j = 0; j < 4; ++j) {
          int t = mt * 254 - 2 + wm * 64 + m * 16 + (lane >> 4) * 4 + j; t = t < 0 ? 0 : (t > L - 1 ? L - 1 : t);
          const float rstd = rsqrtf(RSS[t] * (1.f / 1024.f) + EPS);
#pragma unroll
          for (int n = 0; n < 8; ++n) reg[(m * 16 + (lane >> 4) * 4 + j) * 136 + n * 16 + (lane & 15)] = f2bf(acc[m][n][j] * rstd);
        }
    }
    __syncthreads();
    {
      const int cg = tid & 15, rg = tid >> 4;
      const int ch = nt * 128 + cg * 8;
      float wg[3][8], wv[3][8], bg[8], bv[8], g2[8], g1[8], v2[8], v1[8];
#pragma unroll
      for (int k = 0; k < 3; ++k) {
        const f32x4 a0 = *(const f32x4*)(cw + k * 5632 + ch), a1 = *(const f32x4*)(cw + k * 5632 + ch + 4);
        const f32x4 c0 = *(const f32x4*)(cw + k * 5632 + 2816 + ch), c1 = *(const f32x4*)(cw + k * 5632 + 2816 + ch + 4);
#pragma unroll
        for (int j = 0; j < 4; ++j) { wg[k][j] = a0[j]; wg[k][4 + j] = a1[j]; wv[k][j] = c0[j]; wv[k][4 + j] = c1[j]; }
      }
      {
        const f32x4 a0 = *(const f32x4*)(cbias + ch), a1 = *(const f32x4*)(cbias + ch + 4);
        const f32x4 c0 = *(const f32x4*)(cbias + 2816 + ch), c1 = *(const f32x4*)(cbias + 2816 + ch + 4);
#pragma unroll
        for (int j = 0; j < 4; ++j) { bg[j] = a0[j]; bg[4 + j] = a1[j]; bv[j] = c0[j]; bv[4 + j] = c1[j]; }
      }
      const int R0 = rg * 8;
#pragma unroll
      for (int q = 0; q < 2; ++q) {
        const int R = R0 - 2 + q;
        u32x4 gvv = {0u, 0u, 0u, 0u}, vvv = {0u, 0u, 0u, 0u};
        if (R >= 0 && mt * 254 - 2 + R >= 0) {
          const char* sl = smem + ((R >> 6) * 2) * EPI_WAVE_BYTES + ((R & 63) * 136 + cg * 8) * 2;
          gvv = *(const u32x4*)sl; vvv = *(const u32x4*)(sl + EPI_WAVE_BYTES);
        }
#pragma unroll
        for (int j = 0; j < 4; ++j) {
          if (q == 0) { g2[2 * j] = lo_f(gvv[j]); g2[2 * j + 1] = hi_f(gvv[j]); v2[2 * j] = lo_f(vvv[j]); v2[2 * j + 1] = hi_f(vvv[j]); }
          else { g1[2 * j] = lo_f(gvv[j]); g1[2 * j + 1] = hi_f(gvv[j]); v1[2 * j] = lo_f(vvv[j]); v1[2 * j + 1] = hi_f(vvv[j]); }
        }
      }
#pragma unroll 2
      for (int i = 0; i < 8; ++i) {
        const int R = R0 + i, t = mt * 254 - 2 + R;
        u32x4 gvv = {0u, 0u, 0u, 0u}, vvv = {0u, 0u, 0u, 0u};
        if (t >= 0) {
          const char* sl = smem + ((R >> 6) * 2) * EPI_WAVE_BYTES + ((R & 63) * 136 + cg * 8) * 2;
          gvv = *(const u32x4*)sl; vvv = *(const u32x4*)(sl + EPI_WAVE_BYTES);
        }
        float o[8];
#pragma unroll
        for (int j = 0; j < 8; ++j) {
          const float gx = (j & 1) ? hi_f(gvv[j >> 1]) : lo_f(gvv[j >> 1]);
          const float vx = (j & 1) ? hi_f(vvv[j >> 1]) : lo_f(vvv[j >> 1]);
          const float ag = bg[j] + wg[0][j] * g2[j] + wg[1][j] * g1[j] + wg[2][j] * gx;
          const float av = bv[j] + wv[0][j] * v2[j] + wv[1][j] * v1[j] + wv[2][j] * vx;
          o[j] = silu_f(ag) * av;
          g2[j] = g1[j]; g1[j] = gx; v2[j] = v1[j]; v1[j] = vx;
        }
        if (R >= 2 && t < L) {
          u32x4 pk; pk[0] = pack2(o[0], o[1]); pk[1] = pack2(o[2], o[3]); pk[2] = pack2(o[4], o[5]); pk[3] = pack2(o[6], o[7]);
          *(u32x4*)(ACT + (size_t)t * 2816 + ch) = pk;
        }
      }
    }
    __syncthreads();
  }
}

DEV void phase_down8(const Params& p, int b, char* smem) {
  for (int kk = 0;; ++kk) {
    const int it = tile_index(kk);
    if (it >= 256) break;
    const int mt = it >> 3, nt = it & 7;
    f32x4 acc[4][4];
    ZERO_ACC(acc, 4)
    gemm_tile8<4>(acc, (const u16*)(p.ws + OFF_ACT), 2816, NMETA + mt * 256, L - 1, (const u16*)(p.ws + OFF_WDOWN), 2816, nt * 128, 2816, smem);
    const int tid = get_tid8(), lane = tid & 63, w = tid >> 6, wm = w >> 1, wn = w & 1, r = lane & 31, h = lane >> 5;
    float* reg = (float*)(smem + w * EPI_WAVE_BYTES);
#pragma unroll
    for (int m = 0; m < 4; ++m)
#pragma unroll
      for (int n = 0; n < 4; ++n)
#pragma unroll
        for (int j = 0; j < 4; ++j) reg[(m * 16 + (lane >> 4) * 4 + j) * 68 + n * 16 + (lane & 15)] = acc[m][n][j];
    EPI_FENCE();
#pragma unroll
    for (int j = 0; j < 16; ++j) {
      const int row = (lane >> 4) + 4 * j, c4 = (lane & 15) * 4;
      const f32x4 a = *(const f32x4*)(reg + row * 68 + c4);
      const size_t idx = ((size_t)b * SEQ + mt * 256 + wm * 64 + row) * 1024 + nt * 128 + wn * 64 + c4;
      const f32x4 x = *(const f32x4*)(p.out + idx);
      *(f32x4*)(p.out + idx) = x + a;
    }
    __syncthreads();
  }
}

#define XB_TMO      128
#define XB_XCNT(j)  (256  + 64 * (j))
#define XB_XSUB(j)  (1280 + 64 * (j))
#define XB_XGEN(j)  (2304 + 64 * (j))
#define XB_TOP      3328
#define XB_TOPGEN   3392
#define XCD_BAR_WORDS 3456
#define XB_SPIN_CAP (1u << 24)
DEV unsigned xb_ld(unsigned* p)              { return __hip_atomic_load(p, __ATOMIC_RELAXED, __HIP_MEMORY_SCOPE_AGENT); }
DEV unsigned xb_add(unsigned* p, unsigned v) { return __hip_atomic_fetch_add(p, v, __ATOMIC_RELAXED, __HIP_MEMORY_SCOPE_AGENT); }
DEV unsigned xb_xcc_id() { return (unsigned)__builtin_amdgcn_s_getreg((3 << 11) | 20) & 0xFu; }
#define XB_SPIN(cond, bar) do { unsigned _sp = 0; while (cond) { __builtin_amdgcn_s_sleep(1); \
    if ((++_sp & 255u) == 0u) { if (xb_ld(&(bar)[XB_TMO])) break; if (_sp > XB_SPIN_CAP) { atomicAdd(&(bar)[XB_TMO], 1u); break; } } } } while (0)
struct XcdBarrier { unsigned* bar; unsigned x; volatile LDSP unsigned* st; };
DEV XcdBarrier xcd_barrier_post(unsigned* bar, volatile LDSP unsigned* st) {
  XcdBarrier b; b.bar = bar; b.x = xb_xcc_id(); b.st = st;
  if (threadIdx.x == 0) (void)xb_add(&bar[XB_XCNT(b.x)], 1u);
  return b;
}
DEV void xcd_barrier_complete(unsigned* bar, unsigned x, unsigned& nloc, unsigned& nx) {
  const unsigned G = gridDim.x * gridDim.y * gridDim.z;
  unsigned sum, cnt, mine, sp = 0u;
  for (;;) {
    sum = 0u; cnt = 0u; mine = 0u;
#pragma unroll
    for (unsigned j = 0; j < 16; ++j) { const unsigned c = xb_ld(&bar[XB_XCNT(j)]); sum += c; cnt += (c > 0u) ? 1u : 0u; mine = (j == x) ? c : mine; }
    if (sum == G) break;
    __builtin_amdgcn_s_sleep(1);
    if ((++sp & 255u) == 0u) { if (xb_ld(&bar[XB_TMO])) break; if (sp > XB_SPIN_CAP) { atomicAdd(&bar[XB_TMO], 1u); break; } }
  }
  nloc = mine > 0u ? mine : 1u; nx = cnt > 0u ? cnt : 1u;
}
DEV void xcd_barrier(const XcdBarrier& b) {
  asm volatile("s_waitcnt vmcnt(0)" ::: "memory");
  __syncthreads();
  if (threadIdx.x == 0) {
    unsigned* bar = b.bar;
    __builtin_amdgcn_s_waitcnt(0);
    unsigned nloc = b.st[0], nx = b.st[1];
    if (nloc == 0u) { xcd_barrier_complete(bar, b.x, nloc, nx); b.st[0] = nloc; b.st[1] = nx; }
    const unsigned old = xb_add(&bar[XB_XSUB(b.x)], 1u);
    const unsigned gen = old / nloc;
    if (old + 1u == (gen + 1u) * nloc) {
      __builtin_amdgcn_fence(__ATOMIC_RELEASE, "agent");
      asm volatile("s_waitcnt vmcnt(0)" ::: "memory");
      const unsigned og = xb_add(&bar[XB_TOP], 1u);
      const unsigned tg = og / nx;
      if (og + 1u == (tg + 1u) * nx) xb_add(&bar[XB_TOPGEN], 1u);
      else XB_SPIN(xb_ld(&bar[XB_TOPGEN]) == tg, bar);
      __builtin_amdgcn_fence(__ATOMIC_ACQUIRE, "agent");
      xb_add(&bar[XB_XGEN(b.x)], 1u);
      asm volatile("s_waitcnt vmcnt(0)" ::: "memory");
    } else {
      XB_SPIN(xb_ld(&bar[XB_XGEN(b.x)]) == gen, bar);
      __builtin_amdgcn_fence(__ATOMIC_ACQUIRE, "agent");
      asm volatile("s_waitcnt vmcnt(0)" ::: "memory");
    }
  }
  __syncthreads();
}

constexpr int N_PHASES = 19;

__global__ void __launch_bounds__(512) fwd_kernel(Params p, int ph0, int ph1) {
  __shared__ __attribute__((aligned(16))) char smem[SMEM_BYTES];
  __shared__ uint4 xb_words;
  if (threadIdx.x == 0) xb_words = make_uint4(0u, 0u, 0u, 0u);
  __syncthreads();
  XcdBarrier xb = xcd_barrier_post((unsigned*)(p.ws + OFF_BAR), (volatile LDSP unsigned*)&xb_words);
  if (ph1 < 0) cg::this_grid().sync();
  for (int ph = ph0; ph < ph1; ++ph) {
    char* tsm = smem + (get_tid8() >> 8) * SMEM_TEAM;
    const int b = ph >= 10 ? 1 : 0;
    const int lp = (ph == 0) ? 0 : (ph == 18 ? 9 : (ph >= 10 ? ph - 9 : ph));
    switch (lp) {
      case 0: phase_prep(p, 0, true, tsm); break;
      case 1: phase_inproj8(p, b, smem); break;
      case 2: {
        int it = get_bid();
        for (; it < 1024; it += nworkers()) ret_kv_item(p, it, tsm);
        for (; it < 2048; it += nworkers()) ssd_state_item(p, it - 1024, tsm);
      } break;
      case 3: phase_scan(p); break;
      case 4: {
        {
          const int rb0 = get_rbid(), rb = (rb0 & 7) * 32 + (rb0 >> 3), team = get_tid8() >> 8;
          for (int j = 0; j < 3; ++j) {
            int kind = -1, idx = 0;
            if (rb < 4) {
              const int q = rb * 3 + j;
              const int rt = (q < 2) ? 128 : ((q >> 1) - 1) * 4;
              kind = 0; idx = rt * 4 + (q & 1) * 2 + team;
            } else if (rb < 10) {
              if (j < 2) { kind = 1; idx = (246 + (rb - 4) * 2 + j) * 2 + team; }
            } else if (j < 2) {
              const int k = rb - 10, ri = k >> 1;
              const int rt = (ri < 12) ? ((ri / 3) * 4 + 1 + ri % 3) : (17 + ri - 12);
              kind = j; idx = (j == 0) ? (rt * 4 + (k & 1) * 2 + team) : (k * 2 + team);
            }
            if (kind == 0) ret_out_item(p, idx, tsm);
            else if (kind == 1) ssd_out_item(p, idx, tsm);
          }
        }
      } break;
      case 5: phase_merge8(p, smem, tsm); break;
      case 6: phase_outproj8(p, b, smem); break;
      case 7: phase_up8(p, smem); break;
      case 8: phase_down8(p, b, smem); break;
      case 9: {
        if (ph == 9) { phase_final_norm(p, 0); phase_prep(p, 1, false, tsm); }
        else phase_final_norm(p, 1);
      } break;
    }
    if (ph + 1 < ph1) xcd_barrier(xb);
  }
}

#ifndef MK_SINGLE
#define MK_SINGLE 1
#endif

extern "C" void kernel_launch(void* const* d_in, const int* in_sizes, int n_in, void* d_out, int out_size, void* d_ws, size_t ws_size,
                              hipStream_t stream) {
  static int grid_blocks = 0;
  if (!grid_blocks) {
    int dev = 0, cus = 0, per_cu = 0;
    hipGetDevice(&dev);
    hipDeviceGetAttribute(&cus, hipDeviceAttributeMultiprocessorCount, dev);
    hipOccupancyMaxActiveBlocksPerMultiprocessor(&per_cu, fwd_kernel, 512, 0);
    per_cu = 1;
    if (cus != 256) fprintf(stderr, "kernel_launch: built for a 256-CU device (static phase schedules assume 256 workgroups), found %d CUs\n", cus);
    cus = 256;
    grid_blocks = cus * per_cu;
  }
  Params p{};
  for (int i = 0; i < 19; ++i) p.in[i] = (const float*)d_in[i];
  p.out = (float*)d_out;
  p.ws = (char*)d_ws;
#if MK_SINGLE
  (void)hipMemsetAsync((char*)d_ws + OFF_BAR, 0, XCD_BAR_WORDS * 4, stream);
  int ph0 = 0, ph1 = N_PHASES;
  void* args[] = {&p, &ph0, &ph1};
  hipError_t e = hipLaunchCooperativeKernel((void*)fwd_kernel, dim3(grid_blocks), dim3(512), args, 0, stream);
  if (e != hipSuccess) fprintf(stderr, "cooperative launch failed: %s (grid %d)\n", hipGetErrorString(e), grid_blocks);
#else
  for (int ph = 0; ph < N_PHASES; ++ph) {
    hipLaunchKernelGGL(fwd_kernel, dim3(grid_blocks), dim3(512), 0, stream, p, ph, ph + 1);
  }
#endif
}
```

```cpp
#include <hip/hip_runtime.h>
#include <hip/hip_cooperative_groups.h>
#include <cstdio>
namespace cg = cooperative_groups;

typedef unsigned short u16;
typedef __bf16 bf16x8 __attribute__((ext_vector_type(8)));
typedef short s16x4 __attribute__((ext_vector_type(4)));
typedef short s16x8 __attribute__((ext_vector_type(8)));
typedef float f32x16 __attribute__((ext_vector_type(16)));
typedef unsigned int u32x4 __attribute__((ext_vector_type(4)));
typedef unsigned int u32x2 __attribute__((ext_vector_type(2)));
typedef float f32x4 __attribute__((ext_vector_type(4)));

#define DEV __device__ __forceinline__
#define LDSP __attribute__((address_space(3)))

constexpr int D = 1024;
constexpr int L = 8208;
constexpr int SEQ = 8192;
constexpr int NMETA = 16;
constexpr int NPROJ = 13344;
constexpr int NPROJ_PAD = 13568;
constexpr int DFF = 2816;
constexpr float EPS = 1e-6f;

constexpr size_t OFF_Z = 0;
constexpr size_t OFF_G = 33619968;
constexpr size_t OFF_GS = 67239936;
constexpr size_t OFF_GR = 84049920;
constexpr size_t OFF_Q = 100859904;
constexpr size_t OFF_XBC = 117669888;
constexpr size_t OFF_K = 168099840;
constexpr size_t OFF_V = 184909824;
constexpr size_t OFF_DT = 218529792;
constexpr size_t OFF_S2 = 219580416;
constexpr size_t OFF_S1 = 227969024;
constexpr size_t OFF_CD = 261523456;
constexpr size_t OFF_HM = 261531648;
constexpr size_t OFF_BAR = 261597184;
constexpr size_t OFF_RSS = 261611520;
constexpr size_t OFF_WOUT = OFF_S1;
constexpr size_t OFF_WUP = OFF_S1 + 2097152;
constexpr size_t OFF_WDOWN = OFF_S1 + 13631488;
constexpr size_t OFF_UP = OFF_XBC;
constexpr size_t OFF_ACT = OFF_Z;
constexpr size_t OFF_U2 = OFF_Q;
constexpr size_t OUT_HALF = 33554432;

constexpr int SMEM_TEAM = 73728;
constexpr int SMEM_BYTES = 2 * SMEM_TEAM;

struct Params {
  const float* in[19];
  float* out;
  char* ws;
};

DEV int get_tid8() { int t = threadIdx.x; asm volatile("" : "+v"(t)); return t; }
DEV int get_tid() { int t = threadIdx.x & 255; asm volatile("" : "+v"(t)); return t; }
DEV int get_rbid() { int t = blockIdx.x; asm volatile("" : "+s"(t)); return t; }
DEV int get_bid() { int t = get_rbid() * 2 + (get_tid8() >> 8); return __builtin_amdgcn_readfirstlane(t); }
DEV int nworkers() { return (int)gridDim.x * 2; }
DEV float bf2f(u16 h) { return __uint_as_float(((unsigned)h) << 16); }
typedef __bf16 bf16x2_t __attribute__((ext_vector_type(2)));
typedef float f32x2_t __attribute__((ext_vector_type(2)));
DEV u16 f2bf(float f) { const __bf16 h = (__bf16)f; return __builtin_bit_cast(u16, h); }
DEV unsigned pack2(float a, float b) { const f32x2_t v = {a, b}; return __builtin_bit_cast(unsigned, __builtin_convertvector(v, bf16x2_t)); }
DEV float silu_f(float x) { return x * __builtin_amdgcn_rcpf(1.f + __expf(-x)); }
DEV float sigmoid_f(float x) { return __builtin_amdgcn_rcpf(1.f + __expf(-x)); }
DEV float lo_f(unsigned u) { return __uint_as_float(u << 16); }
DEV float hi_f(unsigned u) { return __uint_as_float(u & 0xffff0000u); }
DEV float wave_sum(float v) {
#pragma unroll
  for (int o = 32; o > 0; o >>= 1) v += __shfl_xor(v, o);
  return v;
}
DEV float half_sum(float v) {
#pragma unroll
  for (int o = 16; o > 0; o >>= 1) v += __shfl_xor(v, o);
  return v;
}
DEV float log_gamma(int h) {
  return h == 0 ? -0.0317486983145803f : (h == 1 ? -0.015748356968139168f : (h == 2 ? -0.007843177461025893f : -0.003913899321136329f));
}
DEV f32x16 mfma(bf16x8 a, bf16x8 b, f32x16 c) { return __builtin_amdgcn_mfma_f32_32x32x16_bf16(a, b, c, 0, 0, 0); }
DEV f32x16 zero16() { f32x16 z;
#pragma unroll
  for (int i = 0; i < 16; ++i) z[i] = 0.f;
  return z; }
DEV int acc_row(int i, int h) { return (i & 3) + 8 * (i >> 2) + 4 * h; }

DEV bf16x8 frag_tr(const u16* T, int ld, int k0, int x0, int lane) {
  const int h = lane >> 5, blk = (lane >> 4) & 1, q = (lane & 15) >> 2, pp = lane & 3;
  const u16* a0 = T + (k0 + 8 * h + q) * ld + x0 + 16 * blk + 4 * pp;
  s16x4 lo = __builtin_amdgcn_ds_read_tr16_b64_v4i16((LDSP s16x4*)a0);
  s16x4 hi = __builtin_amdgcn_ds_read_tr16_b64_v4i16((LDSP s16x4*)(a0 + 4 * ld));
  s16x8 v = {lo[0], lo[1], lo[2], lo[3], hi[0], hi[1], hi[2], hi[3]};
  return __builtin_bit_cast(bf16x8, v);
}
DEV bf16x8 frag_row(const u16* T, int ld, int row, int k) {
  return *(const bf16x8*)(T + row * ld + k);
}

template <int MI>
DEV void gemm_tile(f32x16 (&acc)[MI][2], const u16* __restrict__ A, int lda, int arow0, int arow_max,
                   const u16* __restrict__ B, int ldb, int brow0, int K, char* smem) {
  constexpr int BM = MI * 64;
  constexpr int LD = 72;
  constexpr int ACH = BM * 8 / 256;
  u16* As = (u16*)smem;
  u16* Bs = As + BM * LD;
  const int tid = get_tid(), lane = tid & 63, w = tid >> 6, wm = w >> 1, wn = w & 1, r = lane & 31, h = lane >> 5;
  u32x4 ra[ACH], rb[4];
  const u16* ap[ACH];
  const u16* bp[4];
#pragma unroll
  for (int i = 0; i < ACH; ++i) {
    int c = tid + i * 256, row = c >> 3, kc = c & 7;
    int gr = arow0 + row; gr = gr > arow_max ? arow_max : gr;
    ap[i] = A + (size_t)gr * lda + kc * 8;
  }
#pragma unroll
  for (int i = 0; i < 4; ++i) {
    int c = tid + i * 256, row = c >> 3, kc = c & 7;
    bp[i] = B + (size_t)(brow0 + row) * ldb + kc * 8;
  }
#pragma unroll
  for (int i = 0; i < ACH; ++i) ra[i] = *(const u32x4*)(ap[i]);
#pragma unroll
  for (int i = 0; i < 4; ++i) rb[i] = *(const u32x4*)(bp[i]);
  const int nk = K >> 6;
  for (int kt = 0; kt < nk; ++kt) {
#pragma unroll
    for (int i = 0; i < ACH; ++i) { int c = tid + i * 256, row = c >> 3, kc = c & 7; *(u32x4*)(As + row * LD + kc * 8) = ra[i]; }
#pragma unroll
    for (int i = 0; i < 4; ++i) { int c = tid + i * 256, row = c >> 3, kc = c & 7; *(u32x4*)(Bs + row * LD + kc * 8) = rb[i]; }
    __syncthreads();
    if (kt + 1 < nk) {
#pragma unroll
      for (int i = 0; i < ACH; ++i) ra[i] = *(const u32x4*)(ap[i] + (kt + 1) * 64);
#pragma unroll
      for (int i = 0; i < 4; ++i) rb[i] = *(const u32x4*)(bp[i] + (kt + 1) * 64);
    }
#pragma unroll
    for (int ks = 0; ks < 4; ++ks) {
      bf16x8 a[MI], b[2];
#pragma unroll
      for (int mi = 0; mi < MI; ++mi) a[mi] = frag_row(As, LD, wm * MI * 32 + mi * 32 + r, ks * 16 + h * 8);
#pragma unroll
      for (int ni = 0; ni < 2; ++ni) b[ni] = frag_row(Bs, LD, wn * 64 + ni * 32 + r, ks * 16 + h * 8);
#pragma unroll
      for (int mi = 0; mi < MI; ++mi)
#pragma unroll
        for (int ni = 0; ni < 2; ++ni) acc[mi][ni] = mfma(a[mi], b[ni], acc[mi][ni]);
    }
    __syncthreads();
  }
}

DEV int orig_col(int n) {
  if (n < 5120) return n;
  if (n < 7168) {
    int q = n - 5120; int which = q >> 10; int c = q & 1023; int head = c >> 8; int ip = c & 255; int blk = ip >> 6; int wi = ip & 63;
    int j = (wi < 32) ? (blk * 32 + wi) : (128 + blk * 32 + wi - 32);
    return 5152 + which * 1024 + head * 256 + j;
  }
  if (n < 13312) return n + 32;
  if (n < 13344) return 5120 + (n - 13312);
  return -1;
}
DEV void convert_tile(const float* __restrict__ W, int Nsrc, int K, u16* __restrict__ WT, int kt, int ntile, int mode, char* smem, const float* __restrict__ kscale = nullptr) {
  float* t = (float*)smem;
  const int tid = get_tid();
  {
    const int tx = tid & 15, ty = tid >> 4;
    const int n = ntile * 64 + tx * 4;
    int on = n;
    if (mode == 1) on = orig_col(n);
    else if (mode == 2) { const int tl = n >> 8, wi = n & 255; on = (wi < 128) ? (tl * 128 + wi) : (2816 + tl * 128 + wi - 128); }
#pragma unroll
    for (int kk = ty; kk < 64; kk += 16) {
      f32x4 v = {0.f, 0.f, 0.f, 0.f};
      if (on >= 0) v = *(const f32x4*)(W + (size_t)(kt * 64 + kk) * Nsrc + on);
      if (kscale) v = v * kscale[kt * 64 + kk];
      *(f32x4*)(t + kk * 68 + tx * 4) = v;
    }
  }
  __syncthreads();
  {
    const int nn = tid >> 2, kq = (tid & 3) * 16;
    u32x4 o[2];
#pragma unroll
    for (int j = 0; j < 8; ++j) o[j >> 2][j & 3] = pack2(t[(kq + 2 * j) * 68 + nn], t[(kq + 2 * j + 1) * 68 + nn]);
    u16* d = WT + (size_t)(ntile * 64 + nn) * K + kt * 64 + kq;
    *(u32x4*)d = o[0]; *(u32x4*)(d + 8) = o[1];
  }
  __syncthreads();
}

DEV void rmsnorm_row_bf16(const float* __restrict__ src, const float* __restrict__ w, u16* __restrict__ dst, int lane) {
  f32x4 v[4]; float ss = 0.f;
#pragma unroll
  for (int j = 0; j < 4; ++j) { v[j] = *(const f32x4*)(src + j * 256 + lane * 4); ss += v[j][0] * v[j][0] + v[j][1] * v[j][1] + v[j][2] * v[j][2] + v[j][3] * v[j][3]; }
  ss = wave_sum(ss);
  const float rstd = rsqrtf(ss * (1.f / 1024.f) + EPS);
#pragma unroll
  for (int j = 0; j < 4; ++j) {
    f32x4 ww = *(const f32x4*)(w + j * 256 + lane * 4);
    u32x2 o; o[0] = pack2(v[j][0] * rstd * ww[0], v[j][1] * rstd * ww[1]); o[1] = pack2(v[j][2] * rstd * ww[2], v[j][3] * rstd * ww[3]);
    *(u32x2*)(dst + j * 256 + lane * 4) = o;
  }
}
DEV void rmsnorm_row_f32_inplace(float* __restrict__ row, const float* __restrict__ w, int lane) {
  f32x4 v[4]; float ss = 0.f;
#pragma unroll
  for (int j = 0; j < 4; ++j) { v[j] = *(const f32x4*)(row + j * 256 + lane * 4); ss += v[j][0] * v[j][0] + v[j][1] * v[j][1] + v[j][2] * v[j][2] + v[j][3] * v[j][3]; }
  ss = wave_sum(ss);
  const float rstd = rsqrtf(ss * (1.f / 1024.f) + EPS);
#pragma unroll
  for (int j = 0; j < 4; ++j) {
    f32x4 ww = *(const f32x4*)(w + j * 256 + lane * 4);
    f32x4 o; o[0] = v[j][0] * rstd * ww[0]; o[1] = v[j][1] * rstd * ww[1]; o[2] = v[j][2] * rstd * ww[2]; o[3] = v[j][3] * rstd * ww[3];
    *(f32x4*)(row + j * 256 + lane * 4) = o;
  }
}

template <int R, int C, bool SCALE>
DEV void stage_conv(u16* dst, int ld, const u16* __restrict__ xbc, int row0, int ch0, const float* __restrict__ cw, const float* __restrict__ cb, const float* rs) {
  constexpr int CG = C / 8, RG = 256 / CG, RPT = R / RG;
  const int tid = get_tid();
  const int cgi = tid % CG, rgi = tid / CG;
  const int ch = ch0 + cgi * 8, r0 = rgi * RPT;
  float w[4][8], bias[8], xw[3][8];
#pragma unroll
  for (int k = 0; k < 4; ++k) {
    f32x4 a = *(const f32x4*)(cw + k * 3072 + ch), b = *(const f32x4*)(cw + k * 3072 + ch + 4);
#pragma unroll
    for (int j = 0; j < 4; ++j) { w[k][j] = a[j]; w[k][4 + j] = b[j]; }
  }
  {
    f32x4 a = *(const f32x4*)(cb + ch), b = *(const f32x4*)(cb + ch + 4);
#pragma unroll
    for (int j = 0; j < 4; ++j) { bias[j] = a[j]; bias[4 + j] = b[j]; }
  }
#pragma unroll
  for (int k = 0; k < 3; ++k) {
    const int tr = row0 + r0 - 3 + k;
    u32x4 v = {0u, 0u, 0u, 0u};
    if (tr >= 0 && tr < L) v = *(const u32x4*)(xbc + (size_t)tr * 3072 + ch);
#pragma unroll
    for (int j = 0; j < 4; ++j) { xw[k][2 * j] = lo_f(v[j]); xw[k][2 * j + 1] = hi_f(v[j]); }
  }
#pragma unroll
  for (int i = 0; i < RPT; ++i) {
    const int tr = row0 + r0 + i;
    const bool valid = tr < L;
    u32x4 v = {0u, 0u, 0u, 0u};
    if (valid) v = *(const u32x4*)(xbc + (size_t)tr * 3072 + ch);
    float xc[8], o[8];
#pragma unroll
    for (int j = 0; j < 4; ++j) { xc[2 * j] = lo_f(v[j]); xc[2 * j + 1] = hi_f(v[j]); }
    float sc = 1.f;
    if (SCALE) sc = rs[(cgi >> 3) * 128 + r0 + i];
#pragma unroll
    for (int j = 0; j < 8; ++j) {
      float a = bias[j] + w[0][j] * xw[0][j] + w[1][j] * xw[1][j] + w[2][j] * xw[2][j] + w[3][j] * xc[j];
      a = silu_f(a) * sc;
      o[j] = valid ? a : 0.f;
      xw[0][j] = xw[1][j]; xw[1][j] = xw[2][j]; xw[2][j] = xc[j];
    }
    u32x4 pk; pk[0] = pack2(o[0], o[1]); pk[1] = pack2(o[2], o[3]); pk[2] = pack2(o[4], o[5]); pk[3] = pack2(o[6], o[7]);
    *(u32x4*)(dst + (r0 + i) * ld + cgi * 8) = pk;
  }
}

DEV float chunk_cumsum(const float* __restrict__ DT, int c, int H, float A, float* acs, float* dts, int lane) {
  const int s0 = 2 * lane;
  const int t0 = c * 128 + s0;
  const float d0 = (t0 < L) ? DT[(size_t)t0 * 32 + H] : 0.f;
  const float d1 = (t0 + 1 < L) ? DT[(size_t)(t0 + 1) * 32 + H] : 0.f;
  const float a0 = d0 * A, a1 = a0 + d1 * A;
  float tot = a1;
#pragma unroll
  for (int o = 1; o < 64; o <<= 1) { float n = __shfl_up(tot, o); if (lane >= o) tot += n; }
  const float excl = tot - a1;
  acs[s0] = excl + a0; acs[s0 + 1] = excl + a1;
  dts[s0] = d0; dts[s0 + 1] = d1;
  return __shfl(tot, 63);
}

DEV void phase_prep(const Params& p, int b, bool first, char* smem) {
  const int tid = get_tid(), lane = tid & 63, w = tid >> 6;
  u16* U = (u16*)((char*)p.out + OUT_HALF);
  const int n_norm = L / 4;
  const int n_win = 16 * (NPROJ_PAD / 64);
  const int n_wb = first ? 2 * 32 * 16 : 0;
  const int total = n_norm + n_win + n_wb;
  for (int it = get_bid(); it < total; it += nworkers()) {
    if (it < n_norm) {
      const int t = it * 4 + w;
      const float* src = (t < NMETA) ? (p.in[1] + (size_t)t * D) : (p.in[0] + ((size_t)b * SEQ + (t - NMETA)) * D);
      rmsnorm_row_bf16(src, p.in[2], U + (size_t)t * D, lane);
    } else if (it < n_norm + n_win) {
      const int j = it - n_norm; const int ntile = j >> 4, kt = j & 15;
      convert_tile(p.in[3], NPROJ, 1024, (u16*)(p.ws + OFF_S1), kt, ntile, 1, smem);
    } else {
      int j = it - n_norm - n_win; const int which = j >> 9; j &= 511; const int ntile = j >> 5, kt = j & 31;
      convert_tile(p.in[10 + which], 1024, 2048, (u16*)(p.ws + OFF_S2 + (size_t)which * 4194304), kt, ntile, 0, smem);
    }
  }
}

DEV void phase_inproj(const Params& p, int b, char* smem) {
  const int tid = get_tid(), lane = tid & 63, w = tid >> 6, wm = w >> 1, wn = w & 1, r = lane & 31, h = lane >> 5;
  const u16* U = (const u16*)((char*)p.out + OUT_HALF);
  const u16* WT = (const u16*)(p.ws + OFF_S1);
  const int MT = 65, NT = 105;
  for (int it = get_bid(); it < MT * NT; it += gridDim.x) {
    const int nt = it / MT, mt = it % MT;
    f32x16 acc[2][2];
#pragma unroll
    for (int mi = 0; mi < 2; ++mi)
#pragma unroll
      for (int ni = 0; ni < 2; ++ni) acc[mi][ni] = zero16();
    gemm_tile<2>(acc, U, 1024, mt * 128, L - 1, WT, 1024, nt * 128, 1024, smem);
    const int n0 = nt * 128;
    if (nt >= 40 && nt < 56) {
      const bool isk = nt >= 48;
      const int cq = n0 - (isk ? 6144 : 5120);
      const int blk = ((cq & 255) >> 6) + wn;
      const int jf = blk * 32 + r;
      const double invf_rev = exp(-(double)jf * 0.07252236513367073) * 0.15915494309189535;
      const float sc = isk ? 0.0625f : 1.f;
      u16* dst = (u16*)(p.ws + (isk ? OFF_K : OFF_Q));
#pragma unroll
      for (int mi = 0; mi < 2; ++mi)
#pragma unroll
        for (int i = 0; i < 16; ++i) {
          const int t = mt * 128 + wm * 64 + mi * 32 + acc_row(i, h);
          if (t < L) {
            double rev = (double)t * invf_rev;
            rev -= floor(rev);
            const float fr = (float)rev;
            const float sn = __builtin_amdgcn_sinf(fr), cs = __builtin_amdgcn_cosf(fr);
            const float x1 = acc[mi][0][i], x2 = acc[mi][1][i];
            const float o1 = (x1 * cs - x2 * sn) * sc, o2 = (x2 * cs + x1 * sn) * sc;
            u16* d = dst + (size_t)t * 1024 + cq + wn * 64 + r;
            d[0] = f2bf(o1); d[32] = f2bf(o2);
          }
        }
    } else if (nt == 104) {
      float* DT = (float*)(p.ws + OFF_DT);
      if (wn == 0) {
        const float bias = p.in[6][r];
#pragma unroll
        for (int mi = 0; mi < 2; ++mi)
#pragma unroll
          for (int i = 0; i < 16; ++i) {
            const int t = mt * 128 + wm * 64 + mi * 32 + acc_row(i, h);
            if (t < L) {
              const float x = acc[mi][0][i] + bias;
              const float e = __expf(x);
              DT[(size_t)t * 32 + r] = (x > 20.f) ? x : (e < 0.01f ? e * (1.f - 0.5f * e + e * e * (1.f / 3.f)) : __logf(1.f + e));
            }
          }
      }
    } else {
      u16* dst; int ld, c0; bool sig = false;
      if (nt < 16) { dst = (u16*)(p.ws + OFF_Z); ld = 2048; c0 = n0; }
      else if (nt < 40) { dst = (u16*)(p.ws + OFF_XBC); ld = 3072; c0 = n0 - 2048; }
      else if (nt < 72) { dst = (u16*)(p.ws + OFF_V); ld = 2048; c0 = n0 - 7168; }
      else if (nt < 88) { dst = (u16*)(p.ws + OFF_G); ld = 2048; c0 = n0 - 9216; }
      else if (nt < 96) { dst = (u16*)(p.ws + OFF_GS); ld = 1024; c0 = n0 - 11264; sig = true; }
      else { dst = (u16*)(p.ws + OFF_GR); ld = 1024; c0 = n0 - 12288; sig = true; }
#pragma unroll
      for (int mi = 0; mi < 2; ++mi)
#pragma unroll
        for (int ni = 0; ni < 2; ++ni)
#pragma unroll
          for (int i = 0; i < 16; ++i) {
            const int t = mt * 128 + wm * 64 + mi * 32 + acc_row(i, h);
            if (t < L) {
              float v = acc[mi][ni][i];
              if (sig) v = sigmoid_f(v);
              dst[(size_t)t * ld + c0 + wn * 64 + ni * 32 + r] = f2bf(v);
            }
          }
    }
  }
}

DEV void ssd_state_item(const Params& p, int it, char* smem) {
  const int tid = get_tid(), lane = tid & 63, w = tid >> 6, wm = w >> 1, wn = w & 1, r = lane & 31, h = lane >> 5;
  const int c = it >> 4, hp = it & 15, H0 = hp * 2, g = H0 >> 3;
  u16* Xw = (u16*)smem;
  u16* Bc = Xw + 128 * 136;
  float* wsc = (float*)(Bc + 128 * 136);
  float* tmp = wsc + 256;
  const float* DT = (const float*)(p.ws + OFF_DT);
  float* CD = (float*)(p.ws + OFF_CD);
  const u16* XBC = (const u16*)(p.ws + OFF_XBC);
  if (w < 2) {
    const int H = H0 + w;
    const float A = -expf(p.in[7][H]);
    float* acs = tmp + w * 128;
    float* dts = wsc + w * 128;
    const float aend = chunk_cumsum(DT, c, H, A, acs, dts, lane);
    const int s0 = 2 * lane;
    const float w0 = __expf(aend - acs[s0]) * dts[s0], w1 = __expf(aend - acs[s0 + 1]) * dts[s0 + 1];
    dts[s0] = w0; dts[s0 + 1] = w1;
    if (lane == 0) CD[c * 32 + H] = __expf(aend);
  }
  __syncthreads();
  stage_conv<128, 128, true>(Xw, 136, XBC, c * 128, H0 * 64, p.in[4], p.in[5], wsc);
  stage_conv<128, 128, false>(Bc, 136, XBC, c * 128, 2048 + g * 128, p.in[4], p.in[5], nullptr);
  __syncthreads();
  f32x16 acc[2][2];
#pragma unroll
  for (int mi = 0; mi < 2; ++mi)
#pragma unroll
    for (int ni = 0; ni < 2; ++ni) acc[mi][ni] = zero16();
#pragma unroll
  for (int ks = 0; ks < 8; ++ks) {
    bf16x8 a[2], bq[2];
#pragma unroll
    for (int mi = 0; mi < 2; ++mi) a[mi] = frag_tr(Xw, 136, ks * 16, wm * 64 + mi * 32, lane);
#pragma unroll
    for (int ni = 0; ni < 2; ++ni) bq[ni] = frag_tr(Bc, 136, ks * 16, wn * 64 + ni * 32, lane);
#pragma unroll
    for (int mi = 0; mi < 2; ++mi)
#pragma unroll
      for (int ni = 0; ni < 2; ++ni) acc[mi][ni] = mfma(a[mi], bq[ni], acc[mi][ni]);
  }
  u16* ST = (u16*)(p.ws + OFF_S1) + (size_t)(c * 32 + H0) * 8192;
  __syncthreads();
#pragma unroll
  for (int mi = 0; mi < 2; ++mi)
#pragma unroll
    for (int ni = 0; ni < 2; ++ni)
#pragma unroll
      for (int i = 0; i < 16; ++i) Xw[(wm * 64 + mi * 32 + acc_row(i, h)) * 136 + wn * 64 + ni * 32 + r] = f2bf(acc[mi][ni][i]);
  asm volatile("s_waitcnt lgkmcnt(0)" ::: "memory");
#pragma unroll
  for (int j = 0; j < 8; ++j) {
    const int m = wm * 64 + (lane >> 3) + 8 * j, n = wn * 64 + (lane & 7) * 8;
    *(u32x4*)(ST + m * 128 + n) = *(const u32x4*)(Xw + m * 136 + n);
  }
  __syncthreads();
}

DEV void ret_kv_item(const Params& p, int it, char* smem) {
  const int tid = get_tid(), lane = tid & 63, w = tid >> 6, wm = w >> 1, wn = w & 1, r = lane & 31, h = lane >> 5;
  const int sc = it >> 5, rem = it & 31, hd = rem >> 3, dt2 = (rem >> 2) & 1, et = rem & 3;
  u16* Vt = (u16*)smem;
  u16* Kt = Vt + 128 * 136;
  const u16* Vg = (const u16*)(p.ws + OFF_V);
  const u16* Kg = (const u16*)(p.ws + OFF_K);
  const float lg = log_gamma(hd);
  f32x16 acc[2][2];
#pragma unroll
  for (int mi = 0; mi < 2; ++mi)
#pragma unroll
    for (int ni = 0; ni < 2; ++ni) acc[mi][ni] = zero16();
  for (int half = 0; half < 2; ++half) {
#pragma unroll
    for (int i = 0; i < 8; ++i) {
      const int cidx = tid + i * 256, row = cidx >> 4, cc = cidx & 15;
      const int tok = sc * 256 + half * 128 + row;
      u32x4 v = *(const u32x4*)(Vg + (size_t)tok * 2048 + hd * 512 + et * 128 + cc * 8);
      *(u32x4*)(Vt + row * 136 + cc * 8) = v;
      u32x4 kk = *(const u32x4*)(Kg + (size_t)tok * 1024 + hd * 256 + dt2 * 128 + cc * 8);
      const float dec = __expf((float)(255 - (half * 128 + row)) * lg);
      u32x4 ko;
#pragma unroll
      for (int j = 0; j < 4; ++j) ko[j] = pack2(lo_f(kk[j]) * dec, hi_f(kk[j]) * dec);
      *(u32x4*)(Kt + row * 136 + cc * 8) = ko;
    }
    __syncthreads();
#pragma unroll
    for (int ks = 0; ks < 8; ++ks) {
      bf16x8 a[2], bq[2];
#pragma unroll
      for (int mi = 0; mi < 2; ++mi) a[mi] = frag_tr(Vt, 136, ks * 16, wm * 64 + mi * 32, lane);
#pragma unroll
      for (int ni = 0; ni < 2; ++ni) bq[ni] = frag_tr(Kt, 136, ks * 16, wn * 64 + ni * 32, lane);
#pragma unroll
      for (int mi = 0; mi < 2; ++mi)
#pragma unroll
        for (int ni = 0; ni < 2; ++ni) acc[mi][ni] = mfma(a[mi], bq[ni], acc[mi][ni]);
    }
    __syncthreads();
  }
  u16* RST = (u16*)((char*)p.out + OUT_HALF) + ((size_t)(sc * 4 + hd) * 512 + et * 128) * 256 + dt2 * 128;
#pragma unroll
  for (int mi = 0; mi < 2; ++mi)
#pragma unroll
    for (int ni = 0; ni < 2; ++ni)
#pragma unroll
      for (int i = 0; i < 16; ++i) Vt[(wm * 64 + mi * 32 + acc_row(i, h)) * 136 + wn * 64 + ni * 32 + r] = f2bf(acc[mi][ni][i]);
  asm volatile("s_waitcnt lgkmcnt(0)" ::: "memory");
#pragma unroll
  for (int j = 0; j < 8; ++j) {
    const int e = wm * 64 + (lane >> 3) + 8 * j, d = wn * 64 + (lane & 7) * 8;
    *(u32x4*)(RST + (size_t)e * 256 + d) = *(const u32x4*)(Vt + e * 136 + d);
  }
  __syncthreads();
}

DEV void phase_scan(const Params& p) {
  const int gt = get_bid() * 256 + get_tid(), nth = nworkers() * 256;
  const float* CD = (const float*)(p.ws + OFF_CD);
  for (int v = gt; v < 32768 + 65536; v += nth) {
    float st[8];
#pragma unroll
    for (int j = 0; j < 8; ++j) st[j] = 0.f;
    if (v < 32768) {
      const int e0 = v * 8, H = e0 >> 13;
      u16* base = (u16*)(p.ws + OFF_S1) + e0;
      for (int c0 = 0; c0 < 64; c0 += 8) {
        u32x4 x[8];
#pragma unroll
        for (int u = 0; u < 8; ++u) x[u] = *(const u32x4*)(base + (size_t)(c0 + u) * 262144);
#pragma unroll
        for (int u = 0; u < 8; ++u) {
          const float dcy = CD[(c0 + u) * 32 + H];
          u32x4 o;
#pragma unroll
          for (int j = 0; j < 4; ++j) {
            st[2 * j] = st[2 * j] * dcy + lo_f(x[u][j]);
            st[2 * j + 1] = st[2 * j + 1] * dcy + hi_f(x[u][j]);
            o[j] = pack2(st[2 * j], st[2 * j + 1]);
          }
          *(u32x4*)(base + (size_t)(c0 + u) * 262144) = o;
        }
      }
    } else {
      const int e0 = (v - 32768) * 8, hd = e0 >> 17;
      const float g256 = __expf(256.f * log_gamma(hd));
      u16* base = (u16*)((char*)p.out + OUT_HALF) + e0;
      for (int c0 = 0; c0 < 32; c0 += 8) {
        u32x4 x[8];
#pragma unroll
        for (int u = 0; u < 8; ++u) x[u] = *(const u32x4*)(base + (size_t)(c0 + u) * 524288);
#pragma unroll
        for (int u = 0; u < 8; ++u) {
          u32x4 o;
#pragma unroll
          for (int j = 0; j < 4; ++j) {
            st[2 * j] = st[2 * j] * g256 + lo_f(x[u][j]);
            st[2 * j + 1] = st[2 * j + 1] * g256 + hi_f(x[u][j]);
            o[j] = pack2(st[2 * j], st[2 * j + 1]);
          }
          *(u32x4*)(base + (size_t)(c0 + u) * 524288) = o;
        }
      }
    }
  }
}

DEV void ssd_out_item(const Params& p, int it, char* smem) {
  const int tid = get_tid(), lane = tid & 63, w = tid >> 6, wm = w >> 1, wn = w & 1, r = lane & 31, h = lane >> 5;
  const int c = it >> 3, rem = it & 7, g = rem & 3, lh = rem >> 2;
  if (c == 64 && lh == 1) return;
  u16* Ct = (u16*)smem;
  u16* Bt = Ct + 64 * 136;
  u16* Lt = Bt;
  u16* Xt = Bt + 128 * 136;
  float* acs = (float*)(Xt + 128 * 72);
  float* dts = acs + 128;
  float* rowsq = dts + 128;
  const u16* XBC = (const u16*)(p.ws + OFF_XBC);
  const float* DT = (const float*)(p.ws + OFF_DT);
  u16* Z = (u16*)(p.ws + OFF_Z);
  const int tok0 = c * 128;
  stage_conv<64, 128, false>(Ct, 136, XBC, tok0 + lh * 64, 2560 + g * 128, p.in[4], p.in[5], nullptr);
  stage_conv<128, 128, false>(Bt, 136, XBC, tok0, 2048 + g * 128, p.in[4], p.in[5], nullptr);
  if (tid < 64) rowsq[tid] = 0.f;
  __syncthreads();
  f32x16 cb[2];
  cb[0] = zero16(); cb[1] = zero16();
#pragma unroll
  for (int ks = 0; ks < 8; ++ks) {
    bf16x8 a = frag_row(Ct, 136, wm * 32 + r, ks * 16 + h * 8);
#pragma unroll
    for (int ni = 0; ni < 2; ++ni) {
      bf16x8 bq = frag_row(Bt, 136, wn * 64 + ni * 32 + r, ks * 16 + h * 8);
      cb[ni] = mfma(a, bq, cb[ni]);
    }
  }
  for (int hh = 0; hh < 8; ++hh) {
    const int H = g * 8 + hh;
    u32x4 zv[2];
    {
      int tz = tok0 + lh * 64 + (tid >> 2); tz = tz < L ? tz : L - 1;
      const u16* zp0 = Z + (size_t)tz * 2048 + H * 64 + (tid & 3) * 16;
      zv[0] = *(const u32x4*)zp0; zv[1] = *(const u32x4*)(zp0 + 8);
    }
    __syncthreads();
    if (w == 0) {
      const float A = -expf(p.in[7][H]);
      chunk_cumsum(DT, c, H, A, acs, dts, lane);
    }
    stage_conv<128, 64, false>(Xt, 72, XBC, tok0, H * 64, p.in[4], p.in[5], nullptr);
    __syncthreads();
#pragma unroll
    for (int ni = 0; ni < 2; ++ni)
#pragma unroll
      for (int i = 0; i < 16; ++i) {
        const int ll = wm * 32 + acc_row(i, h), l = lh * 64 + ll, s = wn * 64 + ni * 32 + r;
        float val = 0.f;
        if (s <= l) val = cb[ni][i] * __expf(acs[l] - acs[s]) * dts[s];
        Lt[ll * 136 + s] = f2bf(val);
      }
    f32x16 y = zero16();
    if (c > 0) {
      const u16* pv = (const u16*)(p.ws + OFF_S1) + ((size_t)((c - 1) * 32 + H) * 64 + wn * 32 + r) * 128 + h * 8;
#pragma unroll
      for (int ks = 0; ks < 8; ++ks) {
        bf16x8 a = frag_row(Ct, 136, wm * 32 + r, ks * 16 + h * 8);
        bf16x8 bq = *(const bf16x8*)(pv + ks * 16);
        y = mfma(a, bq, y);
      }
#pragma unroll
      for (int i = 0; i < 16; ++i) { const int l = lh * 64 + wm * 32 + acc_row(i, h); y[i] *= __expf(acs[l]); }
    }
    __syncthreads();
#pragma unroll
    for (int ks = 0; ks < 8; ++ks) {
      bf16x8 a = frag_row(Lt, 136, wm * 32 + r, ks * 16 + h * 8);
      bf16x8 bq = frag_tr(Xt, 72, ks * 16, wn * 32, lane);
      y = mfma(a, bq, y);
    }
    const float Dsk = p.in[8][H];
    float* Ys = (float*)(Bt + 64 * 136);
#pragma unroll
    for (int i = 0; i < 16; ++i) Ys[(wm * 32 + acc_row(i, h)) * 68 + wn * 32 + r] = y[i];
    __syncthreads();
    {
      const int row = tid >> 2, q = tid & 3, l = lh * 64 + row, t = tok0 + l;
      float sq = 0.f;
      if (t < L) {
        u16* zp = Z + (size_t)t * 2048 + H * 64 + q * 16;
        u32x4 xv[2], ov[2];
        xv[0] = *(const u32x4*)(Xt + l * 72 + q * 16); xv[1] = *(const u32x4*)(Xt + l * 72 + q * 16 + 8);
#pragma unroll
        for (int k = 0; k < 2; ++k) {
          const f32x4 ya = *(const f32x4*)(Ys + row * 68 + q * 16 + k * 8), yb = *(const f32x4*)(Ys + row * 68 + q * 16 + k * 8 + 4);
          float o[8];
#pragma unroll
          for (int j = 0; j < 4; ++j) {
            const float y0 = (j < 2) ? ya[2 * j] : yb[2 * j - 4], y1 = (j < 2) ? ya[2 * j + 1] : yb[2 * j - 3];
            o[2 * j] = (y0 + Dsk * lo_f(xv[k][j])) * silu_f(lo_f(zv[k][j]));
            o[2 * j + 1] = (y1 + Dsk * hi_f(xv[k][j])) * silu_f(hi_f(zv[k][j]));
            sq += o[2 * j] * o[2 * j] + o[2 * j + 1] * o[2 * j + 1];
            ov[k][j] = pack2(o[2 * j], o[2 * j + 1]);
          }
        }
        *(u32x4*)zp = ov[0]; *(u32x4*)(zp + 8) = ov[1];
      }
      sq += __shfl_xor(sq, 1); sq += __shfl_xor(sq, 2);
      if (q == 0) rowsq[row] += sq;
    }
  }
  __syncthreads();
  {
    const int row = tid >> 2, q = tid & 3, t = tok0 + lh * 64 + row;
    if (t < L) {
      const float rn = rsqrtf(rowsq[row] * (1.f / 512.f) + EPS);
      u32x4 v[16];
#pragma unroll
      for (int hh = 0; hh < 8; ++hh) {
        const u16* zp = Z + (size_t)t * 2048 + (g * 8 + hh) * 64 + q * 16;
        v[2 * hh] = *(const u32x4*)zp; v[2 * hh + 1] = *(const u32x4*)(zp + 8);
      }
#pragma unroll
      for (int hh = 0; hh < 8; ++hh) {
        u16* zp = Z + (size_t)t * 2048 + (g * 8 + hh) * 64 + q * 16;
        const float* nwp = p.in[9] + (g * 8 + hh) * 64 + q * 16;
#pragma unroll
        for (int k = 0; k < 2; ++k) {
          const f32x4 wa = *(const f32x4*)(nwp + k * 8), wb = *(const f32x4*)(nwp + k * 8 + 4);
          u32x4 o;
          o[0] = pack2(lo_f(v[2 * hh + k][0]) * rn * wa[0], hi_f(v[2 * hh + k][0]) * rn * wa[1]);
          o[1] = pack2(lo_f(v[2 * hh + k][1]) * rn * wa[2], hi_f(v[2 * hh + k][1]) * rn * wa[3]);
          o[2] = pack2(lo_f(v[2 * hh + k][2]) * rn * wb[0], hi_f(v[2 * hh + k][2]) * rn * wb[1]);
          o[3] = pack2(lo_f(v[2 * hh + k][3]) * rn * wb[2], hi_f(v[2 * hh + k][3]) * rn * wb[3]);
          *(u32x4*)(zp + k * 8) = o;
        }
      }
    }
  }
  __syncthreads();
}

DEV void ret_out_item(const Params& p, int it, char* smem) {
  const int tid = get_tid(), lane = tid & 63, w = tid >> 6, wm = w >> 1, wn = w & 1, r = lane & 31, h = lane >> 5;
  const int rt = it >> 2, hd = it & 3;
  const int t0 = rt * 64, sc = rt >> 2, qtr = rt & 3;
  u16* P = (u16*)smem;
  char* gsm = smem + 33792;
  u16* Vt = (u16*)gsm;
  float* rowsq = (float*)(smem + 33792 + 27648);
  const u16* Qg = (const u16*)(p.ws + OFF_Q) + hd * 256;
  const u16* Kg = (const u16*)(p.ws + OFF_K) + hd * 256;
  const u16* Vg = (const u16*)(p.ws + OFF_V);
  u16* Gg = (u16*)(p.ws + OFF_G);
  const u16* RST = (const u16*)((char*)p.out + OUT_HALF);
  const float lg = log_gamma(hd);
  if (tid < 64) rowsq[tid] = 0.f;
  const int nkb = (qtr >= 2) ? 2 : 1;
  for (int kb = 0; kb < nkb; ++kb) {
    f32x16 acc[1][2];
    acc[0][0] = zero16(); acc[0][1] = zero16();
    gemm_tile<1>(acc, Qg, 1024, t0, L - 1, Kg, 1024, sc * 256 + kb * 128, 256, gsm);
#pragma unroll
    for (int ni = 0; ni < 2; ++ni)
#pragma unroll
      for (int i = 0; i < 16; ++i) {
        const int ll = wm * 32 + acc_row(i, h), lp = qtr * 64 + ll, s = kb * 128 + wn * 64 + ni * 32 + r;
        float val = 0.f;
        if (s <= lp) val = acc[0][ni][i] * __expf((float)(lp - s) * lg);
        P[ll * 264 + s] = f2bf(val);
      }
  }
  float rs[16];
#pragma unroll
  for (int i = 0; i < 16; ++i) rs[i] = 0.f;
  for (int et = 0; et < 4; ++et) {
    f32x16 acc[1][2];
    acc[0][0] = zero16(); acc[0][1] = zero16();
    u32x4 gv[4], vreg[4];
    {
      int tg = t0 + (tid >> 2); tg = tg < L ? tg : L - 1;
      const u16* gp0 = Gg + (size_t)tg * 2048 + hd * 512 + et * 128 + (tid & 3) * 32;
#pragma unroll
      for (int k = 0; k < 4; ++k) gv[k] = *(const u32x4*)(gp0 + k * 8);
#pragma unroll
      for (int i = 0; i < 4; ++i) {
        const int cidx = tid + i * 256, row = cidx >> 4, cc = cidx & 15;
        int tok = sc * 256 + row; tok = tok < L ? tok : L - 1;
        vreg[i] = *(const u32x4*)(Vg + (size_t)tok * 2048 + hd * 512 + et * 128 + cc * 8);
      }
    }
    if (sc > 0) {
      gemm_tile<1>(acc, Qg, 1024, t0, L - 1, RST + ((size_t)((sc - 1) * 4 + hd) * 512 + et * 128) * 256, 256, 0, 256, gsm);
#pragma unroll
      for (int ni = 0; ni < 2; ++ni)
#pragma unroll
        for (int i = 0; i < 16; ++i) {
          const int lp = qtr * 64 + wm * 32 + acc_row(i, h);
          acc[0][ni][i] *= __expf((float)(lp + 1) * lg);
        }
    }
    for (int kb64 = 0; kb64 <= qtr; ++kb64) {
#pragma unroll
      for (int i = 0; i < 4; ++i) {
        const int cidx = tid + i * 256, row = cidx >> 4, cc = cidx & 15;
        const int tok = sc * 256 + kb64 * 64 + row;
        u32x4 v = {0u, 0u, 0u, 0u};
        if (tok < L) v = vreg[i];
        *(u32x4*)(Vt + row * 136 + cc * 8) = v;
      }
      __syncthreads();
      if (kb64 < qtr) {
#pragma unroll
        for (int i = 0; i < 4; ++i) {
          const int cidx = tid + i * 256, row = cidx >> 4, cc = cidx & 15;
          int tok = sc * 256 + (kb64 + 1) * 64 + row; tok = tok < L ? tok : L - 1;
          vreg[i] = *(const u32x4*)(Vg + (size_t)tok * 2048 + hd * 512 + et * 128 + cc * 8);
        }
      }
#pragma unroll
      for (int ks = 0; ks < 4; ++ks) {
        bf16x8 a = frag_row(P, 264, wm * 32 + r, kb64 * 64 + ks * 16 + h * 8);
#pragma unroll
        for (int ni = 0; ni < 2; ++ni) {
          bf16x8 bq = frag_tr(Vt, 136, ks * 16, wn * 64 + ni * 32, lane);
          acc[0][ni] = mfma(a, bq, acc[0][ni]);
        }
      }
      __syncthreads();
    }
    u16* Os = (u16*)gsm;
#pragma unroll
    for (int ni = 0; ni < 2; ++ni)
#pragma unroll
      for (int i = 0; i < 16; ++i) {
        const float o = acc[0][ni][i];
        if (t0 + wm * 32 + acc_row(i, h) < L) rs[i] += o * o;
        Os[(wm * 32 + acc_row(i, h)) * 136 + wn * 64 + ni * 32 + r] = f2bf(o);
      }
    __syncthreads();
    {
      const int row = tid >> 2, q = tid & 3, t = t0 + row;
      if (t < L) {
        u16* gp = Gg + (size_t)t * 2048 + hd * 512 + et * 128 + q * 32;
        u32x4 ov[4];
#pragma unroll
        for (int k = 0; k < 4; ++k) ov[k] = *(const u32x4*)(Os + row * 136 + q * 32 + k * 8);
#pragma unroll
        for (int k = 0; k < 4; ++k) {
          u32x4 o;
#pragma unroll
          for (int j = 0; j < 4; ++j) o[j] = pack2(silu_f(lo_f(gv[k][j])) * lo_f(ov[k][j]), silu_f(hi_f(gv[k][j])) * hi_f(ov[k][j]));
          *(u32x4*)(gp + k * 8) = o;
        }
      }
    }
    __syncthreads();
  }
#pragma unroll
  for (int i = 0; i < 16; ++i) {
    const float v = half_sum(rs[i]);
    if (r == 0) atomicAdd(&rowsq[wm * 32 + acc_row(i, h)], v);
  }
  __syncthreads();
  {
    const int row = tid >> 2, q = tid & 3, t = t0 + row;
    if (t < L) {
      const float rn = rsqrtf(rowsq[row] * (1.f / 512.f) + EPS);
      u32x4 v[16];
#pragma unroll
      for (int et = 0; et < 4; ++et)
#pragma unroll
        for (int k = 0; k < 4; ++k) v[et * 4 + k] = *(const u32x4*)(Gg + (size_t)t * 2048 + hd * 512 + et * 128 + q * 32 + k * 8);
#pragma unroll
      for (int et = 0; et < 4; ++et)
#pragma unroll
        for (int k = 0; k < 4; ++k) {
          u32x4 o;
#pragma unroll
          for (int j = 0; j < 4; ++j) o[j] = pack2(lo_f(v[et * 4 + k][j]) * rn, hi_f(v[et * 4 + k][j]) * rn);
          *(u32x4*)(Gg + (size_t)t * 2048 + hd * 512 + et * 128 + q * 32 + k * 8) = o;
        }
    }
  }
  __syncthreads();
}

DEV void merge_tile(const Params& p, int it, char* smem) {
  const int tid = get_tid(), lane = tid & 63, w = tid >> 6, wm = w >> 1, wn = w & 1, r = lane & 31, h = lane >> 5;
  const int nt = it / 65, mt = it % 65;
  u16* GS = (u16*)(p.ws + OFF_GS);
  const u16* GR = (const u16*)(p.ws + OFF_GR);
  f32x16 acc[2][2];
#pragma unroll
  for (int mi = 0; mi < 2; ++mi)
#pragma unroll
    for (int ni = 0; ni < 2; ++ni) acc[mi][ni] = zero16();
  gemm_tile<2>(acc, (const u16*)(p.ws + OFF_Z), 2048, mt * 128, L - 1, (const u16*)(p.ws + OFF_S2), 2048, nt * 128, 2048, smem);
#pragma unroll
  for (int mi = 0; mi < 2; ++mi)
#pragma unroll
    for (int ni = 0; ni < 2; ++ni)
#pragma unroll
      for (int i = 0; i < 16; ++i) {
        const int t = mt * 128 + wm * 64 + mi * 32 + acc_row(i, h);
        if (t < L) {
          const size_t idx = (size_t)t * 1024 + nt * 128 + wn * 64 + ni * 32 + r;
          GS[idx] = f2bf(bf2f(GS[idx]) * acc[mi][ni][i]);
        }
        acc[mi][ni][i] = 0.f;
      }
  gemm_tile<2>(acc, (const u16*)(p.ws + OFF_G), 2048, mt * 128, L - 1, (const u16*)(p.ws + OFF_S2 + 4194304), 2048, nt * 128, 2048, smem);
#pragma unroll
  for (int mi = 0; mi < 2; ++mi)
#pragma unroll
    for (int ni = 0; ni < 2; ++ni)
#pragma unroll
      for (int i = 0; i < 16; ++i) {
        const int t = mt * 128 + wm * 64 + mi * 32 + acc_row(i, h);
        if (t < L) {
          const size_t idx = (size_t)t * 1024 + nt * 128 + wn * 64 + ni * 32 + r;
          GS[idx] = f2bf(bf2f(GS[idx]) + bf2f(GR[idx]) * acc[mi][ni][i]);
        }
      }
}

DEV void phase_merge(const Params& p, char* smem) {
  const int n_tiles = 65 * 8;
  const int n_wout = 16 * 16, n_wup = 16 * 88, n_wdown = 44 * 16;
  const int total = n_tiles + n_wout + n_wup + n_wdown;
  for (int it = get_bid(); it < total; it += nworkers()) {
    if (it < n_tiles) merge_tile(p, it, smem);
    else if (it < n_tiles + n_wout) { const int j = it - n_tiles; convert_tile(p.in[12], 1024, 1024, (u16*)(p.ws + OFF_WOUT), j & 15, j >> 4, 0, smem); }
    else if (it < n_tiles + n_wout + n_wup) { const int j = it - n_tiles - n_wout; convert_tile(p.in[14], 5632, 1024, (u16*)(p.ws + OFF_WUP), j & 15, j >> 4, 0, smem); }
    else { const int j = it - n_tiles - n_wout - n_wup; convert_tile(p.in[17], 1024, 2816, (u16*)(p.ws + OFF_WDOWN), j % 44, j / 44, 0, smem); }
  }
}

DEV void phase_outproj(const Params& p, int b, char* smem) {
  const int tid = get_tid(), lane = tid & 63, w = tid >> 6, wm = w >> 1, wn = w & 1, r = lane & 31, h = lane >> 5;
  float* HM = (float*)(p.ws + OFF_HM);
  for (int it = get_bid(); it < 65 * 8; it += gridDim.x) {
    const int nt = it / 65, mt = it % 65;
    f32x16 acc[2][2];
#pragma unroll
    for (int mi = 0; mi < 2; ++mi)
#pragma unroll
      for (int ni = 0; ni < 2; ++ni) acc[mi][ni] = zero16();
    gemm_tile<2>(acc, (const u16*)(p.ws + OFF_GS), 1024, mt * 128, L - 1, (const u16*)(p.ws + OFF_WOUT), 1024, nt * 128, 1024, smem);
#pragma unroll
    for (int mi = 0; mi < 2; ++mi)
#pragma unroll
      for (int ni = 0; ni < 2; ++ni)
#pragma unroll
        for (int i = 0; i < 16; ++i) {
          const int t = mt * 128 + wm * 64 + mi * 32 + acc_row(i, h);
          const int col = nt * 128 + wn * 64 + ni * 32 + r;
          if (t < NMETA) HM[t * 1024 + col] = p.in[1][t * 1024 + col] + acc[mi][ni][i];
          else if (t < L) {
            const size_t idx = ((size_t)b * SEQ + (t - NMETA)) * 1024 + col;
            p.out[idx] = p.in[0][idx] + acc[mi][ni][i];
          }
        }
  }
}

DEV void phase_norm2(const Params& p, int b) {
  const int lane = get_tid() & 63, w = get_tid() >> 6;
  u16* U2 = (u16*)(p.ws + OFF_U2);
  for (int it = get_bid(); it < L / 4; it += nworkers()) {
    const int t = it * 4 + w;
    const float* src = (t < NMETA) ? ((const float*)(p.ws + OFF_HM) + (size_t)t * D) : (p.out + ((size_t)b * SEQ + (t - NMETA)) * D);
    rmsnorm_row_bf16(src, p.in[13], U2 + (size_t)t * D, lane);
  }
}

DEV void phase_up(const Params& p, char* smem) {
  const int tid = get_tid(), lane = tid & 63, w = tid >> 6, wm = w >> 1, wn = w & 1, r = lane & 31, h = lane >> 5;
  u16* UP = (u16*)(p.ws + OFF_UP);
  for (int it = get_bid(); it < 65 * 44; it += gridDim.x) {
    const int nt = it / 65, mt = it % 65;
    f32x16 acc[2][2];
#pragma unroll
    for (int mi = 0; mi < 2; ++mi)
#pragma unroll
      for (int ni = 0; ni < 2; ++ni) acc[mi][ni] = zero16();
    gemm_tile<2>(acc, (const u16*)(p.ws + OFF_U2), 1024, mt * 128, L - 1, (const u16*)(p.ws + OFF_WUP), 1024, nt * 128, 1024, smem);
#pragma unroll
    for (int mi = 0; mi < 2; ++mi)
#pragma unroll
      for (int ni = 0; ni < 2; ++ni)
#pragma unroll
        for (int i = 0; i < 16; ++i) {
          const int t = mt * 128 + wm * 64 + mi * 32 + acc_row(i, h);
          if (t < L) UP[(size_t)t * 5632 + nt * 128 + wn * 64 + ni * 32 + r] = f2bf(acc[mi][ni][i]);
        }
  }
}

DEV void phase_ffn_act(const Params& p) {
  const int gt = get_bid() * 256 + get_tid(), nth = nworkers() * 256;
  const u16* UP = (const u16*)(p.ws + OFF_UP);
  u16* ACT = (u16*)(p.ws + OFF_ACT);
  const float* cw = p.in[15];
  const float* cbias = p.in[16];
  for (int u = gt; u < 513 * 352; u += nth) {
    const int rb = u / 352, cgp = u % 352, ch = cgp * 8, t0 = rb * 16;
    float wg[3][8], wv[3][8], bg[8], bv[8], g2[8], g1[8], v2[8], v1[8];
#pragma unroll
    for (int k = 0; k < 3; ++k)
#pragma unroll
      for (int j = 0; j < 8; ++j) { wg[k][j] = cw[k * 5632 + ch + j]; wv[k][j] = cw[k * 5632 + 2816 + ch + j]; }
#pragma unroll
    for (int j = 0; j < 8; ++j) { bg[j] = cbias[ch + j]; bv[j] = cbias[2816 + ch + j]; }
    {
      u32x4 a = {0u, 0u, 0u, 0u}, bq = {0u, 0u, 0u, 0u}, c2 = {0u, 0u, 0u, 0u}, d2 = {0u, 0u, 0u, 0u};
      if (t0 >= 2) {
        a = *(const u32x4*)(UP + (size_t)(t0 - 2) * 5632 + ch); bq = *(const u32x4*)(UP + (size_t)(t0 - 1) * 5632 + ch);
        c2 = *(const u32x4*)(UP + (size_t)(t0 - 2) * 5632 + 2816 + ch); d2 = *(const u32x4*)(UP + (size_t)(t0 - 1) * 5632 + 2816 + ch);
      }
#pragma unroll
      for (int j = 0; j < 4; ++j) {
        g2[2 * j] = lo_f(a[j]); g2[2 * j + 1] = hi_f(a[j]); g1[2 * j] = lo_f(bq[j]); g1[2 * j + 1] = hi_f(bq[j]);
        v2[2 * j] = lo_f(c2[j]); v2[2 * j + 1] = hi_f(c2[j]); v1[2 * j] = lo_f(d2[j]); v1[2 * j + 1] = hi_f(d2[j]);
      }
    }
#pragma unroll 4
    for (int i = 0; i < 16; ++i) {
      const int t = t0 + i;
      const u32x4 a = *(const u32x4*)(UP + (size_t)t * 5632 + ch);
      const u32x4 c2 = *(const u32x4*)(UP + (size_t)t * 5632 + 2816 + ch);
      float o[8];
#pragma unroll
      for (int j = 0; j < 8; ++j) {
        const float gx = (j & 1) ? hi_f(a[j >> 1]) : lo_f(a[j >> 1]);
        const float vx = (j & 1) ? hi_f(c2[j >> 1]) : lo_f(c2[j >> 1]);
        const float ag = bg[j] + wg[0][j] * g2[j] + wg[1][j] * g1[j] + wg[2][j] * gx;
        const float av = bv[j] + wv[0][j] * v2[j] + wv[1][j] * v1[j] + wv[2][j] * vx;
        o[j] = silu_f(ag) * av;
        g2[j] = g1[j]; g1[j] = gx; v2[j] = v1[j]; v1[j] = vx;
      }
      u32x4 pk; pk[0] = pack2(o[0], o[1]); pk[1] = pack2(o[2], o[3]); pk[2] = pack2(o[4], o[5]); pk[3] = pack2(o[6], o[7]);
      *(u32x4*)(ACT + (size_t)t * 2816 + ch) = pk;
    }
  }
}

DEV void phase_down(const Params& p, int b, char* smem) {
  const int tid = get_tid(), lane = tid & 63, w = tid >> 6, wm = w >> 1, wn = w & 1, r = lane & 31, h = lane >> 5;
  for (int it = get_bid(); it < 64 * 8; it += gridDim.x) {
    const int nt = it / 64, mt = it % 64;
    f32x16 acc[2][2];
#pragma unroll
    for (int mi = 0; mi < 2; ++mi)
#pragma unroll
      for (int ni = 0; ni < 2; ++ni) acc[mi][ni] = zero16();
    gemm_tile<2>(acc, (const u16*)(p.ws + OFF_ACT), 2816, NMETA + mt * 128, L - 1, (const u16*)(p.ws + OFF_WDOWN), 2816, nt * 128, 2816, smem);
#pragma unroll
    for (int mi = 0; mi < 2; ++mi)
#pragma unroll
      for (int ni = 0; ni < 2; ++ni)
#pragma unroll
        for (int i = 0; i < 16; ++i) {
          const int rr = mt * 128 + wm * 64 + mi * 32 + acc_row(i, h);
          const size_t idx = ((size_t)b * SEQ + rr) * 1024 + nt * 128 + wn * 64 + ni * 32 + r;
          p.out[idx] += acc[mi][ni][i];
        }
  }
}

DEV void phase_final_norm(const Params& p, int b) {
  const int lane = get_tid() & 63, w = get_tid() >> 6;
  for (int it = get_bid(); it < SEQ / 4; it += nworkers()) {
    const int rr = it * 4 + w;
    rmsnorm_row_f32_inplace(p.out + ((size_t)b * SEQ + rr) * D, p.in[18], lane);
  }
}


DEV u32x4 add_bf16x8(u32x4 a, u32x4 b) {
  u32x4 o;
#pragma unroll
  for (int j = 0; j < 4; ++j) o[j] = pack2(lo_f(a[j]) + lo_f(b[j]), hi_f(a[j]) + hi_f(b[j]));
  return o;
}
template <int NJ, bool ADD2 = false>
DEV void gemm_tile8(f32x4 (&acc)[4][NJ], const u16* __restrict__ A, int lda, int arow0, int arow_max,
                    const u16* __restrict__ B, int ldb, int brow0, int K, char* smem, const u16* __restrict__ A2 = nullptr) {
  constexpr int BN = NJ * 32;
  constexpr int BCH = BN / 64;
  constexpr int STAGE = (256 + BN) * 64;
  u16* S = (u16*)smem;
  const int tid = get_tid8(), lane = tid & 63, w = tid >> 6, wm = w >> 1, wn = w & 1;
  u32x4 ra[4], rb[BCH], ra2[ADD2 ? 4 : 1];
  unsigned aoff[4], boff[BCH];
  const char* Ab = (const char*)A;
  const char* Ab2 = (const char*)A2;
  const char* Bb = (const char*)(B + (size_t)brow0 * ldb);
  const int crow = tid >> 3, kc = tid & 7;
  const unsigned sto = (unsigned)(crow * 64 + ((kc ^ ((crow >> 1) & 7)) * 8));
#pragma unroll
  for (int i = 0; i < 4; ++i) {
    int gr = arow0 + crow + i * 64; gr = gr > arow_max ? arow_max : gr; gr = gr < 0 ? 0 : gr;
    aoff[i] = ((unsigned)gr * (unsigned)lda + kc * 8) * 2u;
  }
#pragma unroll
  for (int i = 0; i < BCH; ++i) boff[i] = ((unsigned)(crow + i * 64) * (unsigned)ldb + kc * 8) * 2u;
  const int fr = lane & 15, swz = fr >> 1, cq = lane >> 4;
  const unsigned fa = (unsigned)((wm * 64 + fr) * 64), fb = (unsigned)((256 + wn * (NJ * 16) + fr) * 64);
  const unsigned c0 = (unsigned)(((cq) ^ swz) * 8), c1 = (unsigned)(((4 + cq) ^ swz) * 8);
  const int nk = K >> 6;
#pragma unroll
  for (int i = 0; i < 4; ++i) { ra[i] = *(const u32x4*)(Ab + aoff[i]); if (ADD2) ra2[i] = *(const u32x4*)(Ab2 + aoff[i]); }
#pragma unroll
  for (int i = 0; i < BCH; ++i) rb[i] = *(const u32x4*)(Bb + boff[i]);
#pragma unroll
  for (int i = 0; i < 4; ++i) *(u32x4*)(S + sto + i * 64 * 64) = ADD2 ? add_bf16x8(ra[i], ra2[i]) : ra[i];
#pragma unroll
  for (int i = 0; i < BCH; ++i) *(u32x4*)(S + sto + (256 + i * 64) * 64) = rb[i];
  if (nk > 1) {
#pragma unroll
    for (int i = 0; i < 4; ++i) { ra[i] = *(const u32x4*)(Ab + aoff[i] + 128); if (ADD2) ra2[i] = *(const u32x4*)(Ab2 + aoff[i] + 128); }
#pragma unroll
    for (int i = 0; i < BCH; ++i) rb[i] = *(const u32x4*)(Bb + boff[i] + 128);
  }
  __syncthreads();
  for (int kt = 0; kt < nk; ++kt) {
    const u16* Sc = S + (kt & 1) * STAGE;
    {
      bf16x8 a[4], b[NJ];
#pragma unroll
      for (int m = 0; m < 4; ++m) a[m] = *(const bf16x8*)(Sc + fa + m * 16 * 64 + c0);
#pragma unroll
      for (int n = 0; n < NJ; ++n) b[n] = *(const bf16x8*)(Sc + fb + n * 16 * 64 + c0);
      __builtin_amdgcn_s_setprio(1);
#pragma unroll
      for (int m = 0; m < 4; ++m)
#pragma unroll
        for (int n = 0; n < NJ; ++n) acc[m][n] = __builtin_amdgcn_mfma_f32_16x16x32_bf16(a[m], b[n], acc[m][n], 0, 0, 0);
      __builtin_amdgcn_s_setprio(0);
    }
    bf16x8 a1[4], b1[NJ];
#pragma unroll
    for (int m = 0; m < 4; ++m) a1[m] = *(const bf16x8*)(Sc + fa + m * 16 * 64 + c1);
#pragma unroll
    for (int n = 0; n < NJ; ++n) b1[n] = *(const bf16x8*)(Sc + fb + n * 16 * 64 + c1);
    if (kt + 1 < nk) {
      u16* Aw = S + ((kt + 1) & 1) * STAGE;
#pragma unroll
      for (int i = 0; i < 4; ++i) *(u32x4*)(Aw + sto + i * 64 * 64) = ADD2 ? add_bf16x8(ra[i], ra2[i]) : ra[i];
#pragma unroll
      for (int i = 0; i < BCH; ++i) *(u32x4*)(Aw + sto + (256 + i * 64) * 64) = rb[i];
      if (kt + 2 < nk) {
        const unsigned ko = (unsigned)(kt + 2) * 128u;
#pragma unroll
        for (int i = 0; i < 4; ++i) { ra[i] = *(const u32x4*)(Ab + aoff[i] + ko); if (ADD2) ra2[i] = *(const u32x4*)(Ab2 + aoff[i] + ko); }
#pragma unroll
        for (int i = 0; i < BCH; ++i) rb[i] = *(const u32x4*)(Bb + boff[i] + ko);
      }
    }
    {
      __builtin_amdgcn_s_setprio(1);
#pragma unroll
      for (int m = 0; m < 4; ++m)
#pragma unroll
        for (int n = 0; n < NJ; ++n) acc[m][n] = __builtin_amdgcn_mfma_f32_16x16x32_bf16(a1[m], b1[n], acc[m][n], 0, 0, 0);
      __builtin_amdgcn_s_setprio(0);
    }
    __syncthreads();
  }
}

DEV f32x4 thin16(const u16* __restrict__ A, int lda, int row0, const u16* __restrict__ BT, int ldb, int col0, int K, int lane) {
  const u16* ap = A + (size_t)(row0 + (lane & 15)) * lda + 8 * (lane >> 4);
  const u16* bp = BT + (size_t)(col0 + (lane & 15)) * ldb + 8 * (lane >> 4);
  f32x4 acc = {0.f, 0.f, 0.f, 0.f};
  for (int k0 = 0; k0 < K; k0 += 128) {
    bf16x8 a[4], b[4];
#pragma unroll
    for (int j = 0; j < 4; ++j) { a[j] = *(const bf16x8*)(ap + k0 + j * 32); b[j] = *(const bf16x8*)(bp + k0 + j * 32); }
#pragma unroll
    for (int j = 0; j < 4; ++j) acc = __builtin_amdgcn_mfma_f32_16x16x32_bf16(a[j], b[j], acc, 0, 0, 0);
  }
  return acc;
}

DEV int tile_index(int k) { const int G = gridDim.x, rb = get_rbid(); return k * G + (rb & 7) * (G >> 3) + (rb >> 3); }
DEV void tile_decode(int T, int MT, int NT, int& mt, int& nt) {
  const int per = MT * 8;
  const int nb = T / per, rem = T - nb * per;
  int width = NT - nb * 8; width = width > 8 ? 8 : width;
  mt = rem / width; nt = nb * 8 + (rem - mt * width);
}

#define ZERO_ACC(acc, NJ_) _Pragma("unroll") for (int m_ = 0; m_ < 4; ++m_) _Pragma("unroll") for (int n_ = 0; n_ < NJ_; ++n_) { acc[m_][n_][0] = 0.f; acc[m_][n_][1] = 0.f; acc[m_][n_][2] = 0.f; acc[m_][n_][3] = 0.f; }

constexpr int EPI_WAVE_BYTES = 17408;
#define EPI_FENCE() asm volatile("s_waitcnt lgkmcnt(0)" ::: "memory")
DEV void epi_store_bf16_128(const u16* reg, u16* __restrict__ dst, int ld, int trow, int col0, int lane) {
#pragma unroll
  for (int j = 0; j < 16; ++j) {
    const int row = (lane >> 4) + 4 * j, t = trow + row;
    const u32x4 v = *(const u32x4*)(reg + row * 136 + (lane & 15) * 8);
    if (t < L) *(u32x4*)(dst + (size_t)t * ld + col0 + (lane & 15) * 8) = v;
  }
}

DEV void phase_inproj8(const Params& p, int b, char* smem) {
  const u16* U = (const u16*)((char*)p.out + OUT_HALF);
  const u16* WT = (const u16*)(p.ws + OFF_S1);
  const int MT = 33, NT = 53;
  for (int kk = 0;; ++kk) {
    const int it = tile_index(kk);
    if (it >= MT * NT) break;
    int mt, nt; tile_decode(it, MT, NT, mt, nt);
    f32x4 acc[4][8];
    ZERO_ACC(acc, 8)
    gemm_tile8<8>(acc, U, 1024, mt * 256, L - 1, WT, 1024, nt * 256, 1024, smem);
    const int tid = get_tid8(), lane = tid & 63, w = tid >> 6, wm = w >> 1, wn = w & 1, r = lane & 31, h = lane >> 5;
    u16* reg = (u16*)(smem + w * EPI_WAVE_BYTES);
    const int n0 = nt * 256;
    const int trow = mt * 256 + wm * 64;
    if (nt >= 20 && nt < 28) {
      const bool isk = nt >= 24;
      const int cq = n0 - (isk ? 6144 : 5120);
      const float sc = isk ? 0.0625f : 1.f;
      u16* dst = (u16*)(p.ws + (isk ? OFF_K : OFF_Q));
#pragma unroll
      for (int pr = 0; pr < 4; ++pr) {
        const int n1 = 4 * (pr >> 1) + (pr & 1);
        const int jf = (wn * 2 + (pr >> 1)) * 32 + (pr & 1) * 16 + (lane & 15);
        const float invf_rev = exp2f(-(float)jf * 0.10462765653f) * 0.15915494309189535f;
#pragma unroll
        for (int m = 0; m < 4; ++m)
#pragma unroll
          for (int j = 0; j < 4; ++j) {
            const int row = m * 16 + (lane >> 4) * 4 + j;
            const float tf = (float)(trow + row);
            const float ph = tf * invf_rev, pl = fmaf(tf, invf_rev, -ph);
            const float fr = (ph - floorf(ph)) + pl;
            const float sn = __builtin_amdgcn_sinf(fr), cs = __builtin_amdgcn_cosf(fr);
            const float x1 = acc[m][n1][j], x2 = acc[m][n1 + 2][j];
            reg[row * 136 + n1 * 16 + (lane & 15)] = f2bf((x1 * cs - x2 * sn) * sc);
            reg[row * 136 + n1 * 16 + 32 + (lane & 15)] = f2bf((x2 * cs + x1 * sn) * sc);
          }
      }
      EPI_FENCE();
      epi_store_bf16_128(reg, dst, 1024, trow, cq + wn * 128, lane);
    } else if (nt == 52) {
      float* DT = (float*)(p.ws + OFF_DT);
      if (wn == 0) {
#pragma unroll
        for (int n = 0; n < 2; ++n) {
          const int col = n * 16 + (lane & 15);
          const float bias = p.in[6][col];
#pragma unroll
          for (int m = 0; m < 4; ++m)
#pragma unroll
            for (int j = 0; j < 4; ++j) {
              const int t = trow + m * 16 + (lane >> 4) * 4 + j;
              if (t < L) {
                const float x = acc[m][n][j] + bias;
                const float e = __expf(x);
                DT[(size_t)t * 32 + col] = (x > 20.f) ? x : (e < 0.01f ? e * (1.f - 0.5f * e + e * e * (1.f / 3.f)) : __logf(1.f + e));
              }
            }
        }
      }
    } else {
      u16* dst; int ld, c0; bool sig = false;
      if (nt < 8) { dst = (u16*)(p.ws + OFF_Z); ld = 2048; c0 = n0; }
      else if (nt < 20) { dst = (u16*)(p.ws + OFF_XBC); ld = 3072; c0 = n0 - 2048; }
      else if (nt < 36) { dst = (u16*)(p.ws + OFF_V); ld = 2048; c0 = n0 - 7168; }
      else if (nt < 44) { dst = (u16*)(p.ws + OFF_G); ld = 2048; c0 = n0 - 9216; }
      else if (nt < 48) { dst = (u16*)(p.ws + OFF_GS); ld = 1024; c0 = n0 - 11264; sig = true; }
      else { dst = (u16*)(p.ws + OFF_GR); ld = 1024; c0 = n0 - 12288; sig = true; }
#pragma unroll
      for (int m = 0; m < 4; ++m)
#pragma unroll
        for (int n = 0; n < 8; ++n)
#pragma unroll
          for (int j = 0; j < 4; ++j) {
            float v = acc[m][n][j];
            if (sig) v = sigmoid_f(v);
            reg[(m * 16 + (lane >> 4) * 4 + j) * 136 + n * 16 + (lane & 15)] = f2bf(v);
          }
      EPI_FENCE();
      epi_store_bf16_128(reg, dst, ld, trow, c0 + wn * 128, lane);
    }
    __syncthreads();
  }
}

DEV void phase_merge8(const Params& p, char* smem, char* smem_team) {
  u16* GS = (u16*)(p.ws + OFF_GS);
  u16* GR = (u16*)(p.ws + OFF_GR);
  const u16* Zb = (const u16*)(p.ws + OFF_Z);
  const u16* Gb = (const u16*)(p.ws + OFF_G);
  const u16* WBS = (const u16*)(p.ws + OFF_S2);
  const u16* WBR = (const u16*)(p.ws + OFF_S2 + 4194304);
  for (int kk = 0;; ++kk) {
    const int it = tile_index(kk);
    if (it >= 256) break;
    const int branch = it >> 7, tl = it & 127, mt = tl >> 2, nt = tl & 3;
    f32x4 acc[4][8];
    ZERO_ACC(acc, 8)
    gemm_tile8<8>(acc, branch ? Gb : Zb, 2048, mt * 256, L - 1, branch ? WBR : WBS, 2048, nt * 256, 2048, smem);
    const int tid = get_tid8(), lane = tid & 63, w = tid >> 6, wm = w >> 1, wn = w & 1;
    float* reg = (float*)(smem + w * EPI_WAVE_BYTES);
    u16* GT = branch ? GR : GS;
#pragma unroll
    for (int hf = 0; hf < 2; ++hf) {
#pragma unroll
      for (int m = 0; m < 4; ++m)
#pragma unroll
        for (int n = 0; n < 4; ++n)
#pragma unroll
          for (int j = 0; j < 4; ++j) reg[(m * 16 + (lane >> 4) * 4 + j) * 68 + n * 16 + (lane & 15)] = acc[m][hf * 4 + n][j];
      EPI_FENCE();
#pragma unroll
      for (int j = 0; j < 16; ++j) {
        const int row = (lane >> 4) + 4 * j, c4 = (lane & 15) * 4;
        const f32x4 a = *(const f32x4*)(reg + row * 68 + c4);
        const size_t idx = (size_t)(mt * 256 + wm * 64 + row) * 1024 + nt * 256 + wn * 128 + hf * 64 + c4;
        const u32x2 g = *(const u32x2*)(GT + idx);
        u32x2 o; o[0] = pack2(lo_f(g[0]) * a[0], hi_f(g[0]) * a[1]); o[1] = pack2(lo_f(g[1]) * a[2], hi_f(g[1]) * a[3]);
        *(u32x2*)(GT + idx) = o;
      }
      EPI_FENCE();
    }
    __syncthreads();
  }
  for (int ct = get_rbid(); ct < 128; ct += gridDim.x) {
    const int tid = get_tid8(), lane = tid & 63, w = tid >> 6;
    const int branch = ct >> 6, c16 = ct & 63;
    f32x4* red = (f32x4*)smem;
    red[w * 64 + lane] = thin16((branch ? Gb : Zb) + w * 256, 2048, 8192, (branch ? WBR : WBS) + w * 256, 2048, c16 * 16, 256, lane);
    __syncthreads();
    if (w == 0) {
      u16* GT = branch ? GR : GS;
      f32x4 a1 = red[lane];
#pragma unroll
      for (int q = 1; q < 8; ++q) a1 += red[q * 64 + lane];
#pragma unroll
      for (int j = 0; j < 4; ++j) {
        const size_t idx = (size_t)(8192 + (lane >> 4) * 4 + j) * 1024 + c16 * 16 + (lane & 15);
        GT[idx] = f2bf(bf2f(GT[idx]) * a1[j]);
      }
    }
    __syncthreads();
  }
  {
    float* RSS = (float*)(p.ws + OFF_RSS);
    for (int i = get_bid() * 256 + get_tid(); i < L; i += nworkers() * 256) RSS[i] = 0.f;
  }
  const int n_wout = 16 * 16, n_wup = 16 * 88, n_wdown = 44 * 16;
  for (int it = get_bid(); it < n_wout + n_wup + n_wdown; it += nworkers()) {
    if (it < n_wout) { convert_tile(p.in[12], 1024, 1024, (u16*)(p.ws + OFF_WOUT), it & 15, it >> 4, 0, smem_team); }
    else if (it < n_wout + n_wup) { const int j = it - n_wout; convert_tile(p.in[14], 5632, 1024, (u16*)(p.ws + OFF_WUP), j & 15, j >> 4, 2, smem_team, p.in[13]);   }
    else { const int j = it - n_wout - n_wup; convert_tile(p.in[17], 1024, 2816, (u16*)(p.ws + OFF_WDOWN), j % 44, j / 44, 0, smem_team); }
  }
}

DEV void phase_outproj8(const Params& p, int b, char* smem) {
  const int tid = get_tid8(), lane = tid & 63, w = tid >> 6, wm = w >> 1, wn = w & 1, r = lane & 31, h = lane >> 5;
  u16* U2 = (u16*)(p.ws + OFF_U2);
  float* RSS = (float*)(p.ws + OFF_RSS);
  const u16* Mg = (const u16*)(p.ws + OFF_GS);
  const u16* WO = (const u16*)(p.ws + OFF_WOUT);
  float* reg = (float*)(smem + w * EPI_WAVE_BYTES);
  for (int kk = 0;; ++kk) {
    const int it = tile_index(kk);
    if (it >= 256) break;
    const int mt = it >> 3, nt = it & 7;
    f32x4 acc[4][4];
    ZERO_ACC(acc, 4)
    gemm_tile8<4, true>(acc, Mg, 1024, mt * 256, L - 1, WO, 1024, nt * 128, 1024, smem, (const u16*)(p.ws + OFF_GR));
#pragma unroll
    for (int m = 0; m < 4; ++m)
#pragma unroll
      for (int n = 0; n < 4; ++n)
#pragma unroll
        for (int j = 0; j < 4; ++j) reg[(m * 16 + (lane >> 4) * 4 + j) * 68 + n * 16 + (lane & 15)] = acc[m][n][j];
    EPI_FENCE();
#pragma unroll
    for (int j = 0; j < 16; ++j) {
      const int row = (lane >> 4) + 4 * j, c4 = (lane & 15) * 4;
      const f32x4 a = *(const f32x4*)(reg + row * 68 + c4);
      const int t = mt * 256 + wm * 64 + row, col = nt * 128 + wn * 64 + c4;
      f32x4 hv;
      if (t < NMETA) {
        hv = *(const f32x4*)(p.in[1] + t * 1024 + col) + a;
      } else {
        const size_t idx = ((size_t)b * SEQ + (t - NMETA)) * 1024 + col;
        hv = *(const f32x4*)(p.in[0] + idx) + a;
        *(f32x4*)(p.out + idx) = hv;
      }
      u32x2 hb; hb[0] = pack2(hv[0], hv[1]); hb[1] = pack2(hv[2], hv[3]);
      *(u32x2*)(U2 + (size_t)t * 1024 + col) = hb;
      float sq = hv[0] * hv[0] + hv[1] * hv[1] + hv[2] * hv[2] + hv[3] * hv[3];
      sq += __shfl_xor(sq, 1); sq += __shfl_xor(sq, 2); sq += __shfl_xor(sq, 4); sq += __shfl_xor(sq, 8);
      if ((lane & 15) == 0) atomicAdd(&RSS[t], sq);
    }
    __syncthreads();
  }
  for (int ct = get_rbid(); ct < 64; ct += gridDim.x) {
    const int tid = get_tid8(), lane = tid & 63, w = tid >> 6;
    f32x4* red = (f32x4*)smem;
    red[w * 64 + lane] = thin16(Mg + w * 128, 1024, 8192, WO + w * 128, 1024, ct * 16, 128, lane)
                       + thin16((const u16*)(p.ws + OFF_GR) + w * 128, 1024, 8192, WO + w * 128, 1024, ct * 16, 128, lane);
    __syncthreads();
    if (w == 0) {
      f32x4 a1 = red[lane];
#pragma unroll
      for (int q = 1; q < 8; ++q) a1 += red[q * 64 + lane];
#pragma unroll
      for (int j = 0; j < 4; ++j) {
        const int t = 8192 + (lane >> 4) * 4 + j;
        const size_t idx = ((size_t)b * SEQ + (t - NMETA)) * 1024 + ct * 16 + (lane & 15);
        const float hv = p.in[0][idx] + a1[j];
        p.out[idx] = hv;
        U2[(size_t)t * 1024 + ct * 16 + (lane & 15)] = f2bf(hv);
        float sq = hv * hv;
        sq += __shfl_xor(sq, 1); sq += __shfl_xor(sq, 2); sq += __shfl_xor(sq, 4); sq += __shfl_xor(sq, 8);
        if ((lane & 15) == 0) atomicAdd(&RSS[t], sq);
      }
    }
    __syncthreads();
  }
}

DEV void phase_up8(const Params& p, char* smem) {
  u16* ACT = (u16*)(p.ws + OFF_ACT);
  const float* cw = p.in[15];
  const float* cbias = p.in[16];
  for (int kk = 0;; ++kk) {
    const int it = tile_index(kk);
    if (it >= 33 * 22) break;
    int mt, nt; tile_decode(it, 33, 22, mt, nt);
    f32x4 acc[4][8];
    ZERO_ACC(acc, 8)
    gemm_tile8<8>(acc, (const u16*)(p.ws + OFF_U2), 1024, mt * 254 - 2, L - 1, (const u16*)(p.ws + OFF_WUP), 1024, nt * 256, 1024, smem);
    const int tid = get_tid8(), lane = tid & 63, w = tid >> 6;
    u16* reg = (u16*)(smem + w * EPI_WAVE_BYTES);
    {
      const float* RSS = (const float*)(p.ws + OFF_RSS);
      const int wm = w >> 1;
#pragma unroll
      for (int m = 0; m < 4; ++m)
#pragma unroll
        for (int j = 0; j < 4; ++j) {
          int t = mt * 254 - 2 + wm * 64 + m * 16 + (lane >> 4) * 4 + j; t = t < 0 ? 0 : (t > L - 1 ? L - 1 : t);
          const float rstd = rsqrtf(RSS[t] * (1.f / 1024.f) + EPS);
#pragma unroll
          for (int n = 0; n < 8; ++n) reg[(m * 16 + (lane >> 4) * 4 + j) * 136 + n * 16 + (lane & 15)] = f2bf(acc[m][n][j] * rstd);
        }
    }
    __syncthreads();
    {
      const int cg = tid & 15, rg = tid >> 4;
      const int ch = nt * 128 + cg * 8;
      float wg[3][8], wv[3][8], bg[8], bv[8], g2[8], g1[8], v2[8], v1[8];
#pragma unroll
      for (int k = 0; k < 3; ++k) {
        const f32x4 a0 = *(const f32x4*)(cw + k * 5632 + ch), a1 = *(const f32x4*)(cw + k * 5632 + ch + 4);
        const f32x4 c0 = *(const f32x4*)(cw + k * 5632 + 2816 + ch), c1 = *(const f32x4*)(cw + k * 5632 + 2816 + ch + 4);
#pragma unroll
        for (int j = 0; j < 4; ++j) { wg[k][j] = a0[j]; wg[k][4 + j] = a1[j]; wv[k][j] = c0[j]; wv[k][4 + j] = c1[j]; }
      }
      {
        const f32x4 a0 = *(const f32x4*)(cbias + ch), a1 = *(const f32x4*)(cbias + ch + 4);
        const f32x4 c0 = *(const f32x4*)(cbias + 2816 + ch), c1 = *(const f32x4*)(cbias + 2816 + ch + 4);
#pragma unroll
        for (int j = 0; j < 4; ++j) { bg[j] = a0[j]; bg[4 + j] = a1[j]; bv[j] = c0[j]; bv[4 + j] = c1[j]; }
      }
      const int R0 = rg * 8;
#pragma unroll
      for (int q = 0; q < 2; ++q) {
        const int R = R0 - 2 + q;
        u32x4 gvv = {0u, 0u, 0u, 0u}, vvv = {0u, 0u, 0u, 0u};
        if (R >= 0 && mt * 254 - 2 + R >= 0) {
          const char* sl = smem + ((R >> 6) * 2) * EPI_WAVE_BYTES + ((R & 63) * 136 + cg * 8) * 2;
          gvv = *(const u32x4*)sl; vvv = *(const u32x4*)(sl + EPI_WAVE_BYTES);
        }
#pragma unroll
        for (int j = 0; j < 4; ++j) {
          if (q == 0) { g2[2 * j] = lo_f(gvv[j]); g2[2 * j + 1] = hi_f(gvv[j]); v2[2 * j] = lo_f(vvv[j]); v2[2 * j + 1] = hi_f(vvv[j]); }
          else { g1[2 * j] = lo_f(gvv[j]); g1[2 * j + 1] = hi_f(gvv[j]); v1[2 * j] = lo_f(vvv[j]); v1[2 * j + 1] = hi_f(vvv[j]); }
        }
      }
#pragma unroll 2
      for (int i = 0; i < 8; ++i) {
        const int R = R0 + i, t = mt * 254 - 2 + R;
        u32x4 gvv = {0u, 0u, 0u, 0u}, vvv = {0u, 0u, 0u, 0u};
        if (t >= 0) {
          const char* sl = smem + ((R >> 6) * 2) * EPI_WAVE_BYTES + ((R & 63) * 136 + cg * 8) * 2;
          gvv = *(const u32x4*)sl; vvv = *(const u32x4*)(sl + EPI_WAVE_BYTES);
        }
        float o[8];
#pragma unroll
        for (int j = 0; j < 8; ++j) {
          const float gx = (j & 1) ? hi_f(gvv[j >> 1]) : lo_f(gvv[j >> 1]);
          const float vx = (j & 1) ? hi_f(vvv[j >> 1]) : lo_f(vvv[j >> 1]);
          const float ag = bg[j] + wg[0][j] * g2[j] + wg[1][j] * g1[j] + wg[2][j] * gx;
          const float av = bv[j] + wv[0][j] * v2[j] + wv[1][j] * v1[j] + wv[2][j] * vx;
          o[j] = silu_f(ag) * av;
          g2[j] = g1[j]; g1[j] = gx; v2[j] = v1[j]; v1[j] = vx;
        }
        if (R >= 2 && t < L) {
          u32x4 pk; pk[0] = pack2(o[0], o[1]); pk[1] = pack2(o[2], o[3]); pk[2] = pack2(o[4], o[5]); pk[3] = pack2(o[6], o[7]);
          *(u32x4*)(ACT + (size_t)t * 2816 + ch) = pk;
        }
      }
    }
    __syncthreads();
  }
}

DEV void phase_down8(const Params& p, int b, char* smem) {
  for (int kk = 0;; ++kk) {
    const int it = tile_index(kk);
    if (it >= 256) break;
    const int mt = it >> 3, nt = it & 7;
    f32x4 acc[4][4];
    ZERO_ACC(acc, 4)
    gemm_tile8<4>(acc, (const u16*)(p.ws + OFF_ACT), 2816, NMETA + mt * 256, L - 1, (const u16*)(p.ws + OFF_WDOWN), 2816, nt * 128, 2816, smem);
    const int tid = get_tid8(), lane = tid & 63, w = tid >> 6, wm = w >> 1, wn = w & 1, r = lane & 31, h = lane >> 5;
    float* reg = (float*)(smem + w * EPI_WAVE_BYTES);
#pragma unroll
    for (int m = 0; m < 4; ++m)
#pragma unroll
      for (int n = 0; n < 4; ++n)
#pragma unroll
        for (int j = 0; j < 4; ++j) reg[(m * 16 + (lane >> 4) * 4 + j) * 68 + n * 16 + (lane & 15)] = acc[m][n][j];
    EPI_FENCE();
#pragma unroll
    for (int j = 0; j < 16; ++j) {
      const int row = (lane >> 4) + 4 * j, c4 = (lane & 15) * 4;
      const f32x4 a = *(const f32x4*)(reg + row * 68 + c4);
      const size_t idx = ((size_t)b * SEQ + mt * 256 + wm * 64 + row) * 1024 + nt * 128 + wn * 64 + c4;
      const f32x4 x = *(const f32x4*)(p.out + idx);
      *(f32x4*)(p.out + idx) = x + a;
    }
    __syncthreads();
  }
}

#define XB_TMO      128
#define XB_XCNT(j)  (256  + 64 * (j))
#define XB_XSUB(j)  (1280 + 64 * (j))
#define XB_XGEN(j)  (2304 + 64 * (j))
#define XB_TOP      3328
#define XB_TOPGEN   3392
#define XCD_BAR_WORDS 3456
#define XB_SPIN_CAP (1u << 24)
DEV unsigned xb_ld(unsigned* p)              { return __hip_atomic_load(p, __ATOMIC_RELAXED, __HIP_MEMORY_SCOPE_AGENT); }
DEV unsigned xb_add(unsigned* p, unsigned v) { return __hip_atomic_fetch_add(p, v, __ATOMIC_RELAXED, __HIP_MEMORY_SCOPE_AGENT); }
DEV unsigned xb_xcc_id() { return (unsigned)__builtin_amdgcn_s_getreg((3 << 11) | 20) & 0xFu; }
#define XB_SPIN(cond, bar) do { unsigned _sp = 0; while (cond) { __builtin_amdgcn_s_sleep(1); \
    if ((++_sp & 255u) == 0u) { if (xb_ld(&(bar)[XB_TMO])) break; if (_sp > XB_SPIN_CAP) { atomicAdd(&(bar)[XB_TMO], 1u); break; } } } } while (0)
struct XcdBarrier { unsigned* bar; unsigned x; volatile LDSP unsigned* st; };
DEV XcdBarrier xcd_barrier_post(unsigned* bar, volatile LDSP unsigned* st) {
  XcdBarrier b; b.bar = bar; b.x = xb_xcc_id(); b.st = st;
  if (threadIdx.x == 0) (void)xb_add(&bar[XB_XCNT(b.x)], 1u);
  return b;
}
DEV void xcd_barrier_complete(unsigned* bar, unsigned x, unsigned& nloc, unsigned& nx) {
  const unsigned G = gridDim.x * gridDim.y * gridDim.z;
  unsigned sum, cnt, mine, sp = 0u;
  for (;;) {
    sum = 0u; cnt = 0u; mine = 0u;
#pragma unroll
    for (unsigned j = 0; j < 16; ++j) { const unsigned c = xb_ld(&bar[XB_XCNT(j)]); sum += c; cnt += (c > 0u) ? 1u : 0u; mine = (j == x) ? c : mine; }
    if (sum == G) break;
    __builtin_amdgcn_s_sleep(1);
    if ((++sp & 255u) == 0u) { if (xb_ld(&bar[XB_TMO])) break; if (sp > XB_SPIN_CAP) { atomicAdd(&bar[XB_TMO], 1u); break; } }
  }
  nloc = mine > 0u ? mine : 1u; nx = cnt > 0u ? cnt : 1u;
}
DEV void xcd_barrier(const XcdBarrier& b) {
  asm volatile("s_waitcnt vmcnt(0)" ::: "memory");
  __syncthreads();
  if (threadIdx.x == 0) {
    unsigned* bar = b.bar;
    __builtin_amdgcn_s_waitcnt(0);
    unsigned nloc = b.st[0], nx = b.st[1];
    if (nloc == 0u) { xcd_barrier_complete(bar, b.x, nloc, nx); b.st[0] = nloc; b.st[1] = nx; }
    const unsigned old = xb_add(&bar[XB_XSUB(b.x)], 1u);
    const unsigned gen = old / nloc;
    if (old + 1u == (gen + 1u) * nloc) {
      __builtin_amdgcn_fence(__ATOMIC_RELEASE, "agent");
      asm volatile("s_waitcnt vmcnt(0)" ::: "memory");
      const unsigned og = xb_add(&bar[XB_TOP], 1u);
      const unsigned tg = og / nx;
      if (og + 1u == (tg + 1u) * nx) xb_add(&bar[XB_TOPGEN], 1u);
      else XB_SPIN(xb_ld(&bar[XB_TOPGEN]) == tg, bar);
      __builtin_amdgcn_fence(__ATOMIC_ACQUIRE, "agent");
      xb_add(&bar[XB_XGEN(b.x)], 1u);
      asm volatile("s_waitcnt vmcnt(0)" ::: "memory");
    } else {
      XB_SPIN(xb_ld(&bar[XB_XGEN(b.x)]) == gen, bar);
      __builtin_amdgcn_fence(__ATOMIC_ACQUIRE, "agent");
      asm volatile("s_waitcnt vmcnt(0)" ::: "memory");
    }
  }
  __syncthreads();
}

constexpr int N_PHASES = 19;

__global__ void __launch_bounds__(512) fwd_kernel(Params p, int ph0, int ph1) {
  __shared__ __attribute__((aligned(16))) char smem[SMEM_BYTES];
  __shared__ uint4 xb_words;
  if (threadIdx.x == 0) xb_words = make_uint4(0u, 0u, 0u, 0u);
  __syncthreads();
  XcdBarrier xb = xcd_barrier_post((unsigned*)(p.ws + OFF_BAR), (volatile LDSP unsigned*)&xb_words);
  if (ph1 < 0) cg::this_grid().sync();
  for (int ph = ph0; ph < ph1; ++ph) {
    char* tsm = smem + (get_tid8() >> 8) * SMEM_TEAM;
    const int b = ph >= 10 ? 1 : 0;
    const int lp = (ph == 0) ? 0 : (ph == 18 ? 9 : (ph >= 10 ? ph - 9 : ph));
    switch (lp) {
      case 0: phase_prep(p, 0, true, tsm); break;
      case 1: phase_inproj8(p, b, smem); break;
      case 2: {
        int it = get_bid();
        for (; it < 1024; it += nworkers()) ret_kv_item(p, it, tsm);
        for (; it < 2048; it += nworkers()) ssd_state_item(p, it - 1024, tsm);
      } break;
      case 3: phase_scan(p); break;
      case 4: {
        {
          const int rb0 = get_rbid(), rb = (rb0 & 7) * 32 + (rb0 >> 3), team = get_tid8() >> 8;
          for (int j = 0; j < 3; ++j) {
            int kind = -1, idx = 0;
            if (rb < 4) {
              const int q = rb * 3 + j;
              const int rt = (q < 2) ? 128 : ((q >> 1) - 1) * 4;
              kind = 0; idx = rt * 4 + (q & 1) * 2 + team;
            } else if (rb < 10) {
              if (j < 2) { kind = 1; idx = (246 + (rb - 4) * 2 + j) * 2 + team; }
            } else if (j < 2) {
              const int k = rb - 10, ri = k >> 1;
              const int rt = (ri < 12) ? ((ri / 3) * 4 + 1 + ri % 3) : (17 + ri - 12);
              kind = j; idx = (j == 0) ? (rt * 4 + (k & 1) * 2 + team) : (k * 2 + team);
            }
            if (kind == 0) ret_out_item(p, idx, tsm);
            else if (kind == 1) ssd_out_item(p, idx, tsm);
          }
        }
      } break;
      case 5: phase_merge8(p, smem, tsm); break;
      case 6: phase_outproj8(p, b, smem); break;
      case 7: phase_up8(p, smem); break;
      case 8: phase_down8(p, b, smem); break;
      case 9: {
        if (ph == 9) { phase_final_norm(p, 0); phase_prep(p, 1, false, tsm); }
        else phase_final_norm(p, 1);
      } break;
    }
    if (ph + 1 < ph1) xcd_barrier(xb);
  }
}

#ifndef MK_SINGLE
#define MK_SINGLE 1
#endif

extern "C" void kernel_launch(void* const* d_in, const int* in_sizes, int n_in, void* d_out, int out_size, void* d_ws, size_t ws_size,
                              hipStream_t stream) {
  static int grid_blocks = 0;
  if (!grid_blocks) {
    int dev = 0, cus = 0, per_cu = 0;
    hipGetDevice(&dev);
    hipDeviceGetAttribute(&cus, hipDeviceAttributeMultiprocessorCount, dev);
    hipOccupancyMaxActiveBlocksPerMultiprocessor(&per_cu, fwd_kernel, 512, 0);
    per_cu = 1;
    if (cus != 256) fprintf(stderr, "kernel_launch: built for a 256-CU device (static phase schedules assume 256 workgroups), found %d CUs\n", cus);
    cus = 256;
    grid_blocks = cus * per_cu;
  }
  Params p{};
  for (int i = 0; i < 19; ++i) p.in[i] = (const float*)d_in[i];
  p.out = (float*)d_out;
  p.ws = (char*)d_ws;
#if MK_SINGLE
  (void)hipMemsetAsync((char*)d_ws + OFF_BAR, 0, XCD_BAR_WORDS * 4, stream);
  int ph0 = 0, ph1 = N_PHASES;
  void* args[] = {&p, &ph0, &ph1};
  hipError_t e = hipLaunchCooperativeKernel((void*)fwd_kernel, dim3(grid_blocks), dim3(512), args, 0, stream);
  if (e != hipSuccess) fprintf(stderr, "cooperative launch failed: %s (grid %d)\n", hipGetErrorString(e), grid_blocks);
#else
  for (int ph = 0; ph < N_PHASES; ++ph) {
    hipLaunchKernelGGL(fwd_kernel, dim3(grid_blocks), dim3(512), 0, stream, p, ph, ph + 1);
  }
#endif
}
```

```cpp
#include <hip/hip_runtime.h>
#include <hip/hip_cooperative_groups.h>
#include <cstdio>
namespace cg = cooperative_groups;

typedef unsigned short u16;
typedef __bf16 bf16x8 __attribute__((ext_vector_type(8)));
typedef short s16x4 __attribute__((ext_vector_type(4)));
typedef short s16x8 __attribute__((ext_vector_type(8)));
typedef float f32x16 __attribute__((ext_vector_type(16)));
typedef unsigned int u32x4 __attribute__((ext_vector_type(4)));
typedef unsigned int u32x2 __attribute__((ext_vector_type(2)));
typedef float f32x4 __attribute__((ext_vector_type(4)));

#define DEV __device__ __forceinline__
#define LDSP __attribute__((address_space(3)))

constexpr int D = 1024;
constexpr int L = 8208;
constexpr int SEQ = 8192;
constexpr int NMETA = 16;
constexpr int NPROJ = 13344;
constexpr int NPROJ_PAD = 13568;
constexpr int DFF = 2816;
constexpr float EPS = 1e-6f;

constexpr size_t OFF_Z = 0;
constexpr size_t OFF_G = 33619968;
constexpr size_t OFF_GS = 67239936;
constexpr size_t OFF_GR = 84049920;
constexpr size_t OFF_Q = 100859904;
constexpr size_t OFF_XBC = 117669888;
constexpr size_t OFF_K = 168099840;
constexpr size_t OFF_V = 184909824;
constexpr size_t OFF_DT = 218529792;
constexpr size_t OFF_S2 = 219580416;
constexpr size_t OFF_S1 = 227969024;
constexpr size_t OFF_CD = 261523456;
constexpr size_t OFF_HM = 261531648;
constexpr size_t OFF_BAR = 261597184;
constexpr size_t OFF_RSS = 261611520;
constexpr size_t OFF_WOUT = OFF_S1;
constexpr size_t OFF_WUP = OFF_S1 + 2097152;
constexpr size_t OFF_WDOWN = OFF_S1 + 13631488;
constexpr size_t OFF_UP = OFF_XBC;
constexpr size_t OFF_ACT = OFF_Z;
constexpr size_t OFF_U2 = OFF_Q;
constexpr size_t OUT_HALF = 33554432;

constexpr int SMEM_TEAM = 73728;
constexpr int SMEM_BYTES = 2 * SMEM_TEAM;

struct Params {
  const float* in[19];
  float* out;
  char* ws;
};

DEV int get_tid8() { int t = threadIdx.x; asm volatile("" : "+v"(t)); return t; }
DEV int get_tid() { int t = threadIdx.x & 255; asm volatile("" : "+v"(t)); return t; }
DEV int get_rbid() { int t = blockIdx.x; asm volatile("" : "+s"(t)); return t; }
DEV int get_bid() { int t = get_rbid() * 2 + (get_tid8() >> 8); return __builtin_amdgcn_readfirstlane(t); }
DEV int nworkers() { return (int)gridDim.x * 2; }
DEV float bf2f(u16 h) { return __uint_as_float(((unsigned)h) << 16); }
typedef __bf16 bf16x2_t __attribute__((ext_vector_type(2)));
typedef float f32x2_t __attribute__((ext_vector_type(2)));
DEV u16 f2bf(float f) { const __bf16 h = (__bf16)f; return __builtin_bit_cast(u16, h); }
DEV unsigned pack2(float a, float b) { const f32x2_t v = {a, b}; return __builtin_bit_cast(unsigned, __builtin_convertvector(v, bf16x2_t)); }
DEV float silu_f(float x) { return x * __builtin_amdgcn_rcpf(1.f + __expf(-x)); }
DEV float sigmoid_f(float x) { return __builtin_amdgcn_rcpf(1.f + __expf(-x)); }
DEV float lo_f(unsigned u) { return __uint_as_float(u << 16); }
DEV float hi_f(unsigned u) { return __uint_as_float(u & 0xffff0000u); }
DEV float wave_sum(float v) {
#pragma unroll
  for (int o = 32; o > 0; o >>= 1) v += __shfl_xor(v, o);
  return v;
}
DEV float half_sum(float v) {
#pragma unroll
  for (int o = 16; o > 0; o >>= 1) v += __shfl_xor(v, o);
  return v;
}
DEV float log_gamma(int h) {
  return h == 0 ? -0.0317486983145803f : (h == 1 ? -0.015748356968139168f : (h == 2 ? -0.007843177461025893f : -0.003913899321136329f));
}
DEV f32x16 mfma(bf16x8 a, bf16x8 b, f32x16 c) { return __builtin_amdgcn_mfma_f32_32x32x16_bf16(a, b, c, 0, 0, 0); }
DEV f32x16 zero16() { f32x16 z;
#pragma unroll
  for (int i = 0; i < 16; ++i) z[i] = 0.f;
  return z; }
DEV int acc_row(int i, int h) { return (i & 3) + 8 * (i >> 2) + 4 * h; }

DEV bf16x8 frag_tr(const u16* T, int ld, int k0, int x0, int lane) {
  const int h = lane >> 5, blk = (lane >> 4) & 1, q = (lane & 15) >> 2, pp = lane & 3;
  const u16* a0 = T + (k0 + 8 * h + q) * ld + x0 + 16 * blk + 4 * pp;
  s16x4 lo = __builtin_amdgcn_ds_read_tr16_b64_v4i16((LDSP s16x4*)a0);
  s16x4 hi = __builtin_amdgcn_ds_read_tr16_b64_v4i16((LDSP s16x4*)(a0 + 4 * ld));
  s16x8 v = {lo[0], lo[1], lo[2], lo[3], hi[0], hi[1], hi[2], hi[3]};
  return __builtin_bit_cast(bf16x8, v);
}
DEV bf16x8 frag_row(const u16* T, int ld, int row, int k) {
  return *(const bf16x8*)(T + row * ld + k);
}

template <int MI>
DEV void gemm_tile(f32x16 (&acc)[MI][2], const u16* __restrict__ A, int lda, int arow0, int arow_max,
                   const u16* __restrict__ B, int ldb, int brow0, int K, char* smem) {
  constexpr int BM = MI * 64;
  constexpr int LD = 72;
  constexpr int ACH = BM * 8 / 256;
  u16* As = (u16*)smem;
  u16* Bs = As + BM * LD;
  const int tid = get_tid(), lane = tid & 63, w = tid >> 6, wm = w >> 1, wn = w & 1, r = lane & 31, h = lane >> 5;
  u32x4 ra[ACH], rb[4];
  const u16* ap[ACH];
  const u16* bp[4];
#pragma unroll
  for (int i = 0; i < ACH; ++i) {
    int c = tid + i * 256, row = c >> 3, kc = c & 7;
    int gr = arow0 + row; gr = gr > arow_max ? arow_max : gr;
    ap[i] = A + (size_t)gr * lda + kc * 8;
  }
#pragma unroll
  for (int i = 0; i < 4; ++i) {
    int c = tid + i * 256, row = c >> 3, kc = c & 7;
    bp[i] = B + (size_t)(brow0 + row) * ldb + kc * 8;
  }
#pragma unroll
  for (int i = 0; i < ACH; ++i) ra[i] = *(const u32x4*)(ap[i]);
#pragma unroll
  for (int i = 0; i < 4; ++i) rb[i] = *(const u32x4*)(bp[i]);
  const int nk = K >> 6;
  for (int kt = 0; kt < nk; ++kt) {
#pragma unroll
    for (int i = 0; i < ACH; ++i) { int c = tid + i * 256, row = c >> 3, kc = c & 7; *(u32x4*)(As + row * LD + kc * 8) = ra[i]; }
#pragma unroll
    for (int i = 0; i < 4; ++i) { int c = tid + i * 256, row = c >> 3, kc = c & 7; *(u32x4*)(Bs + row * LD + kc * 8) = rb[i]; }
    __syncthreads();
    if (kt + 1 < nk) {
#pragma unroll
      for (int i = 0; i < ACH; ++i) ra[i] = *(const u32x4*)(ap[i] + (kt + 1) * 64);
#pragma unroll
      for (int i = 0; i < 4; ++i) rb[i] = *(const u32x4*)(bp[i] + (kt + 1) * 64);
    }
#pragma unroll
    for (int ks = 0; ks < 4; ++ks) {
      bf16x8 a[MI], b[2];
#pragma unroll
      for (int mi = 0; mi < MI; ++mi) a[mi] = frag_row(As, LD, wm * MI * 32 + mi * 32 + r, ks * 16 + h * 8);
#pragma unroll
      for (int ni = 0; ni < 2; ++ni) b[ni] = frag_row(Bs, LD, wn * 64 + ni * 32 + r, ks * 16 + h * 8);
#pragma unroll
      for (int mi = 0; mi < MI; ++mi)
#pragma unroll
        for (int ni = 0; ni < 2; ++ni) acc[mi][ni] = mfma(a[mi], b[ni], acc[mi][ni]);
    }
    __syncthreads();
  }
}

DEV int orig_col(int n) {
  if (n < 5120) return n;
  if (n < 7168) {
    int q = n - 5120; int which = q >> 10; int c = q & 1023; int head = c >> 8; int ip = c & 255; int blk = ip >> 6; int wi = ip & 63;
    int j = (wi < 32) ? (blk * 32 + wi) : (128 + blk * 32 + wi - 32);
    return 5152 + which * 1024 + head * 256 + j;
  }
  if (n < 13312) return n + 32;
  if (n < 13344) return 5120 + (n - 13312);
  return -1;
}
DEV void convert_tile(const float* __restrict__ W, int Nsrc, int K, u16* __restrict__ WT, int kt, int ntile, int mode, char* smem, const float* __restrict__ kscale = nullptr) {
  float* t = (float*)smem;
  const int tid = get_tid();
  {
    const int tx = tid & 15, ty = tid >> 4;
    const int n = ntile * 64 + tx * 4;
    int on = n;
    if (mode == 1) on = orig_col(n);
    else if (mode == 2) { const int tl = n >> 8, wi = n & 255; on = (wi < 128) ? (tl * 128 + wi) : (2816 + tl * 128 + wi - 128); }
#pragma unroll
    for (int kk = ty; kk < 64; kk += 16) {
      f32x4 v = {0.f, 0.f, 0.f, 0.f};
      if (on >= 0) v = *(const f32x4*)(W + (size_t)(kt * 64 + kk) * Nsrc + on);
      if (kscale) v = v * kscale[kt * 64 + kk];
      *(f32x4*)(t + kk * 68 + tx * 4) = v;
    }
  }
  __syncthreads();
  {
    const int nn = tid >> 2, kq = (tid & 3) * 16;
    u32x4 o[2];
#pragma unroll
    for (int j = 0; j < 8; ++j) o[j >> 2][j & 3] = pack2(t[(kq + 2 * j) * 68 + nn], t[(kq + 2 * j + 1) * 68 + nn]);
    u16* d = WT + (size_t)(ntile * 64 + nn) * K + kt * 64 + kq;
    *(u32x4*)d = o[0]; *(u32x4*)(d + 8) = o[1];
  }
  __syncthreads();
}

DEV void rmsnorm_row_bf16(const float* __restrict__ src, const float* __restrict__ w, u16* __restrict__ dst, int lane) {
  f32x4 v[4]; float ss = 0.f;
#pragma unroll
  for (int j = 0; j < 4; ++j) { v[j] = *(const f32x4*)(src + j * 256 + lane * 4); ss += v[j][0] * v[j][0] + v[j][1] * v[j][1] + v[j][2] * v[j][2] + v[j][3] * v[j][3]; }
  ss = wave_sum(ss);
  const float rstd = rsqrtf(ss * (1.f / 1024.f) + EPS);
#pragma unroll
  for (int j = 0; j < 4; ++j) {
    f32x4 ww = *(const f32x4*)(w + j * 256 + lane * 4);
    u32x2 o; o[0] = pack2(v[j][0] * rstd * ww[0], v[j][1] * rstd * ww[1]); o[1] = pack2(v[j][2] * rstd * ww[2], v[j][3] * rstd * ww[3]);
    *(u32x2*)(dst + j * 256 + lane * 4) = o;
  }
}
DEV void rmsnorm_row_f32_inplace(float* __restrict__ row, const float* __restrict__ w, int lane) {
  f32x4 v[4]; float ss = 0.f;
#pragma unroll
  for (int j = 0; j < 4; ++j) { v[j] = *(const f32x4*)(row + j * 256 + lane * 4); ss += v[j][0] * v[j][0] + v[j][1] * v[j][1] + v[j][2] * v[j][2] + v[j][3] * v[j][3]; }
  ss = wave_sum(ss);
  const float rstd = rsqrtf(ss * (1.f / 1024.f) + EPS);
#pragma unroll
  for (int j = 0; j < 4; ++j) {
    f32x4 ww = *(const f32x4*)(w + j * 256 + lane * 4);
    f32x4 o; o[0] = v[j][0] * rstd * ww[0]; o[1] = v[j][1] * rstd * ww[1]; o[2] = v[j][2] * rstd * ww[2]; o[3] = v[j][3] * rstd * ww[3];
    *(f32x4*)(row + j * 256 + lane * 4) = o;
  }
}

template <int R, int C, bool SCALE>
DEV void stage_conv(u16* dst, int ld, const u16* __restrict__ xbc, int row0, int ch0, const float* __restrict__ cw, const float* __restrict__ cb, const float* rs) {
  constexpr int CG = C / 8, RG = 256 / CG, RPT = R / RG;
  const int tid = get_tid();
  const int cgi = tid % CG, rgi = tid / CG;
  const int ch = ch0 + cgi * 8, r0 = rgi * RPT;
  float w[4][8], bias[8], xw[3][8];
#pragma unroll
  for (int k = 0; k < 4; ++k) {
    f32x4 a = *(const f32x4*)(cw + k * 3072 + ch), b = *(const f32x4*)(cw + k * 3072 + ch + 4);
#pragma unroll
    for (int j = 0; j < 4; ++j) { w[k][j] = a[j]; w[k][4 + j] = b[j]; }
  }
  {
    f32x4 a = *(const f32x4*)(cb + ch), b = *(const f32x4*)(cb + ch + 4);
#pragma unroll
    for (int j = 0; j < 4; ++j) { bias[j] = a[j]; bias[4 + j] = b[j]; }
  }
#pragma unroll
  for (int k = 0; k < 3; ++k) {
    const int tr = row0 + r0 - 3 + k;
    u32x4 v = {0u, 0u, 0u, 0u};
    if (tr >= 0 && tr < L) v = *(const u32x4*)(xbc + (size_t)tr * 3072 + ch);
#pragma unroll
    for (int j = 0; j < 4; ++j) { xw[k][2 * j] = lo_f(v[j]); xw[k][2 * j + 1] = hi_f(v[j]); }
  }
#pragma unroll
  for (int i = 0; i < RPT; ++i) {
    const int tr = row0 + r0 + i;
    const bool valid = tr < L;
    u32x4 v = {0u, 0u, 0u, 0u};
    if (valid) v = *(const u32x4*)(xbc + (size_t)tr * 3072 + ch);
    if (!valid) { const u32x4 z4 = {0u, 0u, 0u, 0u}; *(u32x4*)(dst + (r0 + i) * ld + cgi * 8) = z4; continue; }
    float xc[8], o[8];
#pragma unroll
    for (int j = 0; j < 4; ++j) { xc[2 * j] = lo_f(v[j]); xc[2 * j + 1] = hi_f(v[j]); }
    float sc = 1.f;
    if (SCALE) sc = rs[(cgi >> 3) * 128 + r0 + i];
#pragma unroll
    for (int j = 0; j < 8; ++j) {
      float a = bias[j] + w[0][j] * xw[0][j] + w[1][j] * xw[1][j] + w[2][j] * xw[2][j] + w[3][j] * xc[j];
      a = silu_f(a) * sc;
      o[j] = valid ? a : 0.f;
      xw[0][j] = xw[1][j]; xw[1][j] = xw[2][j]; xw[2][j] = xc[j];
    }
    u32x4 pk; pk[0] = pack2(o[0], o[1]); pk[1] = pack2(o[2], o[3]); pk[2] = pack2(o[4], o[5]); pk[3] = pack2(o[6], o[7]);
    *(u32x4*)(dst + (r0 + i) * ld + cgi * 8) = pk;
  }
}

DEV float chunk_cumsum(const float* __restrict__ DT, int c, int H, float A, float* acs, float* dts, int lane) {
  const int s0 = 2 * lane;
  const int t0 = c * 128 + s0;
  const float d0 = (t0 < L) ? DT[(size_t)t0 * 32 + H] : 0.f;
  const float d1 = (t0 + 1 < L) ? DT[(size_t)(t0 + 1) * 32 + H] : 0.f;
  const float a0 = d0 * A, a1 = a0 + d1 * A;
  float tot = a1;
#pragma unroll
  for (int o = 1; o < 64; o <<= 1) { float n = __shfl_up(tot, o); if (lane >= o) tot += n; }
  const float excl = tot - a1;
  acs[s0] = excl + a0; acs[s0 + 1] = excl + a1;
  dts[s0] = d0; dts[s0 + 1] = d1;
  return __shfl(tot, 63);
}

DEV void phase_prep(const Params& p, int b, bool first, char* smem) {
  const int tid = get_tid(), lane = tid & 63, w = tid >> 6;
  u16* U = (u16*)((char*)p.out + OUT_HALF);
  const int n_norm = L / 4;
  const int n_win = 16 * (NPROJ_PAD / 64);
  const int n_wb = first ? 2 * 32 * 16 : 0;
  const int total = n_norm + n_win + n_wb;
  for (int it = get_bid(); it < total; it += nworkers()) {
    if (it < n_norm) {
      const int t = it * 4 + w;
      const float* src = (t < NMETA) ? (p.in[1] + (size_t)t * D) : (p.in[0] + ((size_t)b * SEQ + (t - NMETA)) * D);
      rmsnorm_row_bf16(src, p.in[2], U + (size_t)t * D, lane);
    } else if (it < n_norm + n_win) {
      const int j = it - n_norm; const int ntile = j >> 4, kt = j & 15;
      convert_tile(p.in[3], NPROJ, 1024, (u16*)(p.ws + OFF_S1), kt, ntile, 1, smem);
    } else {
      int j = it - n_norm - n_win; const int which = j >> 9; j &= 511; const int ntile = j >> 5, kt = j & 31;
      convert_tile(p.in[10 + which], 1024, 2048, (u16*)(p.ws + OFF_S2 + (size_t)which * 4194304), kt, ntile, 0, smem);
    }
  }
}

DEV void phase_inproj(const Params& p, int b, char* smem) {
  const int tid = get_tid(), lane = tid & 63, w = tid >> 6, wm = w >> 1, wn = w & 1, r = lane & 31, h = lane >> 5;
  const u16* U = (const u16*)((char*)p.out + OUT_HALF);
  const u16* WT = (const u16*)(p.ws + OFF_S1);
  const int MT = 65, NT = 105;
  for (int it = get_bid(); it < MT * NT; it += gridDim.x) {
    const int nt = it / MT, mt = it % MT;
    f32x16 acc[2][2];
#pragma unroll
    for (int mi = 0; mi < 2; ++mi)
#pragma unroll
      for (int ni = 0; ni < 2; ++ni) acc[mi][ni] = zero16();
    gemm_tile<2>(acc, U, 1024, mt * 128, L - 1, WT, 1024, nt * 128, 1024, smem);
    const int n0 = nt * 128;
    if (nt >= 40 && nt < 56) {
      const bool isk = nt >= 48;
      const int cq = n0 - (isk ? 6144 : 5120);
      const int blk = ((cq & 255) >> 6) + wn;
      const int jf = blk * 32 + r;
      const double invf_rev = exp(-(double)jf * 0.07252236513367073) * 0.15915494309189535;
      const float sc = isk ? 0.0625f : 1.f;
      u16* dst = (u16*)(p.ws + (isk ? OFF_K : OFF_Q));
#pragma unroll
      for (int mi = 0; mi < 2; ++mi)
#pragma unroll
        for (int i = 0; i < 16; ++i) {
          const int t = mt * 128 + wm * 64 + mi * 32 + acc_row(i, h);
          if (t < L) {
            double rev = (double)t * invf_rev;
            rev -= floor(rev);
            const float fr = (float)rev;
            const float sn = __builtin_amdgcn_sinf(fr), cs = __builtin_amdgcn_cosf(fr);
            const float x1 = acc[mi][0][i], x2 = acc[mi][1][i];
            const float o1 = (x1 * cs - x2 * sn) * sc, o2 = (x2 * cs + x1 * sn) * sc;
            u16* d = dst + (size_t)t * 1024 + cq + wn * 64 + r;
            d[0] = f2bf(o1); d[32] = f2bf(o2);
          }
        }
    } else if (nt == 104) {
      float* DT = (float*)(p.ws + OFF_DT);
      if (wn == 0) {
        const float bias = p.in[6][r];
#pragma unroll
        for (int mi = 0; mi < 2; ++mi)
#pragma unroll
          for (int i = 0; i < 16; ++i) {
            const int t = mt * 128 + wm * 64 + mi * 32 + acc_row(i, h);
            if (t < L) {
              const float x = acc[mi][0][i] + bias;
              const float e = __expf(x);
              DT[(size_t)t * 32 + r] = (x > 20.f) ? x : (e < 0.01f ? e * (1.f - 0.5f * e + e * e * (1.f / 3.f)) : __logf(1.f + e));
            }
          }
      }
    } else {
      u16* dst; int ld, c0; bool sig = false;
      if (nt < 16) { dst = (u16*)(p.ws + OFF_Z); ld = 2048; c0 = n0; }
      else if (nt < 40) { dst = (u16*)(p.ws + OFF_XBC); ld = 3072; c0 = n0 - 2048; }
      else if (nt < 72) { dst = (u16*)(p.ws + OFF_V); ld = 2048; c0 = n0 - 7168; }
      else if (nt < 88) { dst = (u16*)(p.ws + OFF_G); ld = 2048; c0 = n0 - 9216; }
      else if (nt < 96) { dst = (u16*)(p.ws + OFF_GS); ld = 1024; c0 = n0 - 11264; sig = true; }
      else { dst = (u16*)(p.ws + OFF_GR); ld = 1024; c0 = n0 - 12288; sig = true; }
#pragma unroll
      for (int mi = 0; mi < 2; ++mi)
#pragma unroll
        for (int ni = 0; ni < 2; ++ni)
#pragma unroll
          for (int i = 0; i < 16; ++i) {
            const int t = mt * 128 + wm * 64 + mi * 32 + acc_row(i, h);
            if (t < L) {
              float v = acc[mi][ni][i];
              if (sig) v = sigmoid_f(v);
              dst[(size_t)t * ld + c0 + wn * 64 + ni * 32 + r] = f2bf(v);
            }
          }
    }
  }
}

DEV void ssd_state_item(const Params& p, int it, char* smem) {
  const int tid = get_tid(), lane = tid & 63, w = tid >> 6, wm = w >> 1, wn = w & 1, r = lane & 31, h = lane >> 5;
  const int c = it >> 4, hp = it & 15, H0 = hp * 2, g = H0 >> 3;
  u16* Xw = (u16*)smem;
  u16* Bc = Xw + 128 * 136;
  float* wsc = (float*)(Bc + 128 * 136);
  float* tmp = wsc + 256;
  const float* DT = (const float*)(p.ws + OFF_DT);
  float* CD = (float*)(p.ws + OFF_CD);
  const u16* XBC = (const u16*)(p.ws + OFF_XBC);
  if (w < 2) {
    const int H = H0 + w;
    const float A = -expf(p.in[7][H]);
    float* acs = tmp + w * 128;
    float* dts = wsc + w * 128;
    const float aend = chunk_cumsum(DT, c, H, A, acs, dts, lane);
    const int s0 = 2 * lane;
    const float w0 = __expf(aend - acs[s0]) * dts[s0], w1 = __expf(aend - acs[s0 + 1]) * dts[s0 + 1];
    dts[s0] = w0; dts[s0 + 1] = w1;
    if (lane == 0) CD[c * 32 + H] = __expf(aend);
  }
  __syncthreads();
  stage_conv<128, 128, true>(Xw, 136, XBC, c * 128, H0 * 64, p.in[4], p.in[5], wsc);
  stage_conv<128, 128, false>(Bc, 136, XBC, c * 128, 2048 + g * 128, p.in[4], p.in[5], nullptr);
  __syncthreads();
  f32x16 acc[2][2];
#pragma unroll
  for (int mi = 0; mi < 2; ++mi)
#pragma unroll
    for (int ni = 0; ni < 2; ++ni) acc[mi][ni] = zero16();
#pragma unroll
  for (int ks = 0; ks < 8; ++ks) {
    bf16x8 a[2], bq[2];
#pragma unroll
    for (int mi = 0; mi < 2; ++mi) a[mi] = frag_tr(Xw, 136, ks * 16, wm * 64 + mi * 32, lane);
#pragma unroll
    for (int ni = 0; ni < 2; ++ni) bq[ni] = frag_tr(Bc, 136, ks * 16, wn * 64 + ni * 32, lane);
#pragma unroll
    for (int mi = 0; mi < 2; ++mi)
#pragma unroll
      for (int ni = 0; ni < 2; ++ni) acc[mi][ni] = mfma(a[mi], bq[ni], acc[mi][ni]);
  }
  u16* ST = (u16*)(p.ws + OFF_S1) + (size_t)(c * 32 + H0) * 8192;
  __syncthreads();
#pragma unroll
  for (int mi = 0; mi < 2; ++mi)
#pragma unroll
    for (int ni = 0; ni < 2; ++ni)
#pragma unroll
      for (int i = 0; i < 16; ++i) Xw[(wm * 64 + mi * 32 + acc_row(i, h)) * 136 + wn * 64 + ni * 32 + r] = f2bf(acc[mi][ni][i]);
  asm volatile("s_waitcnt lgkmcnt(0)" ::: "memory");
#pragma unroll
  for (int j = 0; j < 8; ++j) {
    const int m = wm * 64 + (lane >> 3) + 8 * j, n = wn * 64 + (lane & 7) * 8;
    *(u32x4*)(ST + m * 128 + n) = *(const u32x4*)(Xw + m * 136 + n);
  }
  __syncthreads();
}

DEV void ret_kv_item(const Params& p, int it, char* smem) {
  const int tid = get_tid(), lane = tid & 63, w = tid >> 6, wm = w >> 1, wn = w & 1, r = lane & 31, h = lane >> 5;
  const int sc = it >> 5, rem = it & 31, hd = rem >> 3, dt2 = (rem >> 2) & 1, et = rem & 3;
  u16* Vt = (u16*)smem;
  u16* Kt = Vt + 128 * 136;
  const u16* Vg = (const u16*)(p.ws + OFF_V);
  const u16* Kg = (const u16*)(p.ws + OFF_K);
  const float lg = log_gamma(hd);
  f32x16 acc[2][2];
#pragma unroll
  for (int mi = 0; mi < 2; ++mi)
#pragma unroll
    for (int ni = 0; ni < 2; ++ni) acc[mi][ni] = zero16();
  for (int half = 0; half < 2; ++half) {
#pragma unroll
    for (int i = 0; i < 8; ++i) {
      const int cidx = tid + i * 256, row = cidx >> 4, cc = cidx & 15;
      const int tok = sc * 256 + half * 128 + row;
      u32x4 v = *(const u32x4*)(Vg + (size_t)tok * 2048 + hd * 512 + et * 128 + cc * 8);
      *(u32x4*)(Vt + row * 136 + cc * 8) = v;
      u32x4 kk = *(const u32x4*)(Kg + (size_t)tok * 1024 + hd * 256 + dt2 * 128 + cc * 8);
      const float dec = __expf((float)(255 - (half * 128 + row)) * lg);
      u32x4 ko;
#pragma unroll
      for (int j = 0; j < 4; ++j) ko[j] = pack2(lo_f(kk[j]) * dec, hi_f(kk[j]) * dec);
      *(u32x4*)(Kt + row * 136 + cc * 8) = ko;
    }
    __syncthreads();
#pragma unroll
    for (int ks = 0; ks < 8; ++ks) {
      bf16x8 a[2], bq[2];
#pragma unroll
      for (int mi = 0; mi < 2; ++mi) a[mi] = frag_tr(Vt, 136, ks * 16, wm * 64 + mi * 32, lane);
#pragma unroll
      for (int ni = 0; ni < 2; ++ni) bq[ni] = frag_tr(Kt, 136, ks * 16, wn * 64 + ni * 32, lane);
#pragma unroll
      for (int mi = 0; mi < 2; ++mi)
#pragma unroll
        for (int ni = 0; ni < 2; ++ni) acc[mi][ni] = mfma(a[mi], bq[ni], acc[mi][ni]);
    }
    __syncthreads();
  }
  u16* RST = (u16*)((char*)p.out + OUT_HALF) + ((size_t)(sc * 4 + hd) * 512 + et * 128) * 256 + dt2 * 128;
#pragma unroll
  for (int mi = 0; mi < 2; ++mi)
#pragma unroll
    for (int ni = 0; ni < 2; ++ni)
#pragma unroll
      for (int i = 0; i < 16; ++i) Vt[(wm * 64 + mi * 32 + acc_row(i, h)) * 136 + wn * 64 + ni * 32 + r] = f2bf(acc[mi][ni][i]);
  asm volatile("s_waitcnt lgkmcnt(0)" ::: "memory");
#pragma unroll
  for (int j = 0; j < 8; ++j) {
    const int e = wm * 64 + (lane >> 3) + 8 * j, d = wn * 64 + (lane & 7) * 8;
    *(u32x4*)(RST + (size_t)e * 256 + d) = *(const u32x4*)(Vt + e * 136 + d);
  }
  __syncthreads();
}

DEV void phase_scan(const Params& p) {
  const int gt = get_bid() * 256 + get_tid(), nth = nworkers() * 256;
  const float* CD = (const float*)(p.ws + OFF_CD);
  for (int v = gt; v < 32768 + 65536; v += nth) {
    float st[8];
#pragma unroll
    for (int j = 0; j < 8; ++j) st[j] = 0.f;
    if (v < 32768) {
      const int e0 = v * 8, H = e0 >> 13;
      u16* base = (u16*)(p.ws + OFF_S1) + e0;
      for (int c0 = 0; c0 < 64; c0 += 8) {
        u32x4 x[8];
#pragma unroll
        for (int u = 0; u < 8; ++u) x[u] = *(const u32x4*)(base + (size_t)(c0 + u) * 262144);
#pragma unroll
        for (int u = 0; u < 8; ++u) {
          const float dcy = CD[(c0 + u) * 32 + H];
          u32x4 o;
#pragma unroll
          for (int j = 0; j < 4; ++j) {
            st[2 * j] = st[2 * j] * dcy + lo_f(x[u][j]);
            st[2 * j + 1] = st[2 * j + 1] * dcy + hi_f(x[u][j]);
            o[j] = pack2(st[2 * j], st[2 * j + 1]);
          }
          *(u32x4*)(base + (size_t)(c0 + u) * 262144) = o;
        }
      }
    } else {
      const int e0 = (v - 32768) * 8, hd = e0 >> 17;
      const float g256 = __expf(256.f * log_gamma(hd));
      u16* base = (u16*)((char*)p.out + OUT_HALF) + e0;
      for (int c0 = 0; c0 < 32; c0 += 8) {
        u32x4 x[8];
#pragma unroll
        for (int u = 0; u < 8; ++u) x[u] = *(const u32x4*)(base + (size_t)(c0 + u) * 524288);
#pragma unroll
        for (int u = 0; u < 8; ++u) {
          u32x4 o;
#pragma unroll
          for (int j = 0; j < 4; ++j) {
            st[2 * j] = st[2 * j] * g256 + lo_f(x[u][j]);
            st[2 * j + 1] = st[2 * j + 1] * g256 + hi_f(x[u][j]);
            o[j] = pack2(st[2 * j], st[2 * j + 1]);
          }
          *(u32x4*)(base + (size_t)(c0 + u) * 524288) = o;
        }
      }
    }
  }
}

DEV void ssd_out_item(const Params& p, int it, char* smem) {
  const int tid = get_tid(), lane = tid & 63, w = tid >> 6, wm = w >> 1, wn = w & 1, r = lane & 31, h = lane >> 5;
  const int c = it >> 3, rem = it & 7, g = rem & 3, lh = rem >> 2;
  if (c == 64 && lh == 1) return;
  u16* Ct = (u16*)smem;
  u16* Bt = Ct + 64 * 136;
  u16* Lt = Bt;
  u16* Xt = Bt + 128 * 136;
  float* acs = (float*)(Xt + 128 * 72);
  float* dts = acs + 128;
  float* rowsq = dts + 128;
  const u16* XBC = (const u16*)(p.ws + OFF_XBC);
  const float* DT = (const float*)(p.ws + OFF_DT);
  u16* Z = (u16*)(p.ws + OFF_Z);
  const int tok0 = c * 128;
  const bool tailc = (L - tok0) < 128;
  stage_conv<64, 128, false>(Ct, 136, XBC, tok0 + lh * 64, 2560 + g * 128, p.in[4], p.in[5], nullptr);
  stage_conv<128, 128, false>(Bt, 136, XBC, tok0, 2048 + g * 128, p.in[4], p.in[5], nullptr);
  if (tid < 64) rowsq[tid] = 0.f;
  __syncthreads();
  f32x16 cb[2];
  cb[0] = zero16(); cb[1] = zero16();
#pragma unroll
  for (int ks = 0; ks < 8; ++ks) {
    bf16x8 a = frag_row(Ct, 136, wm * 32 + r, ks * 16 + h * 8);
#pragma unroll
    for (int ni = 0; ni < 2; ++ni) {
      bf16x8 bq = frag_row(Bt, 136, wn * 64 + ni * 32 + r, ks * 16 + h * 8);
      cb[ni] = mfma(a, bq, cb[ni]);
    }
  }
  for (int hh = 0; hh < 8; ++hh) {
    const int H = g * 8 + hh;
    u32x4 zv[2];
    {
      int tz = tok0 + lh * 64 + (tid >> 2); tz = tz < L ? tz : L - 1;
      const u16* zp0 = Z + (size_t)tz * 2048 + H * 64 + (tid & 3) * 16;
      zv[0] = *(const u32x4*)zp0; zv[1] = *(const u32x4*)(zp0 + 8);
    }
    __syncthreads();
    if (w == 0) {
      const float A = -expf(p.in[7][H]);
      chunk_cumsum(DT, c, H, A, acs, dts, lane);
    }
    stage_conv<128, 64, false>(Xt, 72, XBC, tok0, H * 64, p.in[4], p.in[5], nullptr);
    __syncthreads();
#pragma unroll
    for (int ni = 0; ni < 2; ++ni) {
      if (tailc && (wn | ni)) continue;
#pragma unroll
      for (int i = 0; i < 16; ++i) {
        const int ll = wm * 32 + acc_row(i, h), l = lh * 64 + ll, s = wn * 64 + ni * 32 + r;
        float val = 0.f;
        if (s <= l) val = cb[ni][i] * __expf(acs[l] - acs[s]) * dts[s];
        Lt[ll * 136 + s] = f2bf(val);
      }
    }
    f32x16 y = zero16();
    if (c > 0) {
      const u16* pv = (const u16*)(p.ws + OFF_S1) + ((size_t)((c - 1) * 32 + H) * 64 + wn * 32 + r) * 128 + h * 8;
#pragma unroll
      for (int ks = 0; ks < 8; ++ks) {
        bf16x8 a = frag_row(Ct, 136, wm * 32 + r, ks * 16 + h * 8);
        bf16x8 bq = *(const bf16x8*)(pv + ks * 16);
        y = mfma(a, bq, y);
      }
#pragma unroll
      for (int i = 0; i < 16; ++i) { const int l = lh * 64 + wm * 32 + acc_row(i, h); y[i] *= __expf(acs[l]); }
    }
    __syncthreads();
#pragma unroll
    for (int ks = 0; ks < 8; ++ks) {
      if (tailc && ks >= 2) break;
      bf16x8 a = frag_row(Lt, 136, wm * 32 + r, ks * 16 + h * 8);
      bf16x8 bq = frag_tr(Xt, 72, ks * 16, wn * 32, lane);
      y = mfma(a, bq, y);
    }
    const float Dsk = p.in[8][H];
    float* Ys = (float*)(Bt + 64 * 136);
#pragma unroll
    for (int i = 0; i < 16; ++i) Ys[(wm * 32 + acc_row(i, h)) * 68 + wn * 32 + r] = y[i];
    __syncthreads();
    {
      const int row = tid >> 2, q = tid & 3, l = lh * 64 + row, t = tok0 + l;
      float sq = 0.f;
      if (t < L) {
        u16* zp = Z + (size_t)t * 2048 + H * 64 + q * 16;
        u32x4 xv[2], ov[2];
        xv[0] = *(const u32x4*)(Xt + l * 72 + q * 16); xv[1] = *(const u32x4*)(Xt + l * 72 + q * 16 + 8);
#pragma unroll
        for (int k = 0; k < 2; ++k) {
          const f32x4 ya = *(const f32x4*)(Ys + row * 68 + q * 16 + k * 8), yb = *(const f32x4*)(Ys + row * 68 + q * 16 + k * 8 + 4);
          float o[8];
#pragma unroll
          for (int j = 0; j < 4; ++j) {
            const float y0 = (j < 2) ? ya[2 * j] : yb[2 * j - 4], y1 = (j < 2) ? ya[2 * j + 1] : yb[2 * j - 3];
            o[2 * j] = (y0 + Dsk * lo_f(xv[k][j])) * silu_f(lo_f(zv[k][j]));
            o[2 * j + 1] = (y1 + Dsk * hi_f(xv[k][j])) * silu_f(hi_f(zv[k][j]));
            sq += o[2 * j] * o[2 * j] + o[2 * j + 1] * o[2 * j + 1];
            ov[k][j] = pack2(o[2 * j], o[2 * j + 1]);
          }
        }
        *(u32x4*)zp = ov[0]; *(u32x4*)(zp + 8) = ov[1];
      }
      sq += __shfl_xor(sq, 1); sq += __shfl_xor(sq, 2);
      if (q == 0) rowsq[row] += sq;
    }
  }
  __syncthreads();
  {
    const int row = tid >> 2, q = tid & 3, t = tok0 + lh * 64 + row;
    if (t < L) {
      const float rn = rsqrtf(rowsq[row] * (1.f / 512.f) + EPS);
      u32x4 v[16];
#pragma unroll
      for (int hh = 0; hh < 8; ++hh) {
        const u16* zp = Z + (size_t)t * 2048 + (g * 8 + hh) * 64 + q * 16;
        v[2 * hh] = *(const u32x4*)zp; v[2 * hh + 1] = *(const u32x4*)(zp + 8);
      }
#pragma unroll
      for (int hh = 0; hh < 8; ++hh) {
        u16* zp = Z + (size_t)t * 2048 + (g * 8 + hh) * 64 + q * 16;
        const float* nwp = p.in[9] + (g * 8 + hh) * 64 + q * 16;
#pragma unroll
        for (int k = 0; k < 2; ++k) {
          const f32x4 wa = *(const f32x4*)(nwp + k * 8), wb = *(const f32x4*)(nwp + k * 8 + 4);
          u32x4 o;
          o[0] = pack2(lo_f(v[2 * hh + k][0]) * rn * wa[0], hi_f(v[2 * hh + k][0]) * rn * wa[1]);
          o[1] = pack2(lo_f(v[2 * hh + k][1]) * rn * wa[2], hi_f(v[2 * hh + k][1]) * rn * wa[3]);
          o[2] = pack2(lo_f(v[2 * hh + k][2]) * rn * wb[0], hi_f(v[2 * hh + k][2]) * rn * wb[1]);
          o[3] = pack2(lo_f(v[2 * hh + k][3]) * rn * wb[2], hi_f(v[2 * hh + k][3]) * rn * wb[3]);
          *(u32x4*)(zp + k * 8) = o;
        }
      }
    }
  }
  __syncthreads();
}

DEV void ret_out_item(const Params& p, int it, char* smem) {
  const int tid = get_tid(), lane = tid & 63, w = tid >> 6, wm = w >> 1, wn = w & 1, r = lane & 31, h = lane >> 5;
  const int rt = it >> 2, hd = it & 3;
  const int t0 = rt * 64, sc = rt >> 2, qtr = rt & 3;
  u16* P = (u16*)smem;
  char* gsm = smem + 33792;
  u16* Vt = (u16*)gsm;
  float* rowsq = (float*)(smem + 33792 + 27648);
  const u16* Qg = (const u16*)(p.ws + OFF_Q) + hd * 256;
  const u16* Kg = (const u16*)(p.ws + OFF_K) + hd * 256;
  const u16* Vg = (const u16*)(p.ws + OFF_V);
  u16* Gg = (u16*)(p.ws + OFF_G);
  const u16* RST = (const u16*)((char*)p.out + OUT_HALF);
  const float lg = log_gamma(hd);
  if (tid < 64) rowsq[tid] = 0.f;
  const int nkb = (qtr >= 2) ? 2 : 1;
  for (int kb = 0; kb < nkb; ++kb) {
    f32x16 acc[1][2];
    acc[0][0] = zero16(); acc[0][1] = zero16();
    gemm_tile<1>(acc, Qg, 1024, t0, L - 1, Kg, 1024, sc * 256 + kb * 128, 256, gsm);
#pragma unroll
    for (int ni = 0; ni < 2; ++ni)
#pragma unroll
      for (int i = 0; i < 16; ++i) {
        const int ll = wm * 32 + acc_row(i, h), lp = qtr * 64 + ll, s = kb * 128 + wn * 64 + ni * 32 + r;
        float val = 0.f;
        if (s <= lp) val = acc[0][ni][i] * __expf((float)(lp - s) * lg);
        P[ll * 264 + s] = f2bf(val);
      }
  }
  float rs[16];
#pragma unroll
  for (int i = 0; i < 16; ++i) rs[i] = 0.f;
  for (int et = 0; et < 4; ++et) {
    f32x16 acc[1][2];
    acc[0][0] = zero16(); acc[0][1] = zero16();
    u32x4 gv[4], vreg[4];
    {
      int tg = t0 + (tid >> 2); tg = tg < L ? tg : L - 1;
      const u16* gp0 = Gg + (size_t)tg * 2048 + hd * 512 + et * 128 + (tid & 3) * 32;
#pragma unroll
      for (int k = 0; k < 4; ++k) gv[k] = *(const u32x4*)(gp0 + k * 8);
#pragma unroll
      for (int i = 0; i < 4; ++i) {
        const int cidx = tid + i * 256, row = cidx >> 4, cc = cidx & 15;
        int tok = sc * 256 + row; tok = tok < L ? tok : L - 1;
        vreg[i] = *(const u32x4*)(Vg + (size_t)tok * 2048 + hd * 512 + et * 128 + cc * 8);
      }
    }
    if (sc > 0) {
      gemm_tile<1>(acc, Qg, 1024, t0, L - 1, RST + ((size_t)((sc - 1) * 4 + hd) * 512 + et * 128) * 256, 256, 0, 256, gsm);
#pragma unroll
      for (int ni = 0; ni < 2; ++ni)
#pragma unroll
        for (int i = 0; i < 16; ++i) {
          const int lp = qtr * 64 + wm * 32 + acc_row(i, h);
          acc[0][ni][i] *= __expf((float)(lp + 1) * lg);
        }
    }
    for (int kb64 = 0; kb64 <= qtr; ++kb64) {
#pragma unroll
      for (int i = 0; i < 4; ++i) {
        const int cidx = tid + i * 256, row = cidx >> 4, cc = cidx & 15;
        const int tok = sc * 256 + kb64 * 64 + row;
        u32x4 v = {0u, 0u, 0u, 0u};
        if (tok < L) v = vreg[i];
        *(u32x4*)(Vt + row * 136 + cc * 8) = v;
      }
      __syncthreads();
      if (kb64 < qtr) {
#pragma unroll
        for (int i = 0; i < 4; ++i) {
          const int cidx = tid + i * 256, row = cidx >> 4, cc = cidx & 15;
          int tok = sc * 256 + (kb64 + 1) * 64 + row; tok = tok < L ? tok : L - 1;
          vreg[i] = *(const u32x4*)(Vg + (size_t)tok * 2048 + hd * 512 + et * 128 + cc * 8);
        }
      }
#pragma unroll
      for (int ks = 0; ks < 4; ++ks) {
        bf16x8 a = frag_row(P, 264, wm * 32 + r, kb64 * 64 + ks * 16 + h * 8);
#pragma unroll
        for (int ni = 0; ni < 2; ++ni) {
          bf16x8 bq = frag_tr(Vt, 136, ks * 16, wn * 64 + ni * 32, lane);
          acc[0][ni] = mfma(a, bq, acc[0][ni]);
        }
      }
      __syncthreads();
    }
    u16* Os = (u16*)gsm;
#pragma unroll
    for (int ni = 0; ni < 2; ++ni)
#pragma unroll
      for (int i = 0; i < 16; ++i) {
        const float o = acc[0][ni][i];
        if (t0 + wm * 32 + acc_row(i, h) < L) rs[i] += o * o;
        Os[(wm * 32 + acc_row(i, h)) * 136 + wn * 64 + ni * 32 + r] = f2bf(o);
      }
    __syncthreads();
    {
      const int row = tid >> 2, q = tid & 3, t = t0 + row;
      if (t < L) {
        u16* gp = Gg + (size_t)t * 2048 + hd * 512 + et * 128 + q * 32;
        u32x4 ov[4];
#pragma unroll
        for (int k = 0; k < 4; ++k) ov[k] = *(const u32x4*)(Os + row * 136 + q * 32 + k * 8);
#pragma unroll
        for (int k = 0; k < 4; ++k) {
          u32x4 o;
#pragma unroll
          for (int j = 0; j < 4; ++j) o[j] = pack2(silu_f(lo_f(gv[k][j])) * lo_f(ov[k][j]), silu_f(hi_f(gv[k][j])) * hi_f(ov[k][j]));
          *(u32x4*)(gp + k * 8) = o;
        }
      }
    }
    __syncthreads();
  }
#pragma unroll
  for (int i = 0; i < 16; ++i) {
    const float v = half_sum(rs[i]);
    if (r == 0) atomicAdd(&rowsq[wm * 32 + acc_row(i, h)], v);
  }
  __syncthreads();
  {
    const int row = tid >> 2, q = tid & 3, t = t0 + row;
    if (t < L) {
      const float rn = rsqrtf(rowsq[row] * (1.f / 512.f) + EPS);
      u32x4 v[16];
#pragma unroll
      for (int et = 0; et < 4; ++et)
#pragma unroll
        for (int k = 0; k < 4; ++k) v[et * 4 + k] = *(const u32x4*)(Gg + (size_t)t * 2048 + hd * 512 + et * 128 + q * 32 + k * 8);
#pragma unroll
      for (int et = 0; et < 4; ++et)
#pragma unroll
        for (int k = 0; k < 4; ++k) {
          u32x4 o;
#pragma unroll
          for (int j = 0; j < 4; ++j) o[j] = pack2(lo_f(v[et * 4 + k][j]) * rn, hi_f(v[et * 4 + k][j]) * rn);
          *(u32x4*)(Gg + (size_t)t * 2048 + hd * 512 + et * 128 + q * 32 + k * 8) = o;
        }
    }
  }
  __syncthreads();
}

DEV void merge_tile(const Params& p, int it, char* smem) {
  const int tid = get_tid(), lane = tid & 63, w = tid >> 6, wm = w >> 1, wn = w & 1, r = lane & 31, h = lane >> 5;
  const int nt = it / 65, mt = it % 65;
  u16* GS = (u16*)(p.ws + OFF_GS);
  const u16* GR = (const u16*)(p.ws + OFF_GR);
  f32x16 acc[2][2];
#pragma unroll
  for (int mi = 0; mi < 2; ++mi)
#pragma unroll
    for (int ni = 0; ni < 2; ++ni) acc[mi][ni] = zero16();
  gemm_tile<2>(acc, (const u16*)(p.ws + OFF_Z), 2048, mt * 128, L - 1, (const u16*)(p.ws + OFF_S2), 2048, nt * 128, 2048, smem);
#pragma unroll
  for (int mi = 0; mi < 2; ++mi)
#pragma unroll
    for (int ni = 0; ni < 2; ++ni)
#pragma unroll
      for (int i = 0; i < 16; ++i) {
        const int t = mt * 128 + wm * 64 + mi * 32 + acc_row(i, h);
        if (t < L) {
          const size_t idx = (size_t)t * 1024 + nt * 128 + wn * 64 + ni * 32 + r;
          GS[idx] = f2bf(bf2f(GS[idx]) * acc[mi][ni][i]);
        }
        acc[mi][ni][i] = 0.f;
      }
  gemm_tile<2>(acc, (const u16*)(p.ws + OFF_G), 2048, mt * 128, L - 1, (const u16*)(p.ws + OFF_S2 + 4194304), 2048, nt * 128, 2048, smem);
#pragma unroll
  for (int mi = 0; mi < 2; ++mi)
#pragma unroll
    for (int ni = 0; ni < 2; ++ni)
#pragma unroll
      for (int i = 0; i < 16; ++i) {
        const int t = mt * 128 + wm * 64 + mi * 32 + acc_row(i, h);
        if (t < L) {
          const size_t idx = (size_t)t * 1024 + nt * 128 + wn * 64 + ni * 32 + r;
          GS[idx] = f2bf(bf2f(GS[idx]) + bf2f(GR[idx]) * acc[mi][ni][i]);
        }
      }
}

DEV void phase_merge(const Params& p, char* smem) {
  const int n_tiles = 65 * 8;
  const int n_wout = 16 * 16, n_wup = 16 * 88, n_wdown = 44 * 16;
  const int total = n_tiles + n_wout + n_wup + n_wdown;
  for (int it = get_bid(); it < total; it += nworkers()) {
    if (it < n_tiles) merge_tile(p, it, smem);
    else if (it < n_tiles + n_wout) { const int j = it - n_tiles; convert_tile(p.in[12], 1024, 1024, (u16*)(p.ws + OFF_WOUT), j & 15, j >> 4, 0, smem); }
    else if (it < n_tiles + n_wout + n_wup) { const int j = it - n_tiles - n_wout; convert_tile(p.in[14], 5632, 1024, (u16*)(p.ws + OFF_WUP), j & 15, j >> 4, 0, smem); }
    else { const int j = it - n_tiles - n_wout - n_wup; convert_tile(p.in[17], 1024, 2816, (u16*)(p.ws + OFF_WDOWN), j % 44, j / 44, 0, smem); }
  }
}

DEV void phase_outproj(const Params& p, int b, char* smem) {
  const int tid = get_tid(), lane = tid & 63, w = tid >> 6, wm = w >> 1, wn = w & 1, r = lane & 31, h = lane >> 5;
  float* HM = (float*)(p.ws + OFF_HM);
  for (int it = get_bid(); it < 65 * 8; it += gridDim.x) {
    const int nt = it / 65, mt = it % 65;
    f32x16 acc[2][2];
#pragma unroll
    for (int mi = 0; mi < 2; ++mi)
#pragma unroll
      for (int ni = 0; ni < 2; ++ni) acc[mi][ni] = zero16();
    gemm_tile<2>(acc, (const u16*)(p.ws + OFF_GS), 1024, mt * 128, L - 1, (const u16*)(p.ws + OFF_WOUT), 1024, nt * 128, 1024, smem);
#pragma unroll
    for (int mi = 0; mi < 2; ++mi)
#pragma unroll
      for (int ni = 0; ni < 2; ++ni)
#pragma unroll
        for (int i = 0; i < 16; ++i) {
          const int t = mt * 128 + wm * 64 + mi * 32 + acc_row(i, h);
          const int col = nt * 128 + wn * 64 + ni * 32 + r;
          if (t < NMETA) HM[t * 1024 + col] = p.in[1][t * 1024 + col] + acc[mi][ni][i];
          else if (t < L) {
            const size_t idx = ((size_t)b * SEQ + (t - NMETA)) * 1024 + col;
            p.out[idx] = p.in[0][idx] + acc[mi][ni][i];
          }
        }
  }
}

DEV void phase_norm2(const Params& p, int b) {
  const int lane = get_tid() & 63, w = get_tid() >> 6;
  u16* U2 = (u16*)(p.ws + OFF_U2);
  for (int it = get_bid(); it < L / 4; it += nworkers()) {
    const int t = it * 4 + w;
    const float* src = (t < NMETA) ? ((const float*)(p.ws + OFF_HM) + (size_t)t * D) : (p.out + ((size_t)b * SEQ + (t - NMETA)) * D);
    rmsnorm_row_bf16(src, p.in[13], U2 + (size_t)t * D, lane);
  }
}

DEV void phase_up(const Params& p, char* smem) {
  const int tid = get_tid(), lane = tid & 63, w = tid >> 6, wm = w >> 1, wn = w & 1, r = lane & 31, h = lane >> 5;
  u16* UP = (u16*)(p.ws + OFF_UP);
  for (int it = get_bid(); it < 65 * 44; it += gridDim.x) {
    const int nt = it / 65, mt = it % 65;
    f32x16 acc[2][2];
#pragma unroll
    for (int mi = 0; mi < 2; ++mi)
#pragma unroll
      for (int ni = 0; ni < 2; ++ni) acc[mi][ni] = zero16();
    gemm_tile<2>(acc, (const u16*)(p.ws + OFF_U2), 1024, mt * 128, L - 1, (const u16*)(p.ws + OFF_WUP), 1024, nt * 128, 1024, smem);
#pragma unroll
    for (int mi = 0; mi < 2; ++mi)
#pragma unroll
      for (int ni = 0; ni < 2; ++ni)
#pragma unroll
        for (int i = 0; i < 16; ++i) {
          const int t = mt * 128 + wm * 64 + mi * 32 + acc_row(i, h);
          if (t < L) UP[(size_t)t * 5632 + nt * 128 + wn * 64 + ni * 32 + r] = f2bf(acc[mi][ni][i]);
        }
  }
}

DEV void phase_ffn_act(const Params& p) {
  const int gt = get_bid() * 256 + get_tid(), nth = nworkers() * 256;
  const u16* UP = (const u16*)(p.ws + OFF_UP);
  u16* ACT = (u16*)(p.ws + OFF_ACT);
  const float* cw = p.in[15];
  const float* cbias = p.in[16];
  for (int u = gt; u < 513 * 352; u += nth) {
    const int rb = u / 352, cgp = u % 352, ch = cgp * 8, t0 = rb * 16;
    float wg[3][8], wv[3][8], bg[8], bv[8], g2[8], g1[8], v2[8], v1[8];
#pragma unroll
    for (int k = 0; k < 3; ++k)
#pragma unroll
      for (int j = 0; j < 8; ++j) { wg[k][j] = cw[k * 5632 + ch + j]; wv[k][j] = cw[k * 5632 + 2816 + ch + j]; }
#pragma unroll
    for (int j = 0; j < 8; ++j) { bg[j] = cbias[ch + j]; bv[j] = cbias[2816 + ch + j]; }
    {
      u32x4 a = {0u, 0u, 0u, 0u}, bq = {0u, 0u, 0u, 0u}, c2 = {0u, 0u, 0u, 0u}, d2 = {0u, 0u, 0u, 0u};
      if (t0 >= 2) {
        a = *(const u32x4*)(UP + (size_t)(t0 - 2) * 5632 + ch); bq = *(const u32x4*)(UP + (size_t)(t0 - 1) * 5632 + ch);
        c2 = *(const u32x4*)(UP + (size_t)(t0 - 2) * 5632 + 2816 + ch); d2 = *(const u32x4*)(UP + (size_t)(t0 - 1) * 5632 + 2816 + ch);
      }
#pragma unroll
      for (int j = 0; j < 4; ++j) {
        g2[2 * j] = lo_f(a[j]); g2[2 * j + 1] = hi_f(a[j]); g1[2 * j] = lo_f(bq[j]); g1[2 * j + 1] = hi_f(bq[j]);
        v2[2 * j] = lo_f(c2[j]); v2[2 * j + 1] = hi_f(c2[j]); v1[2 * j] = lo_f(d2[j]); v1[2 * j + 1] = hi_f(d2[j]);
      }
    }
#pragma unroll 4
    for (int i = 0; i < 16; ++i) {
      const int t = t0 + i;
      const u32x4 a = *(const u32x4*)(UP + (size_t)t * 5632 + ch);
      const u32x4 c2 = *(const u32x4*)(UP + (size_t)t * 5632 + 2816 + ch);
      float o[8];
#pragma unroll
      for (int j = 0; j < 8; ++j) {
        const float gx = (j & 1) ? hi_f(a[j >> 1]) : lo_f(a[j >> 1]);
        const float vx = (j & 1) ? hi_f(c2[j >> 1]) : lo_f(c2[j >> 1]);
        const float ag = bg[j] + wg[0][j] * g2[j] + wg[1][j] * g1[j] + wg[2][j] * gx;
        const float av = bv[j] + wv[0][j] * v2[j] + wv[1][j] * v1[j] + wv[2][j] * vx;
        o[j] = silu_f(ag) * av;
        g2[j] = g1[j]; g1[j] = gx; v2[j] = v1[j]; v1[j] = vx;
      }
      u32x4 pk; pk[0] = pack2(o[0], o[1]); pk[1] = pack2(o[2], o[3]); pk[2] = pack2(o[4], o[5]); pk[3] = pack2(o[6], o[7]);
      *(u32x4*)(ACT + (size_t)t * 2816 + ch) = pk;
    }
  }
}

DEV void phase_down(const Params& p, int b, char* smem) {
  const int tid = get_tid(), lane = tid & 63, w = tid >> 6, wm = w >> 1, wn = w & 1, r = lane & 31, h = lane >> 5;
  for (int it = get_bid(); it < 64 * 8; it += gridDim.x) {
    const int nt = it / 64, mt = it % 64;
    f32x16 acc[2][2];
#pragma unroll
    for (int mi = 0; mi < 2; ++mi)
#pragma unroll
      for (int ni = 0; ni < 2; ++ni) acc[mi][ni] = zero16();
    gemm_tile<2>(acc, (const u16*)(p.ws + OFF_ACT), 2816, NMETA + mt * 128, L - 1, (const u16*)(p.ws + OFF_WDOWN), 2816, nt * 128, 2816, smem);
#pragma unroll
    for (int mi = 0; mi < 2; ++mi)
#pragma unroll
      for (int ni = 0; ni < 2; ++ni)
#pragma unroll
        for (int i = 0; i < 16; ++i) {
          const int rr = mt * 128 + wm * 64 + mi * 32 + acc_row(i, h);
          const size_t idx = ((size_t)b * SEQ + rr) * 1024 + nt * 128 + wn * 64 + ni * 32 + r;
          p.out[idx] += acc[mi][ni][i];
        }
  }
}

DEV void phase_final_norm(const Params& p, int b) {
  const int lane = get_tid() & 63, w = get_tid() >> 6;
  for (int it = get_bid(); it < SEQ / 4; it += nworkers()) {
    const int rr = it * 4 + w;
    rmsnorm_row_f32_inplace(p.out + ((size_t)b * SEQ + rr) * D, p.in[18], lane);
  }
}


DEV u32x4 add_bf16x8(u32x4 a, u32x4 b) {
  u32x4 o;
#pragma unroll
  for (int j = 0; j < 4; ++j) o[j] = pack2(lo_f(a[j]) + lo_f(b[j]), hi_f(a[j]) + hi_f(b[j]));
  return o;
}
template <int NJ, bool ADD2 = false>
DEV void gemm_tile8(f32x4 (&acc)[4][NJ], const u16* __restrict__ A, int lda, int arow0, int arow_max,
                    const u16* __restrict__ B, int ldb, int brow0, int K, char* smem, const u16* __restrict__ A2 = nullptr) {
  constexpr int BN = NJ * 32;
  constexpr int BCH = BN / 64;
  constexpr int STAGE = (256 + BN) * 64;
  u16* S = (u16*)smem;
  const int tid = get_tid8(), lane = tid & 63, w = tid >> 6, wm = w >> 1, wn = w & 1;
  u32x4 ra[4], rb[BCH], ra2[ADD2 ? 4 : 1];
  unsigned aoff[4], boff[BCH];
  const char* Ab = (const char*)A;
  const char* Ab2 = (const char*)A2;
  const char* Bb = (const char*)(B + (size_t)brow0 * ldb);
  const int crow = tid >> 3, kc = tid & 7;
  const unsigned sto = (unsigned)(crow * 64 + ((kc ^ ((crow >> 1) & 7)) * 8));
#pragma unroll
  for (int i = 0; i < 4; ++i) {
    int gr = arow0 + crow + i * 64; gr = gr > arow_max ? arow_max : gr; gr = gr < 0 ? 0 : gr;
    aoff[i] = ((unsigned)gr * (unsigned)lda + kc * 8) * 2u;
  }
#pragma unroll
  for (int i = 0; i < BCH; ++i) boff[i] = ((unsigned)(crow + i * 64) * (unsigned)ldb + kc * 8) * 2u;
  const int fr = lane & 15, swz = fr >> 1, cq = lane >> 4;
  const unsigned fa = (unsigned)((wm * 64 + fr) * 64), fb = (unsigned)((256 + wn * (NJ * 16) + fr) * 64);
  const unsigned c0 = (unsigned)(((cq) ^ swz) * 8), c1 = (unsigned)(((4 + cq) ^ swz) * 8);
  const int nk = K >> 6;
#pragma unroll
  for (int i = 0; i < 4; ++i) { ra[i] = *(const u32x4*)(Ab + aoff[i]); if (ADD2) ra2[i] = *(const u32x4*)(Ab2 + aoff[i]); }
#pragma unroll
  for (int i = 0; i < BCH; ++i) rb[i] = *(const u32x4*)(Bb + boff[i]);
#pragma unroll
  for (int i = 0; i < 4; ++i) *(u32x4*)(S + sto + i * 64 * 64) = ADD2 ? add_bf16x8(ra[i], ra2[i]) : ra[i];
#pragma unroll
  for (int i = 0; i < BCH; ++i) *(u32x4*)(S + sto + (256 + i * 64) * 64) = rb[i];
  if (nk > 1) {
#pragma unroll
    for (int i = 0; i < 4; ++i) { ra[i] = *(const u32x4*)(Ab + aoff[i] + 128); if (ADD2) ra2[i] = *(const u32x4*)(Ab2 + aoff[i] + 128); }
#pragma unroll
    for (int i = 0; i < BCH; ++i) rb[i] = *(const u32x4*)(Bb + boff[i] + 128);
  }
  __syncthreads();
  for (int kt = 0; kt < nk; ++kt) {
    const u16* Sc = S + (kt & 1) * STAGE;
    {
      bf16x8 a[4], b[NJ];
#pragma unroll
      for (int m = 0; m < 4; ++m) a[m] = *(const bf16x8*)(Sc + fa + m * 16 * 64 + c0);
#pragma unroll
      for (int n = 0; n < NJ; ++n) b[n] = *(const bf16x8*)(Sc + fb + n * 16 * 64 + c0);
      __builtin_amdgcn_s_setprio(1);
#pragma unroll
      for (int m = 0; m < 4; ++m)
#pragma unroll
        for (int n = 0; n < NJ; ++n) acc[m][n] = __builtin_amdgcn_mfma_f32_16x16x32_bf16(a[m], b[n], acc[m][n], 0, 0, 0);
      __builtin_amdgcn_s_setprio(0);
    }
    bf16x8 a1[4], b1[NJ];
#pragma unroll
    for (int m = 0; m < 4; ++m) a1[m] = *(const bf16x8*)(Sc + fa + m * 16 * 64 + c1);
#pragma unroll
    for (int n = 0; n < NJ; ++n) b1[n] = *(const bf16x8*)(Sc + fb + n * 16 * 64 + c1);
    if (kt + 1 < nk) {
      u16* Aw = S + ((kt + 1) & 1) * STAGE;
#pragma unroll
      for (int i = 0; i < 4; ++i) *(u32x4*)(Aw + sto + i * 64 * 64) = ADD2 ? add_bf16x8(ra[i], ra2[i]) : ra[i];
#pragma unroll
      for (int i = 0; i < BCH; ++i) *(u32x4*)(Aw + sto + (256 + i * 64) * 64) = rb[i];
      if (kt + 2 < nk) {
        const unsigned ko = (unsigned)(kt + 2) * 128u;
#pragma unroll
        for (int i = 0; i < 4; ++i) { ra[i] = *(const u32x4*)(Ab + aoff[i] + ko); if (ADD2) ra2[i] = *(const u32x4*)(Ab2 + aoff[i] + ko); }
#pragma unroll
        for (int i = 0; i < BCH; ++i) rb[i] = *(const u32x4*)(Bb + boff[i] + ko);
      }
    }
    {
      __builtin_amdgcn_s_setprio(1);
#pragma unroll
      for (int m = 0; m < 4; ++m)
#pragma unroll
        for (int n = 0; n < NJ; ++n) acc[m][n] = __builtin_amdgcn_mfma_f32_16x16x32_bf16(a1[m], b1[n], acc[m][n], 0, 0, 0);
      __builtin_amdgcn_s_setprio(0);
    }
    __syncthreads();
  }
}

DEV f32x4 thin16(const u16* __restrict__ A, int lda, int row0, const u16* __restrict__ BT, int ldb, int col0, int K, int lane) {
  const u16* ap = A + (size_t)(row0 + (lane & 15)) * lda + 8 * (lane >> 4);
  const u16* bp = BT + (size_t)(col0 + (lane & 15)) * ldb + 8 * (lane >> 4);
  f32x4 acc = {0.f, 0.f, 0.f, 0.f};
  for (int k0 = 0; k0 < K; k0 += 128) {
    bf16x8 a[4], b[4];
#pragma unroll
    for (int j = 0; j < 4; ++j) { a[j] = *(const bf16x8*)(ap + k0 + j * 32); b[j] = *(const bf16x8*)(bp + k0 + j * 32); }
#pragma unroll
    for (int j = 0; j < 4; ++j) acc = __builtin_amdgcn_mfma_f32_16x16x32_bf16(a[j], b[j], acc, 0, 0, 0);
  }
  return acc;
}

DEV int tile_index(int k) { const int G = gridDim.x, rb = get_rbid(); return k * G + (rb & 7) * (G >> 3) + (rb >> 3); }
DEV void tile_decode(int T, int MT, int NT, int& mt, int& nt) {
  const int per = MT * 8;
  const int nb = T / per, rem = T - nb * per;
  int width = NT - nb * 8; width = width > 8 ? 8 : width;
  mt = rem / width; nt = nb * 8 + (rem - mt * width);
}

#define ZERO_ACC(acc, NJ_) _Pragma("unroll") for (int m_ = 0; m_ < 4; ++m_) _Pragma("unroll") for (int n_ = 0; n_ < NJ_; ++n_) { acc[m_][n_][0] = 0.f; acc[m_][n_][1] = 0.f; acc[m_][n_][2] = 0.f; acc[m_][n_][3] = 0.f; }

constexpr int EPI_WAVE_BYTES = 17408;
#define EPI_FENCE() asm volatile("s_waitcnt lgkmcnt(0)" ::: "memory")
DEV void epi_store_bf16_128(const u16* reg, u16* __restrict__ dst, int ld, int trow, int col0, int lane) {
#pragma unroll
  for (int j = 0; j < 16; ++j) {
    const int row = (lane >> 4) + 4 * j, t = trow + row;
    const u32x4 v = *(const u32x4*)(reg + row * 136 + (lane & 15) * 8);
    if (t < L) *(u32x4*)(dst + (size_t)t * ld + col0 + (lane & 15) * 8) = v;
  }
}

DEV void phase_inproj8(const Params& p, int b, char* smem) {
  const u16* U = (const u16*)((char*)p.out + OUT_HALF);
  const u16* WT = (const u16*)(p.ws + OFF_S1);
  const int MT = 33, NT = 53;
  for (int kk = 0;; ++kk) {
    const int it = tile_index(kk);
    if (it >= MT * NT) break;
    int mt, nt; tile_decode(it, MT, NT, mt, nt);
    f32x4 acc[4][8];
    ZERO_ACC(acc, 8)
    gemm_tile8<8>(acc, U, 1024, mt * 256, L - 1, WT, 1024, nt * 256, 1024, smem);
    const int tid = get_tid8(), lane = tid & 63, w = tid >> 6, wm = w >> 1, wn = w & 1, r = lane & 31, h = lane >> 5;
    u16* reg = (u16*)(smem + w * EPI_WAVE_BYTES);
    const int n0 = nt * 256;
    const int trow = mt * 256 + wm * 64;
    if (nt >= 20 && nt < 28) {
      const bool isk = nt >= 24;
      const int cq = n0 - (isk ? 6144 : 5120);
      const float sc = isk ? 0.0625f : 1.f;
      u16* dst = (u16*)(p.ws + (isk ? OFF_K : OFF_Q));
#pragma unroll
      for (int pr = 0; pr < 4; ++pr) {
        const int n1 = 4 * (pr >> 1) + (pr & 1);
        const int jf = (wn * 2 + (pr >> 1)) * 32 + (pr & 1) * 16 + (lane & 15);
        const float invf_rev = exp2f(-(float)jf * 0.10462765653f) * 0.15915494309189535f;
#pragma unroll
        for (int m = 0; m < 4; ++m)
#pragma unroll
          for (int j = 0; j < 4; ++j) {
            const int row = m * 16 + (lane >> 4) * 4 + j;
            const float tf = (float)(trow + row);
            const float ph = tf * invf_rev, pl = fmaf(tf, invf_rev, -ph);
            const float fr = (ph - floorf(ph)) + pl;
            const float sn = __builtin_amdgcn_sinf(fr), cs = __builtin_amdgcn_cosf(fr);
            const float x1 = acc[m][n1][j], x2 = acc[m][n1 + 2][j];
            reg[row * 136 + n1 * 16 + (lane & 15)] = f2bf((x1 * cs - x2 * sn) * sc);
            reg[row * 136 + n1 * 16 + 32 + (lane & 15)] = f2bf((x2 * cs + x1 * sn) * sc);
          }
      }
      EPI_FENCE();
      epi_store_bf16_128(reg, dst, 1024, trow, cq + wn * 128, lane);
    } else if (nt == 52) {
      float* DT = (float*)(p.ws + OFF_DT);
      if (wn == 0) {
#pragma unroll
        for (int n = 0; n < 2; ++n) {
          const int col = n * 16 + (lane & 15);
          const float bias = p.in[6][col];
#pragma unroll
          for (int m = 0; m < 4; ++m)
#pragma unroll
            for (int j = 0; j < 4; ++j) {
              const int t = trow + m * 16 + (lane >> 4) * 4 + j;
              if (t < L) {
                const float x = acc[m][n][j] + bias;
                const float e = __expf(x);
                DT[(size_t)t * 32 + col] = (x > 20.f) ? x : (e < 0.01f ? e * (1.f - 0.5f * e + e * e * (1.f / 3.f)) : __logf(1.f + e));
              }
            }
        }
      }
    } else {
      u16* dst; int ld, c0; bool sig = false;
      if (nt < 8) { dst = (u16*)(p.ws + OFF_Z); ld = 2048; c0 = n0; }
      else if (nt < 20) { dst = (u16*)(p.ws + OFF_XBC); ld = 3072; c0 = n0 - 2048; }
      else if (nt < 36) { dst = (u16*)(p.ws + OFF_V); ld = 2048; c0 = n0 - 7168; }
      else if (nt < 44) { dst = (u16*)(p.ws + OFF_G); ld = 2048; c0 = n0 - 9216; }
      else if (nt < 48) { dst = (u16*)(p.ws + OFF_GS); ld = 1024; c0 = n0 - 11264; sig = true; }
      else { dst = (u16*)(p.ws + OFF_GR); ld = 1024; c0 = n0 - 12288; sig = true; }
#pragma unroll
      for (int m = 0; m < 4; ++m)
#pragma unroll
        for (int n = 0; n < 8; ++n)
#pragma unroll
          for (int j = 0; j < 4; ++j) {
            float v = acc[m][n][j];
            if (sig) v = sigmoid_f(v);
            reg[(m * 16 + (lane >> 4) * 4 + j) * 136 + n * 16 + (lane & 15)] = f2bf(v);
          }
      EPI_FENCE();
      epi_store_bf16_128(reg, dst, ld, trow, c0 + wn * 128, lane);
    }
    __syncthreads();
  }
}

DEV void phase_merge8(const Params& p, char* smem, char* smem_team) {
  u16* GS = (u16*)(p.ws + OFF_GS);
  u16* GR = (u16*)(p.ws + OFF_GR);
  const u16* Zb = (const u16*)(p.ws + OFF_Z);
  const u16* Gb = (const u16*)(p.ws + OFF_G);
  const u16* WBS = (const u16*)(p.ws + OFF_S2);
  const u16* WBR = (const u16*)(p.ws + OFF_S2 + 4194304);
  for (int kk = 0;; ++kk) {
    const int it = tile_index(kk);
    if (it >= 256) break;
    const int branch = it >> 7, tl = it & 127, mt = tl >> 2, nt = tl & 3;
    f32x4 acc[4][8];
    ZERO_ACC(acc, 8)
    gemm_tile8<8>(acc, branch ? Gb : Zb, 2048, mt * 256, L - 1, branch ? WBR : WBS, 2048, nt * 256, 2048, smem);
    const int tid = get_tid8(), lane = tid & 63, w = tid >> 6, wm = w >> 1, wn = w & 1;
    float* reg = (float*)(smem + w * EPI_WAVE_BYTES);
    u16* GT = branch ? GR : GS;
#pragma unroll
    for (int hf = 0; hf < 2; ++hf) {
#pragma unroll
      for (int m = 0; m < 4; ++m)
#pragma unroll
        for (int n = 0; n < 4; ++n)
#pragma unroll
          for (int j = 0; j < 4; ++j) reg[(m * 16 + (lane >> 4) * 4 + j) * 68 + n * 16 + (lane & 15)] = acc[m][hf * 4 + n][j];
      EPI_FENCE();
#pragma unroll
      for (int j = 0; j < 16; ++j) {
        const int row = (lane >> 4) + 4 * j, c4 = (lane & 15) * 4;
        const f32x4 a = *(const f32x4*)(reg + row * 68 + c4);
        const size_t idx = (size_t)(mt * 256 + wm * 64 + row) * 1024 + nt * 256 + wn * 128 + hf * 64 + c4;
        const u32x2 g = *(const u32x2*)(GT + idx);
        u32x2 o; o[0] = pack2(lo_f(g[0]) * a[0], hi_f(g[0]) * a[1]); o[1] = pack2(lo_f(g[1]) * a[2], hi_f(g[1]) * a[3]);
        *(u32x2*)(GT + idx) = o;
      }
      EPI_FENCE();
    }
    __syncthreads();
  }
  for (int ct = get_rbid(); ct < 128; ct += gridDim.x) {
    const int tid = get_tid8(), lane = tid & 63, w = tid >> 6;
    const int branch = ct >> 6, c16 = ct & 63;
    f32x4* red = (f32x4*)smem;
    red[w * 64 + lane] = thin16((branch ? Gb : Zb) + w * 256, 2048, 8192, (branch ? WBR : WBS) + w * 256, 2048, c16 * 16, 256, lane);
    __syncthreads();
    if (w == 0) {
      u16* GT = branch ? GR : GS;
      f32x4 a1 = red[lane];
#pragma unroll
      for (int q = 1; q < 8; ++q) a1 += red[q * 64 + lane];
#pragma unroll
      for (int j = 0; j < 4; ++j) {
        const size_t idx = (size_t)(8192 + (lane >> 4) * 4 + j) * 1024 + c16 * 16 + (lane & 15);
        GT[idx] = f2bf(bf2f(GT[idx]) * a1[j]);
      }
    }
    __syncthreads();
  }
  {
    float* RSS = (float*)(p.ws + OFF_RSS);
    for (int i = get_bid() * 256 + get_tid(); i < L; i += nworkers() * 256) RSS[i] = 0.f;
  }
  const int n_wout = 16 * 16, n_wup = 16 * 88, n_wdown = 44 * 16;
  for (int it = get_bid(); it < n_wout + n_wup + n_wdown; it += nworkers()) {
    if (it < n_wout) { convert_tile(p.in[12], 1024, 1024, (u16*)(p.ws + OFF_WOUT), it & 15, it >> 4, 0, smem_team); }
    else if (it < n_wout + n_wup) { const int j = it - n_wout; convert_tile(p.in[14], 5632, 1024, (u16*)(p.ws + OFF_WUP), j & 15, j >> 4, 2, smem_team, p.in[13]);   }
    else { const int j = it - n_wout - n_wup; convert_tile(p.in[17], 1024, 2816, (u16*)(p.ws + OFF_WDOWN), j % 44, j / 44, 0, smem_team); }
  }
}

DEV void phase_outproj8(const Params& p, int b, char* smem) {
  const int tid = get_tid8(), lane = tid & 63, w = tid >> 6, wm = w >> 1, wn = w & 1, r = lane & 31, h = lane >> 5;
  u16* U2 = (u16*)(p.ws + OFF_U2);
  float* RSS = (float*)(p.ws + OFF_RSS);
  const u16* Mg = (const u16*)(p.ws + OFF_GS);
  const u16* WO = (const u16*)(p.ws + OFF_WOUT);
  float* reg = (float*)(smem + w * EPI_WAVE_BYTES);
  for (int kk = 0;; ++kk) {
    const int it = tile_index(kk);
    if (it >= 256) break;
    const int mt = it >> 3, nt = it & 7;
    f32x4 acc[4][4];
    ZERO_ACC(acc, 4)
    gemm_tile8<4, true>(acc, Mg, 1024, mt * 256, L - 1, WO, 1024, nt * 128, 1024, smem, (const u16*)(p.ws + OFF_GR));
#pragma unroll
    for (int m = 0; m < 4; ++m)
#pragma unroll
      for (int n = 0; n < 4; ++n)
#pragma unroll
        for (int j = 0; j < 4; ++j) reg[(m * 16 + (lane >> 4) * 4 + j) * 68 + n * 16 + (lane & 15)] = acc[m][n][j];
    EPI_FENCE();
#pragma unroll
    for (int j = 0; j < 16; ++j) {
      const int row = (lane >> 4) + 4 * j, c4 = (lane & 15) * 4;
      const f32x4 a = *(const f32x4*)(reg + row * 68 + c4);
      const int t = mt * 256 + wm * 64 + row, col = nt * 128 + wn * 64 + c4;
      f32x4 hv;
      if (t < NMETA) {
        hv = *(const f32x4*)(p.in[1] + t * 1024 + col) + a;
      } else {
        const size_t idx = ((size_t)b * SEQ + (t - NMETA)) * 1024 + col;
        hv = *(const f32x4*)(p.in[0] + idx) + a;
        *(f32x4*)(p.out + idx) = hv;
      }
      u32x2 hb; hb[0] = pack2(hv[0], hv[1]); hb[1] = pack2(hv[2], hv[3]);
      *(u32x2*)(U2 + (size_t)t * 1024 + col) = hb;
      float sq = hv[0] * hv[0] + hv[1] * hv[1] + hv[2] * hv[2] + hv[3] * hv[3];
      sq += __shfl_xor(sq, 1); sq += __shfl_xor(sq, 2); sq += __shfl_xor(sq, 4); sq += __shfl_xor(sq, 8);
      if ((lane & 15) == 0) atomicAdd(&RSS[t], sq);
    }
    __syncthreads();
  }
  for (int ct = get_rbid(); ct < 64; ct += gridDim.x) {
    const int tid = get_tid8(), lane = tid & 63, w = tid >> 6;
    f32x4* red = (f32x4*)smem;
    red[w * 64 + lane] = thin16(Mg + w * 128, 1024, 8192, WO + w * 128, 1024, ct * 16, 128, lane)
                       + thin16((const u16*)(p.ws + OFF_GR) + w * 128, 1024, 8192, WO + w * 128, 1024, ct * 16, 128, lane);
    __syncthreads();
    if (w == 0) {
      f32x4 a1 = red[lane];
#pragma unroll
      for (int q = 1; q < 8; ++q) a1 += red[q * 64 + lane];
#pragma unroll
      for (int j = 0; j < 4; ++j) {
        const int t = 8192 + (lane >> 4) * 4 + j;
        const size_t idx = ((size_t)b * SEQ + (t - NMETA)) * 1024 + ct * 16 + (lane & 15);
        const float hv = p.in[0][idx] + a1[j];
        p.out[idx] = hv;
        U2[(size_t)t * 1024 + ct * 16 + (lane & 15)] = f2bf(hv);
        float sq = hv * hv;
        sq += __shfl_xor(sq, 1); sq += __shfl_xor(sq, 2); sq += __shfl_xor(sq, 4); sq += __shfl_xor(sq, 8);
        if ((lane & 15) == 0) atomicAdd(&RSS[t], sq);
      }
    }
    __syncthreads();
  }
}

DEV void phase_up8(const Params& p, char* smem) {
  u16* ACT = (u16*)(p.ws + OFF_ACT);
  const float* cw = p.in[15];
  const float* cbias = p.in[16];
  for (int kk = 0;; ++kk) {
    const int it = tile_index(kk);
    if (it >= 33 * 22) break;
    int mt, nt; tile_decode(it, 33, 22, mt, nt);
    f32x4 acc[4][8];
    ZERO_ACC(acc, 8)
    gemm_tile8<8>(acc, (const u16*)(p.ws + OFF_U2), 1024, mt * 254 - 2, L - 1, (const u16*)(p.ws + OFF_WUP), 1024, nt * 256, 1024, smem);
    const int tid = get_tid8(), lane = tid & 63, w = tid >> 6;
    u16* reg = (u16*)(smem + w * EPI_WAVE_BYTES);
    {
      const float* RSS = (const float*)(p.ws + OFF_RSS);
      const int wm = w >> 1;
#pragma unroll
      for (int m = 0; m < 4; ++m)
#pragma unroll
        for (int j = 0; j < 4; ++j) {
          int t = mt * 254 - 2 + wm * 64 + m * 16 + (lane >> 4) * 4 + j; t = t < 0 ? 0 : (t > L - 1 ? L - 1 : t);
          const float rstd = rsqrtf(RSS[t] * (1.f / 1024.f) + EPS);
#pragma unroll
          for (int n = 0; n < 8; ++n) reg[(m * 16 + (lane >> 4) * 4 + j) * 136 + n * 16 + (lane & 15)] = f2bf(acc[m][n][j] * rstd);
        }
    }
    __syncthreads();
    {
      const int cg = tid & 15, rg = tid >> 4;
      const int ch = nt * 128 + cg * 8;
      float wg[3][8], wv[3][8], bg[8], bv[8], g2[8], g1[8], v2[8], v1[8];
#pragma unroll
      for (int k = 0; k < 3; ++k) {
        const f32x4 a0 = *(const f32x4*)(cw + k * 5632 + ch), a1 = *(const f32x4*)(cw + k * 5632 + ch + 4);
        const f32x4 c0 = *(const f32x4*)(cw + k * 5632 + 2816 + ch), c1 = *(const f32x4*)(cw + k * 5632 + 2816 + ch + 4);
#pragma unroll
        for (int j = 0; j < 4; ++j) { wg[k][j] = a0[j]; wg[k][4 + j] = a1[j]; wv[k][j] = c0[j]; wv[k][4 + j] = c1[j]; }
      }
      {
        const f32x4 a0 = *(const f32x4*)(cbias + ch), a1 = *(const f32x4*)(cbias + ch + 4);
        const f32x4 c0 = *(const f32x4*)(cbias + 2816 + ch), c1 = *(const f32x4*)(cbias + 2816 + ch + 4);
#pragma unroll
        for (int j = 0; j < 4; ++j) { bg[j] = a0[j]; bg[4 + j] = a1[j]; bv[j] = c0[j]; bv[4 + j] = c1[j]; }
      }
      const int R0 = rg * 8;
#pragma unroll
      for (int q = 0; q < 2; ++q) {
        const int R = R0 - 2 + q;
        u32x4 gvv = {0u, 0u, 0u, 0u}, vvv = {0u, 0u, 0u, 0u};
        if (R >= 0 && mt * 254 - 2 + R >= 0) {
          const char* sl = smem + ((R >> 6) * 2) * EPI_WAVE_BYTES + ((R & 63) * 136 + cg * 8) * 2;
          gvv = *(const u32x4*)sl; vvv = *(const u32x4*)(sl + EPI_WAVE_BYTES);
        }
#pragma unroll
        for (int j = 0; j < 4; ++j) {
          if (q == 0) { g2[2 * j] = lo_f(gvv[j]); g2[2 * j + 1] = hi_f(gvv[j]); v2[2 * j] = lo_f(vvv[j]); v2[2 * j + 1] = hi_f(vvv[j]); }
          else { g1[2 * j] = lo_f(gvv[j]); g1[2 * j + 1] = hi_f(gvv[j]); v1[2 * j] = lo_f(vvv[j]); v1[2 * j + 1] = hi_f(vvv[j]); }
        }
      }
#pragma unroll 2
      for (int i = 0; i < 8; ++i) {
        const int R = R0 + i, t = mt * 254 - 2 + R;
        u32x4 gvv = {0u, 0u, 0u, 0u}, vvv = {0u, 0u, 0u, 0u};
        if (t >= 0) {
          const char* sl = smem + ((R >> 6) * 2) * EPI_WAVE_BYTES + ((R & 63) * 136 + cg * 8) * 2;
          gvv = *(const u32x4*)sl; vvv = *(const u32x4*)(sl + EPI_WAVE_BYTES);
        }
        float o[8];
#pragma unroll
        for (int j = 0; j < 8; ++j) {
          const float gx = (j & 1) ? hi_f(gvv[j >> 1]) : lo_f(gvv[j >> 1]);
          const float vx = (j & 1) ? hi_f(vvv[j >> 1]) : lo_f(vvv[j >> 1]);
          const float ag = bg[j] + wg[0][j] * g2[j] + wg[1][j] * g1[j] + wg[2][j] * gx;
          const float av = bv[j] + wv[0][j] * v2[j] + wv[1][j] * v1[j] + wv[2][j] * vx;
          o[j] = silu_f(ag) * av;
          g2[j] = g1[j]; g1[j] = gx; v2[j] = v1[j]; v1[j] = vx;
        }
        if (R >= 2 && t < L) {
          u32x4 pk; pk[0] = pack2(o[0], o[1]); pk[1] = pack2(o[2], o[3]); pk[2] = pack2(o[4], o[5]); pk[3] = pack2(o[6], o[7]);
          *(u32x4*)(ACT + (size_t)t * 2816 + ch) = pk;
        }
      }
    }
    __syncthreads();
  }
}

DEV void phase_down8(const Params& p, int b, char* smem) {
  for (int kk = 0;; ++kk) {
    const int it = tile_index(kk);
    if (it >= 256) break;
    const int mt = it >> 3, nt = it & 7;
    f32x4 acc[4][4];
    ZERO_ACC(acc, 4)
    gemm_tile8<4>(acc, (const u16*)(p.ws + OFF_ACT), 2816, NMETA + mt * 256, L - 1, (const u16*)(p.ws + OFF_WDOWN), 2816, nt * 128, 2816, smem);
    const int tid = get_tid8(), lane = tid & 63, w = tid >> 6, wm = w >> 1, wn = w & 1, r = lane & 31, h = lane >> 5;
    float* reg = (float*)(smem + w * EPI_WAVE_BYTES);
#pragma unroll
    for (int m = 0; m < 4; ++m)
#pragma unroll
      for (int n = 0; n < 4; ++n)
#pragma unroll
        for (int j = 0; j < 4; ++j) reg[(m * 16 + (lane >> 4) * 4 + j) * 68 + n * 16 + (lane & 15)] = acc[m][n][j];
    EPI_FENCE();
#pragma unroll
    for (int j = 0; j < 16; ++j) {
      const int row = (lane >> 4) + 4 * j, c4 = (lane & 15) * 4;
      const f32x4 a = *(const f32x4*)(reg + row * 68 + c4);
      const size_t idx = ((size_t)b * SEQ + mt * 256 + wm * 64 + row) * 1024 + nt * 128 + wn * 64 + c4;
      const f32x4 x = *(const f32x4*)(p.out + idx);
      *(f32x4*)(p.out + idx) = x + a;
    }
    __syncthreads();
  }
}

#define XB_TMO      128
#define XB_XCNT(j)  (256  + 64 * (j))
#define XB_XSUB(j)  (1280 + 64 * (j))
#define XB_XGEN(j)  (2304 + 64 * (j))
#define XB_TOP      3328
#define XB_TOPGEN   3392
#define XCD_BAR_WORDS 3456
#define XB_SPIN_CAP (1u << 24)
DEV unsigned xb_ld(unsigned* p)              { return __hip_atomic_load(p, __ATOMIC_RELAXED, __HIP_MEMORY_SCOPE_AGENT); }
DEV unsigned xb_add(unsigned* p, unsigned v) { return __hip_atomic_fetch_add(p, v, __ATOMIC_RELAXED, __HIP_MEMORY_SCOPE_AGENT); }
DEV unsigned xb_xcc_id() { return (unsigned)__builtin_amdgcn_s_getreg((3 << 11) | 20) & 0xFu; }
#define XB_SPIN(cond, bar) do { unsigned _sp = 0; while (cond) { __builtin_amdgcn_s_sleep(1); \
    if ((++_sp & 255u) == 0u) { if (xb_ld(&(bar)[XB_TMO])) break; if (_sp > XB_SPIN_CAP) { atomicAdd(&(bar)[XB_TMO], 1u); break; } } } } while (0)
struct XcdBarrier { unsigned* bar; unsigned x; volatile LDSP unsigned* st; };
DEV XcdBarrier xcd_barrier_post(unsigned* bar, volatile LDSP unsigned* st) {
  XcdBarrier b; b.bar = bar; b.x = xb_xcc_id(); b.st = st;
  if (threadIdx.x == 0) (void)xb_add(&bar[XB_XCNT(b.x)], 1u);
  return b;
}
DEV void xcd_barrier_complete(unsigned* bar, unsigned x, unsigned& nloc, unsigned& nx) {
  const unsigned G = gridDim.x * gridDim.y * gridDim.z;
  unsigned sum, cnt, mine, sp = 0u;
  for (;;) {
    sum = 0u; cnt = 0u; mine = 0u;
#pragma unroll
    for (unsigned j = 0; j < 16; ++j) { const unsigned c = xb_ld(&bar[XB_XCNT(j)]); sum += c; cnt += (c > 0u) ? 1u : 0u; mine = (j == x) ? c : mine; }
    if (sum == G) break;
    __builtin_amdgcn_s_sleep(1);
    if ((++sp & 255u) == 0u) { if (xb_ld(&bar[XB_TMO])) break; if (sp > XB_SPIN_CAP) { atomicAdd(&bar[XB_TMO], 1u); break; } }
  }
  nloc = mine > 0u ? mine : 1u; nx = cnt > 0u ? cnt : 1u;
}
DEV void xcd_barrier(const XcdBarrier& b) {
  asm volatile("s_waitcnt vmcnt(0)" ::: "memory");
  __syncthreads();
  if (threadIdx.x == 0) {
    unsigned* bar = b.bar;
    __builtin_amdgcn_s_waitcnt(0);
    unsigned nloc = b.st[0], nx = b.st[1];
    if (nloc == 0u) { xcd_barrier_complete(bar, b.x, nloc, nx); b.st[0] = nloc; b.st[1] = nx; }
    const unsigned old = xb_add(&bar[XB_XSUB(b.x)], 1u);
    const unsigned gen = old / nloc;
    if (old + 1u == (gen + 1u) * nloc) {
      __builtin_amdgcn_fence(__ATOMIC_RELEASE, "agent");
      asm volatile("s_waitcnt vmcnt(0)" ::: "memory");
      const unsigned og = xb_add(&bar[XB_TOP], 1u);
      const unsigned tg = og / nx;
      if (og + 1u == (tg + 1u) * nx) xb_add(&bar[XB_TOPGEN], 1u);
      else XB_SPIN(xb_ld(&bar[XB_TOPGEN]) == tg, bar);
      __builtin_amdgcn_fence(__ATOMIC_ACQUIRE, "agent");
      xb_add(&bar[XB_XGEN(b.x)], 1u);
      asm volatile("s_waitcnt vmcnt(0)" ::: "memory");
    } else {
      XB_SPIN(xb_ld(&bar[XB_XGEN(b.x)]) == gen, bar);
      __builtin_amdgcn_fence(__ATOMIC_ACQUIRE, "agent");
      asm volatile("s_waitcnt vmcnt(0)" ::: "memory");
    }
  }
  __syncthreads();
}

constexpr int N_PHASES = 19;

__global__ void __launch_bounds__(512) fwd_kernel(Params p, int ph0, int ph1) {
  __shared__ __attribute__((aligned(16))) char smem[SMEM_BYTES];
  __shared__ uint4 xb_words;
  if (threadIdx.x == 0) xb_words = make_uint4(0u, 0u, 0u, 0u);
  __syncthreads();
  XcdBarrier xb = xcd_barrier_post((unsigned*)(p.ws + OFF_BAR), (volatile LDSP unsigned*)&xb_words);
  if (ph1 < 0) cg::this_grid().sync();
  for (int ph = ph0; ph < ph1; ++ph) {
    char* tsm = smem + (get_tid8() >> 8) * SMEM_TEAM;
    const int b = ph >= 10 ? 1 : 0;
    const int lp = (ph == 0) ? 0 : (ph == 18 ? 9 : (ph >= 10 ? ph - 9 : ph));
    switch (lp) {
      case 0: phase_prep(p, 0, true, tsm); break;
      case 1: phase_inproj8(p, b, smem); break;
      case 2: {
        int it = get_bid();
        for (; it < 1024; it += nworkers()) ret_kv_item(p, it, tsm);
        for (; it < 2048; it += nworkers()) ssd_state_item(p, it - 1024, tsm);
      } break;
      case 3: phase_scan(p); break;
      case 4: {
        {
          const int rb0 = get_rbid(), rb = (rb0 & 7) * 32 + (rb0 >> 3), team = get_tid8() >> 8;
          for (int j = 0; j < 3; ++j) {
            int kind = -1, idx = 0;
            if (j == 0) {
              if (rb >= 2) { const int k = rb - 2; kind = 0; idx = (1 + (k >> 1)) * 4 + (k & 1) * 2 + team; }
            } else if (j == 1) {
              kind = 1; idx = rb * 2 + team;
            } else {
              if (rb < 2) { kind = 1; idx = (256 + rb) * 2 + team; }
              else if (rb < 6) { const int k = rb - 2; kind = 0; idx = ((k >> 1) ? 0 : 128) * 4 + (k & 1) * 2 + team; }
            }
            if (kind == 0) ret_out_item(p, idx, tsm);
            else if (kind == 1) ssd_out_item(p, idx, tsm);
          }
        }
      } break;
      case 5: phase_merge8(p, smem, tsm); break;
      case 6: phase_outproj8(p, b, smem); break;
      case 7: phase_up8(p, smem); break;
      case 8: phase_down8(p, b, smem); break;
      case 9: {
        if (ph == 9) { phase_final_norm(p, 0); phase_prep(p, 1, false, tsm); }
        else phase_final_norm(p, 1);
      } break;
    }
    if (ph + 1 < ph1) xcd_barrier(xb);
  }
}

#ifndef MK_SINGLE
#define MK_SINGLE 1
#endif

extern "C" void kernel_launch(void* const* d_in, const int* in_sizes, int n_in, void* d_out, int out_size, void* d_ws, size_t ws_size,
                              hipStream_t stream) {
  static int grid_blocks = 0;
  if (!grid_blocks) {
    int dev = 0, cus = 0, per_cu = 0;
    hipGetDevice(&dev);
    hipDeviceGetAttribute(&cus, hipDeviceAttributeMultiprocessorCount, dev);
    hipOccupancyMaxActiveBlocksPerMultiprocessor(&per_cu, fwd_kernel, 512, 0);
    per_cu = 1;
    if (cus != 256) fprintf(stderr, "kernel_launch: built for a 256-CU device (static phase schedules assume 256 workgroups), found %d CUs\n", cus);
    cus = 256;
    grid_blocks = cus * per_cu;
  }
  Params p{};
  for (int i = 0; i < 19; ++i) p.in[i] = (const float*)d_in[i];
  p.out = (float*)d_out;
  p.ws = (char*)d_ws;
#if MK_SINGLE
  (void)hipMemsetAsync((char*)d_ws + OFF_BAR, 0, XCD_BAR_WORDS * 4, stream);
  int ph0 = 0, ph1 = N_PHASES;
  void* args[] = {&p, &ph0, &ph1};
  hipError_t e = hipLaunchCooperativeKernel((void*)fwd_kernel, dim3(grid_blocks), dim3(512), args, 0, stream);
  if (e != hipSuccess) fprintf(stderr, "cooperative launch failed: %s (grid %d)\n", hipGetErrorString(e), grid_blocks);
#else
  for (int ph = 0; ph < N_PHASES; ++ph) {
    hipLaunchKernelGGL(fwd_kernel, dim3(grid_blocks), dim3(512), 0, stream, p, ph, ph + 1);
  }
#endif
}
```

```cpp
#include <hip/hip_runtime.h>
#include <hip/hip_cooperative_groups.h>
#include <cstdio>
namespace cg = cooperative_groups;

typedef unsigned short u16;
typedef __bf16 bf16x8 __attribute__((ext_vector_type(8)));
typedef short s16x4 __attribute__((ext_vector_type(4)));
typedef short s16x8 __attribute__((ext_vector_type(8)));
typedef float f32x16 __attribute__((ext_vector_type(16)));
typedef unsigned int u32x4 __attribute__((ext_vector_type(4)));
typedef unsigned int u32x2 __attribute__((ext_vector_type(2)));
typedef float f32x4 __attribute__((ext_vector_type(4)));

#define DEV __device__ __forceinline__
#define LDSP __attribute__((address_space(3)))

constexpr int D = 1024;
constexpr int L = 8208;
constexpr int SEQ = 8192;
constexpr int NMETA = 16;
constexpr int NPROJ = 13344;
constexpr int NPROJ_PAD = 13568;
constexpr int DFF = 2816;
constexpr float EPS = 1e-6f;

constexpr size_t OFF_Z = 0;
constexpr size_t OFF_G = 33619968;
constexpr size_t OFF_GS = 67239936;
constexpr size_t OFF_GR = 84049920;
constexpr size_t OFF_Q = 100859904;
constexpr size_t OFF_XBC = 117669888;
constexpr size_t OFF_K = 168099840;
constexpr size_t OFF_V = 184909824;
constexpr size_t OFF_DT = 218529792;
constexpr size_t OFF_S2 = 219580416;
constexpr size_t OFF_S1 = 227969024;
constexpr size_t OFF_CD = 261523456;
constexpr size_t OFF_HM = 261531648;
constexpr size_t OFF_BAR = 261597184;
constexpr size_t OFF_RSS = 261611520;
constexpr size_t OFF_WOUT = OFF_S1;
constexpr size_t OFF_WUP = OFF_S1 + 2097152;
constexpr size_t OFF_WDOWN = OFF_S1 + 13631488;
constexpr size_t OFF_UP = OFF_XBC;
constexpr size_t OFF_ACT = OFF_Z;
constexpr size_t OFF_U2 = OFF_Q;
constexpr size_t OUT_HALF = 33554432;

constexpr int SMEM_TEAM = 73728;
constexpr int SMEM_BYTES = 2 * SMEM_TEAM;

struct Params {
  const float* in[19];
  float* out;
  char* ws;
};

DEV int get_tid8() { int t = threadIdx.x; asm volatile("" : "+v"(t)); return t; }
DEV int get_tid() { int t = threadIdx.x & 255; asm volatile("" : "+v"(t)); return t; }
DEV int get_rbid() { int t = blockIdx.x; asm volatile("" : "+s"(t)); return t; }
DEV int get_bid() { int t = get_rbid() * 2 + (get_tid8() >> 8); return __builtin_amdgcn_readfirstlane(t); }
DEV int nworkers() { return (int)gridDim.x * 2; }
DEV float bf2f(u16 h) { return __uint_as_float(((unsigned)h) << 16); }
typedef __bf16 bf16x2_t __attribute__((ext_vector_type(2)));
typedef float f32x2_t __attribute__((ext_vector_type(2)));
DEV u16 f2bf(float f) { const __bf16 h = (__bf16)f; return __builtin_bit_cast(u16, h); }
DEV unsigned pack2(float a, float b) { const f32x2_t v = {a, b}; return __builtin_bit_cast(unsigned, __builtin_convertvector(v, bf16x2_t)); }
DEV float silu_f(float x) { return x * __builtin_amdgcn_rcpf(1.f + __expf(-x)); }
DEV float sigmoid_f(float x) { return __builtin_amdgcn_rcpf(1.f + __expf(-x)); }
DEV float lo_f(unsigned u) { return __uint_as_float(u << 16); }
DEV float hi_f(unsigned u) { return __uint_as_float(u & 0xffff0000u); }
DEV float wave_sum(float v) {
#pragma unroll
  for (int o = 32; o > 0; o >>= 1) v += __shfl_xor(v, o);
  return v;
}
DEV float half_sum(float v) {
#pragma unroll
  for (int o = 16; o > 0; o >>= 1) v += __shfl_xor(v, o);
  return v;
}
DEV float log_gamma(int h) {
  return h == 0 ? -0.0317486983145803f : (h == 1 ? -0.015748356968139168f : (h == 2 ? -0.007843177461025893f : -0.003913899321136329f));
}
DEV f32x16 mfma(bf16x8 a, bf16x8 b, f32x16 c) { return __builtin_amdgcn_mfma_f32_32x32x16_bf16(a, b, c, 0, 0, 0); }
DEV f32x16 zero16() { f32x16 z;
#pragma unroll
  for (int i = 0; i < 16; ++i) z[i] = 0.f;
  return z; }
DEV int acc_row(int i, int h) { return (i & 3) + 8 * (i >> 2) + 4 * h; }

DEV bf16x8 frag_tr(const u16* T, int ld, int k0, int x0, int lane) {
  const int h = lane >> 5, blk = (lane >> 4) & 1, q = (lane & 15) >> 2, pp = lane & 3;
  const u16* a0 = T + (k0 + 8 * h + q) * ld + x0 + 16 * blk + 4 * pp;
  s16x4 lo = __builtin_amdgcn_ds_read_tr16_b64_v4i16((LDSP s16x4*)a0);
  s16x4 hi = __builtin_amdgcn_ds_read_tr16_b64_v4i16((LDSP s16x4*)(a0 + 4 * ld));
  s16x8 v = {lo[0], lo[1], lo[2], lo[3], hi[0], hi[1], hi[2], hi[3]};
  return __builtin_bit_cast(bf16x8, v);
}
DEV bf16x8 frag_row(const u16* T, int ld, int row, int k) {
  return *(const bf16x8*)(T + row * ld + k);
}

template <int MI>
DEV void gemm_tile(f32x16 (&acc)[MI][2], const u16* __restrict__ A, int lda, int arow0, int arow_max,
                   const u16* __restrict__ B, int ldb, int brow0, int K, char* smem) {
  constexpr int BM = MI * 64;
  constexpr int LD = 72;
  constexpr int ACH = BM * 8 / 256;
  u16* As = (u16*)smem;
  u16* Bs = As + BM * LD;
  const int tid = get_tid(), lane = tid & 63, w = tid >> 6, wm = w >> 1, wn = w & 1, r = lane & 31, h = lane >> 5;
  u32x4 ra[ACH], rb[4];
  const u16* ap[ACH];
  const u16* bp[4];
#pragma unroll
  for (int i = 0; i < ACH; ++i) {
    int c = tid + i * 256, row = c >> 3, kc = c & 7;
    int gr = arow0 + row; gr = gr > arow_max ? arow_max : gr;
    ap[i] = A + (size_t)gr * lda + kc * 8;
  }
#pragma unroll
  for (int i = 0; i < 4; ++i) {
    int c = tid + i * 256, row = c >> 3, kc = c & 7;
    bp[i] = B + (size_t)(brow0 + row) * ldb + kc * 8;
  }
#pragma unroll
  for (int i = 0; i < ACH; ++i) ra[i] = *(const u32x4*)(ap[i]);
#pragma unroll
  for (int i = 0; i < 4; ++i) rb[i] = *(const u32x4*)(bp[i]);
  const int nk = K >> 6;
  for (int kt = 0; kt < nk; ++kt) {
#pragma unroll
    for (int i = 0; i < ACH; ++i) { int c = tid + i * 256, row = c >> 3, kc = c & 7; *(u32x4*)(As + row * LD + kc * 8) = ra[i]; }
#pragma unroll
    for (int i = 0; i < 4; ++i) { int c = tid + i * 256, row = c >> 3, kc = c & 7; *(u32x4*)(Bs + row * LD + kc * 8) = rb[i]; }
    __syncthreads();
    if (kt + 1 < nk) {
#pragma unroll
      for (int i = 0; i < ACH; ++i) ra[i] = *(const u32x4*)(ap[i] + (kt + 1) * 64);
#pragma unroll
      for (int i = 0; i < 4; ++i) rb[i] = *(const u32x4*)(bp[i] + (kt + 1) * 64);
    }
#pragma unroll
    for (int ks = 0; ks < 4; ++ks) {
      bf16x8 a[MI], b[2];
#pragma unroll
      for (int mi = 0; mi < MI; ++mi) a[mi] = frag_row(As, LD, wm * MI * 32 + mi * 32 + r, ks * 16 + h * 8);
#pragma unroll
      for (int ni = 0; ni < 2; ++ni) b[ni] = frag_row(Bs, LD, wn * 64 + ni * 32 + r, ks * 16 + h * 8);
#pragma unroll
      for (int mi = 0; mi < MI; ++mi)
#pragma unroll
        for (int ni = 0; ni < 2; ++ni) acc[mi][ni] = mfma(a[mi], b[ni], acc[mi][ni]);
    }
    __syncthreads();
  }
}

DEV int orig_col(int n) {
  if (n < 5120) return n;
  if (n < 7168) {
    int q = n - 5120; int which = q >> 10; int c = q & 1023; int head = c >> 8; int ip = c & 255; int blk = ip >> 6; int wi = ip & 63;
    int j = (wi < 32) ? (blk * 32 + wi) : (128 + blk * 32 + wi - 32);
    return 5152 + which * 1024 + head * 256 + j;
  }
  if (n < 13312) return n + 32;
  if (n < 13344) return 5120 + (n - 13312);
  return -1;
}
DEV void convert_tile(const float* __restrict__ W, int Nsrc, int K, u16* __restrict__ WT, int kt, int ntile, int mode, char* smem, const float* __restrict__ kscale = nullptr) {
  float* t = (float*)smem;
  const int tid = get_tid();
  {
    const int tx = tid & 15, ty = tid >> 4;
    const int n = ntile * 64 + tx * 4;
    int on = n;
    if (mode == 1) on = orig_col(n);
    else if (mode == 2) { const int tl = n >> 8, wi = n & 255; on = (wi < 128) ? (tl * 128 + wi) : (2816 + tl * 128 + wi - 128); }
#pragma unroll
    for (int kk = ty; kk < 64; kk += 16) {
      f32x4 v = {0.f, 0.f, 0.f, 0.f};
      if (on >= 0) v = *(const f32x4*)(W + (size_t)(kt * 64 + kk) * Nsrc + on);
      if (kscale) v = v * kscale[kt * 64 + kk];
      *(f32x4*)(t + kk * 68 + tx * 4) = v;
    }
  }
  __syncthreads();
  {
    const int nn = tid >> 2, kq = (tid & 3) * 16;
    u32x4 o[2];
#pragma unroll
    for (int j = 0; j < 8; ++j) o[j >> 2][j & 3] = pack2(t[(kq + 2 * j) * 68 + nn], t[(kq + 2 * j + 1) * 68 + nn]);
    u16* d = WT + (size_t)(ntile * 64 + nn) * K + kt * 64 + kq;
    *(u32x4*)d = o[0]; *(u32x4*)(d + 8) = o[1];
  }
  __syncthreads();
}

DEV void rmsnorm_row_bf16(const float* __restrict__ src, const float* __restrict__ w, u16* __restrict__ dst, int lane) {
  f32x4 v[4]; float ss = 0.f;
#pragma unroll
  for (int j = 0; j < 4; ++j) { v[j] = *(const f32x4*)(src + j * 256 + lane * 4); ss += v[j][0] * v[j][0] + v[j][1] * v[j][1] + v[j][2] * v[j][2] + v[j][3] * v[j][3]; }
  ss = wave_sum(ss);
  const float rstd = rsqrtf(ss * (1.f / 1024.f) + EPS);
#pragma unroll
  for (int j = 0; j < 4; ++j) {
    f32x4 ww = *(const f32x4*)(w + j * 256 + lane * 4);
    u32x2 o; o[0] = pack2(v[j][0] * rstd * ww[0], v[j][1] * rstd * ww[1]); o[1] = pack2(v[j][2] * rstd * ww[2], v[j][3] * rstd * ww[3]);
    *(u32x2*)(dst + j * 256 + lane * 4) = o;
  }
}
DEV void rmsnorm_row_f32_inplace(float* __restrict__ row, const float* __restrict__ w, int lane) {
  f32x4 v[4]; float ss = 0.f;
#pragma unroll
  for (int j = 0; j < 4; ++j) { v[j] = *(const f32x4*)(row + j * 256 + lane * 4); ss += v[j][0] * v[j][0] + v[j][1] * v[j][1] + v[j][2] * v[j][2] + v[j][3] * v[j][3]; }
  ss = wave_sum(ss);
  const float rstd = rsqrtf(ss * (1.f / 1024.f) + EPS);
#pragma unroll
  for (int j = 0; j < 4; ++j) {
    f32x4 ww = *(const f32x4*)(w + j * 256 + lane * 4);
    f32x4 o; o[0] = v[j][0] * rstd * ww[0]; o[1] = v[j][1] * rstd * ww[1]; o[2] = v[j][2] * rstd * ww[2]; o[3] = v[j][3] * rstd * ww[3];
    *(f32x4*)(row + j * 256 + lane * 4) = o;
  }
}

template <int R, int C, bool SCALE>
DEV void stage_conv(u16* dst, int ld, const u16* __restrict__ xbc, int row0, int ch0, const float* __restrict__ cw, const float* __restrict__ cb, const float* rs) {
  constexpr int CG = C / 8, RG = 256 / CG, RPT = R / RG;
  const int tid = get_tid();
  const int cgi = tid % CG, rgi = tid / CG;
  const int ch = ch0 + cgi * 8, r0 = rgi * RPT;
  float w[4][8], bias[8], xw[3][8];
#pragma unroll
  for (int k = 0; k < 4; ++k) {
    f32x4 a = *(const f32x4*)(cw + k * 3072 + ch), b = *(const f32x4*)(cw + k * 3072 + ch + 4);
#pragma unroll
    for (int j = 0; j < 4; ++j) { w[k][j] = a[j]; w[k][4 + j] = b[j]; }
  }
  {
    f32x4 a = *(const f32x4*)(cb + ch), b = *(const f32x4*)(cb + ch + 4);
#pragma unroll
    for (int j = 0; j < 4; ++j) { bias[j] = a[j]; bias[4 + j] = b[j]; }
  }
#pragma unroll
  for (int k = 0; k < 3; ++k) {
    const int tr = row0 + r0 - 3 + k;
    u32x4 v = {0u, 0u, 0u, 0u};
    if (tr >= 0 && tr < L) v = *(const u32x4*)(xbc + (size_t)tr * 3072 + ch);
#pragma unroll
    for (int j = 0; j < 4; ++j) { xw[k][2 * j] = lo_f(v[j]); xw[k][2 * j + 1] = hi_f(v[j]); }
  }
#pragma unroll
  for (int i = 0; i < RPT; ++i) {
    const int tr = row0 + r0 + i;
    const bool valid = tr < L;
    u32x4 v = {0u, 0u, 0u, 0u};
    if (valid) v = *(const u32x4*)(xbc + (size_t)tr * 3072 + ch);
    if (!valid) { const u32x4 z4 = {0u, 0u, 0u, 0u}; *(u32x4*)(dst + (r0 + i) * ld + cgi * 8) = z4; continue; }
    float xc[8], o[8];
#pragma unroll
    for (int j = 0; j < 4; ++j) { xc[2 * j] = lo_f(v[j]); xc[2 * j + 1] = hi_f(v[j]); }
    float sc = 1.f;
    if (SCALE) sc = rs[(cgi >> 3) * 128 + r0 + i];
#pragma unroll
    for (int j = 0; j < 8; ++j) {
      float a = bias[j] + w[0][j] * xw[0][j] + w[1][j] * xw[1][j] + w[2][j] * xw[2][j] + w[3][j] * xc[j];
      a = silu_f(a) * sc;
      o[j] = valid ? a : 0.f;
      xw[0][j] = xw[1][j]; xw[1][j] = xw[2][j]; xw[2][j] = xc[j];
    }
    u32x4 pk; pk[0] = pack2(o[0], o[1]); pk[1] = pack2(o[2], o[3]); pk[2] = pack2(o[4], o[5]); pk[3] = pack2(o[6], o[7]);
    *(u32x4*)(dst + (r0 + i) * ld + cgi * 8) = pk;
  }
}

DEV float chunk_cumsum(const float* __restrict__ DT, int c, int H, float A, float* acs, float* dts, int lane) {
  const int s0 = 2 * lane;
  const int t0 = c * 128 + s0;
  const float d0 = (t0 < L) ? DT[(size_t)t0 * 32 + H] : 0.f;
  const float d1 = (t0 + 1 < L) ? DT[(size_t)(t0 + 1) * 32 + H] : 0.f;
  const float a0 = d0 * A, a1 = a0 + d1 * A;
  float tot = a1;
#pragma unroll
  for (int o = 1; o < 64; o <<= 1) { float n = __shfl_up(tot, o); if (lane >= o) tot += n; }
  const float excl = tot - a1;
  acs[s0] = excl + a0; acs[s0 + 1] = excl + a1;
  dts[s0] = d0; dts[s0 + 1] = d1;
  return __shfl(tot, 63);
}

DEV void phase_prep(const Params& p, int b, bool first, char* smem) {
  const int tid = get_tid(), lane = tid & 63, w = tid >> 6;
  u16* U = (u16*)((char*)p.out + OUT_HALF);
  const int n_norm = L / 4;
  const int n_win = 16 * (NPROJ_PAD / 64);
  const int n_wb = first ? 2 * 32 * 16 : 0;
  const int total = n_norm + n_win + n_wb;
  for (int it = get_bid(); it < total; it += nworkers()) {
    if (it < n_norm) {
      const int t = it * 4 + w;
      const float* src = (t < NMETA) ? (p.in[1] + (size_t)t * D) : (p.in[0] + ((size_t)b * SEQ + (t - NMETA)) * D);
      rmsnorm_row_bf16(src, p.in[2], U + (size_t)t * D, lane);
    } else if (it < n_norm + n_win) {
      const int j = it - n_norm; const int ntile = j >> 4, kt = j & 15;
      convert_tile(p.in[3], NPROJ, 1024, (u16*)(p.ws + OFF_S1), kt, ntile, 1, smem);
    } else {
      int j = it - n_norm - n_win; const int which = j >> 9; j &= 511; const int ntile = j >> 5, kt = j & 31;
      convert_tile(p.in[10 + which], 1024, 2048, (u16*)(p.ws + OFF_S2 + (size_t)which * 4194304), kt, ntile, 0, smem);
    }
  }
}

DEV void phase_inproj(const Params& p, int b, char* smem) {
  const int tid = get_tid(), lane = tid & 63, w = tid >> 6, wm = w >> 1, wn = w & 1, r = lane & 31, h = lane >> 5;
  const u16* U = (const u16*)((char*)p.out + OUT_HALF);
  const u16* WT = (const u16*)(p.ws + OFF_S1);
  const int MT = 65, NT = 105;
  for (int it = get_bid(); it < MT * NT; it += gridDim.x) {
    const int nt = it / MT, mt = it % MT;
    f32x16 acc[2][2];
#pragma unroll
    for (int mi = 0; mi < 2; ++mi)
#pragma unroll
      for (int ni = 0; ni < 2; ++ni) acc[mi][ni] = zero16();
    gemm_tile<2>(acc, U, 1024, mt * 128, L - 1, WT, 1024, nt * 128, 1024, smem);
    const int n0 = nt * 128;
    if (nt >= 40 && nt < 56) {
      const bool isk = nt >= 48;
      const int cq = n0 - (isk ? 6144 : 5120);
      const int blk = ((cq & 255) >> 6) + wn;
      const int jf = blk * 32 + r;
      const double invf_rev = exp(-(double)jf * 0.07252236513367073) * 0.15915494309189535;
      const float sc = isk ? 0.0625f : 1.f;
      u16* dst = (u16*)(p.ws + (isk ? OFF_K : OFF_Q));
#pragma unroll
      for (int mi = 0; mi < 2; ++mi)
#pragma unroll
        for (int i = 0; i < 16; ++i) {
          const int t = mt * 128 + wm * 64 + mi * 32 + acc_row(i, h);
          if (t < L) {
            double rev = (double)t * invf_rev;
            rev -= floor(rev);
            const float fr = (float)rev;
            const float sn = __builtin_amdgcn_sinf(fr), cs = __builtin_amdgcn_cosf(fr);
            const float x1 = acc[mi][0][i], x2 = acc[mi][1][i];
            const float o1 = (x1 * cs - x2 * sn) * sc, o2 = (x2 * cs + x1 * sn) * sc;
            u16* d = dst + (size_t)t * 1024 + cq + wn * 64 + r;
            d[0] = f2bf(o1); d[32] = f2bf(o2);
          }
        }
    } else if (nt == 104) {
      float* DT = (float*)(p.ws + OFF_DT);
      if (wn == 0) {
        const float bias = p.in[6][r];
#pragma unroll
        for (int mi = 0; mi < 2; ++mi)
#pragma unroll
          for (int i = 0; i < 16; ++i) {
            const int t = mt * 128 + wm * 64 + mi * 32 + acc_row(i, h);
            if (t < L) {
              const float x = acc[mi][0][i] + bias;
              const float e = __expf(x);
              DT[(size_t)t * 32 + r] = (x > 20.f) ? x : (e < 0.01f ? e * (1.f - 0.5f * e + e * e * (1.f / 3.f)) : __logf(1.f + e));
            }
          }
      }
    } else {
      u16* dst; int ld, c0; bool sig = false;
      if (nt < 16) { dst = (u16*)(p.ws + OFF_Z); ld = 2048; c0 = n0; }
      else if (nt < 40) { dst = (u16*)(p.ws + OFF_XBC); ld = 3072; c0 = n0 - 2048; }
      else if (nt < 72) { dst = (u16*)(p.ws + OFF_V); ld = 2048; c0 = n0 - 7168; }
      else if (nt < 88) { dst = (u16*)(p.ws + OFF_G); ld = 2048; c0 = n0 - 9216; }
      else if (nt < 96) { dst = (u16*)(p.ws + OFF_GS); ld = 1024; c0 = n0 - 11264; sig = true; }
      else { dst = (u16*)(p.ws + OFF_GR); ld = 1024; c0 = n0 - 12288; sig = true; }
#pragma unroll
      for (int mi = 0; mi < 2; ++mi)
#pragma unroll
        for (int ni = 0; ni < 2; ++ni)
#pragma unroll
          for (int i = 0; i < 16; ++i) {
            const int t = mt * 128 + wm * 64 + mi * 32 + acc_row(i, h);
            if (t < L) {
              float v = acc[mi][ni][i];
              if (sig) v = sigmoid_f(v);
              dst[(size_t)t * ld + c0 + wn * 64 + ni * 32 + r] = f2bf(v);
            }
          }
    }
  }
}

DEV void ssd_state_item(const Params& p, int it, char* smem) {
  const int tid = get_tid(), lane = tid & 63, w = tid >> 6, wm = w >> 1, wn = w & 1, r = lane & 31, h = lane >> 5;
  const int c = it >> 4, hp = it & 15, H0 = hp * 2, g = H0 >> 3;
  u16* Xw = (u16*)smem;
  u16* Bc = Xw + 128 * 136;
  float* wsc = (float*)(Bc + 128 * 136);
  float* tmp = wsc + 256;
  const float* DT = (const float*)(p.ws + OFF_DT);
  float* CD = (float*)(p.ws + OFF_CD);
  const u16* XBC = (const u16*)(p.ws + OFF_XBC);
  if (w < 2) {
    const int H = H0 + w;
    const float A = -expf(p.in[7][H]);
    float* acs = tmp + w * 128;
    float* dts = wsc + w * 128;
    const float aend = chunk_cumsum(DT, c, H, A, acs, dts, lane);
    const int s0 = 2 * lane;
    const float w0 = __expf(aend - acs[s0]) * dts[s0], w1 = __expf(aend - acs[s0 + 1]) * dts[s0 + 1];
    dts[s0] = w0; dts[s0 + 1] = w1;
    if (lane == 0) CD[c * 32 + H] = __expf(aend);
  }
  __syncthreads();
  stage_conv<128, 128, true>(Xw, 136, XBC, c * 128, H0 * 64, p.in[4], p.in[5], wsc);
  stage_conv<128, 128, false>(Bc, 136, XBC, c * 128, 2048 + g * 128, p.in[4], p.in[5], nullptr);
  __syncthreads();
  f32x16 acc[2][2];
#pragma unroll
  for (int mi = 0; mi < 2; ++mi)
#pragma unroll
    for (int ni = 0; ni < 2; ++ni) acc[mi][ni] = zero16();
#pragma unroll
  for (int ks = 0; ks < 8; ++ks) {
    bf16x8 a[2], bq[2];
#pragma unroll
    for (int mi = 0; mi < 2; ++mi) a[mi] = frag_tr(Xw, 136, ks * 16, wm * 64 + mi * 32, lane);
#pragma unroll
    for (int ni = 0; ni < 2; ++ni) bq[ni] = frag_tr(Bc, 136, ks * 16, wn * 64 + ni * 32, lane);
#pragma unroll
    for (int mi = 0; mi < 2; ++mi)
#pragma unroll
      for (int ni = 0; ni < 2; ++ni) acc[mi][ni] = mfma(a[mi], bq[ni], acc[mi][ni]);
  }
  u16* ST = (u16*)(p.ws + OFF_S1) + (size_t)(c * 32 + H0) * 8192;
  __syncthreads();
#pragma unroll
  for (int mi = 0; mi < 2; ++mi)
#pragma unroll
    for (int ni = 0; ni < 2; ++ni)
#pragma unroll
      for (int i = 0; i < 16; ++i) Xw[(wm * 64 + mi * 32 + acc_row(i, h)) * 136 + wn * 64 + ni * 32 + r] = f2bf(acc[mi][ni][i]);
  asm volatile("s_waitcnt lgkmcnt(0)" ::: "memory");
#pragma unroll
  for (int j = 0; j < 8; ++j) {
    const int m = wm * 64 + (lane >> 3) + 8 * j, n = wn * 64 + (lane & 7) * 8;
    *(u32x4*)(ST + m * 128 + n) = *(const u32x4*)(Xw + m * 136 + n);
  }
  __syncthreads();
}

DEV void ret_kv_item(const Params& p, int it, char* smem) {
  const int tid = get_tid(), lane = tid & 63, w = tid >> 6, wm = w >> 1, wn = w & 1, r = lane & 31, h = lane >> 5;
  const int sc = it >> 5, rem = it & 31, hd = rem >> 3, dt2 = (rem >> 2) & 1, et = rem & 3;
  u16* Vt = (u16*)smem;
  u16* Kt = Vt + 128 * 136;
  const u16* Vg = (const u16*)(p.ws + OFF_V);
  const u16* Kg = (const u16*)(p.ws + OFF_K);
  const float lg = log_gamma(hd);
  f32x16 acc[2][2];
#pragma unroll
  for (int mi = 0; mi < 2; ++mi)
#pragma unroll
    for (int ni = 0; ni < 2; ++ni) acc[mi][ni] = zero16();
  for (int half = 0; half < 2; ++half) {
#pragma unroll
    for (int i = 0; i < 8; ++i) {
      const int cidx = tid + i * 256, row = cidx >> 4, cc = cidx & 15;
      const int tok = sc * 256 + half * 128 + row;
      u32x4 v = *(const u32x4*)(Vg + (size_t)tok * 2048 + hd * 512 + et * 128 + cc * 8);
      *(u32x4*)(Vt + row * 136 + cc * 8) = v;
      u32x4 kk = *(const u32x4*)(Kg + (size_t)tok * 1024 + hd * 256 + dt2 * 128 + cc * 8);
      const float dec = __expf((float)(255 - (half * 128 + row)) * lg);
      u32x4 ko;
#pragma unroll
      for (int j = 0; j < 4; ++j) ko[j] = pack2(lo_f(kk[j]) * dec, hi_f(kk[j]) * dec);
      *(u32x4*)(Kt + row * 136 + cc * 8) = ko;
    }
    __syncthreads();
#pragma unroll
    for (int ks = 0; ks < 8; ++ks) {
      bf16x8 a[2], bq[2];
#pragma unroll
      for (int mi = 0; mi < 2; ++mi) a[mi] = frag_tr(Vt, 136, ks * 16, wm * 64 + mi * 32, lane);
#pragma unroll
      for (int ni = 0; ni < 2; ++ni) bq[ni] = frag_tr(Kt, 136, ks * 16, wn * 64 + ni * 32, lane);
#pragma unroll
      for (int mi = 0; mi < 2; ++mi)
#pragma unroll
        for (int ni = 0; ni < 2; ++ni) acc[mi][ni] = mfma(a[mi], bq[ni], acc[mi][ni]);
    }
    __syncthreads();
  }
  u16* RST = (u16*)((char*)p.out + OUT_HALF) + ((size_t)(sc * 4 + hd) * 512 + et * 128) * 256 + dt2 * 128;
#pragma unroll
  for (int mi = 0; mi < 2; ++mi)
#pragma unroll
    for (int ni = 0; ni < 2; ++ni)
#pragma unroll
      for (int i = 0; i < 16; ++i) Vt[(wm * 64 + mi * 32 + acc_row(i, h)) * 136 + wn * 64 + ni * 32 + r] = f2bf(acc[mi][ni][i]);
  asm volatile("s_waitcnt lgkmcnt(0)" ::: "memory");
#pragma unroll
  for (int j = 0; j < 8; ++j) {
    const int e = wm * 64 + (lane >> 3) + 8 * j, d = wn * 64 + (lane & 7) * 8;
    *(u32x4*)(RST + (size_t)e * 256 + d) = *(const u32x4*)(Vt + e * 136 + d);
  }
  __syncthreads();
}

DEV void phase_scan(const Params& p) {
  const int gt = get_bid() * 256 + get_tid(), nth = nworkers() * 256;
  const float* CD = (const float*)(p.ws + OFF_CD);
  for (int v = gt; v < 32768 + 65536; v += nth) {
    float st[8];
#pragma unroll
    for (int j = 0; j < 8; ++j) st[j] = 0.f;
    if (v < 32768) {
      const int e0 = v * 8, H = e0 >> 13;
      u16* base = (u16*)(p.ws + OFF_S1) + e0;
      for (int c0 = 0; c0 < 64; c0 += 8) {
        u32x4 x[8];
#pragma unroll
        for (int u = 0; u < 8; ++u) x[u] = *(const u32x4*)(base + (size_t)(c0 + u) * 262144);
#pragma unroll
        for (int u = 0; u < 8; ++u) {
          const float dcy = CD[(c0 + u) * 32 + H];
          u32x4 o;
#pragma unroll
          for (int j = 0; j < 4; ++j) {
            st[2 * j] = st[2 * j] * dcy + lo_f(x[u][j]);
            st[2 * j + 1] = st[2 * j + 1] * dcy + hi_f(x[u][j]);
            o[j] = pack2(st[2 * j], st[2 * j + 1]);
          }
          *(u32x4*)(base + (size_t)(c0 + u) * 262144) = o;
        }
      }
    } else {
      const int e0 = (v - 32768) * 8, hd = e0 >> 17;
      const float g256 = __expf(256.f * log_gamma(hd));
      u16* base = (u16*)((char*)p.out + OUT_HALF) + e0;
      for (int c0 = 0; c0 < 32; c0 += 8) {
        u32x4 x[8];
#pragma unroll
        for (int u = 0; u < 8; ++u) x[u] = *(const u32x4*)(base + (size_t)(c0 + u) * 524288);
#pragma unroll
        for (int u = 0; u < 8; ++u) {
          u32x4 o;
#pragma unroll
          for (int j = 0; j < 4; ++j) {
            st[2 * j] = st[2 * j] * g256 + lo_f(x[u][j]);
            st[2 * j + 1] = st[2 * j + 1] * g256 + hi_f(x[u][j]);
            o[j] = pack2(st[2 * j], st[2 * j + 1]);
          }
          *(u32x4*)(base + (size_t)(c0 + u) * 524288) = o;
        }
      }
    }
  }
}

DEV void ssd_out_item(const Params& p, int it, char* smem) {
  const int tid = get_tid(), lane = tid & 63, w = tid >> 6, wm = w >> 1, wn = w & 1, r = lane & 31, h = lane >> 5;
  const int c = it >> 3, rem = it & 7, g = rem & 3, lh = rem >> 2;
  if (c == 64 && lh == 1) return;
  u16* Ct = (u16*)smem;
  u16* Bt = Ct + 64 * 136;
  u16* Lt = Bt;
  u16* Xt = Bt + 128 * 136;
  float* acs = (float*)(Xt + 128 * 72);
  float* dts = acs + 128;
  float* rowsq = dts + 128;
  const u16* XBC = (const u16*)(p.ws + OFF_XBC);
  const float* DT = (const float*)(p.ws + OFF_DT);
  u16* Z = (u16*)(p.ws + OFF_Z);
  const int tok0 = c * 128;
  const bool tailc = (L - tok0) < 128;
  stage_conv<64, 128, false>(Ct, 136, XBC, tok0 + lh * 64, 2560 + g * 128, p.in[4], p.in[5], nullptr);
  stage_conv<128, 128, false>(Bt, 136, XBC, tok0, 2048 + g * 128, p.in[4], p.in[5], nullptr);
  if (tid < 64) rowsq[tid] = 0.f;
  __syncthreads();
  f32x16 cb[2];
  cb[0] = zero16(); cb[1] = zero16();
#pragma unroll
  for (int ks = 0; ks < 8; ++ks) {
    bf16x8 a = frag_row(Ct, 136, wm * 32 + r, ks * 16 + h * 8);
#pragma unroll
    for (int ni = 0; ni < 2; ++ni) {
      bf16x8 bq = frag_row(Bt, 136, wn * 64 + ni * 32 + r, ks * 16 + h * 8);
      cb[ni] = mfma(a, bq, cb[ni]);
    }
  }
  for (int hh = 0; hh < 8; ++hh) {
    const int H = g * 8 + hh;
    u32x4 zv[2];
    {
      int tz = tok0 + lh * 64 + (tid >> 2); tz = tz < L ? tz : L - 1;
      const u16* zp0 = Z + (size_t)tz * 2048 + H * 64 + (tid & 3) * 16;
      zv[0] = *(const u32x4*)zp0; zv[1] = *(const u32x4*)(zp0 + 8);
    }
    if (w == 0) {
      const float A = -expf(p.in[7][H]);
      chunk_cumsum(DT, c, H, A, acs, dts, lane);
    }
    stage_conv<128, 64, false>(Xt, 72, XBC, tok0, H * 64, p.in[4], p.in[5], nullptr);
    __syncthreads();
#pragma unroll
    for (int ni = 0; ni < 2; ++ni) {
      if (tailc && (wn | ni)) continue;
#pragma unroll
      for (int i = 0; i < 16; ++i) {
        const int ll = wm * 32 + acc_row(i, h), l = lh * 64 + ll, s = wn * 64 + ni * 32 + r;
        float val = 0.f;
        if (s <= l) val = cb[ni][i] * __expf(acs[l] - acs[s]) * dts[s];
        Lt[ll * 136 + s] = f2bf(val);
      }
    }
    f32x16 y = zero16();
    if (c > 0) {
      const u16* pv = (const u16*)(p.ws + OFF_S1) + ((size_t)((c - 1) * 32 + H) * 64 + wn * 32 + r) * 128 + h * 8;
#pragma unroll
      for (int ks = 0; ks < 8; ++ks) {
        bf16x8 a = frag_row(Ct, 136, wm * 32 + r, ks * 16 + h * 8);
        bf16x8 bq = *(const bf16x8*)(pv + ks * 16);
        y = mfma(a, bq, y);
      }
#pragma unroll
      for (int i = 0; i < 16; ++i) { const int l = lh * 64 + wm * 32 + acc_row(i, h); y[i] *= __expf(acs[l]); }
    }
    __syncthreads();
#pragma unroll
    for (int ks = 0; ks < 8; ++ks) {
      if (tailc && ks >= 2) break;
      bf16x8 a = frag_row(Lt, 136, wm * 32 + r, ks * 16 + h * 8);
      bf16x8 bq = frag_tr(Xt, 72, ks * 16, wn * 32, lane);
      y = mfma(a, bq, y);
    }
    const float Dsk = p.in[8][H];
    float* Ys = (float*)(Bt + 64 * 136);
#pragma unroll
    for (int i = 0; i < 16; ++i) Ys[(wm * 32 + acc_row(i, h)) * 68 + wn * 32 + r] = y[i];
    u32x4 xv[2];
    {
      const int lx = lh * 64 + (tid >> 2);
      xv[0] = *(const u32x4*)(Xt + lx * 72 + (tid & 3) * 16); xv[1] = *(const u32x4*)(Xt + lx * 72 + (tid & 3) * 16 + 8);
    }
    __syncthreads();
    {
      const int row = tid >> 2, q = tid & 3, l = lh * 64 + row, t = tok0 + l;
      float sq = 0.f;
      if (t < L) {
        u16* zp = Z + (size_t)t * 2048 + H * 64 + q * 16;
        u32x4 ov[2];
#pragma unroll
        for (int k = 0; k < 2; ++k) {
          const f32x4 ya = *(const f32x4*)(Ys + row * 68 + q * 16 + k * 8), yb = *(const f32x4*)(Ys + row * 68 + q * 16 + k * 8 + 4);
          float o[8];
#pragma unroll
          for (int j = 0; j < 4; ++j) {
            const float y0 = (j < 2) ? ya[2 * j] : yb[2 * j - 4], y1 = (j < 2) ? ya[2 * j + 1] : yb[2 * j - 3];
            o[2 * j] = (y0 + Dsk * lo_f(xv[k][j])) * silu_f(lo_f(zv[k][j]));
            o[2 * j + 1] = (y1 + Dsk * hi_f(xv[k][j])) * silu_f(hi_f(zv[k][j]));
            sq += o[2 * j] * o[2 * j] + o[2 * j + 1] * o[2 * j + 1];
            ov[k][j] = pack2(o[2 * j], o[2 * j + 1]);
          }
        }
        *(u32x4*)zp = ov[0]; *(u32x4*)(zp + 8) = ov[1];
      }
      sq += __shfl_xor(sq, 1); sq += __shfl_xor(sq, 2);
      if (q == 0) rowsq[row] += sq;
    }
  }
  __syncthreads();
  {
    const int row = tid >> 2, q = tid & 3, t = tok0 + lh * 64 + row;
    if (t < L) {
      const float rn = rsqrtf(rowsq[row] * (1.f / 512.f) + EPS);
      u32x4 v[16];
#pragma unroll
      for (int hh = 0; hh < 8; ++hh) {
        const u16* zp = Z + (size_t)t * 2048 + (g * 8 + hh) * 64 + q * 16;
        v[2 * hh] = *(const u32x4*)zp; v[2 * hh + 1] = *(const u32x4*)(zp + 8);
      }
#pragma unroll
      for (int hh = 0; hh < 8; ++hh) {
        u16* zp = Z + (size_t)t * 2048 + (g * 8 + hh) * 64 + q * 16;
        const float* nwp = p.in[9] + (g * 8 + hh) * 64 + q * 16;
#pragma unroll
        for (int k = 0; k < 2; ++k) {
          const f32x4 wa = *(const f32x4*)(nwp + k * 8), wb = *(const f32x4*)(nwp + k * 8 + 4);
          u32x4 o;
          o[0] = pack2(lo_f(v[2 * hh + k][0]) * rn * wa[0], hi_f(v[2 * hh + k][0]) * rn * wa[1]);
          o[1] = pack2(lo_f(v[2 * hh + k][1]) * rn * wa[2], hi_f(v[2 * hh + k][1]) * rn * wa[3]);
          o[2] = pack2(lo_f(v[2 * hh + k][2]) * rn * wb[0], hi_f(v[2 * hh + k][2]) * rn * wb[1]);
          o[3] = pack2(lo_f(v[2 * hh + k][3]) * rn * wb[2], hi_f(v[2 * hh + k][3]) * rn * wb[3]);
          *(u32x4*)(zp + k * 8) = o;
        }
      }
    }
  }
  __syncthreads();
}

DEV void ret_out_item(const Params& p, int it, char* smem) {
  const int tid = get_tid(), lane = tid & 63, w = tid >> 6, wm = w >> 1, wn = w & 1, r = lane & 31, h = lane >> 5;
  const int rt = it >> 2, hd = it & 3;
  const int t0 = rt * 64, sc = rt >> 2, qtr = rt & 3;
  u16* P = (u16*)smem;
  char* gsm = smem + 33792;
  u16* Vt = (u16*)gsm;
  float* rowsq = (float*)(smem + 33792 + 27648);
  const u16* Qg = (const u16*)(p.ws + OFF_Q) + hd * 256;
  const u16* Kg = (const u16*)(p.ws + OFF_K) + hd * 256;
  const u16* Vg = (const u16*)(p.ws + OFF_V);
  u16* Gg = (u16*)(p.ws + OFF_G);
  const u16* RST = (const u16*)((char*)p.out + OUT_HALF);
  const float lg = log_gamma(hd);
  if (tid < 64) rowsq[tid] = 0.f;
  const int nkb = (qtr >= 2) ? 2 : 1;
  for (int kb = 0; kb < nkb; ++kb) {
    f32x16 acc[1][2];
    acc[0][0] = zero16(); acc[0][1] = zero16();
    gemm_tile<1>(acc, Qg, 1024, t0, L - 1, Kg, 1024, sc * 256 + kb * 128, 256, gsm);
#pragma unroll
    for (int ni = 0; ni < 2; ++ni)
#pragma unroll
      for (int i = 0; i < 16; ++i) {
        const int ll = wm * 32 + acc_row(i, h), lp = qtr * 64 + ll, s = kb * 128 + wn * 64 + ni * 32 + r;
        float val = 0.f;
        if (s <= lp) val = acc[0][ni][i] * __expf((float)(lp - s) * lg);
        P[ll * 264 + s] = f2bf(val);
      }
  }
  float rs[16];
#pragma unroll
  for (int i = 0; i < 16; ++i) rs[i] = 0.f;
  for (int et = 0; et < 4; ++et) {
    f32x16 acc[1][2];
    acc[0][0] = zero16(); acc[0][1] = zero16();
    u32x4 gv[4], vreg[4];
    {
      int tg = t0 + (tid >> 2); tg = tg < L ? tg : L - 1;
      const u16* gp0 = Gg + (size_t)tg * 2048 + hd * 512 + et * 128 + (tid & 3) * 32;
#pragma unroll
      for (int k = 0; k < 4; ++k) gv[k] = *(const u32x4*)(gp0 + k * 8);
#pragma unroll
      for (int i = 0; i < 4; ++i) {
        const int cidx = tid + i * 256, row = cidx >> 4, cc = cidx & 15;
        int tok = sc * 256 + row; tok = tok < L ? tok : L - 1;
        vreg[i] = *(const u32x4*)(Vg + (size_t)tok * 2048 + hd * 512 + et * 128 + cc * 8);
      }
    }
    if (sc > 0) {
      gemm_tile<1>(acc, Qg, 1024, t0, L - 1, RST + ((size_t)((sc - 1) * 4 + hd) * 512 + et * 128) * 256, 256, 0, 256, gsm);
#pragma unroll
      for (int ni = 0; ni < 2; ++ni)
#pragma unroll
        for (int i = 0; i < 16; ++i) {
          const int lp = qtr * 64 + wm * 32 + acc_row(i, h);
          acc[0][ni][i] *= __expf((float)(lp + 1) * lg);
        }
    }
    for (int kb64 = 0; kb64 <= qtr; ++kb64) {
#pragma unroll
      for (int i = 0; i < 4; ++i) {
        const int cidx = tid + i * 256, row = cidx >> 4, cc = cidx & 15;
        const int tok = sc * 256 + kb64 * 64 + row;
        u32x4 v = {0u, 0u, 0u, 0u};
        if (tok < L) v = vreg[i];
        *(u32x4*)(Vt + row * 136 + cc * 8) = v;
      }
      __syncthreads();
      if (kb64 < qtr) {
#pragma unroll
        for (int i = 0; i < 4; ++i) {
          const int cidx = tid + i * 256, row = cidx >> 4, cc = cidx & 15;
          int tok = sc * 256 + (kb64 + 1) * 64 + row; tok = tok < L ? tok : L - 1;
          vreg[i] = *(const u32x4*)(Vg + (size_t)tok * 2048 + hd * 512 + et * 128 + cc * 8);
        }
      }
#pragma unroll
      for (int ks = 0; ks < 4; ++ks) {
        bf16x8 a = frag_row(P, 264, wm * 32 + r, kb64 * 64 + ks * 16 + h * 8);
#pragma unroll
        for (int ni = 0; ni < 2; ++ni) {
          bf16x8 bq = frag_tr(Vt, 136, ks * 16, wn * 64 + ni * 32, lane);
          acc[0][ni] = mfma(a, bq, acc[0][ni]);
        }
      }
      __syncthreads();
    }
    u16* Os = (u16*)gsm;
#pragma unroll
    for (int ni = 0; ni < 2; ++ni)
#pragma unroll
      for (int i = 0; i < 16; ++i) {
        const float o = acc[0][ni][i];
        if (t0 + wm * 32 + acc_row(i, h) < L) rs[i] += o * o;
        Os[(wm * 32 + acc_row(i, h)) * 136 + wn * 64 + ni * 32 + r] = f2bf(o);
      }
    __syncthreads();
    {
      const int row = tid >> 2, q = tid & 3, t = t0 + row;
      if (t < L) {
        u16* gp = Gg + (size_t)t * 2048 + hd * 512 + et * 128 + q * 32;
        u32x4 ov[4];
#pragma unroll
        for (int k = 0; k < 4; ++k) ov[k] = *(const u32x4*)(Os + row * 136 + q * 32 + k * 8);
#pragma unroll
        for (int k = 0; k < 4; ++k) {
          u32x4 o;
#pragma unroll
          for (int j = 0; j < 4; ++j) o[j] = pack2(silu_f(lo_f(gv[k][j])) * lo_f(ov[k][j]), silu_f(hi_f(gv[k][j])) * hi_f(ov[k][j]));
          *(u32x4*)(gp + k * 8) = o;
        }
      }
    }
    __syncthreads();
  }
#pragma unroll
  for (int i = 0; i < 16; ++i) {
    const float v = half_sum(rs[i]);
    if (r == 0) atomicAdd(&rowsq[wm * 32 + acc_row(i, h)], v);
  }
  __syncthreads();
  {
    const int row = tid >> 2, q = tid & 3, t = t0 + row;
    if (t < L) {
      const float rn = rsqrtf(rowsq[row] * (1.f / 512.f) + EPS);
      u32x4 v[16];
#pragma unroll
      for (int et = 0; et < 4; ++et)
#pragma unroll
        for (int k = 0; k < 4; ++k) v[et * 4 + k] = *(const u32x4*)(Gg + (size_t)t * 2048 + hd * 512 + et * 128 + q * 32 + k * 8);
#pragma unroll
      for (int et = 0; et < 4; ++et)
#pragma unroll
        for (int k = 0; k < 4; ++k) {
          u32x4 o;
#pragma unroll
          for (int j = 0; j < 4; ++j) o[j] = pack2(lo_f(v[et * 4 + k][j]) * rn, hi_f(v[et * 4 + k][j]) * rn);
          *(u32x4*)(Gg + (size_t)t * 2048 + hd * 512 + et * 128 + q * 32 + k * 8) = o;
        }
    }
  }
  __syncthreads();
}

DEV void merge_tile(const Params& p, int it, char* smem) {
  const int tid = get_tid(), lane = tid & 63, w = tid >> 6, wm = w >> 1, wn = w & 1, r = lane & 31, h = lane >> 5;
  const int nt = it / 65, mt = it % 65;
  u16* GS = (u16*)(p.ws + OFF_GS);
  const u16* GR = (const u16*)(p.ws + OFF_GR);
  f32x16 acc[2][2];
#pragma unroll
  for (int mi = 0; mi < 2; ++mi)
#pragma unroll
    for (int ni = 0; ni < 2; ++ni) acc[mi][ni] = zero16();
  gemm_tile<2>(acc, (const u16*)(p.ws + OFF_Z), 2048, mt * 128, L - 1, (const u16*)(p.ws + OFF_S2), 2048, nt * 128, 2048, smem);
#pragma unroll
  for (int mi = 0; mi < 2; ++mi)
#pragma unroll
    for (int ni = 0; ni < 2; ++ni)
#pragma unroll
      for (int i = 0; i < 16; ++i) {
        const int t = mt * 128 + wm * 64 + mi * 32 + acc_row(i, h);
        if (t < L) {
          const size_t idx = (size_t)t * 1024 + nt * 128 + wn * 64 + ni * 32 + r;
          GS[idx] = f2bf(bf2f(GS[idx]) * acc[mi][ni][i]);
        }
        acc[mi][ni][i] = 0.f;
      }
  gemm_tile<2>(acc, (const u16*)(p.ws + OFF_G), 2048, mt * 128, L - 1, (const u16*)(p.ws + OFF_S2 + 4194304), 2048, nt * 128, 2048, smem);
#pragma unroll
  for (int mi = 0; mi < 2; ++mi)
#pragma unroll
    for (int ni = 0; ni < 2; ++ni)
#pragma unroll
      for (int i = 0; i < 16; ++i) {
        const int t = mt * 128 + wm * 64 + mi * 32 + acc_row(i, h);
        if (t < L) {
          const size_t idx = (size_t)t * 1024 + nt * 128 + wn * 64 + ni * 32 + r;
          GS[idx] = f2bf(bf2f(GS[idx]) + bf2f(GR[idx]) * acc[mi][ni][i]);
        }
      }
}

DEV void phase_merge(const Params& p, char* smem) {
  const int n_tiles = 65 * 8;
  const int n_wout = 16 * 16, n_wup = 16 * 88, n_wdown = 44 * 16;
  const int total = n_tiles + n_wout + n_wup + n_wdown;
  for (int it = get_bid(); it < total; it += nworkers()) {
    if (it < n_tiles) merge_tile(p, it, smem);
    else if (it < n_tiles + n_wout) { const int j = it - n_tiles; convert_tile(p.in[12], 1024, 1024, (u16*)(p.ws + OFF_WOUT), j & 15, j >> 4, 0, smem); }
    else if (it < n_tiles + n_wout + n_wup) { const int j = it - n_tiles - n_wout; convert_tile(p.in[14], 5632, 1024, (u16*)(p.ws + OFF_WUP), j & 15, j >> 4, 0, smem); }
    else { const int j = it - n_tiles - n_wout - n_wup; convert_tile(p.in[17], 1024, 2816, (u16*)(p.ws + OFF_WDOWN), j % 44, j / 44, 0, smem); }
  }
}

DEV void phase_outproj(const Params& p, int b, char* smem) {
  const int tid = get_tid(), lane = tid & 63, w = tid >> 6, wm = w >> 1, wn = w & 1, r = lane & 31, h = lane >> 5;
  float* HM = (float*)(p.ws + OFF_HM);
  for (int it = get_bid(); it < 65 * 8; it += gridDim.x) {
    const int nt = it / 65, mt = it % 65;
    f32x16 acc[2][2];
#pragma unroll
    for (int mi = 0; mi < 2; ++mi)
#pragma unroll
      for (int ni = 0; ni < 2; ++ni) acc[mi][ni] = zero16();
    gemm_tile<2>(acc, (const u16*)(p.ws + OFF_GS), 1024, mt * 128, L - 1, (const u16*)(p.ws + OFF_WOUT), 1024, nt * 128, 1024, smem);
#pragma unroll
    for (int mi = 0; mi < 2; ++mi)
#pragma unroll
      for (int ni = 0; ni < 2; ++ni)
#pragma unroll
        for (int i = 0; i < 16; ++i) {
          const int t = mt * 128 + wm * 64 + mi * 32 + acc_row(i, h);
          const int col = nt * 128 + wn * 64 + ni * 32 + r;
          if (t < NMETA) HM[t * 1024 + col] = p.in[1][t * 1024 + col] + acc[mi][ni][i];
          else if (t < L) {
            const size_t idx = ((size_t)b * SEQ + (t - NMETA)) * 1024 + col;
            p.out[idx] = p.in[0][idx] + acc[mi][ni][i];
          }
        }
  }
}

DEV void phase_norm2(const Params& p, int b) {
  const int lane = get_tid() & 63, w = get_tid() >> 6;
  u16* U2 = (u16*)(p.ws + OFF_U2);
  for (int it = get_bid(); it < L / 4; it += nworkers()) {
    const int t = it * 4 + w;
    const float* src = (t < NMETA) ? ((const float*)(p.ws + OFF_HM) + (size_t)t * D) : (p.out + ((size_t)b * SEQ + (t - NMETA)) * D);
    rmsnorm_row_bf16(src, p.in[13], U2 + (size_t)t * D, lane);
  }
}

DEV void phase_up(const Params& p, char* smem) {
  const int tid = get_tid(), lane = tid & 63, w = tid >> 6, wm = w >> 1, wn = w & 1, r = lane & 31, h = lane >> 5;
  u16* UP = (u16*)(p.ws + OFF_UP);
  for (int it = get_bid(); it < 65 * 44; it += gridDim.x) {
    const int nt = it / 65, mt = it % 65;
    f32x16 acc[2][2];
#pragma unroll
    for (int mi = 0; mi < 2; ++mi)
#pragma unroll
      for (int ni = 0; ni < 2; ++ni) acc[mi][ni] = zero16();
    gemm_tile<2>(acc, (const u16*)(p.ws + OFF_U2), 1024, mt * 128, L - 1, (const u16*)(p.ws + OFF_WUP), 1024, nt * 128, 1024, smem);
#pragma unroll
    for (int mi = 0; mi < 2; ++mi)
#pragma unroll
      for (int ni = 0; ni < 2; ++ni)
#pragma unroll
        for (int i = 0; i < 16; ++i) {
          const int t = mt * 128 + wm * 64 + mi * 32 + acc_row(i, h);
          if (t < L) UP[(size_t)t * 5632 + nt * 128 + wn * 64 + ni * 32 + r] = f2bf(acc[mi][ni][i]);
        }
  }
}

DEV void phase_ffn_act(const Params& p) {
  const int gt = get_bid() * 256 + get_tid(), nth = nworkers() * 256;
  const u16* UP = (const u16*)(p.ws + OFF_UP);
  u16* ACT = (u16*)(p.ws + OFF_ACT);
  const float* cw = p.in[15];
  const float* cbias = p.in[16];
  for (int u = gt; u < 513 * 352; u += nth) {
    const int rb = u / 352, cgp = u % 352, ch = cgp * 8, t0 = rb * 16;
    float wg[3][8], wv[3][8], bg[8], bv[8], g2[8], g1[8], v2[8], v1[8];
#pragma unroll
    for (int k = 0; k < 3; ++k)
#pragma unroll
      for (int j = 0; j < 8; ++j) { wg[k][j] = cw[k * 5632 + ch + j]; wv[k][j] = cw[k * 5632 + 2816 + ch + j]; }
#pragma unroll
    for (int j = 0; j < 8; ++j) { bg[j] = cbias[ch + j]; bv[j] = cbias[2816 + ch + j]; }
    {
      u32x4 a = {0u, 0u, 0u, 0u}, bq = {0u, 0u, 0u, 0u}, c2 = {0u, 0u, 0u, 0u}, d2 = {0u, 0u, 0u, 0u};
      if (t0 >= 2) {
        a = *(const u32x4*)(UP + (size_t)(t0 - 2) * 5632 + ch); bq = *(const u32x4*)(UP + (size_t)(t0 - 1) * 5632 + ch);
        c2 = *(const u32x4*)(UP + (size_t)(t0 - 2) * 5632 + 2816 + ch); d2 = *(const u32x4*)(UP + (size_t)(t0 - 1) * 5632 + 2816 + ch);
      }
#pragma unroll
      for (int j = 0; j < 4; ++j) {
        g2[2 * j] = lo_f(a[j]); g2[2 * j + 1] = hi_f(a[j]); g1[2 * j] = lo_f(bq[j]); g1[2 * j + 1] = hi_f(bq[j]);
        v2[2 * j] = lo_f(c2[j]); v2[2 * j + 1] = hi_f(c2[j]); v1[2 * j] = lo_f(d2[j]); v1[2 * j + 1] = hi_f(d2[j]);
      }
    }
#pragma unroll 4
    for (int i = 0; i < 16; ++i) {
      const int t = t0 + i;
      const u32x4 a = *(const u32x4*)(UP + (size_t)t * 5632 + ch);
      const u32x4 c2 = *(const u32x4*)(UP + (size_t)t * 5632 + 2816 + ch);
      float o[8];
#pragma unroll
      for (int j = 0; j < 8; ++j) {
        const float gx = (j & 1) ? hi_f(a[j >> 1]) : lo_f(a[j >> 1]);
        const float vx = (j & 1) ? hi_f(c2[j >> 1]) : lo_f(c2[j >> 1]);
        const float ag = bg[j] + wg[0][j] * g2[j] + wg[1][j] * g1[j] + wg[2][j] * gx;
        const float av = bv[j] + wv[0][j] * v2[j] + wv[1][j] * v1[j] + wv[2][j] * vx;
        o[j] = silu_f(ag) * av;
        g2[j] = g1[j]; g1[j] = gx; v2[j] = v1[j]; v1[j] = vx;
      }
      u32x4 pk; pk[0] = pack2(o[0], o[1]); pk[1] = pack2(o[2], o[3]); pk[2] = pack2(o[4], o[5]); pk[3] = pack2(o[6], o[7]);
      *(u32x4*)(ACT + (size_t)t * 2816 + ch) = pk;
    }
  }
}

DEV void phase_down(const Params& p, int b, char* smem) {
  const int tid = get_tid(), lane = tid & 63, w = tid >> 6, wm = w >> 1, wn = w & 1, r = lane & 31, h = lane >> 5;
  for (int it = get_bid(); it < 64 * 8; it += gridDim.x) {
    const int nt = it / 64, mt = it % 64;
    f32x16 acc[2][2];
#pragma unroll
    for (int mi = 0; mi < 2; ++mi)
#pragma unroll
      for (int ni = 0; ni < 2; ++ni) acc[mi][ni] = zero16();
    gemm_tile<2>(acc, (const u16*)(p.ws + OFF_ACT), 2816, NMETA + mt * 128, L - 1, (const u16*)(p.ws + OFF_WDOWN), 2816, nt * 128, 2816, smem);
#pragma unroll
    for (int mi = 0; mi < 2; ++mi)
#pragma unroll
      for (int ni = 0; ni < 2; ++ni)
#pragma unroll
        for (int i = 0; i < 16; ++i) {
          const int rr = mt * 128 + wm * 64 + mi * 32 + acc_row(i, h);
          const size_t idx = ((size_t)b * SEQ + rr) * 1024 + nt * 128 + wn * 64 + ni * 32 + r;
          p.out[idx] += acc[mi][ni][i];
        }
  }
}

DEV void phase_final_norm(const Params& p, int b) {
  const int lane = get_tid() & 63, w = get_tid() >> 6;
  for (int it = get_bid(); it < SEQ / 4; it += nworkers()) {
    const int rr = it * 4 + w;
    rmsnorm_row_f32_inplace(p.out + ((size_t)b * SEQ + rr) * D, p.in[18], lane);
  }
}


DEV u32x4 add_bf16x8(u32x4 a, u32x4 b) {
  u32x4 o;
#pragma unroll
  for (int j = 0; j < 4; ++j) o[j] = pack2(lo_f(a[j]) + lo_f(b[j]), hi_f(a[j]) + hi_f(b[j]));
  return o;
}
template <int NJ, bool ADD2 = false>
DEV void gemm_tile8(f32x4 (&acc)[4][NJ], const u16* __restrict__ A, int lda, int arow0, int arow_max,
                    const u16* __restrict__ B, int ldb, int brow0, int K, char* smem, const u16* __restrict__ A2 = nullptr) {
  constexpr int BN = NJ * 32;
  constexpr int BCH = BN / 64;
  constexpr int STAGE = (256 + BN) * 64;
  u16* S = (u16*)smem;
  const int tid = get_tid8(), lane = tid & 63, w = tid >> 6, wm = w >> 1, wn = w & 1;
  u32x4 ra[4], rb[BCH], ra2[ADD2 ? 4 : 1];
  unsigned aoff[4], boff[BCH];
  const char* Ab = (const char*)A;
  const char* Ab2 = (const char*)A2;
  const char* Bb = (const char*)(B + (size_t)brow0 * ldb);
  const int crow = tid >> 3, kc = tid & 7;
  const unsigned sto = (unsigned)(crow * 64 + ((kc ^ ((crow >> 1) & 7)) * 8));
#pragma unroll
  for (int i = 0; i < 4; ++i) {
    int gr = arow0 + crow + i * 64; gr = gr > arow_max ? arow_max : gr; gr = gr < 0 ? 0 : gr;
    aoff[i] = ((unsigned)gr * (unsigned)lda + kc * 8) * 2u;
  }
#pragma unroll
  for (int i = 0; i < BCH; ++i) boff[i] = ((unsigned)(crow + i * 64) * (unsigned)ldb + kc * 8) * 2u;
  const int fr = lane & 15, swz = fr >> 1, cq = lane >> 4;
  const unsigned fa = (unsigned)((wm * 64 + fr) * 64), fb = (unsigned)((256 + wn * (NJ * 16) + fr) * 64);
  const unsigned c0 = (unsigned)(((cq) ^ swz) * 8), c1 = (unsigned)(((4 + cq) ^ swz) * 8);
  const int nk = K >> 6;
#pragma unroll
  for (int i = 0; i < 4; ++i) { ra[i] = *(const u32x4*)(Ab + aoff[i]); if (ADD2) ra2[i] = *(const u32x4*)(Ab2 + aoff[i]); }
#pragma unroll
  for (int i = 0; i < BCH; ++i) rb[i] = *(const u32x4*)(Bb + boff[i]);
#pragma unroll
  for (int i = 0; i < 4; ++i) *(u32x4*)(S + sto + i * 64 * 64) = ADD2 ? add_bf16x8(ra[i], ra2[i]) : ra[i];
#pragma unroll
  for (int i = 0; i < BCH; ++i) *(u32x4*)(S + sto + (256 + i * 64) * 64) = rb[i];
  if (nk > 1) {
#pragma unroll
    for (int i = 0; i < 4; ++i) { ra[i] = *(const u32x4*)(Ab + aoff[i] + 128); if (ADD2) ra2[i] = *(const u32x4*)(Ab2 + aoff[i] + 128); }
#pragma unroll
    for (int i = 0; i < BCH; ++i) rb[i] = *(const u32x4*)(Bb + boff[i] + 128);
  }
  __syncthreads();
  for (int kt = 0; kt < nk; ++kt) {
    const u16* Sc = S + (kt & 1) * STAGE;
    {
      bf16x8 a[4], b[NJ];
#pragma unroll
      for (int m = 0; m < 4; ++m) a[m] = *(const bf16x8*)(Sc + fa + m * 16 * 64 + c0);
#pragma unroll
      for (int n = 0; n < NJ; ++n) b[n] = *(const bf16x8*)(Sc + fb + n * 16 * 64 + c0);
      __builtin_amdgcn_s_setprio(1);
#pragma unroll
      for (int m = 0; m < 4; ++m)
#pragma unroll
        for (int n = 0; n < NJ; ++n) acc[m][n] = __builtin_amdgcn_mfma_f32_16x16x32_bf16(a[m], b[n], acc[m][n], 0, 0, 0);
      __builtin_amdgcn_s_setprio(0);
    }
    bf16x8 a1[4], b1[NJ];
#pragma unroll
    for (int m = 0; m < 4; ++m) a1[m] = *(const bf16x8*)(Sc + fa + m * 16 * 64 + c1);
#pragma unroll
    for (int n = 0; n < NJ; ++n) b1[n] = *(const bf16x8*)(Sc + fb + n * 16 * 64 + c1);
    if (kt + 1 < nk) {
      u16* Aw = S + ((kt + 1) & 1) * STAGE;
#pragma unroll
      for (int i = 0; i < 4; ++i) *(u32x4*)(Aw + sto + i * 64 * 64) = ADD2 ? add_bf16x8(ra[i], ra2[i]) : ra[i];
#pragma unroll
      for (int i = 0; i < BCH; ++i) *(u32x4*)(Aw + sto + (256 + i * 64) * 64) = rb[i];
      if (kt + 2 < nk) {
        const unsigned ko = (unsigned)(kt + 2) * 128u;
#pragma unroll
        for (int i = 0; i < 4; ++i) { ra[i] = *(const u32x4*)(Ab + aoff[i] + ko); if (ADD2) ra2[i] = *(const u32x4*)(Ab2 + aoff[i] + ko); }
#pragma unroll
        for (int i = 0; i < BCH; ++i) rb[i] = *(const u32x4*)(Bb + boff[i] + ko);
      }
    }
    {
      __builtin_amdgcn_s_setprio(1);
#pragma unroll
      for (int m = 0; m < 4; ++m)
#pragma unroll
        for (int n = 0; n < NJ; ++n) acc[m][n] = __builtin_amdgcn_mfma_f32_16x16x32_bf16(a1[m], b1[n], acc[m][n], 0, 0, 0);
      __builtin_amdgcn_s_setprio(0);
    }
    __syncthreads();
  }
}

DEV f32x4 thin16(const u16* __restrict__ A, int lda, int row0, const u16* __restrict__ BT, int ldb, int col0, int K, int lane) {
  const u16* ap = A + (size_t)(row0 + (lane & 15)) * lda + 8 * (lane >> 4);
  const u16* bp = BT + (size_t)(col0 + (lane & 15)) * ldb + 8 * (lane >> 4);
  f32x4 acc = {0.f, 0.f, 0.f, 0.f};
  for (int k0 = 0; k0 < K; k0 += 128) {
    bf16x8 a[4], b[4];
#pragma unroll
    for (int j = 0; j < 4; ++j) { a[j] = *(const bf16x8*)(ap + k0 + j * 32); b[j] = *(const bf16x8*)(bp + k0 + j * 32); }
#pragma unroll
    for (int j = 0; j < 4; ++j) acc = __builtin_amdgcn_mfma_f32_16x16x32_bf16(a[j], b[j], acc, 0, 0, 0);
  }
  return acc;
}

DEV int tile_index(int k) { const int G = gridDim.x, rb = get_rbid(); return k * G + (rb & 7) * (G >> 3) + (rb >> 3); }
DEV void tile_decode(int T, int MT, int NT, int& mt, int& nt) {
  const int per = MT * 8;
  const int nb = T / per, rem = T - nb * per;
  int width = NT - nb * 8; width = width > 8 ? 8 : width;
  mt = rem / width; nt = nb * 8 + (rem - mt * width);
}

#define ZERO_ACC(acc, NJ_) _Pragma("unroll") for (int m_ = 0; m_ < 4; ++m_) _Pragma("unroll") for (int n_ = 0; n_ < NJ_; ++n_) { acc[m_][n_][0] = 0.f; acc[m_][n_][1] = 0.f; acc[m_][n_][2] = 0.f; acc[m_][n_][3] = 0.f; }

constexpr int EPI_WAVE_BYTES = 17408;
#define EPI_FENCE() asm volatile("s_waitcnt lgkmcnt(0)" ::: "memory")
DEV void epi_store_bf16_128(const u16* reg, u16* __restrict__ dst, int ld, int trow, int col0, int lane) {
#pragma unroll
  for (int j = 0; j < 16; ++j) {
    const int row = (lane >> 4) + 4 * j, t = trow + row;
    const u32x4 v = *(const u32x4*)(reg + row * 136 + (lane & 15) * 8);
    if (t < L) *(u32x4*)(dst + (size_t)t * ld + col0 + (lane & 15) * 8) = v;
  }
}

DEV void phase_inproj8(const Params& p, int b, char* smem) {
  const u16* U = (const u16*)((char*)p.out + OUT_HALF);
  const u16* WT = (const u16*)(p.ws + OFF_S1);
  const int MT = 33, NT = 53;
  for (int kk = 0;; ++kk) {
    const int it = tile_index(kk);
    if (it >= MT * NT) break;
    int mt, nt; tile_decode(it, MT, NT, mt, nt);
    f32x4 acc[4][8];
    ZERO_ACC(acc, 8)
    gemm_tile8<8>(acc, U, 1024, mt * 256, L - 1, WT, 1024, nt * 256, 1024, smem);
    const int tid = get_tid8(), lane = tid & 63, w = tid >> 6, wm = w >> 1, wn = w & 1, r = lane & 31, h = lane >> 5;
    u16* reg = (u16*)(smem + w * EPI_WAVE_BYTES);
    const int n0 = nt * 256;
    const int trow = mt * 256 + wm * 64;
    if (nt >= 20 && nt < 28) {
      const bool isk = nt >= 24;
      const int cq = n0 - (isk ? 6144 : 5120);
      const float sc = isk ? 0.0625f : 1.f;
      u16* dst = (u16*)(p.ws + (isk ? OFF_K : OFF_Q));
#pragma unroll
      for (int pr = 0; pr < 4; ++pr) {
        const int n1 = 4 * (pr >> 1) + (pr & 1);
        const int jf = (wn * 2 + (pr >> 1)) * 32 + (pr & 1) * 16 + (lane & 15);
        const float invf_rev = exp2f(-(float)jf * 0.10462765653f) * 0.15915494309189535f;
#pragma unroll
        for (int m = 0; m < 4; ++m)
#pragma unroll
          for (int j = 0; j < 4; ++j) {
            const int row = m * 16 + (lane >> 4) * 4 + j;
            const float tf = (float)(trow + row);
            const float ph = tf * invf_rev, pl = fmaf(tf, invf_rev, -ph);
            const float fr = (ph - floorf(ph)) + pl;
            const float sn = __builtin_amdgcn_sinf(fr), cs = __builtin_amdgcn_cosf(fr);
            const float x1 = acc[m][n1][j], x2 = acc[m][n1 + 2][j];
            reg[row * 136 + n1 * 16 + (lane & 15)] = f2bf((x1 * cs - x2 * sn) * sc);
            reg[row * 136 + n1 * 16 + 32 + (lane & 15)] = f2bf((x2 * cs + x1 * sn) * sc);
          }
      }
      EPI_FENCE();
      epi_store_bf16_128(reg, dst, 1024, trow, cq + wn * 128, lane);
    } else if (nt == 52) {
      float* DT = (float*)(p.ws + OFF_DT);
      if (wn == 0) {
#pragma unroll
        for (int n = 0; n < 2; ++n) {
          const int col = n * 16 + (lane & 15);
          const float bias = p.in[6][col];
#pragma unroll
          for (int m = 0; m < 4; ++m)
#pragma unroll
            for (int j = 0; j < 4; ++j) {
              const int t = trow + m * 16 + (lane >> 4) * 4 + j;
              if (t < L) {
                const float x = acc[m][n][j] + bias;
                const float e = __expf(x);
                DT[(size_t)t * 32 + col] = (x > 20.f) ? x : (e < 0.01f ? e * (1.f - 0.5f * e + e * e * (1.f / 3.f)) : __logf(1.f + e));
              }
            }
        }
      }
    } else {
      u16* dst; int ld, c0; bool sig = false;
      if (nt < 8) { dst = (u16*)(p.ws + OFF_Z); ld = 2048; c0 = n0; }
      else if (nt < 20) { dst = (u16*)(p.ws + OFF_XBC); ld = 3072; c0 = n0 - 2048; }
      else if (nt < 36) { dst = (u16*)(p.ws + OFF_V); ld = 2048; c0 = n0 - 7168; }
      else if (nt < 44) { dst = (u16*)(p.ws + OFF_G); ld = 2048; c0 = n0 - 9216; }
      else if (nt < 48) { dst = (u16*)(p.ws + OFF_GS); ld = 1024; c0 = n0 - 11264; sig = true; }
      else { dst = (u16*)(p.ws + OFF_GR); ld = 1024; c0 = n0 - 12288; sig = true; }
#pragma unroll
      for (int m = 0; m < 4; ++m)
#pragma unroll
        for (int n = 0; n < 8; ++n)
#pragma unroll
          for (int j = 0; j < 4; ++j) {
            float v = acc[m][n][j];
            if (sig) v = sigmoid_f(v);
            reg[(m * 16 + (lane >> 4) * 4 + j) * 136 + n * 16 + (lane & 15)] = f2bf(v);
          }
      EPI_FENCE();
      epi_store_bf16_128(reg, dst, ld, trow, c0 + wn * 128, lane);
    }
    __syncthreads();
  }
}

DEV void phase_merge8(const Params& p, char* smem, char* smem_team) {
  u16* GS = (u16*)(p.ws + OFF_GS);
  u16* GR = (u16*)(p.ws + OFF_GR);
  const u16* Zb = (const u16*)(p.ws + OFF_Z);
  const u16* Gb = (const u16*)(p.ws + OFF_G);
  const u16* WBS = (const u16*)(p.ws + OFF_S2);
  const u16* WBR = (const u16*)(p.ws + OFF_S2 + 4194304);
  for (int kk = 0;; ++kk) {
    const int it = tile_index(kk);
    if (it >= 256) break;
    const int branch = it >> 7, tl = it & 127, mt = tl >> 2, nt = tl & 3;
    f32x4 acc[4][8];
    ZERO_ACC(acc, 8)
    gemm_tile8<8>(acc, branch ? Gb : Zb, 2048, mt * 256, L - 1, branch ? WBR : WBS, 2048, nt * 256, 2048, smem);
    const int tid = get_tid8(), lane = tid & 63, w = tid >> 6, wm = w >> 1, wn = w & 1;
    float* reg = (float*)(smem + w * EPI_WAVE_BYTES);
    u16* GT = branch ? GR : GS;
#pragma unroll
    for (int hf = 0; hf < 2; ++hf) {
#pragma unroll
      for (int m = 0; m < 4; ++m)
#pragma unroll
        for (int n = 0; n < 4; ++n)
#pragma unroll
          for (int j = 0; j < 4; ++j) reg[(m * 16 + (lane >> 4) * 4 + j) * 68 + n * 16 + (lane & 15)] = acc[m][hf * 4 + n][j];
      EPI_FENCE();
#pragma unroll
      for (int j = 0; j < 16; ++j) {
        const int row = (lane >> 4) + 4 * j, c4 = (lane & 15) * 4;
        const f32x4 a = *(const f32x4*)(reg + row * 68 + c4);
        const size_t idx = (size_t)(mt * 256 + wm * 64 + row) * 1024 + nt * 256 + wn * 128 + hf * 64 + c4;
        const u32x2 g = *(const u32x2*)(GT + idx);
        u32x2 o; o[0] = pack2(lo_f(g[0]) * a[0], hi_f(g[0]) * a[1]); o[1] = pack2(lo_f(g[1]) * a[2], hi_f(g[1]) * a[3]);
        *(u32x2*)(GT + idx) = o;
      }
      EPI_FENCE();
    }
    __syncthreads();
  }
  for (int ct = get_rbid(); ct < 128; ct += gridDim.x) {
    const int tid = get_tid8(), lane = tid & 63, w = tid >> 6;
    const int branch = ct >> 6, c16 = ct & 63;
    f32x4* red = (f32x4*)smem;
    red[w * 64 + lane] = thin16((branch ? Gb : Zb) + w * 256, 2048, 8192, (branch ? WBR : WBS) + w * 256, 2048, c16 * 16, 256, lane);
    __syncthreads();
    if (w == 0) {
      u16* GT = branch ? GR : GS;
      f32x4 a1 = red[lane];
#pragma unroll
      for (int q = 1; q < 8; ++q) a1 += red[q * 64 + lane];
#pragma unroll
      for (int j = 0; j < 4; ++j) {
        const size_t idx = (size_t)(8192 + (lane >> 4) * 4 + j) * 1024 + c16 * 16 + (lane & 15);
        GT[idx] = f2bf(bf2f(GT[idx]) * a1[j]);
      }
    }
    __syncthreads();
  }
  {
    float* RSS = (float*)(p.ws + OFF_RSS);
    for (int i = get_bid() * 256 + get_tid(); i < L; i += nworkers() * 256) RSS[i] = 0.f;
  }
  const int n_wout = 16 * 16, n_wup = 16 * 88, n_wdown = 44 * 16;
  for (int it = get_bid(); it < n_wout + n_wup + n_wdown; it += nworkers()) {
    if (it < n_wout) { convert_tile(p.in[12], 1024, 1024, (u16*)(p.ws + OFF_WOUT), it & 15, it >> 4, 0, smem_team); }
    else if (it < n_wout + n_wup) { const int j = it - n_wout; convert_tile(p.in[14], 5632, 1024, (u16*)(p.ws + OFF_WUP), j & 15, j >> 4, 2, smem_team, p.in[13]);   }
    else { const int j = it - n_wout - n_wup; convert_tile(p.in[17], 1024, 2816, (u16*)(p.ws + OFF_WDOWN), j % 44, j / 44, 0, smem_team); }
  }
}

DEV void phase_outproj8(const Params& p, int b, char* smem) {
  const int tid = get_tid8(), lane = tid & 63, w = tid >> 6, wm = w >> 1, wn = w & 1, r = lane & 31, h = lane >> 5;
  u16* U2 = (u16*)(p.ws + OFF_U2);
  float* RSS = (float*)(p.ws + OFF_RSS);
  const u16* Mg = (const u16*)(p.ws + OFF_GS);
  const u16* WO = (const u16*)(p.ws + OFF_WOUT);
  float* reg = (float*)(smem + w * EPI_WAVE_BYTES);
  for (int kk = 0;; ++kk) {
    const int it = tile_index(kk);
    if (it >= 256) break;
    const int mt = it >> 3, nt = it & 7;
    f32x4 acc[4][4];
    ZERO_ACC(acc, 4)
    gemm_tile8<4, true>(acc, Mg, 1024, mt * 256, L - 1, WO, 1024, nt * 128, 1024, smem, (const u16*)(p.ws + OFF_GR));
#pragma unroll
    for (int m = 0; m < 4; ++m)
#pragma unroll
      for (int n = 0; n < 4; ++n)
#pragma unroll
        for (int j = 0; j < 4; ++j) reg[(m * 16 + (lane >> 4) * 4 + j) * 68 + n * 16 + (lane & 15)] = acc[m][n][j];
    EPI_FENCE();
#pragma unroll
    for (int j = 0; j < 16; ++j) {
      const int row = (lane >> 4) + 4 * j, c4 = (lane & 15) * 4;
      const f32x4 a = *(const f32x4*)(reg + row * 68 + c4);
      const int t = mt * 256 + wm * 64 + row, col = nt * 128 + wn * 64 + c4;
      f32x4 hv;
      if (t < NMETA) {
        hv = *(const f32x4*)(p.in[1] + t * 1024 + col) + a;
      } else {
        const size_t idx = ((size_t)b * SEQ + (t - NMETA)) * 1024 + col;
        hv = *(const f32x4*)(p.in[0] + idx) + a;
        *(f32x4*)(p.out + idx) = hv;
      }
      u32x2 hb; hb[0] = pack2(hv[0], hv[1]); hb[1] = pack2(hv[2], hv[3]);
      *(u32x2*)(U2 + (size_t)t * 1024 + col) = hb;
      float sq = hv[0] * hv[0] + hv[1] * hv[1] + hv[2] * hv[2] + hv[3] * hv[3];
      sq += __shfl_xor(sq, 1); sq += __shfl_xor(sq, 2); sq += __shfl_xor(sq, 4); sq += __shfl_xor(sq, 8);
      if ((lane & 15) == 0) atomicAdd(&RSS[t], sq);
    }
    __syncthreads();
  }
  for (int ct = get_rbid(); ct < 64; ct += gridDim.x) {
    const int tid = get_tid8(), lane = tid & 63, w = tid >> 6;
    f32x4* red = (f32x4*)smem;
    red[w * 64 + lane] = thin16(Mg + w * 128, 1024, 8192, WO + w * 128, 1024, ct * 16, 128, lane)
                       + thin16((const u16*)(p.ws + OFF_GR) + w * 128, 1024, 8192, WO + w * 128, 1024, ct * 16, 128, lane);
    __syncthreads();
    if (w == 0) {
      f32x4 a1 = red[lane];
#pragma unroll
      for (int q = 1; q < 8; ++q) a1 += red[q * 64 + lane];
#pragma unroll
      for (int j = 0; j < 4; ++j) {
        const int t = 8192 + (lane >> 4) * 4 + j;
        const size_t idx = ((size_t)b * SEQ + (t - NMETA)) * 1024 + ct * 16 + (lane & 15);
        const float hv = p.in[0][idx] + a1[j];
        p.out[idx] = hv;
        U2[(size_t)t * 1024 + ct * 16 + (lane & 15)] = f2bf(hv);
        float sq = hv * hv;
        sq += __shfl_xor(sq, 1); sq += __shfl_xor(sq, 2); sq += __shfl_xor(sq, 4); sq += __shfl_xor(sq, 8);
        if ((lane & 15) == 0) atomicAdd(&RSS[t], sq);
      }
    }
    __syncthreads();
  }
}

DEV void phase_up8(const Params& p, char* smem) {
  u16* ACT = (u16*)(p.ws + OFF_ACT);
  const float* cw = p.in[15];
  const float* cbias = p.in[16];
  for (int kk = 0;; ++kk) {
    const int it = tile_index(kk);
    if (it >= 33 * 22) break;
    int mt, nt; tile_decode(it, 33, 22, mt, nt);
    f32x4 acc[4][8];
    ZERO_ACC(acc, 8)
    gemm_tile8<8>(acc, (const u16*)(p.ws + OFF_U2), 1024, mt * 254 - 2, L - 1, (const u16*)(p.ws + OFF_WUP), 1024, nt * 256, 1024, smem);
    const int tid = get_tid8(), lane = tid & 63, w = tid >> 6;
    u16* reg = (u16*)(smem + w * EPI_WAVE_BYTES);
    {
      const float* RSS = (const float*)(p.ws + OFF_RSS);
      const int wm = w >> 1;
#pragma unroll
      for (int m = 0; m < 4; ++m)
#pragma unroll
        for (int j = 0; j < 4; ++j) {
          int t = mt * 254 - 2 + wm * 64 + m * 16 + (lane >> 4) * 4 + j; t = t < 0 ? 0 : (t > L - 1 ? L - 1 : t);
          const float rstd = rsqrtf(RSS[t] * (1.f / 1024.f) + EPS);
#pragma unroll
          for (int n = 0; n < 8; ++n) reg[(m * 16 + (lane >> 4) * 4 + j) * 136 + n * 16 + (lane & 15)] = f2bf(acc[m][n][j] * rstd);
        }
    }
    __syncthreads();
    {
      const int cg = tid & 15, rg = tid >> 4;
      const int ch = nt * 128 + cg * 8;
      float wg[3][8], wv[3][8], bg[8], bv[8], g2[8], g1[8], v2[8], v1[8];
#pragma unroll
      for (int k = 0; k < 3; ++k) {
        const f32x4 a0 = *(const f32x4*)(cw + k * 5632 + ch), a1 = *(const f32x4*)(cw + k * 5632 + ch + 4);
        const f32x4 c0 = *(const f32x4*)(cw + k * 5632 + 2816 + ch), c1 = *(const f32x4*)(cw + k * 5632 + 2816 + ch + 4);
#pragma unroll
        for (int j = 0; j < 4; ++j) { wg[k][j] = a0[j]; wg[k][4 + j] = a1[j]; wv[k][j] = c0[j]; wv[k][4 + j] = c1[j]; }
      }
      {
        const f32x4 a0 = *(const f32x4*)(cbias + ch), a1 = *(const f32x4*)(cbias + ch + 4);
        const f32x4 c0 = *(const f32x4*)(cbias + 2816 + ch), c1 = *(const f32x4*)(cbias + 2816 + ch + 4);
#pragma unroll
        for (int j = 0; j < 4; ++j) { bg[j] = a0[j]; bg[4 + j] = a1[j]; bv[j] = c0[j]; bv[4 + j] = c1[j]; }
      }
      const int R0 = rg * 8;
#pragma unroll
      for (int q = 0; q < 2; ++q) {
        const int R = R0 - 2 + q;
        u32x4 gvv = {0u, 0u, 0u, 0u}, vvv = {0u, 0u, 0u, 0u};
        if (R >= 0 && mt * 254 - 2 + R >= 0) {
          const char* sl = smem + ((R >> 6) * 2) * EPI_WAVE_BYTES + ((R & 63) * 136 + cg * 8) * 2;
          gvv = *(const u32x4*)sl; vvv = *(const u32x4*)(sl + EPI_WAVE_BYTES);
        }
#pragma unroll
        for (int j = 0; j < 4; ++j) {
          if (q == 0) { g2[2 * j] = lo_f(gvv[j]); g2[2 * j + 1] = hi_f(gvv[j]); v2[2 * j] = lo_f(vvv[j]); v2[2 * j + 1] = hi_f(vvv[j]); }
          else { g1[2 * j] = lo_f(gvv[j]); g1[2 * j + 1] = hi_f(gvv[j]); v1[2 * j] = lo_f(vvv[j]); v1[2 * j + 1] = hi_f(vvv[j]); }
        }
      }
#pragma unroll 2
      for (int i = 0; i < 8; ++i) {
        const int R = R0 + i, t = mt * 254 - 2 + R;
        u32x4 gvv = {0u, 0u, 0u, 0u}, vvv = {0u, 0u, 0u, 0u};
        if (t >= 0) {
          const char* sl = smem + ((R >> 6) * 2) * EPI_WAVE_BYTES + ((R & 63) * 136 + cg * 8) * 2;
          gvv = *(const u32x4*)sl; vvv = *(const u32x4*)(sl + EPI_WAVE_BYTES);
        }
        float o[8];
#pragma unroll
        for (int j = 0; j < 8; ++j) {
          const float gx = (j & 1) ? hi_f(gvv[j >> 1]) : lo_f(gvv[j >> 1]);
          const float vx = (j & 1) ? hi_f(vvv[j >> 1]) : lo_f(vvv[j >> 1]);
          const float ag = bg[j] + wg[0][j] * g2[j] + wg[1][j] * g1[j] + wg[2][j] * gx;
          const float av = bv[j] + wv[0][j] * v2[j] + wv[1][j] * v1[j] + wv[2][j] * vx;
          o[j] = silu_f(ag) * av;
          g2[j] = g1[j]; g1[j] = gx; v2[j] = v1[j]; v1[j] = vx;
        }
        if (R >= 2 && t < L) {
          u32x4 pk; pk[0] = pack2(o[0], o[1]); pk[1] = pack2(o[2], o[3]); pk[2] = pack2(o[4], o[5]); pk[3] = pack2(o[6], o[7]);
          *(u32x4*)(ACT + (size_t)t * 2816 + ch) = pk;
        }
      }
    }
    __syncthreads();
  }
}

DEV void phase_down8(const Params& p, int b, char* smem) {
  for (int kk = 0;; ++kk) {
    const int it = tile_index(kk);
    if (it >= 256) break;
    const int mt = it >> 3, nt = it & 7;
    f32x4 acc[4][4];
    ZERO_ACC(acc, 4)
    gemm_tile8<4>(acc, (const u16*)(p.ws + OFF_ACT), 2816, NMETA + mt * 256, L - 1, (const u16*)(p.ws + OFF_WDOWN), 2816, nt * 128, 2816, smem);
    const int tid = get_tid8(), lane = tid & 63, w = tid >> 6, wm = w >> 1, wn = w & 1, r = lane & 31, h = lane >> 5;
    float* reg = (float*)(smem + w * EPI_WAVE_BYTES);
#pragma unroll
    for (int m = 0; m < 4; ++m)
#pragma unroll
      for (int n = 0; n < 4; ++n)
#pragma unroll
        for (int j = 0; j < 4; ++j) reg[(m * 16 + (lane >> 4) * 4 + j) * 68 + n * 16 + (lane & 15)] = acc[m][n][j];
    EPI_FENCE();
#pragma unroll
    for (int j = 0; j < 16; ++j) {
      const int row = (lane >> 4) + 4 * j, c4 = (lane & 15) * 4;
      const f32x4 a = *(const f32x4*)(reg + row * 68 + c4);
      const size_t idx = ((size_t)b * SEQ + mt * 256 + wm * 64 + row) * 1024 + nt * 128 + wn * 64 + c4;
      const f32x4 x = *(const f32x4*)(p.out + idx);
      *(f32x4*)(p.out + idx) = x + a;
    }
    __syncthreads();
  }
}

#define XB_TMO      128
#define XB_XCNT(j)  (256  + 64 * (j))
#define XB_XSUB(j)  (1280 + 64 * (j))
#define XB_XGEN(j)  (2304 + 64 * (j))
#define XB_TOP      3328
#define XB_TOPGEN   3392
#define XCD_BAR_WORDS 3456
#define XB_SPIN_CAP (1u << 24)
DEV unsigned xb_ld(unsigned* p)              { return __hip_atomic_load(p, __ATOMIC_RELAXED, __HIP_MEMORY_SCOPE_AGENT); }
DEV unsigned xb_add(unsigned* p, unsigned v) { return __hip_atomic_fetch_add(p, v, __ATOMIC_RELAXED, __HIP_MEMORY_SCOPE_AGENT); }
DEV unsigned xb_xcc_id() { return (unsigned)__builtin_amdgcn_s_getreg((3 << 11) | 20) & 0xFu; }
#define XB_SPIN(cond, bar) do { unsigned _sp = 0; while (cond) { __builtin_amdgcn_s_sleep(1); \
    if ((++_sp & 255u) == 0u) { if (xb_ld(&(bar)[XB_TMO])) break; if (_sp > XB_SPIN_CAP) { atomicAdd(&(bar)[XB_TMO], 1u); break; } } } } while (0)
struct XcdBarrier { unsigned* bar; unsigned x; volatile LDSP unsigned* st; };
DEV XcdBarrier xcd_barrier_post(unsigned* bar, volatile LDSP unsigned* st) {
  XcdBarrier b; b.bar = bar; b.x = xb_xcc_id(); b.st = st;
  if (threadIdx.x == 0) (void)xb_add(&bar[XB_XCNT(b.x)], 1u);
  return b;
}
DEV void xcd_barrier_complete(unsigned* bar, unsigned x, unsigned& nloc, unsigned& nx) {
  const unsigned G = gridDim.x * gridDim.y * gridDim.z;
  unsigned sum, cnt, mine, sp = 0u;
  for (;;) {
    sum = 0u; cnt = 0u; mine = 0u;
#pragma unroll
    for (unsigned j = 0; j < 16; ++j) { const unsigned c = xb_ld(&bar[XB_XCNT(j)]); sum += c; cnt += (c > 0u) ? 1u : 0u; mine = (j == x) ? c : mine; }
    if (sum == G) break;
    __builtin_amdgcn_s_sleep(1);
    if ((++sp & 255u) == 0u) { if (xb_ld(&bar[XB_TMO])) break; if (sp > XB_SPIN_CAP) { atomicAdd(&bar[XB_TMO], 1u); break; } }
  }
  nloc = mine > 0u ? mine : 1u; nx = cnt > 0u ? cnt : 1u;
}
DEV void xcd_barrier(const XcdBarrier& b) {
  asm volatile("s_waitcnt vmcnt(0)" ::: "memory");
  __syncthreads();
  if (threadIdx.x == 0) {
    unsigned* bar = b.bar;
    __builtin_amdgcn_s_waitcnt(0);
    unsigned nloc = b.st[0], nx = b.st[1];
    if (nloc == 0u) { xcd_barrier_complete(bar, b.x, nloc, nx); b.st[0] = nloc; b.st[1] = nx; }
    const unsigned old = xb_add(&bar[XB_XSUB(b.x)], 1u);
    const unsigned gen = old / nloc;
    if (old + 1u == (gen + 1u) * nloc) {
      __builtin_amdgcn_fence(__ATOMIC_RELEASE, "agent");
      asm volatile("s_waitcnt vmcnt(0)" ::: "memory");
      const unsigned og = xb_add(&bar[XB_TOP], 1u);
      const unsigned tg = og / nx;
      if (og + 1u == (tg + 1u) * nx) xb_add(&bar[XB_TOPGEN], 1u);
      else XB_SPIN(xb_ld(&bar[XB_TOPGEN]) == tg, bar);
      __builtin_amdgcn_fence(__ATOMIC_ACQUIRE, "agent");
      xb_add(&bar[XB_XGEN(b.x)], 1u);
      asm volatile("s_waitcnt vmcnt(0)" ::: "memory");
    } else {
      XB_SPIN(xb_ld(&bar[XB_XGEN(b.x)]) == gen, bar);
      __builtin_amdgcn_fence(__ATOMIC_ACQUIRE, "agent");
      asm volatile("s_waitcnt vmcnt(0)" ::: "memory");
    }
  }
  __syncthreads();
}

constexpr int N_PHASES = 19;

__global__ void __launch_bounds__(512) fwd_kernel(Params p, int ph0, int ph1) {
  __shared__ __attribute__((aligned(16))) char smem[SMEM_BYTES];
  __shared__ uint4 xb_words;
  if (threadIdx.x == 0) xb_words = make_uint4(0u, 0u, 0u, 0u);
  __syncthreads();
  XcdBarrier xb = xcd_barrier_post((unsigned*)(p.ws + OFF_BAR), (volatile LDSP unsigned*)&xb_words);
  if (ph1 < 0) cg::this_grid().sync();
  for (int ph = ph0; ph < ph1; ++ph) {
    char* tsm = smem + (get_tid8() >> 8) * SMEM_TEAM;
    const int b = ph >= 10 ? 1 : 0;
    const int lp = (ph == 0) ? 0 : (ph == 18 ? 9 : (ph >= 10 ? ph - 9 : ph));
    switch (lp) {
      case 0: phase_prep(p, 0, true, tsm); break;
      case 1: phase_inproj8(p, b, smem); break;
      case 2: {
        int it = get_bid();
        for (; it < 1024; it += nworkers()) ret_kv_item(p, it, tsm);
        for (; it < 2048; it += nworkers()) ssd_state_item(p, it - 1024, tsm);
      } break;
      case 3: phase_scan(p); break;
      case 4: {
        {
          const int rb0 = get_rbid(), rb = (rb0 & 7) * 32 + (rb0 >> 3), team = get_tid8() >> 8;
          for (int j = 0; j < 3; ++j) {
            int kind = -1, idx = 0;
            if (j == 0) {
              if (rb >= 2) { const int k = rb - 2; kind = 0; idx = (1 + (k >> 1)) * 4 + (k & 1) * 2 + team; }
            } else if (j == 1) {
              kind = 1; idx = rb * 2 + team;
            } else {
              if (rb < 2) { kind = 1; idx = (256 + rb) * 2 + team; }
              else if (rb < 6) { const int k = rb - 2; kind = 0; idx = ((k >> 1) ? 0 : 128) * 4 + (k & 1) * 2 + team; }
            }
            if (kind == 0) ret_out_item(p, idx, tsm);
            else if (kind == 1) ssd_out_item(p, idx, tsm);
          }
        }
      } break;
      case 5: phase_merge8(p, smem, tsm); break;
      case 6: phase_outproj8(p, b, smem); break;
      case 7: phase_up8(p, smem); break;
      case 8: phase_down8(p, b, smem); break;
      case 9: {
        if (ph == 9) { phase_final_norm(p, 0); phase_prep(p, 1, false, tsm); }
        else phase_final_norm(p, 1);
      } break;
    }
    if (ph + 1 < ph1) xcd_barrier(xb);
  }
}

#ifndef MK_SINGLE
#define MK_SINGLE 1
#endif

extern "C" void kernel_launch(void* const* d_in, const int* in_sizes, int n_in, void* d_out, int out_size, void* d_ws, size_t ws_size,
                              hipStream_t stream) {
  static int grid_blocks = 0;
  if (!grid_blocks) {
    int dev = 0, cus = 0, per_cu = 0;
    hipGetDevice(&dev);
    hipDeviceGetAttribute(&cus, hipDeviceAttributeMultiprocessorCount, dev);
    hipOccupancyMaxActiveBlocksPerMultiprocessor(&per_cu, fwd_kernel, 512, 0);
    per_cu = 1;
    if (cus != 256) fprintf(stderr, "kernel_launch: built for a 256-CU device (static phase schedules assume 256 workgroups), found %d CUs\n", cus);
    cus = 256;
    grid_blocks = cus * per_cu;
  }
  Params p{};
  for (int i = 0; i < 19; ++i) p.in[i] = (const float*)d_in[i];
  p.out = (float*)d_out;
  p.ws = (char*)d_ws;
#if MK_SINGLE
  (void)hipMemsetAsync((char*)d_ws + OFF_BAR, 0, XCD_BAR_WORDS * 4, stream);
  int ph0 = 0, ph1 = N_PHASES;
  void* args[] = {&p, &ph0, &ph1};
  hipError_t e = hipLaunchCooperativeKernel((void*)fwd_kernel, dim3(grid_blocks), dim3(512), args, 0, stream);
  if (e != hipSuccess) fprintf(stderr, "cooperative launch failed: %s (grid %d)\n", hipGetErrorString(e), grid_blocks);
#else
  for (int ph = 0; ph < N_PHASES; ++ph) {
    hipLaunchKernelGGL(fwd_kernel, dim3(grid_blocks), dim3(512), 0, stream, p, ph, ph + 1);
  }
#endif
}
```

```cpp
#include <hip/hip_runtime.h>
#include <hip/hip_cooperative_groups.h>
#include <cstdio>
namespace cg = cooperative_groups;

typedef unsigned short u16;
typedef __bf16 bf16x8 __attribute__((ext_vector_type(8)));
typedef short s16x4 __attribute__((ext_vector_type(4)));
typedef short s16x8 __attribute__((ext_vector_type(8)));
typedef float f32x16 __attribute__((ext_vector_type(16)));
typedef unsigned int u32x4 __attribute__((ext_vector_type(4)));
typedef unsigned int u32x2 __attribute__((ext_vector_type(2)));
typedef float f32x4 __attribute__((ext_vector_type(4)));

#define DEV __device__ __forceinline__
#define LDSP __attribute__((address_space(3)))

constexpr int D = 1024;
constexpr int L = 8208;
constexpr int SEQ = 8192;
constexpr int NMETA = 16;
constexpr int NPROJ = 13344;
constexpr int NPROJ_PAD = 13568;
constexpr int DFF = 2816;
constexpr float EPS = 1e-6f;

constexpr size_t OFF_Z = 0;
constexpr size_t OFF_G = 33619968;
constexpr size_t OFF_GS = 67239936;
constexpr size_t OFF_GR = 84049920;
constexpr size_t OFF_Q = 100859904;
constexpr size_t OFF_XBC = 117669888;
constexpr size_t OFF_K = 168099840;
constexpr size_t OFF_V = 184909824;
constexpr size_t OFF_DT = 218529792;
constexpr size_t OFF_S2 = 219580416;
constexpr size_t OFF_S1 = 227969024;
constexpr size_t OFF_CD = 261523456;
constexpr size_t OFF_HM = 261531648;
constexpr size_t OFF_BAR = 261597184;
constexpr size_t OFF_RSS = 261611520;
constexpr size_t OFF_WOUT = OFF_S1;
constexpr size_t OFF_WUP = OFF_S1 + 2097152;
constexpr size_t OFF_WDOWN = OFF_S1 + 13631488;
constexpr size_t OFF_UP = OFF_XBC;
constexpr size_t OFF_ACT = OFF_Z;
constexpr size_t OFF_U2 = OFF_Q;
constexpr size_t OUT_HALF = 33554432;

constexpr int SMEM_TEAM = 73728;
constexpr int SMEM_BYTES = 2 * SMEM_TEAM;

struct Params {
  const float* in[19];
  float* out;
  char* ws;
};

DEV int get_tid8() { int t = threadIdx.x; asm volatile("" : "+v"(t)); return t; }
DEV int get_tid() { int t = threadIdx.x & 255; asm volatile("" : "+v"(t)); return t; }
DEV int get_rbid() { int t = blockIdx.x; asm volatile("" : "+s"(t)); return t; }
DEV int get_bid() { int t = get_rbid() * 2 + (get_tid8() >> 8); return __builtin_amdgcn_readfirstlane(t); }
DEV int nworkers() { return (int)gridDim.x * 2; }
DEV float bf2f(u16 h) { return __uint_as_float(((unsigned)h) << 16); }
typedef __bf16 bf16x2_t __attribute__((ext_vector_type(2)));
typedef float f32x2_t __attribute__((ext_vector_type(2)));
DEV u16 f2bf(float f) { const __bf16 h = (__bf16)f; return __builtin_bit_cast(u16, h); }
DEV unsigned pack2(float a, float b) { const f32x2_t v = {a, b}; return __builtin_bit_cast(unsigned, __builtin_convertvector(v, bf16x2_t)); }
DEV float silu_f(float x) { return x * __builtin_amdgcn_rcpf(1.f + __expf(-x)); }
DEV float sigmoid_f(float x) { return __builtin_amdgcn_rcpf(1.f + __expf(-x)); }
DEV float lo_f(unsigned u) { return __uint_as_float(u << 16); }
DEV float hi_f(unsigned u) { return __uint_as_float(u & 0xffff0000u); }
DEV float wave_sum(float v) {
#pragma unroll
  for (int o = 32; o > 0; o >>= 1) v += __shfl_xor(v, o);
  return v;
}
DEV float half_sum(float v) {
#pragma unroll
  for (int o = 16; o > 0; o >>= 1) v += __shfl_xor(v, o);
  return v;
}
DEV float log_gamma(int h) {
  return h == 0 ? -0.0317486983145803f : (h == 1 ? -0.015748356968139168f : (h == 2 ? -0.007843177461025893f : -0.003913899321136329f));
}
DEV f32x16 mfma(bf16x8 a, bf16x8 b, f32x16 c) { return __builtin_amdgcn_mfma_f32_32x32x16_bf16(a, b, c, 0, 0, 0); }
DEV f32x16 zero16() { f32x16 z;
#pragma unroll
  for (int i = 0; i < 16; ++i) z[i] = 0.f;
  return z; }
DEV int acc_row(int i, int h) { return (i & 3) + 8 * (i >> 2) + 4 * h; }

DEV bf16x8 frag_tr(const u16* T, int ld, int k0, int x0, int lane) {
  const int h = lane >> 5, blk = (lane >> 4) & 1, q = (lane & 15) >> 2, pp = lane & 3;
  const u16* a0 = T + (k0 + 8 * h + q) * ld + x0 + 16 * blk + 4 * pp;
  s16x4 lo = __builtin_amdgcn_ds_read_tr16_b64_v4i16((LDSP s16x4*)a0);
  s16x4 hi = __builtin_amdgcn_ds_read_tr16_b64_v4i16((LDSP s16x4*)(a0 + 4 * ld));
  s16x8 v = {lo[0], lo[1], lo[2], lo[3], hi[0], hi[1], hi[2], hi[3]};
  return __builtin_bit_cast(bf16x8, v);
}
DEV bf16x8 frag_row(const u16* T, int ld, int row, int k) {
  return *(const bf16x8*)(T + row * ld + k);
}

template <int MI>
DEV void gemm_tile(f32x16 (&acc)[MI][2], const u16* __restrict__ A, int lda, int arow0, int arow_max,
                   const u16* __restrict__ B, int ldb, int brow0, int K, char* smem) {
  constexpr int BM = MI * 64;
  constexpr int LD = 72;
  constexpr int ACH = BM * 8 / 256;
  u16* As = (u16*)smem;
  u16* Bs = As + BM * LD;
  const int tid = get_tid(), lane = tid & 63, w = tid >> 6, wm = w >> 1, wn = w & 1, r = lane & 31, h = lane >> 5;
  u32x4 ra[ACH], rb[4];
  const u16* ap[ACH];
  const u16* bp[4];
#pragma unroll
  for (int i = 0; i < ACH; ++i) {
    int c = tid + i * 256, row = c >> 3, kc = c & 7;
    int gr = arow0 + row; gr = gr > arow_max ? arow_max : gr;
    ap[i] = A + (size_t)gr * lda + kc * 8;
  }
#pragma unroll
  for (int i = 0; i < 4; ++i) {
    int c = tid + i * 256, row = c >> 3, kc = c & 7;
    bp[i] = B + (size_t)(brow0 + row) * ldb + kc * 8;
  }
#pragma unroll
  for (int i = 0; i < ACH; ++i) ra[i] = *(const u32x4*)(ap[i]);
#pragma unroll
  for (int i = 0; i < 4; ++i) rb[i] = *(const u32x4*)(bp[i]);
  const int nk = K >> 6;
  for (int kt = 0; kt < nk; ++kt) {
#pragma unroll
    for (int i = 0; i < ACH; ++i) { int c = tid + i * 256, row = c >> 3, kc = c & 7; *(u32x4*)(As + row * LD + kc * 8) = ra[i]; }
#pragma unroll
    for (int i = 0; i < 4; ++i) { int c = tid + i * 256, row = c >> 3, kc = c & 7; *(u32x4*)(Bs + row * LD + kc * 8) = rb[i]; }
    __syncthreads();
    if (kt + 1 < nk) {
#pragma unroll
      for (int i = 0; i < ACH; ++i) ra[i] = *(const u32x4*)(ap[i] + (kt + 1) * 64);
#pragma unroll
      for (int i = 0; i < 4; ++i) rb[i] = *(const u32x4*)(bp[i] + (kt + 1) * 64);
    }
#pragma unroll
    for (int ks = 0; ks < 4; ++ks) {
      bf16x8 a[MI], b[2];
#pragma unroll
      for (int mi = 0; mi < MI; ++mi) a[mi] = frag_row(As, LD, wm * MI * 32 + mi * 32 + r, ks * 16 + h * 8);
#pragma unroll
      for (int ni = 0; ni < 2; ++ni) b[ni] = frag_row(Bs, LD, wn * 64 + ni * 32 + r, ks * 16 + h * 8);
#pragma unroll
      for (int mi = 0; mi < MI; ++mi)
#pragma unroll
        for (int ni = 0; ni < 2; ++ni) acc[mi][ni] = mfma(a[mi], b[ni], acc[mi][ni]);
    }
    __syncthreads();
  }
}

DEV int orig_col(int n) {
  if (n < 5120) return n;
  if (n < 7168) {
    int q = n - 5120; int which = q >> 10; int c = q & 1023; int head = c >> 8; int ip = c & 255; int blk = ip >> 6; int wi = ip & 63;
    int j = (wi < 32) ? (blk * 32 + wi) : (128 + blk * 32 + wi - 32);
    return 5152 + which * 1024 + head * 256 + j;
  }
  if (n < 13312) return n + 32;
  if (n < 13344) return 5120 + (n - 13312);
  return -1;
}
DEV void convert_tile(const float* __restrict__ W, int Nsrc, int K, u16* __restrict__ WT, int kt, int ntile, int mode, char* smem, const float* __restrict__ kscale = nullptr) {
  float* t = (float*)smem;
  const int tid = get_tid();
  {
    const int tx = tid & 15, ty = tid >> 4;
    const int n = ntile * 64 + tx * 4;
    int on = n;
    if (mode == 1) on = orig_col(n);
    else if (mode == 2) { const int tl = n >> 8, wi = n & 255; on = (wi < 128) ? (tl * 128 + wi) : (2816 + tl * 128 + wi - 128); }
#pragma unroll
    for (int kk = ty; kk < 64; kk += 16) {
      f32x4 v = {0.f, 0.f, 0.f, 0.f};
      if (on >= 0) v = *(const f32x4*)(W + (size_t)(kt * 64 + kk) * Nsrc + on);
      if (kscale) v = v * kscale[kt * 64 + kk];
      *(f32x4*)(t + kk * 68 + tx * 4) = v;
    }
  }
  __syncthreads();
  {
    const int nn = tid >> 2, kq = (tid & 3) * 16;
    u32x4 o[2];
#pragma unroll
    for (int j = 0; j < 8; ++j) o[j >> 2][j & 3] = pack2(t[(kq + 2 * j) * 68 + nn], t[(kq + 2 * j + 1) * 68 + nn]);
    u16* d = WT + (size_t)(ntile * 64 + nn) * K + kt * 64 + kq;
    *(u32x4*)d = o[0]; *(u32x4*)(d + 8) = o[1];
  }
  __syncthreads();
}

DEV void rmsnorm_row_bf16(const float* __restrict__ src, const float* __restrict__ w, u16* __restrict__ dst, int lane) {
  f32x4 v[4]; float ss = 0.f;
#pragma unroll
  for (int j = 0; j < 4; ++j) { v[j] = *(const f32x4*)(src + j * 256 + lane * 4); ss += v[j][0] * v[j][0] + v[j][1] * v[j][1] + v[j][2] * v[j][2] + v[j][3] * v[j][3]; }
  ss = wave_sum(ss);
  const float rstd = rsqrtf(ss * (1.f / 1024.f) + EPS);
#pragma unroll
  for (int j = 0; j < 4; ++j) {
    f32x4 ww = *(const f32x4*)(w + j * 256 + lane * 4);
    u32x2 o; o[0] = pack2(v[j][0] * rstd * ww[0], v[j][1] * rstd * ww[1]); o[1] = pack2(v[j][2] * rstd * ww[2], v[j][3] * rstd * ww[3]);
    *(u32x2*)(dst + j * 256 + lane * 4) = o;
  }
}
DEV void rmsnorm_row_f32_inplace(float* __restrict__ row, const float* __restrict__ w, int lane) {
  f32x4 v[4]; float ss = 0.f;
#pragma unroll
  for (int j = 0; j < 4; ++j) { v[j] = *(const f32x4*)(row + j * 256 + lane * 4); ss += v[j][0] * v[j][0] + v[j][1] * v[j][1] + v[j][2] * v[j][2] + v[j][3] * v[j][3]; }
  ss = wave_sum(ss);
  const float rstd = rsqrtf(ss * (1.f / 1024.f) + EPS);
#pragma unroll
  for (int j = 0; j < 4; ++j) {
    f32x4 ww = *(const f32x4*)(w + j * 256 + lane * 4);
    f32x4 o; o[0] = v[j][0] * rstd * ww[0]; o[1] = v[j][1] * rstd * ww[1]; o[2] = v[j][2] * rstd * ww[2]; o[3] = v[j][3] * rstd * ww[3];
    *(f32x4*)(row + j * 256 + lane * 4) = o;
  }
}

template <int R, int C, bool SCALE>
DEV void stage_conv(u16* dst, int ld, const u16* __restrict__ xbc, int row0, int ch0, const float* __restrict__ cw, const float* __restrict__ cb, const float* rs) {
  constexpr int CG = C / 8, RG = 256 / CG, RPT = R / RG;
  const int tid = get_tid();
  const int cgi = tid % CG, rgi = tid / CG;
  const int ch = ch0 + cgi * 8, r0 = rgi * RPT;
  float w[4][8], bias[8], xw[3][8];
#pragma unroll
  for (int k = 0; k < 4; ++k) {
    f32x4 a = *(const f32x4*)(cw + k * 3072 + ch), b = *(const f32x4*)(cw + k * 3072 + ch + 4);
#pragma unroll
    for (int j = 0; j < 4; ++j) { w[k][j] = a[j]; w[k][4 + j] = b[j]; }
  }
  {
    f32x4 a = *(const f32x4*)(cb + ch), b = *(const f32x4*)(cb + ch + 4);
#pragma unroll
    for (int j = 0; j < 4; ++j) { bias[j] = a[j]; bias[4 + j] = b[j]; }
  }
#pragma unroll
  for (int k = 0; k < 3; ++k) {
    const int tr = row0 + r0 - 3 + k;
    u32x4 v = {0u, 0u, 0u, 0u};
    if (tr >= 0 && tr < L) v = *(const u32x4*)(xbc + (size_t)tr * 3072 + ch);
#pragma unroll
    for (int j = 0; j < 4; ++j) { xw[k][2 * j] = lo_f(v[j]); xw[k][2 * j + 1] = hi_f(v[j]); }
  }
#pragma unroll
  for (int i = 0; i < RPT; ++i) {
    const int tr = row0 + r0 + i;
    const bool valid = tr < L;
    u32x4 v = {0u, 0u, 0u, 0u};
    if (valid) v = *(const u32x4*)(xbc + (size_t)tr * 3072 + ch);
    if (!valid) { const u32x4 z4 = {0u, 0u, 0u, 0u}; *(u32x4*)(dst + (r0 + i) * ld + cgi * 8) = z4; continue; }
    float xc[8], o[8];
#pragma unroll
    for (int j = 0; j < 4; ++j) { xc[2 * j] = lo_f(v[j]); xc[2 * j + 1] = hi_f(v[j]); }
    float sc = 1.f;
    if (SCALE) sc = rs[(cgi >> 3) * 128 + r0 + i];
#pragma unroll
    for (int j = 0; j < 8; ++j) {
      float a = bias[j] + w[0][j] * xw[0][j] + w[1][j] * xw[1][j] + w[2][j] * xw[2][j] + w[3][j] * xc[j];
      a = silu_f(a) * sc;
      o[j] = valid ? a : 0.f;
      xw[0][j] = xw[1][j]; xw[1][j] = xw[2][j]; xw[2][j] = xc[j];
    }
    u32x4 pk; pk[0] = pack2(o[0], o[1]); pk[1] = pack2(o[2], o[3]); pk[2] = pack2(o[4], o[5]); pk[3] = pack2(o[6], o[7]);
    *(u32x4*)(dst + (r0 + i) * ld + cgi * 8) = pk;
  }
}

DEV float chunk_cumsum(const float* __restrict__ DT, int c, int H, float A, float* acs, float* dts, int lane) {
  const int s0 = 2 * lane;
  const int t0 = c * 128 + s0;
  const float d0 = (t0 < L) ? DT[(size_t)t0 * 32 + H] : 0.f;
  const float d1 = (t0 + 1 < L) ? DT[(size_t)(t0 + 1) * 32 + H] : 0.f;
  const float a0 = d0 * A, a1 = a0 + d1 * A;
  float tot = a1;
#pragma unroll
  for (int o = 1; o < 64; o <<= 1) { float n = __shfl_up(tot, o); if (lane >= o) tot += n; }
  const float excl = tot - a1;
  acs[s0] = excl + a0; acs[s0 + 1] = excl + a1;
  dts[s0] = d0; dts[s0 + 1] = d1;
  return __shfl(tot, 63);
}

DEV void phase_prep(const Params& p, int b, bool first, char* smem) {
  const int tid = get_tid(), lane = tid & 63, w = tid >> 6;
  u16* U = (u16*)((char*)p.out + OUT_HALF);
  const int n_norm = L / 4;
  const int n_win = 16 * (NPROJ_PAD / 64);
  const int n_wb = first ? 2 * 32 * 16 : 0;
  const int total = n_norm + n_win + n_wb;
  for (int it = get_bid(); it < total; it += nworkers()) {
    if (it < n_norm) {
      const int t = it * 4 + w;
      const float* src = (t < NMETA) ? (p.in[1] + (size_t)t * D) : (p.in[0] + ((size_t)b * SEQ + (t - NMETA)) * D);
      rmsnorm_row_bf16(src, p.in[2], U + (size_t)t * D, lane);
    } else if (it < n_norm + n_win) {
      const int j = it - n_norm; const int ntile = j >> 4, kt = j & 15;
      convert_tile(p.in[3], NPROJ, 1024, (u16*)(p.ws + OFF_S1), kt, ntile, 1, smem);
    } else {
      int j = it - n_norm - n_win; const int which = j >> 9; j &= 511; const int ntile = j >> 5, kt = j & 31;
      convert_tile(p.in[10 + which], 1024, 2048, (u16*)(p.ws + OFF_S2 + (size_t)which * 4194304), kt, ntile, 0, smem);
    }
  }
}

DEV void phase_inproj(const Params& p, int b, char* smem) {
  const int tid = get_tid(), lane = tid & 63, w = tid >> 6, wm = w >> 1, wn = w & 1, r = lane & 31, h = lane >> 5;
  const u16* U = (const u16*)((char*)p.out + OUT_HALF);
  const u16* WT = (const u16*)(p.ws + OFF_S1);
  const int MT = 65, NT = 105;
  for (int it = get_bid(); it < MT * NT; it += gridDim.x) {
    const int nt = it / MT, mt = it % MT;
    f32x16 acc[2][2];
#pragma unroll
    for (int mi = 0; mi < 2; ++mi)
#pragma unroll
      for (int ni = 0; ni < 2; ++ni) acc[mi][ni] = zero16();
    gemm_tile<2>(acc, U, 1024, mt * 128, L - 1, WT, 1024, nt * 128, 1024, smem);
    const int n0 = nt * 128;
    if (nt >= 40 && nt < 56) {
      const bool isk = nt >= 48;
      const int cq = n0 - (isk ? 6144 : 5120);
      const int blk = ((cq & 255) >> 6) + wn;
      const int jf = blk * 32 + r;
      const double invf_rev = exp(-(double)jf * 0.07252236513367073) * 0.15915494309189535;
      const float sc = isk ? 0.0625f : 1.f;
      u16* dst = (u16*)(p.ws + (isk ? OFF_K : OFF_Q));
#pragma unroll
      for (int mi = 0; mi < 2; ++mi)
#pragma unroll
        for (int i = 0; i < 16; ++i) {
          const int t = mt * 128 + wm * 64 + mi * 32 + acc_row(i, h);
          if (t < L) {
            double rev = (double)t * invf_rev;
            rev -= floor(rev);
            const float fr = (float)rev;
            const float sn = __builtin_amdgcn_sinf(fr), cs = __builtin_amdgcn_cosf(fr);
            const float x1 = acc[mi][0][i], x2 = acc[mi][1][i];
            const float o1 = (x1 * cs - x2 * sn) * sc, o2 = (x2 * cs + x1 * sn) * sc;
            u16* d = dst + (size_t)t * 1024 + cq + wn * 64 + r;
            d[0] = f2bf(o1); d[32] = f2bf(o2);
          }
        }
    } else if (nt == 104) {
      float* DT = (float*)(p.ws + OFF_DT);
      if (wn == 0) {
        const float bias = p.in[6][r];
#pragma unroll
        for (int mi = 0; mi < 2; ++mi)
#pragma unroll
          for (int i = 0; i < 16; ++i) {
            const int t = mt * 128 + wm * 64 + mi * 32 + acc_row(i, h);
            if (t < L) {
              const float x = acc[mi][0][i] + bias;
              const float e = __expf(x);
              DT[(size_t)t * 32 + r] = (x > 20.f) ? x : (e < 0.01f ? e * (1.f - 0.5f * e + e * e * (1.f / 3.f)) : __logf(1.f + e));
            }
          }
      }
    } else {
      u16* dst; int ld, c0; bool sig = false;
      if (nt < 16) { dst = (u16*)(p.ws + OFF_Z); ld = 2048; c0 = n0; }
      else if (nt < 40) { dst = (u16*)(p.ws + OFF_XBC); ld = 3072; c0 = n0 - 2048; }
      else if (nt < 72) { dst = (u16*)(p.ws + OFF_V); ld = 2048; c0 = n0 - 7168; }
      else if (nt < 88) { dst = (u16*)(p.ws + OFF_G); ld = 2048; c0 = n0 - 9216; }
      else if (nt < 96) { dst = (u16*)(p.ws + OFF_GS); ld = 1024; c0 = n0 - 11264; sig = true; }
      else { dst = (u16*)(p.ws + OFF_GR); ld = 1024; c0 = n0 - 12288; sig = true; }
#pragma unroll
      for (int mi = 0; mi < 2; ++mi)
#pragma unroll
        for (int ni = 0; ni < 2; ++ni)
#pragma unroll
          for (int i = 0; i < 16; ++i) {
            const int t = mt * 128 + wm * 64 + mi * 32 + acc_row(i, h);
            if (t < L) {
              float v = acc[mi][ni][i];
              if (sig) v = sigmoid_f(v);
              dst[(size_t)t * ld + c0 + wn * 64 + ni * 32 + r] = f2bf(v);
            }
          }
    }
  }
}

DEV void ssd_state_item(const Params& p, int it, char* smem) {
  const int tid = get_tid(), lane = tid & 63, w = tid >> 6, wm = w >> 1, wn = w & 1, r = lane & 31, h = lane >> 5;
  const int c = it >> 4, hp = it & 15, H0 = hp * 2, g = H0 >> 3;
  u16* Xw = (u16*)smem;
  u16* Bc = Xw + 128 * 136;
  float* wsc = (float*)(Bc + 128 * 136);
  float* tmp = wsc + 256;
  const float* DT = (const float*)(p.ws + OFF_DT);
  float* CD = (float*)(p.ws + OFF_CD);
  const u16* XBC = (const u16*)(p.ws + OFF_XBC);
  if (w < 2) {
    const int H = H0 + w;
    const float A = -expf(p.in[7][H]);
    float* acs = tmp + w * 128;
    float* dts = wsc + w * 128;
    const float aend = chunk_cumsum(DT, c, H, A, acs, dts, lane);
    const int s0 = 2 * lane;
    const float w0 = __expf(aend - acs[s0]) * dts[s0], w1 = __expf(aend - acs[s0 + 1]) * dts[s0 + 1];
    dts[s0] = w0; dts[s0 + 1] = w1;
    if (lane == 0) CD[c * 32 + H] = __expf(aend);
  }
  __syncthreads();
  stage_conv<128, 128, true>(Xw, 136, XBC, c * 128, H0 * 64, p.in[4], p.in[5], wsc);
  stage_conv<128, 128, false>(Bc, 136, XBC, c * 128, 2048 + g * 128, p.in[4], p.in[5], nullptr);
  __syncthreads();
  f32x16 acc[2][2];
#pragma unroll
  for (int mi = 0; mi < 2; ++mi)
#pragma unroll
    for (int ni = 0; ni < 2; ++ni) acc[mi][ni] = zero16();
#pragma unroll
  for (int ks = 0; ks < 8; ++ks) {
    bf16x8 a[2], bq[2];
#pragma unroll
    for (int mi = 0; mi < 2; ++mi) a[mi] = frag_tr(Xw, 136, ks * 16, wm * 64 + mi * 32, lane);
#pragma unroll
    for (int ni = 0; ni < 2; ++ni) bq[ni] = frag_tr(Bc, 136, ks * 16, wn * 64 + ni * 32, lane);
#pragma unroll
    for (int mi = 0; mi < 2; ++mi)
#pragma unroll
      for (int ni = 0; ni < 2; ++ni) acc[mi][ni] = mfma(a[mi], bq[ni], acc[mi][ni]);
  }
  u16* ST = (u16*)(p.ws + OFF_S1) + (size_t)(c * 32 + H0) * 8192;
  __syncthreads();
#pragma unroll
  for (int mi = 0; mi < 2; ++mi)
#pragma unroll
    for (int ni = 0; ni < 2; ++ni)
#pragma unroll
      for (int i = 0; i < 16; ++i) Xw[(wm * 64 + mi * 32 + acc_row(i, h)) * 136 + wn * 64 + ni * 32 + r] = f2bf(acc[mi][ni][i]);
  asm volatile("s_waitcnt lgkmcnt(0)" ::: "memory");
#pragma unroll
  for (int j = 0; j < 8; ++j) {
    const int m = wm * 64 + (lane >> 3) + 8 * j, n = wn * 64 + (lane & 7) * 8;
    *(u32x4*)(ST + m * 128 + n) = *(const u32x4*)(Xw + m * 136 + n);
  }
  __syncthreads();
}

DEV void ret_kv_item(const Params& p, int it, char* smem) {
  const int tid = get_tid(), lane = tid & 63, w = tid >> 6, wm = w >> 1, wn = w & 1, r = lane & 31, h = lane >> 5;
  const int sc = it >> 5, rem = it & 31, hd = rem >> 3, dt2 = (rem >> 2) & 1, et = rem & 3;
  u16* Vt = (u16*)smem;
  u16* Kt = Vt + 128 * 136;
  const u16* Vg = (const u16*)(p.ws + OFF_V);
  const u16* Kg = (const u16*)(p.ws + OFF_K);
  const float lg = log_gamma(hd);
  f32x16 acc[2][2];
#pragma unroll
  for (int mi = 0; mi < 2; ++mi)
#pragma unroll
    for (int ni = 0; ni < 2; ++ni) acc[mi][ni] = zero16();
  u32x4 vr[8], kr[8];
#pragma unroll
  for (int i = 0; i < 8; ++i) {
    const int cidx = tid + i * 256, row = cidx >> 4, cc = cidx & 15;
    const int tok = sc * 256 + row;
    vr[i] = *(const u32x4*)(Vg + (size_t)tok * 2048 + hd * 512 + et * 128 + cc * 8);
    kr[i] = *(const u32x4*)(Kg + (size_t)tok * 1024 + hd * 256 + dt2 * 128 + cc * 8);
  }
  for (int half = 0; half < 2; ++half) {
#pragma unroll
    for (int i = 0; i < 8; ++i) {
      const int cidx = tid + i * 256, row = cidx >> 4, cc = cidx & 15;
      *(u32x4*)(Vt + row * 136 + cc * 8) = vr[i];
      const u32x4 kk = kr[i];
      const float dec = __expf((float)(255 - (half * 128 + row)) * lg);
      u32x4 ko;
#pragma unroll
      for (int j = 0; j < 4; ++j) ko[j] = pack2(lo_f(kk[j]) * dec, hi_f(kk[j]) * dec);
      *(u32x4*)(Kt + row * 136 + cc * 8) = ko;
    }
    __syncthreads();
    if (half == 0) {
#pragma unroll
      for (int i = 0; i < 8; ++i) {
        const int cidx = tid + i * 256, row = cidx >> 4, cc = cidx & 15;
        const int tok = sc * 256 + 128 + row;
        vr[i] = *(const u32x4*)(Vg + (size_t)tok * 2048 + hd * 512 + et * 128 + cc * 8);
        kr[i] = *(const u32x4*)(Kg + (size_t)tok * 1024 + hd * 256 + dt2 * 128 + cc * 8);
      }
    }
#pragma unroll
    for (int ks = 0; ks < 8; ++ks) {
      bf16x8 a[2], bq[2];
#pragma unroll
      for (int mi = 0; mi < 2; ++mi) a[mi] = frag_tr(Vt, 136, ks * 16, wm * 64 + mi * 32, lane);
#pragma unroll
      for (int ni = 0; ni < 2; ++ni) bq[ni] = frag_tr(Kt, 136, ks * 16, wn * 64 + ni * 32, lane);
#pragma unroll
      for (int mi = 0; mi < 2; ++mi)
#pragma unroll
        for (int ni = 0; ni < 2; ++ni) acc[mi][ni] = mfma(a[mi], bq[ni], acc[mi][ni]);
    }
    __syncthreads();
  }
  u16* RST = (u16*)((char*)p.out + OUT_HALF) + ((size_t)(sc * 4 + hd) * 512 + et * 128) * 256 + dt2 * 128;
#pragma unroll
  for (int mi = 0; mi < 2; ++mi)
#pragma unroll
    for (int ni = 0; ni < 2; ++ni)
#pragma unroll
      for (int i = 0; i < 16; ++i) Vt[(wm * 64 + mi * 32 + acc_row(i, h)) * 136 + wn * 64 + ni * 32 + r] = f2bf(acc[mi][ni][i]);
  asm volatile("s_waitcnt lgkmcnt(0)" ::: "memory");
#pragma unroll
  for (int j = 0; j < 8; ++j) {
    const int e = wm * 64 + (lane >> 3) + 8 * j, d = wn * 64 + (lane & 7) * 8;
    *(u32x4*)(RST + (size_t)e * 256 + d) = *(const u32x4*)(Vt + e * 136 + d);
  }
  __syncthreads();
}

DEV void phase_scan(const Params& p) {
  const int gt = get_bid() * 256 + get_tid(), nth = nworkers() * 256;
  const float* CD = (const float*)(p.ws + OFF_CD);
  for (int v = gt; v < 32768 + 65536; v += nth) {
    float st[8];
#pragma unroll
    for (int j = 0; j < 8; ++j) st[j] = 0.f;
    if (v < 32768) {
      const int e0 = v * 8, H = e0 >> 13;
      u16* base = (u16*)(p.ws + OFF_S1) + e0;
      for (int c0 = 0; c0 < 64; c0 += 8) {
        u32x4 x[8];
#pragma unroll
        for (int u = 0; u < 8; ++u) x[u] = *(const u32x4*)(base + (size_t)(c0 + u) * 262144);
#pragma unroll
        for (int u = 0; u < 8; ++u) {
          const float dcy = CD[(c0 + u) * 32 + H];
          u32x4 o;
#pragma unroll
          for (int j = 0; j < 4; ++j) {
            st[2 * j] = st[2 * j] * dcy + lo_f(x[u][j]);
            st[2 * j + 1] = st[2 * j + 1] * dcy + hi_f(x[u][j]);
            o[j] = pack2(st[2 * j], st[2 * j + 1]);
          }
          *(u32x4*)(base + (size_t)(c0 + u) * 262144) = o;
        }
      }
    } else {
      const int e0 = (v - 32768) * 8, hd = e0 >> 17;
      const float g256 = __expf(256.f * log_gamma(hd));
      u16* base = (u16*)((char*)p.out + OUT_HALF) + e0;
      for (int c0 = 0; c0 < 32; c0 += 8) {
        u32x4 x[8];
#pragma unroll
        for (int u = 0; u < 8; ++u) x[u] = *(const u32x4*)(base + (size_t)(c0 + u) * 524288);
#pragma unroll
        for (int u = 0; u < 8; ++u) {
          u32x4 o;
#pragma unroll
          for (int j = 0; j < 4; ++j) {
            st[2 * j] = st[2 * j] * g256 + lo_f(x[u][j]);
            st[2 * j + 1] = st[2 * j + 1] * g256 + hi_f(x[u][j]);
            o[j] = pack2(st[2 * j], st[2 * j + 1]);
          }
          *(u32x4*)(base + (size_t)(c0 + u) * 524288) = o;
        }
      }
    }
  }
}

DEV void ssd_out_item(const Params& p, int it, char* smem) {
  const int tid = get_tid(), lane = tid & 63, w = tid >> 6, wm = w >> 1, wn = w & 1, r = lane & 31, h = lane >> 5;
  const int c = it >> 3, rem = it & 7, g = rem & 3, lh = rem >> 2;
  if (c == 64 && lh == 1) return;
  u16* Ct = (u16*)smem;
  u16* Bt = Ct + 64 * 136;
  u16* Lt = Bt;
  u16* Xt = Bt + 128 * 136;
  float* acs = (float*)(Xt + 128 * 72);
  float* dts = acs + 128;
  float* rowsq = dts + 128;
  const u16* XBC = (const u16*)(p.ws + OFF_XBC);
  const float* DT = (const float*)(p.ws + OFF_DT);
  u16* Z = (u16*)(p.ws + OFF_Z);
  const int tok0 = c * 128;
  const bool tailc = (L - tok0) < 128;
  stage_conv<64, 128, false>(Ct, 136, XBC, tok0 + lh * 64, 2560 + g * 128, p.in[4], p.in[5], nullptr);
  stage_conv<128, 128, false>(Bt, 136, XBC, tok0, 2048 + g * 128, p.in[4], p.in[5], nullptr);
  if (tid < 64) rowsq[tid] = 0.f;
  __syncthreads();
  f32x16 cb[2];
  cb[0] = zero16(); cb[1] = zero16();
#pragma unroll
  for (int ks = 0; ks < 8; ++ks) {
    bf16x8 a = frag_row(Ct, 136, wm * 32 + r, ks * 16 + h * 8);
#pragma unroll
    for (int ni = 0; ni < 2; ++ni) {
      bf16x8 bq = frag_row(Bt, 136, wn * 64 + ni * 32 + r, ks * 16 + h * 8);
      cb[ni] = mfma(a, bq, cb[ni]);
    }
  }
  for (int hh = 0; hh < 8; ++hh) {
    const int H = g * 8 + hh;
    u32x4 zv[2];
    {
      int tz = tok0 + lh * 64 + (tid >> 2); tz = tz < L ? tz : L - 1;
      const u16* zp0 = Z + (size_t)tz * 2048 + H * 64 + (tid & 3) * 16;
      zv[0] = *(const u32x4*)zp0; zv[1] = *(const u32x4*)(zp0 + 8);
    }
    if (w == 0) {
      const float A = -expf(p.in[7][H]);
      chunk_cumsum(DT, c, H, A, acs, dts, lane);
    }
    stage_conv<128, 64, false>(Xt, 72, XBC, tok0, H * 64, p.in[4], p.in[5], nullptr);
    __syncthreads();
#pragma unroll
    for (int ni = 0; ni < 2; ++ni) {
      if (tailc && (wn | ni)) continue;
#pragma unroll
      for (int i = 0; i < 16; ++i) {
        const int ll = wm * 32 + acc_row(i, h), l = lh * 64 + ll, s = wn * 64 + ni * 32 + r;
        float val = 0.f;
        if (s <= l) val = cb[ni][i] * __expf(acs[l] - acs[s]) * dts[s];
        Lt[ll * 136 + s] = f2bf(val);
      }
    }
    f32x16 y = zero16();
    if (c > 0) {
      const u16* pv = (const u16*)(p.ws + OFF_S1) + ((size_t)((c - 1) * 32 + H) * 64 + wn * 32 + r) * 128 + h * 8;
#pragma unroll
      for (int ks = 0; ks < 8; ++ks) {
        bf16x8 a = frag_row(Ct, 136, wm * 32 + r, ks * 16 + h * 8);
        bf16x8 bq = *(const bf16x8*)(pv + ks * 16);
        y = mfma(a, bq, y);
      }
#pragma unroll
      for (int i = 0; i < 16; ++i) { const int l = lh * 64 + wm * 32 + acc_row(i, h); y[i] *= __expf(acs[l]); }
    }
    __syncthreads();
#pragma unroll
    for (int ks = 0; ks < 8; ++ks) {
      if (tailc && ks >= 2) break;
      bf16x8 a = frag_row(Lt, 136, wm * 32 + r, ks * 16 + h * 8);
      bf16x8 bq = frag_tr(Xt, 72, ks * 16, wn * 32, lane);
      y = mfma(a, bq, y);
    }
    const float Dsk = p.in[8][H];
    float* Ys = (float*)(Bt + 64 * 136);
#pragma unroll
    for (int i = 0; i < 16; ++i) Ys[(wm * 32 + acc_row(i, h)) * 68 + wn * 32 + r] = y[i];
    u32x4 xv[2];
    {
      const int lx = lh * 64 + (tid >> 2);
      xv[0] = *(const u32x4*)(Xt + lx * 72 + (tid & 3) * 16); xv[1] = *(const u32x4*)(Xt + lx * 72 + (tid & 3) * 16 + 8);
    }
    __syncthreads();
    {
      const int row = tid >> 2, q = tid & 3, l = lh * 64 + row, t = tok0 + l;
      float sq = 0.f;
      if (t < L) {
        u16* zp = Z + (size_t)t * 2048 + H * 64 + q * 16;
        u32x4 ov[2];
#pragma unroll
        for (int k = 0; k < 2; ++k) {
          const f32x4 ya = *(const f32x4*)(Ys + row * 68 + q * 16 + k * 8), yb = *(const f32x4*)(Ys + row * 68 + q * 16 + k * 8 + 4);
          float o[8];
#pragma unroll
          for (int j = 0; j < 4; ++j) {
            const float y0 = (j < 2) ? ya[2 * j] : yb[2 * j - 4], y1 = (j < 2) ? ya[2 * j + 1] : yb[2 * j - 3];
            o[2 * j] = (y0 + Dsk * lo_f(xv[k][j])) * silu_f(lo_f(zv[k][j]));
            o[2 * j + 1] = (y1 + Dsk * hi_f(xv[k][j])) * silu_f(hi_f(zv[k][j]));
            sq += o[2 * j] * o[2 * j] + o[2 * j + 1] * o[2 * j + 1];
            ov[k][j] = pack2(o[2 * j], o[2 * j + 1]);
          }
        }
        *(u32x4*)zp = ov[0]; *(u32x4*)(zp + 8) = ov[1];
      }
      sq += __shfl_xor(sq, 1); sq += __shfl_xor(sq, 2);
      if (q == 0) rowsq[row] += sq;
    }
  }
  __syncthreads();
  {
    const int row = tid >> 2, q = tid & 3, t = tok0 + lh * 64 + row;
    if (t < L) {
      const float rn = rsqrtf(rowsq[row] * (1.f / 512.f) + EPS);
      u32x4 v[16];
#pragma unroll
      for (int hh = 0; hh < 8; ++hh) {
        const u16* zp = Z + (size_t)t * 2048 + (g * 8 + hh) * 64 + q * 16;
        v[2 * hh] = *(const u32x4*)zp; v[2 * hh + 1] = *(const u32x4*)(zp + 8);
      }
#pragma unroll
      for (int hh = 0; hh < 8; ++hh) {
        u16* zp = Z + (size_t)t * 2048 + (g * 8 + hh) * 64 + q * 16;
        const float* nwp = p.in[9] + (g * 8 + hh) * 64 + q * 16;
#pragma unroll
        for (int k = 0; k < 2; ++k) {
          const f32x4 wa = *(const f32x4*)(nwp + k * 8), wb = *(const f32x4*)(nwp + k * 8 + 4);
          u32x4 o;
          o[0] = pack2(lo_f(v[2 * hh + k][0]) * rn * wa[0], hi_f(v[2 * hh + k][0]) * rn * wa[1]);
          o[1] = pack2(lo_f(v[2 * hh + k][1]) * rn * wa[2], hi_f(v[2 * hh + k][1]) * rn * wa[3]);
          o[2] = pack2(lo_f(v[2 * hh + k][2]) * rn * wb[0], hi_f(v[2 * hh + k][2]) * rn * wb[1]);
          o[3] = pack2(lo_f(v[2 * hh + k][3]) * rn * wb[2], hi_f(v[2 * hh + k][3]) * rn * wb[3]);
          *(u32x4*)(zp + k * 8) = o;
        }
      }
    }
  }
  __syncthreads();
}

DEV void ret_out_item(const Params& p, int it, char* smem) {
  const int tid = get_tid(), lane = tid & 63, w = tid >> 6, wm = w >> 1, wn = w & 1, r = lane & 31, h = lane >> 5;
  const int rt = it >> 2, hd = it & 3;
  const int t0 = rt * 64, sc = rt >> 2, qtr = rt & 3;
  u16* P = (u16*)smem;
  char* gsm = smem + 33792;
  u16* Vt = (u16*)gsm;
  float* rowsq = (float*)(smem + 33792 + 27648);
  const u16* Qg = (const u16*)(p.ws + OFF_Q) + hd * 256;
  const u16* Kg = (const u16*)(p.ws + OFF_K) + hd * 256;
  const u16* Vg = (const u16*)(p.ws + OFF_V);
  u16* Gg = (u16*)(p.ws + OFF_G);
  const u16* RST = (const u16*)((char*)p.out + OUT_HALF);
  const float lg = log_gamma(hd);
  if (tid < 64) rowsq[tid] = 0.f;
  const int nkb = (qtr >= 2) ? 2 : 1;
  for (int kb = 0; kb < nkb; ++kb) {
    f32x16 acc[1][2];
    acc[0][0] = zero16(); acc[0][1] = zero16();
    gemm_tile<1>(acc, Qg, 1024, t0, L - 1, Kg, 1024, sc * 256 + kb * 128, 256, gsm);
#pragma unroll
    for (int ni = 0; ni < 2; ++ni)
#pragma unroll
      for (int i = 0; i < 16; ++i) {
        const int ll = wm * 32 + acc_row(i, h), lp = qtr * 64 + ll, s = kb * 128 + wn * 64 + ni * 32 + r;
        float val = 0.f;
        if (s <= lp) val = acc[0][ni][i] * __expf((float)(lp - s) * lg);
        P[ll * 264 + s] = f2bf(val);
      }
  }
  float rs[16];
#pragma unroll
  for (int i = 0; i < 16; ++i) rs[i] = 0.f;
  for (int et = 0; et < 4; ++et) {
    f32x16 acc[1][2];
    acc[0][0] = zero16(); acc[0][1] = zero16();
    u32x4 gv[4], vreg[4];
    {
      int tg = t0 + (tid >> 2); tg = tg < L ? tg : L - 1;
      const u16* gp0 = Gg + (size_t)tg * 2048 + hd * 512 + et * 128 + (tid & 3) * 32;
#pragma unroll
      for (int k = 0; k < 4; ++k) gv[k] = *(const u32x4*)(gp0 + k * 8);
#pragma unroll
      for (int i = 0; i < 4; ++i) {
        const int cidx = tid + i * 256, row = cidx >> 4, cc = cidx & 15;
        int tok = sc * 256 + row; tok = tok < L ? tok : L - 1;
        vreg[i] = *(const u32x4*)(Vg + (size_t)tok * 2048 + hd * 512 + et * 128 + cc * 8);
      }
    }
    if (sc > 0) {
      gemm_tile<1>(acc, Qg, 1024, t0, L - 1, RST + ((size_t)((sc - 1) * 4 + hd) * 512 + et * 128) * 256, 256, 0, 256, gsm);
#pragma unroll
      for (int ni = 0; ni < 2; ++ni)
#pragma unroll
        for (int i = 0; i < 16; ++i) {
          const int lp = qtr * 64 + wm * 32 + acc_row(i, h);
          acc[0][ni][i] *= __expf((float)(lp + 1) * lg);
        }
    }
    for (int kb64 = 0; kb64 <= qtr; ++kb64) {
#pragma unroll
      for (int i = 0; i < 4; ++i) {
        const int cidx = tid + i * 256, row = cidx >> 4, cc = cidx & 15;
        const int tok = sc * 256 + kb64 * 64 + row;
        u32x4 v = {0u, 0u, 0u, 0u};
        if (tok < L) v = vreg[i];
        *(u32x4*)(Vt + row * 136 + cc * 8) = v;
      }
      __syncthreads();
      if (kb64 < qtr) {
#pragma unroll
        for (int i = 0; i < 4; ++i) {
          const int cidx = tid + i * 256, row = cidx >> 4, cc = cidx & 15;
          int tok = sc * 256 + (kb64 + 1) * 64 + row; tok = tok < L ? tok : L - 1;
          vreg[i] = *(const u32x4*)(Vg + (size_t)tok * 2048 + hd * 512 + et * 128 + cc * 8);
        }
      }
#pragma unroll
      for (int ks = 0; ks < 4; ++ks) {
        bf16x8 a = frag_row(P, 264, wm * 32 + r, kb64 * 64 + ks * 16 + h * 8);
#pragma unroll
        for (int ni = 0; ni < 2; ++ni) {
          bf16x8 bq = frag_tr(Vt, 136, ks * 16, wn * 64 + ni * 32, lane);
          acc[0][ni] = mfma(a, bq, acc[0][ni]);
        }
      }
      __syncthreads();
    }
    u16* Os = (u16*)gsm;
#pragma unroll
    for (int ni = 0; ni < 2; ++ni)
#pragma unroll
      for (int i = 0; i < 16; ++i) {
        const float o = acc[0][ni][i];
        if (t0 + wm * 32 + acc_row(i, h) < L) rs[i] += o * o;
        Os[(wm * 32 + acc_row(i, h)) * 136 + wn * 64 + ni * 32 + r] = f2bf(o);
      }
    __syncthreads();
    {
      const int row = tid >> 2, q = tid & 3, t = t0 + row;
      if (t < L) {
        u16* gp = Gg + (size_t)t * 2048 + hd * 512 + et * 128 + q * 32;
        u32x4 ov[4];
#pragma unroll
        for (int k = 0; k < 4; ++k) ov[k] = *(const u32x4*)(Os + row * 136 + q * 32 + k * 8);
#pragma unroll
        for (int k = 0; k < 4; ++k) {
          u32x4 o;
#pragma unroll
          for (int j = 0; j < 4; ++j) o[j] = pack2(silu_f(lo_f(gv[k][j])) * lo_f(ov[k][j]), silu_f(hi_f(gv[k][j])) * hi_f(ov[k][j]));
          *(u32x4*)(gp + k * 8) = o;
        }
      }
    }
    __syncthreads();
  }
#pragma unroll
  for (int i = 0; i < 16; ++i) {
    const float v = half_sum(rs[i]);
    if (r == 0) atomicAdd(&rowsq[wm * 32 + acc_row(i, h)], v);
  }
  __syncthreads();
  {
    const int row = tid >> 2, q = tid & 3, t = t0 + row;
    if (t < L) {
      const float rn = rsqrtf(rowsq[row] * (1.f / 512.f) + EPS);
      u32x4 v[16];
#pragma unroll
      for (int et = 0; et < 4; ++et)
#pragma unroll
        for (int k = 0; k < 4; ++k) v[et * 4 + k] = *(const u32x4*)(Gg + (size_t)t * 2048 + hd * 512 + et * 128 + q * 32 + k * 8);
#pragma unroll
      for (int et = 0; et < 4; ++et)
#pragma unroll
        for (int k = 0; k < 4; ++k) {
          u32x4 o;
#pragma unroll
          for (int j = 0; j < 4; ++j) o[j] = pack2(lo_f(v[et * 4 + k][j]) * rn, hi_f(v[et * 4 + k][j]) * rn);
          *(u32x4*)(Gg + (size_t)t * 2048 + hd * 512 + et * 128 + q * 32 + k * 8) = o;
        }
    }
  }
  __syncthreads();
}

DEV void merge_tile(const Params& p, int it, char* smem) {
  const int tid = get_tid(), lane = tid & 63, w = tid >> 6, wm = w >> 1, wn = w & 1, r = lane & 31, h = lane >> 5;
  const int nt = it / 65, mt = it % 65;
  u16* GS = (u16*)(p.ws + OFF_GS);
  const u16* GR = (const u16*)(p.ws + OFF_GR);
  f32x16 acc[2][2];
#pragma unroll
  for (int mi = 0; mi < 2; ++mi)
#pragma unroll
    for (int ni = 0; ni < 2; ++ni) acc[mi][ni] = zero16();
  gemm_tile<2>(acc, (const u16*)(p.ws + OFF_Z), 2048, mt * 128, L - 1, (const u16*)(p.ws + OFF_S2), 2048, nt * 128, 2048, smem);
#pragma unroll
  for (int mi = 0; mi < 2; ++mi)
#pragma unroll
    for (int ni = 0; ni < 2; ++ni)
#pragma unroll
      for (int i = 0; i < 16; ++i) {
        const int t = mt * 128 + wm * 64 + mi * 32 + acc_row(i, h);
        if (t < L) {
          const size_t idx = (size_t)t * 1024 + nt * 128 + wn * 64 + ni * 32 + r;
          GS[idx] = f2bf(bf2f(GS[idx]) * acc[mi][ni][i]);
        }
        acc[mi][ni][i] = 0.f;
      }
  gemm_tile<2>(acc, (const u16*)(p.ws + OFF_G), 2048, mt * 128, L - 1, (const u16*)(p.ws + OFF_S2 + 4194304), 2048, nt * 128, 2048, smem);
#pragma unroll
  for (int mi = 0; mi < 2; ++mi)
#pragma unroll
    for (int ni = 0; ni < 2; ++ni)
#pragma unroll
      for (int i = 0; i < 16; ++i) {
        const int t = mt * 128 + wm * 64 + mi * 32 + acc_row(i, h);
        if (t < L) {
          const size_t idx = (size_t)t * 1024 + nt * 128 + wn * 64 + ni * 32 + r;
          GS[idx] = f2bf(bf2f(GS[idx]) + bf2f(GR[idx]) * acc[mi][ni][i]);
        }
      }
}

DEV void phase_merge(const Params& p, char* smem) {
  const int n_tiles = 65 * 8;
  const int n_wout = 16 * 16, n_wup = 16 * 88, n_wdown = 44 * 16;
  const int total = n_tiles + n_wout + n_wup + n_wdown;
  for (int it = get_bid(); it < total; it += nworkers()) {
    if (it < n_tiles) merge_tile(p, it, smem);
    else if (it < n_tiles + n_wout) { const int j = it - n_tiles; convert_tile(p.in[12], 1024, 1024, (u16*)(p.ws + OFF_WOUT), j & 15, j >> 4, 0, smem); }
    else if (it < n_tiles + n_wout + n_wup) { const int j = it - n_tiles - n_wout; convert_tile(p.in[14], 5632, 1024, (u16*)(p.ws + OFF_WUP), j & 15, j >> 4, 0, smem); }
    else { const int j = it - n_tiles - n_wout - n_wup; convert_tile(p.in[17], 1024, 2816, (u16*)(p.ws + OFF_WDOWN), j % 44, j / 44, 0, smem); }
  }
}

DEV void phase_outproj(const Params& p, int b, char* smem) {
  const int tid = get_tid(), lane = tid & 63, w = tid >> 6, wm = w >> 1, wn = w & 1, r = lane & 31, h = lane >> 5;
  float* HM = (float*)(p.ws + OFF_HM);
  for (int it = get_bid(); it < 65 * 8; it += gridDim.x) {
    const int nt = it / 65, mt = it % 65;
    f32x16 acc[2][2];
#pragma unroll
    for (int mi = 0; mi < 2; ++mi)
#pragma unroll
      for (int ni = 0; ni < 2; ++ni) acc[mi][ni] = zero16();
    gemm_tile<2>(acc, (const u16*)(p.ws + OFF_GS), 1024, mt * 128, L - 1, (const u16*)(p.ws + OFF_WOUT), 1024, nt * 128, 1024, smem);
#pragma unroll
    for (int mi = 0; mi < 2; ++mi)
#pragma unroll
      for (int ni = 0; ni < 2; ++ni)
#pragma unroll
        for (int i = 0; i < 16; ++i) {
          const int t = mt * 128 + wm * 64 + mi * 32 + acc_row(i, h);
          const int col = nt * 128 + wn * 64 + ni * 32 + r;
          if (t < NMETA) HM[t * 1024 + col] = p.in[1][t * 1024 + col] + acc[mi][ni][i];
          else if (t < L) {
            const size_t idx = ((size_t)b * SEQ + (t - NMETA)) * 1024 + col;
            p.out[idx] = p.in[0][idx] + acc[mi][ni][i];
          }
        }
  }
}

DEV void phase_norm2(const Params& p, int b) {
  const int lane = get_tid() & 63, w = get_tid() >> 6;
  u16* U2 = (u16*)(p.ws + OFF_U2);
  for (int it = get_bid(); it < L / 4; it += nworkers()) {
    const int t = it * 4 + w;
    const float* src = (t < NMETA) ? ((const float*)(p.ws + OFF_HM) + (size_t)t * D) : (p.out + ((size_t)b * SEQ + (t - NMETA)) * D);
    rmsnorm_row_bf16(src, p.in[13], U2 + (size_t)t * D, lane);
  }
}

DEV void phase_up(const Params& p, char* smem) {
  const int tid = get_tid(), lane = tid & 63, w = tid >> 6, wm = w >> 1, wn = w & 1, r = lane & 31, h = lane >> 5;
  u16* UP = (u16*)(p.ws + OFF_UP);
  for (int it = get_bid(); it < 65 * 44; it += gridDim.x) {
    const int nt = it / 65, mt = it % 65;
    f32x16 acc[2][2];
#pragma unroll
    for (int mi = 0; mi < 2; ++mi)
#pragma unroll
      for (int ni = 0; ni < 2; ++ni) acc[mi][ni] = zero16();
    gemm_tile<2>(acc, (const u16*)(p.ws + OFF_U2), 1024, mt * 128, L - 1, (const u16*)(p.ws + OFF_WUP), 1024, nt * 128, 1024, smem);
#pragma unroll
    for (int mi = 0; mi < 2; ++mi)
#pragma unroll
      for (int ni = 0; ni < 2; ++ni)
#pragma unroll
        for (int i = 0; i < 16; ++i) {
          const int t = mt * 128 + wm * 64 + mi * 32 + acc_row(i, h);
          if (t < L) UP[(size_t)t * 5632 + nt * 128 + wn * 64 + ni * 32 + r] = f2bf(acc[mi][ni][i]);
        }
  }
}

DEV void phase_ffn_act(const Params& p) {
  const int gt = get_bid() * 256 + get_tid(), nth = nworkers() * 256;
  const u16* UP = (const u16*)(p.ws + OFF_UP);
  u16* ACT = (u16*)(p.ws + OFF_ACT);
  const float* cw = p.in[15];
  const float* cbias = p.in[16];
  for (int u = gt; u < 513 * 352; u += nth) {
    const int rb = u / 352, cgp = u % 352, ch = cgp * 8, t0 = rb * 16;
    float wg[3][8], wv[3][8], bg[8], bv[8], g2[8], g1[8], v2[8], v1[8];
#pragma unroll
    for (int k = 0; k < 3; ++k)
#pragma unroll
      for (int j = 0; j < 8; ++j) { wg[k][j] = cw[k * 5632 + ch + j]; wv[k][j] = cw[k * 5632 + 2816 + ch + j]; }
#pragma unroll
    for (int j = 0; j < 8; ++j) { bg[j] = cbias[ch + j]; bv[j] = cbias[2816 + ch + j]; }
    {
      u32x4 a = {0u, 0u, 0u, 0u}, bq = {0u, 0u, 0u, 0u}, c2 = {0u, 0u, 0u, 0u}, d2 = {0u, 0u, 0u, 0u};
      if (t0 >= 2) {
        a = *(const u32x4*)(UP + (size_t)(t0 - 2) * 5632 + ch); bq = *(const u32x4*)(UP + (size_t)(t0 - 1) * 5632 + ch);
        c2 = *(const u32x4*)(UP + (size_t)(t0 - 2) * 5632 + 2816 + ch); d2 = *(const u32x4*)(UP + (size_t)(t0 - 1) * 5632 + 2816 + ch);
      }
#pragma unroll
      for (int j = 0; j < 4; ++j) {
        g2[2 * j] = lo_f(a[j]); g2[2 * j + 1] = hi_f(a[j]); g1[2 * j] = lo_f(bq[j]); g1[2 * j + 1] = hi_f(bq[j]);
        v2[2 * j] = lo_f(c2[j]); v2[2 * j + 1] = hi_f(c2[j]); v1[2 * j] = lo_f(d2[j]); v1[2 * j + 1] = hi_f(d2[j]);
      }
    }
#pragma unroll 4
    for (int i = 0; i < 16; ++i) {
      const int t = t0 + i;
      const u32x4 a = *(const u32x4*)(UP + (size_t)t * 5632 + ch);
      const u32x4 c2 = *(const u32x4*)(UP + (size_t)t * 5632 + 2816 + ch);
      float o[8];
#pragma unroll
      for (int j = 0; j < 8; ++j) {
        const float gx = (j & 1) ? hi_f(a[j >> 1]) : lo_f(a[j >> 1]);
        const float vx = (j & 1) ? hi_f(c2[j >> 1]) : lo_f(c2[j >> 1]);
        const float ag = bg[j] + wg[0][j] * g2[j] + wg[1][j] * g1[j] + wg[2][j] * gx;
        const float av = bv[j] + wv[0][j] * v2[j] + wv[1][j] * v1[j] + wv[2][j] * vx;
        o[j] = silu_f(ag) * av;
        g2[j] = g1[j]; g1[j] = gx; v2[j] = v1[j]; v1[j] = vx;
      }
      u32x4 pk; pk[0] = pack2(o[0], o[1]); pk[1] = pack2(o[2], o[3]); pk[2] = pack2(o[4], o[5]); pk[3] = pack2(o[6], o[7]);
      *(u32x4*)(ACT + (size_t)t * 2816 + ch) = pk;
    }
  }
}

DEV void phase_down(const Params& p, int b, char* smem) {
  const int tid = get_tid(), lane = tid & 63, w = tid >> 6, wm = w >> 1, wn = w & 1, r = lane & 31, h = lane >> 5;
  for (int it = get_bid(); it < 64 * 8; it += gridDim.x) {
    const int nt = it / 64, mt = it % 64;
    f32x16 acc[2][2];
#pragma unroll
    for (int mi = 0; mi < 2; ++mi)
#pragma unroll
      for (int ni = 0; ni < 2; ++ni) acc[mi][ni] = zero16();
    gemm_tile<2>(acc, (const u16*)(p.ws + OFF_ACT), 2816, NMETA + mt * 128, L - 1, (const u16*)(p.ws + OFF_WDOWN), 2816, nt * 128, 2816, smem);
#pragma unroll
    for (int mi = 0; mi < 2; ++mi)
#pragma unroll
      for (int ni = 0; ni < 2; ++ni)
#pragma unroll
        for (int i = 0; i < 16; ++i) {
          const int rr = mt * 128 + wm * 64 + mi * 32 + acc_row(i, h);
          const size_t idx = ((size_t)b * SEQ + rr) * 1024 + nt * 128 + wn * 64 + ni * 32 + r;
          p.out[idx] += acc[mi][ni][i];
        }
  }
}

DEV void phase_final_norm(const Params& p, int b) {
  const int lane = get_tid() & 63, w = get_tid() >> 6;
  for (int it = get_bid(); it < SEQ / 4; it += nworkers()) {
    const int rr = it * 4 + w;
    rmsnorm_row_f32_inplace(p.out + ((size_t)b * SEQ + rr) * D, p.in[18], lane);
  }
}


DEV u32x4 add_bf16x8(u32x4 a, u32x4 b) {
  u32x4 o;
#pragma unroll
  for (int j = 0; j < 4; ++j) o[j] = pack2(lo_f(a[j]) + lo_f(b[j]), hi_f(a[j]) + hi_f(b[j]));
  return o;
}
template <int NJ, bool ADD2 = false>
DEV void gemm_tile8(f32x4 (&acc)[4][NJ], const u16* __restrict__ A, int lda, int arow0, int arow_max,
                    const u16* __restrict__ B, int ldb, int brow0, int K, char* smem, const u16* __restrict__ A2 = nullptr) {
  constexpr int BN = NJ * 32;
  constexpr int BCH = BN / 64;
  constexpr int STAGE = (256 + BN) * 64;
  u16* S = (u16*)smem;
  const int tid = get_tid8(), lane = tid & 63, w = tid >> 6, wm = w >> 1, wn = w & 1;
  u32x4 ra[4], rb[BCH], ra2[ADD2 ? 4 : 1];
  unsigned aoff[4], boff[BCH];
  const char* Ab = (const char*)A;
  const char* Ab2 = (const char*)A2;
  const char* Bb = (const char*)(B + (size_t)brow0 * ldb);
  const int crow = tid >> 3, kc = tid & 7;
  const unsigned sto = (unsigned)(crow * 64 + ((kc ^ ((crow >> 1) & 7)) * 8));
#pragma unroll
  for (int i = 0; i < 4; ++i) {
    int gr = arow0 + crow + i * 64; gr = gr > arow_max ? arow_max : gr; gr = gr < 0 ? 0 : gr;
    aoff[i] = ((unsigned)gr * (unsigned)lda + kc * 8) * 2u;
  }
#pragma unroll
  for (int i = 0; i < BCH; ++i) boff[i] = ((unsigned)(crow + i * 64) * (unsigned)ldb + kc * 8) * 2u;
  const int fr = lane & 15, swz = fr >> 1, cq = lane >> 4;
  const unsigned fa = (unsigned)((wm * 64 + fr) * 64), fb = (unsigned)((256 + wn * (NJ * 16) + fr) * 64);
  const unsigned c0 = (unsigned)(((cq) ^ swz) * 8), c1 = (unsigned)(((4 + cq) ^ swz) * 8);
  const int nk = K >> 6;
#pragma unroll
  for (int i = 0; i < 4; ++i) { ra[i] = *(const u32x4*)(Ab + aoff[i]); if (ADD2) ra2[i] = *(const u32x4*)(Ab2 + aoff[i]); }
#pragma unroll
  for (int i = 0; i < BCH; ++i) rb[i] = *(const u32x4*)(Bb + boff[i]);
#pragma unroll
  for (int i = 0; i < 4; ++i) *(u32x4*)(S + sto + i * 64 * 64) = ADD2 ? add_bf16x8(ra[i], ra2[i]) : ra[i];
#pragma unroll
  for (int i = 0; i < BCH; ++i) *(u32x4*)(S + sto + (256 + i * 64) * 64) = rb[i];
  if (nk > 1) {
#pragma unroll
    for (int i = 0; i < 4; ++i) { ra[i] = *(const u32x4*)(Ab + aoff[i] + 128); if (ADD2) ra2[i] = *(const u32x4*)(Ab2 + aoff[i] + 128); }
#pragma unroll
    for (int i = 0; i < BCH; ++i) rb[i] = *(const u32x4*)(Bb + boff[i] + 128);
  }
  __syncthreads();
  for (int kt = 0; kt < nk; ++kt) {
    const u16* Sc = S + (kt & 1) * STAGE;
    {
      bf16x8 a[4], b[NJ];
#pragma unroll
      for (int m = 0; m < 4; ++m) a[m] = *(const bf16x8*)(Sc + fa + m * 16 * 64 + c0);
#pragma unroll
      for (int n = 0; n < NJ; ++n) b[n] = *(const bf16x8*)(Sc + fb + n * 16 * 64 + c0);
      __builtin_amdgcn_s_setprio(1);
#pragma unroll
      for (int m = 0; m < 4; ++m)
#pragma unroll
        for (int n = 0; n < NJ; ++n) acc[m][n] = __builtin_amdgcn_mfma_f32_16x16x32_bf16(a[m], b[n], acc[m][n], 0, 0, 0);
      __builtin_amdgcn_s_setprio(0);
    }
    bf16x8 a1[4], b1[NJ];
#pragma unroll
    for (int m = 0; m < 4; ++m) a1[m] = *(const bf16x8*)(Sc + fa + m * 16 * 64 + c1);
#pragma unroll
    for (int n = 0; n < NJ; ++n) b1[n] = *(const bf16x8*)(Sc + fb + n * 16 * 64 + c1);
    if (kt + 1 < nk) {
      u16* Aw = S + ((kt + 1) & 1) * STAGE;
#pragma unroll
      for (int i = 0; i < 4; ++i) *(u32x4*)(Aw + sto + i * 64 * 64) = ADD2 ? add_bf16x8(ra[i], ra2[i]) : ra[i];
#pragma unroll
      for (int i = 0; i < BCH; ++i) *(u32x4*)(Aw + sto + (256 + i * 64) * 64) = rb[i];
      if (kt + 2 < nk) {
        const unsigned ko = (unsigned)(kt + 2) * 128u;
#pragma unroll
        for (int i = 0; i < 4; ++i) { ra[i] = *(const u32x4*)(Ab + aoff[i] + ko); if (ADD2) ra2[i] = *(const u32x4*)(Ab2 + aoff[i] + ko); }
#pragma unroll
        for (int i = 0; i < BCH; ++i) rb[i] = *(const u32x4*)(Bb + boff[i] + ko);
      }
    }
    {
      __builtin_amdgcn_s_setprio(1);
#pragma unroll
      for (int m = 0; m < 4; ++m)
#pragma unroll
        for (int n = 0; n < NJ; ++n) acc[m][n] = __builtin_amdgcn_mfma_f32_16x16x32_bf16(a1[m], b1[n], acc[m][n], 0, 0, 0);
      __builtin_amdgcn_s_setprio(0);
    }
    __syncthreads();
  }
}

DEV f32x4 thin16(const u16* __restrict__ A, int lda, int row0, const u16* __restrict__ BT, int ldb, int col0, int K, int lane) {
  const u16* ap = A + (size_t)(row0 + (lane & 15)) * lda + 8 * (lane >> 4);
  const u16* bp = BT + (size_t)(col0 + (lane & 15)) * ldb + 8 * (lane >> 4);
  f32x4 acc = {0.f, 0.f, 0.f, 0.f};
  for (int k0 = 0; k0 < K; k0 += 128) {
    bf16x8 a[4], b[4];
#pragma unroll
    for (int j = 0; j < 4; ++j) { a[j] = *(const bf16x8*)(ap + k0 + j * 32); b[j] = *(const bf16x8*)(bp + k0 + j * 32); }
#pragma unroll
    for (int j = 0; j < 4; ++j) acc = __builtin_amdgcn_mfma_f32_16x16x32_bf16(a[j], b[j], acc, 0, 0, 0);
  }
  return acc;
}

DEV int tile_index(int k) { const int G = gridDim.x, rb = get_rbid(); return k * G + (rb & 7) * (G >> 3) + (rb >> 3); }
DEV void tile_decode(int T, int MT, int NT, int& mt, int& nt) {
  const int per = MT * 8;
  const int nb = T / per, rem = T - nb * per;
  int width = NT - nb * 8; width = width > 8 ? 8 : width;
  mt = rem / width; nt = nb * 8 + (rem - mt * width);
}

#define ZERO_ACC(acc, NJ_) _Pragma("unroll") for (int m_ = 0; m_ < 4; ++m_) _Pragma("unroll") for (int n_ = 0; n_ < NJ_; ++n_) { acc[m_][n_][0] = 0.f; acc[m_][n_][1] = 0.f; acc[m_][n_][2] = 0.f; acc[m_][n_][3] = 0.f; }

constexpr int EPI_WAVE_BYTES = 17408;
#define EPI_FENCE() asm volatile("s_waitcnt lgkmcnt(0)" ::: "memory")
DEV void epi_store_bf16_128(const u16* reg, u16* __restrict__ dst, int ld, int trow, int col0, int lane) {
#pragma unroll
  for (int j = 0; j < 16; ++j) {
    const int row = (lane >> 4) + 4 * j, t = trow + row;
    const u32x4 v = *(const u32x4*)(reg + row * 136 + (lane & 15) * 8);
    if (t < L) *(u32x4*)(dst + (size_t)t * ld + col0 + (lane & 15) * 8) = v;
  }
}

DEV void phase_inproj8(const Params& p, int b, char* smem) {
  const u16* U = (const u16*)((char*)p.out + OUT_HALF);
  const u16* WT = (const u16*)(p.ws + OFF_S1);
  const int MT = 33, NT = 53;
  for (int kk = 0;; ++kk) {
    const int it = tile_index(kk);
    if (it >= MT * NT) break;
    int mt, nt; tile_decode(it, MT, NT, mt, nt);
    f32x4 acc[4][8];
    ZERO_ACC(acc, 8)
    gemm_tile8<8>(acc, U, 1024, mt * 256, L - 1, WT, 1024, nt * 256, 1024, smem);
    const int tid = get_tid8(), lane = tid & 63, w = tid >> 6, wm = w >> 1, wn = w & 1, r = lane & 31, h = lane >> 5;
    u16* reg = (u16*)(smem + w * EPI_WAVE_BYTES);
    const int n0 = nt * 256;
    const int trow = mt * 256 + wm * 64;
    if (nt >= 20 && nt < 28) {
      const bool isk = nt >= 24;
      const int cq = n0 - (isk ? 6144 : 5120);
      const float sc = isk ? 0.0625f : 1.f;
      u16* dst = (u16*)(p.ws + (isk ? OFF_K : OFF_Q));
#pragma unroll
      for (int pr = 0; pr < 4; ++pr) {
        const int n1 = 4 * (pr >> 1) + (pr & 1);
        const int jf = (wn * 2 + (pr >> 1)) * 32 + (pr & 1) * 16 + (lane & 15);
        const float invf_rev = exp2f(-(float)jf * 0.10462765653f) * 0.15915494309189535f;
#pragma unroll
        for (int m = 0; m < 4; ++m)
#pragma unroll
          for (int j = 0; j < 4; ++j) {
            const int row = m * 16 + (lane >> 4) * 4 + j;
            const float tf = (float)(trow + row);
            const float ph = tf * invf_rev, pl = fmaf(tf, invf_rev, -ph);
            const float fr = (ph - floorf(ph)) + pl;
            const float sn = __builtin_amdgcn_sinf(fr), cs = __builtin_amdgcn_cosf(fr);
            const float x1 = acc[m][n1][j], x2 = acc[m][n1 + 2][j];
            reg[row * 136 + n1 * 16 + (lane & 15)] = f2bf((x1 * cs - x2 * sn) * sc);
            reg[row * 136 + n1 * 16 + 32 + (lane & 15)] = f2bf((x2 * cs + x1 * sn) * sc);
          }
      }
      EPI_FENCE();
      epi_store_bf16_128(reg, dst, 1024, trow, cq + wn * 128, lane);
    } else if (nt == 52) {
      float* DT = (float*)(p.ws + OFF_DT);
      if (wn == 0) {
#pragma unroll
        for (int n = 0; n < 2; ++n) {
          const int col = n * 16 + (lane & 15);
          const float bias = p.in[6][col];
#pragma unroll
          for (int m = 0; m < 4; ++m)
#pragma unroll
            for (int j = 0; j < 4; ++j) {
              const int t = trow + m * 16 + (lane >> 4) * 4 + j;
              if (t < L) {
                const float x = acc[m][n][j] + bias;
                const float e = __expf(x);
                DT[(size_t)t * 32 + col] = (x > 20.f) ? x : (e < 0.01f ? e * (1.f - 0.5f * e + e * e * (1.f / 3.f)) : __logf(1.f + e));
              }
            }
        }
      }
    } else {
      u16* dst; int ld, c0; bool sig = false;
      if (nt < 8) { dst = (u16*)(p.ws + OFF_Z); ld = 2048; c0 = n0; }
      else if (nt < 20) { dst = (u16*)(p.ws + OFF_XBC); ld = 3072; c0 = n0 - 2048; }
      else if (nt < 36) { dst = (u16*)(p.ws + OFF_V); ld = 2048; c0 = n0 - 7168; }
      else if (nt < 44) { dst = (u16*)(p.ws + OFF_G); ld = 2048; c0 = n0 - 9216; }
      else if (nt < 48) { dst = (u16*)(p.ws + OFF_GS); ld = 1024; c0 = n0 - 11264; sig = true; }
      else { dst = (u16*)(p.ws + OFF_GR); ld = 1024; c0 = n0 - 12288; sig = true; }
#pragma unroll
      for (int m = 0; m < 4; ++m)
#pragma unroll
        for (int n = 0; n < 8; ++n)
#pragma unroll
          for (int j = 0; j < 4; ++j) {
            float v = acc[m][n][j];
            if (sig) v = sigmoid_f(v);
            reg[(m * 16 + (lane >> 4) * 4 + j) * 136 + n * 16 + (lane & 15)] = f2bf(v);
          }
      EPI_FENCE();
      epi_store_bf16_128(reg, dst, ld, trow, c0 + wn * 128, lane);
    }
    __syncthreads();
  }
}

DEV void phase_merge8(const Params& p, char* smem, char* smem_team) {
  u16* GS = (u16*)(p.ws + OFF_GS);
  u16* GR = (u16*)(p.ws + OFF_GR);
  const u16* Zb = (const u16*)(p.ws + OFF_Z);
  const u16* Gb = (const u16*)(p.ws + OFF_G);
  const u16* WBS = (const u16*)(p.ws + OFF_S2);
  const u16* WBR = (const u16*)(p.ws + OFF_S2 + 4194304);
  for (int kk = 0;; ++kk) {
    const int it = tile_index(kk);
    if (it >= 256) break;
    const int branch = it >> 7, tl = it & 127, mt = tl >> 2, nt = tl & 3;
    f32x4 acc[4][8];
    ZERO_ACC(acc, 8)
    gemm_tile8<8>(acc, branch ? Gb : Zb, 2048, mt * 256, L - 1, branch ? WBR : WBS, 2048, nt * 256, 2048, smem);
    const int tid = get_tid8(), lane = tid & 63, w = tid >> 6, wm = w >> 1, wn = w & 1;
    float* reg = (float*)(smem + w * EPI_WAVE_BYTES);
    u16* GT = branch ? GR : GS;
#pragma unroll
    for (int hf = 0; hf < 2; ++hf) {
#pragma unroll
      for (int m = 0; m < 4; ++m)
#pragma unroll
        for (int n = 0; n < 4; ++n)
#pragma unroll
          for (int j = 0; j < 4; ++j) reg[(m * 16 + (lane >> 4) * 4 + j) * 68 + n * 16 + (lane & 15)] = acc[m][hf * 4 + n][j];
      EPI_FENCE();
#pragma unroll
      for (int j = 0; j < 16; ++j) {
        const int row = (lane >> 4) + 4 * j, c4 = (lane & 15) * 4;
        const f32x4 a = *(const f32x4*)(reg + row * 68 + c4);
        const size_t idx = (size_t)(mt * 256 + wm * 64 + row) * 1024 + nt * 256 + wn * 128 + hf * 64 + c4;
        const u32x2 g = *(const u32x2*)(GT + idx);
        u32x2 o; o[0] = pack2(lo_f(g[0]) * a[0], hi_f(g[0]) * a[1]); o[1] = pack2(lo_f(g[1]) * a[2], hi_f(g[1]) * a[3]);
        *(u32x2*)(GT + idx) = o;
      }
      EPI_FENCE();
    }
    __syncthreads();
  }
  for (int ct = get_rbid(); ct < 128; ct += gridDim.x) {
    const int tid = get_tid8(), lane = tid & 63, w = tid >> 6;
    const int branch = ct >> 6, c16 = ct & 63;
    f32x4* red = (f32x4*)smem;
    red[w * 64 + lane] = thin16((branch ? Gb : Zb) + w * 256, 2048, 8192, (branch ? WBR : WBS) + w * 256, 2048, c16 * 16, 256, lane);
    __syncthreads();
    if (w == 0) {
      u16* GT = branch ? GR : GS;
      f32x4 a1 = red[lane];
#pragma unroll
      for (int q = 1; q < 8; ++q) a1 += red[q * 64 + lane];
#pragma unroll
      for (int j = 0; j < 4; ++j) {
        const size_t idx = (size_t)(8192 + (lane >> 4) * 4 + j) * 1024 + c16 * 16 + (lane & 15);
        GT[idx] = f2bf(bf2f(GT[idx]) * a1[j]);
      }
    }
    __syncthreads();
  }
  {
    float* RSS = (float*)(p.ws + OFF_RSS);
    for (int i = get_bid() * 256 + get_tid(); i < L; i += nworkers() * 256) RSS[i] = 0.f;
  }
  const int n_wout = 16 * 16, n_wup = 16 * 88, n_wdown = 44 * 16;
  for (int it = get_bid(); it < n_wout + n_wup + n_wdown; it += nworkers()) {
    if (it < n_wout) { convert_tile(p.in[12], 1024, 1024, (u16*)(p.ws + OFF_WOUT), it & 15, it >> 4, 0, smem_team); }
    else if (it < n_wout + n_wup) { const int j = it - n_wout; convert_tile(p.in[14], 5632, 1024, (u16*)(p.ws + OFF_WUP), j & 15, j >> 4, 2, smem_team, p.in[13]);   }
    else { const int j = it - n_wout - n_wup; convert_tile(p.in[17], 1024, 2816, (u16*)(p.ws + OFF_WDOWN), j % 44, j / 44, 0, smem_team); }
  }
}

DEV void phase_outproj8(const Params& p, int b, char* smem) {
  const int tid = get_tid8(), lane = tid & 63, w = tid >> 6, wm = w >> 1, wn = w & 1, r = lane & 31, h = lane >> 5;
  u16* U2 = (u16*)(p.ws + OFF_U2);
  float* RSS = (float*)(p.ws + OFF_RSS);
  const u16* Mg = (const u16*)(p.ws + OFF_GS);
  const u16* WO = (const u16*)(p.ws + OFF_WOUT);
  float* reg = (float*)(smem + w * EPI_WAVE_BYTES);
  for (int kk = 0;; ++kk) {
    const int it = tile_index(kk);
    if (it >= 256) break;
    const int mt = it >> 3, nt = it & 7;
    f32x4 acc[4][4];
    ZERO_ACC(acc, 4)
    gemm_tile8<4, true>(acc, Mg, 1024, mt * 256, L - 1, WO, 1024, nt * 128, 1024, smem, (const u16*)(p.ws + OFF_GR));
#pragma unroll
    for (int m = 0; m < 4; ++m)
#pragma unroll
      for (int n = 0; n < 4; ++n)
#pragma unroll
        for (int j = 0; j < 4; ++j) reg[(m * 16 + (lane >> 4) * 4 + j) * 68 + n * 16 + (lane & 15)] = acc[m][n][j];
    EPI_FENCE();
#pragma unroll
    for (int j = 0; j < 16; ++j) {
      const int row = (lane >> 4) + 4 * j, c4 = (lane & 15) * 4;
      const f32x4 a = *(const f32x4*)(reg + row * 68 + c4);
      const int t = mt * 256 + wm * 64 + row, col = nt * 128 + wn * 64 + c4;
      f32x4 hv;
      if (t < NMETA) {
        hv = *(const f32x4*)(p.in[1] + t * 1024 + col) + a;
      } else {
        const size_t idx = ((size_t)b * SEQ + (t - NMETA)) * 1024 + col;
        hv = *(const f32x4*)(p.in[0] + idx) + a;
        *(f32x4*)(p.out + idx) = hv;
      }
      u32x2 hb; hb[0] = pack2(hv[0], hv[1]); hb[1] = pack2(hv[2], hv[3]);
      *(u32x2*)(U2 + (size_t)t * 1024 + col) = hb;
      float sq = hv[0] * hv[0] + hv[1] * hv[1] + hv[2] * hv[2] + hv[3] * hv[3];
      sq += __shfl_xor(sq, 1); sq += __shfl_xor(sq, 2); sq += __shfl_xor(sq, 4); sq += __shfl_xor(sq, 8);
      if ((lane & 15) == 0) atomicAdd(&RSS[t], sq);
    }
    __syncthreads();
  }
  for (int ct = get_rbid(); ct < 64; ct += gridDim.x) {
    const int tid = get_tid8(), lane = tid & 63, w = tid >> 6;
    f32x4* red = (f32x4*)smem;
    red[w * 64 + lane] = thin16(Mg + w * 128, 1024, 8192, WO + w * 128, 1024, ct * 16, 128, lane)
                       + thin16((const u16*)(p.ws + OFF_GR) + w * 128, 1024, 8192, WO + w * 128, 1024, ct * 16, 128, lane);
    __syncthreads();
    if (w == 0) {
      f32x4 a1 = red[lane];
#pragma unroll
      for (int q = 1; q < 8; ++q) a1 += red[q * 64 + lane];
#pragma unroll
      for (int j = 0; j < 4; ++j) {
        const int t = 8192 + (lane >> 4) * 4 + j;
        const size_t idx = ((size_t)b * SEQ + (t - NMETA)) * 1024 + ct * 16 + (lane & 15);
        const float hv = p.in[0][idx] + a1[j];
        p.out[idx] = hv;
        U2[(size_t)t * 1024 + ct * 16 + (lane & 15)] = f2bf(hv);
        float sq = hv * hv;
        sq += __shfl_xor(sq, 1); sq += __shfl_xor(sq, 2); sq += __shfl_xor(sq, 4); sq += __shfl_xor(sq, 8);
        if ((lane & 15) == 0) atomicAdd(&RSS[t], sq);
      }
    }
    __syncthreads();
  }
}

DEV void phase_up8(const Params& p, char* smem) {
  u16* ACT = (u16*)(p.ws + OFF_ACT);
  const float* cw = p.in[15];
  const float* cbias = p.in[16];
  for (int kk = 0;; ++kk) {
    const int it = tile_index(kk);
    if (it >= 33 * 22) break;
    int mt, nt; tile_decode(it, 33, 22, mt, nt);
    f32x4 acc[4][8];
    ZERO_ACC(acc, 8)
    gemm_tile8<8>(acc, (const u16*)(p.ws + OFF_U2), 1024, mt * 254 - 2, L - 1, (const u16*)(p.ws + OFF_WUP), 1024, nt * 256, 1024, smem);
    const int tid = get_tid8(), lane = tid & 63, w = tid >> 6;
    u16* reg = (u16*)(smem + w * EPI_WAVE_BYTES);
    {
      const float* RSS = (const float*)(p.ws + OFF_RSS);
      const int wm = w >> 1;
#pragma unroll
      for (int m = 0; m < 4; ++m)
#pragma unroll
        for (int j = 0; j < 4; ++j) {
          int t = mt * 254 - 2 + wm * 64 + m * 16 + (lane >> 4) * 4 + j; t = t < 0 ? 0 : (t > L - 1 ? L - 1 : t);
          const float rstd = rsqrtf(RSS[t] * (1.f / 1024.f) + EPS);
#pragma unroll
          for (int n = 0; n < 8; ++n) reg[(m * 16 + (lane >> 4) * 4 + j) * 136 + n * 16 + (lane & 15)] = f2bf(acc[m][n][j] * rstd);
        }
    }
    __syncthreads();
    {
      const int cg = tid & 15, rg = tid >> 4;
      const int ch = nt * 128 + cg * 8;
      float wg[3][8], wv[3][8], bg[8], bv[8], g2[8], g1[8], v2[8], v1[8];
#pragma unroll
      for (int k = 0; k < 3; ++k) {
        const f32x4 a0 = *(const f32x4*)(cw + k * 5632 + ch), a1 = *(const f32x4*)(cw + k * 5632 + ch + 4);
        const f32x4 c0 = *(const f32x4*)(cw + k * 5632 + 2816 + ch), c1 = *(const f32x4*)(cw + k * 5632 + 2816 + ch + 4);
#pragma unroll
        for (int j = 0; j < 4; ++j) { wg[k][j] = a0[j]; wg[k][4 + j] = a1[j]; wv[k][j] = c0[j]; wv[k][4 + j] = c1[j]; }
      }
      {
        const f32x4 a0 = *(const f32x4*)(cbias + ch), a1 = *(const f32x4*)(cbias + ch + 4);
        const f32x4 c0 = *(const f32x4*)(cbias + 2816 + ch), c1 = *(const f32x4*)(cbias + 2816 + ch + 4);
#pragma unroll
        for (int j = 0; j < 4; ++j) { bg[j] = a0[j]; bg[4 + j] = a1[j]; bv[j] = c0[j]; bv[4 + j] = c1[j]; }
      }
      const int R0 = rg * 8;
#pragma unroll
      for (int q = 0; q < 2; ++q) {
        const int R = R0 - 2 + q;
        u32x4 gvv = {0u, 0u, 0u, 0u}, vvv = {0u, 0u, 0u, 0u};
        if (R >= 0 && mt * 254 - 2 + R >= 0) {
          const char* sl = smem + ((R >> 6) * 2) * EPI_WAVE_BYTES + ((R & 63) * 136 + cg * 8) * 2;
          gvv = *(const u32x4*)sl; vvv = *(const u32x4*)(sl + EPI_WAVE_BYTES);
        }
#pragma unroll
        for (int j = 0; j < 4; ++j) {
          if (q == 0) { g2[2 * j] = lo_f(gvv[j]); g2[2 * j + 1] = hi_f(gvv[j]); v2[2 * j] = lo_f(vvv[j]); v2[2 * j + 1] = hi_f(vvv[j]); }
          else { g1[2 * j] = lo_f(gvv[j]); g1[2 * j + 1] = hi_f(gvv[j]); v1[2 * j] = lo_f(vvv[j]); v1[2 * j + 1] = hi_f(vvv[j]); }
        }
      }
#pragma unroll 2
      for (int i = 0; i < 8; ++i) {
        const int R = R0 + i, t = mt * 254 - 2 + R;
        u32x4 gvv = {0u, 0u, 0u, 0u}, vvv = {0u, 0u, 0u, 0u};
        if (t >= 0) {
          const char* sl = smem + ((R >> 6) * 2) * EPI_WAVE_BYTES + ((R & 63) * 136 + cg * 8) * 2;
          gvv = *(const u32x4*)sl; vvv = *(const u32x4*)(sl + EPI_WAVE_BYTES);
        }
        float o[8];
#pragma unroll
        for (int j = 0; j < 8; ++j) {
          const float gx = (j & 1) ? hi_f(gvv[j >> 1]) : lo_f(gvv[j >> 1]);
          const float vx = (j & 1) ? hi_f(vvv[j >> 1]) : lo_f(vvv[j >> 1]);
          const float ag = bg[j] + wg[0][j] * g2[j] + wg[1][j] * g1[j] + wg[2][j] * gx;
          const float av = bv[j] + wv[0][j] * v2[j] + wv[1][j] * v1[j] + wv[2][j] * vx;
          o[j] = silu_f(ag) * av;
          g2[j] = g1[j]; g1[j] = gx; v2[j] = v1[j]; v1[j] = vx;
        }
        if (R >= 2 && t < L) {
          u32x4 pk; pk[0] = pack2(o[0], o[1]); pk[1] = pack2(o[2], o[3]); pk[2] = pack2(o[4], o[5]); pk[3] = pack2(o[6], o[7]);
          *(u32x4*)(ACT + (size_t)t * 2816 + ch) = pk;
        }
      }
    }
    __syncthreads();
  }
}

DEV void phase_down8(const Params& p, int b, char* smem) {
  for (int kk = 0;; ++kk) {
    const int it = tile_index(kk);
    if (it >= 256) break;
    const int mt = it >> 3, nt = it & 7;
    f32x4 acc[4][4];
    ZERO_ACC(acc, 4)
    gemm_tile8<4>(acc, (const u16*)(p.ws + OFF_ACT), 2816, NMETA + mt * 256, L - 1, (const u16*)(p.ws + OFF_WDOWN), 2816, nt * 128, 2816, smem);
    const int tid = get_tid8(), lane = tid & 63, w = tid >> 6, wm = w >> 1, wn = w & 1, r = lane & 31, h = lane >> 5;
    float* reg = (float*)(smem + w * EPI_WAVE_BYTES);
#pragma unroll
    for (int m = 0; m < 4; ++m)
#pragma unroll
      for (int n = 0; n < 4; ++n)
#pragma unroll
        for (int j = 0; j < 4; ++j) reg[(m * 16 + (lane >> 4) * 4 + j) * 68 + n * 16 + (lane & 15)] = acc[m][n][j];
    EPI_FENCE();
#pragma unroll
    for (int j = 0; j < 16; ++j) {
      const int row = (lane >> 4) + 4 * j, c4 = (lane & 15) * 4;
      const f32x4 a = *(const f32x4*)(reg + row * 68 + c4);
      const size_t idx = ((size_t)b * SEQ + mt * 256 + wm * 64 + row) * 1024 + nt * 128 + wn * 64 + c4;
      const f32x4 x = *(const f32x4*)(p.out + idx);
      *(f32x4*)(p.out + idx) = x + a;
    }
    __syncthreads();
  }
}

#define XB_TMO      128
#define XB_XCNT(j)  (256  + 64 * (j))
#define XB_XSUB(j)  (1280 + 64 * (j))
#define XB_XGEN(j)  (2304 + 64 * (j))
#define XB_TOP      3328
#define XB_TOPGEN   3392
#define XCD_BAR_WORDS 3456
#define XB_SPIN_CAP (1u << 24)
DEV unsigned xb_ld(unsigned* p)              { return __hip_atomic_load(p, __ATOMIC_RELAXED, __HIP_MEMORY_SCOPE_AGENT); }
DEV unsigned xb_add(unsigned* p, unsigned v) { return __hip_atomic_fetch_add(p, v, __ATOMIC_RELAXED, __HIP_MEMORY_SCOPE_AGENT); }
DEV unsigned xb_xcc_id() { return (unsigned)__builtin_amdgcn_s_getreg((3 << 11) | 20) & 0xFu; }
#define XB_SPIN(cond, bar) do { unsigned _sp = 0; while (cond) { __builtin_amdgcn_s_sleep(1); \
    if ((++_sp & 255u) == 0u) { if (xb_ld(&(bar)[XB_TMO])) break; if (_sp > XB_SPIN_CAP) { atomicAdd(&(bar)[XB_TMO], 1u); break; } } } } while (0)
struct XcdBarrier { unsigned* bar; unsigned x; volatile LDSP unsigned* st; };
DEV XcdBarrier xcd_barrier_post(unsigned* bar, volatile LDSP unsigned* st) {
  XcdBarrier b; b.bar = bar; b.x = xb_xcc_id(); b.st = st;
  if (threadIdx.x == 0) (void)xb_add(&bar[XB_XCNT(b.x)], 1u);
  return b;
}
DEV void xcd_barrier_complete(unsigned* bar, unsigned x, unsigned& nloc, unsigned& nx) {
  const unsigned G = gridDim.x * gridDim.y * gridDim.z;
  unsigned sum, cnt, mine, sp = 0u;
  for (;;) {
    sum = 0u; cnt = 0u; mine = 0u;
#pragma unroll
    for (unsigned j = 0; j < 16; ++j) { const unsigned c = xb_ld(&bar[XB_XCNT(j)]); sum += c; cnt += (c > 0u) ? 1u : 0u; mine = (j == x) ? c : mine; }
    if (sum == G) break;
    __builtin_amdgcn_s_sleep(1);
    if ((++sp & 255u) == 0u) { if (xb_ld(&bar[XB_TMO])) break; if (sp > XB_SPIN_CAP) { atomicAdd(&bar[XB_TMO], 1u); break; } }
  }
  nloc = mine > 0u ? mine : 1u; nx = cnt > 0u ? cnt : 1u;
}
DEV void xcd_barrier(const XcdBarrier& b) {
  asm volatile("s_waitcnt vmcnt(0)" ::: "memory");
  __syncthreads();
  if (threadIdx.x == 0) {
    unsigned* bar = b.bar;
    __builtin_amdgcn_s_waitcnt(0);
    unsigned nloc = b.st[0], nx = b.st[1];
    if (nloc == 0u) { xcd_barrier_complete(bar, b.x, nloc, nx); b.st[0] = nloc; b.st[1] = nx; }
    const unsigned old = xb_add(&bar[XB_XSUB(b.x)], 1u);
    const unsigned gen = old / nloc;
    if (old + 1u == (gen + 1u) * nloc) {
      __builtin_amdgcn_fence(__ATOMIC_RELEASE, "agent");
      asm volatile("s_waitcnt vmcnt(0)" ::: "memory");
      const unsigned og = xb_add(&bar[XB_TOP], 1u);
      const unsigned tg = og / nx;
      if (og + 1u == (tg + 1u) * nx) xb_add(&bar[XB_TOPGEN], 1u);
      else XB_SPIN(xb_ld(&bar[XB_TOPGEN]) == tg, bar);
      __builtin_amdgcn_fence(__ATOMIC_ACQUIRE, "agent");
      xb_add(&bar[XB_XGEN(b.x)], 1u);
      asm volatile("s_waitcnt vmcnt(0)" ::: "memory");
    } else {
      XB_SPIN(xb_ld(&bar[XB_XGEN(b.x)]) == gen, bar);
      __builtin_amdgcn_fence(__ATOMIC_ACQUIRE, "agent");
      asm volatile("s_waitcnt vmcnt(0)" ::: "memory");
    }
  }
  __syncthreads();
}

constexpr int N_PHASES = 19;

__global__ void __launch_bounds__(512) fwd_kernel(Params p, int ph0, int ph1) {
  __shared__ __attribute__((aligned(16))) char smem[SMEM_BYTES];
  __shared__ uint4 xb_words;
  if (threadIdx.x == 0) xb_words = make_uint4(0u, 0u, 0u, 0u);
  __syncthreads();
  XcdBarrier xb = xcd_barrier_post((unsigned*)(p.ws + OFF_BAR), (volatile LDSP unsigned*)&xb_words);
  if (ph1 < 0) cg::this_grid().sync();
  for (int ph = ph0; ph < ph1; ++ph) {
    char* tsm = smem + (get_tid8() >> 8) * SMEM_TEAM;
    const int b = ph >= 10 ? 1 : 0;
    const int lp = (ph == 0) ? 0 : (ph == 18 ? 9 : (ph >= 10 ? ph - 9 : ph));
    switch (lp) {
      case 0: phase_prep(p, 0, true, tsm); break;
      case 1: phase_inproj8(p, b, smem); break;
      case 2: {
        int it = get_bid();
        for (; it < 1024; it += nworkers()) ret_kv_item(p, it, tsm);
        for (; it < 2048; it += nworkers()) ssd_state_item(p, it - 1024, tsm);
      } break;
      case 3: phase_scan(p); break;
      case 4: {
        {
          const int rb0 = get_rbid(), rb = (rb0 & 7) * 32 + (rb0 >> 3), team = get_tid8() >> 8;
          for (int j = 0; j < 3; ++j) {
            int kind = -1, idx = 0;
            if (j == 0) {
              if (rb >= 2) { const int k = rb - 2; kind = 0; idx = (1 + (k >> 1)) * 4 + (k & 1) * 2 + team; }
            } else if (j == 1) {
              kind = 1; idx = rb * 2 + team;
            } else {
              if (rb < 2) { kind = 1; idx = (256 + rb) * 2 + team; }
              else if (rb < 6) { const int k = rb - 2; kind = 0; idx = ((k >> 1) ? 0 : 128) * 4 + (k & 1) * 2 + team; }
            }
            if (kind == 0) ret_out_item(p, idx, tsm);
            else if (kind == 1) ssd_out_item(p, idx, tsm);
          }
        }
      } break;
      case 5: phase_merge8(p, smem, tsm); break;
      case 6: phase_outproj8(p, b, smem); break;
      case 7: phase_up8(p, smem); break;
      case 8: phase_down8(p, b, smem); break;
      case 9: {
        if (ph == 9) { phase_final_norm(p, 0); phase_prep(p, 1, false, tsm); }
        else phase_final_norm(p, 1);
      } break;
    }
    if (ph + 1 < ph1) xcd_barrier(xb);
  }
}

#ifndef MK_SINGLE
#define MK_SINGLE 1
#endif

extern "C" void kernel_launch(void* const* d_in, const int* in_sizes, int n_in, void* d_out, int out_size, void* d_ws, size_t ws_size,
                              hipStream_t stream) {
  static int grid_blocks = 0;
  if (!grid_blocks) {
    int dev = 0, cus = 0, per_cu = 0;
    hipGetDevice(&dev);
    hipDeviceGetAttribute(&cus, hipDeviceAttributeMultiprocessorCount, dev);
    hipOccupancyMaxActiveBlocksPerMultiprocessor(&per_cu, fwd_kernel, 512, 0);
    per_cu = 1;
    if (cus != 256) fprintf(stderr, "kernel_launch: built for a 256-CU device (static phase schedules assume 256 workgroups), found %d CUs\n", cus);
    cus = 256;
    grid_blocks = cus * per_cu;
  }
  Params p{};
  for (int i = 0; i < 19; ++i) p.in[i] = (const float*)d_in[i];
  p.out = (float*)d_out;
  p.ws = (char*)d_ws;
#if MK_SINGLE
  (void)hipMemsetAsync((char*)d_ws + OFF_BAR, 0, XCD_BAR_WORDS * 4, stream);
  int ph0 = 0, ph1 = N_PHASES;
  void* args[] = {&p, &ph0, &ph1};
  hipError_t e = hipLaunchCooperativeKernel((void*)fwd_kernel, dim3(grid_blocks), dim3(512), args, 0, stream);
  if (e != hipSuccess) fprintf(stderr, "cooperative launch failed: %s (grid %d)\n", hipGetErrorString(e), grid_blocks);
#else
  for (int ph = 0; ph < N_PHASES; ++ph) {
    hipLaunchKernelGGL(fwd_kernel, dim3(grid_blocks), dim3(512), 0, stream, p, ph, ph + 1);
  }
#endif
}
```

```cpp
#include <hip/hip_runtime.h>
#include <hip/hip_cooperative_groups.h>
#include <cstdio>
namespace cg = cooperative_groups;

typedef unsigned short u16;
typedef __bf16 bf16x8 __attribute__((ext_vector_type(8)));
typedef short s16x4 __attribute__((ext_vector_type(4)));
typedef short s16x8 __attribute__((ext_vector_type(8)));
typedef float f32x16 __attribute__((ext_vector_type(16)));
typedef unsigned int u32x4 __attribute__((ext_vector_type(4)));
typedef unsigned int u32x2 __attribute__((ext_vector_type(2)));
typedef float f32x4 __attribute__((ext_vector_type(4)));

#define DEV __device__ __forceinline__
#define LDSP __attribute__((address_space(3)))

constexpr int D = 1024;
constexpr int L = 8208;
constexpr int SEQ = 8192;
constexpr int NMETA = 16;
constexpr int NPROJ = 13344;
constexpr int NPROJ_PAD = 13568;
constexpr int DFF = 2816;
constexpr float EPS = 1e-6f;

constexpr size_t OFF_Z = 0;
constexpr size_t OFF_G = 33619968;
constexpr size_t OFF_GS = 67239936;
constexpr size_t OFF_GR = 84049920;
constexpr size_t OFF_Q = 100859904;
constexpr size_t OFF_XBC = 117669888;
constexpr size_t OFF_K = 168099840;
constexpr size_t OFF_V = 184909824;
constexpr size_t OFF_DT = 218529792;
constexpr size_t OFF_S2 = 219580416;
constexpr size_t OFF_S1 = 227969024;
constexpr size_t OFF_CD = 261523456;
constexpr size_t OFF_HM = 261531648;
constexpr size_t OFF_BAR = 261597184;
constexpr size_t OFF_RSS = 261611520;
constexpr size_t OFF_WOUT = OFF_S1;
constexpr size_t OFF_WUP = OFF_S1 + 2097152;
constexpr size_t OFF_WDOWN = OFF_S1 + 13631488;
constexpr size_t OFF_UP = OFF_XBC;
constexpr size_t OFF_ACT = OFF_Z;
constexpr size_t OFF_U2 = OFF_Q;
constexpr size_t OUT_HALF = 33554432;

constexpr int SMEM_TEAM = 73728;
constexpr int SMEM_BYTES = 2 * SMEM_TEAM;

struct Params {
  const float* in[19];
  float* out;
  char* ws;
};

DEV int get_tid8() { int t = threadIdx.x; asm volatile("" : "+v"(t)); return t; }
DEV int get_tid() { int t = threadIdx.x & 255; asm volatile("" : "+v"(t)); return t; }
DEV int get_rbid() { int t = blockIdx.x; asm volatile("" : "+s"(t)); return t; }
DEV int get_bid() { int t = get_rbid() * 2 + (get_tid8() >> 8); return __builtin_amdgcn_readfirstlane(t); }
DEV int nworkers() { return (int)gridDim.x * 2; }
DEV float bf2f(u16 h) { return __uint_as_float(((unsigned)h) << 16); }
typedef __bf16 bf16x2_t __attribute__((ext_vector_type(2)));
typedef float f32x2_t __attribute__((ext_vector_type(2)));
DEV u16 f2bf(float f) { const __bf16 h = (__bf16)f; return __builtin_bit_cast(u16, h); }
DEV unsigned pack2(float a, float b) { const f32x2_t v = {a, b}; return __builtin_bit_cast(unsigned, __builtin_convertvector(v, bf16x2_t)); }
DEV float silu_f(float x) { return x * __builtin_amdgcn_rcpf(1.f + __expf(-x)); }
DEV float sigmoid_f(float x) { return __builtin_amdgcn_rcpf(1.f + __expf(-x)); }
DEV float lo_f(unsigned u) { return __uint_as_float(u << 16); }
DEV float hi_f(unsigned u) { return __uint_as_float(u & 0xffff0000u); }
DEV float wave_sum(float v) {
#pragma unroll
  for (int o = 32; o > 0; o >>= 1) v += __shfl_xor(v, o);
  return v;
}
DEV float half_sum(float v) {
#pragma unroll
  for (int o = 16; o > 0; o >>= 1) v += __shfl_xor(v, o);
  return v;
}
DEV float log_gamma(int h) {
  return h == 0 ? -0.0317486983145803f : (h == 1 ? -0.015748356968139168f : (h == 2 ? -0.007843177461025893f : -0.003913899321136329f));
}
DEV f32x16 mfma(bf16x8 a, bf16x8 b, f32x16 c) { return __builtin_amdgcn_mfma_f32_32x32x16_bf16(a, b, c, 0, 0, 0); }
DEV f32x16 zero16() { f32x16 z;
#pragma unroll
  for (int i = 0; i < 16; ++i) z[i] = 0.f;
  return z; }
DEV int acc_row(int i, int h) { return (i & 3) + 8 * (i >> 2) + 4 * h; }

DEV bf16x8 frag_tr(const u16* T, int ld, int k0, int x0, int lane) {
  const int h = lane >> 5, blk = (lane >> 4) & 1, q = (lane & 15) >> 2, pp = lane & 3;
  const u16* a0 = T + (k0 + 8 * h + q) * ld + x0 + 16 * blk + 4 * pp;
  s16x4 lo = __builtin_amdgcn_ds_read_tr16_b64_v4i16((LDSP s16x4*)a0);
  s16x4 hi = __builtin_amdgcn_ds_read_tr16_b64_v4i16((LDSP s16x4*)(a0 + 4 * ld));
  s16x8 v = {lo[0], lo[1], lo[2], lo[3], hi[0], hi[1], hi[2], hi[3]};
  return __builtin_bit_cast(bf16x8, v);
}
DEV bf16x8 frag_row(const u16* T, int ld, int row, int k) {
  return *(const bf16x8*)(T + row * ld + k);
}

template <int MI>
DEV void gemm_tile(f32x16 (&acc)[MI][2], const u16* __restrict__ A, int lda, int arow0, int arow_max,
                   const u16* __restrict__ B, int ldb, int brow0, int K, char* smem) {
  constexpr int BM = MI * 64;
  constexpr int LD = 72;
  constexpr int ACH = BM * 8 / 256;
  u16* As = (u16*)smem;
  u16* Bs = As + BM * LD;
  const int tid = get_tid(), lane = tid & 63, w = tid >> 6, wm = w >> 1, wn = w & 1, r = lane & 31, h = lane >> 5;
  u32x4 ra[ACH], rb[4];
  const u16* ap[ACH];
  const u16* bp[4];
#pragma unroll
  for (int i = 0; i < ACH; ++i) {
    int c = tid + i * 256, row = c >> 3, kc = c & 7;
    int gr = arow0 + row; gr = gr > arow_max ? arow_max : gr;
    ap[i] = A + (size_t)gr * lda + kc * 8;
  }
#pragma unroll
  for (int i = 0; i < 4; ++i) {
    int c = tid + i * 256, row = c >> 3, kc = c & 7;
    bp[i] = B + (size_t)(brow0 + row) * ldb + kc * 8;
  }
#pragma unroll
  for (int i = 0; i < ACH; ++i) ra[i] = *(const u32x4*)(ap[i]);
#pragma unroll
  for (int i = 0; i < 4; ++i) rb[i] = *(const u32x4*)(bp[i]);
  const int nk = K >> 6;
  for (int kt = 0; kt < nk; ++kt) {
#pragma unroll
    for (int i = 0; i < ACH; ++i) { int c = tid + i * 256, row = c >> 3, kc = c & 7; *(u32x4*)(As + row * LD + kc * 8) = ra[i]; }
#pragma unroll
    for (int i = 0; i < 4; ++i) { int c = tid + i * 256, row = c >> 3, kc = c & 7; *(u32x4*)(Bs + row * LD + kc * 8) = rb[i]; }
    __syncthreads();
    if (kt + 1 < nk) {
#pragma unroll
      for (int i = 0; i < ACH; ++i) ra[i] = *(const u32x4*)(ap[i] + (kt + 1) * 64);
#pragma unroll
      for (int i = 0; i < 4; ++i) rb[i] = *(const u32x4*)(bp[i] + (kt + 1) * 64);
    }
#pragma unroll
    for (int ks = 0; ks < 4; ++ks) {
      bf16x8 a[MI], b[2];
#pragma unroll
      for (int mi = 0; mi < MI; ++mi) a[mi] = frag_row(As, LD, wm * MI * 32 + mi * 32 + r, ks * 16 + h * 8);
#pragma unroll
      for (int ni = 0; ni < 2; ++ni) b[ni] = frag_row(Bs, LD, wn * 64 + ni * 32 + r, ks * 16 + h * 8);
#pragma unroll
      for (int mi = 0; mi < MI; ++mi)
#pragma unroll
        for (int ni = 0; ni < 2; ++ni) acc[mi][ni] = mfma(a[mi], b[ni], acc[mi][ni]);
    }
    __syncthreads();
  }
}

DEV int orig_col(int n) {
  if (n < 5120) return n;
  if (n < 7168) {
    int q = n - 5120; int which = q >> 10; int c = q & 1023; int head = c >> 8; int ip = c & 255; int blk = ip >> 6; int wi = ip & 63;
    int j = (wi < 32) ? (blk * 32 + wi) : (128 + blk * 32 + wi - 32);
    return 5152 + which * 1024 + head * 256 + j;
  }
  if (n < 13312) return n + 32;
  if (n < 13344) return 5120 + (n - 13312);
  return -1;
}
DEV void convert_tile(const float* __restrict__ W, int Nsrc, int K, u16* __restrict__ WT, int kt, int ntile, int mode, char* smem, const float* __restrict__ kscale = nullptr) {
  float* t = (float*)smem;
  const int tid = get_tid();
  {
    const int tx = tid & 15, ty = tid >> 4;
    const int n = ntile * 64 + tx * 4;
    int on = n;
    if (mode == 1) on = orig_col(n);
    else if (mode == 2) { const int tl = n >> 8, wi = n & 255; on = (wi < 128) ? (tl * 128 + wi) : (2816 + tl * 128 + wi - 128); }
#pragma unroll
    for (int kk = ty; kk < 64; kk += 16) {
      f32x4 v = {0.f, 0.f, 0.f, 0.f};
      if (on >= 0) v = *(const f32x4*)(W + (size_t)(kt * 64 + kk) * Nsrc + on);
      if (kscale) v = v * kscale[kt * 64 + kk];
      *(f32x4*)(t + kk * 68 + tx * 4) = v;
    }
  }
  __syncthreads();
  {
    const int nn = tid >> 2, kq = (tid & 3) * 16;
    u32x4 o[2];
#pragma unroll
    for (int j = 0; j < 8; ++j) o[j >> 2][j & 3] = pack2(t[(kq + 2 * j) * 68 + nn], t[(kq + 2 * j + 1) * 68 + nn]);
    u16* d = WT + (size_t)(ntile * 64 + nn) * K + kt * 64 + kq;
    *(u32x4*)d = o[0]; *(u32x4*)(d + 8) = o[1];
  }
  __syncthreads();
}

DEV void rmsnorm_row_bf16(const float* __restrict__ src, const float* __restrict__ w, u16* __restrict__ dst, int lane) {
  f32x4 v[4]; float ss = 0.f;
#pragma unroll
  for (int j = 0; j < 4; ++j) { v[j] = *(const f32x4*)(src + j * 256 + lane * 4); ss += v[j][0] * v[j][0] + v[j][1] * v[j][1] + v[j][2] * v[j][2] + v[j][3] * v[j][3]; }
  ss = wave_sum(ss);
  const float rstd = rsqrtf(ss * (1.f / 1024.f) + EPS);
#pragma unroll
  for (int j = 0; j < 4; ++j) {
    f32x4 ww = *(const f32x4*)(w + j * 256 + lane * 4);
    u32x2 o; o[0] = pack2(v[j][0] * rstd * ww[0], v[j][1] * rstd * ww[1]); o[1] = pack2(v[j][2] * rstd * ww[2], v[j][3] * rstd * ww[3]);
    *(u32x2*)(dst + j * 256 + lane * 4) = o;
  }
}
DEV void rmsnorm_row_f32_inplace(float* __restrict__ row, const float* __restrict__ w, int lane) {
  f32x4 v[4]; float ss = 0.f;
#pragma unroll
  for (int j = 0; j < 4; ++j) { v[j] = *(const f32x4*)(row + j * 256 + lane * 4); ss += v[j][0] * v[j][0] + v[j][1] * v[j][1] + v[j][2] * v[j][2] + v[j][3] * v[j][3]; }
  ss = wave_sum(ss);
  const float rstd = rsqrtf(ss * (1.f / 1024.f) + EPS);
#pragma unroll
  for (int j = 0; j < 4; ++j) {
    f32x4 ww = *(const f32x4*)(w + j * 256 + lane * 4);
    f32x4 o; o[0] = v[j][0] * rstd * ww[0]; o[1] = v[j][1] * rstd * ww[1]; o[2] = v[j][2] * rstd * ww[2]; o[3] = v[j][3] * rstd * ww[3];
    *(f32x4*)(row + j * 256 + lane * 4) = o;
  }
}

template <int R, int C, bool SCALE>
DEV void stage_conv(u16* dst, int ld, const u16* __restrict__ xbc, int row0, int ch0, const float* __restrict__ cw, const float* __restrict__ cb, const float* rs) {
  constexpr int CG = C / 8, RG = 256 / CG, RPT = R / RG;
  const int tid = get_tid();
  const int cgi = tid % CG, rgi = tid / CG;
  const int ch = ch0 + cgi * 8, r0 = rgi * RPT;
  float w[4][8], bias[8], xw[3][8];
#pragma unroll
  for (int k = 0; k < 4; ++k) {
    f32x4 a = *(const f32x4*)(cw + k * 3072 + ch), b = *(const f32x4*)(cw + k * 3072 + ch + 4);
#pragma unroll
    for (int j = 0; j < 4; ++j) { w[k][j] = a[j]; w[k][4 + j] = b[j]; }
  }
  {
    f32x4 a = *(const f32x4*)(cb + ch), b = *(const f32x4*)(cb + ch + 4);
#pragma unroll
    for (int j = 0; j < 4; ++j) { bias[j] = a[j]; bias[4 + j] = b[j]; }
  }
#pragma unroll
  for (int k = 0; k < 3; ++k) {
    const int tr = row0 + r0 - 3 + k;
    u32x4 v = {0u, 0u, 0u, 0u};
    if (tr >= 0 && tr < L) v = *(const u32x4*)(xbc + (size_t)tr * 3072 + ch);
#pragma unroll
    for (int j = 0; j < 4; ++j) { xw[k][2 * j] = lo_f(v[j]); xw[k][2 * j + 1] = hi_f(v[j]); }
  }
#pragma unroll
  for (int i = 0; i < RPT; ++i) {
    const int tr = row0 + r0 + i;
    const bool valid = tr < L;
    u32x4 v = {0u, 0u, 0u, 0u};
    if (valid) v = *(const u32x4*)(xbc + (size_t)tr * 3072 + ch);
    if (!valid) { const u32x4 z4 = {0u, 0u, 0u, 0u}; *(u32x4*)(dst + (r0 + i) * ld + cgi * 8) = z4; continue; }
    float xc[8], o[8];
#pragma unroll
    for (int j = 0; j < 4; ++j) { xc[2 * j] = lo_f(v[j]); xc[2 * j + 1] = hi_f(v[j]); }
    float sc = 1.f;
    if (SCALE) sc = rs[(cgi >> 3) * 128 + r0 + i];
#pragma unroll
    for (int j = 0; j < 8; ++j) {
      float a = bias[j] + w[0][j] * xw[0][j] + w[1][j] * xw[1][j] + w[2][j] * xw[2][j] + w[3][j] * xc[j];
      a = silu_f(a) * sc;
      o[j] = valid ? a : 0.f;
      xw[0][j] = xw[1][j]; xw[1][j] = xw[2][j]; xw[2][j] = xc[j];
    }
    u32x4 pk; pk[0] = pack2(o[0], o[1]); pk[1] = pack2(o[2], o[3]); pk[2] = pack2(o[4], o[5]); pk[3] = pack2(o[6], o[7]);
    *(u32x4*)(dst + (r0 + i) * ld + cgi * 8) = pk;
  }
}

DEV float chunk_cumsum(const float* __restrict__ DT, int c, int H, float A, float* acs, float* dts, int lane) {
  const int s0 = 2 * lane;
  const int t0 = c * 128 + s0;
  const float d0 = (t0 < L) ? DT[(size_t)t0 * 32 + H] : 0.f;
  const float d1 = (t0 + 1 < L) ? DT[(size_t)(t0 + 1) * 32 + H] : 0.f;
  const float a0 = d0 * A, a1 = a0 + d1 * A;
  float tot = a1;
#pragma unroll
  for (int o = 1; o < 64; o <<= 1) { float n = __shfl_up(tot, o); if (lane >= o) tot += n; }
  const float excl = tot - a1;
  acs[s0] = excl + a0; acs[s0 + 1] = excl + a1;
  dts[s0] = d0; dts[s0 + 1] = d1;
  return __shfl(tot, 63);
}

DEV void phase_prep(const Params& p, int b, bool first, char* smem) {
  const int tid = get_tid(), lane = tid & 63, w = tid >> 6;
  u16* U = (u16*)((char*)p.out + OUT_HALF);
  const int n_norm = L / 4;
  const int n_win = 16 * (NPROJ_PAD / 64);
  const int n_wb = first ? 2 * 32 * 16 : 0;
  const int total = n_norm + n_win + n_wb;
  for (int it = get_bid(); it < total; it += nworkers()) {
    if (it < n_norm) {
      const int t = it * 4 + w;
      const float* src = (t < NMETA) ? (p.in[1] + (size_t)t * D) : (p.in[0] + ((size_t)b * SEQ + (t - NMETA)) * D);
      rmsnorm_row_bf16(src, p.in[2], U + (size_t)t * D, lane);
    } else if (it < n_norm + n_win) {
      const int j = it - n_norm; const int ntile = j >> 4, kt = j & 15;
      convert_tile(p.in[3], NPROJ, 1024, (u16*)(p.ws + OFF_S1), kt, ntile, 1, smem);
    } else {
      int j = it - n_norm - n_win; const int which = j >> 9; j &= 511; const int ntile = j >> 5, kt = j & 31;
      convert_tile(p.in[10 + which], 1024, 2048, (u16*)(p.ws + OFF_S2 + (size_t)which * 4194304), kt, ntile, 0, smem);
    }
  }
}

DEV void phase_inproj(const Params& p, int b, char* smem) {
  const int tid = get_tid(), lane = tid & 63, w = tid >> 6, wm = w >> 1, wn = w & 1, r = lane & 31, h = lane >> 5;
  const u16* U = (const u16*)((char*)p.out + OUT_HALF);
  const u16* WT = (const u16*)(p.ws + OFF_S1);
  const int MT = 65, NT = 105;
  for (int it = get_bid(); it < MT * NT; it += gridDim.x) {
    const int nt = it / MT, mt = it % MT;
    f32x16 acc[2][2];
#pragma unroll
    for (int mi = 0; mi < 2; ++mi)
#pragma unroll
      for (int ni = 0; ni < 2; ++ni) acc[mi][ni] = zero16();
    gemm_tile<2>(acc, U, 1024, mt * 128, L - 1, WT, 1024, nt * 128, 1024, smem);
    const int n0 = nt * 128;
    if (nt >= 40 && nt < 56) {
      const bool isk = nt >= 48;
      const int cq = n0 - (isk ? 6144 : 5120);
      const int blk = ((cq & 255) >> 6) + wn;
      const int jf = blk * 32 + r;
      const double invf_rev = exp(-(double)jf * 0.07252236513367073) * 0.15915494309189535;
      const float sc = isk ? 0.0625f : 1.f;
      u16* dst = (u16*)(p.ws + (isk ? OFF_K : OFF_Q));
#pragma unroll
      for (int mi = 0; mi < 2; ++mi)
#pragma unroll
        for (int i = 0; i < 16; ++i) {
          const int t = mt * 128 + wm * 64 + mi * 32 + acc_row(i, h);
          if (t < L) {
            double rev = (double)t * invf_rev;
            rev -= floor(rev);
            const float fr = (float)rev;
            const float sn = __builtin_amdgcn_sinf(fr), cs = __builtin_amdgcn_cosf(fr);
            const float x1 = acc[mi][0][i], x2 = acc[mi][1][i];
            const float o1 = (x1 * cs - x2 * sn) * sc, o2 = (x2 * cs + x1 * sn) * sc;
            u16* d = dst + (size_t)t * 1024 + cq + wn * 64 + r;
            d[0] = f2bf(o1); d[32] = f2bf(o2);
          }
        }
    } else if (nt == 104) {
      float* DT = (float*)(p.ws + OFF_DT);
      if (wn == 0) {
        const float bias = p.in[6][r];
#pragma unroll
        for (int mi = 0; mi < 2; ++mi)
#pragma unroll
          for (int i = 0; i < 16; ++i) {
            const int t = mt * 128 + wm * 64 + mi * 32 + acc_row(i, h);
            if (t < L) {
              const float x = acc[mi][0][i] + bias;
              const float e = __expf(x);
              DT[(size_t)t * 32 + r] = (x > 20.f) ? x : (e < 0.01f ? e * (1.f - 0.5f * e + e * e * (1.f / 3.f)) : __logf(1.f + e));
            }
          }
      }
    } else {
      u16* dst; int ld, c0; bool sig = false;
      if (nt < 16) { dst = (u16*)(p.ws + OFF_Z); ld = 2048; c0 = n0; }
      else if (nt < 40) { dst = (u16*)(p.ws + OFF_XBC); ld = 3072; c0 = n0 - 2048; }
      else if (nt < 72) { dst = (u16*)(p.ws + OFF_V); ld = 2048; c0 = n0 - 7168; }
      else if (nt < 88) { dst = (u16*)(p.ws + OFF_G); ld = 2048; c0 = n0 - 9216; }
      else if (nt < 96) { dst = (u16*)(p.ws + OFF_GS); ld = 1024; c0 = n0 - 11264; sig = true; }
      else { dst = (u16*)(p.ws + OFF_GR); ld = 1024; c0 = n0 - 12288; sig = true; }
#pragma unroll
      for (int mi = 0; mi < 2; ++mi)
#pragma unroll
        for (int ni = 0; ni < 2; ++ni)
#pragma unroll
          for (int i = 0; i < 16; ++i) {
            const int t = mt * 128 + wm * 64 + mi * 32 + acc_row(i, h);
            if (t < L) {
              float v = acc[mi][ni][i];
              if (sig) v = sigmoid_f(v);
              dst[(size_t)t * ld + c0 + wn * 64 + ni * 32 + r] = f2bf(v);
            }
          }
    }
  }
}

DEV void ssd_state_item(const Params& p, int it, char* smem) {
  const int tid = get_tid(), lane = tid & 63, w = tid >> 6, wm = w >> 1, wn = w & 1, r = lane & 31, h = lane >> 5;
  const int c = it >> 4, hp = it & 15, H0 = hp * 2, g = H0 >> 3;
  u16* Xw = (u16*)smem;
  u16* Bc = Xw + 128 * 136;
  float* wsc = (float*)(Bc + 128 * 136);
  float* tmp = wsc + 256;
  const float* DT = (const float*)(p.ws + OFF_DT);
  float* CD = (float*)(p.ws + OFF_CD);
  const u16* XBC = (const u16*)(p.ws + OFF_XBC);
  if (w < 2) {
    const int H = H0 + w;
    const float A = -expf(p.in[7][H]);
    float* acs = tmp + w * 128;
    float* dts = wsc + w * 128;
    const float aend = chunk_cumsum(DT, c, H, A, acs, dts, lane);
    const int s0 = 2 * lane;
    const float w0 = __expf(aend - acs[s0]) * dts[s0], w1 = __expf(aend - acs[s0 + 1]) * dts[s0 + 1];
    dts[s0] = w0; dts[s0 + 1] = w1;
    if (lane == 0) CD[c * 32 + H] = __expf(aend);
  }
  __syncthreads();
  stage_conv<128, 128, true>(Xw, 136, XBC, c * 128, H0 * 64, p.in[4], p.in[5], wsc);
  stage_conv<128, 128, false>(Bc, 136, XBC, c * 128, 2048 + g * 128, p.in[4], p.in[5], nullptr);
  __syncthreads();
  f32x16 acc[2][2];
#pragma unroll
  for (int mi = 0; mi < 2; ++mi)
#pragma unroll
    for (int ni = 0; ni < 2; ++ni) acc[mi][ni] = zero16();
#pragma unroll
  for (int ks = 0; ks < 8; ++ks) {
    bf16x8 a[2], bq[2];
#pragma unroll
    for (int mi = 0; mi < 2; ++mi) a[mi] = frag_tr(Xw, 136, ks * 16, wm * 64 + mi * 32, lane);
#pragma unroll
    for (int ni = 0; ni < 2; ++ni) bq[ni] = frag_tr(Bc, 136, ks * 16, wn * 64 + ni * 32, lane);
#pragma unroll
    for (int mi = 0; mi < 2; ++mi)
#pragma unroll
      for (int ni = 0; ni < 2; ++ni) acc[mi][ni] = mfma(a[mi], bq[ni], acc[mi][ni]);
  }
  u16* ST = (u16*)(p.ws + OFF_S1) + (size_t)(c * 32 + H0) * 8192;
  __syncthreads();
#pragma unroll
  for (int mi = 0; mi < 2; ++mi)
#pragma unroll
    for (int ni = 0; ni < 2; ++ni)
#pragma unroll
      for (int i = 0; i < 16; ++i) Xw[(wm * 64 + mi * 32 + acc_row(i, h)) * 136 + wn * 64 + ni * 32 + r] = f2bf(acc[mi][ni][i]);
  asm volatile("s_waitcnt lgkmcnt(0)" ::: "memory");
#pragma unroll
  for (int j = 0; j < 8; ++j) {
    const int m = wm * 64 + (lane >> 3) + 8 * j, n = wn * 64 + (lane & 7) * 8;
    *(u32x4*)(ST + m * 128 + n) = *(const u32x4*)(Xw + m * 136 + n);
  }
  __syncthreads();
}

DEV void ret_kv_item(const Params& p, int it, char* smem) {
  const int tid = get_tid(), lane = tid & 63, w = tid >> 6, wm = w >> 1, wn = w & 1, r = lane & 31, h = lane >> 5;
  const int sc = it >> 5, rem = it & 31, hd = rem >> 3, dt2 = (rem >> 2) & 1, et = rem & 3;
  u16* Vt = (u16*)smem;
  u16* Kt = Vt + 128 * 136;
  const u16* Vg = (const u16*)(p.ws + OFF_V);
  const u16* Kg = (const u16*)(p.ws + OFF_K);
  const float lg = log_gamma(hd);
  f32x16 acc[2][2];
#pragma unroll
  for (int mi = 0; mi < 2; ++mi)
#pragma unroll
    for (int ni = 0; ni < 2; ++ni) acc[mi][ni] = zero16();
  u32x4 vr[8], kr[8];
#pragma unroll
  for (int i = 0; i < 8; ++i) {
    const int cidx = tid + i * 256, row = cidx >> 4, cc = cidx & 15;
    const int tok = sc * 256 + row;
    vr[i] = *(const u32x4*)(Vg + (size_t)tok * 2048 + hd * 512 + et * 128 + cc * 8);
    kr[i] = *(const u32x4*)(Kg + (size_t)tok * 1024 + hd * 256 + dt2 * 128 + cc * 8);
  }
  for (int half = 0; half < 2; ++half) {
#pragma unroll
    for (int i = 0; i < 8; ++i) {
      const int cidx = tid + i * 256, row = cidx >> 4, cc = cidx & 15;
      *(u32x4*)(Vt + row * 136 + cc * 8) = vr[i];
      const u32x4 kk = kr[i];
      const float dec = __expf((float)(255 - (half * 128 + row)) * lg);
      u32x4 ko;
#pragma unroll
      for (int j = 0; j < 4; ++j) ko[j] = pack2(lo_f(kk[j]) * dec, hi_f(kk[j]) * dec);
      *(u32x4*)(Kt + row * 136 + cc * 8) = ko;
    }
    __syncthreads();
    if (half == 0) {
#pragma unroll
      for (int i = 0; i < 8; ++i) {
        const int cidx = tid + i * 256, row = cidx >> 4, cc = cidx & 15;
        const int tok = sc * 256 + 128 + row;
        vr[i] = *(const u32x4*)(Vg + (size_t)tok * 2048 + hd * 512 + et * 128 + cc * 8);
        kr[i] = *(const u32x4*)(Kg + (size_t)tok * 1024 + hd * 256 + dt2 * 128 + cc * 8);
      }
    }
#pragma unroll
    for (int ks = 0; ks < 8; ++ks) {
      bf16x8 a[2], bq[2];
#pragma unroll
      for (int mi = 0; mi < 2; ++mi) a[mi] = frag_tr(Vt, 136, ks * 16, wm * 64 + mi * 32, lane);
#pragma unroll
      for (int ni = 0; ni < 2; ++ni) bq[ni] = frag_tr(Kt, 136, ks * 16, wn * 64 + ni * 32, lane);
#pragma unroll
      for (int mi = 0; mi < 2; ++mi)
#pragma unroll
        for (int ni = 0; ni < 2; ++ni) acc[mi][ni] = mfma(a[mi], bq[ni], acc[mi][ni]);
    }
    __syncthreads();
  }
  u16* RST = (u16*)((char*)p.out + OUT_HALF) + ((size_t)(sc * 4 + hd) * 512 + et * 128) * 256 + dt2 * 128;
#pragma unroll
  for (int mi = 0; mi < 2; ++mi)
#pragma unroll
    for (int ni = 0; ni < 2; ++ni)
#pragma unroll
      for (int i = 0; i < 16; ++i) Vt[(wm * 64 + mi * 32 + acc_row(i, h)) * 136 + wn * 64 + ni * 32 + r] = f2bf(acc[mi][ni][i]);
  asm volatile("s_waitcnt lgkmcnt(0)" ::: "memory");
#pragma unroll
  for (int j = 0; j < 8; ++j) {
    const int e = wm * 64 + (lane >> 3) + 8 * j, d = wn * 64 + (lane & 7) * 8;
    *(u32x4*)(RST + (size_t)e * 256 + d) = *(const u32x4*)(Vt + e * 136 + d);
  }
  __syncthreads();
}

DEV void phase_scan(const Params& p) {
  const int gt = get_bid() * 256 + get_tid(), nth = nworkers() * 256;
  const float* CD = (const float*)(p.ws + OFF_CD);
  for (int v = gt; v < 32768 + 65536; v += nth) {
    float st[8];
#pragma unroll
    for (int j = 0; j < 8; ++j) st[j] = 0.f;
    if (v < 32768) {
      const int e0 = v * 8, H = e0 >> 13;
      u16* base = (u16*)(p.ws + OFF_S1) + e0;
      for (int c0 = 0; c0 < 64; c0 += 8) {
        u32x4 x[8];
#pragma unroll
        for (int u = 0; u < 8; ++u) x[u] = *(const u32x4*)(base + (size_t)(c0 + u) * 262144);
#pragma unroll
        for (int u = 0; u < 8; ++u) {
          const float dcy = CD[(c0 + u) * 32 + H];
          u32x4 o;
#pragma unroll
          for (int j = 0; j < 4; ++j) {
            st[2 * j] = st[2 * j] * dcy + lo_f(x[u][j]);
            st[2 * j + 1] = st[2 * j + 1] * dcy + hi_f(x[u][j]);
            o[j] = pack2(st[2 * j], st[2 * j + 1]);
          }
          *(u32x4*)(base + (size_t)(c0 + u) * 262144) = o;
        }
      }
    } else {
      const int e0 = (v - 32768) * 8, hd = e0 >> 17;
      const float g256 = __expf(256.f * log_gamma(hd));
      u16* base = (u16*)((char*)p.out + OUT_HALF) + e0;
      for (int c0 = 0; c0 < 32; c0 += 8) {
        u32x4 x[8];
#pragma unroll
        for (int u = 0; u < 8; ++u) x[u] = *(const u32x4*)(base + (size_t)(c0 + u) * 524288);
#pragma unroll
        for (int u = 0; u < 8; ++u) {
          u32x4 o;
#pragma unroll
          for (int j = 0; j < 4; ++j) {
            st[2 * j] = st[2 * j] * g256 + lo_f(x[u][j]);
            st[2 * j + 1] = st[2 * j + 1] * g256 + hi_f(x[u][j]);
            o[j] = pack2(st[2 * j], st[2 * j + 1]);
          }
          *(u32x4*)(base + (size_t)(c0 + u) * 524288) = o;
        }
      }
    }
  }
}

DEV void ssd_out_item(const Params& p, int it, char* smem) {
  const int tid = get_tid(), lane = tid & 63, w = tid >> 6, wm = w >> 1, wn = w & 1, r = lane & 31, h = lane >> 5;
  const int c = it >> 3, rem = it & 7, g = rem & 3, lh = rem >> 2;
  if (c == 64 && lh == 1) return;
  u16* Ct = (u16*)smem;
  u16* Bt = Ct + 64 * 136;
  u16* Lt = Bt;
  u16* Xt = Bt + 128 * 136;
  float* acs = (float*)(Xt + 128 * 72);
  float* dts = acs + 128;
  float* rowsq = dts + 128;
  const u16* XBC = (const u16*)(p.ws + OFF_XBC);
  const float* DT = (const float*)(p.ws + OFF_DT);
  u16* Z = (u16*)(p.ws + OFF_Z);
  const int tok0 = c * 128;
  const bool tailc = (L - tok0) < 128;
  stage_conv<64, 128, false>(Ct, 136, XBC, tok0 + lh * 64, 2560 + g * 128, p.in[4], p.in[5], nullptr);
  stage_conv<128, 128, false>(Bt, 136, XBC, tok0, 2048 + g * 128, p.in[4], p.in[5], nullptr);
  if (tid < 64) rowsq[tid] = 0.f;
  __syncthreads();
  f32x16 cb[2];
  cb[0] = zero16(); cb[1] = zero16();
#pragma unroll
  for (int ks = 0; ks < 8; ++ks) {
    bf16x8 a = frag_row(Ct, 136, wm * 32 + r, ks * 16 + h * 8);
#pragma unroll
    for (int ni = 0; ni < 2; ++ni) {
      bf16x8 bq = frag_row(Bt, 136, wn * 64 + ni * 32 + r, ks * 16 + h * 8);
      cb[ni] = mfma(a, bq, cb[ni]);
    }
  }
  for (int hh = 0; hh < 8; ++hh) {
    const int H = g * 8 + hh;
    u32x4 zv[2];
    {
      int tz = tok0 + lh * 64 + (tid >> 2); tz = tz < L ? tz : L - 1;
      const u16* zp0 = Z + (size_t)tz * 2048 + H * 64 + (tid & 3) * 16;
      zv[0] = *(const u32x4*)zp0; zv[1] = *(const u32x4*)(zp0 + 8);
    }
    if (w == 0) {
      const float A = -expf(p.in[7][H]) * 1.4426950408889634f;
      chunk_cumsum(DT, c, H, A, acs, dts, lane);
    }
    stage_conv<128, 64, false>(Xt, 72, XBC, tok0, H * 64, p.in[4], p.in[5], nullptr);
    __syncthreads();
#pragma unroll
    for (int ni = 0; ni < 2; ++ni) {
      if (tailc && (wn | ni)) continue;
#pragma unroll
      for (int i = 0; i < 16; ++i) {
        const int ll = wm * 32 + acc_row(i, h), l = lh * 64 + ll, s = wn * 64 + ni * 32 + r;
        float val = 0.f;
        if (s <= l) val = cb[ni][i] * __builtin_amdgcn_exp2f(acs[l] - acs[s]) * dts[s];
        Lt[ll * 136 + s] = f2bf(val);
      }
    }
    f32x16 y = zero16();
    if (c > 0) {
      const u16* pv = (const u16*)(p.ws + OFF_S1) + ((size_t)((c - 1) * 32 + H) * 64 + wn * 32 + r) * 128 + h * 8;
#pragma unroll
      for (int ks = 0; ks < 8; ++ks) {
        bf16x8 a = frag_row(Ct, 136, wm * 32 + r, ks * 16 + h * 8);
        bf16x8 bq = *(const bf16x8*)(pv + ks * 16);
        y = mfma(a, bq, y);
      }
#pragma unroll
      for (int i = 0; i < 16; ++i) { const int l = lh * 64 + wm * 32 + acc_row(i, h); y[i] *= __builtin_amdgcn_exp2f(acs[l]); }
    }
    __syncthreads();
#pragma unroll
    for (int ks = 0; ks < 8; ++ks) {
      if (tailc && ks >= 2) break;
      bf16x8 a = frag_row(Lt, 136, wm * 32 + r, ks * 16 + h * 8);
      bf16x8 bq = frag_tr(Xt, 72, ks * 16, wn * 32, lane);
      y = mfma(a, bq, y);
    }
    const float Dsk = p.in[8][H];
    float* Ys = (float*)(Bt + 64 * 136);
#pragma unroll
    for (int i = 0; i < 16; ++i) Ys[(wm * 32 + acc_row(i, h)) * 68 + wn * 32 + r] = y[i];
    u32x4 xv[2];
    {
      const int lx = lh * 64 + (tid >> 2);
      xv[0] = *(const u32x4*)(Xt + lx * 72 + (tid & 3) * 16); xv[1] = *(const u32x4*)(Xt + lx * 72 + (tid & 3) * 16 + 8);
    }
    __syncthreads();
    {
      const int row = tid >> 2, q = tid & 3, l = lh * 64 + row, t = tok0 + l;
      float sq = 0.f;
      if (t < L) {
        u16* zp = Z + (size_t)t * 2048 + H * 64 + q * 16;
        u32x4 ov[2];
#pragma unroll
        for (int k = 0; k < 2; ++k) {
          const f32x4 ya = *(const f32x4*)(Ys + row * 68 + q * 16 + k * 8), yb = *(const f32x4*)(Ys + row * 68 + q * 16 + k * 8 + 4);
          float o[8];
#pragma unroll
          for (int j = 0; j < 4; ++j) {
            const float y0 = (j < 2) ? ya[2 * j] : yb[2 * j - 4], y1 = (j < 2) ? ya[2 * j + 1] : yb[2 * j - 3];
            o[2 * j] = (y0 + Dsk * lo_f(xv[k][j])) * silu_f(lo_f(zv[k][j]));
            o[2 * j + 1] = (y1 + Dsk * hi_f(xv[k][j])) * silu_f(hi_f(zv[k][j]));
            sq += o[2 * j] * o[2 * j] + o[2 * j + 1] * o[2 * j + 1];
            ov[k][j] = pack2(o[2 * j], o[2 * j + 1]);
          }
        }
        *(u32x4*)zp = ov[0]; *(u32x4*)(zp + 8) = ov[1];
      }
      sq += __shfl_xor(sq, 1); sq += __shfl_xor(sq, 2);
      if (q == 0) rowsq[row] += sq;
    }
  }
  __syncthreads();
  {
    const int row = tid >> 2, q = tid & 3, t = tok0 + lh * 64 + row;
    if (t < L) {
      const float rn = rsqrtf(rowsq[row] * (1.f / 512.f) + EPS);
      u32x4 v[16];
#pragma unroll
      for (int hh = 0; hh < 8; ++hh) {
        const u16* zp = Z + (size_t)t * 2048 + (g * 8 + hh) * 64 + q * 16;
        v[2 * hh] = *(const u32x4*)zp; v[2 * hh + 1] = *(const u32x4*)(zp + 8);
      }
#pragma unroll
      for (int hh = 0; hh < 8; ++hh) {
        u16* zp = Z + (size_t)t * 2048 + (g * 8 + hh) * 64 + q * 16;
        const float* nwp = p.in[9] + (g * 8 + hh) * 64 + q * 16;
#pragma unroll
        for (int k = 0; k < 2; ++k) {
          const f32x4 wa = *(const f32x4*)(nwp + k * 8), wb = *(const f32x4*)(nwp + k * 8 + 4);
          u32x4 o;
          o[0] = pack2(lo_f(v[2 * hh + k][0]) * rn * wa[0], hi_f(v[2 * hh + k][0]) * rn * wa[1]);
          o[1] = pack2(lo_f(v[2 * hh + k][1]) * rn * wa[2], hi_f(v[2 * hh + k][1]) * rn * wa[3]);
          o[2] = pack2(lo_f(v[2 * hh + k][2]) * rn * wb[0], hi_f(v[2 * hh + k][2]) * rn * wb[1]);
          o[3] = pack2(lo_f(v[2 * hh + k][3]) * rn * wb[2], hi_f(v[2 * hh + k][3]) * rn * wb[3]);
          *(u32x4*)(zp + k * 8) = o;
        }
      }
    }
  }
  __syncthreads();
}

DEV void ret_out_item(const Params& p, int it, char* smem) {
  const int tid = get_tid(), lane = tid & 63, w = tid >> 6, wm = w >> 1, wn = w & 1, r = lane & 31, h = lane >> 5;
  const int rt = it >> 2, hd = it & 3;
  const int t0 = rt * 64, sc = rt >> 2, qtr = rt & 3;
  u16* P = (u16*)smem;
  char* gsm = smem + 33792;
  u16* Vt = (u16*)gsm;
  float* rowsq = (float*)(smem + 33792 + 27648);
  const u16* Qg = (const u16*)(p.ws + OFF_Q) + hd * 256;
  const u16* Kg = (const u16*)(p.ws + OFF_K) + hd * 256;
  const u16* Vg = (const u16*)(p.ws + OFF_V);
  u16* Gg = (u16*)(p.ws + OFF_G);
  const u16* RST = (const u16*)((char*)p.out + OUT_HALF);
  const float lg = log_gamma(hd);
  if (tid < 64) rowsq[tid] = 0.f;
  const int nkb = (qtr >= 2) ? 2 : 1;
  for (int kb = 0; kb < nkb; ++kb) {
    f32x16 acc[1][2];
    acc[0][0] = zero16(); acc[0][1] = zero16();
    gemm_tile<1>(acc, Qg, 1024, t0, L - 1, Kg, 1024, sc * 256 + kb * 128, 256, gsm);
#pragma unroll
    for (int ni = 0; ni < 2; ++ni)
#pragma unroll
      for (int i = 0; i < 16; ++i) {
        const int ll = wm * 32 + acc_row(i, h), lp = qtr * 64 + ll, s = kb * 128 + wn * 64 + ni * 32 + r;
        float val = 0.f;
        if (s <= lp) val = acc[0][ni][i] * __expf((float)(lp - s) * lg);
        P[ll * 264 + s] = f2bf(val);
      }
  }
  float rs[16];
#pragma unroll
  for (int i = 0; i < 16; ++i) rs[i] = 0.f;
  for (int et = 0; et < 4; ++et) {
    f32x16 acc[1][2];
    acc[0][0] = zero16(); acc[0][1] = zero16();
    u32x4 gv[4], vreg[4];
    {
      int tg = t0 + (tid >> 2); tg = tg < L ? tg : L - 1;
      const u16* gp0 = Gg + (size_t)tg * 2048 + hd * 512 + et * 128 + (tid & 3) * 32;
#pragma unroll
      for (int k = 0; k < 4; ++k) gv[k] = *(const u32x4*)(gp0 + k * 8);
#pragma unroll
      for (int i = 0; i < 4; ++i) {
        const int cidx = tid + i * 256, row = cidx >> 4, cc = cidx & 15;
        int tok = sc * 256 + row; tok = tok < L ? tok : L - 1;
        vreg[i] = *(const u32x4*)(Vg + (size_t)tok * 2048 + hd * 512 + et * 128 + cc * 8);
      }
    }
    if (sc > 0) {
      gemm_tile<1>(acc, Qg, 1024, t0, L - 1, RST + ((size_t)((sc - 1) * 4 + hd) * 512 + et * 128) * 256, 256, 0, 256, gsm);
#pragma unroll
      for (int ni = 0; ni < 2; ++ni)
#pragma unroll
        for (int i = 0; i < 16; ++i) {
          const int lp = qtr * 64 + wm * 32 + acc_row(i, h);
          acc[0][ni][i] *= __expf((float)(lp + 1) * lg);
        }
    }
    for (int kb64 = 0; kb64 <= qtr; ++kb64) {
#pragma unroll
      for (int i = 0; i < 4; ++i) {
        const int cidx = tid + i * 256, row = cidx >> 4, cc = cidx & 15;
        const int tok = sc * 256 + kb64 * 64 + row;
        u32x4 v = {0u, 0u, 0u, 0u};
        if (tok < L) v = vreg[i];
        *(u32x4*)(Vt + row * 136 + cc * 8) = v;
      }
      __syncthreads();
      if (kb64 < qtr) {
#pragma unroll
        for (int i = 0; i < 4; ++i) {
          const int cidx = tid + i * 256, row = cidx >> 4, cc = cidx & 15;
          int tok = sc * 256 + (kb64 + 1) * 64 + row; tok = tok < L ? tok : L - 1;
          vreg[i] = *(const u32x4*)(Vg + (size_t)tok * 2048 + hd * 512 + et * 128 + cc * 8);
        }
      }
#pragma unroll
      for (int ks = 0; ks < 4; ++ks) {
        bf16x8 a = frag_row(P, 264, wm * 32 + r, kb64 * 64 + ks * 16 + h * 8);
#pragma unroll
        for (int ni = 0; ni < 2; ++ni) {
          bf16x8 bq = frag_tr(Vt, 136, ks * 16, wn * 64 + ni * 32, lane);
          acc[0][ni] = mfma(a, bq, acc[0][ni]);
        }
      }
      __syncthreads();
    }
    u16* Os = (u16*)gsm;
#pragma unroll
    for (int ni = 0; ni < 2; ++ni)
#pragma unroll
      for (int i = 0; i < 16; ++i) {
        const float o = acc[0][ni][i];
        if (t0 + wm * 32 + acc_row(i, h) < L) rs[i] += o * o;
        Os[(wm * 32 + acc_row(i, h)) * 136 + wn * 64 + ni * 32 + r] = f2bf(o);
      }
    __syncthreads();
    {
      const int row = tid >> 2, q = tid & 3, t = t0 + row;
      if (t < L) {
        u16* gp = Gg + (size_t)t * 2048 + hd * 512 + et * 128 + q * 32;
        u32x4 ov[4];
#pragma unroll
        for (int k = 0; k < 4; ++k) ov[k] = *(const u32x4*)(Os + row * 136 + q * 32 + k * 8);
#pragma unroll
        for (int k = 0; k < 4; ++k) {
          u32x4 o;
#pragma unroll
          for (int j = 0; j < 4; ++j) o[j] = pack2(silu_f(lo_f(gv[k][j])) * lo_f(ov[k][j]), silu_f(hi_f(gv[k][j])) * hi_f(ov[k][j]));
          *(u32x4*)(gp + k * 8) = o;
        }
      }
    }
    __syncthreads();
  }
#pragma unroll
  for (int i = 0; i < 16; ++i) {
    const float v = half_sum(rs[i]);
    if (r == 0) atomicAdd(&rowsq[wm * 32 + acc_row(i, h)], v);
  }
  __syncthreads();
  {
    const int row = tid >> 2, q = tid & 3, t = t0 + row;
    if (t < L) {
      const float rn = rsqrtf(rowsq[row] * (1.f / 512.f) + EPS);
      u32x4 v[16];
#pragma unroll
      for (int et = 0; et < 4; ++et)
#pragma unroll
        for (int k = 0; k < 4; ++k) v[et * 4 + k] = *(const u32x4*)(Gg + (size_t)t * 2048 + hd * 512 + et * 128 + q * 32 + k * 8);
#pragma unroll
      for (int et = 0; et < 4; ++et)
#pragma unroll
        for (int k = 0; k < 4; ++k) {
          u32x4 o;
#pragma unroll
          for (int j = 0; j < 4; ++j) o[j] = pack2(lo_f(v[et * 4 + k][j]) * rn, hi_f(v[et * 4 + k][j]) * rn);
          *(u32x4*)(Gg + (size_t)t * 2048 + hd * 512 + et * 128 + q * 32 + k * 8) = o;
        }
    }
  }
  __syncthreads();
}

DEV void merge_tile(const Params& p, int it, char* smem) {
  const int tid = get_tid(), lane = tid & 63, w = tid >> 6, wm = w >> 1, wn = w & 1, r = lane & 31, h = lane >> 5;
  const int nt = it / 65, mt = it % 65;
  u16* GS = (u16*)(p.ws + OFF_GS);
  const u16* GR = (const u16*)(p.ws + OFF_GR);
  f32x16 acc[2][2];
#pragma unroll
  for (int mi = 0; mi < 2; ++mi)
#pragma unroll
    for (int ni = 0; ni < 2; ++ni) acc[mi][ni] = zero16();
  gemm_tile<2>(acc, (const u16*)(p.ws + OFF_Z), 2048, mt * 128, L - 1, (const u16*)(p.ws + OFF_S2), 2048, nt * 128, 2048, smem);
#pragma unroll
  for (int mi = 0; mi < 2; ++mi)
#pragma unroll
    for (int ni = 0; ni < 2; ++ni)
#pragma unroll
      for (int i = 0; i < 16; ++i) {
        const int t = mt * 128 + wm * 64 + mi * 32 + acc_row(i, h);
        if (t < L) {
          const size_t idx = (size_t)t * 1024 + nt * 128 + wn * 64 + ni * 32 + r;
          GS[idx] = f2bf(bf2f(GS[idx]) * acc[mi][ni][i]);
        }
        acc[mi][ni][i] = 0.f;
      }
  gemm_tile<2>(acc, (const u16*)(p.ws + OFF_G), 2048, mt * 128, L - 1, (const u16*)(p.ws + OFF_S2 + 4194304), 2048, nt * 128, 2048, smem);
#pragma unroll
  for (int mi = 0; mi < 2; ++mi)
#pragma unroll
    for (int ni = 0; ni < 2; ++ni)
#pragma unroll
      for (int i = 0; i < 16; ++i) {
        const int t = mt * 128 + wm * 64 + mi * 32 + acc_row(i, h);
        if (t < L) {
          const size_t idx = (size_t)t * 1024 + nt * 128 + wn * 64 + ni * 32 + r;
          GS[idx] = f2bf(bf2f(GS[idx]) + bf2f(GR[idx]) * acc[mi][ni][i]);
        }
      }
}

DEV void phase_merge(const Params& p, char* smem) {
  const int n_tiles = 65 * 8;
  const int n_wout = 16 * 16, n_wup = 16 * 88, n_wdown = 44 * 16;
  const int total = n_tiles + n_wout + n_wup + n_wdown;
  for (int it = get_bid(); it < total; it += nworkers()) {
    if (it < n_tiles) merge_tile(p, it, smem);
    else if (it < n_tiles + n_wout) { const int j = it - n_tiles; convert_tile(p.in[12], 1024, 1024, (u16*)(p.ws + OFF_WOUT), j & 15, j >> 4, 0, smem); }
    else if (it < n_tiles + n_wout + n_wup) { const int j = it - n_tiles - n_wout; convert_tile(p.in[14], 5632, 1024, (u16*)(p.ws + OFF_WUP), j & 15, j >> 4, 0, smem); }
    else { const int j = it - n_tiles - n_wout - n_wup; convert_tile(p.in[17], 1024, 2816, (u16*)(p.ws + OFF_WDOWN), j % 44, j / 44, 0, smem); }
  }
}

DEV void phase_outproj(const Params& p, int b, char* smem) {
  const int tid = get_tid(), lane = tid & 63, w = tid >> 6, wm = w >> 1, wn = w & 1, r = lane & 31, h = lane >> 5;
  float* HM = (float*)(p.ws + OFF_HM);
  for (int it = get_bid(); it < 65 * 8; it += gridDim.x) {
    const int nt = it / 65, mt = it % 65;
    f32x16 acc[2][2];
#pragma unroll
    for (int mi = 0; mi < 2; ++mi)
#pragma unroll
      for (int ni = 0; ni < 2; ++ni) acc[mi][ni] = zero16();
    gemm_tile<2>(acc, (const u16*)(p.ws + OFF_GS), 1024, mt * 128, L - 1, (const u16*)(p.ws + OFF_WOUT), 1024, nt * 128, 1024, smem);
#pragma unroll
    for (int mi = 0; mi < 2; ++mi)
#pragma unroll
      for (int ni = 0; ni < 2; ++ni)
#pragma unroll
        for (int i = 0; i < 16; ++i) {
          const int t = mt * 128 + wm * 64 + mi * 32 + acc_row(i, h);
          const int col = nt * 128 + wn * 64 + ni * 32 + r;
          if (t < NMETA) HM[t * 1024 + col] = p.in[1][t * 1024 + col] + acc[mi][ni][i];
          else if (t < L) {
            const size_t idx = ((size_t)b * SEQ + (t - NMETA)) * 1024 + col;
            p.out[idx] = p.in[0][idx] + acc[mi][ni][i];
          }
        }
  }
}

DEV void phase_norm2(const Params& p, int b) {
  const int lane = get_tid() & 63, w = get_tid() >> 6;
  u16* U2 = (u16*)(p.ws + OFF_U2);
  for (int it = get_bid(); it < L / 4; it += nworkers()) {
    const int t = it * 4 + w;
    const float* src = (t < NMETA) ? ((const float*)(p.ws + OFF_HM) + (size_t)t * D) : (p.out + ((size_t)b * SEQ + (t - NMETA)) * D);
    rmsnorm_row_bf16(src, p.in[13], U2 + (size_t)t * D, lane);
  }
}

DEV void phase_up(const Params& p, char* smem) {
  const int tid = get_tid(), lane = tid & 63, w = tid >> 6, wm = w >> 1, wn = w & 1, r = lane & 31, h = lane >> 5;
  u16* UP = (u16*)(p.ws + OFF_UP);
  for (int it = get_bid(); it < 65 * 44; it += gridDim.x) {
    const int nt = it / 65, mt = it % 65;
    f32x16 acc[2][2];
#pragma unroll
    for (int mi = 0; mi < 2; ++mi)
#pragma unroll
      for (int ni = 0; ni < 2; ++ni) acc[mi][ni] = zero16();
    gemm_tile<2>(acc, (const u16*)(p.ws + OFF_U2), 1024, mt * 128, L - 1, (const u16*)(p.ws + OFF_WUP), 1024, nt * 128, 1024, smem);
#pragma unroll
    for (int mi = 0; mi < 2; ++mi)
#pragma unroll
      for (int ni = 0; ni < 2; ++ni)
#pragma unroll
        for (int i = 0; i < 16; ++i) {
          const int t = mt * 128 + wm * 64 + mi * 32 + acc_row(i, h);
          if (t < L) UP[(size_t)t * 5632 + nt * 128 + wn * 64 + ni * 32 + r] = f2bf(acc[mi][ni][i]);
        }
  }
}

DEV void phase_ffn_act(const Params& p) {
  const int gt = get_bid() * 256 + get_tid(), nth = nworkers() * 256;
  const u16* UP = (const u16*)(p.ws + OFF_UP);
  u16* ACT = (u16*)(p.ws + OFF_ACT);
  const float* cw = p.in[15];
  const float* cbias = p.in[16];
  for (int u = gt; u < 513 * 352; u += nth) {
    const int rb = u / 352, cgp = u % 352, ch = cgp * 8, t0 = rb * 16;
    float wg[3][8], wv[3][8], bg[8], bv[8], g2[8], g1[8], v2[8], v1[8];
#pragma unroll
    for (int k = 0; k < 3; ++k)
#pragma unroll
      for (int j = 0; j < 8; ++j) { wg[k][j] = cw[k * 5632 + ch + j]; wv[k][j] = cw[k * 5632 + 2816 + ch + j]; }
#pragma unroll
    for (int j = 0; j < 8; ++j) { bg[j] = cbias[ch + j]; bv[j] = cbias[2816 + ch + j]; }
    {
      u32x4 a = {0u, 0u, 0u, 0u}, bq = {0u, 0u, 0u, 0u}, c2 = {0u, 0u, 0u, 0u}, d2 = {0u, 0u, 0u, 0u};
      if (t0 >= 2) {
        a = *(const u32x4*)(UP + (size_t)(t0 - 2) * 5632 + ch); bq = *(const u32x4*)(UP + (size_t)(t0 - 1) * 5632 + ch);
        c2 = *(const u32x4*)(UP + (size_t)(t0 - 2) * 5632 + 2816 + ch); d2 = *(const u32x4*)(UP + (size_t)(t0 - 1) * 5632 + 2816 + ch);
      }
#pragma unroll
      for (int j = 0; j < 4; ++j) {
        g2[2 * j] = lo_f(a[j]); g2[2 * j + 1] = hi_f(a[j]); g1[2 * j] = lo_f(bq[j]); g1[2 * j + 1] = hi_f(bq[j]);
        v2[2 * j] = lo_f(c2[j]); v2[2 * j + 1] = hi_f(c2[j]); v1[2 * j] = lo_f(d2[j]); v1[2 * j + 1] = hi_f(d2[j]);
      }
    }
#pragma unroll 4
    for (int i = 0; i < 16; ++i) {
      const int t = t0 + i;
      const u32x4 a = *(const u32x4*)(UP + (size_t)t * 5632 + ch);
      const u32x4 c2 = *(const u32x4*)(UP + (size_t)t * 5632 + 2816 + ch);
      float o[8];
#pragma unroll
      for (int j = 0; j < 8; ++j) {
        const float gx = (j & 1) ? hi_f(a[j >> 1]) : lo_f(a[j >> 1]);
        const float vx = (j & 1) ? hi_f(c2[j >> 1]) : lo_f(c2[j >> 1]);
        const float ag = bg[j] + wg[0][j] * g2[j] + wg[1][j] * g1[j] + wg[2][j] * gx;
        const float av = bv[j] + wv[0][j] * v2[j] + wv[1][j] * v1[j] + wv[2][j] * vx;
        o[j] = silu_f(ag) * av;
        g2[j] = g1[j]; g1[j] = gx; v2[j] = v1[j]; v1[j] = vx;
      }
      u32x4 pk; pk[0] = pack2(o[0], o[1]); pk[1] = pack2(o[2], o[3]); pk[2] = pack2(o[4], o[5]); pk[3] = pack2(o[6], o[7]);
      *(u32x4*)(ACT + (size_t)t * 2816 + ch) = pk;
    }
  }
}

DEV void phase_down(const Params& p, int b, char* smem) {
  const int tid = get_tid(), lane = tid & 63, w = tid >> 6, wm = w >> 1, wn = w & 1, r = lane & 31, h = lane >> 5;
  for (int it = get_bid(); it < 64 * 8; it += gridDim.x) {
    const int nt = it / 64, mt = it % 64;
    f32x16 acc[2][2];
#pragma unroll
    for (int mi = 0; mi < 2; ++mi)
#pragma unroll
      for (int ni = 0; ni < 2; ++ni) acc[mi][ni] = zero16();
    gemm_tile<2>(acc, (const u16*)(p.ws + OFF_ACT), 2816, NMETA + mt * 128, L - 1, (const u16*)(p.ws + OFF_WDOWN), 2816, nt * 128, 2816, smem);
#pragma unroll
    for (int mi = 0; mi < 2; ++mi)
#pragma unroll
      for (int ni = 0; ni < 2; ++ni)
#pragma unroll
        for (int i = 0; i < 16; ++i) {
          const int rr = mt * 128 + wm * 64 + mi * 32 + acc_row(i, h);
          const size_t idx = ((size_t)b * SEQ + rr) * 1024 + nt * 128 + wn * 64 + ni * 32 + r;
          p.out[idx] += acc[mi][ni][i];
        }
  }
}

DEV void phase_final_norm(const Params& p, int b) {
  const int lane = get_tid() & 63, w = get_tid() >> 6;
  for (int it = get_bid(); it < SEQ / 4; it += nworkers()) {
    const int rr = it * 4 + w;
    rmsnorm_row_f32_inplace(p.out + ((size_t)b * SEQ + rr) * D, p.in[18], lane);
  }
}


DEV u32x4 add_bf16x8(u32x4 a, u32x4 b) {
  u32x4 o;
#pragma unroll
  for (int j = 0; j < 4; ++j) o[j] = pack2(lo_f(a[j]) + lo_f(b[j]), hi_f(a[j]) + hi_f(b[j]));
  return o;
}
template <int NJ, bool ADD2 = false>
DEV void gemm_tile8(f32x4 (&acc)[4][NJ], const u16* __restrict__ A, int lda, int arow0, int arow_max,
                    const u16* __restrict__ B, int ldb, int brow0, int K, char* smem, const u16* __restrict__ A2 = nullptr) {
  constexpr int BN = NJ * 32;
  constexpr int BCH = BN / 64;
  constexpr int STAGE = (256 + BN) * 64;
  u16* S = (u16*)smem;
  const int tid = get_tid8(), lane = tid & 63, w = tid >> 6, wm = w >> 1, wn = w & 1;
  u32x4 ra[4], rb[BCH], ra2[ADD2 ? 4 : 1];
  unsigned aoff[4], boff[BCH];
  const char* Ab = (const char*)A;
  const char* Ab2 = (const char*)A2;
  const char* Bb = (const char*)(B + (size_t)brow0 * ldb);
  const int crow = tid >> 3, kc = tid & 7;
  const unsigned sto = (unsigned)(crow * 64 + ((kc ^ ((crow >> 1) & 7)) * 8));
#pragma unroll
  for (int i = 0; i < 4; ++i) {
    int gr = arow0 + crow + i * 64; gr = gr > arow_max ? arow_max : gr; gr = gr < 0 ? 0 : gr;
    aoff[i] = ((unsigned)gr * (unsigned)lda + kc * 8) * 2u;
  }
#pragma unroll
  for (int i = 0; i < BCH; ++i) boff[i] = ((unsigned)(crow + i * 64) * (unsigned)ldb + kc * 8) * 2u;
  const int fr = lane & 15, swz = fr >> 1, cq = lane >> 4;
  const unsigned fa = (unsigned)((wm * 64 + fr) * 64), fb = (unsigned)((256 + wn * (NJ * 16) + fr) * 64);
  const unsigned c0 = (unsigned)(((cq) ^ swz) * 8), c1 = (unsigned)(((4 + cq) ^ swz) * 8);
  const int nk = K >> 6;
#pragma unroll
  for (int i = 0; i < 4; ++i) { ra[i] = *(const u32x4*)(Ab + aoff[i]); if (ADD2) ra2[i] = *(const u32x4*)(Ab2 + aoff[i]); }
#pragma unroll
  for (int i = 0; i < BCH; ++i) rb[i] = *(const u32x4*)(Bb + boff[i]);
#pragma unroll
  for (int i = 0; i < 4; ++i) *(u32x4*)(S + sto + i * 64 * 64) = ADD2 ? add_bf16x8(ra[i], ra2[i]) : ra[i];
#pragma unroll
  for (int i = 0; i < BCH; ++i) *(u32x4*)(S + sto + (256 + i * 64) * 64) = rb[i];
  if (nk > 1) {
#pragma unroll
    for (int i = 0; i < 4; ++i) { ra[i] = *(const u32x4*)(Ab + aoff[i] + 128); if (ADD2) ra2[i] = *(const u32x4*)(Ab2 + aoff[i] + 128); }
#pragma unroll
    for (int i = 0; i < BCH; ++i) rb[i] = *(const u32x4*)(Bb + boff[i] + 128);
  }
  __syncthreads();
  for (int kt = 0; kt < nk; ++kt) {
    const u16* Sc = S + (kt & 1) * STAGE;
    {
      bf16x8 a[4], b[NJ];
#pragma unroll
      for (int m = 0; m < 4; ++m) a[m] = *(const bf16x8*)(Sc + fa + m * 16 * 64 + c0);
#pragma unroll
      for (int n = 0; n < NJ; ++n) b[n] = *(const bf16x8*)(Sc + fb + n * 16 * 64 + c0);
      __builtin_amdgcn_s_setprio(1);
#pragma unroll
      for (int m = 0; m < 4; ++m)
#pragma unroll
        for (int n = 0; n < NJ; ++n) acc[m][n] = __builtin_amdgcn_mfma_f32_16x16x32_bf16(a[m], b[n], acc[m][n], 0, 0, 0);
      __builtin_amdgcn_s_setprio(0);
    }
    bf16x8 a1[4], b1[NJ];
#pragma unroll
    for (int m = 0; m < 4; ++m) a1[m] = *(const bf16x8*)(Sc + fa + m * 16 * 64 + c1);
#pragma unroll
    for (int n = 0; n < NJ; ++n) b1[n] = *(const bf16x8*)(Sc + fb + n * 16 * 64 + c1);
    if (kt + 1 < nk) {
      u16* Aw = S + ((kt + 1) & 1) * STAGE;
#pragma unroll
      for (int i = 0; i < 4; ++i) *(u32x4*)(Aw + sto + i * 64 * 64) = ADD2 ? add_bf16x8(ra[i], ra2[i]) : ra[i];
#pragma unroll
      for (int i = 0; i < BCH; ++i) *(u32x4*)(Aw + sto + (256 + i * 64) * 64) = rb[i];
      if (kt + 2 < nk) {
        const unsigned ko = (unsigned)(kt + 2) * 128u;
#pragma unroll
        for (int i = 0; i < 4; ++i) { ra[i] = *(const u32x4*)(Ab + aoff[i] + ko); if (ADD2) ra2[i] = *(const u32x4*)(Ab2 + aoff[i] + ko); }
#pragma unroll
        for (int i = 0; i < BCH; ++i) rb[i] = *(const u32x4*)(Bb + boff[i] + ko);
      }
    }
    {
      __builtin_amdgcn_s_setprio(1);
#pragma unroll
      for (int m = 0; m < 4; ++m)
#pragma unroll
        for (int n = 0; n < NJ; ++n) acc[m][n] = __builtin_amdgcn_mfma_f32_16x16x32_bf16(a1[m], b1[n], acc[m][n], 0, 0, 0);
      __builtin_amdgcn_s_setprio(0);
    }
    __syncthreads();
  }
}

DEV f32x4 thin16(const u16* __restrict__ A, int lda, int row0, const u16* __restrict__ BT, int ldb, int col0, int K, int lane) {
  const u16* ap = A + (size_t)(row0 + (lane & 15)) * lda + 8 * (lane >> 4);
  const u16* bp = BT + (size_t)(col0 + (lane & 15)) * ldb + 8 * (lane >> 4);
  f32x4 acc = {0.f, 0.f, 0.f, 0.f};
  for (int k0 = 0; k0 < K; k0 += 128) {
    bf16x8 a[4], b[4];
#pragma unroll
    for (int j = 0; j < 4; ++j) { a[j] = *(const bf16x8*)(ap + k0 + j * 32); b[j] = *(const bf16x8*)(bp + k0 + j * 32); }
#pragma unroll
    for (int j = 0; j < 4; ++j) acc = __builtin_amdgcn_mfma_f32_16x16x32_bf16(a[j], b[j], acc, 0, 0, 0);
  }
  return acc;
}

DEV int tile_index(int k) { const int G = gridDim.x, rb = get_rbid(); return k * G + (rb & 7) * (G >> 3) + (rb >> 3); }
DEV void tile_decode(int T, int MT, int NT, int& mt, int& nt) {
  const int per = MT * 8;
  const int nb = T / per, rem = T - nb * per;
  int width = NT - nb * 8; width = width > 8 ? 8 : width;
  mt = rem / width; nt = nb * 8 + (rem - mt * width);
}

#define ZERO_ACC(acc, NJ_) _Pragma("unroll") for (int m_ = 0; m_ < 4; ++m_) _Pragma("unroll") for (int n_ = 0; n_ < NJ_; ++n_) { acc[m_][n_][0] = 0.f; acc[m_][n_][1] = 0.f; acc[m_][n_][2] = 0.f; acc[m_][n_][3] = 0.f; }

constexpr int EPI_WAVE_BYTES = 17408;
#define EPI_FENCE() asm volatile("s_waitcnt lgkmcnt(0)" ::: "memory")
DEV void epi_store_bf16_128(const u16* reg, u16* __restrict__ dst, int ld, int trow, int col0, int lane) {
#pragma unroll
  for (int j = 0; j < 16; ++j) {
    const int row = (lane >> 4) + 4 * j, t = trow + row;
    const u32x4 v = *(const u32x4*)(reg + row * 136 + (lane & 15) * 8);
    if (t < L) *(u32x4*)(dst + (size_t)t * ld + col0 + (lane & 15) * 8) = v;
  }
}

DEV void phase_inproj8(const Params& p, int b, char* smem) {
  const u16* U = (const u16*)((char*)p.out + OUT_HALF);
  const u16* WT = (const u16*)(p.ws + OFF_S1);
  const int MT = 33, NT = 53;
  for (int kk = 0;; ++kk) {
    const int it = tile_index(kk);
    if (it >= MT * NT) break;
    int mt, nt; tile_decode(it, MT, NT, mt, nt);
    f32x4 acc[4][8];
    ZERO_ACC(acc, 8)
    gemm_tile8<8>(acc, U, 1024, mt * 256, L - 1, WT, 1024, nt * 256, 1024, smem);
    const int tid = get_tid8(), lane = tid & 63, w = tid >> 6, wm = w >> 1, wn = w & 1, r = lane & 31, h = lane >> 5;
    u16* reg = (u16*)(smem + w * EPI_WAVE_BYTES);
    const int n0 = nt * 256;
    const int trow = mt * 256 + wm * 64;
    if (nt >= 20 && nt < 28) {
      const bool isk = nt >= 24;
      const int cq = n0 - (isk ? 6144 : 5120);
      const float sc = isk ? 0.0625f : 1.f;
      u16* dst = (u16*)(p.ws + (isk ? OFF_K : OFF_Q));
#pragma unroll
      for (int pr = 0; pr < 4; ++pr) {
        const int n1 = 4 * (pr >> 1) + (pr & 1);
        const int jf = (wn * 2 + (pr >> 1)) * 32 + (pr & 1) * 16 + (lane & 15);
        const float invf_rev = exp2f(-(float)jf * 0.10462765653f) * 0.15915494309189535f;
#pragma unroll
        for (int m = 0; m < 4; ++m)
#pragma unroll
          for (int j = 0; j < 4; ++j) {
            const int row = m * 16 + (lane >> 4) * 4 + j;
            const float tf = (float)(trow + row);
            const float ph = tf * invf_rev, pl = fmaf(tf, invf_rev, -ph);
            const float fr = (ph - floorf(ph)) + pl;
            const float sn = __builtin_amdgcn_sinf(fr), cs = __builtin_amdgcn_cosf(fr);
            const float x1 = acc[m][n1][j], x2 = acc[m][n1 + 2][j];
            reg[row * 136 + n1 * 16 + (lane & 15)] = f2bf((x1 * cs - x2 * sn) * sc);
            reg[row * 136 + n1 * 16 + 32 + (lane & 15)] = f2bf((x2 * cs + x1 * sn) * sc);
          }
      }
      EPI_FENCE();
      epi_store_bf16_128(reg, dst, 1024, trow, cq + wn * 128, lane);
    } else if (nt == 52) {
      float* DT = (float*)(p.ws + OFF_DT);
      if (wn == 0) {
#pragma unroll
        for (int n = 0; n < 2; ++n) {
          const int col = n * 16 + (lane & 15);
          const float bias = p.in[6][col];
#pragma unroll
          for (int m = 0; m < 4; ++m)
#pragma unroll
            for (int j = 0; j < 4; ++j) {
              const int t = trow + m * 16 + (lane >> 4) * 4 + j;
              if (t < L) {
                const float x = acc[m][n][j] + bias;
                const float e = __expf(x);
                DT[(size_t)t * 32 + col] = (x > 20.f) ? x : (e < 0.01f ? e * (1.f - 0.5f * e + e * e * (1.f / 3.f)) : __logf(1.f + e));
              }
            }
        }
      }
    } else {
      u16* dst; int ld, c0; bool sig = false;
      if (nt < 8) { dst = (u16*)(p.ws + OFF_Z); ld = 2048; c0 = n0; }
      else if (nt < 20) { dst = (u16*)(p.ws + OFF_XBC); ld = 3072; c0 = n0 - 2048; }
      else if (nt < 36) { dst = (u16*)(p.ws + OFF_V); ld = 2048; c0 = n0 - 7168; }
      else if (nt < 44) { dst = (u16*)(p.ws + OFF_G); ld = 2048; c0 = n0 - 9216; }
      else if (nt < 48) { dst = (u16*)(p.ws + OFF_GS); ld = 1024; c0 = n0 - 11264; sig = true; }
      else { dst = (u16*)(p.ws + OFF_GR); ld = 1024; c0 = n0 - 12288; sig = true; }
#pragma unroll
      for (int m = 0; m < 4; ++m)
#pragma unroll
        for (int n = 0; n < 8; ++n)
#pragma unroll
          for (int j = 0; j < 4; ++j) {
            float v = acc[m][n][j];
            if (sig) v = sigmoid_f(v);
            reg[(m * 16 + (lane >> 4) * 4 + j) * 136 + n * 16 + (lane & 15)] = f2bf(v);
          }
      EPI_FENCE();
      epi_store_bf16_128(reg, dst, ld, trow, c0 + wn * 128, lane);
    }
    __syncthreads();
  }
}

DEV void phase_merge8(const Params& p, char* smem, char* smem_team) {
  u16* GS = (u16*)(p.ws + OFF_GS);
  u16* GR = (u16*)(p.ws + OFF_GR);
  const u16* Zb = (const u16*)(p.ws + OFF_Z);
  const u16* Gb = (const u16*)(p.ws + OFF_G);
  const u16* WBS = (const u16*)(p.ws + OFF_S2);
  const u16* WBR = (const u16*)(p.ws + OFF_S2 + 4194304);
  for (int kk = 0;; ++kk) {
    const int it = tile_index(kk);
    if (it >= 256) break;
    const int branch = it >> 7, tl = it & 127, mt = tl >> 2, nt = tl & 3;
    f32x4 acc[4][8];
    ZERO_ACC(acc, 8)
    gemm_tile8<8>(acc, branch ? Gb : Zb, 2048, mt * 256, L - 1, branch ? WBR : WBS, 2048, nt * 256, 2048, smem);
    const int tid = get_tid8(), lane = tid & 63, w = tid >> 6, wm = w >> 1, wn = w & 1;
    float* reg = (float*)(smem + w * EPI_WAVE_BYTES);
    u16* GT = branch ? GR : GS;
#pragma unroll
    for (int hf = 0; hf < 2; ++hf) {
#pragma unroll
      for (int m = 0; m < 4; ++m)
#pragma unroll
        for (int n = 0; n < 4; ++n)
#pragma unroll
          for (int j = 0; j < 4; ++j) reg[(m * 16 + (lane >> 4) * 4 + j) * 68 + n * 16 + (lane & 15)] = acc[m][hf * 4 + n][j];
      EPI_FENCE();
#pragma unroll
      for (int j = 0; j < 16; ++j) {
        const int row = (lane >> 4) + 4 * j, c4 = (lane & 15) * 4;
        const f32x4 a = *(const f32x4*)(reg + row * 68 + c4);
        const size_t idx = (size_t)(mt * 256 + wm * 64 + row) * 1024 + nt * 256 + wn * 128 + hf * 64 + c4;
        const u32x2 g = *(const u32x2*)(GT + idx);
        u32x2 o; o[0] = pack2(lo_f(g[0]) * a[0], hi_f(g[0]) * a[1]); o[1] = pack2(lo_f(g[1]) * a[2], hi_f(g[1]) * a[3]);
        *(u32x2*)(GT + idx) = o;
      }
      EPI_FENCE();
    }
    __syncthreads();
  }
  for (int ct = get_rbid(); ct < 128; ct += gridDim.x) {
    const int tid = get_tid8(), lane = tid & 63, w = tid >> 6;
    const int branch = ct >> 6, c16 = ct & 63;
    f32x4* red = (f32x4*)smem;
    red[w * 64 + lane] = thin16((branch ? Gb : Zb) + w * 256, 2048, 8192, (branch ? WBR : WBS) + w * 256, 2048, c16 * 16, 256, lane);
    __syncthreads();
    if (w == 0) {
      u16* GT = branch ? GR : GS;
      f32x4 a1 = red[lane];
#pragma unroll
      for (int q = 1; q < 8; ++q) a1 += red[q * 64 + lane];
#pragma unroll
      for (int j = 0; j < 4; ++j) {
        const size_t idx = (size_t)(8192 + (lane >> 4) * 4 + j) * 1024 + c16 * 16 + (lane & 15);
        GT[idx] = f2bf(bf2f(GT[idx]) * a1[j]);
      }
    }
    __syncthreads();
  }
  {
    float* RSS = (float*)(p.ws + OFF_RSS);
    for (int i = get_bid() * 256 + get_tid(); i < L; i += nworkers() * 256) RSS[i] = 0.f;
  }
  const int n_wout = 16 * 16, n_wup = 16 * 88, n_wdown = 44 * 16;
  for (int it = get_bid(); it < n_wout + n_wup + n_wdown; it += nworkers()) {
    if (it < n_wout) { convert_tile(p.in[12], 1024, 1024, (u16*)(p.ws + OFF_WOUT), it & 15, it >> 4, 0, smem_team); }
    else if (it < n_wout + n_wup) { const int j = it - n_wout; convert_tile(p.in[14], 5632, 1024, (u16*)(p.ws + OFF_WUP), j & 15, j >> 4, 2, smem_team, p.in[13]);   }
    else { const int j = it - n_wout - n_wup; convert_tile(p.in[17], 1024, 2816, (u16*)(p.ws + OFF_WDOWN), j % 44, j / 44, 0, smem_team); }
  }
}

DEV void phase_outproj8(const Params& p, int b, char* smem) {
  const int tid = get_tid8(), lane = tid & 63, w = tid >> 6, wm = w >> 1, wn = w & 1, r = lane & 31, h = lane >> 5;
  u16* U2 = (u16*)(p.ws + OFF_U2);
  float* RSS = (float*)(p.ws + OFF_RSS);
  const u16* Mg = (const u16*)(p.ws + OFF_GS);
  const u16* WO = (const u16*)(p.ws + OFF_WOUT);
  float* reg = (float*)(smem + w * EPI_WAVE_BYTES);
  for (int kk = 0;; ++kk) {
    const int it = tile_index(kk);
    if (it >= 256) break;
    const int mt = it >> 3, nt = it & 7;
    f32x4 acc[4][4];
    ZERO_ACC(acc, 4)
    gemm_tile8<4, true>(acc, Mg, 1024, mt * 256, L - 1, WO, 1024, nt * 128, 1024, smem, (const u16*)(p.ws + OFF_GR));
#pragma unroll
    for (int m = 0; m < 4; ++m)
#pragma unroll
      for (int n = 0; n < 4; ++n)
#pragma unroll
        for (int j = 0; j < 4; ++j) reg[(m * 16 + (lane >> 4) * 4 + j) * 68 + n * 16 + (lane & 15)] = acc[m][n][j];
    EPI_FENCE();
#pragma unroll
    for (int j = 0; j < 16; ++j) {
      const int row = (lane >> 4) + 4 * j, c4 = (lane & 15) * 4;
      const f32x4 a = *(const f32x4*)(reg + row * 68 + c4);
      const int t = mt * 256 + wm * 64 + row, col = nt * 128 + wn * 64 + c4;
      f32x4 hv;
      if (t < NMETA) {
        hv = *(const f32x4*)(p.in[1] + t * 1024 + col) + a;
      } else {
        const size_t idx = ((size_t)b * SEQ + (t - NMETA)) * 1024 + col;
        hv = *(const f32x4*)(p.in[0] + idx) + a;
        *(f32x4*)(p.out + idx) = hv;
      }
      u32x2 hb; hb[0] = pack2(hv[0], hv[1]); hb[1] = pack2(hv[2], hv[3]);
      *(u32x2*)(U2 + (size_t)t * 1024 + col) = hb;
      float sq = hv[0] * hv[0] + hv[1] * hv[1] + hv[2] * hv[2] + hv[3] * hv[3];
      sq += __shfl_xor(sq, 1); sq += __shfl_xor(sq, 2); sq += __shfl_xor(sq, 4); sq += __shfl_xor(sq, 8);
      if ((lane & 15) == 0) atomicAdd(&RSS[t], sq);
    }
    __syncthreads();
  }
  for (int ct = get_rbid(); ct < 64; ct += gridDim.x) {
    const int tid = get_tid8(), lane = tid & 63, w = tid >> 6;
    f32x4* red = (f32x4*)smem;
    red[w * 64 + lane] = thin16(Mg + w * 128, 1024, 8192, WO + w * 128, 1024, ct * 16, 128, lane)
                       + thin16((const u16*)(p.ws + OFF_GR) + w * 128, 1024, 8192, WO + w * 128, 1024, ct * 16, 128, lane);
    __syncthreads();
    if (w == 0) {
      f32x4 a1 = red[lane];
#pragma unroll
      for (int q = 1; q < 8; ++q) a1 += red[q * 64 + lane];
#pragma unroll
      for (int j = 0; j < 4; ++j) {
        const int t = 8192 + (lane >> 4) * 4 + j;
        const size_t idx = ((size_t)b * SEQ + (t - NMETA)) * 1024 + ct * 16 + (lane & 15);
        const float hv = p.in[0][idx] + a1[j];
        p.out[idx] = hv;
        U2[(size_t)t * 1024 + ct * 16 + (lane & 15)] = f2bf(hv);
        float sq = hv * hv;
        sq += __shfl_xor(sq, 1); sq += __shfl_xor(sq, 2); sq += __shfl_xor(sq, 4); sq += __shfl_xor(sq, 8);
        if ((lane & 15) == 0) atomicAdd(&RSS[t], sq);
      }
    }
    __syncthreads();
  }
}

DEV void phase_up8(const Params& p, char* smem) {
  u16* ACT = (u16*)(p.ws + OFF_ACT);
  const float* cw = p.in[15];
  const float* cbias = p.in[16];
  for (int kk = 0;; ++kk) {
    const int it = tile_index(kk);
    if (it >= 33 * 22) break;
    int mt, nt; tile_decode(it, 33, 22, mt, nt);
    f32x4 acc[4][8];
    ZERO_ACC(acc, 8)
    gemm_tile8<8>(acc, (const u16*)(p.ws + OFF_U2), 1024, mt * 254 - 2, L - 1, (const u16*)(p.ws + OFF_WUP), 1024, nt * 256, 1024, smem);
    const int tid = get_tid8(), lane = tid & 63, w = tid >> 6;
    u16* reg = (u16*)(smem + w * EPI_WAVE_BYTES);
    {
      const float* RSS = (const float*)(p.ws + OFF_RSS);
      const int wm = w >> 1;
#pragma unroll
      for (int m = 0; m < 4; ++m)
#pragma unroll
        for (int j = 0; j < 4; ++j) {
          int t = mt * 254 - 2 + wm * 64 + m * 16 + (lane >> 4) * 4 + j; t = t < 0 ? 0 : (t > L - 1 ? L - 1 : t);
          const float rstd = rsqrtf(RSS[t] * (1.f / 1024.f) + EPS);
#pragma unroll
          for (int n = 0; n < 8; ++n) reg[(m * 16 + (lane >> 4) * 4 + j) * 136 + n * 16 + (lane & 15)] = f2bf(acc[m][n][j] * rstd);
        }
    }
    __syncthreads();
    {
      const int cg = tid & 15, rg = tid >> 4;
      const int ch = nt * 128 + cg * 8;
      float wg[3][8], wv[3][8], bg[8], bv[8], g2[8], g1[8], v2[8], v1[8];
#pragma unroll
      for (int k = 0; k < 3; ++k) {
        const f32x4 a0 = *(const f32x4*)(cw + k * 5632 + ch), a1 = *(const f32x4*)(cw + k * 5632 + ch + 4);
        const f32x4 c0 = *(const f32x4*)(cw + k * 5632 + 2816 + ch), c1 = *(const f32x4*)(cw + k * 5632 + 2816 + ch + 4);
#pragma unroll
        for (int j = 0; j < 4; ++j) { wg[k][j] = a0[j]; wg[k][4 + j] = a1[j]; wv[k][j] = c0[j]; wv[k][4 + j] = c1[j]; }
      }
      {
        const f32x4 a0 = *(const f32x4*)(cbias + ch), a1 = *(const f32x4*)(cbias + ch + 4);
        const f32x4 c0 = *(const f32x4*)(cbias + 2816 + ch), c1 = *(const f32x4*)(cbias + 2816 + ch + 4);
#pragma unroll
        for (int j = 0; j < 4; ++j) { bg[j] = a0[j]; bg[4 + j] = a1[j]; bv[j] = c0[j]; bv[4 + j] = c1[j]; }
      }
      const int R0 = rg * 8;
#pragma unroll
      for (int q = 0; q < 2; ++q) {
        const int R = R0 - 2 + q;
        u32x4 gvv = {0u, 0u, 0u, 0u}, vvv = {0u, 0u, 0u, 0u};
        if (R >= 0 && mt * 254 - 2 + R >= 0) {
          const char* sl = smem + ((R >> 6) * 2) * EPI_WAVE_BYTES + ((R & 63) * 136 + cg * 8) * 2;
          gvv = *(const u32x4*)sl; vvv = *(const u32x4*)(sl + EPI_WAVE_BYTES);
        }
#pragma unroll
        for (int j = 0; j < 4; ++j) {
          if (q == 0) { g2[2 * j] = lo_f(gvv[j]); g2[2 * j + 1] = hi_f(gvv[j]); v2[2 * j] = lo_f(vvv[j]); v2[2 * j + 1] = hi_f(vvv[j]); }
          else { g1[2 * j] = lo_f(gvv[j]); g1[2 * j + 1] = hi_f(gvv[j]); v1[2 * j] = lo_f(vvv[j]); v1[2 * j + 1] = hi_f(vvv[j]); }
        }
      }
#pragma unroll 2
      for (int i = 0; i < 8; ++i) {
        const int R = R0 + i, t = mt * 254 - 2 + R;
        u32x4 gvv = {0u, 0u, 0u, 0u}, vvv = {0u, 0u, 0u, 0u};
        if (t >= 0) {
          const char* sl = smem + ((R >> 6) * 2) * EPI_WAVE_BYTES + ((R & 63) * 136 + cg * 8) * 2;
          gvv = *(const u32x4*)sl; vvv = *(const u32x4*)(sl + EPI_WAVE_BYTES);
        }
        float o[8];
#pragma unroll
        for (int j = 0; j < 8; ++j) {
          const float gx = (j & 1) ? hi_f(gvv[j >> 1]) : lo_f(gvv[j >> 1]);
          const float vx = (j & 1) ? hi_f(vvv[j >> 1]) : lo_f(vvv[j >> 1]);
          const float ag = bg[j] + wg[0][j] * g2[j] + wg[1][j] * g1[j] + wg[2][j] * gx;
          const float av = bv[j] + wv[0][j] * v2[j] + wv[1][j] * v1[j] + wv[2][j] * vx;
          o[j] = silu_f(ag) * av;
          g2[j] = g1[j]; g1[j] = gx; v2[j] = v1[j]; v1[j] = vx;
        }
        if (R >= 2 && t < L) {
          u32x4 pk; pk[0] = pack2(o[0], o[1]); pk[1] = pack2(o[2], o[3]); pk[2] = pack2(o[4], o[5]); pk[3] = pack2(o[6], o[7]);
          *(u32x4*)(ACT + (size_t)t * 2816 + ch) = pk;
        }
      }
    }
    __syncthreads();
  }
}

DEV void phase_down8(const Params& p, int b, char* smem) {
  for (int kk = 0;; ++kk) {
    const int it = tile_index(kk);
    if (it >= 256) break;
    const int mt = it >> 3, nt = it & 7;
    f32x4 acc[4][4];
    ZERO_ACC(acc, 4)
    gemm_tile8<4>(acc, (const u16*)(p.ws + OFF_ACT), 2816, NMETA + mt * 256, L - 1, (const u16*)(p.ws + OFF_WDOWN), 2816, nt * 128, 2816, smem);
    const int tid = get_tid8(), lane = tid & 63, w = tid >> 6, wm = w >> 1, wn = w & 1, r = lane & 31, h = lane >> 5;
    float* reg = (float*)(smem + w * EPI_WAVE_BYTES);
#pragma unroll
    for (int m = 0; m < 4; ++m)
#pragma unroll
      for (int n = 0; n < 4; ++n)
#pragma unroll
        for (int j = 0; j < 4; ++j) reg[(m * 16 + (lane >> 4) * 4 + j) * 68 + n * 16 + (lane & 15)] = acc[m][n][j];
    EPI_FENCE();
#pragma unroll
    for (int j = 0; j < 16; ++j) {
      const int row = (lane >> 4) + 4 * j, c4 = (lane & 15) * 4;
      const f32x4 a = *(const f32x4*)(reg + row * 68 + c4);
      const size_t idx = ((size_t)b * SEQ + mt * 256 + wm * 64 + row) * 1024 + nt * 128 + wn * 64 + c4;
      const f32x4 x = *(const f32x4*)(p.out + idx);
      *(f32x4*)(p.out + idx) = x + a;
    }
    __syncthreads();
  }
}

#define XB_TMO      128
#define XB_XCNT(j)  (256  + 64 * (j))
#define XB_XSUB(j)  (1280 + 64 * (j))
#define XB_XGEN(j)  (2304 + 64 * (j))
#define XB_TOP      3328
#define XB_TOPGEN   3392
#define XCD_BAR_WORDS 3456
#define XB_SPIN_CAP (1u << 24)
DEV unsigned xb_ld(unsigned* p)              { return __hip_atomic_load(p, __ATOMIC_RELAXED, __HIP_MEMORY_SCOPE_AGENT); }
DEV unsigned xb_add(unsigned* p, unsigned v) { return __hip_atomic_fetch_add(p, v, __ATOMIC_RELAXED, __HIP_MEMORY_SCOPE_AGENT); }
DEV unsigned xb_xcc_id() { return (unsigned)__builtin_amdgcn_s_getreg((3 << 11) | 20) & 0xFu; }
#define XB_SPIN(cond, bar) do { unsigned _sp = 0; while (cond) { __builtin_amdgcn_s_sleep(1); \
    if ((++_sp & 255u) == 0u) { if (xb_ld(&(bar)[XB_TMO])) break; if (_sp > XB_SPIN_CAP) { atomicAdd(&(bar)[XB_TMO], 1u); break; } } } } while (0)
struct XcdBarrier { unsigned* bar; unsigned x; volatile LDSP unsigned* st; };
DEV XcdBarrier xcd_barrier_post(unsigned* bar, volatile LDSP unsigned* st) {
  XcdBarrier b; b.bar = bar; b.x = xb_xcc_id(); b.st = st;
  if (threadIdx.x == 0) (void)xb_add(&bar[XB_XCNT(b.x)], 1u);
  return b;
}
DEV void xcd_barrier_complete(unsigned* bar, unsigned x, unsigned& nloc, unsigned& nx) {
  const unsigned G = gridDim.x * gridDim.y * gridDim.z;
  unsigned sum, cnt, mine, sp = 0u;
  for (;;) {
    sum = 0u; cnt = 0u; mine = 0u;
#pragma unroll
    for (unsigned j = 0; j < 16; ++j) { const unsigned c = xb_ld(&bar[XB_XCNT(j)]); sum += c; cnt += (c > 0u) ? 1u : 0u; mine = (j == x) ? c : mine; }
    if (sum == G) break;
    __builtin_amdgcn_s_sleep(1);
    if ((++sp & 255u) == 0u) { if (xb_ld(&bar[XB_TMO])) break; if (sp > XB_SPIN_CAP) { atomicAdd(&bar[XB_TMO], 1u); break; } }
  }
  nloc = mine > 0u ? mine : 1u; nx = cnt > 0u ? cnt : 1u;
}
DEV void xcd_barrier(const XcdBarrier& b) {
  asm volatile("s_waitcnt vmcnt(0)" ::: "memory");
  __syncthreads();
  if (threadIdx.x == 0) {
    unsigned* bar = b.bar;
    __builtin_amdgcn_s_waitcnt(0);
    unsigned nloc = b.st[0], nx = b.st[1];
    if (nloc == 0u) { xcd_barrier_complete(bar, b.x, nloc, nx); b.st[0] = nloc; b.st[1] = nx; }
    const unsigned old = xb_add(&bar[XB_XSUB(b.x)], 1u);
    const unsigned gen = old / nloc;
    if (old + 1u == (gen + 1u) * nloc) {
      __builtin_amdgcn_fence(__ATOMIC_RELEASE, "agent");
      asm volatile("s_waitcnt vmcnt(0)" ::: "memory");
      const unsigned og = xb_add(&bar[XB_TOP], 1u);
      const unsigned tg = og / nx;
      if (og + 1u == (tg + 1u) * nx) xb_add(&bar[XB_TOPGEN], 1u);
      else XB_SPIN(xb_ld(&bar[XB_TOPGEN]) == tg, bar);
      __builtin_amdgcn_fence(__ATOMIC_ACQUIRE, "agent");
      xb_add(&bar[XB_XGEN(b.x)], 1u);
      asm volatile("s_waitcnt vmcnt(0)" ::: "memory");
    } else {
      XB_SPIN(xb_ld(&bar[XB_XGEN(b.x)]) == gen, bar);
      __builtin_amdgcn_fence(__ATOMIC_ACQUIRE, "agent");
      asm volatile("s_waitcnt vmcnt(0)" ::: "memory");
    }
  }
  __syncthreads();
}

constexpr int N_PHASES = 19;

__global__ void __launch_bounds__(512) fwd_kernel(Params p, int ph0, int ph1) {
  __shared__ __attribute__((aligned(16))) char smem[SMEM_BYTES];
  __shared__ uint4 xb_words;
  if (threadIdx.x == 0) xb_words = make_uint4(0u, 0u, 0u, 0u);
  __syncthreads();
  XcdBarrier xb = xcd_barrier_post((unsigned*)(p.ws + OFF_BAR), (volatile LDSP unsigned*)&xb_words);
  if (ph1 < 0) cg::this_grid().sync();
  for (int ph = ph0; ph < ph1; ++ph) {
    char* tsm = smem + (get_tid8() >> 8) * SMEM_TEAM;
    const int b = ph >= 10 ? 1 : 0;
    const int lp = (ph == 0) ? 0 : (ph == 18 ? 9 : (ph >= 10 ? ph - 9 : ph));
    switch (lp) {
      case 0: phase_prep(p, 0, true, tsm); break;
      case 1: phase_inproj8(p, b, smem); break;
      case 2: {
        int it = get_bid();
        for (; it < 1024; it += nworkers()) ret_kv_item(p, it, tsm);
        for (; it < 2048; it += nworkers()) ssd_state_item(p, it - 1024, tsm);
      } break;
      case 3: phase_scan(p); break;
      case 4: {
        {
          const int rb0 = get_rbid(), rb = (rb0 & 7) * 32 + (rb0 >> 3), team = get_tid8() >> 8;
          for (int j = 0; j < 3; ++j) {
            int kind = -1, idx = 0;
            if (j == 0) {
              if (rb >= 2) { const int k = rb - 2; kind = 0; idx = (1 + (k >> 1)) * 4 + (k & 1) * 2 + team; }
            } else if (j == 1) {
              kind = 1; idx = rb * 2 + team;
            } else {
              if (rb < 2) { kind = 1; idx = (256 + rb) * 2 + team; }
              else if (rb < 6) { const int k = rb - 2; kind = 0; idx = ((k >> 1) ? 0 : 128) * 4 + (k & 1) * 2 + team; }
            }
            if (kind == 0) ret_out_item(p, idx, tsm);
            else if (kind == 1) ssd_out_item(p, idx, tsm);
          }
        }
      } break;
      case 5: phase_merge8(p, smem, tsm); break;
      case 6: phase_outproj8(p, b, smem); break;
      case 7: phase_up8(p, smem); break;
      case 8: phase_down8(p, b, smem); break;
      case 9: {
        if (ph == 9) { phase_final_norm(p, 0); phase_prep(p, 1, false, tsm); }
        else phase_final_norm(p, 1);
      } break;
    }
    if (ph + 1 < ph1) xcd_barrier(xb);
  }
}

#ifndef MK_SINGLE
#define MK_SINGLE 1
#endif

extern "C" void kernel_launch(void* const* d_in, const int* in_sizes, int n_in, void* d_out, int out_size, void* d_ws, size_t ws_size,
                              hipStream_t stream) {
  static int grid_blocks = 0;
  if (!grid_blocks) {
    int dev = 0, cus = 0, per_cu = 0;
    hipGetDevice(&dev);
    hipDeviceGetAttribute(&cus, hipDeviceAttributeMultiprocessorCount, dev);
    hipOccupancyMaxActiveBlocksPerMultiprocessor(&per_cu, fwd_kernel, 512, 0);
    per_cu = 1;
    if (cus != 256) fprintf(stderr, "kernel_launch: built for a 256-CU device (static phase schedules assume 256 workgroups), found %d CUs\n", cus);
    cus = 256;
    grid_blocks = cus * per_cu;
  }
  Params p{};
  for (int i = 0; i < 19; ++i) p.in[i] = (const float*)d_in[i];
  p.out = (float*)d_out;
  p.ws = (char*)d_ws;
#if MK_SINGLE
  (void)hipMemsetAsync((char*)d_ws + OFF_BAR, 0, XCD_BAR_WORDS * 4, stream);
  int ph0 = 0, ph1 = N_PHASES;
  void* args[] = {&p, &ph0, &ph1};
  hipError_t e = hipLaunchCooperativeKernel((void*)fwd_kernel, dim3(grid_blocks), dim3(512), args, 0, stream);
  if (e != hipSuccess) fprintf(stderr, "cooperative launch failed: %s (grid %d)\n", hipGetErrorString(e), grid_blocks);
#else
  for (int ph = 0; ph < N_PHASES; ++ph) {
    hipLaunchKernelGGL(fwd_kernel, dim3(grid_blocks), dim3(512), 0, stream, p, ph, ph + 1);
  }
#endif
}
```
